# Optimizing an MI355X kernel written in HIP

```python
import math
import jax
import jax.numpy as jnp
from jax import lax
import numpy as np

D_MODEL = 1024
BATCH = 8
SEQ = 2048
DEPTH = 2

GRID_W = 64
CTX_LEN = 256
NORM_EPS = 1e-6

RW_HEAD_DIM = 64
RW_DIM = D_MODEL // 2
RW_HEADS = RW_DIM // RW_HEAD_DIM
RW_LORA_W = 32
RW_LORA_A = 32
RW_LORA_G = 96
RW_GN_EPS = 64e-5
RW_COLS = 3 * RW_DIM + 2 * RW_LORA_W + 2 * RW_LORA_A + RW_LORA_G
RW_SPLITS = (RW_DIM, 2 * RW_DIM, 3 * RW_DIM, 3 * RW_DIM + 2 * RW_LORA_W, 3 * RW_DIM + 2 * RW_LORA_W + 2 * RW_LORA_A)

MB_HEAD_DIM = 64
MB_DIM = D_MODEL // 2
MB_HEADS = MB_DIM // MB_HEAD_DIM
MB_GROUPS = 2
MB_STATE = 128
MB_CONV = 5
MB_CHUNK = 128
MB_XBC = MB_DIM + 2 * MB_GROUPS * MB_STATE
MB_COLS = MB_DIM + MB_XBC + 2 * MB_HEADS
MB_SPLITS = (MB_DIM, MB_DIM + MB_XBC)

MIX_IN = RW_COLS + MB_COLS
MIX_OUT = RW_DIM + MB_DIM

NA_HEAD_DIM = 64
NA_HEADS = D_MODEL // NA_HEAD_DIM
NA_KH = 8
NA_KW = 16
NA_QB = 16
NA_KB = 32

D_FF = 2816
N_EXPERTS = 8
TOP_K = 2

kernel_name = 'hybrid_rwkv7_mamba2_natten_moe_dit'


def _rms_norm(h, g):
    hf = h.astype(jnp.float32)
    hf = hf * lax.rsqrt(jnp.mean(hf * hf, axis=-1, keepdims=True) + NORM_EPS)
    return (hf * g.astype(jnp.float32)).astype(h.dtype)


def _modulate(h, shift, scale):
    return h * (1 + scale) + shift


def _heads(t, n_heads):
    return t.reshape(t.shape[:-1] + (n_heads, t.shape[-1] // n_heads))


def _swiglu(h, w1, w3, w2):
    return (jax.nn.silu(h @ w1) * (h @ w3)) @ w2


def _centred_shift(z, mu_prev, mu_next):
    z_prev = jnp.pad(z, ((0, 0), (1, 0), (0, 0)))[:, :-1]
    z_next = jnp.pad(z, ((0, 0), (0, 1), (0, 0)))[:, 1:]
    return z + mu_prev * (z_prev - z) + mu_next * (z_next - z)


def _centred_dwconv(x, w, b):
    k_w, ch = w.shape
    y = lax.conv_general_dilated(x, w[:, None, :].astype(x.dtype), window_strides=(1,),
                                 padding=[(k_w // 2, k_w // 2)],
                                 dimension_numbers=('NWC', 'WIO', 'NWC'), feature_group_count=ch)
    return y + b


def _rwkv7_scan(s0, r, w, k, v, a, b):
    def step(S, inp):
        r_t, w_t, k_t, v_t, a_t, b_t = inp
        sa = jnp.einsum('bhvk,bhk->bhv', S, a_t)
        S = S * w_t[:, :, None, :] + sa[..., None] * b_t[:, :, None, :] + v_t[..., None] * k_t[:, :, None, :]
        return S, jnp.einsum('bhvk,bhk->bhv', S, r_t)
    xs = tuple(jnp.moveaxis(t, 1, 0) for t in (r, w, k, v, a, b))
    s_fin, ys = lax.scan(step, s0, xs)
    return s_fin, jnp.moveaxis(ys, 0, 1)


def _segsum(x):
    n = x.shape[-1]
    cs = jnp.cumsum(x, axis=-1)
    return jnp.where(np.tril(np.ones((n, n), dtype=bool)), cs[..., :, None] - cs[..., None, :], -jnp.inf)


def _ssd_chunked(s0, X, A, Bm, Cm):
    b, t, nh, p = X.shape
    n = Bm.shape[-1]
    nc, cl = t // MB_CHUNK, MB_CHUNK
    X = X.reshape(b, nc, cl, nh, p)
    Bm = Bm.reshape(b, nc, cl, nh, n)
    Cm = Cm.reshape(b, nc, cl, nh, n)
    A = A.reshape(b, nc, cl, nh).transpose(0, 3, 1, 2)
    A_cs = jnp.cumsum(A, axis=-1)
    L = jnp.exp(_segsum(A))
    y_diag = jnp.einsum('bclhn,bcshn,bhcls,bcshp->bclhp', Cm, Bm, L, X)
    decay_states = jnp.exp(A_cs[..., -1:] - A_cs)
    states = jnp.einsum('bclhn,bhcl,bclhp->bchpn', Bm, decay_states, X)
    states = jnp.concatenate([s0[:, None], states], axis=1)
    chunk_decay = jnp.exp(_segsum(jnp.pad(A_cs[..., -1], ((0, 0), (0, 0), (1, 0)))))
    states = jnp.einsum('bhzc,bchpn->bzhpn', chunk_decay, states)
    y_off = jnp.einsum('bclhn,bchpn,bhcl->bclhp', Cm, states[:, :-1], jnp.exp(A_cs))
    return states[:, -1], (y_diag + y_off).reshape(b, t, nh, p)


def _prefix_scan(scan_fn, ctx_args, lat_args, s0, reverse):
    if reverse:
        ctx_args = tuple(jnp.flip(t, axis=1) for t in ctx_args)
        lat_args = tuple(jnp.flip(t, axis=1) for t in lat_args)
    s_ctx, y_ctx = scan_fn(s0, *ctx_args)
    _, y_lat = scan_fn(s_ctx, *lat_args)
    if reverse:
        y_ctx, y_lat = jnp.flip(y_ctx, axis=1), jnp.flip(y_lat, axis=1)
    return y_ctx, y_lat


def _rwkv_mamba_mixer(a_ctx, a_lat, w_in, w_out, rw_mu, rw_w0, rw_w_up, rw_a0, rw_a_up, rw_g_up,
                      rw_k_k, rw_k_a, rw_r_k, rw_gn_w, rw_gn_b, mb_conv_w, mb_conv_b,
                      mb_dt_bias, mb_a_log, mb_d, mb_norm_w):
    f32 = jnp.float32

    def prepare(h):
        b, t, _ = h.shape
        z = h @ w_in
        z_rw = _centred_shift(z[..., :RW_COLS], rw_mu[0], rw_mu[1])
        r, k, v, lw, la, lg = jnp.split(z_rw, RW_SPLITS, axis=-1)
        lw = lw.reshape(b, t, 2, RW_LORA_W)
        la = la.reshape(b, t, 2, RW_LORA_A)
        logw = (rw_w0 + jnp.einsum('btdl,dlc->btdc', jnp.tanh(lw), rw_w_up)).astype(f32)
        decay = jnp.exp(-jnp.exp(-jax.nn.softplus(-logw) - 0.5))
        iclr = jax.nn.sigmoid((rw_a0 + jnp.einsum('btdl,dlc->btdc', la, rw_a_up)).astype(f32))
        gate = jax.nn.sigmoid(lg) @ rw_g_up
        kk = _heads(k * rw_k_k, RW_HEADS).astype(f32)
        kk = kk / jnp.maximum(jnp.sqrt(jnp.sum(kk * kk, axis=-1, keepdims=True)), 1e-12)
        k_dir = _heads((k[:, :, None, :] * (1 + (iclr - 1) * rw_k_a)).astype(f32), RW_HEADS)
        rh = _heads(r.astype(f32), RW_HEADS)
        vh = _heads(v.astype(f32), RW_HEADS)
        dh = _heads(decay, RW_HEADS)
        ih = _heads(iclr, RW_HEADS)
        rw_args = [(rh, dh[:, :, d], k_dir[:, :, d], vh, -kk, kk * ih[:, :, d]) for d in range(2)]
        bonus_f = jnp.sum(rh * k_dir[:, :, 0] * rw_r_k[0].astype(f32), axis=-1, keepdims=True)
        bonus_b = jnp.sum(rh * k_dir[:, :, 1] * rw_r_k[1].astype(f32), axis=-1, keepdims=True)
        bonus = (bonus_f + bonus_b) * vh
        zg, xbc, dt_raw = jnp.split(z[..., RW_COLS:], MB_SPLITS, axis=-1)
        xbc = jax.nn.silu(_centred_dwconv(xbc, mb_conv_w, mb_conv_b))
        xm, bm, cm = jnp.split(xbc, (MB_DIM, MB_DIM + MB_GROUPS * MB_STATE), axis=-1)
        xm = _heads(xm.astype(f32), MB_HEADS)
        rep = MB_HEADS // MB_GROUPS
        bm = jnp.repeat(_heads(bm.astype(f32), MB_GROUPS), rep, axis=2)
        cm = jnp.repeat(_heads(cm.astype(f32), MB_GROUPS), rep, axis=2)
        dt = jax.nn.softplus(dt_raw.reshape(b, t, 2, MB_HEADS).astype(f32) + mb_dt_bias.astype(f32))
        a_neg = -jnp.exp(mb_a_log.astype(f32))
        mb_args = [(xm * dt[:, :, d, :, None], dt[:, :, d] * a_neg[d], bm, cm) for d in range(2)]
        return rw_args, mb_args, bonus, gate, xm, zg

    pc, pl = prepare(a_ctx), prepare(a_lat)
    bsz = a_lat.shape[0]
    s0_rw = jnp.zeros((bsz, RW_HEADS, RW_HEAD_DIM, RW_HEAD_DIM), f32)
    s0_mb = jnp.zeros((bsz, MB_HEADS, MB_HEAD_DIM, MB_STATE), f32)
    yrf_c, yrf_l = _prefix_scan(_rwkv7_scan, pc[0][0], pl[0][0], s0_rw, False)
    yrb_c, yrb_l = _prefix_scan(_rwkv7_scan, pc[0][1], pl[0][1], s0_rw, True)
    ymf_c, ymf_l = _prefix_scan(_ssd_chunked, pc[1][0], pl[1][0], s0_mb, False)
    ymb_c, ymb_l = _prefix_scan(_ssd_chunked, pc[1][1], pl[1][1], s0_mb, True)

    def finish(h, p, y_rw, y_mb):
        b, t, _ = h.shape
        _, _, bonus, gate, xm, zg = p
        mu = jnp.mean(y_rw, axis=-1, keepdims=True)
        var = jnp.mean(jnp.square(y_rw - mu), axis=-1, keepdims=True)
        y_rw = ((y_rw - mu) * lax.rsqrt(var + RW_GN_EPS)).reshape(b, t, RW_DIM) * rw_gn_w + rw_gn_b
        o_rw = (y_rw + bonus.reshape(b, t, RW_DIM)) * gate
        y_mb = (y_mb + mb_d.astype(f32)[:, None] * xm).reshape(b, t, MB_DIM) * jax.nn.silu(zg.astype(f32))
        y_mb = y_mb.reshape(b, t, MB_GROUPS, MB_DIM // MB_GROUPS)
        y_mb = (y_mb * lax.rsqrt(jnp.mean(y_mb * y_mb, axis=-1, keepdims=True) + NORM_EPS)).reshape(b, t, MB_DIM) * mb_norm_w
        return jnp.concatenate([o_rw, y_mb], axis=-1).astype(h.dtype) @ w_out

    return (finish(a_ctx, pc, yrf_c + yrb_c, ymf_c + ymb_c),
            finish(a_lat, pl, yrf_l + yrb_l, ymf_l + ymb_l))


def _neighbourhood_attention(a_ctx, a_lat, w_qkv, w_out, rpb, with_ctx_queries):
    b, t, d_model = a_lat.shape
    rows = t // GRID_W
    kh = min(NA_KH, rows)
    scale = NA_HEAD_DIM ** -0.5
    q, k, v = jnp.split(a_lat @ w_qkv, 3, axis=-1)
    qc, kc, vc = jnp.split(a_ctx @ w_qkv, 3, axis=-1)
    q_grid = (_heads(q, NA_HEADS) * scale).reshape(b, rows, GRID_W, NA_HEADS, NA_HEAD_DIM)
    k_grid = _heads(k, NA_HEADS).reshape(b, rows, GRID_W, NA_HEADS, NA_HEAD_DIM)
    v_grid = _heads(v, NA_HEADS).reshape(b, rows, GRID_W, NA_HEADS, NA_HEAD_DIM)
    qc, kc, vc = _heads(qc, NA_HEADS) * scale, _heads(kc, NA_HEADS), _heads(vc, NA_HEADS)

    n_cb = GRID_W // NA_QB
    q_cols = np.arange(GRID_W).reshape(n_cb, NA_QB)
    kb_start = np.clip(np.arange(n_cb) * NA_QB - NA_KW // 2, 0, GRID_W - NA_KB)
    key_cols = kb_start[:, None] + np.arange(NA_KB)
    win_start = np.clip(q_cols - NA_KW // 2, 0, GRID_W - NA_KW)
    kcol = key_cols[:, None, :]
    col_in = (kcol >= win_start[..., None]) & (kcol < win_start[..., None] + NA_KW)
    col_bias_idx = np.clip(kcol - q_cols[:, :, None] + NA_KW - 1, 0, 2 * NA_KW - 2)
    mask = np.broadcast_to(col_in[:, :, None, :], (n_cb, NA_QB, kh, NA_KB)).reshape(n_cb, NA_QB, kh * NA_KB)
    n_lat = kh * NA_KB

    def row_block(r):
        rs = jnp.clip(r - kh // 2, 0, rows - kh)
        k_rows = lax.dynamic_slice_in_dim(k_grid, rs, kh, axis=1)
        v_rows = lax.dynamic_slice_in_dim(v_grid, rs, kh, axis=1)
        k_blk = k_rows[:, :, key_cols].transpose(0, 2, 1, 3, 4, 5).reshape(b, n_cb, n_lat, NA_HEADS, NA_HEAD_DIM)
        v_blk = v_rows[:, :, key_cols].transpose(0, 2, 1, 3, 4, 5).reshape(b, n_cb, n_lat, NA_HEADS, NA_HEAD_DIM)
        q_blk = lax.dynamic_index_in_dim(q_grid, r, axis=1, keepdims=False).reshape(b, n_cb, NA_QB, NA_HEADS, NA_HEAD_DIM)
        row_idx = rs + jnp.arange(kh) - r + (NA_KH - 1)
        bias = rpb[:, row_idx][:, :, col_bias_idx]
        bias = bias.transpose(0, 2, 3, 1, 4).reshape(NA_HEADS, n_cb, NA_QB, n_lat).astype(jnp.float32)
        s_lat = jnp.einsum('bjqhd,bjkhd->bhjqk', q_blk, k_blk).astype(jnp.float32) + bias
        s_lat = jnp.where(mask, s_lat, -jnp.inf)
        s_ctx = jnp.einsum('bjqhd,bkhd->bhjqk', q_blk, kc).astype(jnp.float32)
        p = jax.nn.softmax(jnp.concatenate([s_lat, s_ctx], axis=-1), axis=-1).astype(v.dtype)
        o = (jnp.einsum('bhjqk,bjkhd->bjqhd', p[..., :n_lat], v_blk)
             + jnp.einsum('bhjqk,bkhd->bjqhd', p[..., n_lat:], vc))
        return o.reshape(b, GRID_W, d_model)

    o_rows = lax.map(row_block, jnp.arange(rows))
    o_lat = o_rows.transpose(1, 0, 2, 3).reshape(b, t, d_model) @ w_out
    o_ctx = None
    if with_ctx_queries:
        s = jnp.einsum('bqhd,bkhd->bhqk', qc, kc).astype(jnp.float32)
        p = jax.nn.softmax(s, axis=-1).astype(vc.dtype)
        o_ctx = jnp.einsum('bhqk,bkhd->bqhd', p, vc).reshape(a_ctx.shape) @ w_out
    return o_ctx, o_lat


def _moe_swiglu(h, router_w, router_b, w1, w3, w2):
    logits = (h @ router_w).astype(jnp.float32) + router_b.astype(jnp.float32)
    top_vals, top_idx = lax.top_k(logits, TOP_K)
    top_w = jax.nn.softmax(top_vals, axis=-1)
    gates = jnp.sum(jax.nn.one_hot(top_idx, N_EXPERTS, dtype=jnp.float32) * top_w[..., None], axis=-2).astype(h.dtype)
    out = jnp.zeros_like(h)
    for e in range(N_EXPERTS):
        out = out + gates[..., e:e + 1] * _swiglu(h, w1[e], w3[e], w2[e])
    return out


def setup_inputs(seed: int = 0) -> dict:
    key = jax.random.key(seed)
    keys = iter(jax.random.split(key, 64))
    d = D_MODEL
    ne, no = (DEPTH + 1) // 2, DEPTH // 2

    def nrm(shape, scale):
        return scale * jax.random.normal(next(keys), shape, jnp.float32)

    def uni(shape, lo, hi):
        return jax.random.uniform(next(keys), shape, jnp.float32, lo, hi)

    dt0 = jnp.exp(uni((ne, 2, MB_HEADS), math.log(1e-3), math.log(1e-1)))
    return {
        'x': nrm((BATCH, SEQ, d), 1.0),
        'c': nrm((BATCH, d), 1.0),
        'ctx': nrm((BATCH, CTX_LEN, d), 1.0),
        'c_ctx': nrm((d,), 1.0),
        'w_ada': nrm((DEPTH, d, 6 * d), 0.5 * d ** -0.5),
        'b_ada': nrm((DEPTH, 6 * d), 0.02),
        'norm_mix': 1.0 + nrm((DEPTH, d), 0.05),
        'norm_ffn': 1.0 + nrm((DEPTH, d), 0.05),
        'norm_final': 1.0 + nrm((d,), 0.05),
        'mix_w_in': nrm((ne, d, MIX_IN), d ** -0.5),
        'mix_w_out': nrm((ne, MIX_OUT, d), MIX_OUT ** -0.5),
        'rw_mu': uni((ne, 2, RW_COLS), 0.0, 0.5),
        'rw_w0': uni((ne, 2, RW_DIM), -6.0, 1.0),
        'rw_w_up': nrm((ne, 2, RW_LORA_W, RW_DIM), 0.5 * RW_LORA_W ** -0.5),
        'rw_a0': nrm((ne, 2, RW_DIM), 0.5),
        'rw_a_up': nrm((ne, 2, RW_LORA_A, RW_DIM), 0.5 * RW_LORA_A ** -0.5),
        'rw_g_up': nrm((ne, RW_LORA_G, RW_DIM), RW_LORA_G ** -0.5),
        'rw_k_k': 0.85 + nrm((ne, RW_DIM), 0.05),
        'rw_k_a': 1.0 + nrm((ne, RW_DIM), 0.05),
        'rw_r_k': nrm((ne, 2, RW_HEADS, RW_HEAD_DIM), 0.1),
        'rw_gn_w': 1.0 + nrm((ne, RW_DIM), 0.05),
        'rw_gn_b': nrm((ne, RW_DIM), 0.02),
        'mb_conv_w': nrm((ne, MB_CONV, MB_XBC), MB_CONV ** -0.5),
        'mb_conv_b': nrm((ne, MB_XBC), 0.02),
        'mb_dt_bias': dt0 + jnp.log(-jnp.expm1(-dt0)),
        'mb_a_log': jnp.log(uni((ne, 2, MB_HEADS), 1.0, 16.0)),
        'mb_d': 1.0 + nrm((ne, MB_HEADS), 0.1),
        'mb_norm_w': 1.0 + nrm((ne, MB_DIM), 0.05),
        'ffn_w1': nrm((ne, d, D_FF), d ** -0.5),
        'ffn_w3': nrm((ne, d, D_FF), d ** -0.5),
        'ffn_w2': nrm((ne, D_FF, d), D_FF ** -0.5),
        'na_w_qkv': nrm((no, d, 3 * d), d ** -0.5),
        'na_w_out': nrm((no, d, d), d ** -0.5),
        'na_rpb': nrm((no, NA_HEADS, 2 * NA_KH - 1, 2 * NA_KW - 1), 0.1),
        'moe_router_w': nrm((no, d, N_EXPERTS), d ** -0.5),
        'moe_router_b': nrm((no, N_EXPERTS), 0.01),
        'moe_w1': nrm((no, N_EXPERTS, d, D_FF), d ** -0.5),
        'moe_w3': nrm((no, N_EXPERTS, d, D_FF), d ** -0.5),
        'moe_w2': nrm((no, N_EXPERTS, D_FF, d), D_FF ** -0.5),
    }


def reference(x, c, ctx, c_ctx, w_ada, b_ada, norm_mix, norm_ffn, norm_final, mix_w_in, mix_w_out,
              rw_mu, rw_w0, rw_w_up, rw_a0, rw_a_up, rw_g_up, rw_k_k, rw_k_a, rw_r_k, rw_gn_w, rw_gn_b,
              mb_conv_w, mb_conv_b, mb_dt_bias, mb_a_log, mb_d, mb_norm_w, ffn_w1, ffn_w3, ffn_w2,
              na_w_qkv, na_w_out, na_rpb, moe_router_w, moe_router_b, moe_w1, moe_w3, moe_w2):
    h_ctx, h_lat = ctx, x
    c_lat_act, c_ctx_act = jax.nn.silu(c), jax.nn.silu(c_ctx)
    for i in range(DEPTH):
        j = i // 2
        update_ctx = i < DEPTH - 1
        m_lat = jnp.split((c_lat_act @ w_ada[i] + b_ada[i])[:, None, :], 6, axis=-1)
        m_ctx = jnp.split(c_ctx_act @ w_ada[i] + b_ada[i], 6, axis=-1)
        a_lat = _modulate(_rms_norm(h_lat, norm_mix[i]), m_lat[0], m_lat[1])
        a_ctx = _modulate(_rms_norm(h_ctx, norm_mix[i]), m_ctx[0], m_ctx[1])
        if i % 2 == 0:
            o_ctx, o_lat = _rwkv_mamba_mixer(a_ctx, a_lat, mix_w_in[j], mix_w_out[j], rw_mu[j], rw_w0[j],
                                             rw_w_up[j], rw_a0[j], rw_a_up[j], rw_g_up[j], rw_k_k[j],
                                             rw_k_a[j], rw_r_k[j], rw_gn_w[j], rw_gn_b[j], mb_conv_w[j],
                                             mb_conv_b[j], mb_dt_bias[j], mb_a_log[j], mb_d[j], mb_norm_w[j])
        else:
            o_ctx, o_lat = _neighbourhood_attention(a_ctx, a_lat, na_w_qkv[j], na_w_out[j], na_rpb[j], update_ctx)

        def channel_mixer(t):
            if i % 2 == 0:
                return _swiglu(t, ffn_w1[j], ffn_w3[j], ffn_w2[j])
            return _moe_swiglu(t, moe_router_w[j], moe_router_b[j], moe_w1[j], moe_w3[j], moe_w2[j])

        h_lat = h_lat + m_lat[2] * o_lat
        h_lat = h_lat + m_lat[5] * channel_mixer(_modulate(_rms_norm(h_lat, norm_ffn[i]), m_lat[3], m_lat[4]))
        if update_ctx:
            h_ctx = h_ctx + m_ctx[2] * o_ctx
            h_ctx = h_ctx + m_ctx[5] * channel_mixer(_modulate(_rms_norm(h_ctx, norm_ffn[i]), m_ctx[3], m_ctx[4]))
    return _rms_norm(h_lat, norm_final)
```

```cpp
#include <hip/hip_runtime.h>
#include <cstdio>
#include <cstdint>
#include <cmath>
#define MK_PER_PHASE 1
namespace pg8 {
#define PG8_LAS __attribute__((address_space(3)))
typedef unsigned short bf16_t;
typedef short bf16x8 __attribute__((ext_vector_type(8)));
typedef float f32x4 __attribute__((ext_vector_type(4)));
typedef unsigned u32x4 __attribute__((ext_vector_type(4)));
constexpr int BM = 256, BK = 64, HALF = 128, HTB = HALF * BK * 2  , STAGE_BYTES = 8 * HTB, NXCD = 8, WGM = 8;

__host__ __device__ __forceinline__ int lds_byte(int r, int c) { const int st = (r >> 4) * 2 + (c >> 5), rr = r & 15, cc = c & 31, ob = rr * 64 + cc * 2; return st * 1024 + (ob ^ (((ob >> 9) & 1) << 5)); }
__host__ __device__ __forceinline__ void stage_rc(int b, int& R, int& C) { const int st = b / 1024, sb = b % 1024, swz = sb ^ (((sb >> 9) & 1) << 5); R = (st >> 1) * 16 + swz / 64; C = (st & 1) * 32 + (swz % 64) / 2; }
__host__ __device__ __forceinline__ int perm32(int rho) { const int n = rho >> 4, i = rho & 15; return 8 * (i >> 2) + 4 * n + (i & 3); }

struct Unit { int pm, pn; };
struct Gemm { const bf16_t* A; const bf16_t* Bt; int M, N, K; };

struct StaticOrder {
    int nM, nN, nwg, G, c;
    __host__ __device__ void init(int M, int N, int G_, int c_) { nM = M / BM; nN = N / BM; nwg = nM * nN; G = G_; c = c_; }
    __host__ __device__ bool next(int i, Unit& u) const {
        const long L = (long)i * G + c; if (L >= nwg) return false;
        int wgid = (int)L; { const int q = nwg / NXCD, r = nwg % NXCD, xcd = wgid % NXCD, off = wgid / NXCD; wgid = (xcd < r ? xcd * (q + 1) : r * (q + 1) + (xcd - r) * q) + off; }
        const int nig = WGM * nN, gid = wgid / nig, fm = gid * WGM, gsz = (nM - fm) < WGM ? (nM - fm) : WGM;
        u.pm = fm + ((wgid % nig) % gsz); u.pn = (wgid % nig) / gsz; return true;
    }
    __device__ __forceinline__ void a_ready(const Unit&) const {}
    __device__ __forceinline__ void done(const Unit&) const {}
};

__device__ __forceinline__ unsigned cvt_pk_bf16(float lo, float hi) { unsigned r; asm volatile("v_cvt_pk_bf16_f32 %0, %1, %2" : "=v"(r) : "v"(lo), "v"(hi)); return r; }
typedef float f32x2 __attribute__((ext_vector_type(2)));
__device__ __forceinline__ f32x2 gelu_pk(f32x2 v) {
    const f32x2 av = __builtin_elementwise_abs(v), d = av * 0.2316418882f + 1.0f;
    f32x2 t; t.x = __builtin_amdgcn_rcpf(d.x); t.y = __builtin_amdgcn_rcpf(d.y);
    f32x2 q = t * 0.5307027145f + (-0.7265760135f); q = q * t + 0.7107068705f; q = q * t + (-0.142248368f); q = q * t + 0.127414796f; q = q * t;
    const f32x2 s = (v * v) * (-0.72134752044f);
    f32x2 e; e.x = __builtin_amdgcn_exp2f(s.x); e.y = __builtin_amdgcn_exp2f(s.y);
    const f32x2 m = v * (q * e), r = v - m;
    f32x2 o; o.x = v.x < 0.f ? m.x : r.x; o.y = v.y < 0.f ? m.y : r.y; return o;
}

template <int ACT  > struct EpiBf16 {
    static constexpr bool PERM = true, AFTER_DRAIN = false; static_assert(ACT == 0 || ACT == 1, "EpiBf16: ACT is 0 (none) or 1 (gelu_pk)");
    bf16_t* O; int ldc; const float* bias; int split_cols; size_t split_stride; float scale0;
    __device__ __forceinline__ void operator()(const f32x4 (&acc)[2][2][4][2], const Unit& u, int wr, int wc, int fr, int fq) const {
        const int row0 = u.pm * BM + wr * 64 + fr; int colt = u.pn * BM; bf16_t* base = O;
        float sc = 1.f; if (split_cols) { const int t = colt / split_cols; base += (size_t)t * split_stride; colt -= t * split_cols; if (t == 0) sc = scale0; }
        const int col0 = colt + wc * 32 + 8 * fq, bcol0 = u.pn * BM + wc * 32 + 8 * fq;
        f32x4 bv[2][2];
#pragma unroll
        for (int bj = 0; bj < 2; ++bj)
#pragma unroll
            for (int n = 0; n < 2; ++n) bv[bj][n] = bias ? *(const f32x4*)(bias + bcol0 + bj * HALF + 4 * n) : (f32x4){0.f, 0.f, 0.f, 0.f};
#pragma unroll
        for (int ai = 0; ai < 2; ++ai)
#pragma unroll
            for (int m = 0; m < 4; ++m) { bf16_t* rowp = base + (size_t)(row0 + ai * HALF + m * 16) * ldc + col0;
#pragma unroll
                for (int bj = 0; bj < 2; ++bj) { f32x4 v0 = acc[ai][bj][m][0] + bv[bj][0], v1 = acc[ai][bj][m][1] + bv[bj][1];
                    if (ACT == 1) { f32x2 a = gelu_pk((f32x2){v0[0], v0[1]}), b = gelu_pk((f32x2){v0[2], v0[3]}), c = gelu_pk((f32x2){v1[0], v1[1]}), d = gelu_pk((f32x2){v1[2], v1[3]});
                        v0 = (f32x4){a.x, a.y, b.x, b.y}; v1 = (f32x4){c.x, c.y, d.x, d.y}; }
                    v0 = v0 * sc; v1 = v1 * sc; u32x4 w; w.x = cvt_pk_bf16(v0[0], v0[1]); w.y = cvt_pk_bf16(v0[2], v0[3]); w.z = cvt_pk_bf16(v1[0], v1[1]); w.w = cvt_pk_bf16(v1[2], v1[3]);
                    *(u32x4*)(rowp + bj * HALF) = w; } }
    }
};
template <class Epi, class Sched, bool ALIGN_EPI = false, bool SP2 = false>
__device__ __forceinline__ void gemm_phase(PG8_LAS unsigned char* lds, const Gemm g, const Sched& S, const Epi& E) {
    const int tid = threadIdx.x, wid = __builtin_amdgcn_readfirstlane(tid >> 6), lane = tid & 63, wr = wid >> 2, wc = wid & 3, fr = lane & 15, fq = lane >> 4;
    const int K = g.K, nt = K / BK;
    unsigned voffA[2], voffB[2];
#pragma unroll
    for (int i = 0; i < 2; ++i) { int R, C; stage_rc(tid * 16 + i * 8192, R, C); const int Rb = Epi::PERM ? ((R & ~31) + perm32(R & 31)) : R;
        voffA[i] = (unsigned)(R * K + C) * 2u; voffB[i] = (unsigned)(Rb * K + C) * 2u; }
    const size_t kstep = (size_t)(BK * 2);
    const size_t hstep = (size_t)HALF * K * 2;
    const size_t tstep = 2 * hstep;
    const unsigned ldsw = (unsigned)wid * 1024u;
    const int aoff = lds_byte(wr * 64 + fr, fq * 8), boff = lds_byte(wc * 32 + fr, fq * 8);
#define PG8_SA(b, h) (((b) * 2 + (h)) * HTB)
#define PG8_SB(b, h) ((4 + (b) * 2 + (h)) * HTB)
#define PG8_STAGE(bufoff, gbase, voff) do { _Pragma("unroll") for (int _i = 0; _i < 2; ++_i) \
        __builtin_amdgcn_global_load_lds((const unsigned*)((const char*)(gbase) + (voff)[_i]), (PG8_LAS unsigned*)(lds + (bufoff) + ldsw + _i * 8192), 16, 0, 0); } while (0)
#define PG8_LDA(dst, b, h) do { _Pragma("unroll") for (int m = 0; m < 4; ++m) _Pragma("unroll") for (int k = 0; k < 2; ++k) dst[m][k] = *(const PG8_LAS bf16x8*)(lds + PG8_SA(b, h) + aoff + m * 2048 + k * 1024); } while (0)
#define PG8_LDB(dst, b, h) do { _Pragma("unroll") for (int n = 0; n < 2; ++n) _Pragma("unroll") for (int k = 0; k < 2; ++k) dst[n][k] = *(const PG8_LAS bf16x8*)(lds + PG8_SB(b, h) + boff + n * 2048 + k * 1024); } while (0)
#define PG8_MMA(ai, bj, At, Bt) do { __builtin_amdgcn_s_setprio(1); _Pragma("unroll") for (int m = 0; m < 4; ++m) _Pragma("unroll") for (int n = 0; n < 2; ++n) _Pragma("unroll") for (int k = 0; k < 2; ++k) \
        acc[ai][bj][m][n] = __builtin_amdgcn_mfma_f32_16x16x32_bf16(Bt[n][k], At[m][k], acc[ai][bj][m][n], 0, 0, 0); __builtin_amdgcn_s_setprio(0); } while (0)
#define PG8_WAIT_V(n) asm volatile("s_waitcnt vmcnt(" #n ")" ::: "memory")
#define PG8_WAIT_L(n) asm volatile("s_waitcnt lgkmcnt(" #n ")" ::: "memory")
#define PG8_BAR __builtin_amdgcn_s_barrier()
#define PG8_SCHED __builtin_amdgcn_sched_barrier(0)
    Unit cur, nxt; int ui = 0;
    if (!S.next(0, cur)) return;
    f32x4 acc[2][2][4][2];
#pragma unroll
    for (int a = 0; a < 2; ++a)
#pragma unroll
        for (int b = 0; b < 2; ++b)
#pragma unroll
            for (int m = 0; m < 4; ++m)
#pragma unroll
                for (int n = 0; n < 2; ++n) acc[a][b][m][n] = (f32x4){0.f, 0.f, 0.f, 0.f};
    bf16x8 At[4][2], B0[2][2], B1[2][2];
    const char* cA = (const char*)g.A + (size_t)cur.pm * tstep; const char* cB = (const char*)g.Bt + (size_t)cur.pn * tstep;
    S.a_ready(cur);
    if constexpr (SP2) {
        PG8_STAGE(PG8_SB(0, 0), cB, voffB); PG8_STAGE(PG8_SB(0, 1), cB + hstep, voffB); PG8_STAGE(PG8_SA(0, 0), cA, voffA); PG8_STAGE(PG8_SA(0, 1), cA + hstep, voffA);
        if (wr == 1) PG8_BAR;
        PG8_WAIT_V(2); PG8_BAR;
        PG8_STAGE(PG8_SB(1, 0), cB + kstep, voffB); PG8_STAGE(PG8_SA(1, 0), cA + kstep, voffA); PG8_STAGE(PG8_SB(1, 1), cB + hstep + kstep, voffB);
        PG8_WAIT_V(6); PG8_BAR;
    } else {
        PG8_STAGE(PG8_SB(0, 0), cB, voffB); PG8_STAGE(PG8_SA(0, 0), cA, voffA); PG8_STAGE(PG8_SB(0, 1), cB + hstep, voffB); PG8_STAGE(PG8_SA(0, 1), cA + hstep, voffA);
        if (wr == 1) PG8_BAR;
        PG8_WAIT_V(4); PG8_BAR;
        PG8_STAGE(PG8_SB(1, 0), cB + kstep, voffB); PG8_STAGE(PG8_SA(1, 0), cA + kstep, voffA); PG8_STAGE(PG8_SB(1, 1), cB + hstep + kstep, voffB);
        PG8_WAIT_V(6); PG8_BAR;
    }
    for (;;) {
        const bool has_next = S.next(ui + 1, nxt);
        const char* nA = has_next ? (const char*)g.A + (size_t)nxt.pm * tstep : cA; const char* nB = has_next ? (const char*)g.Bt + (size_t)nxt.pn * tstep : cB;
        for (int t = 0; t < nt; t += 2) {
            const bool last = (t == nt - 2);
            const char* a1 = cA + (size_t)(t + 1) * kstep;
            const char* a2 = last ? nA : cA + (size_t)(t + 2) * kstep; const char* b2 = last ? nB : cB + (size_t)(t + 2) * kstep;
            const char* a3 = a2 + kstep; const char* b3 = b2 + kstep;
            if (last && has_next) S.a_ready(nxt);
            if constexpr (SP2) {
            PG8_LDB(B0, 0, 0); PG8_LDB(B1, 0, 1); PG8_SCHED; PG8_LDA(At, 0, 0); PG8_STAGE(PG8_SA(1, 1), a1 + hstep, voffA);
            PG8_WAIT_V(8); PG8_WAIT_L(0); PG8_BAR; PG8_MMA(0, 0, At, B0); PG8_MMA(0, 1, At, B1); PG8_BAR; PG8_SCHED;
            PG8_LDA(At, 0, 1); PG8_STAGE(PG8_SB(0, 0), b2, voffB); PG8_STAGE(PG8_SB(0, 1), b2 + hstep, voffB); PG8_STAGE(PG8_SA(0, 0), a2, voffA);
            PG8_WAIT_V(8); PG8_WAIT_L(0); PG8_BAR; PG8_MMA(1, 0, At, B0); PG8_MMA(1, 1, At, B1); PG8_BAR; PG8_SCHED;
            PG8_LDB(B0, 1, 0); PG8_LDB(B1, 1, 1); PG8_SCHED; PG8_LDA(At, 1, 0); PG8_STAGE(PG8_SA(0, 1), a2 + hstep, voffA);
            PG8_WAIT_V(8); PG8_WAIT_L(0); PG8_BAR; PG8_MMA(0, 0, At, B0); PG8_MMA(0, 1, At, B1); PG8_BAR; PG8_SCHED;
            PG8_LDA(At, 1, 1); PG8_STAGE(PG8_SB(1, 0), b3, voffB); PG8_STAGE(PG8_SB(1, 1), b3 + hstep, voffB); PG8_STAGE(PG8_SA(1, 0), a3, voffA);
            PG8_WAIT_V(8); PG8_WAIT_L(0); PG8_BAR; PG8_MMA(1, 0, At, B0); PG8_MMA(1, 1, At, B1); PG8_BAR; PG8_SCHED;
            } else {
            PG8_LDB(B0, 0, 0); PG8_SCHED; PG8_LDA(At, 0, 0); PG8_STAGE(PG8_SA(1, 1), a1 + hstep, voffA);
            PG8_WAIT_L(8); PG8_BAR; PG8_WAIT_L(0); PG8_MMA(0, 0, At, B0); PG8_BAR; PG8_SCHED;
            PG8_LDB(B1, 0, 1); PG8_STAGE(PG8_SB(0, 0), b2, voffB);
            PG8_BAR; PG8_WAIT_L(0); PG8_MMA(0, 1, At, B1); PG8_BAR;
            PG8_LDA(At, 0, 1); PG8_STAGE(PG8_SA(0, 0), a2, voffA);
            PG8_BAR; PG8_WAIT_L(0); PG8_MMA(1, 0, At, B0); PG8_BAR; PG8_SCHED;
            PG8_STAGE(PG8_SB(0, 1), b2 + hstep, voffB);
            PG8_WAIT_V(6); PG8_BAR; PG8_MMA(1, 1, At, B1); PG8_BAR;
            PG8_LDB(B0, 1, 0); PG8_SCHED; PG8_LDA(At, 1, 0); PG8_STAGE(PG8_SA(0, 1), a2 + hstep, voffA);
            PG8_WAIT_L(8); PG8_BAR; PG8_WAIT_L(0); PG8_MMA(0, 0, At, B0); PG8_BAR; PG8_SCHED;
            PG8_LDB(B1, 1, 1); PG8_STAGE(PG8_SB(1, 0), b3, voffB);
            PG8_BAR; PG8_WAIT_L(0); PG8_MMA(0, 1, At, B1); PG8_BAR;
            PG8_LDA(At, 1, 1); PG8_STAGE(PG8_SA(1, 0), a3, voffA);
            PG8_BAR; PG8_WAIT_L(0); PG8_MMA(1, 0, At, B0); PG8_BAR; PG8_SCHED;
            PG8_STAGE(PG8_SB(1, 1), b3 + hstep, voffB);
            PG8_WAIT_V(6); PG8_BAR; PG8_MMA(1, 1, At, B1); PG8_BAR;
            }
        }
        if constexpr (ALIGN_EPI) { if (wr == 0) PG8_BAR; }
        if constexpr (!Epi::AFTER_DRAIN) { E(acc, cur, wr, wc, fr, fq); S.done(cur); }
        if (!has_next) break;
#pragma unroll
        for (int a = 0; a < 2; ++a)
#pragma unroll
            for (int b = 0; b < 2; ++b)
#pragma unroll
                for (int m = 0; m < 4; ++m)
#pragma unroll
                    for (int n = 0; n < 2; ++n) acc[a][b][m][n] = (f32x4){0.f, 0.f, 0.f, 0.f};
        cur = nxt; cA = nA; cB = nB; ++ui;
        if constexpr (ALIGN_EPI) { if (wr == 1) PG8_BAR; }
    }
    PG8_WAIT_V(0);
    if constexpr (!ALIGN_EPI) { if (wr == 0) PG8_BAR; }
    PG8_BAR;
    if constexpr (Epi::AFTER_DRAIN) { E.fused(acc, cur, wr, wc, fr, fq, lds, wid, lane); S.done(cur); }
#undef PG8_SA
#undef PG8_SB
#undef PG8_STAGE
#undef PG8_LDA
#undef PG8_LDB
#undef PG8_MMA
#undef PG8_WAIT_V
#undef PG8_WAIT_L
#undef PG8_BAR
#undef PG8_SCHED
}
}

#define GAS __attribute__((address_space(1)))
#define LAS __attribute__((address_space(3)))
typedef unsigned short bf16;
typedef unsigned v4u __attribute__((ext_vector_type(4)));
typedef float f32x4 __attribute__((ext_vector_type(4)));
typedef short bf16x8 __attribute__((ext_vector_type(8)));
typedef GAS unsigned gu32;
typedef GAS unsigned long long gu64;
#define RLX_AGENT __ATOMIC_RELAXED, __HIP_MEMORY_SCOPE_AGENT
#define LDS_WAIT() asm volatile("s_waitcnt lgkmcnt(0)" ::: "memory")
#define VM_WAIT() asm volatile("s_waitcnt vmcnt(0)" ::: "memory")
__device__ __forceinline__ unsigned long long rt() { return __builtin_amdgcn_s_memrealtime(); }
__device__ __forceinline__ unsigned f2bf(float f) { unsigned u = __builtin_bit_cast(unsigned, f); return (u + 0x7fffu + ((u >> 16) & 1u)) >> 16; }
__device__ __forceinline__ unsigned pk2(float lo, float hi) { return f2bf(lo) | (f2bf(hi) << 16); }
#define XB_TMO      128
#define XB_XCNT(j)  (256  + 64 * (j))
#define XB_XSUB(j)  (1280 + 64 * (j))
#define XB_XGEN(j)  (2304 + 64 * (j))
#define XB_TOP      3328
#define XB_TOPGEN   3392
#define XCD_BAR_WORDS 3456
#define XB_SPIN_CAP (1u << 18)

__device__ __forceinline__ unsigned xb_ld(unsigned* p)              { return __hip_atomic_load(p, __ATOMIC_RELAXED, __HIP_MEMORY_SCOPE_AGENT); }
__device__ __forceinline__ unsigned xb_add(unsigned* p, unsigned v) { return __hip_atomic_fetch_add(p, v, __ATOMIC_RELAXED, __HIP_MEMORY_SCOPE_AGENT); }
__device__ __forceinline__ unsigned xb_xcc_id() { return (unsigned)__builtin_amdgcn_s_getreg((3 << 11) | 20) & 0xFu; }
#define XB_SPIN(cond, bar) do { unsigned _sp = 0; while (cond) { __builtin_amdgcn_s_sleep(1); \
    if ((++_sp & 255u) == 0u) { if (xb_ld(&(bar)[XB_TMO])) break; if (_sp > XB_SPIN_CAP) { atomicAdd(&(bar)[XB_TMO], 1u); break; } } } } while (0)

struct XcdBarrier {
    unsigned* bar; unsigned x;
    volatile LAS unsigned* st;
};

__device__ __forceinline__ XcdBarrier xcd_barrier_post(unsigned* bar, volatile LAS unsigned* st) {
    XcdBarrier b; b.bar = bar; b.x = xb_xcc_id(); b.st = st;
    if (threadIdx.x == 0) (void)xb_add(&bar[XB_XCNT(b.x)], 1u);
    return b;
}
__device__ __forceinline__ void xcd_barrier_complete(unsigned* bar, unsigned x, unsigned& nloc, unsigned& nx) {
    const unsigned G = gridDim.x * gridDim.y * gridDim.z;
    unsigned sum, cnt, mine, sp = 0u;
    for (;;) {
        sum = 0u; cnt = 0u; mine = 0u;
#pragma unroll
        for (unsigned j = 0; j < 16; ++j) { const unsigned c = xb_ld(&bar[XB_XCNT(j)]); sum += c; cnt += (c > 0u) ? 1u : 0u; mine = (j == x) ? c : mine; }
        if (sum == G) break;
        __builtin_amdgcn_s_sleep(1);
        if ((++sp & 255u) == 0u) { if (xb_ld(&bar[XB_TMO])) break; if (sp > XB_SPIN_CAP) { atomicAdd(&bar[XB_TMO], 1u); break; } }
    }
    nloc = mine > 0u ? mine : 1u; nx = cnt > 0u ? cnt : 1u;
}

__device__ __forceinline__ void xcd_barrier(const XcdBarrier& b) {
    asm volatile("s_waitcnt vmcnt(0)" ::: "memory");
    __syncthreads();
    if (threadIdx.x == 0) {
        unsigned* bar = b.bar;
        __builtin_amdgcn_s_waitcnt(0);
        unsigned nloc = b.st[0], nx = b.st[1];
        if (nloc == 0u) { xcd_barrier_complete(bar, b.x, nloc, nx); b.st[0] = nloc; b.st[1] = nx; }
        const unsigned old = xb_add(&bar[XB_XSUB(b.x)], 1u);
        const unsigned gen = old / nloc;
        if (old + 1u == (gen + 1u) * nloc) {
            __builtin_amdgcn_fence(__ATOMIC_RELEASE, "agent");
            asm volatile("s_waitcnt vmcnt(0)" ::: "memory");
            const unsigned og = xb_add(&bar[XB_TOP], 1u);
            const unsigned tg = og / nx;
            if (og + 1u == (tg + 1u) * nx) xb_add(&bar[XB_TOPGEN], 1u);
            else XB_SPIN(xb_ld(&bar[XB_TOPGEN]) == tg, bar);
            __builtin_amdgcn_fence(__ATOMIC_ACQUIRE, "agent");
            xb_add(&bar[XB_XGEN(b.x)], 1u);
            asm volatile("s_waitcnt vmcnt(0)" ::: "memory");
        } else {
            XB_SPIN(xb_ld(&bar[XB_XGEN(b.x)]) == gen, bar);
            __builtin_amdgcn_fence(__ATOMIC_ACQUIRE, "agent");
            asm volatile("s_waitcnt vmcnt(0)" ::: "memory");
        }
    }
    __syncthreads();
}


constexpr int NWAVES = 8, NTHR = 512;
constexpr int D = 1024, NB = 8, SEQ = 2048, CTXL = 256;
constexpr int M_CTX = NB * CTXL, M_LAT = NB * SEQ, M_ALL = M_CTX + M_LAT;
constexpr int RWC = 1760, MIXIN = 3312, ZLD = 3328, FF = 2816, NE = 8;
constexpr int PRV = 9 * 512;
constexpr int MOE_ROWS = 34816;
constexpr size_t MiB = 1u << 20;
constexpr size_t WS_CTL = 0, CTL_ZERO_BYTES = 1 * MiB;
constexpr size_t WS_MODS = 1 * MiB;
constexpr size_t WS_TOK = 1 * MiB + 512 * 1024;
constexpr size_t WS_WIN_T = 2 * MiB;
constexpr size_t WS_WOUT_T = WS_WIN_T + (size_t)ZLD * D * 2;
constexpr size_t WS_W13_T = WS_WOUT_T + 2 * MiB;
constexpr size_t WS_W2_T = WS_W13_T + 11 * MiB;
constexpr size_t WS_QKV_T = WS_W2_T + (size_t)D * FF * 2;
constexpr size_t WS_NAO_T = WS_QKV_T + 6 * MiB;
constexpr size_t WS_HCTX = 35 * MiB;
constexpr size_t WS_A = 43 * MiB;
constexpr size_t WS_R = 79 * MiB;
constexpr size_t WS_Z = WS_R;
constexpr size_t WS_PR = 196 * MiB;
constexpr size_t WS_PM = 358 * MiB;
constexpr size_t WS_DT = 394 * MiB;
constexpr size_t WS_BONUS = 395 * MiB + 256 * 1024;
constexpr size_t WS_GATE = 396 * MiB;
constexpr size_t WS_ZG = 414 * MiB;
constexpr size_t WS_YRW = WS_R;
constexpr size_t WS_YMB = WS_R + 36 * MiB;
constexpr size_t WS_HID = WS_R;
constexpr size_t WS_MOEW13 = 316 * MiB;
constexpr size_t WS_MOEW2 = 404 * MiB;
constexpr size_t WS_Q = WS_R, WS_K = WS_R + 36 * MiB, WS_V = WS_R + 72 * MiB;
constexpr size_t WS_O = WS_R + 108 * MiB;
constexpr size_t WS_A4 = 111 * MiB;
constexpr size_t WS_XG = 43 * MiB;
constexpr size_t WS_HIDG = 111 * MiB;
constexpr size_t WS_YG = 43 * MiB;
constexpr size_t WS_END = 448 * MiB;
static_assert(WS_NAO_T + 2 * MiB <= WS_HCTX && WS_ZG + 18 * MiB <= WS_END && WS_MOEW2 + 44 * MiB <= WS_END && WS_HIDG + (size_t)MOE_ROWS * FF * 2 <= WS_MOEW13, "ws map");
static_assert(WS_Z + (size_t)M_ALL * ZLD * 2 <= WS_PR && WS_PR + (size_t)M_ALL * PRV * 2 <= WS_PM && WS_XG + (size_t)MOE_ROWS * D * 2 <= WS_HIDG, "ws map 2");
constexpr int CW_TMO = 0, CW_CODE = 1, CW_BAR = 4096, CW_CNT = 8192;
constexpr int RING_BYTES = 131072, LDSCTL_OFF = RING_BYTES, MISC_OFF = LDSCTL_OFF + 320, LDS_BYTES = 147456;

typedef unsigned v2u __attribute__((ext_vector_type(2)));
typedef float v2f __attribute__((ext_vector_type(2)));
typedef short s16x4 __attribute__((ext_vector_type(4)));
typedef short v4i16_t __attribute__((ext_vector_type(4)));
__device__ __forceinline__ float bflo(unsigned u) { return __uint_as_float(u << 16); }
__device__ __forceinline__ float bfhi(unsigned u) { return __uint_as_float(u & 0xffff0000u); }
__device__ __forceinline__ float ldbf(const bf16* p) { return __uint_as_float((unsigned)(*p) << 16); }
__device__ __forceinline__ float sigm(float x) { return 1.f / (1.f + __expf(-x)); }
__device__ __forceinline__ float wave_sum(float v) {
#pragma unroll
    for (int o = 1; o < 64; o <<= 1) v += __shfl_xor(v, o);
    return v;
}

struct Frame {
    LAS unsigned char* lds;
    volatile LAS unsigned* MISC;
    gu32* ctl;
    int tid, lane, wave, G, bid;
};

__device__ __forceinline__ void tr_item(const float* W, int K, int N, bf16* WT, int drow0, int k0, int n0, LAS float* scr, int lane) {
    const int nn = n0 + (lane & 31);
#pragma unroll 8
    for (int i = 0; i < 32; ++i) { const int kk = 2 * i + (lane >> 5); scr[kk * 33 + (lane & 31)] = (nn < N) ? W[(size_t)(k0 + kk) * N + nn] : 0.f; }
    LDS_WAIT(); asm volatile("" ::: "memory");
    const int c = lane & 7;
#pragma unroll
    for (int j = 0; j < 4; ++j) { const int n = (lane >> 3) + 8 * j; const LAS float* s = scr + (8 * c) * 33 + n;
        v4u o; o.x = pk2(s[0 * 33], s[1 * 33]); o.y = pk2(s[2 * 33], s[3 * 33]); o.z = pk2(s[4 * 33], s[5 * 33]); o.w = pk2(s[6 * 33], s[7 * 33]);
        *(GAS v4u*)(WT + (size_t)(drow0 + n) * K + k0 + 8 * c) = o; }
    LDS_WAIT(); asm volatile("" ::: "memory");
}
template <int MODE  >
__device__ __forceinline__ bool tr_matrix(int& it, const float* W, int K, int N, bf16* WT, LAS float* scr, int lane) {
    const int nblk = (N + 31) / 32, items = (K / 64) * nblk;
    if (it >= items) { it -= items; return false; }
    const int kb = it / nblk, nb = it % nblk, n0 = nb * 32;
    int drow0 = n0;
    if (MODE == 1) drow0 = (n0 >> 7) * 256 + (n0 & 127);
    if (MODE == 2) drow0 = (n0 >> 7) * 256 + 128 + (n0 & 127);
    tr_item(W, K, N, WT, drow0, kb * 64, n0, scr, lane);
    return true;
}

__device__ __forceinline__ void p0_phase(Frame& F, const float* c, const float* c_ctx, const float* w_ada, const float* b_ada, float* mods,
                                         const float* mix_w_in, const float* mix_w_out, const float* ffn_w1, const float* ffn_w3, const float* ffn_w2,
                                         const float* na_w_qkv, const float* na_w_out, unsigned char* ws) {
    for (int u = F.bid; u < 192; u += F.G) {
        LAS float* sc = (LAS float*)(F.lds);
        LAS float* red = (LAS float*)(F.lds + 36864);
        for (int i = F.tid; i < 9 * 1024; i += NTHR) { const int b = i >> 10, k = i & 1023; const float v = (b < 8) ? c[b * 1024 + k] : c_ctx[k]; sc[i] = v / (1.f + __expf(-v)); }
        __syncthreads();
        const int layer = u / 96, col = (u % 96) * 64 + F.lane;
        const float* W = w_ada + (size_t)layer * 1024 * 6144 + col;
        float acc[9];
#pragma unroll
        for (int b = 0; b < 9; ++b) acc[b] = 0.f;
        const int k0 = F.wave * 128;
#pragma unroll 8
        for (int k = 0; k < 128; ++k) { const float w = W[(size_t)(k0 + k) * 6144];
#pragma unroll
            for (int b = 0; b < 9; ++b) acc[b] += sc[b * 1024 + k0 + k] * w; }
#pragma unroll
        for (int b = 0; b < 9; ++b) red[(F.wave * 9 + b) * 64 + F.lane] = acc[b];
        __syncthreads();
        if (F.wave == 0) {
#pragma unroll
            for (int b = 0; b < 9; ++b) { float s = 0.f;
#pragma unroll
                for (int w = 0; w < 8; ++w) s += red[(w * 9 + b) * 64 + F.lane];
                mods[(layer * 9 + b) * 6144 + col] = s + b_ada[layer * 6144 + col]; }
        }
        __syncthreads();
    }
    LAS float* scr = (LAS float*)(F.lds + 57344 + F.wave * 8704);
    const int gw = F.bid * NWAVES + F.wave, NGW = F.G * NWAVES;
    constexpr int NITEMS = 16 * 104 + 512 + 1408 * 3 + 1536 + 512;
    for (int it0 = gw; it0 < NITEMS; it0 += NGW) {
        int it = it0;
        if (tr_matrix<0>(it, mix_w_in, 1024, MIXIN, (bf16*)(ws + WS_WIN_T), scr, F.lane)) continue;
        if (tr_matrix<0>(it, mix_w_out, 1024, 1024, (bf16*)(ws + WS_WOUT_T), scr, F.lane)) continue;
        if (tr_matrix<1>(it, ffn_w1, 1024, FF, (bf16*)(ws + WS_W13_T), scr, F.lane)) continue;
        if (tr_matrix<2>(it, ffn_w3, 1024, FF, (bf16*)(ws + WS_W13_T), scr, F.lane)) continue;
        if (tr_matrix<0>(it, ffn_w2, FF, 1024, (bf16*)(ws + WS_W2_T), scr, F.lane)) continue;
        if (tr_matrix<0>(it, na_w_qkv, 1024, 3072, (bf16*)(ws + WS_QKV_T), scr, F.lane)) continue;
        tr_matrix<0>(it, na_w_out, 1024, 1024, (bf16*)(ws + WS_NAO_T), scr, F.lane);
    }
}
__device__ __forceinline__ void moe_weight_phase(Frame& F, const float* w1, const float* w3, const float* w2, unsigned char* ws) {
    LAS float* scr = (LAS float*)(F.lds + 57344 + F.wave * 8704);
    const int gw = F.bid * NWAVES + F.wave, NGW = F.G * NWAVES;
    constexpr int PER_E = 1408 * 3;
    for (int it0 = gw; it0 < NE * PER_E; it0 += NGW) {
        const int e = it0 / PER_E; int it = it0 % PER_E;
        bf16* w13t = (bf16*)(ws + WS_MOEW13) + (size_t)e * 5632 * 1024; bf16* w2t = (bf16*)(ws + WS_MOEW2) + (size_t)e * 1024 * FF;
        if (tr_matrix<1>(it, w1 + (size_t)e * 1024 * FF, 1024, FF, w13t, scr, F.lane)) continue;
        if (tr_matrix<2>(it, w3 + (size_t)e * 1024 * FF, 1024, FF, w13t, scr, F.lane)) continue;
        tr_matrix<0>(it, w2 + (size_t)e * 1024 * FF, FF, 1024, w2t, scr, F.lane);
    }
}

__device__ __forceinline__ void normmod_row(const float* xrow, const float* g, const float* sh, const float* sc, bf16* orow, int lane, f32x4 (&a)[4]) {
    const GAS f32x4* xr = (const GAS f32x4*)xrow + lane;
    float ss = 0.f;
#pragma unroll
    for (int j = 0; j < 4; ++j) { a[j] = xr[64 * j]; ss += (a[j].x * a[j].x + a[j].y * a[j].y) + (a[j].z * a[j].z + a[j].w * a[j].w); }
    const float rs = rsqrtf(wave_sum(ss) * (1.f / 1024.f) + 1e-6f);
    GAS unsigned long long* o8 = (GAS unsigned long long*)orow + lane;
#pragma unroll
    for (int j = 0; j < 4; ++j) {
        const f32x4 gg = ((const GAS f32x4*)g)[lane + 64 * j], s1 = ((const GAS f32x4*)sc)[lane + 64 * j], s0 = ((const GAS f32x4*)sh)[lane + 64 * j];
        a[j] = (a[j] * rs) * gg * (s1 + 1.f) + s0;
        o8[64 * j] = (unsigned long long)pk2(a[j].x, a[j].y) | ((unsigned long long)pk2(a[j].z, a[j].w) << 32);
    }
}
__device__ __forceinline__ void normmod_phase(Frame& F, const float* src_ctx, const float* src_lat, const float* g, const float* mods_l, int off_shift, int off_scale, bf16* dst) {
    const int gw = F.bid * NWAVES + F.wave, NGW = F.G * NWAVES;
    for (int r = gw; r < M_ALL; r += NGW) {
        const bool isctx = r < M_CTX; const int rl = isctx ? r : r - M_CTX; const int mi = isctx ? 8 : (rl >> 11);
        const float* xrow = (isctx ? src_ctx : src_lat) + (size_t)rl * D; const float* mp = mods_l + mi * 6144;
        f32x4 a[4]; normmod_row(xrow, g, mp + off_shift, mp + off_scale, dst + (size_t)r * D, F.lane, a);
    }
}

namespace pg8 {
struct EpiResGate {
    static constexpr bool PERM = false, AFTER_DRAIN = false;
    const float* base_c; const float* base_l; float* out_c; float* out_l; const float* mods_l; int gate_off; int ctx_tiles;
    __device__ __forceinline__ void operator()(const f32x4 (&acc)[2][2][4][2], const Unit& u, int wr, int wc, int fr, int fq) const {
        const bool isctx = u.pm < ctx_tiles; const int rt = isctx ? u.pm : u.pm - ctx_tiles; const int mi = isctx ? 8 : (rt >> 3);
        const float* base = isctx ? base_c : base_l; float* out = isctx ? out_c : out_l;
        const int col0 = u.pn * BM + wc * 32 + 4 * fq; const float* gp = mods_l + mi * 6144 + gate_off + col0;
        f32x4 gv[2][2];
#pragma unroll
        for (int bj = 0; bj < 2; ++bj)
#pragma unroll
            for (int n = 0; n < 2; ++n) gv[bj][n] = *(const f32x4*)(gp + bj * HALF + n * 16);
#pragma unroll
        for (int ai = 0; ai < 2; ++ai)
#pragma unroll
            for (int m = 0; m < 4; ++m) { const size_t off = (size_t)(rt * BM + ai * HALF + wr * 64 + m * 16 + fr) * 1024 + col0;
#pragma unroll
                for (int bj = 0; bj < 2; ++bj)
#pragma unroll
                    for (int n = 0; n < 2; ++n) { const f32x4 b = *(const f32x4*)(base + off + bj * HALF + n * 16); *(f32x4*)(out + off + bj * HALF + n * 16) = b + gv[bj][n] * acc[ai][bj][m][n]; } }
    }
};
struct EpiSwiGLU {
    static constexpr bool PERM = true, AFTER_DRAIN = false;
    bf16_t* O; int ldo; int nt_mod;
    __device__ __forceinline__ void operator()(const f32x4 (&acc)[2][2][4][2], const Unit& u, int wr, int wc, int fr, int fq) const {
        const int pnl = u.pn % nt_mod; const int row0 = u.pm * BM + wr * 64 + fr, col0 = pnl * HALF + wc * 32 + 8 * fq;
#pragma unroll
        for (int ai = 0; ai < 2; ++ai)
#pragma unroll
            for (int m = 0; m < 4; ++m) { bf16_t* rowp = O + (size_t)(row0 + ai * HALF + m * 16) * ldo + col0;
                float h[8];
#pragma unroll
                for (int n = 0; n < 2; ++n)
#pragma unroll
                    for (int e = 0; e < 4; ++e) { const float a = acc[ai][0][m][n][e], b = acc[ai][1][m][n][e]; h[n * 4 + e] = a * b * __builtin_amdgcn_rcpf(1.f + __expf(-a)); }
                u32x4 w; w.x = cvt_pk_bf16(h[0], h[1]); w.y = cvt_pk_bf16(h[2], h[3]); w.z = cvt_pk_bf16(h[4], h[5]); w.w = cvt_pk_bf16(h[6], h[7]);
                *(u32x4*)rowp = w; }
    }
};
struct EpiPlainMod {
    static constexpr bool PERM = true, AFTER_DRAIN = false;
    bf16_t* O; int ldo; int nt_mod;
    __device__ __forceinline__ void operator()(const f32x4 (&acc)[2][2][4][2], const Unit& u, int wr, int wc, int fr, int fq) const {
        const int pnl = u.pn % nt_mod; const int row0 = u.pm * BM + wr * 64 + fr, col0 = pnl * BM + wc * 32 + 8 * fq;
#pragma unroll
        for (int ai = 0; ai < 2; ++ai)
#pragma unroll
            for (int m = 0; m < 4; ++m) { bf16_t* rowp = O + (size_t)(row0 + ai * HALF + m * 16) * ldo + col0;
#pragma unroll
                for (int bj = 0; bj < 2; ++bj) { const f32x4 v0 = acc[ai][bj][m][0], v1 = acc[ai][bj][m][1];
                    u32x4 w; w.x = cvt_pk_bf16(v0[0], v0[1]); w.y = cvt_pk_bf16(v0[2], v0[3]); w.z = cvt_pk_bf16(v1[0], v1[1]); w.w = cvt_pk_bf16(v1[2], v1[3]);
                    *(u32x4*)(rowp + bj * HALF) = w; } }
    }
};
struct MoeOrder {
    int tb[9]; int ntn, G, c;
    __device__ __forceinline__ bool next(int i, Unit& u) const {
        const int L = i * G + c; if (L >= tb[8] * ntn) return false;
        const int mt = L / ntn, pn = L % ntn; int e = 0;
#pragma unroll
        for (int k = 1; k < 8; ++k) e += (mt >= tb[k]) ? 1 : 0;
        u.pm = mt; u.pn = e * ntn + pn; return true;
    }
    __device__ __forceinline__ void a_ready(const Unit&) const {}
    __device__ __forceinline__ void done(const Unit&) const {}
};
}

struct PrepIn { const float *rw_mu, *rw_w0, *rw_w_up, *rw_a0, *rw_a_up, *rw_g_up, *rw_k_k, *rw_k_a, *rw_r_k, *conv_w, *conv_b, *dt_bias; };
__device__ __forceinline__ void prepare_phase(Frame& F, const PrepIn& P, const bf16* Z, bf16* PR, bf16* PM, float* DT, float* BONUS, bf16* GATE, bf16* ZG) {
    LAS float* act = (LAS float*)F.lds;
    const int c = F.tid;
    const float mu0r = P.rw_mu[c], mu1r = P.rw_mu[RWC + c], mu0k = P.rw_mu[512 + c], mu1k = P.rw_mu[RWC + 512 + c], mu0v = P.rw_mu[1024 + c], mu1v = P.rw_mu[RWC + 1024 + c];
    const float w00 = P.rw_w0[c], w01 = P.rw_w0[512 + c], a00 = P.rw_a0[c], a01 = P.rw_a0[512 + c], kkc = P.rw_k_k[c], kac = P.rw_k_a[c], rk0 = P.rw_r_k[c], rk1 = P.rw_r_k[512 + c];
    float cw[2][5], cb[2];
#pragma unroll
    for (int q = 0; q < 2; ++q) { cb[q] = P.conv_b[q * 512 + c];
#pragma unroll
        for (int k = 0; k < 5; ++k) cw[q][k] = P.conv_w[k * 1024 + q * 512 + c]; }
    float mu0a = 0.f, mu1a = 0.f;
    if (c < 224) { mu0a = P.rw_mu[1536 + c]; mu1a = P.rw_mu[RWC + 1536 + c]; }
    const float dtb = (c < 16) ? P.dt_bias[c] : 0.f;

    for (int tile = F.bid; tile < M_ALL / 8; tile += F.G) {
        const int g0 = tile * 8; const bool isctx = g0 < M_CTX; const int T = isctx ? CTXL : SEQ; const int t0 = isctx ? (g0 & (CTXL - 1)) : ((g0 - M_CTX) & (SEQ - 1));
        const bf16* zb = Z + (size_t)g0 * ZLD;
        if (c < 224) {
            const int col = 1536 + c;
            float zp = (t0 > 0) ? ldbf(zb - ZLD + col) : 0.f, zc = ldbf(zb + col);
#pragma unroll
            for (int tb = 0; tb < 8; ++tb) {
                const float zn = (t0 + tb + 1 < T) ? ldbf(zb + (size_t)(tb + 1) * ZLD + col) : 0.f;
                const float zs = zc + mu0a * (zp - zc) + mu1a * (zn - zc);
                float a;
                if (c < 64) a = 2.f * sigm(2.f * zs) - 1.f; else if (c < 128) a = zs; else a = sigm(zs);
                act[c * 8 + tb] = a; zp = zc; zc = zn;
            }
        }
        float r[8], k[8], v[8];
        {
            float rp = (t0 > 0) ? ldbf(zb - ZLD + c) : 0.f, rc = ldbf(zb + c);
            float kp = (t0 > 0) ? ldbf(zb - ZLD + 512 + c) : 0.f, kc = ldbf(zb + 512 + c);
            float vp = (t0 > 0) ? ldbf(zb - ZLD + 1024 + c) : 0.f, vc = ldbf(zb + 1024 + c);
#pragma unroll
            for (int tb = 0; tb < 8; ++tb) {
                const bool hn = (t0 + tb + 1 < T); const bf16* zn = zb + (size_t)(tb + 1) * ZLD;
                const float rn = hn ? ldbf(zn + c) : 0.f, kn = hn ? ldbf(zn + 512 + c) : 0.f, vn = hn ? ldbf(zn + 1024 + c) : 0.f;
                r[tb] = rc + mu0r * (rp - rc) + mu1r * (rn - rc); k[tb] = kc + mu0k * (kp - kc) + mu1k * (kn - kc); v[tb] = vc + mu0v * (vp - vc) + mu1v * (vn - vc);
                rp = rc; rc = rn; kp = kc; kc = kn; vp = vc; vc = vn;
            }
        }
        __syncthreads();
        float lw0[8], lw1[8], ia0[8], ia1[8], gt[8];
#pragma unroll
        for (int tb = 0; tb < 8; ++tb) { lw0[tb] = 0.f; lw1[tb] = 0.f; ia0[tb] = 0.f; ia1[tb] = 0.f; gt[tb] = 0.f; }
        const LAS f32x4* act4 = (const LAS f32x4*)act;
#pragma unroll 2
        for (int l = 0; l < 32; ++l) {
            const float wu0 = P.rw_w_up[l * 512 + c], wu1 = P.rw_w_up[(32 + l) * 512 + c], au0 = P.rw_a_up[l * 512 + c], au1 = P.rw_a_up[(32 + l) * 512 + c];
            const f32x4 x0a = act4[l * 2], x0b = act4[l * 2 + 1], x1a = act4[(32 + l) * 2], x1b = act4[(32 + l) * 2 + 1];
            const f32x4 y0a = act4[(64 + l) * 2], y0b = act4[(64 + l) * 2 + 1], y1a = act4[(96 + l) * 2], y1b = act4[(96 + l) * 2 + 1];
#pragma unroll
            for (int e = 0; e < 4; ++e) { lw0[e] += x0a[e] * wu0; lw0[4 + e] += x0b[e] * wu0; lw1[e] += x1a[e] * wu1; lw1[4 + e] += x1b[e] * wu1;
                ia0[e] += y0a[e] * au0; ia0[4 + e] += y0b[e] * au0; ia1[e] += y1a[e] * au1; ia1[4 + e] += y1b[e] * au1; }
        }
#pragma unroll 4
        for (int l = 0; l < 96; ++l) {
            const float gu = P.rw_g_up[l * 512 + c]; const f32x4 xa = act4[(128 + l) * 2], xb = act4[(128 + l) * 2 + 1];
#pragma unroll
            for (int e = 0; e < 4; ++e) { gt[e] += xa[e] * gu; gt[4 + e] += xb[e] * gu; }
        }
#pragma unroll
        for (int tb = 0; tb < 8; ++tb) {
            const size_t g = (size_t)(g0 + tb);
            const float e0 = 0.60653066f * sigm(w00 + lw0[tb]), e1 = 0.60653066f * sigm(w01 + lw1[tb]);
            const float ic0 = sigm(a00 + ia0[tb]), ic1 = sigm(a01 + ia1[tb]);
            const float kks = k[tb] * kkc; const float nrm = sqrtf(wave_sum(kks * kks)); const float kkn = kks / fmaxf(nrm, 1e-12f);
            const float kd0 = k[tb] * (1.f + (ic0 - 1.f) * kac), kd1 = k[tb] * (1.f + (ic1 - 1.f) * kac);
            const float bon = wave_sum(r[tb] * (kd0 * rk0 + kd1 * rk1));
            bf16* pr = PR + g * PRV + c;
            pr[0] = (bf16)f2bf(r[tb]); pr[512] = (bf16)f2bf(v[tb]); pr[1024] = (bf16)f2bf(-kkn);
            pr[1536] = (bf16)f2bf(e0); pr[2048] = (bf16)f2bf(kd0); pr[2560] = (bf16)f2bf(kkn * ic0);
            pr[3072] = (bf16)f2bf(e1); pr[3584] = (bf16)f2bf(kd1); pr[4096] = (bf16)f2bf(kkn * ic1);
            GATE[g * 512 + c] = (bf16)f2bf(gt[tb]);
            if (F.lane == 0) BONUS[g * 8 + F.wave] = bon;
        }
#pragma unroll
        for (int q = 0; q < 2; ++q) {
            const int col = RWC + 512 + q * 512 + c;
            float xm2 = (t0 >= 2) ? ldbf(zb - 2 * ZLD + col) : 0.f, xm1 = (t0 >= 1) ? ldbf(zb - ZLD + col) : 0.f, x0 = ldbf(zb + col), xp1 = (t0 + 1 < T) ? ldbf(zb + ZLD + col) : 0.f;
#pragma unroll
            for (int tb = 0; tb < 8; ++tb) {
                const float xp2 = (t0 + tb + 2 < T) ? ldbf(zb + (size_t)(tb + 2) * ZLD + col) : 0.f;
                float y = cb[q] + cw[q][0] * xm2 + cw[q][1] * xm1 + cw[q][2] * x0 + cw[q][3] * xp1 + cw[q][4] * xp2;
                y = y * sigm(y);
                PM[(size_t)(g0 + tb) * 1024 + q * 512 + c] = (bf16)f2bf(y);
                xm2 = xm1; xm1 = x0; x0 = xp1; xp1 = xp2;
            }
        }
#pragma unroll
        for (int tb = 0; tb < 8; ++tb) ZG[(size_t)(g0 + tb) * 512 + c] = zb[(size_t)tb * ZLD + RWC + c];
        if (c < 16) {
#pragma unroll
            for (int tb = 0; tb < 8; ++tb) { const float x = ldbf(zb + (size_t)tb * ZLD + RWC + 1536 + c) + dtb; DT[(size_t)(g0 + tb) * 16 + c] = (x > 20.f) ? x : log1pf(__expf(x)); }
        }
        __syncthreads();
    }
}

__device__ __forceinline__ void rwkv_scan_unit(Frame& F, int unit, const bf16* PR, bf16* YRW) {
    const int d = unit & 1, h = (unit >> 1) & 7, b = unit >> 4;
    LAS float* buf = (LAS float*)F.lds;
    const int row = F.tid >> 3, jg = F.tid & 7;
    float s[8];
#pragma unroll
    for (int j = 0; j < 8; ++j) s[j] = 0.f;
    bf16* yout = YRW + (size_t)d * M_ALL * 512;
    for (int seg = 0; seg < 2; ++seg) {
        const int T = seg ? SEQ : CTXL; const int gbase = seg ? (M_CTX + b * SEQ) : b * CTXL;
        for (int c0 = 0; c0 < T; c0 += 32) {
            __syncthreads();
            for (int idx = F.tid; idx < 32 * 6 * 32; idx += NTHR) {
                const int tok = idx / 192, rem = idx % 192, vec = rem >> 5, pr = rem & 31;
                const int st = c0 + tok, t = d ? (T - 1 - st) : st;
                const int sv = (vec == 0) ? (3 + 3 * d) : (vec == 1) ? 2 : (vec == 2) ? (5 + 3 * d) : (vec == 3) ? (4 + 3 * d) : (vec == 4) ? 0 : 1;
                const unsigned u = *(const unsigned*)(PR + (size_t)(gbase + t) * PRV + sv * 512 + h * 64 + 2 * pr);
                float lo = bflo(u), hi = bfhi(u);
                if (vec == 0) { lo = __expf(-lo); hi = __expf(-hi); }
                *(LAS v2f*)(buf + (tok * 6 + vec) * 64 + 2 * pr) = (v2f){lo, hi};
            }
            __syncthreads();
            for (int tt = 0; tt < 32; ++tt) {
                const LAS float* p = buf + tt * 384 + jg * 8;
                const f32x4 w0 = *(const LAS f32x4*)(p), w1 = *(const LAS f32x4*)(p + 4);
                const f32x4 a0 = *(const LAS f32x4*)(p + 64), a1 = *(const LAS f32x4*)(p + 68);
                const f32x4 b0 = *(const LAS f32x4*)(p + 128), b1 = *(const LAS f32x4*)(p + 132);
                const f32x4 k0 = *(const LAS f32x4*)(p + 192), k1 = *(const LAS f32x4*)(p + 196);
                const f32x4 r0 = *(const LAS f32x4*)(p + 256), r1 = *(const LAS f32x4*)(p + 260);
                const float v = buf[tt * 384 + 320 + row];
                float sa = 0.f;
#pragma unroll
                for (int j = 0; j < 4; ++j) sa += s[j] * a0[j] + s[4 + j] * a1[j];
                sa += __shfl_xor(sa, 1); sa += __shfl_xor(sa, 2); sa += __shfl_xor(sa, 4);
                float y = 0.f;
#pragma unroll
                for (int j = 0; j < 4; ++j) {
                    s[j] = s[j] * w0[j] + (sa * b0[j] + v * k0[j]); s[4 + j] = s[4 + j] * w1[j] + (sa * b1[j] + v * k1[j]);
                    y += s[j] * r0[j] + s[4 + j] * r1[j];
                }
                y += __shfl_xor(y, 1); y += __shfl_xor(y, 2); y += __shfl_xor(y, 4);
                if (jg == 0) buf[tt * 384 + 320 + row] = y;
            }
            __syncthreads();
            {
                const int tok = F.tid >> 4, i0 = (F.tid & 15) * 4; const int st = c0 + tok, t = d ? (T - 1 - st) : st;
                const LAS float* yp = buf + tok * 384 + 320 + i0;
                v2u o; o.x = pk2(yp[0], yp[1]); o.y = pk2(yp[2], yp[3]);
                *(GAS v2u*)(yout + (size_t)(gbase + t) * 512 + h * 64 + i0) = o;
            }
        }
    }
}
__device__ __forceinline__ void mamba_scan_unit(Frame& F, int unit, const bf16* PM, const float* DT, const float* a_log, bf16* YMB) {
    const int d = unit & 1, h = (unit >> 1) & 7, b = unit >> 4, grp = h >> 2;
    LAS float* buf = (LAS float*)F.lds;
    const int p = F.tid >> 3, ng = F.tid & 7;
    float hs[16];
#pragma unroll
    for (int j = 0; j < 16; ++j) hs[j] = 0.f;
    const float a_neg = -__expf(a_log[d * 8 + h]);
    bf16* yout = YMB + (size_t)d * M_ALL * 512;
    for (int seg = 0; seg < 2; ++seg) {
        const int T = seg ? SEQ : CTXL; const int gbase = seg ? (M_CTX + b * SEQ) : b * CTXL;
        for (int c0 = 0; c0 < T; c0 += 32) {
            __syncthreads();
            for (int idx = F.tid; idx < 32 * 128; idx += NTHR) {
                const int tok = idx >> 7, pr = idx & 127; const int st = c0 + tok, t = d ? (T - 1 - st) : st;
                const int which = pr >> 6, n2 = (pr & 63) * 2;
                const unsigned u = *(const unsigned*)(PM + (size_t)(gbase + t) * 1024 + 512 + which * 256 + grp * 128 + n2);
                *(LAS v2f*)(buf + tok * 328 + which * 128 + n2) = (v2f){bflo(u), bfhi(u)};
            }
            for (int idx = F.tid; idx < 32 * 64; idx += NTHR) {
                const int tok = idx >> 6, pp = idx & 63; const int st = c0 + tok, t = d ? (T - 1 - st) : st;
                const float dt = DT[(size_t)(gbase + t) * 16 + d * 8 + h];
                buf[tok * 328 + 256 + pp] = ldbf(PM + (size_t)(gbase + t) * 1024 + h * 64 + pp) * dt;
                if (pp == 0) buf[tok * 328 + 320] = __expf(dt * a_neg);
            }
            __syncthreads();
            for (int tt = 0; tt < 32; ++tt) {
                const LAS float* q = buf + tt * 328;
                const float dA = q[320], X = q[256 + p];
                float y = 0.f;
#pragma unroll
                for (int j4 = 0; j4 < 4; ++j4) {
                    const f32x4 Bv = *(const LAS f32x4*)(q + ng * 16 + j4 * 4), Cv = *(const LAS f32x4*)(q + 128 + ng * 16 + j4 * 4);
#pragma unroll
                    for (int e = 0; e < 4; ++e) { hs[j4 * 4 + e] = hs[j4 * 4 + e] * dA + X * Bv[e]; y += hs[j4 * 4 + e] * Cv[e]; }
                }
                y += __shfl_xor(y, 1); y += __shfl_xor(y, 2); y += __shfl_xor(y, 4);
                if (ng == 0) buf[tt * 328 + 256 + p] = y;
            }
            __syncthreads();
            {
                const int tok = F.tid >> 4, i0 = (F.tid & 15) * 4; const int st = c0 + tok, t = d ? (T - 1 - st) : st;
                const LAS float* yp = buf + tok * 328 + 256 + i0;
                v2u o; o.x = pk2(yp[0], yp[1]); o.y = pk2(yp[2], yp[3]);
                *(GAS v2u*)(yout + (size_t)(gbase + t) * 512 + h * 64 + i0) = o;
            }
        }
    }
}

struct FinIn { const float *gn_w, *gn_b, *mb_d, *mb_norm_w; };
__device__ __forceinline__ void finish_phase(Frame& F, const FinIn& P, const bf16* YRW, const bf16* YMB, const bf16* PR, const bf16* PM, const float* BONUS, const bf16* GATE, const bf16* ZG, bf16* A) {
    const int gw = F.bid * NWAVES + F.wave, NGW = F.G * NWAVES; const int c0 = F.lane * 8, head = F.lane >> 3;
    float gnw[8], gnb[8], nw[8];
#pragma unroll
    for (int i = 0; i < 8; ++i) { gnw[i] = P.gn_w[c0 + i]; gnb[i] = P.gn_b[c0 + i]; nw[i] = P.mb_norm_w[c0 + i]; }
    const float dd = P.mb_d[head];
    for (int g = gw; g < M_ALL; g += NGW) {
        const size_t gs = (size_t)g;
        const v4u y0 = *(const GAS v4u*)(YRW + gs * 512 + c0), y1 = *(const GAS v4u*)(YRW + (size_t)M_ALL * 512 + gs * 512 + c0);
        const v4u vv = *(const GAS v4u*)(PR + gs * PRV + 512 + c0), gg = *(const GAS v4u*)(GATE + gs * 512 + c0);
        float y[8], vf[8], gf[8];
#pragma unroll
        for (int i = 0; i < 4; ++i) { y[2 * i] = bflo(y0[i]) + bflo(y1[i]); y[2 * i + 1] = bfhi(y0[i]) + bfhi(y1[i]); vf[2 * i] = bflo(vv[i]); vf[2 * i + 1] = bfhi(vv[i]); gf[2 * i] = bflo(gg[i]); gf[2 * i + 1] = bfhi(gg[i]); }
        float s = 0.f;
#pragma unroll
        for (int i = 0; i < 8; ++i) s += y[i];
        s += __shfl_xor(s, 1); s += __shfl_xor(s, 2); s += __shfl_xor(s, 4);
        const float mu = s * (1.f / 64.f); float q = 0.f;
#pragma unroll
        for (int i = 0; i < 8; ++i) { y[i] -= mu; q += y[i] * y[i]; }
        q += __shfl_xor(q, 1); q += __shfl_xor(q, 2); q += __shfl_xor(q, 4);
        const float rstd = rsqrtf(q * (1.f / 64.f) + 64e-5f); const float bon = BONUS[gs * 8 + head];
        float o[8];
#pragma unroll
        for (int i = 0; i < 8; ++i) o[i] = ((y[i] * rstd) * gnw[i] + gnb[i] + bon * vf[i]) * gf[i];
        v4u w; w.x = pk2(o[0], o[1]); w.y = pk2(o[2], o[3]); w.z = pk2(o[4], o[5]); w.w = pk2(o[6], o[7]);
        *(GAS v4u*)(A + gs * 1024 + c0) = w;
        const v4u m0 = *(const GAS v4u*)(YMB + gs * 512 + c0), m1 = *(const GAS v4u*)(YMB + (size_t)M_ALL * 512 + gs * 512 + c0);
        const v4u xx = *(const GAS v4u*)(PM + gs * 1024 + c0), zz = *(const GAS v4u*)(ZG + gs * 512 + c0);
        float ym[8]; float ss = 0.f;
#pragma unroll
        for (int i = 0; i < 4; ++i) {
            const float z0 = bflo(zz[i]), z1 = bfhi(zz[i]);
            ym[2 * i] = (bflo(m0[i]) + bflo(m1[i]) + dd * bflo(xx[i])) * (z0 * sigm(z0)); ym[2 * i + 1] = (bfhi(m0[i]) + bfhi(m1[i]) + dd * bfhi(xx[i])) * (z1 * sigm(z1));
            ss += ym[2 * i] * ym[2 * i] + ym[2 * i + 1] * ym[2 * i + 1];
        }
        ss += __shfl_xor(ss, 1); ss += __shfl_xor(ss, 2); ss += __shfl_xor(ss, 4); ss += __shfl_xor(ss, 8); ss += __shfl_xor(ss, 16);
        const float rr = rsqrtf(ss * (1.f / 256.f) + 1e-6f);
        v4u w2; w2.x = pk2(ym[0] * rr * nw[0], ym[1] * rr * nw[1]); w2.y = pk2(ym[2] * rr * nw[2], ym[3] * rr * nw[3]); w2.z = pk2(ym[4] * rr * nw[4], ym[5] * rr * nw[5]); w2.w = pk2(ym[6] * rr * nw[6], ym[7] * rr * nw[7]);
        *(GAS v4u*)(A + gs * 1024 + 512 + c0) = w2;
    }
}

__device__ __forceinline__ bf16x8 pack8(const f32x4& a, const f32x4& b) {
    v4u w; w.x = pk2(a[0], a[1]); w.y = pk2(a[2], a[3]); w.z = pk2(b[0], b[1]); w.w = pk2(b[2], b[3]); return __builtin_bit_cast(bf16x8, w);
}
__device__ __forceinline__ bf16x8 tr2(const LAS unsigned char* p0, const LAS unsigned char* p1) {
    const s16x4 t0 = __builtin_bit_cast(s16x4, __builtin_amdgcn_ds_read_tr16_b64_v4i16((LAS v4i16_t*)p0));
    const s16x4 t1 = __builtin_bit_cast(s16x4, __builtin_amdgcn_ds_read_tr16_b64_v4i16((LAS v4i16_t*)p1));
    bf16x8 r; r[0] = t0[0]; r[1] = t0[1]; r[2] = t0[2]; r[3] = t0[3]; r[4] = t1[0]; r[5] = t1[1]; r[6] = t1[2]; r[7] = t1[3]; return r;
}
constexpr int KST = 144;
__device__ __forceinline__ void attn_phase(Frame& F, const bf16* Q, const bf16* K, const bf16* V, const float* rpb, bf16* O) {
    LAS unsigned char* ctxK = F.lds; LAS unsigned char* ctxV = F.lds + 36864; LAS unsigned char* vst = F.lds + 73728 + F.wave * 4608; LAS float* rp = (LAS float*)(F.lds + 110592);
    const int lane = F.lane, fr = lane & 15, fq = lane >> 4, tq = (lane & 15) >> 2, tp = lane & 3;
    for (int u = F.bid; u < 256; u += F.G) {
        const int bh = u >> 1, half = u & 1, b = bh >> 4, h = bh & 15;
        __syncthreads();
        {
            const int key = F.tid >> 1, hf = F.tid & 1; const size_t src = (size_t)(b * CTXL + key) * D + h * 64 + hf * 32;
#pragma unroll
            for (int i = 0; i < 4; ++i) { *(LAS v4u*)(ctxK + key * KST + hf * 64 + 16 * i) = *(const GAS v4u*)(K + src + 8 * i); *(LAS v4u*)(ctxV + key * KST + hf * 64 + 16 * i) = *(const GAS v4u*)(V + src + 8 * i); }
            if (F.tid < 465) rp[F.tid] = rpb[h * 465 + F.tid];
        }
        __syncthreads();
        for (int it = 0; it < 8; ++it) {
            const int r = 2 * (half * 8 + it) + (F.wave >> 2), j = F.wave & 3;
            const int rs = min(max(r - 4, 0), 24); const int kb = (j == 0) ? 0 : (j == 1) ? 8 : (j == 2) ? 24 : 32;
            const int qc = 16 * j + fr, wsq = min(max(qc - 8, 0), 48);
            const size_t latbase = (size_t)(M_CTX + b * SEQ);
            bf16x8 qf[2];
            { const bf16* qp = Q + (latbase + r * 64 + qc) * D + h * 64 + 8 * fq; qf[0] = *(const GAS bf16x8*)qp; qf[1] = *(const GAS bf16x8*)(qp + 32); }
            const int cv = kb + 4 * fq - wsq, cc2 = kb + 4 * fq - qc + 15;
            f32x4 sl[8][2], sc[16];
#pragma unroll
            for (int i = 0; i < 8; ++i) {
                const int brow = (rs + i - r + 7) * 31;
#pragma unroll
                for (int blk = 0; blk < 2; ++blk) {
                    const bf16* kp = K + (latbase + (rs + i) * 64 + kb + 16 * blk + fr) * D + h * 64 + 8 * fq;
                    const bf16x8 k0 = *(const GAS bf16x8*)kp, k1 = *(const GAS bf16x8*)(kp + 32);
                    f32x4 s = {0.f, 0.f, 0.f, 0.f};
                    s = __builtin_amdgcn_mfma_f32_16x16x32_bf16(k0, qf[0], s, 0, 0, 0);
                    s = __builtin_amdgcn_mfma_f32_16x16x32_bf16(k1, qf[1], s, 0, 0, 0);
#pragma unroll
                    for (int e = 0; e < 4; ++e) s[e] = ((unsigned)(cv + 16 * blk + e) < 16u) ? (s[e] + rp[brow + min(max(cc2 + 16 * blk + e, 0), 30)]) : -INFINITY;
                    sl[i][blk] = s;
                }
            }
#pragma unroll
            for (int cb = 0; cb < 16; ++cb) {
                const LAS unsigned char* kp = ctxK + (16 * cb + fr) * KST + fq * 16;
                const bf16x8 k0 = *(const LAS bf16x8*)kp, k1 = *(const LAS bf16x8*)(kp + 64);
                f32x4 s = {0.f, 0.f, 0.f, 0.f};
                s = __builtin_amdgcn_mfma_f32_16x16x32_bf16(k0, qf[0], s, 0, 0, 0);
                s = __builtin_amdgcn_mfma_f32_16x16x32_bf16(k1, qf[1], s, 0, 0, 0);
                sc[cb] = s;
            }
            float m = -INFINITY;
#pragma unroll
            for (int i = 0; i < 8; ++i)
#pragma unroll
                for (int blk = 0; blk < 2; ++blk)
#pragma unroll
                    for (int e = 0; e < 4; ++e) m = fmaxf(m, sl[i][blk][e]);
#pragma unroll
            for (int cb = 0; cb < 16; ++cb)
#pragma unroll
                for (int e = 0; e < 4; ++e) m = fmaxf(m, sc[cb][e]);
            m = fmaxf(m, __shfl_xor(m, 16)); m = fmaxf(m, __shfl_xor(m, 32));
            float l = 0.f;
#pragma unroll
            for (int i = 0; i < 8; ++i)
#pragma unroll
                for (int blk = 0; blk < 2; ++blk)
#pragma unroll
                    for (int e = 0; e < 4; ++e) { const float p = __expf(sl[i][blk][e] - m); sl[i][blk][e] = p; l += p; }
#pragma unroll
            for (int cb = 0; cb < 16; ++cb)
#pragma unroll
                for (int e = 0; e < 4; ++e) { const float p = __expf(sc[cb][e] - m); sc[cb][e] = p; l += p; }
            l += __shfl_xor(l, 16); l += __shfl_xor(l, 32);
            const float linv = 1.f / l;
            f32x4 o[4];
#pragma unroll
            for (int db = 0; db < 4; ++db) o[db] = (f32x4){0.f, 0.f, 0.f, 0.f};
#pragma unroll
            for (int i = 0; i < 8; ++i) {
                { const int key = lane >> 1, hf = lane & 1; const bf16* vp = V + (latbase + (rs + i) * 64 + kb + key) * D + h * 64 + hf * 32;
                  v4u t[4];
#pragma unroll
                  for (int x = 0; x < 4; ++x) t[x] = *(const GAS v4u*)(vp + 8 * x);
#pragma unroll
                  for (int x = 0; x < 4; ++x) *(LAS v4u*)(vst + key * KST + hf * 64 + 16 * x) = t[x]; }
                const bf16x8 pa = pack8(sl[i][0], sl[i][1]);
#pragma unroll
                for (int db = 0; db < 4; ++db) {
                    const LAS unsigned char* a0 = vst + (4 * fq + tq) * KST + (db * 16 + 4 * tp) * 2;
                    const bf16x8 vb = tr2(a0, a0 + 16 * KST);
                    o[db] = __builtin_amdgcn_mfma_f32_16x16x32_bf16(pa, vb, o[db], 0, 0, 0);
                }
            }
#pragma unroll
            for (int cc = 0; cc < 8; ++cc) {
                const bf16x8 pa = pack8(sc[2 * cc], sc[2 * cc + 1]);
#pragma unroll
                for (int db = 0; db < 4; ++db) {
                    const LAS unsigned char* a0 = ctxV + (32 * cc + 4 * fq + tq) * KST + (db * 16 + 4 * tp) * 2;
                    const bf16x8 vb = tr2(a0, a0 + 16 * KST);
                    o[db] = __builtin_amdgcn_mfma_f32_16x16x32_bf16(pa, vb, o[db], 0, 0, 0);
                }
            }
#pragma unroll
            for (int e = 0; e < 4; ++e) {
                const float li = __shfl(linv, 4 * fq + e);
                bf16* op = O + ((size_t)(b * SEQ + r * 64 + 16 * j + 4 * fq + e)) * D + h * 64 + fr;
#pragma unroll
                for (int db = 0; db < 4; ++db) op[db * 16] = (bf16)f2bf(o[db][e] * li);
            }
        }
    }
}

__device__ __forceinline__ void router_phase(Frame& F, const float* hlat, const float* g, const float* mods_l, const float* router_w, const float* router_b, bf16* A4, unsigned* tokinfo, gu32* cnt) {
    const int gw = F.bid * NWAVES + F.wave, NGW = F.G * NWAVES;
    for (int r = gw; r < M_LAT; r += NGW) {
        const float* mp = mods_l + (r >> 11) * 6144;
        f32x4 a[4]; normmod_row(hlat + (size_t)r * D, g, mp + 3072, mp + 4096, A4 + (size_t)r * D, F.lane, a);
        float lg[8];
#pragma unroll
        for (int e = 0; e < 8; ++e) lg[e] = 0.f;
#pragma unroll
        for (int j = 0; j < 4; ++j)
#pragma unroll
            for (int x = 0; x < 4; ++x) { const float* rw = router_w + (size_t)((F.lane + 64 * j) * 4 + x) * 8; const f32x4 w0 = *(const GAS f32x4*)rw, w1 = *(const GAS f32x4*)(rw + 4); const float av = a[j][x];
#pragma unroll
                for (int e = 0; e < 4; ++e) { lg[e] += av * w0[e]; lg[4 + e] += av * w1[e]; } }
#pragma unroll
        for (int e = 0; e < 8; ++e) lg[e] = wave_sum(lg[e]) + router_b[e];
        int e0 = 0; float v0 = lg[0];
#pragma unroll
        for (int e = 1; e < 8; ++e) if (lg[e] > v0) { v0 = lg[e]; e0 = e; }
        int e1 = -1; float v1 = -INFINITY;
#pragma unroll
        for (int e = 0; e < 8; ++e) if (e != e0 && lg[e] > v1) { v1 = lg[e]; e1 = e; }
        const float g0 = 1.f / (1.f + __expf(v1 - v0)), g1 = 1.f - g0;
        if (F.lane == 0) {
            const unsigned p0 = __hip_atomic_fetch_add(cnt + 64 * e0, 1u, RLX_AGENT), p1 = __hip_atomic_fetch_add(cnt + 64 * e1, 1u, RLX_AGENT);
            v4u t0; t0.x = (unsigned)e0; t0.y = p0; t0.z = __float_as_uint(g0); t0.w = (unsigned)e1;
            v4u t1; t1.x = p1; t1.y = __float_as_uint(g1); t1.z = 0u; t1.w = 0u;
            *(GAS v4u*)(tokinfo + (size_t)r * 8) = t0; *(GAS v4u*)(tokinfo + (size_t)r * 8 + 4) = t1;
        }
    }
}
__device__ __forceinline__ void moe_bases(gu32* cnt, int (&tb)[9]) {
    int acc = 0;
#pragma unroll
    for (int e = 0; e < 8; ++e) { tb[e] = acc; const unsigned c = __hip_atomic_load(cnt + 64 * e, RLX_AGENT); acc += (int)((c + 255u) >> 8); }
    tb[8] = acc;
}
__device__ __forceinline__ void gather_phase(Frame& F, const bf16* A4, unsigned* tokinfo, gu32* cnt, bf16* XG) {
    int tb[9]; moe_bases(cnt, tb);
    const int gw = F.bid * NWAVES + F.wave, NGW = F.G * NWAVES;
    for (int r = gw; r < M_LAT; r += NGW) {
        const v4u t0 = *(const GAS v4u*)(tokinfo + (size_t)r * 8), t1 = *(const GAS v4u*)(tokinfo + (size_t)r * 8 + 4);
        int tbe0 = 0, tbe1 = 0;
#pragma unroll
        for (int e = 0; e < 8; ++e) { if ((int)t0.x == e) tbe0 = tb[e]; if ((int)t0.w == e) tbe1 = tb[e]; }
        const unsigned row0 = (unsigned)tbe0 * 256u + t0.y, row1 = (unsigned)tbe1 * 256u + t1.x;
        const GAS v4u* src = (const GAS v4u*)(A4 + (size_t)r * D);
        const v4u x0 = src[F.lane], x1 = src[F.lane + 64];
        GAS v4u* d0 = (GAS v4u*)(XG + (size_t)row0 * D); GAS v4u* d1 = (GAS v4u*)(XG + (size_t)row1 * D);
        d0[F.lane] = x0; d0[F.lane + 64] = x1; d1[F.lane] = x0; d1[F.lane + 64] = x1;
        if (F.lane == 0) { tokinfo[(size_t)r * 8 + 6] = row0; tokinfo[(size_t)r * 8 + 7] = row1; }
    }
}
__device__ __forceinline__ void final_phase(Frame& F, float* hout, const bf16* YG, const unsigned* tokinfo, const float* mods_l, const float* norm_final) {
    const int gw = F.bid * NWAVES + F.wave, NGW = F.G * NWAVES;
    for (int r = gw; r < M_LAT; r += NGW) {
        const v4u t0 = *(const GAS v4u*)(tokinfo + (size_t)r * 8), t1 = *(const GAS v4u*)(tokinfo + (size_t)r * 8 + 4);
        const float g0 = __uint_as_float(t0.z), g1 = __uint_as_float(t1.y); const unsigned row0 = t1.z, row1 = t1.w;
        const float* mp = mods_l + (r >> 11) * 6144 + 5120;
        GAS f32x4* hr = (GAS f32x4*)(hout + (size_t)r * D) + F.lane;
        const GAS v2u* y0 = (const GAS v2u*)(YG + (size_t)row0 * D) + F.lane; const GAS v2u* y1 = (const GAS v2u*)(YG + (size_t)row1 * D) + F.lane;
        f32x4 v[4]; float ss = 0.f;
#pragma unroll
        for (int j = 0; j < 4; ++j) {
            const f32x4 hh = hr[64 * j], mm = ((const GAS f32x4*)mp)[F.lane + 64 * j]; const v2u a = y0[64 * j], bq = y1[64 * j];
            f32x4 ya = {bflo(a.x), bfhi(a.x), bflo(a.y), bfhi(a.y)}, yb = {bflo(bq.x), bfhi(bq.x), bflo(bq.y), bfhi(bq.y)};
            v[j] = hh + mm * (ya * g0 + yb * g1);
            ss += (v[j].x * v[j].x + v[j].y * v[j].y) + (v[j].z * v[j].z + v[j].w * v[j].w);
        }
        const float rs = rsqrtf(wave_sum(ss) * (1.f / 1024.f) + 1e-6f);
#pragma unroll
        for (int j = 0; j < 4; ++j) { const f32x4 gg = ((const GAS f32x4*)norm_final)[F.lane + 64 * j]; hr[64 * j] = (v[j] * rs) * gg; }
    }
}

constexpr int NPHASE = 19;
#ifndef MK_PER_PHASE
#define MK_PER_PHASE 0
#endif
struct Args { const float* in[39]; float* out; unsigned char* ws; int ph_lo, ph_hi; };
#define KARGP(k) (((void* const __attribute__((address_space(4)))*)__builtin_amdgcn_kernarg_segment_ptr())[k])
#define KARG(k) ((const float*)KARGP(k))
__global__ void __launch_bounds__(NWAVES * 64, 2) mk_fwd(Args args) {
    extern __shared__ __attribute__((aligned(16))) unsigned char lds[];
    Frame F;
    F.lds = (LAS unsigned char*)lds; F.MISC = (volatile LAS unsigned*)(F.lds + MISC_OFF);
    F.tid = threadIdx.x; F.lane = F.tid & 63; F.wave = __builtin_amdgcn_readfirstlane(F.tid >> 6); F.G = gridDim.x; F.bid = blockIdx.x;
    unsigned char* ws = (unsigned char*)KARGP(40); F.ctl = (gu32*)(ws + WS_CTL);
    for (int u = F.tid; u < (LDS_BYTES - LDSCTL_OFF) / 4; u += NWAVES * 64) ((LAS unsigned*)(F.lds + LDSCTL_OFF))[u] = 0u;
    __syncthreads();
    const int lo = args.ph_lo, hi = args.ph_hi;
    XcdBarrier bar; bar.bar = (unsigned*)(F.ctl + CW_BAR); bar.x = 0; bar.st = nullptr;
    if (hi - lo > 1) bar = xcd_barrier_post((unsigned*)(F.ctl + CW_BAR), F.MISC + 8);
#ifdef PH_MASK
#define IN(k) ((((PH_MASK) >> (k)) & 1) && lo <= (k) && (k) < hi)
#else
#define IN(k) (lo <= (k) && (k) < hi)
#endif
#define SEAM(k) do { if (IN(k) && IN((k) + 1)) xcd_barrier(bar); } while (0)
    const float* x = KARG(0); const float* ctx = KARG(2);
    float* mods = (float*)(ws + WS_MODS); float* hctx = (float*)(ws + WS_HCTX); float* hlat = (float*)KARGP(39);
    bf16* A = (bf16*)(ws + WS_A);
    const int vcu = (F.G % 8 == 0) ? (F.bid % 8) * (F.G / 8) + F.bid / 8 : F.bid; (void)vcu;

    if (IN(0)) { p0_phase(F, KARG(1), KARG(3), KARG(4), KARG(5), mods, KARG(9), KARG(10), KARG(28), KARG(29), KARG(30), KARG(31), KARG(32), ws); }
    SEAM(0);
    if (IN(1)) { normmod_phase(F, ctx, x, KARG(6), mods, 0, 1024, A); }
    SEAM(1);
    if (IN(2)) {
        pg8::Gemm g{A, (const bf16*)(ws + WS_WIN_T), M_ALL, ZLD, D}; pg8::StaticOrder S; S.init(M_ALL, ZLD, F.G, F.bid);
        pg8::EpiBf16<0> E{(bf16*)(ws + WS_Z), ZLD, nullptr, 0, 0, 1.f};
        pg8::gemm_phase<pg8::EpiBf16<0>, pg8::StaticOrder, true, true>(F.lds, g, S, E);
    }
    SEAM(2);
    if (IN(3)) {
        PrepIn P{KARG(11), KARG(12), KARG(13), KARG(14), KARG(15), KARG(16), KARG(17), KARG(18), KARG(19), KARG(22), KARG(23), KARG(24)};
        prepare_phase(F, P, (const bf16*)(ws + WS_Z), (bf16*)(ws + WS_PR), (bf16*)(ws + WS_PM), (float*)(ws + WS_DT), (float*)(ws + WS_BONUS), (bf16*)(ws + WS_GATE), (bf16*)(ws + WS_ZG));
    }
    SEAM(3);
    if (IN(4)) {
        for (int u = F.bid; u < 256; u += F.G) {
            if (u < 128) rwkv_scan_unit(F, u, (const bf16*)(ws + WS_PR), (bf16*)(ws + WS_YRW));
            else mamba_scan_unit(F, u - 128, (const bf16*)(ws + WS_PM), (const float*)(ws + WS_DT), KARG(25), (bf16*)(ws + WS_YMB));
        }
    }
    SEAM(4);
    if (IN(5)) {
        FinIn P{KARG(20), KARG(21), KARG(26), KARG(27)};
        finish_phase(F, P, (const bf16*)(ws + WS_YRW), (const bf16*)(ws + WS_YMB), (const bf16*)(ws + WS_PR), (const bf16*)(ws + WS_PM), (const float*)(ws + WS_BONUS), (const bf16*)(ws + WS_GATE), (const bf16*)(ws + WS_ZG), A);
    }
    SEAM(5);
    if (IN(6)) {
        pg8::Gemm g{A, (const bf16*)(ws + WS_WOUT_T), M_ALL, D, D}; pg8::StaticOrder S; S.init(M_ALL, D, F.G, F.bid);
        pg8::EpiResGate E{ctx, x, hctx, hlat, mods, 2048, 8};
        pg8::gemm_phase<pg8::EpiResGate, pg8::StaticOrder, true, true>(F.lds, g, S, E);
    }
    SEAM(6);
    if (IN(7)) { normmod_phase(F, hctx, hlat, KARG(7), mods, 3072, 4096, A); moe_weight_phase(F, KARG(36), KARG(37), KARG(38), ws); }
    SEAM(7);
    if (IN(8)) {
        pg8::Gemm g{A, (const bf16*)(ws + WS_W13_T), M_ALL, 2 * FF, D}; pg8::StaticOrder S; S.init(M_ALL, 2 * FF, F.G, F.bid);
        pg8::EpiSwiGLU E{(bf16*)(ws + WS_HID), FF, 1 << 20};
        pg8::gemm_phase<pg8::EpiSwiGLU, pg8::StaticOrder, true, true>(F.lds, g, S, E);
    }
    SEAM(8);
    if (IN(9)) {
        pg8::Gemm g{(const bf16*)(ws + WS_HID), (const bf16*)(ws + WS_W2_T), M_ALL, D, FF}; pg8::StaticOrder S; S.init(M_ALL, D, F.G, F.bid);
        pg8::EpiResGate E{hctx, hlat, hctx, hlat, mods, 5120, 8};
        pg8::gemm_phase<pg8::EpiResGate, pg8::StaticOrder, true, true>(F.lds, g, S, E);
    }
    SEAM(9);
    const float* mods1 = mods + 9 * 6144;
    if (IN(10)) { normmod_phase(F, hctx, hlat, KARG(6) + D, mods1, 0, 1024, A); }
    SEAM(10);
    if (IN(11)) {
        pg8::Gemm g{A, (const bf16*)(ws + WS_QKV_T), M_ALL, 3 * D, D}; pg8::StaticOrder S; S.init(M_ALL, 3 * D, F.G, F.bid);
        pg8::EpiBf16<0> E{(bf16*)(ws + WS_Q), D, nullptr, D, (size_t)M_ALL * D, 0.125f};
        pg8::gemm_phase<pg8::EpiBf16<0>, pg8::StaticOrder, true, true>(F.lds, g, S, E);
    }
    SEAM(11);
    if (IN(12)) { attn_phase(F, (const bf16*)(ws + WS_Q), (const bf16*)(ws + WS_K), (const bf16*)(ws + WS_V), KARG(33), (bf16*)(ws + WS_O)); }
    SEAM(12);
    if (IN(13)) {
        pg8::Gemm g{(const bf16*)(ws + WS_O), (const bf16*)(ws + WS_NAO_T), M_LAT, D, D}; pg8::StaticOrder S; S.init(M_LAT, D, F.G, F.bid);
        pg8::EpiResGate E{hlat, hlat, hlat, hlat, mods1, 2048, 0};
        pg8::gemm_phase<pg8::EpiResGate, pg8::StaticOrder, true, true>(F.lds, g, S, E);
    }
    SEAM(13);
    if (IN(14)) { router_phase(F, hlat, KARG(7) + D, mods1, KARG(34), KARG(35), (bf16*)(ws + WS_A4), (unsigned*)(ws + WS_TOK), F.ctl + CW_CNT); }
    SEAM(14);
    if (IN(15)) { gather_phase(F, (const bf16*)(ws + WS_A4), (unsigned*)(ws + WS_TOK), F.ctl + CW_CNT, (bf16*)(ws + WS_XG)); }
    SEAM(15);
    if (IN(16)) {
        pg8::MoeOrder S; moe_bases(F.ctl + CW_CNT, S.tb); S.ntn = 22; S.G = F.G; S.c = F.bid;
        pg8::Gemm g{(const bf16*)(ws + WS_XG), (const bf16*)(ws + WS_MOEW13), MOE_ROWS, NE * 2 * FF, D};
        pg8::EpiSwiGLU E{(bf16*)(ws + WS_HIDG), FF, 22};
        pg8::gemm_phase<pg8::EpiSwiGLU, pg8::MoeOrder, true, true>(F.lds, g, S, E);
    }
    SEAM(16);
    if (IN(17)) {
        pg8::MoeOrder S; moe_bases(F.ctl + CW_CNT, S.tb); S.ntn = 4; S.G = F.G; S.c = F.bid;
        pg8::Gemm g{(const bf16*)(ws + WS_HIDG), (const bf16*)(ws + WS_MOEW2), MOE_ROWS, NE * D, FF};
        pg8::EpiPlainMod E{(bf16*)(ws + WS_YG), D, 4};
        pg8::gemm_phase<pg8::EpiPlainMod, pg8::MoeOrder, true, true>(F.lds, g, S, E);
    }
    SEAM(17);
    if (IN(18)) { final_phase(F, hlat, (const bf16*)(ws + WS_YG), (const unsigned*)(ws + WS_TOK), mods1, KARG(8)); }
#undef IN
#undef SEAM
}

extern "C" void kernel_launch(void* const* d_in, const int* in_sizes, int n_in, void* d_out, int out_size, void* d_ws, size_t ws_size, hipStream_t stream) {
    static int grid = 0;
    if (grid == 0) {
        if (n_in != 39 || out_size != M_LAT * D || ws_size < WS_END) { fprintf(stderr, "kernel_launch: unexpected shapes (n_in %d, out %d, ws %zu)\n", n_in, out_size, ws_size); grid = -1; return; }
        int dev = 0, cus = 0, per_cu = 0;
        if (hipGetDevice(&dev) != hipSuccess || hipDeviceGetAttribute(&cus, hipDeviceAttributeMultiprocessorCount, dev) != hipSuccess) { grid = -1; return; }
        if (hipFuncSetAttribute((const void*)mk_fwd, hipFuncAttributeMaxDynamicSharedMemorySize, LDS_BYTES) != hipSuccess) { fprintf(stderr, "kernel_launch: hipFuncSetAttribute failed\n"); grid = -1; return; }
        if (hipOccupancyMaxActiveBlocksPerMultiprocessor(&per_cu, (const void*)mk_fwd, NWAVES * 64, LDS_BYTES) != hipSuccess || per_cu < 1) fprintf(stderr, "kernel_launch: occupancy query says %d\n", per_cu);
        (void)hipGetLastError();
        grid = cus;
    }
    if (grid < 0) return;
    if (hipMemsetAsync((char*)d_ws + WS_CTL, 0, CTL_ZERO_BYTES, stream) != hipSuccess) return;
    Args a{};
    for (int i = 0; i < 39; ++i) a.in[i] = (const float*)d_in[i];
    a.out = (float*)d_out; a.ws = (unsigned char*)d_ws;
#if MK_PER_PHASE
    for (int p = 0; p < NPHASE; ++p) { a.ph_lo = p; a.ph_hi = p + 1; hipLaunchKernelGGL(mk_fwd, dim3(grid), dim3(NWAVES * 64), LDS_BYTES, stream, a); }
#else
    a.ph_lo = 0; a.ph_hi = NPHASE; hipLaunchKernelGGL(mk_fwd, dim3(grid), dim3(NWAVES * 64), LDS_BYTES, stream, a);
#endif
}
```

```cpp
#include <hip/hip_runtime.h>
#include <cstdio>
#include <cstdint>
#include <cmath>
#define MK_PER_PHASE 0
namespace pg8 {
#define PG8_LAS __attribute__((address_space(3)))
typedef unsigned short bf16_t;
typedef short bf16x8 __attribute__((ext_vector_type(8)));
typedef float f32x4 __attribute__((ext_vector_type(4)));
typedef unsigned u32x4 __attribute__((ext_vector_type(4)));
constexpr int BM = 256, BK = 64, HALF = 128, HTB = HALF * BK * 2  , STAGE_BYTES = 8 * HTB, NXCD = 8, WGM = 8;

__host__ __device__ __forceinline__ int lds_byte(int r, int c) { const int st = (r >> 4) * 2 + (c >> 5), rr = r & 15, cc = c & 31, ob = rr * 64 + cc * 2; return st * 1024 + (ob ^ (((ob >> 9) & 1) << 5)); }
__host__ __device__ __forceinline__ void stage_rc(int b, int& R, int& C) { const int st = b / 1024, sb = b % 1024, swz = sb ^ (((sb >> 9) & 1) << 5); R = (st >> 1) * 16 + swz / 64; C = (st & 1) * 32 + (swz % 64) / 2; }
__host__ __device__ __forceinline__ int perm32(int rho) { const int n = rho >> 4, i = rho & 15; return 8 * (i >> 2) + 4 * n + (i & 3); }

#ifndef PG8_WT
#define PG8_WT 0
#endif
#if PG8_WT
#define PG8_ST16(base_, ptr_, v_) __builtin_amdgcn_raw_buffer_store_b128((v_), __builtin_amdgcn_make_buffer_rsrc((void*)(base_), (short)0, 0x7fffffff, 0x00020000), (int)((const char*)(ptr_) - (const char*)(base_)), 0, 16)
#else
#define PG8_ST16(base_, ptr_, v_) (*(u32x4*)(ptr_) = (v_))
#endif
struct Unit { int pm, pn; int k0 = 0; };
struct Gemm { const bf16_t* A; const bf16_t* Bt; int M, N, K; int ld = 0; };

struct StaticOrder {
    int nM, nN, nwg, G, c;
    __host__ __device__ void init(int M, int N, int G_, int c_) { nM = M / BM; nN = N / BM; nwg = nM * nN; G = G_; c = c_; }
    __host__ __device__ bool next(int i, Unit& u) const {
        const long L = (long)i * G + c; if (L >= nwg) return false;
        int wgid = (int)L; { const int q = nwg / NXCD, r = nwg % NXCD, xcd = wgid % NXCD, off = wgid / NXCD; wgid = (xcd < r ? xcd * (q + 1) : r * (q + 1) + (xcd - r) * q) + off; }
        const int nig = WGM * nN, gid = wgid / nig, fm = gid * WGM, gsz = (nM - fm) < WGM ? (nM - fm) : WGM;
        u.pm = fm + ((wgid % nig) % gsz); u.pn = (wgid % nig) / gsz; return true;
    }
    __device__ __forceinline__ void a_ready(const Unit&) const {}
    __device__ __forceinline__ void done(const Unit&) const {}
};

__device__ __forceinline__ unsigned cvt_pk_bf16(float lo, float hi) { unsigned r; asm volatile("v_cvt_pk_bf16_f32 %0, %1, %2" : "=v"(r) : "v"(lo), "v"(hi)); return r; }
typedef float f32x2 __attribute__((ext_vector_type(2)));
__device__ __forceinline__ f32x2 gelu_pk(f32x2 v) {
    const f32x2 av = __builtin_elementwise_abs(v), d = av * 0.2316418882f + 1.0f;
    f32x2 t; t.x = __builtin_amdgcn_rcpf(d.x); t.y = __builtin_amdgcn_rcpf(d.y);
    f32x2 q = t * 0.5307027145f + (-0.7265760135f); q = q * t + 0.7107068705f; q = q * t + (-0.142248368f); q = q * t + 0.127414796f; q = q * t;
    const f32x2 s = (v * v) * (-0.72134752044f);
    f32x2 e; e.x = __builtin_amdgcn_exp2f(s.x); e.y = __builtin_amdgcn_exp2f(s.y);
    const f32x2 m = v * (q * e), r = v - m;
    f32x2 o; o.x = v.x < 0.f ? m.x : r.x; o.y = v.y < 0.f ? m.y : r.y; return o;
}

template <int ACT  > struct EpiBf16 {
    static constexpr bool PERM = true, AFTER_DRAIN = false; static_assert(ACT == 0 || ACT == 1, "EpiBf16: ACT is 0 (none) or 1 (gelu_pk)");
    bf16_t* O; int ldc; const float* bias; int split_cols; size_t split_stride; float scale0;
    __device__ __forceinline__ void operator()(const f32x4 (&acc)[2][2][4][2], const Unit& u, int wr, int wc, int fr, int fq) const {
        const int row0 = u.pm * BM + wr * 64 + fr; int colt = u.pn * BM; bf16_t* base = O;
        float sc = 1.f; if (split_cols) { const int t = colt / split_cols; base += (size_t)t * split_stride; colt -= t * split_cols; if (t == 0) sc = scale0; }
        const int col0 = colt + wc * 32 + 8 * fq, bcol0 = u.pn * BM + wc * 32 + 8 * fq;
        f32x4 bv[2][2];
#pragma unroll
        for (int bj = 0; bj < 2; ++bj)
#pragma unroll
            for (int n = 0; n < 2; ++n) bv[bj][n] = bias ? *(const f32x4*)(bias + bcol0 + bj * HALF + 4 * n) : (f32x4){0.f, 0.f, 0.f, 0.f};
#pragma unroll
        for (int ai = 0; ai < 2; ++ai)
#pragma unroll
            for (int m = 0; m < 4; ++m) { bf16_t* rowp = base + (size_t)(row0 + ai * HALF + m * 16) * ldc + col0;
#pragma unroll
                for (int bj = 0; bj < 2; ++bj) { f32x4 v0 = acc[ai][bj][m][0] + bv[bj][0], v1 = acc[ai][bj][m][1] + bv[bj][1];
                    if (ACT == 1) { f32x2 a = gelu_pk((f32x2){v0[0], v0[1]}), b = gelu_pk((f32x2){v0[2], v0[3]}), c = gelu_pk((f32x2){v1[0], v1[1]}), d = gelu_pk((f32x2){v1[2], v1[3]});
                        v0 = (f32x4){a.x, a.y, b.x, b.y}; v1 = (f32x4){c.x, c.y, d.x, d.y}; }
                    v0 = v0 * sc; v1 = v1 * sc; u32x4 w; w.x = cvt_pk_bf16(v0[0], v0[1]); w.y = cvt_pk_bf16(v0[2], v0[3]); w.z = cvt_pk_bf16(v1[0], v1[1]); w.w = cvt_pk_bf16(v1[2], v1[3]);
                    PG8_ST16(base, rowp + bj * HALF, w); } }
    }
};
template <class Epi, class Sched, bool ALIGN_EPI = false, bool SP2 = false>
__device__ __forceinline__ void gemm_phase(PG8_LAS unsigned char* lds, const Gemm g, const Sched& S, const Epi& E) {
    const int tid = threadIdx.x, wid = __builtin_amdgcn_readfirstlane(tid >> 6), lane = tid & 63, wr = wid >> 2, wc = wid & 3, fr = lane & 15, fq = lane >> 4;
    const int K = g.K, nt = K / BK, LD = g.ld ? g.ld : g.K;
    unsigned voffA[2], voffB[2];
#pragma unroll
    for (int i = 0; i < 2; ++i) { int R, C; stage_rc(tid * 16 + i * 8192, R, C); const int Rb = Epi::PERM ? ((R & ~31) + perm32(R & 31)) : R;
        voffA[i] = (unsigned)(R * LD + C) * 2u; voffB[i] = (unsigned)(Rb * LD + C) * 2u; }
    const size_t kstep = (size_t)(BK * 2);
    const size_t hstep = (size_t)HALF * LD * 2;
    const size_t tstep = 2 * hstep;
    const unsigned ldsw = (unsigned)wid * 1024u;
    const int aoff = lds_byte(wr * 64 + fr, fq * 8), boff = lds_byte(wc * 32 + fr, fq * 8);
#define PG8_SA(b, h) (((b) * 2 + (h)) * HTB)
#define PG8_SB(b, h) ((4 + (b) * 2 + (h)) * HTB)
#define PG8_STAGE(bufoff, gbase, voff) do { _Pragma("unroll") for (int _i = 0; _i < 2; ++_i) \
        __builtin_amdgcn_global_load_lds((const unsigned*)((const char*)(gbase) + (voff)[_i]), (PG8_LAS unsigned*)(lds + (bufoff) + ldsw + _i * 8192), 16, 0, 0); } while (0)
#define PG8_LDA(dst, b, h) do { _Pragma("unroll") for (int m = 0; m < 4; ++m) _Pragma("unroll") for (int k = 0; k < 2; ++k) dst[m][k] = *(const PG8_LAS bf16x8*)(lds + PG8_SA(b, h) + aoff + m * 2048 + k * 1024); } while (0)
#define PG8_LDB(dst, b, h) do { _Pragma("unroll") for (int n = 0; n < 2; ++n) _Pragma("unroll") for (int k = 0; k < 2; ++k) dst[n][k] = *(const PG8_LAS bf16x8*)(lds + PG8_SB(b, h) + boff + n * 2048 + k * 1024); } while (0)
#define PG8_MMA(ai, bj, At, Bt) do { __builtin_amdgcn_s_setprio(1); _Pragma("unroll") for (int m = 0; m < 4; ++m) _Pragma("unroll") for (int n = 0; n < 2; ++n) _Pragma("unroll") for (int k = 0; k < 2; ++k) \
        acc[ai][bj][m][n] = __builtin_amdgcn_mfma_f32_16x16x32_bf16(Bt[n][k], At[m][k], acc[ai][bj][m][n], 0, 0, 0); __builtin_amdgcn_s_setprio(0); } while (0)
#define PG8_WAIT_V(n) asm volatile("s_waitcnt vmcnt(" #n ")" ::: "memory")
#define PG8_WAIT_L(n) asm volatile("s_waitcnt lgkmcnt(" #n ")" ::: "memory")
#define PG8_BAR __builtin_amdgcn_s_barrier()
#define PG8_SCHED __builtin_amdgcn_sched_barrier(0)
    Unit cur, nxt; int ui = 0;
    if (!S.next(0, cur)) return;
    f32x4 acc[2][2][4][2];
#pragma unroll
    for (int a = 0; a < 2; ++a)
#pragma unroll
        for (int b = 0; b < 2; ++b)
#pragma unroll
            for (int m = 0; m < 4; ++m)
#pragma unroll
                for (int n = 0; n < 2; ++n) acc[a][b][m][n] = (f32x4){0.f, 0.f, 0.f, 0.f};
    bf16x8 At[4][2], B0[2][2], B1[2][2];
    const char* cA = (const char*)g.A + (size_t)cur.pm * tstep + (size_t)cur.k0 * 2; const char* cB = (const char*)g.Bt + (size_t)cur.pn * tstep + (size_t)cur.k0 * 2;
    S.a_ready(cur);
    if constexpr (SP2) {
        PG8_STAGE(PG8_SB(0, 0), cB, voffB); PG8_STAGE(PG8_SB(0, 1), cB + hstep, voffB); PG8_STAGE(PG8_SA(0, 0), cA, voffA); PG8_STAGE(PG8_SA(0, 1), cA + hstep, voffA);
        if (wr == 1) PG8_BAR;
        PG8_WAIT_V(2); PG8_BAR;
        PG8_STAGE(PG8_SB(1, 0), cB + kstep, voffB); PG8_STAGE(PG8_SA(1, 0), cA + kstep, voffA); PG8_STAGE(PG8_SB(1, 1), cB + hstep + kstep, voffB);
        PG8_WAIT_V(6); PG8_BAR;
    } else {
        PG8_STAGE(PG8_SB(0, 0), cB, voffB); PG8_STAGE(PG8_SA(0, 0), cA, voffA); PG8_STAGE(PG8_SB(0, 1), cB + hstep, voffB); PG8_STAGE(PG8_SA(0, 1), cA + hstep, voffA);
        if (wr == 1) PG8_BAR;
        PG8_WAIT_V(4); PG8_BAR;
        PG8_STAGE(PG8_SB(1, 0), cB + kstep, voffB); PG8_STAGE(PG8_SA(1, 0), cA + kstep, voffA); PG8_STAGE(PG8_SB(1, 1), cB + hstep + kstep, voffB);
        PG8_WAIT_V(6); PG8_BAR;
    }
    for (;;) {
        const bool has_next = S.next(ui + 1, nxt);
        const char* nA = has_next ? (const char*)g.A + (size_t)nxt.pm * tstep + (size_t)nxt.k0 * 2 : cA; const char* nB = has_next ? (const char*)g.Bt + (size_t)nxt.pn * tstep + (size_t)nxt.k0 * 2 : cB;
        for (int t = 0; t < nt; t += 2) {
            const bool last = (t == nt - 2);
            const char* a1 = cA + (size_t)(t + 1) * kstep;
            const char* a2 = last ? nA : cA + (size_t)(t + 2) * kstep; const char* b2 = last ? nB : cB + (size_t)(t + 2) * kstep;
            const char* a3 = a2 + kstep; const char* b3 = b2 + kstep;
            if (last && has_next) S.a_ready(nxt);
            if constexpr (SP2) {
            PG8_LDB(B0, 0, 0); PG8_LDB(B1, 0, 1); PG8_SCHED; PG8_LDA(At, 0, 0); PG8_STAGE(PG8_SA(1, 1), a1 + hstep, voffA);
            PG8_WAIT_V(8); PG8_WAIT_L(0); PG8_BAR; PG8_MMA(0, 0, At, B0); PG8_MMA(0, 1, At, B1); PG8_BAR; PG8_SCHED;
            PG8_LDA(At, 0, 1); PG8_STAGE(PG8_SB(0, 0), b2, voffB); PG8_STAGE(PG8_SB(0, 1), b2 + hstep, voffB); PG8_STAGE(PG8_SA(0, 0), a2, voffA);
            PG8_WAIT_V(8); PG8_WAIT_L(0); PG8_BAR; PG8_MMA(1, 0, At, B0); PG8_MMA(1, 1, At, B1); PG8_BAR; PG8_SCHED;
            PG8_LDB(B0, 1, 0); PG8_LDB(B1, 1, 1); PG8_SCHED; PG8_LDA(At, 1, 0); PG8_STAGE(PG8_SA(0, 1), a2 + hstep, voffA);
            PG8_WAIT_V(8); PG8_WAIT_L(0); PG8_BAR; PG8_MMA(0, 0, At, B0); PG8_MMA(0, 1, At, B1); PG8_BAR; PG8_SCHED;
            PG8_LDA(At, 1, 1); PG8_STAGE(PG8_SB(1, 0), b3, voffB); PG8_STAGE(PG8_SB(1, 1), b3 + hstep, voffB); PG8_STAGE(PG8_SA(1, 0), a3, voffA);
            PG8_WAIT_V(8); PG8_WAIT_L(0); PG8_BAR; PG8_MMA(1, 0, At, B0); PG8_MMA(1, 1, At, B1); PG8_BAR; PG8_SCHED;
            } else {
            PG8_LDB(B0, 0, 0); PG8_SCHED; PG8_LDA(At, 0, 0); PG8_STAGE(PG8_SA(1, 1), a1 + hstep, voffA);
            PG8_WAIT_L(8); PG8_BAR; PG8_WAIT_L(0); PG8_MMA(0, 0, At, B0); PG8_BAR; PG8_SCHED;
            PG8_LDB(B1, 0, 1); PG8_STAGE(PG8_SB(0, 0), b2, voffB);
            PG8_BAR; PG8_WAIT_L(0); PG8_MMA(0, 1, At, B1); PG8_BAR;
            PG8_LDA(At, 0, 1); PG8_STAGE(PG8_SA(0, 0), a2, voffA);
            PG8_BAR; PG8_WAIT_L(0); PG8_MMA(1, 0, At, B0); PG8_BAR; PG8_SCHED;
            PG8_STAGE(PG8_SB(0, 1), b2 + hstep, voffB);
            PG8_WAIT_V(6); PG8_BAR; PG8_MMA(1, 1, At, B1); PG8_BAR;
            PG8_LDB(B0, 1, 0); PG8_SCHED; PG8_LDA(At, 1, 0); PG8_STAGE(PG8_SA(0, 1), a2 + hstep, voffA);
            PG8_WAIT_L(8); PG8_BAR; PG8_WAIT_L(0); PG8_MMA(0, 0, At, B0); PG8_BAR; PG8_SCHED;
            PG8_LDB(B1, 1, 1); PG8_STAGE(PG8_SB(1, 0), b3, voffB);
            PG8_BAR; PG8_WAIT_L(0); PG8_MMA(0, 1, At, B1); PG8_BAR;
            PG8_LDA(At, 1, 1); PG8_STAGE(PG8_SA(1, 0), a3, voffA);
            PG8_BAR; PG8_WAIT_L(0); PG8_MMA(1, 0, At, B0); PG8_BAR; PG8_SCHED;
            PG8_STAGE(PG8_SB(1, 1), b3 + hstep, voffB);
            PG8_WAIT_V(6); PG8_BAR; PG8_MMA(1, 1, At, B1); PG8_BAR;
            }
        }
        if constexpr (ALIGN_EPI) { if (wr == 0) PG8_BAR; }
        if constexpr (!Epi::AFTER_DRAIN) { E(acc, cur, wr, wc, fr, fq); S.done(cur); }
        if (!has_next) break;
#pragma unroll
        for (int a = 0; a < 2; ++a)
#pragma unroll
            for (int b = 0; b < 2; ++b)
#pragma unroll
                for (int m = 0; m < 4; ++m)
#pragma unroll
                    for (int n = 0; n < 2; ++n) acc[a][b][m][n] = (f32x4){0.f, 0.f, 0.f, 0.f};
        cur = nxt; cA = nA; cB = nB; ++ui;
        if constexpr (ALIGN_EPI) { if (wr == 1) PG8_BAR; }
    }
    PG8_WAIT_V(0);
    if constexpr (!ALIGN_EPI) { if (wr == 0) PG8_BAR; }
    PG8_BAR;
    if constexpr (Epi::AFTER_DRAIN) { E.fused(acc, cur, wr, wc, fr, fq, lds, wid, lane); S.done(cur); }
#undef PG8_SA
#undef PG8_SB
#undef PG8_STAGE
#undef PG8_LDA
#undef PG8_LDB
#undef PG8_MMA
#undef PG8_WAIT_V
#undef PG8_WAIT_L
#undef PG8_BAR
#undef PG8_SCHED
}
}

#define GAS __attribute__((address_space(1)))
#define LAS __attribute__((address_space(3)))
typedef unsigned short bf16;
typedef unsigned v4u __attribute__((ext_vector_type(4)));
typedef float f32x4 __attribute__((ext_vector_type(4)));
typedef short bf16x8 __attribute__((ext_vector_type(8)));
typedef GAS unsigned gu32;
typedef GAS unsigned long long gu64;
#define RLX_AGENT __ATOMIC_RELAXED, __HIP_MEMORY_SCOPE_AGENT
#define LDS_WAIT() asm volatile("s_waitcnt lgkmcnt(0)" ::: "memory")
#define VM_WAIT() asm volatile("s_waitcnt vmcnt(0)" ::: "memory")
__device__ __forceinline__ unsigned long long rt() { return __builtin_amdgcn_s_memrealtime(); }
__device__ __forceinline__ unsigned f2bf(float f) { unsigned u = __builtin_bit_cast(unsigned, f); return (u + 0x7fffu + ((u >> 16) & 1u)) >> 16; }
typedef float f32x2_t __attribute__((ext_vector_type(2))); typedef __bf16 bf16x2_t __attribute__((ext_vector_type(2)));
__device__ __forceinline__ unsigned pk2(float lo, float hi) { const f32x2_t v = {lo, hi}; const bf16x2_t b = __builtin_convertvector(v, bf16x2_t); return __builtin_bit_cast(unsigned, b); }
#define XB_TMO      128
#define XB_XCNT(j)  (256  + 64 * (j))
#define XB_XSUB(j)  (1280 + 64 * (j))
#define XB_XGEN(j)  (2304 + 64 * (j))
#define XB_TOP      3328
#define XB_TOPGEN   3392
#define XCD_BAR_WORDS 3456
#define XB_SPIN_CAP (1u << 18)

__device__ __forceinline__ unsigned xb_ld(unsigned* p)              { return __hip_atomic_load(p, __ATOMIC_RELAXED, __HIP_MEMORY_SCOPE_AGENT); }
__device__ __forceinline__ unsigned xb_add(unsigned* p, unsigned v) { return __hip_atomic_fetch_add(p, v, __ATOMIC_RELAXED, __HIP_MEMORY_SCOPE_AGENT); }
__device__ __forceinline__ unsigned xb_xcc_id() { return (unsigned)__builtin_amdgcn_s_getreg((3 << 11) | 20) & 0xFu; }
#define XB_SPIN(cond, bar) do { unsigned _sp = 0; while (cond) { __builtin_amdgcn_s_sleep(1); \
    if ((++_sp & 255u) == 0u) { if (xb_ld(&(bar)[XB_TMO])) break; if (_sp > XB_SPIN_CAP) { atomicAdd(&(bar)[XB_TMO], 1u); break; } } } } while (0)

struct XcdBarrier {
    unsigned* bar; unsigned x;
    volatile LAS unsigned* st;
};

__device__ __forceinline__ XcdBarrier xcd_barrier_post(unsigned* bar, volatile LAS unsigned* st) {
    XcdBarrier b; b.bar = bar; b.x = xb_xcc_id(); b.st = st;
    if (threadIdx.x == 0) (void)xb_add(&bar[XB_XCNT(b.x)], 1u);
    return b;
}
__device__ __forceinline__ void xcd_barrier_complete(unsigned* bar, unsigned x, unsigned& nloc, unsigned& nx) {
    const unsigned G = gridDim.x * gridDim.y * gridDim.z;
    unsigned sum, cnt, mine, sp = 0u;
    for (;;) {
        sum = 0u; cnt = 0u; mine = 0u;
#pragma unroll
        for (unsigned j = 0; j < 16; ++j) { const unsigned c = xb_ld(&bar[XB_XCNT(j)]); sum += c; cnt += (c > 0u) ? 1u : 0u; mine = (j == x) ? c : mine; }
        if (sum == G) break;
        __builtin_amdgcn_s_sleep(1);
        if ((++sp & 255u) == 0u) { if (xb_ld(&bar[XB_TMO])) break; if (sp > XB_SPIN_CAP) { atomicAdd(&bar[XB_TMO], 1u); break; } }
    }
    nloc = mine > 0u ? mine : 1u; nx = cnt > 0u ? cnt : 1u;
}

__device__ __forceinline__ void xcd_barrier(const XcdBarrier& b) {
    asm volatile("s_waitcnt vmcnt(0)" ::: "memory");
    __syncthreads();
    if (threadIdx.x == 0) {
        unsigned* bar = b.bar;
        __builtin_amdgcn_s_waitcnt(0);
        unsigned nloc = b.st[0], nx = b.st[1];
        if (nloc == 0u) { xcd_barrier_complete(bar, b.x, nloc, nx); b.st[0] = nloc; b.st[1] = nx; }
        const unsigned old = xb_add(&bar[XB_XSUB(b.x)], 1u);
        const unsigned gen = old / nloc;
        if (old + 1u == (gen + 1u) * nloc) {
            __builtin_amdgcn_fence(__ATOMIC_RELEASE, "agent");
            asm volatile("s_waitcnt vmcnt(0)" ::: "memory");
            const unsigned og = xb_add(&bar[XB_TOP], 1u);
            const unsigned tg = og / nx;
            if (og + 1u == (tg + 1u) * nx) xb_add(&bar[XB_TOPGEN], 1u);
            else XB_SPIN(xb_ld(&bar[XB_TOPGEN]) == tg, bar);
            __builtin_amdgcn_fence(__ATOMIC_ACQUIRE, "agent");
            xb_add(&bar[XB_XGEN(b.x)], 1u);
            asm volatile("s_waitcnt vmcnt(0)" ::: "memory");
        } else {
            XB_SPIN(xb_ld(&bar[XB_XGEN(b.x)]) == gen, bar);
            __builtin_amdgcn_fence(__ATOMIC_ACQUIRE, "agent");
            asm volatile("s_waitcnt vmcnt(0)" ::: "memory");
        }
    }
    __syncthreads();
}


constexpr int NWAVES = 8, NTHR = 512;
constexpr int D = 1024, NB = 8, SEQ = 2048, CTXL = 256;
constexpr int M_CTX = NB * CTXL, M_LAT = NB * SEQ, M_ALL = M_CTX + M_LAT;
constexpr int RWC = 1760, MIXIN = 3312, ZLD = 3328, FF = 2816, NE = 8;
constexpr int PRV = 9 * 512;
constexpr int MOE_ROWS = 34816;
constexpr size_t MiB = 1u << 20;
constexpr size_t WS_CTL = 0, CTL_ZERO_BYTES = 1 * MiB;
constexpr size_t WS_MODS = 1 * MiB;
constexpr size_t WS_TOK = 1 * MiB + 512 * 1024;
constexpr size_t WS_WIN_T = 2 * MiB;
constexpr size_t WS_WOUT_T = WS_WIN_T + (size_t)ZLD * D * 2;
constexpr size_t WS_W13_T = WS_WOUT_T + 2 * MiB;
constexpr size_t WS_W2_T = WS_W13_T + 11 * MiB;
constexpr size_t WS_QKV_T = WS_W2_T + (size_t)D * FF * 2;
constexpr size_t WS_NAO_T = WS_QKV_T + 6 * MiB;
constexpr size_t WS_HCTX = 35 * MiB;
constexpr size_t WS_A = 43 * MiB;
constexpr size_t WS_R = 79 * MiB;
constexpr size_t WS_Z = WS_R;
constexpr size_t WS_PR = 196 * MiB;
constexpr size_t WS_PM = 358 * MiB;
constexpr size_t WS_DT = 394 * MiB;
constexpr size_t WS_BONUS = 395 * MiB + 256 * 1024;
constexpr size_t WS_GATE = 396 * MiB;
constexpr size_t WS_ZG = 414 * MiB;
constexpr size_t WS_YRW = WS_R;
constexpr size_t WS_YMB = WS_R + 36 * MiB;
constexpr size_t WS_HID = WS_R;
constexpr size_t WS_MOEW13 = 316 * MiB;
constexpr size_t WS_MOEW2 = 404 * MiB;
constexpr size_t WS_Q = WS_R, WS_K = WS_R + 36 * MiB, WS_V = WS_R + 72 * MiB;
constexpr size_t WS_O = WS_R + 108 * MiB;
constexpr size_t WS_A4 = 111 * MiB;
constexpr size_t WS_XG = 43 * MiB;
constexpr size_t WS_HIDG = 111 * MiB;
constexpr size_t WS_YG = 43 * MiB;
constexpr size_t WS_SLAB6 = WS_R;
constexpr size_t WS_SLAB9 = WS_R + 99 * MiB;
constexpr size_t WS_TAIL = 316 * MiB;
constexpr size_t WS_END = 448 * MiB;
static_assert(WS_NAO_T + 2 * MiB <= WS_HCTX && WS_ZG + 18 * MiB <= WS_END && WS_MOEW2 + 44 * MiB <= WS_END && WS_HIDG + (size_t)MOE_ROWS * FF * 2 <= WS_MOEW13, "ws map");
static_assert(WS_Z + (size_t)M_ALL * ZLD * 2 <= WS_PR && WS_PR + (size_t)M_ALL * PRV * 2 <= WS_PM && WS_XG + (size_t)MOE_ROWS * D * 2 <= WS_HIDG, "ws map 2");
constexpr int CW_TMO = 0, CW_CODE = 1, CW_BAR = 4096, CW_CNT = 8192;
constexpr int RING_BYTES = 131072, LDSCTL_OFF = RING_BYTES, MISC_OFF = LDSCTL_OFF + 320, LDS_BYTES = 147456;

typedef unsigned v2u __attribute__((ext_vector_type(2)));
typedef float v2f __attribute__((ext_vector_type(2)));
typedef short s16x4 __attribute__((ext_vector_type(4)));
typedef short v4i16_t __attribute__((ext_vector_type(4)));
__device__ __forceinline__ float bflo(unsigned u) { return __uint_as_float(u << 16); }
__device__ __forceinline__ float bfhi(unsigned u) { return __uint_as_float(u & 0xffff0000u); }
__device__ __forceinline__ float ldbf(const bf16* p) { return __uint_as_float((unsigned)(*p) << 16); }
__device__ __forceinline__ float sigm(float x) { return 1.f / (1.f + __expf(-x)); }
__device__ __forceinline__ bf16x8 pack8(const f32x4& a, const f32x4& b) {
    v4u w; w.x = pk2(a[0], a[1]); w.y = pk2(a[2], a[3]); w.z = pk2(b[0], b[1]); w.w = pk2(b[2], b[3]); return __builtin_bit_cast(bf16x8, w);
}
__device__ __forceinline__ float wave_sum(float v) {
#pragma unroll
    for (int o = 1; o < 64; o <<= 1) v += __shfl_xor(v, o);
    return v;
}

struct Frame {
    LAS unsigned char* lds;
    volatile LAS unsigned* MISC;
    gu32* ctl;
    int tid, lane, wave, G, bid;
};

__device__ __forceinline__ void tr_item(const float* W, int K, int N, bf16* WT, int drow0, int k0, int n0, LAS float* scr, int lane) {
    const int nn = n0 + (lane & 31);
    float t[32];
#pragma unroll
    for (int i = 0; i < 32; ++i) { const int kk = 2 * i + (lane >> 5); t[i] = (nn < N) ? W[(size_t)(k0 + kk) * N + nn] : 0.f; }
#pragma unroll
    for (int i = 0; i < 32; ++i) { const int kk = 2 * i + (lane >> 5); scr[kk * 33 + (lane & 31)] = t[i]; }
    LDS_WAIT(); asm volatile("" ::: "memory");
    const int c = lane & 7;
#pragma unroll
    for (int j = 0; j < 4; ++j) { const int n = (lane >> 3) + 8 * j; const LAS float* s = scr + (8 * c) * 33 + n;
        v4u o; o.x = pk2(s[0 * 33], s[1 * 33]); o.y = pk2(s[2 * 33], s[3 * 33]); o.z = pk2(s[4 * 33], s[5 * 33]); o.w = pk2(s[6 * 33], s[7 * 33]);
        *(GAS v4u*)(WT + (size_t)(drow0 + n) * K + k0 + 8 * c) = o; }
    LDS_WAIT(); asm volatile("" ::: "memory");
}
template <int MODE  >
__device__ __forceinline__ bool tr_matrix(int& it, const float* W, int K, int N, bf16* WT, LAS float* scr, int lane) {
    const int nblk = (N + 31) / 32, items = (K / 64) * nblk;
    if (it >= items) { it -= items; return false; }
    const int kb = it / nblk, nb = it % nblk, n0 = nb * 32;
    int drow0 = n0;
    if (MODE == 1) drow0 = (n0 >> 7) * 256 + (n0 & 127);
    if (MODE == 2) drow0 = (n0 >> 7) * 256 + 128 + (n0 & 127);
    tr_item(W, K, N, WT, drow0, kb * 64, n0, scr, lane);
    return true;
}

__device__ __forceinline__ void p0_phase(Frame& F, const float* c, const float* c_ctx, const float* w_ada, const float* b_ada, float* mods,
                                         const float* mix_w_in, const float* mix_w_out, const float* ffn_w1, const float* ffn_w3, const float* ffn_w2,
                                         const float* na_w_qkv, const float* na_w_out, unsigned char* ws) {
    for (int u = F.bid; u < 192; u += F.G) {
        LAS float* sc = (LAS float*)(F.lds);
        LAS float* red = (LAS float*)(F.lds + 36864);
        for (int i = F.tid; i < 9 * 1024; i += NTHR) { const int b = i >> 10, k = i & 1023; const float v = (b < 8) ? c[b * 1024 + k] : c_ctx[k]; sc[i] = v / (1.f + __expf(-v)); }
        __syncthreads();
        const int layer = u / 96, col = (u % 96) * 64 + F.lane;
        const float* W = w_ada + (size_t)layer * 1024 * 6144 + col;
        float acc[9];
#pragma unroll
        for (int b = 0; b < 9; ++b) acc[b] = 0.f;
        const int k0 = F.wave * 128;
#pragma unroll 8
        for (int k = 0; k < 128; ++k) { const float w = W[(size_t)(k0 + k) * 6144];
#pragma unroll
            for (int b = 0; b < 9; ++b) acc[b] += sc[b * 1024 + k0 + k] * w; }
#pragma unroll
        for (int b = 0; b < 9; ++b) red[(F.wave * 9 + b) * 64 + F.lane] = acc[b];
        __syncthreads();
        if (F.wave == 0) {
#pragma unroll
            for (int b = 0; b < 9; ++b) { float s = 0.f;
#pragma unroll
                for (int w = 0; w < 8; ++w) s += red[(w * 9 + b) * 64 + F.lane];
                mods[(layer * 9 + b) * 6144 + col] = s + b_ada[layer * 6144 + col]; }
        }
        __syncthreads();
    }
    LAS float* scr = (LAS float*)(F.lds + 57344 + F.wave * 8704);
    const int gw = F.bid * NWAVES + F.wave, NGW = F.G * NWAVES;
    constexpr int NITEMS = 16 * 104 + 512 + 1408 * 3 + 1536 + 512;
    for (int it0 = gw; it0 < NITEMS; it0 += NGW) {
        int it = it0;
        if (tr_matrix<0>(it, mix_w_in, 1024, MIXIN, (bf16*)(ws + WS_WIN_T), scr, F.lane)) continue;
        if (tr_matrix<0>(it, mix_w_out, 1024, 1024, (bf16*)(ws + WS_WOUT_T), scr, F.lane)) continue;
        if (tr_matrix<1>(it, ffn_w1, 1024, FF, (bf16*)(ws + WS_W13_T), scr, F.lane)) continue;
        if (tr_matrix<2>(it, ffn_w3, 1024, FF, (bf16*)(ws + WS_W13_T), scr, F.lane)) continue;
        if (tr_matrix<0>(it, ffn_w2, FF, 1024, (bf16*)(ws + WS_W2_T), scr, F.lane)) continue;
        if (tr_matrix<0>(it, na_w_qkv, 1024, 3072, (bf16*)(ws + WS_QKV_T), scr, F.lane)) continue;
        tr_matrix<0>(it, na_w_out, 1024, 1024, (bf16*)(ws + WS_NAO_T), scr, F.lane);
    }
}
constexpr int MOE_ITEMS = NE * 1408 * 3, MOE_ITEMS_P6 = 0, MOE_ITEMS_P8 = 10240, MOE_ITEMS_P9 = 23552, MOE_ITEMS_P11 = 0, MOE_ITEMS_P7 = MOE_ITEMS - MOE_ITEMS_P8 - MOE_ITEMS_P9 - MOE_ITEMS_P11;
__device__ __forceinline__ void moe_weight_phase(Frame& F, const float* w1, const float* w3, const float* w2, unsigned char* ws, int lo, int hi, int widx, int nw) {
    LAS float* scr = (LAS float*)(F.lds + 57344 + F.wave * 8704);
    const int gw = widx * NWAVES + F.wave, NGW = nw * NWAVES;
    constexpr int PER_E = 1408 * 3;
    for (int it0 = lo + gw; it0 < hi; it0 += NGW) {
        const int e = it0 / PER_E; int it = it0 % PER_E;
        bf16* w13t = (bf16*)(ws + WS_MOEW13) + (size_t)e * 5632 * 1024; bf16* w2t = (bf16*)(ws + WS_MOEW2) + (size_t)e * 1024 * FF;
        if (tr_matrix<1>(it, w1 + (size_t)e * 1024 * FF, 1024, FF, w13t, scr, F.lane)) continue;
        if (tr_matrix<2>(it, w3 + (size_t)e * 1024 * FF, 1024, FF, w13t, scr, F.lane)) continue;
        tr_matrix<0>(it, w2 + (size_t)e * 1024 * FF, FF, 1024, w2t, scr, F.lane);
    }
}

__device__ __forceinline__ void normmod_row(const float* xrow, const float* g, const float* sh, const float* sc, bf16* orow, int lane, f32x4 (&a)[4], const float* slab = nullptr, int nslab = 0, float* wb = nullptr) {
    const GAS f32x4* xr = (const GAS f32x4*)xrow + lane;
    float ss = 0.f;
#pragma unroll
    for (int j = 0; j < 4; ++j) a[j] = xr[64 * j];
    for (int s = 0; s < nslab; ++s) { const GAS f32x4* sr = (const GAS f32x4*)(slab + (size_t)s * (2048 * 1024)) + lane;
#pragma unroll
        for (int j = 0; j < 4; ++j) a[j] += sr[64 * j]; }
    if (wb) { GAS f32x4* w4 = (GAS f32x4*)wb + lane;
#pragma unroll
        for (int j = 0; j < 4; ++j) w4[64 * j] = a[j]; }
#pragma unroll
    for (int j = 0; j < 4; ++j) ss += (a[j].x * a[j].x + a[j].y * a[j].y) + (a[j].z * a[j].z + a[j].w * a[j].w);
    const float rs = rsqrtf(wave_sum(ss) * (1.f / 1024.f) + 1e-6f);
    GAS unsigned long long* o8 = (GAS unsigned long long*)orow + lane;
#pragma unroll
    for (int j = 0; j < 4; ++j) {
        const f32x4 gg = ((const GAS f32x4*)g)[lane + 64 * j], s1 = ((const GAS f32x4*)sc)[lane + 64 * j], s0 = ((const GAS f32x4*)sh)[lane + 64 * j];
        a[j] = (a[j] * rs) * gg * (s1 + 1.f) + s0;
        o8[64 * j] = (unsigned long long)pk2(a[j].x, a[j].y) | ((unsigned long long)pk2(a[j].z, a[j].w) << 32);
    }
}
__device__ __forceinline__ void normmod_phase(Frame& F, const float* src_ctx, const float* src_lat, const float* g, const float* mods_l, int off_shift, int off_scale, bf16* dst, const float* slab = nullptr, int nslab = 0, float* wb_ctx = nullptr) {
    const int gw = F.bid * NWAVES + F.wave, NGW = F.G * NWAVES;
    for (int r = gw; r < M_ALL; r += NGW) {
        const bool isctx = r < M_CTX; const int rl = isctx ? r : r - M_CTX; const int mi = isctx ? 8 : (rl >> 11);
        const float* xrow = (isctx ? src_ctx : src_lat) + (size_t)rl * D; const float* mp = mods_l + mi * 6144;
        f32x4 a[4];
        if (isctx) normmod_row(xrow, g, mp + off_shift, mp + off_scale, dst + (size_t)r * D, F.lane, a, slab ? slab + (size_t)rl * D : nullptr, nslab, wb_ctx ? wb_ctx + (size_t)rl * D : nullptr);
        else normmod_row(xrow, g, mp + off_shift, mp + off_scale, dst + (size_t)r * D, F.lane, a);
    }
}

namespace pg8 {
struct EpiResGate {
    static constexpr bool PERM = false, AFTER_DRAIN = false;
    const float* base_c; const float* base_l; float* out_c; float* out_l; const float* mods_l; int gate_off; int ctx_tiles;
    __device__ __forceinline__ void operator()(const f32x4 (&acc)[2][2][4][2], const Unit& u, int wr, int wc, int fr, int fq) const {
        const bool isctx = u.pm < ctx_tiles; const int rt = isctx ? u.pm : u.pm - ctx_tiles; const int mi = isctx ? 8 : (rt >> 3);
        const float* base = isctx ? base_c : base_l; float* out = isctx ? out_c : out_l;
        const int col0 = u.pn * BM + wc * 32 + 4 * fq; const float* gp = mods_l + mi * 6144 + gate_off + col0;
        f32x4 gv[2][2];
#pragma unroll
        for (int bj = 0; bj < 2; ++bj)
#pragma unroll
            for (int n = 0; n < 2; ++n) gv[bj][n] = *(const f32x4*)(gp + bj * HALF + n * 16);
#pragma unroll
        for (int ai = 0; ai < 2; ++ai)
#pragma unroll
            for (int m = 0; m < 4; ++m) { const size_t off = (size_t)(rt * BM + ai * HALF + wr * 64 + m * 16 + fr) * 1024 + col0;
#pragma unroll
                for (int bj = 0; bj < 2; ++bj)
#pragma unroll
                    for (int n = 0; n < 2; ++n) { const f32x4 b = *(const f32x4*)(base + off + bj * HALF + n * 16); *(f32x4*)(out + off + bj * HALF + n * 16) = b + gv[bj][n] * acc[ai][bj][m][n]; } }
    }
};
struct EpiSwiGLU {
    static constexpr bool PERM = true, AFTER_DRAIN = false;
    bf16_t* O; int ldo; int nt_mod;
    __device__ __forceinline__ void operator()(const f32x4 (&acc)[2][2][4][2], const Unit& u, int wr, int wc, int fr, int fq) const {
        const int pnl = u.pn % nt_mod; const int row0 = u.pm * BM + wr * 64 + fr, col0 = pnl * HALF + wc * 32 + 8 * fq;
#pragma unroll
        for (int ai = 0; ai < 2; ++ai)
#pragma unroll
            for (int m = 0; m < 4; ++m) { bf16_t* rowp = O + (size_t)(row0 + ai * HALF + m * 16) * ldo + col0;
                float h[8];
#pragma unroll
                for (int n = 0; n < 2; ++n)
#pragma unroll
                    for (int e = 0; e < 4; ++e) { const float a = acc[ai][0][m][n][e], b = acc[ai][1][m][n][e]; h[n * 4 + e] = a * b * __builtin_amdgcn_rcpf(1.f + __expf(-a)); }
                u32x4 w; w.x = cvt_pk_bf16(h[0], h[1]); w.y = cvt_pk_bf16(h[2], h[3]); w.z = cvt_pk_bf16(h[4], h[5]); w.w = cvt_pk_bf16(h[6], h[7]);
                PG8_ST16(O, rowp, w); }
    }
};
struct EpiPlainMod {
    static constexpr bool PERM = true, AFTER_DRAIN = false;
    bf16_t* O; int ldo; int nt_mod;
    __device__ __forceinline__ void operator()(const f32x4 (&acc)[2][2][4][2], const Unit& u, int wr, int wc, int fr, int fq) const {
        const int pnl = u.pn % nt_mod; const int row0 = u.pm * BM + wr * 64 + fr, col0 = pnl * BM + wc * 32 + 8 * fq;
#pragma unroll
        for (int ai = 0; ai < 2; ++ai)
#pragma unroll
            for (int m = 0; m < 4; ++m) { bf16_t* rowp = O + (size_t)(row0 + ai * HALF + m * 16) * ldo + col0;
#pragma unroll
                for (int bj = 0; bj < 2; ++bj) { const f32x4 v0 = acc[ai][bj][m][0], v1 = acc[ai][bj][m][1];
                    u32x4 w; w.x = cvt_pk_bf16(v0[0], v0[1]); w.y = cvt_pk_bf16(v0[2], v0[3]); w.z = cvt_pk_bf16(v1[0], v1[1]); w.w = cvt_pk_bf16(v1[2], v1[3]);
                    PG8_ST16(O, rowp + bj * HALF, w); } }
    }
};
struct SplitKOrder {
    int ntm, nN, ns, kslice, G, c;
    __device__ __forceinline__ bool next(int i, Unit& u) const {
        const int L = i * G + c; if (L >= ntm * nN * ns) return false;
        const int ks = L % ns, t = L / ns; u.pn = t % nN; u.pm = t / nN; u.k0 = ks * kslice; return true;
    }
    __device__ __forceinline__ void a_ready(const Unit&) const {}
    __device__ __forceinline__ void done(const Unit&) const {}
};
struct EpiSlabGate {
    static constexpr bool PERM = false, AFTER_DRAIN = false;
    float* slab; const float* gate; int kslice;
    __device__ __forceinline__ void operator()(const f32x4 (&acc)[2][2][4][2], const Unit& u, int wr, int wc, int fr, int fq) const {
        const int col0 = u.pn * BM + wc * 32 + 4 * fq; float* out = slab + (size_t)(u.k0 / kslice) * (2048 * 1024);
        f32x4 gv[2][2];
#pragma unroll
        for (int bj = 0; bj < 2; ++bj)
#pragma unroll
            for (int n = 0; n < 2; ++n) gv[bj][n] = *(const f32x4*)(gate + col0 + bj * HALF + n * 16);
#pragma unroll
        for (int ai = 0; ai < 2; ++ai)
#pragma unroll
            for (int m = 0; m < 4; ++m) { float* op = out + (size_t)(u.pm * BM + ai * HALF + wr * 64 + m * 16 + fr) * 1024 + col0;
#pragma unroll
                for (int bj = 0; bj < 2; ++bj)
#pragma unroll
                    for (int n = 0; n < 2; ++n) *(f32x4*)(op + bj * HALF + n * 16) = gv[bj][n] * acc[ai][bj][m][n]; }
    }
};
struct MoeOrder {
    int tb[9]; int ntn, G, c; int limit = 0x7fffffff;
    __device__ __forceinline__ bool next(int i, Unit& u) const {
        const int L = i * G + c; if (L >= tb[8] * ntn || L >= limit) return false;
        const int mt = L / ntn, pn = L % ntn; int e = 0;
#pragma unroll
        for (int k = 1; k < 8; ++k) e += (mt >= tb[k]) ? 1 : 0;
        u.pm = mt; u.pn = e * ntn + pn; return true;
    }
    __device__ __forceinline__ void a_ready(const Unit&) const {}
    __device__ __forceinline__ void done(const Unit&) const {}
};
struct MoeTailOrder {
    int tb[9]; int first, ntail, G, c;
    __device__ __forceinline__ bool next(int i, Unit& u) const {
        const int L = i * G + c; if (L >= ntail * 11) return false;
        const int tu = L / 11, ks = L % 11, gu = first + tu, mt = gu >> 2, pn = gu & 3; int e = 0;
#pragma unroll
        for (int k = 1; k < 8; ++k) e += (mt >= tb[k]) ? 1 : 0;
        u.pm = mt; u.pn = e * 4 + pn; u.k0 = ks * 256; return true;
    }
    __device__ __forceinline__ void a_ready(const Unit&) const {}
    __device__ __forceinline__ void done(const Unit&) const {}
};
struct EpiTailSlab {
    static constexpr bool PERM = false, AFTER_DRAIN = false;
    float* slab; int first, ntail;
    __device__ __forceinline__ void operator()(const f32x4 (&acc)[2][2][4][2], const Unit& u, int wr, int wc, int fr, int fq) const {
        const int col0 = (u.pn & 3) * BM + wc * 32 + 4 * fq; float* out = slab + (size_t)(u.k0 >> 8) * ((size_t)(ntail >> 2) * 256 * 1024);
        const int rt = u.pm - (first >> 2);
#pragma unroll
        for (int ai = 0; ai < 2; ++ai)
#pragma unroll
            for (int m = 0; m < 4; ++m) { float* op = out + (size_t)(rt * BM + ai * HALF + wr * 64 + m * 16 + fr) * 1024 + col0;
#pragma unroll
                for (int bj = 0; bj < 2; ++bj)
#pragma unroll
                    for (int n = 0; n < 2; ++n) *(f32x4*)(op + bj * HALF + n * 16) = acc[ai][bj][m][n]; }
    }
};
}

struct PrepIn { const float *rw_mu, *rw_w0, *rw_w_up, *rw_a0, *rw_a_up, *rw_g_up, *rw_k_k, *rw_k_a, *rw_r_k, *conv_w, *conv_b, *dt_bias; };
template <int CTRL> __device__ __forceinline__ float dppf(float x) { return __int_as_float(__builtin_amdgcn_update_dpp(0, __float_as_int(x), CTRL, 0xF, 0xF, true)); }
__device__ __forceinline__ float sum8(float x) { x += dppf<0xB1>(x); x += dppf<0x4E>(x); x += dppf<0x141>(x); return x; }
__device__ __forceinline__ float sum16(float x) { x = sum8(x); x += dppf<0x140>(x); return x; }
__device__ __forceinline__ bf16x8 gather8(const float* p, int stride) {
    v4u w; w.x = pk2(p[0], p[stride]); w.y = pk2(p[2 * stride], p[3 * stride]); w.z = pk2(p[4 * stride], p[5 * stride]); w.w = pk2(p[6 * stride], p[7 * stride]); return __builtin_bit_cast(bf16x8, w);
}
constexpr int ACT_ST = 464;
__device__ __forceinline__ void prepare_phase(Frame& F, const PrepIn& P, const bf16* Z, bf16* PR, bf16* PM, float* DT, float* BONUS, bf16* GATE, bf16* ZG) {
    LAS unsigned short* zs = (LAS unsigned short*)F.lds;
    LAS unsigned char* actb = F.lds + 24576;
    LAS float* cst = (LAS float*)(F.lds + 24576 + 16 * ACT_ST);
    const int tid = F.tid, lane = F.lane, fr = lane & 15, fq = lane >> 4, w = F.wave;
    const int hf = F.bid & 1, wl = w & 3, hd = 4 * hf + wl;
    __syncthreads();
    if (tid < 256) { const int c = 256 * hf + tid; cst[tid] = P.rw_w0[c]; cst[256 + tid] = P.rw_w0[512 + c]; cst[512 + tid] = P.rw_a0[c]; cst[768 + tid] = P.rw_a0[512 + c];
      cst[1024 + tid] = P.rw_k_k[c]; cst[1280 + tid] = P.rw_k_a[c]; cst[1536 + tid] = P.rw_r_k[c]; cst[1792 + tid] = P.rw_r_k[512 + c]; }
    bf16x8 W[16];
#pragma unroll
    for (int cb = 0; cb < 4; ++cb) { const int c = 64 * hd + 4 * fr + cb;
        if (w < 4) { W[cb] = gather8(P.rw_w_up + (size_t)(8 * fq) * 512 + c, 512); W[4 + cb] = gather8(P.rw_w_up + (size_t)(32 + 8 * fq) * 512 + c, 512);
                     W[8 + cb] = gather8(P.rw_a_up + (size_t)(8 * fq) * 512 + c, 512); W[12 + cb] = gather8(P.rw_a_up + (size_t)(32 + 8 * fq) * 512 + c, 512); }
        else { W[cb] = gather8(P.rw_g_up + (size_t)(8 * fq) * 512 + c, 512); W[4 + cb] = gather8(P.rw_g_up + (size_t)(32 + 8 * fq) * 512 + c, 512); W[8 + cb] = gather8(P.rw_g_up + (size_t)(64 + 8 * fq) * 512 + c, 512); W[12 + cb] = W[cb]; } }
    const int col0 = (tid < 256) ? (256 * hf + tid) : (512 + 256 * hf + tid - 256), col1 = (tid < 256) ? (1024 + 256 * hf + tid) : ((tid < 480) ? (1536 + tid - 256) : 1536);
    const int zo0 = tid, zo1 = 512 + (tid & 255);
    const float mu00 = P.rw_mu[col0], mu10 = P.rw_mu[RWC + col0], mu01 = P.rw_mu[col1], mu11 = P.rw_mu[RWC + col1];
    float cw[5];
#pragma unroll
    for (int k = 0; k < 5; ++k) cw[k] = P.conv_w[k * 1024 + 512 * hf + tid];
    const float cbv = P.conv_b[512 * hf + tid], dtb = P.dt_bias[tid & 15];
    __syncthreads();

#ifndef PREP_REPS
#define PREP_REPS 1
#endif
    for (int rb_ = F.bid >> 1; rb_ < (M_ALL / 16) * PREP_REPS; rb_ += (F.G >> 1)) {
        const int rb = rb_ % (M_ALL / 16); const int g0 = rb * 16; const bool isctx = g0 < M_CTX; const int T = isctx ? CTXL : SEQ; const int t0 = isctx ? (g0 & (CTXL - 1)) : ((g0 - M_CTX) & (SEQ - 1));
        const bf16* zb = Z + (size_t)g0 * ZLD;
        const bool hp = t0 > 0, hn = (t0 + 16 < T), hp2 = t0 >= 2, hn2 = (t0 + 17 < T);
        float z0[18], z1[18], x[20];
        const int ccol = RWC + 512 + 512 * hf + tid;
#pragma unroll
        for (int i = 0; i < 18; ++i) { const bool ok = (i == 0) ? hp : ((i == 17) ? hn : true); z0[i] = ok ? ldbf(zb + (ptrdiff_t)(i - 1) * ZLD + col0) : 0.f; z1[i] = ok ? ldbf(zb + (ptrdiff_t)(i - 1) * ZLD + col1) : 0.f; }
#pragma unroll
        for (int i = 0; i < 20; ++i) { const bool ok = (i == 0) ? hp2 : (i == 1) ? hp : (i == 18) ? hn : (i == 19) ? hn2 : true; x[i] = ok ? ldbf(zb + (ptrdiff_t)(i - 2) * ZLD + ccol) : 0.f; }
#pragma unroll
        for (int tb = 0; tb < 16; ++tb) zs[tb * 768 + zo0] = (unsigned short)f2bf(z0[tb + 1] + mu00 * (z0[tb] - z0[tb + 1]) + mu10 * (z0[tb + 2] - z0[tb + 1]));
        {
            const int a = tid - 256;
#pragma unroll
            for (int tb = 0; tb < 16; ++tb) {
                const float zsft = z1[tb + 1] + mu01 * (z1[tb] - z1[tb + 1]) + mu11 * (z1[tb + 2] - z1[tb + 1]);
                if (tid < 256) zs[tb * 768 + zo1] = (unsigned short)f2bf(zsft);
                else if (tid < 480) { const float sg = sigm((a < 64) ? 2.f * zsft : zsft); const float av = (a < 64) ? (2.f * sg - 1.f) : ((a < 128) ? zsft : sg);
                    *(LAS unsigned short*)(actb + tb * ACT_ST + a * 2) = (unsigned short)f2bf(av); }
            }
        }
#pragma unroll
        for (int tb = 0; tb < 16; ++tb) {
            float y = cbv + cw[0] * x[tb] + cw[1] * x[tb + 1] + cw[2] * x[tb + 2] + cw[3] * x[tb + 3] + cw[4] * x[tb + 4];
            y = y * sigm(y);
            PM[(size_t)(g0 + tb) * 1024 + 512 * hf + tid] = (bf16)f2bf(y);
        }
        { const int tb = tid >> 5, cc = tid & 31;
          *(GAS v4u*)(ZG + (size_t)(g0 + tb) * 512 + 256 * hf + cc * 8) = *(const GAS v4u*)(zb + (size_t)tb * ZLD + RWC + 256 * hf + cc * 8); }
        if (hf == 0 && tid < 256) { const int tb = tid >> 4, cc = tid & 15; const float x = ldbf(zb + (size_t)tb * ZLD + RWC + 1536 + cc) + dtb; DT[(size_t)(g0 + tb) * 16 + cc] = (x > 20.f) ? x : log1pf(__expf(x)); }
        __syncthreads();
        const f32x4 zero = {0.f, 0.f, 0.f, 0.f};
        const int cl0 = 64 * wl + 4 * fr;
        if (w < 4) {
            bf16x8 Af[4];
#pragma unroll
            for (int kb = 0; kb < 4; ++kb) Af[kb] = *(const LAS bf16x8*)(actb + fr * ACT_ST + kb * 64 + fq * 16);
            f32x4 lw0[4], lw1[4], ia0[4], ia1[4];
#pragma unroll
            for (int cb = 0; cb < 4; ++cb) {
                lw0[cb] = __builtin_amdgcn_mfma_f32_16x16x32_bf16(Af[0], W[cb], zero, 0, 0, 0); lw1[cb] = __builtin_amdgcn_mfma_f32_16x16x32_bf16(Af[1], W[4 + cb], zero, 0, 0, 0);
                ia0[cb] = __builtin_amdgcn_mfma_f32_16x16x32_bf16(Af[2], W[8 + cb], zero, 0, 0, 0); ia1[cb] = __builtin_amdgcn_mfma_f32_16x16x32_bf16(Af[3], W[12 + cb], zero, 0, 0, 0);
            }
            const f32x4 w00 = *(const LAS f32x4*)(cst + cl0), w01 = *(const LAS f32x4*)(cst + 256 + cl0), a00 = *(const LAS f32x4*)(cst + 512 + cl0), a01 = *(const LAS f32x4*)(cst + 768 + cl0);
            const f32x4 kkc = *(const LAS f32x4*)(cst + 1024 + cl0), kac = *(const LAS f32x4*)(cst + 1280 + cl0), rk0 = *(const LAS f32x4*)(cst + 1536 + cl0), rk1 = *(const LAS f32x4*)(cst + 1792 + cl0);
#pragma unroll
            for (int e = 0; e < 4; ++e) {
                const int tok = 4 * fq + e; const size_t g = (size_t)(g0 + tok);
                const v2u ru = *(const LAS v2u*)(zs + tok * 768 + cl0), ku = *(const LAS v2u*)(zs + tok * 768 + 256 + cl0), vu = *(const LAS v2u*)(zs + tok * 768 + 512 + cl0);
                const f32x4 r = {bflo(ru.x), bfhi(ru.x), bflo(ru.y), bfhi(ru.y)}, k = {bflo(ku.x), bfhi(ku.x), bflo(ku.y), bfhi(ku.y)};
                const f32x4 kks = k * kkc;
                const float ssq = sum16((kks[0] * kks[0] + kks[1] * kks[1]) + (kks[2] * kks[2] + kks[3] * kks[3]));
                const float rn = 1.f / fmaxf(sqrtf(ssq), 1e-12f);
                float ee0[4], ee1[4], kd0[4], kd1[4], bb0[4], bb1[4], na[4]; float bon = 0.f;
#pragma unroll
                for (int cb = 0; cb < 4; ++cb) {
                    ee0[cb] = 0.60653066f * sigm(w00[cb] + lw0[cb][e]); ee1[cb] = 0.60653066f * sigm(w01[cb] + lw1[cb][e]);
                    const float ic0 = sigm(a00[cb] + ia0[cb][e]), ic1 = sigm(a01[cb] + ia1[cb][e]);
                    const float kkn = kks[cb] * rn;
                    kd0[cb] = k[cb] * (1.f + (ic0 - 1.f) * kac[cb]); kd1[cb] = k[cb] * (1.f + (ic1 - 1.f) * kac[cb]);
                    bon += r[cb] * (kd0[cb] * rk0[cb] + kd1[cb] * rk1[cb]);
                    na[cb] = -kkn; bb0[cb] = kkn * ic0; bb1[cb] = kkn * ic1;
                }
                bon = sum16(bon); if (fr == 0) BONUS[g * 8 + hd] = bon;
                bf16* pr = PR + g * PRV + 256 * hf + cl0;
                *(GAS v2u*)(pr) = ru; *(GAS v2u*)(pr + 512) = vu;
                v2u o;
                o.x = pk2(na[0], na[1]); o.y = pk2(na[2], na[3]); *(GAS v2u*)(pr + 1024) = o;
                o.x = pk2(ee0[0], ee0[1]); o.y = pk2(ee0[2], ee0[3]); *(GAS v2u*)(pr + 1536) = o;
                o.x = pk2(kd0[0], kd0[1]); o.y = pk2(kd0[2], kd0[3]); *(GAS v2u*)(pr + 2048) = o;
                o.x = pk2(bb0[0], bb0[1]); o.y = pk2(bb0[2], bb0[3]); *(GAS v2u*)(pr + 2560) = o;
                o.x = pk2(ee1[0], ee1[1]); o.y = pk2(ee1[2], ee1[3]); *(GAS v2u*)(pr + 3072) = o;
                o.x = pk2(kd1[0], kd1[1]); o.y = pk2(kd1[2], kd1[3]); *(GAS v2u*)(pr + 3584) = o;
                o.x = pk2(bb1[0], bb1[1]); o.y = pk2(bb1[2], bb1[3]); *(GAS v2u*)(pr + 4096) = o;
            }
        } else {
            bf16x8 Af[3];
#pragma unroll
            for (int kb = 0; kb < 3; ++kb) Af[kb] = *(const LAS bf16x8*)(actb + fr * ACT_ST + (4 + kb) * 64 + fq * 16);
            f32x4 gt[4];
#pragma unroll
            for (int cb = 0; cb < 4; ++cb) {
                gt[cb] = __builtin_amdgcn_mfma_f32_16x16x32_bf16(Af[0], W[cb], zero, 0, 0, 0);
                gt[cb] = __builtin_amdgcn_mfma_f32_16x16x32_bf16(Af[1], W[4 + cb], gt[cb], 0, 0, 0); gt[cb] = __builtin_amdgcn_mfma_f32_16x16x32_bf16(Af[2], W[8 + cb], gt[cb], 0, 0, 0);
            }
#pragma unroll
            for (int e = 0; e < 4; ++e) { v2u o; o.x = pk2(gt[0][e], gt[1][e]); o.y = pk2(gt[2][e], gt[3][e]); *(GAS v2u*)(GATE + (size_t)(g0 + 4 * fq + e) * 512 + 256 * hf + cl0) = o; }
        }
        __syncthreads();
    }
}

template <int SH> __device__ __forceinline__ float dpp_shr(float x) { return __int_as_float(__builtin_amdgcn_update_dpp(0, __float_as_int(x), 0x110 + SH, 0xF, 0xF, true)); }
__device__ __forceinline__ int scan_row16(int c, int t, int b, int d) {
    const int st = c * 16 + t; const int seg = (st >= CTXL) ? 1 : 0; const int T = seg ? SEQ : CTXL; const int sl = st - seg * CTXL;
    return (seg ? (M_CTX + b * SEQ) : b * CTXL) + (d ? (T - 1 - sl) : sl);
}
__device__ __forceinline__ v4u scale8(const v4u u, float s) {
    v4u o; o.x = pk2(bflo(u.x) * s, bfhi(u.x) * s); o.y = pk2(bflo(u.y) * s, bfhi(u.y) * s); o.z = pk2(bflo(u.z) * s, bfhi(u.z) * s); o.w = pk2(bflo(u.w) * s, bfhi(u.w) * s); return o;
}
__device__ __forceinline__ bf16x8 pack4z(const f32x4& a) { v4u w; w.x = pk2(a[0], a[1]); w.y = pk2(a[2], a[3]); w.z = 0u; w.w = 0u; return __builtin_bit_cast(bf16x8, w); }
__device__ __forceinline__ bf16x8 tr4z(const LAS unsigned char* p) {
    const v2u t = __builtin_bit_cast(v2u, __builtin_amdgcn_ds_read_tr16_b64_v4i16((LAS v4i16_t*)p)); v4u w; w.x = t.x; w.y = t.y; w.z = 0u; w.w = 0u; return __builtin_bit_cast(bf16x8, w);
}
__device__ __forceinline__ bf16x8 cat44(const v2u a, const v2u b) { v4u w; w.x = a.x; w.y = a.y; w.z = b.x; w.w = b.y; return __builtin_bit_cast(bf16x8, w); }
constexpr int NCH16 = (CTXL + SEQ) / 16;
__device__ __forceinline__ f32x4 mm16(const f32x4& xT_c, const f32x4& y_c, const f32x4& acc) {
    return __builtin_amdgcn_mfma_f32_16x16x32_bf16(pack4z(xT_c), pack4z(y_c), acc, 0, 0, 0);
}
constexpr int RING_FLAGS = 122880;
constexpr int NSLOT = 6;
__device__ __forceinline__ unsigned lds_flag_ld(volatile LAS unsigned* p) { return (unsigned)__builtin_amdgcn_readfirstlane((int)*p); }
__device__ __forceinline__ void ring_wait_full(volatile LAS unsigned* fl, int s, int c) { while (lds_flag_ld(fl + s) != (unsigned)(c + 1)) __builtin_amdgcn_s_sleep(1); asm volatile("" ::: "memory"); }
__device__ __forceinline__ void ring_wait_free(volatile LAS unsigned* fl, int s, int c, int nslot = NSLOT) { const unsigned want = 4u * (unsigned)(c / nslot); while (lds_flag_ld(fl + 8 + s) < want) __builtin_amdgcn_s_sleep(1); asm volatile("" ::: "memory"); }
__device__ __forceinline__ void ring_set_full(volatile LAS unsigned* fl, int s, int c, int lane) { asm volatile("s_waitcnt lgkmcnt(0)" ::: "memory"); if (lane == 0) fl[s] = (unsigned)(c + 1); }
__device__ __forceinline__ void ring_done(volatile LAS unsigned* fl, int s, int lane) { asm volatile("s_waitcnt lgkmcnt(0)" ::: "memory"); if (lane == 0) __hip_atomic_fetch_add((LAS unsigned*)(fl + 8 + s), 1u, __ATOMIC_RELAXED, __HIP_MEMORY_SCOPE_WORKGROUP); }

constexpr int RST = 144, RIMG = 16 * RST;
constexpr int RW_SLOT = 18432;
__device__ __forceinline__ void rwkv_block(Frame& F, int unit, const bf16* PR, bf16* YRW) {
    const int d = unit & 1, h = (unit >> 1) & 7, b = unit >> 4;
    const int lane = F.lane, fr = lane & 15, fq = lane >> 4, tq = (lane & 15) >> 2, tp = lane & 3;
    volatile LAS unsigned* fl = (volatile LAS unsigned*)(F.lds + RING_FLAGS);
    __syncthreads();
    if (F.tid < 16) fl[F.tid] = 0u;
    __syncthreads();
    if (F.wave >= 4) {
        const int p = F.wave - 4;
        const int ve = (3 + 3 * d) * 512, vb = (5 + 3 * d) * 512, vk = (4 + 3 * d) * 512;
        bf16x8 Ltri; { v4u w; w.x = ((4 * fq + 0 <= fr) ? 0x3F80u : 0u) | ((4 * fq + 1 <= fr) ? 0x3F800000u : 0u); w.y = ((4 * fq + 2 <= fr) ? 0x3F80u : 0u) | ((4 * fq + 3 <= fr) ? 0x3F800000u : 0u); w.z = 0u; w.w = 0u; Ltri = __builtin_bit_cast(bf16x8, w); }
        v4u rE[2], rA[2], rB[2], rK[2], rR[2], rV[2];
#define RW_LOAD(c_) do { \
        _Pragma("unroll") for (int i = 0; i < 2; ++i) { const int id = lane + 64 * i; const bf16* src = PR + (size_t)scan_row16((c_), id >> 3, b, d) * PRV + h * 64 + (id & 7) * 8; \
            rE[i] = *(const GAS v4u*)(src + ve); rA[i] = *(const GAS v4u*)(src + 1024); rB[i] = *(const GAS v4u*)(src + vb); rK[i] = *(const GAS v4u*)(src + vk); rR[i] = *(const GAS v4u*)(src); rV[i] = *(const GAS v4u*)(src + 512); } } while (0)
        RW_LOAD(p);
        for (int c = p; c < NCH16; c += 4) {
            const int s = c % NSLOT;
            LAS unsigned char* sb = F.lds + s * RW_SLOT;
            LAS unsigned char* RE = sb; LAS unsigned char* RA = sb + RIMG; LAS unsigned char* RB = sb + 2 * RIMG; LAS unsigned char* RK = sb + 3 * RIMG; LAS unsigned char* RR = sb + 4 * RIMG;
            LAS unsigned char* RV = sb + 5 * RIMG; LAS unsigned char* FRG = sb + 6 * RIMG; LAS float* GC = (LAS float*)(sb + 6 * RIMG + 4096);
            ring_wait_free(fl, s, c);
#pragma unroll
            for (int i = 0; i < 2; ++i) { const int id = lane + 64 * i; const int o = (id >> 3) * RST + (id & 7) * 16;
                *(LAS v4u*)(RE + o) = rE[i]; *(LAS v4u*)(RA + o) = rA[i]; *(LAS v4u*)(RB + o) = rB[i]; *(LAS v4u*)(RK + o) = rK[i]; *(LAS v4u*)(RR + o) = rR[i]; *(LAS v4u*)(RV + o) = rV[i]; }
            if (c + 4 < NCH16) RW_LOAD(c + 4);
            asm volatile("s_waitcnt lgkmcnt(0)" ::: "memory");
#pragma unroll
            for (int jb = 0; jb < 4; ++jb) {
                const int tro = (4 * fq + tq) * RST + (16 * jb + 4 * tp) * 2;
                const v2u eu = __builtin_bit_cast(v2u, __builtin_amdgcn_ds_read_tr16_b64_v4i16((LAS v4i16_t*)(RE + tro)));
                const v2u au = __builtin_bit_cast(v2u, __builtin_amdgcn_ds_read_tr16_b64_v4i16((LAS v4i16_t*)(RA + tro)));
                const v2u bu = __builtin_bit_cast(v2u, __builtin_amdgcn_ds_read_tr16_b64_v4i16((LAS v4i16_t*)(RB + tro)));
                const v2u ku = __builtin_bit_cast(v2u, __builtin_amdgcn_ds_read_tr16_b64_v4i16((LAS v4i16_t*)(RK + tro)));
                const v2u ru = __builtin_bit_cast(v2u, __builtin_amdgcn_ds_read_tr16_b64_v4i16((LAS v4i16_t*)(RR + tro)));
                v4u ew; ew.x = eu.x; ew.y = eu.y; ew.z = 0u; ew.w = 0u;
                const f32x4 cum = __builtin_amdgcn_mfma_f32_16x16x32_bf16(Ltri, __builtin_bit_cast(bf16x8, ew), (f32x4){0.f, 0.f, 0.f, 0.f}, 0, 0, 0);
                const float ev[4] = {bflo(eu.x), bfhi(eu.x), bflo(eu.y), bfhi(eu.y)}, av[4] = {bflo(au.x), bfhi(au.x), bflo(au.y), bfhi(au.y)}, bv[4] = {bflo(bu.x), bfhi(bu.x), bflo(bu.y), bfhi(bu.y)};
                const float kv[4] = {bflo(ku.x), bfhi(ku.x), bflo(ku.y), bfhi(ku.y)}, rv[4] = {bflo(ru.x), bfhi(ru.x), bflo(ru.y), bfhi(ru.y)};
#pragma unroll
                for (int e = 0; e < 4; ++e) {
                    const float G = __expf(-cum[e]), Gi = __expf(cum[e]), Gx = __expf(ev[e] - cum[e]);
                    const int o = (4 * fq + e) * RST + (16 * jb + fr) * 2;
                    const unsigned ab = pk2(av[e] * Gx, bv[e] * Gi), kr = pk2(kv[e] * Gi, rv[e] * G);
                    *(LAS unsigned short*)(RA + o) = (unsigned short)ab; *(LAS unsigned short*)(RB + o) = (unsigned short)(ab >> 16);
                    *(LAS unsigned short*)(RK + o) = (unsigned short)kr; *(LAS unsigned short*)(RR + o) = (unsigned short)(kr >> 16);
                    if (e == 3 && fq == 3) GC[16 * jb + fr] = G;
                }
            }
            asm volatile("s_waitcnt lgkmcnt(0)" ::: "memory");
            f32x4 aba = {0.f, 0.f, 0.f, 0.f}, aka = aba, abr = aba, akr = aba, abaT = aba;
#pragma unroll
            for (int kb = 0; kb < 2; ++kb) {
                const int o = fr * RST + kb * 64 + fq * 16;
                const bf16x8 fb = *(const LAS bf16x8*)(RB + o), fk = *(const LAS bf16x8*)(RK + o), fa = *(const LAS bf16x8*)(RA + o), frr = *(const LAS bf16x8*)(RR + o);
                aba = __builtin_amdgcn_mfma_f32_16x16x32_bf16(fb, fa, aba, 0, 0, 0); aka = __builtin_amdgcn_mfma_f32_16x16x32_bf16(fk, fa, aka, 0, 0, 0);
                abr = __builtin_amdgcn_mfma_f32_16x16x32_bf16(fb, frr, abr, 0, 0, 0); akr = __builtin_amdgcn_mfma_f32_16x16x32_bf16(fk, frr, akr, 0, 0, 0);
                abaT = __builtin_amdgcn_mfma_f32_16x16x32_bf16(fa, fb, abaT, 0, 0, 0);
            }
            f32x4 idc;
#pragma unroll
            for (int e = 0; e < 4; ++e) { const int row = 4 * fq + e;
                aba[e] = (row < fr) ? aba[e] : 0.f; aka[e] = (row < fr) ? aka[e] : 0.f; abr[e] = (row <= fr) ? abr[e] : 0.f; akr[e] = (row <= fr) ? akr[e] : 0.f;
                abaT[e] = (fr < row) ? abaT[e] : 0.f; idc[e] = (row == fr) ? 1.f : 0.f; }
            f32x4 t_c = idc + aba, t_T = idc + abaT;
            f32x4 p_c = mm16(abaT, aba, (f32x4){0.f, 0.f, 0.f, 0.f}), p_T = mm16(aba, abaT, (f32x4){0.f, 0.f, 0.f, 0.f});
            { const f32x4 n_c = mm16(t_T, p_c, t_c), n_T = mm16(p_c, t_T, t_T); t_c = n_c; t_T = n_T; }
            { const f32x4 q_c = mm16(p_T, p_c, (f32x4){0.f, 0.f, 0.f, 0.f}), q_T = mm16(p_c, p_T, (f32x4){0.f, 0.f, 0.f, 0.f}); p_c = q_c; p_T = q_T; }
            { const f32x4 n_c = mm16(t_T, p_c, t_c), n_T = mm16(p_c, t_T, t_T); t_c = n_c; t_T = n_T; }
            { const f32x4 q_c = mm16(p_T, p_c, (f32x4){0.f, 0.f, 0.f, 0.f}); p_c = q_c; }
            const f32x4 tm_c = mm16(t_T, p_c, t_c);
            *(LAS bf16x8*)(FRG + lane * 16) = pack4z(tm_c); *(LAS bf16x8*)(FRG + 1024 + lane * 16) = pack4z(aka);
            *(LAS bf16x8*)(FRG + 2048 + lane * 16) = pack4z(abr); *(LAS bf16x8*)(FRG + 3072 + lane * 16) = pack4z(akr);
            ring_set_full(fl, s, c, lane);
        }
#undef RW_LOAD
    } else {
        const int q = F.wave;
        bf16* yout = YRW + (size_t)d * M_ALL * 512 + h * 64 + 16 * q;
        f32x4 T[4];
#pragma unroll
        for (int jb = 0; jb < 4; ++jb) T[jb] = (f32x4){0.f, 0.f, 0.f, 0.f};
        for (int c = 0; c < NCH16; ++c) {
            const int s = c % NSLOT;
            LAS unsigned char* sb = F.lds + s * RW_SLOT;
            LAS unsigned char* RA = sb + RIMG; LAS unsigned char* RB = sb + 2 * RIMG; LAS unsigned char* RK = sb + 3 * RIMG; LAS unsigned char* RR = sb + 4 * RIMG;
            LAS unsigned char* RV = sb + 5 * RIMG; LAS unsigned char* FRG = sb + 6 * RIMG; LAS float* GC = (LAS float*)(sb + 6 * RIMG + 4096);
            ring_wait_full(fl, s, c);
            const bf16x8 tmA = *(const LAS bf16x8*)(FRG + lane * 16), akaA = *(const LAS bf16x8*)(FRG + 1024 + lane * 16), abrA = *(const LAS bf16x8*)(FRG + 2048 + lane * 16), akrA = *(const LAS bf16x8*)(FRG + 3072 + lane * 16);
            const bf16x8 Vf = tr4z(RV + (4 * fq + tq) * RST + (16 * q + 4 * tp) * 2);
            f32x4 x = {0.f, 0.f, 0.f, 0.f}, y = {0.f, 0.f, 0.f, 0.f};
#pragma unroll
            for (int jp = 0; jp < 2; ++jp) {
                const int o = fr * RST + (32 * jp + 4 * fq) * 2;
                const bf16x8 tf = pack8(T[2 * jp], T[2 * jp + 1]);
                x = __builtin_amdgcn_mfma_f32_16x16x32_bf16(cat44(*(const LAS v2u*)(RA + o), *(const LAS v2u*)(RA + o + 32)), tf, x, 0, 0, 0);
                y = __builtin_amdgcn_mfma_f32_16x16x32_bf16(cat44(*(const LAS v2u*)(RR + o), *(const LAS v2u*)(RR + o + 32)), tf, y, 0, 0, 0);
            }
            x = __builtin_amdgcn_mfma_f32_16x16x32_bf16(akaA, Vf, x, 0, 0, 0);
            const f32x4 ut = __builtin_amdgcn_mfma_f32_16x16x32_bf16(tmA, pack4z(x), (f32x4){0.f, 0.f, 0.f, 0.f}, 0, 0, 0);
            y = __builtin_amdgcn_mfma_f32_16x16x32_bf16(abrA, pack4z(ut), y, 0, 0, 0);
            y = __builtin_amdgcn_mfma_f32_16x16x32_bf16(akrA, Vf, y, 0, 0, 0);
            bf16x8 UV; { const v4u vw = __builtin_bit_cast(v4u, Vf); v4u w; w.x = pk2(ut[0], ut[1]); w.y = pk2(ut[2], ut[3]); w.z = vw.x; w.w = vw.y; UV = __builtin_bit_cast(bf16x8, w); }
#pragma unroll
            for (int jb = 0; jb < 4; ++jb) {
                const int tro = (4 * fq + tq) * RST + (16 * jb + 4 * tp) * 2;
                const v2u bt = __builtin_bit_cast(v2u, __builtin_amdgcn_ds_read_tr16_b64_v4i16((LAS v4i16_t*)(RB + tro))), kt = __builtin_bit_cast(v2u, __builtin_amdgcn_ds_read_tr16_b64_v4i16((LAS v4i16_t*)(RK + tro)));
                const f32x4 gc = *(const LAS f32x4*)(GC + 16 * jb + 4 * fq);
                T[jb] = __builtin_amdgcn_mfma_f32_16x16x32_bf16(cat44(bt, kt), UV, T[jb], 0, 0, 0); T[jb] = T[jb] * gc;
            }
            ring_done(fl, s, lane);
#pragma unroll
            for (int e = 0; e < 4; ++e) yout[(size_t)scan_row16(c, 4 * fq + e, b, d) * 512 + fr] = (bf16)f2bf(y[e]);
        }
    }
}

constexpr int MST = 272, MIMG = 16 * MST;
constexpr int MB_NSLOT = 5;
constexpr int MB_SLOT = 21504;
__device__ __forceinline__ void mamba_block(Frame& F, int unit, const bf16* PM, const float* DT, const float* a_log, bf16* YMB) {
    const int d = unit & 1, h = (unit >> 1) & 7, b = unit >> 4, grp = h >> 2;
    const int lane = F.lane, fr = lane & 15, fq = lane >> 4, tq = (lane & 15) >> 2, tp = lane & 3;
    volatile LAS unsigned* fl = (volatile LAS unsigned*)(F.lds + RING_FLAGS);
    __syncthreads();
    if (F.tid < 16) fl[F.tid] = 0u;
    __syncthreads();
    if (F.wave >= 4) {
        const int p = F.wave - 4;
        const float a_neg = -__expf(a_log[d * 8 + h]);
        v4u rB[4], rC[4], rX[2]; float rdt;
#define MB_LOAD(c_) do { \
        _Pragma("unroll") for (int i = 0; i < 4; ++i) { const int t = (lane >> 4) + 4 * i; const bf16* src = PM + (size_t)scan_row16((c_), t, b, d) * 1024 + 512 + grp * 128 + (lane & 15) * 8; rB[i] = *(const GAS v4u*)src; rC[i] = *(const GAS v4u*)(src + 256); } \
        _Pragma("unroll") for (int i = 0; i < 2; ++i) { const int id = lane + 64 * i; rX[i] = *(const GAS v4u*)(PM + (size_t)scan_row16((c_), id >> 3, b, d) * 1024 + h * 64 + (id & 7) * 8); } \
        rdt = DT[(size_t)scan_row16((c_), lane & 15, b, d) * 16 + d * 8 + h]; } while (0)
        MB_LOAD(p);
        for (int c = p; c < NCH16; c += 4) {
            const int s = c % MB_NSLOT;
            LAS unsigned char* sb = F.lds + s * MB_SLOT;
            LAS unsigned char* BR = sb; LAS unsigned char* CR = sb + MIMG; LAS unsigned char* RT = sb + 2 * MIMG; LAS unsigned char* KH = sb + 3 * MIMG; LAS unsigned char* VX = sb + 4 * MIMG;
            LAS unsigned char* FRG = sb + 4 * MIMG + RIMG; LAS float* scal = (LAS float*)(sb + 4 * MIMG + RIMG + 1024);
            ring_wait_free(fl, s, c, MB_NSLOT);
            float cs = rdt * a_neg;
            cs += dpp_shr<1>(cs); cs += dpp_shr<2>(cs); cs += dpp_shr<4>(cs); cs += dpp_shr<8>(cs);
            const float cse = __int_as_float(__builtin_amdgcn_readlane(__float_as_int(cs), 15));
            if (lane < 16) { scal[16 + lane] = cs; scal[32 + lane] = __expf(cs); scal[48 + lane] = rdt; scal[64 + lane] = __expf(cse - cs); }
            if (lane == 0) scal[0] = __expf(cse);
            asm volatile("s_waitcnt lgkmcnt(0)" ::: "memory");
#pragma unroll
            for (int i = 0; i < 4; ++i) { const int t = (lane >> 4) + 4 * i; const float sk = scal[64 + t], sr = scal[32 + t]; const int o = t * MST + (lane & 15) * 16;
                *(LAS v4u*)(BR + o) = rB[i]; *(LAS v4u*)(CR + o) = rC[i]; *(LAS v4u*)(KH + o) = scale8(rB[i], sk); *(LAS v4u*)(RT + o) = scale8(rC[i], sr); }
#pragma unroll
            for (int i = 0; i < 2; ++i) { const int id = lane + 64 * i; const int t = id >> 3; *(LAS v4u*)(VX + t * RST + (id & 7) * 16) = scale8(rX[i], scal[48 + t]); }
            if (c + 4 < NCH16) MB_LOAD(c + 4);
            asm volatile("s_waitcnt lgkmcnt(0)" ::: "memory");
            f32x4 akr = {0.f, 0.f, 0.f, 0.f};
#pragma unroll
            for (int kb = 0; kb < 4; ++kb) akr = __builtin_amdgcn_mfma_f32_16x16x32_bf16(*(const LAS bf16x8*)(BR + fr * MST + kb * 64 + fq * 16), *(const LAS bf16x8*)(CR + fr * MST + kb * 64 + fq * 16), akr, 0, 0, 0);
            const float cst = scal[16 + fr]; const f32x4 css = *(const LAS f32x4*)(scal + 16 + 4 * fq);
#pragma unroll
            for (int e = 0; e < 4; ++e) akr[e] = (4 * fq + e <= fr) ? akr[e] * __expf(cst - css[e]) : 0.f;
            *(LAS bf16x8*)(FRG + lane * 16) = pack4z(akr);
            ring_set_full(fl, s, c, lane);
        }
#undef MB_LOAD
    } else {
        const int q = F.wave;
        bf16* yout = YMB + (size_t)d * M_ALL * 512 + h * 64 + 16 * q;
        f32x4 T[8];
#pragma unroll
        for (int jb = 0; jb < 8; ++jb) T[jb] = (f32x4){0.f, 0.f, 0.f, 0.f};
        for (int c = 0; c < NCH16; ++c) {
            const int s = c % MB_NSLOT;
            LAS unsigned char* sb = F.lds + s * MB_SLOT;
            LAS unsigned char* RT = sb + 2 * MIMG; LAS unsigned char* KH = sb + 3 * MIMG; LAS unsigned char* VX = sb + 4 * MIMG;
            LAS unsigned char* FRG = sb + 4 * MIMG + RIMG; LAS float* scal = (LAS float*)(sb + 4 * MIMG + RIMG + 1024);
            ring_wait_full(fl, s, c);
            const bf16x8 akrA = *(const LAS bf16x8*)(FRG + lane * 16); const float gC = scal[0];
            const bf16x8 Vf = tr4z(VX + (4 * fq + tq) * RST + (16 * q + 4 * tp) * 2);
            f32x4 y = {0.f, 0.f, 0.f, 0.f};
#pragma unroll
            for (int jp = 0; jp < 4; ++jp) {
                const LAS unsigned char* rp = RT + fr * MST + (32 * jp + 4 * fq) * 2;
                y = __builtin_amdgcn_mfma_f32_16x16x32_bf16(cat44(*(const LAS v2u*)rp, *(const LAS v2u*)(rp + 32)), pack8(T[2 * jp], T[2 * jp + 1]), y, 0, 0, 0);
            }
            y = __builtin_amdgcn_mfma_f32_16x16x32_bf16(akrA, Vf, y, 0, 0, 0);
#pragma unroll
            for (int jb = 0; jb < 8; ++jb) T[jb] = __builtin_amdgcn_mfma_f32_16x16x32_bf16(tr4z(KH + (4 * fq + tq) * MST + (16 * jb + 4 * tp) * 2), Vf, T[jb] * gC, 0, 0, 0);
            ring_done(fl, s, lane);
#pragma unroll
            for (int e = 0; e < 4; ++e) yout[(size_t)scan_row16(c, 4 * fq + e, b, d) * 512 + fr] = (bf16)f2bf(y[e]);
        }
    }
}

struct FinIn { const float *gn_w, *gn_b, *mb_d, *mb_norm_w; };
__device__ __forceinline__ void finish_phase(Frame& F, const FinIn& P, const bf16* YRW, const bf16* YMB, const bf16* PR, const bf16* PM, const float* BONUS, const bf16* GATE, const bf16* ZG, bf16* A) {
    const int gw = F.bid * NWAVES + F.wave, NGW = F.G * NWAVES; const int c0 = F.lane * 8, head = F.lane >> 3;
    float gnw[8], gnb[8], nw[8];
#pragma unroll
    for (int i = 0; i < 8; ++i) { gnw[i] = P.gn_w[c0 + i]; gnb[i] = P.gn_b[c0 + i]; nw[i] = P.mb_norm_w[c0 + i]; }
    const float dd = P.mb_d[head];
    for (int g = gw; g < M_ALL; g += NGW) {
        const size_t gs = (size_t)g;
        const v4u y0 = *(const GAS v4u*)(YRW + gs * 512 + c0), y1 = *(const GAS v4u*)(YRW + (size_t)M_ALL * 512 + gs * 512 + c0);
        const v4u vv = *(const GAS v4u*)(PR + gs * PRV + 512 + c0), gg = *(const GAS v4u*)(GATE + gs * 512 + c0);
        float y[8], vf[8], gf[8];
#pragma unroll
        for (int i = 0; i < 4; ++i) { y[2 * i] = bflo(y0[i]) + bflo(y1[i]); y[2 * i + 1] = bfhi(y0[i]) + bfhi(y1[i]); vf[2 * i] = bflo(vv[i]); vf[2 * i + 1] = bfhi(vv[i]); gf[2 * i] = bflo(gg[i]); gf[2 * i + 1] = bfhi(gg[i]); }
        float s = 0.f;
#pragma unroll
        for (int i = 0; i < 8; ++i) s += y[i];
        s += __shfl_xor(s, 1); s += __shfl_xor(s, 2); s += __shfl_xor(s, 4);
        const float mu = s * (1.f / 64.f); float q = 0.f;
#pragma unroll
        for (int i = 0; i < 8; ++i) { y[i] -= mu; q += y[i] * y[i]; }
        q += __shfl_xor(q, 1); q += __shfl_xor(q, 2); q += __shfl_xor(q, 4);
        const float rstd = rsqrtf(q * (1.f / 64.f) + 64e-5f); const float bon = BONUS[gs * 8 + head];
        float o[8];
#pragma unroll
        for (int i = 0; i < 8; ++i) o[i] = ((y[i] * rstd) * gnw[i] + gnb[i] + bon * vf[i]) * gf[i];
        v4u w; w.x = pk2(o[0], o[1]); w.y = pk2(o[2], o[3]); w.z = pk2(o[4], o[5]); w.w = pk2(o[6], o[7]);
        *(GAS v4u*)(A + gs * 1024 + c0) = w;
        const v4u m0 = *(const GAS v4u*)(YMB + gs * 512 + c0), m1 = *(const GAS v4u*)(YMB + (size_t)M_ALL * 512 + gs * 512 + c0);
        const v4u xx = *(const GAS v4u*)(PM + gs * 1024 + c0), zz = *(const GAS v4u*)(ZG + gs * 512 + c0);
        float ym[8]; float ss = 0.f;
#pragma unroll
        for (int i = 0; i < 4; ++i) {
            const float z0 = bflo(zz[i]), z1 = bfhi(zz[i]);
            ym[2 * i] = (bflo(m0[i]) + bflo(m1[i]) + dd * bflo(xx[i])) * (z0 * sigm(z0)); ym[2 * i + 1] = (bfhi(m0[i]) + bfhi(m1[i]) + dd * bfhi(xx[i])) * (z1 * sigm(z1));
            ss += ym[2 * i] * ym[2 * i] + ym[2 * i + 1] * ym[2 * i + 1];
        }
        ss += __shfl_xor(ss, 1); ss += __shfl_xor(ss, 2); ss += __shfl_xor(ss, 4); ss += __shfl_xor(ss, 8); ss += __shfl_xor(ss, 16);
        const float rr = rsqrtf(ss * (1.f / 256.f) + 1e-6f);
        v4u w2; w2.x = pk2(ym[0] * rr * nw[0], ym[1] * rr * nw[1]); w2.y = pk2(ym[2] * rr * nw[2], ym[3] * rr * nw[3]); w2.z = pk2(ym[4] * rr * nw[4], ym[5] * rr * nw[5]); w2.w = pk2(ym[6] * rr * nw[6], ym[7] * rr * nw[7]);
        *(GAS v4u*)(A + gs * 1024 + 512 + c0) = w2;
    }
}

__device__ __forceinline__ bf16x8 tr2(const LAS unsigned char* p0, const LAS unsigned char* p1) {
    const s16x4 t0 = __builtin_bit_cast(s16x4, __builtin_amdgcn_ds_read_tr16_b64_v4i16((LAS v4i16_t*)p0));
    const s16x4 t1 = __builtin_bit_cast(s16x4, __builtin_amdgcn_ds_read_tr16_b64_v4i16((LAS v4i16_t*)p1));
    bf16x8 r; r[0] = t0[0]; r[1] = t0[1]; r[2] = t0[2]; r[3] = t0[3]; r[4] = t1[0]; r[5] = t1[1]; r[6] = t1[2]; r[7] = t1[3]; return r;
}
constexpr int KST = 144;
__device__ __forceinline__ void attn_phase(Frame& F, const bf16* Q, const bf16* K, const bf16* V, const float* rpb, bf16* O) {
    LAS unsigned char* ctxK = F.lds; LAS unsigned char* ctxV = F.lds + 36864; LAS unsigned char* vst = F.lds + 73728 + F.wave * 4608; LAS float* rp = (LAS float*)(F.lds + 110592);
    const int lane = F.lane, fr = lane & 15, fq = lane >> 4, tq = (lane & 15) >> 2, tp = lane & 3;
#ifndef ATT_REPS
#define ATT_REPS 1
#endif
    for (int u_ = F.bid; u_ < 256 * ATT_REPS; u_ += F.G) {
        const int u = u_ & 255; const int bh = u >> 1, half = u & 1, b = bh >> 4, h = bh & 15;
        __syncthreads();
        {
            const int key = F.tid >> 1, hf = F.tid & 1; const size_t src = (size_t)(b * CTXL + key) * D + h * 64 + hf * 32;
#pragma unroll
            for (int i = 0; i < 4; ++i) { *(LAS v4u*)(ctxK + key * KST + hf * 64 + 16 * i) = *(const GAS v4u*)(K + src + 8 * i); *(LAS v4u*)(ctxV + key * KST + hf * 64 + 16 * i) = *(const GAS v4u*)(V + src + 8 * i); }
            if (F.tid < 465) rp[F.tid] = rpb[h * 465 + F.tid];
        }
        __syncthreads();
        for (int it = 0; it < 8; ++it) {
            const int r = 2 * (half * 8 + it) + (F.wave >> 2), j = F.wave & 3;
            const int rs = min(max(r - 4, 0), 24); const int kb = (j == 0) ? 0 : (j == 1) ? 8 : (j == 2) ? 24 : 32;
            const int qc = 16 * j + fr, wsq = min(max(qc - 8, 0), 48);
            const unsigned latbase = (unsigned)(M_CTX + b * SEQ);
            bf16x8 qf[2];
            { const bf16* qp = Q + (unsigned)((latbase + r * 64 + qc) * D + h * 64 + 8 * fq); qf[0] = *(const GAS bf16x8*)qp; qf[1] = *(const GAS bf16x8*)(qp + 32); }
            const int cv = kb + 4 * fq - wsq, cc2 = kb + 4 * fq - qc + 15;
            f32x4 sl[8][2], sc[16];
            const unsigned koff = (unsigned)((latbase + rs * 64 + kb + fr) * D + h * 64 + 8 * fq);
            const unsigned voff = (unsigned)((latbase + rs * 64 + kb + (lane >> 1)) * D + h * 64 + (lane & 1) * 32);
            bf16x8 kc[4], kn[4];
#pragma unroll
            for (int x = 0; x < 4; ++x) kc[x] = *(const GAS bf16x8*)(K + koff + (x >> 1) * 16 * D + (x & 1) * 32);
#pragma unroll
            for (int i = 0; i < 8; ++i) {
                const int brow = (rs + i - r + 7) * 31;
                if (i < 7) {
#pragma unroll
                    for (int x = 0; x < 4; ++x) kn[x] = *(const GAS bf16x8*)(K + koff + (unsigned)((i + 1) * 64 * D) + (x >> 1) * 16 * D + (x & 1) * 32);
                }
#pragma unroll
                for (int blk = 0; blk < 2; ++blk) {
                    f32x4 s = {0.f, 0.f, 0.f, 0.f};
                    s = __builtin_amdgcn_mfma_f32_16x16x32_bf16(kc[2 * blk], qf[0], s, 0, 0, 0);
                    s = __builtin_amdgcn_mfma_f32_16x16x32_bf16(kc[2 * blk + 1], qf[1], s, 0, 0, 0);
#pragma unroll
                    for (int e = 0; e < 4; ++e) s[e] = ((unsigned)(cv + 16 * blk + e) < 16u) ? (s[e] + rp[brow + min(max(cc2 + 16 * blk + e, 0), 30)]) : -INFINITY;
                    sl[i][blk] = s;
                }
#pragma unroll
                for (int x = 0; x < 4; ++x) kc[x] = kn[x];
            }
#pragma unroll
            for (int cb = 0; cb < 16; ++cb) {
                const LAS unsigned char* kp = ctxK + (16 * cb + fr) * KST + fq * 16;
                const bf16x8 k0 = *(const LAS bf16x8*)kp, k1 = *(const LAS bf16x8*)(kp + 64);
                f32x4 s = {0.f, 0.f, 0.f, 0.f};
                s = __builtin_amdgcn_mfma_f32_16x16x32_bf16(k0, qf[0], s, 0, 0, 0);
                s = __builtin_amdgcn_mfma_f32_16x16x32_bf16(k1, qf[1], s, 0, 0, 0);
                sc[cb] = s;
            }
            v4u vr[4];
#pragma unroll
            for (int x = 0; x < 4; ++x) vr[x] = *(const GAS v4u*)(V + voff + 8 * x);
            float m = -INFINITY;
#pragma unroll
            for (int i = 0; i < 8; ++i)
#pragma unroll
                for (int blk = 0; blk < 2; ++blk)
#pragma unroll
                    for (int e = 0; e < 4; ++e) m = fmaxf(m, sl[i][blk][e]);
#pragma unroll
            for (int cb = 0; cb < 16; ++cb)
#pragma unroll
                for (int e = 0; e < 4; ++e) m = fmaxf(m, sc[cb][e]);
            m = fmaxf(m, __shfl_xor(m, 16)); m = fmaxf(m, __shfl_xor(m, 32));
            float l = 0.f;
#pragma unroll
            for (int i = 0; i < 8; ++i)
#pragma unroll
                for (int blk = 0; blk < 2; ++blk)
#pragma unroll
                    for (int e = 0; e < 4; ++e) { const float p = __expf(sl[i][blk][e] - m); sl[i][blk][e] = p; l += p; }
#pragma unroll
            for (int cb = 0; cb < 16; ++cb)
#pragma unroll
                for (int e = 0; e < 4; ++e) { const float p = __expf(sc[cb][e] - m); sc[cb][e] = p; l += p; }
            l += __shfl_xor(l, 16); l += __shfl_xor(l, 32);
            const float linv = 1.f / l;
            f32x4 o[4];
#pragma unroll
            for (int db = 0; db < 4; ++db) o[db] = (f32x4){0.f, 0.f, 0.f, 0.f};
#pragma unroll
            for (int i = 0; i < 8; ++i) {
                { const int key = lane >> 1, hf = lane & 1;
#pragma unroll
                  for (int x = 0; x < 4; ++x) *(LAS v4u*)(vst + key * KST + hf * 64 + 16 * x) = vr[x]; }
                if (i < 7) {
#pragma unroll
                    for (int x = 0; x < 4; ++x) vr[x] = *(const GAS v4u*)(V + voff + (unsigned)((i + 1) * 64 * D) + 8 * x);
                }
                const bf16x8 pa = pack8(sl[i][0], sl[i][1]);
#pragma unroll
                for (int db = 0; db < 4; ++db) {
                    const LAS unsigned char* a0 = vst + (4 * fq + tq) * KST + (db * 16 + 4 * tp) * 2;
                    const bf16x8 vb = tr2(a0, a0 + 16 * KST);
                    o[db] = __builtin_amdgcn_mfma_f32_16x16x32_bf16(pa, vb, o[db], 0, 0, 0);
                }
            }
#pragma unroll
            for (int cc = 0; cc < 8; ++cc) {
                const bf16x8 pa = pack8(sc[2 * cc], sc[2 * cc + 1]);
#pragma unroll
                for (int db = 0; db < 4; ++db) {
                    const LAS unsigned char* a0 = ctxV + (32 * cc + 4 * fq + tq) * KST + (db * 16 + 4 * tp) * 2;
                    const bf16x8 vb = tr2(a0, a0 + 16 * KST);
                    o[db] = __builtin_amdgcn_mfma_f32_16x16x32_bf16(pa, vb, o[db], 0, 0, 0);
                }
            }
#pragma unroll
            for (int e = 0; e < 4; ++e) {
                const float li = __shfl(linv, 4 * fq + e);
                bf16* op = O + (unsigned)((b * SEQ + r * 64 + 16 * j + 4 * fq + e) * D + h * 64 + fr);
#pragma unroll
                for (int db = 0; db < 4; ++db) op[db * 16] = (bf16)f2bf(o[db][e] * li);
            }
        }
    }
}

__device__ __forceinline__ void router_phase(Frame& F, const float* hlat, const float* g, const float* mods_l, const float* router_w, const float* router_b, bf16* A4, unsigned* tokinfo, gu32* cnt) {
    const int gw = F.bid * NWAVES + F.wave, NGW = F.G * NWAVES;
    for (int r = gw; r < M_LAT; r += NGW) {
        const float* mp = mods_l + (r >> 11) * 6144;
        f32x4 a[4]; normmod_row(hlat + (size_t)r * D, g, mp + 3072, mp + 4096, A4 + (size_t)r * D, F.lane, a);
        float lg[8];
#pragma unroll
        for (int e = 0; e < 8; ++e) lg[e] = 0.f;
#pragma unroll
        for (int j = 0; j < 4; ++j)
#pragma unroll
            for (int x = 0; x < 4; ++x) { const float* rw = router_w + (size_t)((F.lane + 64 * j) * 4 + x) * 8; const f32x4 w0 = *(const GAS f32x4*)rw, w1 = *(const GAS f32x4*)(rw + 4); const float av = a[j][x];
#pragma unroll
                for (int e = 0; e < 4; ++e) { lg[e] += av * w0[e]; lg[4 + e] += av * w1[e]; } }
#pragma unroll
        for (int e = 0; e < 8; ++e) lg[e] = wave_sum(lg[e]) + router_b[e];
        int e0 = 0; float v0 = lg[0];
#pragma unroll
        for (int e = 1; e < 8; ++e) if (lg[e] > v0) { v0 = lg[e]; e0 = e; }
        int e1 = -1; float v1 = -INFINITY;
#pragma unroll
        for (int e = 0; e < 8; ++e) if (e != e0 && lg[e] > v1) { v1 = lg[e]; e1 = e; }
        const float g0 = 1.f / (1.f + __expf(v1 - v0)), g1 = 1.f - g0;
        if (F.lane == 0) {
            const unsigned p0 = __hip_atomic_fetch_add(cnt + 64 * e0, 1u, RLX_AGENT), p1 = __hip_atomic_fetch_add(cnt + 64 * e1, 1u, RLX_AGENT);
            v4u t0; t0.x = (unsigned)e0; t0.y = p0; t0.z = __float_as_uint(g0); t0.w = (unsigned)e1;
            v4u t1; t1.x = p1; t1.y = __float_as_uint(g1); t1.z = 0u; t1.w = 0u;
            *(GAS v4u*)(tokinfo + (size_t)r * 8) = t0; *(GAS v4u*)(tokinfo + (size_t)r * 8 + 4) = t1;
        }
    }
}
__device__ __forceinline__ void moe_bases(gu32* cnt, int (&tb)[9]) {
    int acc = 0;
#pragma unroll
    for (int e = 0; e < 8; ++e) { tb[e] = acc; const unsigned c = __hip_atomic_load(cnt + 64 * e, RLX_AGENT); acc += (int)((c + 255u) >> 8); }
    tb[8] = acc;
}
#ifndef MOE_TAIL_SPLIT
#define MOE_TAIL_SPLIT 1
#endif
__device__ __forceinline__ void moe_tail_split(const int (&tb)[9], int G, int& first, int& ntail) {
    const int U = tb[8] * 4; first = (U / G) * G; ntail = U - first;
    if (first == 0 || (first & 3) || ntail > 32) { first = U; ntail = 0; }
#if !MOE_TAIL_SPLIT
    first = U; ntail = 0;
#endif
}
__device__ __forceinline__ void gather_phase(Frame& F, const bf16* A4, unsigned* tokinfo, gu32* cnt, bf16* XG) {
    int tb[9]; moe_bases(cnt, tb);
    const int gw = F.bid * NWAVES + F.wave, NGW = F.G * NWAVES;
    for (int r = gw; r < M_LAT; r += NGW) {
        const v4u t0 = *(const GAS v4u*)(tokinfo + (size_t)r * 8), t1 = *(const GAS v4u*)(tokinfo + (size_t)r * 8 + 4);
        int tbe0 = 0, tbe1 = 0;
#pragma unroll
        for (int e = 0; e < 8; ++e) { if ((int)t0.x == e) tbe0 = tb[e]; if ((int)t0.w == e) tbe1 = tb[e]; }
        const unsigned row0 = (unsigned)tbe0 * 256u + t0.y, row1 = (unsigned)tbe1 * 256u + t1.x;
        const GAS v4u* src = (const GAS v4u*)(A4 + (size_t)r * D);
        const v4u x0 = src[F.lane], x1 = src[F.lane + 64];
        GAS v4u* d0 = (GAS v4u*)(XG + (size_t)row0 * D); GAS v4u* d1 = (GAS v4u*)(XG + (size_t)row1 * D);
        d0[F.lane] = x0; d0[F.lane + 64] = x1; d1[F.lane] = x0; d1[F.lane + 64] = x1;
        if (F.lane == 0) { tokinfo[(size_t)r * 8 + 6] = row0; tokinfo[(size_t)r * 8 + 7] = row1; }
    }
}
__device__ __forceinline__ f32x4 moe_y4(const bf16* YG, const float* slab, unsigned row, int j, int lane, unsigned tailrow0, int first, int ntail) {
    if (row < tailrow0) { const v2u a = ((const GAS v2u*)(YG + (size_t)row * D) + lane)[64 * j]; return (f32x4){bflo(a.x), bfhi(a.x), bflo(a.y), bfhi(a.y)}; }
    const size_t kstride = (size_t)(ntail >> 2) * 256 * 1024; const float* p = slab + (size_t)(row - tailrow0) * 1024 + (lane + 64 * j) * 4; f32x4 s = {0.f, 0.f, 0.f, 0.f};
    for (int ks = 0; ks < 11; ++ks) s += *(const GAS f32x4*)(p + ks * kstride);
    const unsigned w0 = pk2(s[0], s[1]), w1 = pk2(s[2], s[3]);
    return (f32x4){bflo(w0), bfhi(w0), bflo(w1), bfhi(w1)};
}
__device__ __forceinline__ void final_phase(Frame& F, float* hout, const bf16* YG, const unsigned* tokinfo, const float* mods_l, const float* norm_final, const float* slab, gu32* cnt) {
    const int gw = F.bid * NWAVES + F.wave, NGW = F.G * NWAVES;
    int tb[9]; moe_bases(cnt, tb); int first, ntail; moe_tail_split(tb, F.G, first, ntail); const unsigned tailrow0 = (unsigned)(first >> 2) * 256u;
    for (int r = gw; r < M_LAT; r += NGW) {
        const v4u t0 = *(const GAS v4u*)(tokinfo + (size_t)r * 8), t1 = *(const GAS v4u*)(tokinfo + (size_t)r * 8 + 4);
        const float g0 = __uint_as_float(t0.z), g1 = __uint_as_float(t1.y); const unsigned row0 = t1.z, row1 = t1.w;
        const float* mp = mods_l + (r >> 11) * 6144 + 5120;
        GAS f32x4* hr = (GAS f32x4*)(hout + (size_t)r * D) + F.lane;
        f32x4 v[4]; float ss = 0.f;
#pragma unroll
        for (int j = 0; j < 4; ++j) {
            const f32x4 hh = hr[64 * j], mm = ((const GAS f32x4*)mp)[F.lane + 64 * j];
            const f32x4 ya = moe_y4(YG, slab, row0, j, F.lane, tailrow0, first, ntail), yb = moe_y4(YG, slab, row1, j, F.lane, tailrow0, first, ntail);
            v[j] = hh + mm * (ya * g0 + yb * g1);
            ss += (v[j].x * v[j].x + v[j].y * v[j].y) + (v[j].z * v[j].z + v[j].w * v[j].w);
        }
        const float rs = rsqrtf(wave_sum(ss) * (1.f / 1024.f) + 1e-6f);
#pragma unroll
        for (int j = 0; j < 4; ++j) { const f32x4 gg = ((const GAS f32x4*)norm_final)[F.lane + 64 * j]; hr[64 * j] = (v[j] * rs) * gg; }
    }
}

constexpr int NPHASE = 19;
#ifndef MK_PER_PHASE
#define MK_PER_PHASE 0
#endif
__device__ __forceinline__ int fresh_lane() { int l; asm volatile("v_mbcnt_lo_u32_b32 %0, -1, 0\n\tv_mbcnt_hi_u32_b32 %0, -1, %0" : "=v"(l)); return l; }
struct Args { const float* in[39]; float* out; unsigned char* ws; int ph_lo, ph_hi; };
#define KARGP(k) (((void* const __attribute__((address_space(4)))*)__builtin_amdgcn_kernarg_segment_ptr())[k])
#define KARG(k) ((const float*)KARGP(k))
__global__ void __launch_bounds__(NWAVES * 64, 2) mk_fwd(Args args) {
    extern __shared__ __attribute__((aligned(16))) unsigned char lds[];
    Frame F;
    F.lds = (LAS unsigned char*)lds; F.MISC = (volatile LAS unsigned*)(F.lds + MISC_OFF);
    F.tid = threadIdx.x; F.lane = F.tid & 63; F.wave = __builtin_amdgcn_readfirstlane(F.tid >> 6); F.G = gridDim.x; F.bid = blockIdx.x;
    unsigned char* ws = (unsigned char*)KARGP(40); F.ctl = (gu32*)(ws + WS_CTL);
    for (int u = F.tid; u < (LDS_BYTES - LDSCTL_OFF) / 4; u += NWAVES * 64) ((LAS unsigned*)(F.lds + LDSCTL_OFF))[u] = 0u;
    __syncthreads();
    const int lo = args.ph_lo, hi = args.ph_hi;
    XcdBarrier bar; bar.bar = (unsigned*)(F.ctl + CW_BAR); bar.x = 0; bar.st = nullptr;
    if (hi - lo > 1) bar = xcd_barrier_post((unsigned*)(F.ctl + CW_BAR), F.MISC + 8);
#ifdef PH_MASK
#define IN(k) ((((PH_MASK) >> (k)) & 1) && lo <= (k) && (k) < hi)
#else
#define IN(k) (lo <= (k) && (k) < hi)
#endif
#ifndef DUP_MASK
#define DUP_MASK 0
#endif
#define REPS(k) (1 + (((DUP_MASK) >> (k)) & 1))
#ifdef DOUBLE_BAR
#define SEAM(k) do { if (IN(k) && IN((k) + 1)) { xcd_barrier(bar); xcd_barrier(bar); } } while (0)
#else
#define SEAM(k) do { if (IN(k) && IN((k) + 1)) xcd_barrier(bar); } while (0)
#endif
    const float* x = KARG(0); const float* ctx = KARG(2);
    float* mods = (float*)(ws + WS_MODS); float* hctx = (float*)(ws + WS_HCTX); float* hlat = (float*)KARGP(39);
    bf16* A = (bf16*)(ws + WS_A);
    const int vcu = (F.G % 8 == 0) ? (F.bid % 8) * (F.G / 8) + F.bid / 8 : F.bid;

    if (IN(0)) for (int rep_ = 0; rep_ < REPS(0); ++rep_) { if (rep_) __syncthreads(); F.lane = fresh_lane(); F.tid = F.wave * 64 + F.lane; p0_phase(F, KARG(1), KARG(3), KARG(4), KARG(5), mods, KARG(9), KARG(10), KARG(28), KARG(29), KARG(30), KARG(31), KARG(32), ws); }
    SEAM(0);
    if (IN(1)) for (int rep_ = 0; rep_ < REPS(1); ++rep_) { if (rep_) __syncthreads(); F.lane = fresh_lane(); F.tid = F.wave * 64 + F.lane; normmod_phase(F, ctx, x, KARG(6), mods, 0, 1024, A); }
    SEAM(1);
    if (IN(2)) for (int rep_ = 0; rep_ < REPS(2); ++rep_) { if (rep_) __syncthreads(); F.lane = fresh_lane(); F.tid = F.wave * 64 + F.lane;
        pg8::Gemm g{A, (const bf16*)(ws + WS_WIN_T), M_ALL, ZLD, D}; pg8::StaticOrder S; S.init(M_ALL, ZLD, F.G, F.bid);
        pg8::EpiBf16<0> E{(bf16*)(ws + WS_Z), ZLD, nullptr, 0, 0, 1.f};
        pg8::gemm_phase<pg8::EpiBf16<0>, pg8::StaticOrder, true, true>(F.lds, g, S, E);
    }
    SEAM(2);
    if (IN(3)) for (int rep_ = 0; rep_ < REPS(3); ++rep_) { if (rep_) __syncthreads(); F.lane = fresh_lane(); F.tid = F.wave * 64 + F.lane;
        PrepIn P{KARG(11), KARG(12), KARG(13), KARG(14), KARG(15), KARG(16), KARG(17), KARG(18), KARG(19), KARG(22), KARG(23), KARG(24)};
        prepare_phase(F, P, (const bf16*)(ws + WS_Z), (bf16*)(ws + WS_PR), (bf16*)(ws + WS_PM), (float*)(ws + WS_DT), (float*)(ws + WS_BONUS), (bf16*)(ws + WS_GATE), (bf16*)(ws + WS_ZG));
    }
    SEAM(3);
    if (IN(4)) for (int rep_ = 0; rep_ < REPS(4); ++rep_) { if (rep_) __syncthreads(); F.lane = fresh_lane(); F.tid = F.wave * 64 + F.lane;
        for (int u = F.bid; u < 256; u += F.G) {
            if (u < 128) rwkv_block(F, u, (const bf16*)(ws + WS_PR), (bf16*)(ws + WS_YRW));
            else mamba_block(F, u - 128, (const bf16*)(ws + WS_PM), (const float*)(ws + WS_DT), KARG(25), (bf16*)(ws + WS_YMB));
        }
    }
    SEAM(4);
    if (IN(5)) for (int rep_ = 0; rep_ < REPS(5); ++rep_) { if (rep_) __syncthreads(); F.lane = fresh_lane(); F.tid = F.wave * 64 + F.lane;
        FinIn P{KARG(20), KARG(21), KARG(26), KARG(27)};
        finish_phase(F, P, (const bf16*)(ws + WS_YRW), (const bf16*)(ws + WS_YMB), (const bf16*)(ws + WS_PR), (const bf16*)(ws + WS_PM), (const float*)(ws + WS_BONUS), (const bf16*)(ws + WS_GATE), (const bf16*)(ws + WS_ZG), A);
    }
    SEAM(5);
    if (IN(6)) for (int rep_ = 0; rep_ < REPS(6); ++rep_) { if (rep_) __syncthreads(); F.lane = fresh_lane(); F.tid = F.wave * 64 + F.lane;
        {
            pg8::Gemm g{A + (size_t)M_CTX * D, (const bf16*)(ws + WS_WOUT_T), M_LAT, D, D}; pg8::StaticOrder S; S.init(M_LAT, D, F.G, F.bid);
            pg8::EpiResGate E{x, x, hlat, hlat, mods, 2048, 0};
            pg8::gemm_phase<pg8::EpiResGate, pg8::StaticOrder, true, true>(F.lds, g, S, E);
        }
        {
            pg8::Gemm g{A, (const bf16*)(ws + WS_WOUT_T), M_CTX, D, 256, D}; pg8::SplitKOrder S{8, 4, 4, 256, F.G, F.bid};
            pg8::EpiSlabGate E{(float*)(ws + WS_SLAB6), mods + 8 * 6144 + 2048, 256};
            pg8::gemm_phase<pg8::EpiSlabGate, pg8::SplitKOrder, true, true>(F.lds, g, S, E);
        }
        { const int nsub = 8 * 4 * 4; if (F.G > nsub && F.bid >= nsub) moe_weight_phase(F, KARG(36), KARG(37), KARG(38), ws, 0, MOE_ITEMS_P6, F.bid - nsub, F.G - nsub);
          else if (F.G <= nsub) moe_weight_phase(F, KARG(36), KARG(37), KARG(38), ws, 0, MOE_ITEMS_P6, F.bid, F.G); }
    }
    SEAM(6);
    if (IN(7)) for (int rep_ = 0; rep_ < REPS(7); ++rep_) { if (rep_) __syncthreads(); F.lane = fresh_lane(); F.tid = F.wave * 64 + F.lane; normmod_phase(F, ctx, hlat, KARG(7), mods, 3072, 4096, A, (const float*)(ws + WS_SLAB6), 4, hctx); moe_weight_phase(F, KARG(36), KARG(37), KARG(38), ws, MOE_ITEMS_P6, MOE_ITEMS_P7, F.bid, F.G); }
    SEAM(7);
    if (IN(8)) for (int rep_ = 0; rep_ < REPS(8); ++rep_) { if (rep_) __syncthreads(); F.lane = fresh_lane(); F.tid = F.wave * 64 + F.lane;
        pg8::Gemm g{A, (const bf16*)(ws + WS_W13_T), M_ALL, 2 * FF, D}; pg8::StaticOrder S; S.init(M_ALL, 2 * FF, F.G, F.bid);
        pg8::EpiSwiGLU E{(bf16*)(ws + WS_HID), FF, 1 << 20};
        pg8::gemm_phase<pg8::EpiSwiGLU, pg8::StaticOrder, true, true>(F.lds, g, S, E);
        {
            const int nfull = ((M_ALL / 256) * (2 * FF / 256)) % F.G;
            if (nfull != 0 && F.bid >= nfull) moe_weight_phase(F, KARG(36), KARG(37), KARG(38), ws, MOE_ITEMS_P7, MOE_ITEMS_P7 + MOE_ITEMS_P8, F.bid - nfull, F.G - nfull);
            else if (nfull == 0) moe_weight_phase(F, KARG(36), KARG(37), KARG(38), ws, MOE_ITEMS_P7, MOE_ITEMS_P7 + MOE_ITEMS_P8, F.bid, F.G);
        }
    }
    SEAM(8);
    if (IN(9)) for (int rep_ = 0; rep_ < REPS(9); ++rep_) { if (rep_) __syncthreads(); F.lane = fresh_lane(); F.tid = F.wave * 64 + F.lane;
        {
            pg8::Gemm g{(const bf16*)(ws + WS_HID) + (size_t)M_CTX * FF, (const bf16*)(ws + WS_W2_T), M_LAT, D, FF}; pg8::StaticOrder S; S.init(M_LAT, D, F.G, F.bid);
            pg8::EpiResGate E{hlat, hlat, hlat, hlat, mods, 5120, 0};
            pg8::gemm_phase<pg8::EpiResGate, pg8::StaticOrder, true, true>(F.lds, g, S, E);
        }
        {
            pg8::Gemm g{(const bf16*)(ws + WS_HID), (const bf16*)(ws + WS_W2_T), M_CTX, D, 1408, FF}; pg8::SplitKOrder S{8, 4, 2, 1408, F.G, F.bid};
            pg8::EpiSlabGate E{(float*)(ws + WS_SLAB9), mods + 8 * 6144 + 5120, 1408};
            pg8::gemm_phase<pg8::EpiSlabGate, pg8::SplitKOrder, true, true>(F.lds, g, S, E);
        }
        {
            const int nsub = 8 * 4 * 2;
            if (F.G > nsub) { if (F.bid >= nsub) moe_weight_phase(F, KARG(36), KARG(37), KARG(38), ws, MOE_ITEMS_P7 + MOE_ITEMS_P8, MOE_ITEMS_P7 + MOE_ITEMS_P8 + MOE_ITEMS_P9, F.bid - nsub, F.G - nsub); }
            else moe_weight_phase(F, KARG(36), KARG(37), KARG(38), ws, MOE_ITEMS_P7 + MOE_ITEMS_P8, MOE_ITEMS_P7 + MOE_ITEMS_P8 + MOE_ITEMS_P9, F.bid, F.G);
        }
    }
    SEAM(9);
    const float* mods1 = mods + 9 * 6144;
    if (IN(10)) for (int rep_ = 0; rep_ < REPS(10); ++rep_) { if (rep_) __syncthreads(); F.lane = fresh_lane(); F.tid = F.wave * 64 + F.lane; normmod_phase(F, hctx, hlat, KARG(6) + D, mods1, 0, 1024, A, (const float*)(ws + WS_SLAB9), 2); }
    SEAM(10);
    if (IN(11)) for (int rep_ = 0; rep_ < REPS(11); ++rep_) { if (rep_) __syncthreads(); F.lane = fresh_lane(); F.tid = F.wave * 64 + F.lane;
        pg8::Gemm g{A, (const bf16*)(ws + WS_QKV_T), M_ALL, 3 * D, D}; pg8::StaticOrder S; S.init(M_ALL, 3 * D, F.G, F.bid);
        pg8::EpiBf16<0> E{(bf16*)(ws + WS_Q), D, nullptr, D, (size_t)M_ALL * D, 0.125f};
        pg8::gemm_phase<pg8::EpiBf16<0>, pg8::StaticOrder, true, true>(F.lds, g, S, E);
        {
            const int nfull = ((M_ALL / 256) * (3 * D / 256)) % F.G;
            if (nfull != 0 && F.bid >= nfull) moe_weight_phase(F, KARG(36), KARG(37), KARG(38), ws, MOE_ITEMS - MOE_ITEMS_P11, MOE_ITEMS, F.bid - nfull, F.G - nfull);
            else if (nfull == 0) moe_weight_phase(F, KARG(36), KARG(37), KARG(38), ws, MOE_ITEMS - MOE_ITEMS_P11, MOE_ITEMS, F.bid, F.G);
        }
    }
    SEAM(11);
    if (IN(12)) for (int rep_ = 0; rep_ < REPS(12); ++rep_) { if (rep_) __syncthreads(); F.lane = fresh_lane(); F.tid = F.wave * 64 + F.lane; attn_phase(F, (const bf16*)(ws + WS_Q), (const bf16*)(ws + WS_K), (const bf16*)(ws + WS_V), KARG(33), (bf16*)(ws + WS_O)); }
    SEAM(12);
    if (IN(13)) for (int rep_ = 0; rep_ < REPS(13); ++rep_) { if (rep_) __syncthreads(); F.lane = fresh_lane(); F.tid = F.wave * 64 + F.lane;
        pg8::Gemm g{(const bf16*)(ws + WS_O), (const bf16*)(ws + WS_NAO_T), M_LAT, D, D}; pg8::StaticOrder S; S.init(M_LAT, D, F.G, F.bid);
        pg8::EpiResGate E{hlat, hlat, hlat, hlat, mods1, 2048, 0};
        pg8::gemm_phase<pg8::EpiResGate, pg8::StaticOrder, true, true>(F.lds, g, S, E);
    }
    SEAM(13);
    if (IN(14)) for (int rep_ = 0; rep_ < REPS(14); ++rep_) { if (rep_) __syncthreads(); F.lane = fresh_lane(); F.tid = F.wave * 64 + F.lane; router_phase(F, hlat, KARG(7) + D, mods1, KARG(34), KARG(35), (bf16*)(ws + WS_A4), (unsigned*)(ws + WS_TOK), F.ctl + CW_CNT); }
    SEAM(14);
    if (IN(15)) for (int rep_ = 0; rep_ < REPS(15); ++rep_) { if (rep_) __syncthreads(); F.lane = fresh_lane(); F.tid = F.wave * 64 + F.lane; gather_phase(F, (const bf16*)(ws + WS_A4), (unsigned*)(ws + WS_TOK), F.ctl + CW_CNT, (bf16*)(ws + WS_XG)); }
    SEAM(15);
    if (IN(16)) for (int rep_ = 0; rep_ < REPS(16); ++rep_) { if (rep_) __syncthreads(); F.lane = fresh_lane(); F.tid = F.wave * 64 + F.lane;
        pg8::MoeOrder S; moe_bases(F.ctl + CW_CNT, S.tb); S.ntn = 22; S.G = F.G; S.c = vcu;
        pg8::Gemm g{(const bf16*)(ws + WS_XG), (const bf16*)(ws + WS_MOEW13), MOE_ROWS, NE * 2 * FF, D};
        pg8::EpiSwiGLU E{(bf16*)(ws + WS_HIDG), FF, 22};
        pg8::gemm_phase<pg8::EpiSwiGLU, pg8::MoeOrder, true, true>(F.lds, g, S, E);
    }
    SEAM(16);
    if (IN(17)) for (int rep_ = 0; rep_ < REPS(17); ++rep_) { if (rep_) __syncthreads(); F.lane = fresh_lane(); F.tid = F.wave * 64 + F.lane;
        pg8::MoeOrder S; moe_bases(F.ctl + CW_CNT, S.tb); S.ntn = 4; S.G = F.G; S.c = vcu;
        int first, ntail; moe_tail_split(S.tb, F.G, first, ntail); S.limit = first;
        {
            pg8::Gemm g{(const bf16*)(ws + WS_HIDG), (const bf16*)(ws + WS_MOEW2), MOE_ROWS, NE * D, FF};
            pg8::EpiPlainMod E{(bf16*)(ws + WS_YG), D, 4};
            pg8::gemm_phase<pg8::EpiPlainMod, pg8::MoeOrder, true, true>(F.lds, g, S, E);
        }
#if MOE_TAIL_SPLIT
        if (ntail > 0) {
            pg8::MoeTailOrder ST;
#pragma unroll
            for (int k = 0; k < 9; ++k) ST.tb[k] = S.tb[k];
            ST.first = first; ST.ntail = ntail; ST.G = F.G; ST.c = vcu;
            pg8::Gemm g{(const bf16*)(ws + WS_HIDG), (const bf16*)(ws + WS_MOEW2), MOE_ROWS, NE * D, 256, FF};
            pg8::EpiTailSlab E{(float*)(ws + WS_TAIL), first, ntail};
            pg8::gemm_phase<pg8::EpiTailSlab, pg8::MoeTailOrder, true, true>(F.lds, g, ST, E);
        }
#endif
    }
    SEAM(17);
    if (IN(18)) for (int rep_ = 0; rep_ < REPS(18); ++rep_) { if (rep_) __syncthreads(); F.lane = fresh_lane(); F.tid = F.wave * 64 + F.lane; final_phase(F, hlat, (const bf16*)(ws + WS_YG), (const unsigned*)(ws + WS_TOK), mods1, KARG(8), (const float*)(ws + WS_TAIL), F.ctl + CW_CNT); }
#undef IN
#undef SEAM
}

extern "C" void kernel_launch(void* const* d_in, const int* in_sizes, int n_in, void* d_out, int out_size, void* d_ws, size_t ws_size, hipStream_t stream) {
    static int grid = 0;
    if (grid == 0) {
        if (n_in != 39 || out_size != M_LAT * D || ws_size < WS_END) { fprintf(stderr, "kernel_launch: unexpected shapes (n_in %d, out %d, ws %zu)\n", n_in, out_size, ws_size); grid = -1; return; }
        int dev = 0, cus = 0, per_cu = 0;
        if (hipGetDevice(&dev) != hipSuccess || hipDeviceGetAttribute(&cus, hipDeviceAttributeMultiprocessorCount, dev) != hipSuccess) { grid = -1; return; }
        if (hipFuncSetAttribute((const void*)mk_fwd, hipFuncAttributeMaxDynamicSharedMemorySize, LDS_BYTES) != hipSuccess) { fprintf(stderr, "kernel_launch: hipFuncSetAttribute failed\n"); grid = -1; return; }
        if (hipOccupancyMaxActiveBlocksPerMultiprocessor(&per_cu, (const void*)mk_fwd, NWAVES * 64, LDS_BYTES) != hipSuccess || per_cu < 1) fprintf(stderr, "kernel_launch: occupancy query says %d\n", per_cu);
        (void)hipGetLastError();
        grid = cus;
    }
    if (grid < 0) return;
    if (hipMemsetAsync((char*)d_ws + WS_CTL, 0, CTL_ZERO_BYTES, stream) != hipSuccess) return;
    Args a{};
    for (int i = 0; i < 39; ++i) a.in[i] = (const float*)d_in[i];
    a.out = (float*)d_out; a.ws = (unsigned char*)d_ws;
#if MK_PER_PHASE
    for (int p = 0; p < NPHASE; ++p) { a.ph_lo = p; a.ph_hi = p + 1; hipLaunchKernelGGL(mk_fwd, dim3(grid), dim3(NWAVES * 64), LDS_BYTES, stream, a); }
#else
    a.ph_lo = 0; a.ph_hi = NPHASE; hipLaunchKernelGGL(mk_fwd, dim3(grid), dim3(NWAVES * 64), LDS_BYTES, stream, a);
#endif
}
```

```cpp
#include <hip/hip_runtime.h>
#include <cstdio>
#include <cstdint>
#include <cmath>
#define MK_PER_PHASE 0
namespace pg8 {
#define PG8_LAS __attribute__((address_space(3)))
typedef unsigned short bf16_t;
typedef short bf16x8 __attribute__((ext_vector_type(8)));
typedef float f32x4 __attribute__((ext_vector_type(4)));
typedef unsigned u32x4 __attribute__((ext_vector_type(4)));
constexpr int BM = 256, BK = 64, HALF = 128, HTB = HALF * BK * 2  , STAGE_BYTES = 8 * HTB, NXCD = 8, WGM = 8;

__host__ __device__ __forceinline__ int lds_byte(int r, int c) { const int st = (r >> 4) * 2 + (c >> 5), rr = r & 15, cc = c & 31, ob = rr * 64 + cc * 2; return st * 1024 + (ob ^ (((ob >> 9) & 1) << 5)); }
__host__ __device__ __forceinline__ void stage_rc(int b, int& R, int& C) { const int st = b / 1024, sb = b % 1024, swz = sb ^ (((sb >> 9) & 1) << 5); R = (st >> 1) * 16 + swz / 64; C = (st & 1) * 32 + (swz % 64) / 2; }
__host__ __device__ __forceinline__ int perm32(int rho) { const int n = rho >> 4, i = rho & 15; return 8 * (i >> 2) + 4 * n + (i & 3); }

#ifndef PG8_WT
#define PG8_WT 0
#endif
#if PG8_WT
#define PG8_ST16(base_, ptr_, v_) __builtin_amdgcn_raw_buffer_store_b128((v_), __builtin_amdgcn_make_buffer_rsrc((void*)(base_), (short)0, 0x7fffffff, 0x00020000), (int)((const char*)(ptr_) - (const char*)(base_)), 0, 16)
#else
#define PG8_ST16(base_, ptr_, v_) (*(u32x4*)(ptr_) = (v_))
#endif
struct Unit { int pm, pn; int k0 = 0; };
struct Gemm { const bf16_t* A; const bf16_t* Bt; int M, N, K; int ld = 0; };

struct StaticOrder {
    int nM, nN, nwg, G, c;
    __host__ __device__ void init(int M, int N, int G_, int c_) { nM = M / BM; nN = N / BM; nwg = nM * nN; G = G_; c = c_; }
    __host__ __device__ bool next(int i, Unit& u) const {
        const long L = (long)i * G + c; if (L >= nwg) return false;
        int wgid = (int)L; { const int q = nwg / NXCD, r = nwg % NXCD, xcd = wgid % NXCD, off = wgid / NXCD; wgid = (xcd < r ? xcd * (q + 1) : r * (q + 1) + (xcd - r) * q) + off; }
        const int nig = WGM * nN, gid = wgid / nig, fm = gid * WGM, gsz = (nM - fm) < WGM ? (nM - fm) : WGM;
        u.pm = fm + ((wgid % nig) % gsz); u.pn = (wgid % nig) / gsz; return true;
    }
    __device__ __forceinline__ void a_ready(const Unit&) const {}
    __device__ __forceinline__ void done(const Unit&) const {}
};

__device__ __forceinline__ unsigned cvt_pk_bf16(float lo, float hi) { unsigned r; asm volatile("v_cvt_pk_bf16_f32 %0, %1, %2" : "=v"(r) : "v"(lo), "v"(hi)); return r; }
typedef float f32x2 __attribute__((ext_vector_type(2)));
__device__ __forceinline__ f32x2 gelu_pk(f32x2 v) {
    const f32x2 av = __builtin_elementwise_abs(v), d = av * 0.2316418882f + 1.0f;
    f32x2 t; t.x = __builtin_amdgcn_rcpf(d.x); t.y = __builtin_amdgcn_rcpf(d.y);
    f32x2 q = t * 0.5307027145f + (-0.7265760135f); q = q * t + 0.7107068705f; q = q * t + (-0.142248368f); q = q * t + 0.127414796f; q = q * t;
    const f32x2 s = (v * v) * (-0.72134752044f);
    f32x2 e; e.x = __builtin_amdgcn_exp2f(s.x); e.y = __builtin_amdgcn_exp2f(s.y);
    const f32x2 m = v * (q * e), r = v - m;
    f32x2 o; o.x = v.x < 0.f ? m.x : r.x; o.y = v.y < 0.f ? m.y : r.y; return o;
}

template <int ACT  > struct EpiBf16 {
    static constexpr bool PERM = true, AFTER_DRAIN = false; static_assert(ACT == 0 || ACT == 1, "EpiBf16: ACT is 0 (none) or 1 (gelu_pk)");
    bf16_t* O; int ldc; const float* bias; int split_cols; size_t split_stride; float scale0;
    __device__ __forceinline__ void operator()(const f32x4 (&acc)[2][2][4][2], const Unit& u, int wr, int wc, int fr, int fq) const {
        const int row0 = u.pm * BM + wr * 64 + fr; int colt = u.pn * BM; bf16_t* base = O;
        float sc = 1.f; if (split_cols) { const int t = colt / split_cols; base += (size_t)t * split_stride; colt -= t * split_cols; if (t == 0) sc = scale0; }
        const int col0 = colt + wc * 32 + 8 * fq, bcol0 = u.pn * BM + wc * 32 + 8 * fq;
        f32x4 bv[2][2];
#pragma unroll
        for (int bj = 0; bj < 2; ++bj)
#pragma unroll
            for (int n = 0; n < 2; ++n) bv[bj][n] = bias ? *(const f32x4*)(bias + bcol0 + bj * HALF + 4 * n) : (f32x4){0.f, 0.f, 0.f, 0.f};
#pragma unroll
        for (int ai = 0; ai < 2; ++ai)
#pragma unroll
            for (int m = 0; m < 4; ++m) { bf16_t* rowp = base + (size_t)(row0 + ai * HALF + m * 16) * ldc + col0;
#pragma unroll
                for (int bj = 0; bj < 2; ++bj) { f32x4 v0 = acc[ai][bj][m][0] + bv[bj][0], v1 = acc[ai][bj][m][1] + bv[bj][1];
                    if (ACT == 1) { f32x2 a = gelu_pk((f32x2){v0[0], v0[1]}), b = gelu_pk((f32x2){v0[2], v0[3]}), c = gelu_pk((f32x2){v1[0], v1[1]}), d = gelu_pk((f32x2){v1[2], v1[3]});
                        v0 = (f32x4){a.x, a.y, b.x, b.y}; v1 = (f32x4){c.x, c.y, d.x, d.y}; }
                    v0 = v0 * sc; v1 = v1 * sc; u32x4 w; w.x = cvt_pk_bf16(v0[0], v0[1]); w.y = cvt_pk_bf16(v0[2], v0[3]); w.z = cvt_pk_bf16(v1[0], v1[1]); w.w = cvt_pk_bf16(v1[2], v1[3]);
                    PG8_ST16(base, rowp + bj * HALF, w); } }
    }
};
template <class Epi, class Sched, bool ALIGN_EPI = false, bool SP2 = false>
__device__ __forceinline__ void gemm_phase(PG8_LAS unsigned char* lds, const Gemm g, const Sched& S, const Epi& E) {
    const int tid = threadIdx.x, wid = __builtin_amdgcn_readfirstlane(tid >> 6), lane = tid & 63, wr = wid >> 2, wc = wid & 3, fr = lane & 15, fq = lane >> 4;
    const int K = g.K, nt = K / BK, LD = g.ld ? g.ld : g.K;
    unsigned voffA[2], voffB[2];
#pragma unroll
    for (int i = 0; i < 2; ++i) { int R, C; stage_rc(tid * 16 + i * 8192, R, C); const int Rb = Epi::PERM ? ((R & ~31) + perm32(R & 31)) : R;
        voffA[i] = (unsigned)(R * LD + C) * 2u; voffB[i] = (unsigned)(Rb * LD + C) * 2u; }
    const size_t kstep = (size_t)(BK * 2);
    const size_t hstep = (size_t)HALF * LD * 2;
    const size_t tstep = 2 * hstep;
    const unsigned ldsw = (unsigned)wid * 1024u;
    const int aoff = lds_byte(wr * 64 + fr, fq * 8), boff = lds_byte(wc * 32 + fr, fq * 8);
#define PG8_SA(b, h) (((b) * 2 + (h)) * HTB)
#define PG8_SB(b, h) ((4 + (b) * 2 + (h)) * HTB)
#define PG8_STAGE(bufoff, gbase, voff) do { _Pragma("unroll") for (int _i = 0; _i < 2; ++_i) \
        __builtin_amdgcn_global_load_lds((const unsigned*)((const char*)(gbase) + (voff)[_i]), (PG8_LAS unsigned*)(lds + (bufoff) + ldsw + _i * 8192), 16, 0, 0); } while (0)
#define PG8_LDA(dst, b, h) do { _Pragma("unroll") for (int m = 0; m < 4; ++m) _Pragma("unroll") for (int k = 0; k < 2; ++k) dst[m][k] = *(const PG8_LAS bf16x8*)(lds + PG8_SA(b, h) + aoff + m * 2048 + k * 1024); } while (0)
#define PG8_LDB(dst, b, h) do { _Pragma("unroll") for (int n = 0; n < 2; ++n) _Pragma("unroll") for (int k = 0; k < 2; ++k) dst[n][k] = *(const PG8_LAS bf16x8*)(lds + PG8_SB(b, h) + boff + n * 2048 + k * 1024); } while (0)
#define PG8_MMA(ai, bj, At, Bt) do { __builtin_amdgcn_s_setprio(1); _Pragma("unroll") for (int m = 0; m < 4; ++m) _Pragma("unroll") for (int n = 0; n < 2; ++n) _Pragma("unroll") for (int k = 0; k < 2; ++k) \
        acc[ai][bj][m][n] = __builtin_amdgcn_mfma_f32_16x16x32_bf16(Bt[n][k], At[m][k], acc[ai][bj][m][n], 0, 0, 0); __builtin_amdgcn_s_setprio(0); } while (0)
#define PG8_WAIT_V(n) asm volatile("s_waitcnt vmcnt(" #n ")" ::: "memory")
#define PG8_WAIT_L(n) asm volatile("s_waitcnt lgkmcnt(" #n ")" ::: "memory")
#define PG8_BAR __builtin_amdgcn_s_barrier()
#define PG8_SCHED __builtin_amdgcn_sched_barrier(0)
    Unit cur, nxt; int ui = 0;
    if (!S.next(0, cur)) return;
    f32x4 acc[2][2][4][2];
#pragma unroll
    for (int a = 0; a < 2; ++a)
#pragma unroll
        for (int b = 0; b < 2; ++b)
#pragma unroll
            for (int m = 0; m < 4; ++m)
#pragma unroll
                for (int n = 0; n < 2; ++n) acc[a][b][m][n] = (f32x4){0.f, 0.f, 0.f, 0.f};
    bf16x8 At[4][2], B0[2][2], B1[2][2];
    const char* cA = (const char*)g.A + (size_t)cur.pm * tstep + (size_t)cur.k0 * 2; const char* cB = (const char*)g.Bt + (size_t)cur.pn * tstep + (size_t)cur.k0 * 2;
    S.a_ready(cur);
    if constexpr (SP2) {
        PG8_STAGE(PG8_SB(0, 0), cB, voffB); PG8_STAGE(PG8_SB(0, 1), cB + hstep, voffB); PG8_STAGE(PG8_SA(0, 0), cA, voffA); PG8_STAGE(PG8_SA(0, 1), cA + hstep, voffA);
        if (wr == 1) PG8_BAR;
        PG8_WAIT_V(2); PG8_BAR;
        PG8_STAGE(PG8_SB(1, 0), cB + kstep, voffB); PG8_STAGE(PG8_SA(1, 0), cA + kstep, voffA); PG8_STAGE(PG8_SB(1, 1), cB + hstep + kstep, voffB);
        PG8_WAIT_V(6); PG8_BAR;
    } else {
        PG8_STAGE(PG8_SB(0, 0), cB, voffB); PG8_STAGE(PG8_SA(0, 0), cA, voffA); PG8_STAGE(PG8_SB(0, 1), cB + hstep, voffB); PG8_STAGE(PG8_SA(0, 1), cA + hstep, voffA);
        if (wr == 1) PG8_BAR;
        PG8_WAIT_V(4); PG8_BAR;
        PG8_STAGE(PG8_SB(1, 0), cB + kstep, voffB); PG8_STAGE(PG8_SA(1, 0), cA + kstep, voffA); PG8_STAGE(PG8_SB(1, 1), cB + hstep + kstep, voffB);
        PG8_WAIT_V(6); PG8_BAR;
    }
    for (;;) {
        const bool has_next = S.next(ui + 1, nxt);
        const char* nA = has_next ? (const char*)g.A + (size_t)nxt.pm * tstep + (size_t)nxt.k0 * 2 : cA; const char* nB = has_next ? (const char*)g.Bt + (size_t)nxt.pn * tstep + (size_t)nxt.k0 * 2 : cB;
        for (int t = 0; t < nt; t += 2) {
            const bool last = (t == nt - 2);
            const char* a1 = cA + (size_t)(t + 1) * kstep;
            const char* a2 = last ? nA : cA + (size_t)(t + 2) * kstep; const char* b2 = last ? nB : cB + (size_t)(t + 2) * kstep;
            const char* a3 = a2 + kstep; const char* b3 = b2 + kstep;
            if (last && has_next) S.a_ready(nxt);
            if constexpr (SP2) {
            PG8_LDB(B0, 0, 0); PG8_LDB(B1, 0, 1); PG8_SCHED; PG8_LDA(At, 0, 0); PG8_STAGE(PG8_SA(1, 1), a1 + hstep, voffA);
            PG8_WAIT_V(8); PG8_WAIT_L(0); PG8_BAR; PG8_MMA(0, 0, At, B0); PG8_MMA(0, 1, At, B1); PG8_BAR; PG8_SCHED;
            PG8_LDA(At, 0, 1); PG8_STAGE(PG8_SB(0, 0), b2, voffB); PG8_STAGE(PG8_SB(0, 1), b2 + hstep, voffB); PG8_STAGE(PG8_SA(0, 0), a2, voffA);
            PG8_WAIT_V(8); PG8_WAIT_L(0); PG8_BAR; PG8_MMA(1, 0, At, B0); PG8_MMA(1, 1, At, B1); PG8_BAR; PG8_SCHED;
            PG8_LDB(B0, 1, 0); PG8_LDB(B1, 1, 1); PG8_SCHED; PG8_LDA(At, 1, 0); PG8_STAGE(PG8_SA(0, 1), a2 + hstep, voffA);
            PG8_WAIT_V(8); PG8_WAIT_L(0); PG8_BAR; PG8_MMA(0, 0, At, B0); PG8_MMA(0, 1, At, B1); PG8_BAR; PG8_SCHED;
            PG8_LDA(At, 1, 1); PG8_STAGE(PG8_SB(1, 0), b3, voffB); PG8_STAGE(PG8_SB(1, 1), b3 + hstep, voffB); PG8_STAGE(PG8_SA(1, 0), a3, voffA);
            PG8_WAIT_V(8); PG8_WAIT_L(0); PG8_BAR; PG8_MMA(1, 0, At, B0); PG8_MMA(1, 1, At, B1); PG8_BAR; PG8_SCHED;
            } else {
            PG8_LDB(B0, 0, 0); PG8_SCHED; PG8_LDA(At, 0, 0); PG8_STAGE(PG8_SA(1, 1), a1 + hstep, voffA);
            PG8_WAIT_L(8); PG8_BAR; PG8_WAIT_L(0); PG8_MMA(0, 0, At, B0); PG8_BAR; PG8_SCHED;
            PG8_LDB(B1, 0, 1); PG8_STAGE(PG8_SB(0, 0), b2, voffB);
            PG8_BAR; PG8_WAIT_L(0); PG8_MMA(0, 1, At, B1); PG8_BAR;
            PG8_LDA(At, 0, 1); PG8_STAGE(PG8_SA(0, 0), a2, voffA);
            PG8_BAR; PG8_WAIT_L(0); PG8_MMA(1, 0, At, B0); PG8_BAR; PG8_SCHED;
            PG8_STAGE(PG8_SB(0, 1), b2 + hstep, voffB);
            PG8_WAIT_V(6); PG8_BAR; PG8_MMA(1, 1, At, B1); PG8_BAR;
            PG8_LDB(B0, 1, 0); PG8_SCHED; PG8_LDA(At, 1, 0); PG8_STAGE(PG8_SA(0, 1), a2 + hstep, voffA);
            PG8_WAIT_L(8); PG8_BAR; PG8_WAIT_L(0); PG8_MMA(0, 0, At, B0); PG8_BAR; PG8_SCHED;
            PG8_LDB(B1, 1, 1); PG8_STAGE(PG8_SB(1, 0), b3, voffB);
            PG8_BAR; PG8_WAIT_L(0); PG8_MMA(0, 1, At, B1); PG8_BAR;
            PG8_LDA(At, 1, 1); PG8_STAGE(PG8_SA(1, 0), a3, voffA);
            PG8_BAR; PG8_WAIT_L(0); PG8_MMA(1, 0, At, B0); PG8_BAR; PG8_SCHED;
            PG8_STAGE(PG8_SB(1, 1), b3 + hstep, voffB);
            PG8_WAIT_V(6); PG8_BAR; PG8_MMA(1, 1, At, B1); PG8_BAR;
            }
        }
        if constexpr (ALIGN_EPI) { if (wr == 0) PG8_BAR; }
        if constexpr (!Epi::AFTER_DRAIN) { E(acc, cur, wr, wc, fr, fq); S.done(cur); }
        if (!has_next) break;
#pragma unroll
        for (int a = 0; a < 2; ++a)
#pragma unroll
            for (int b = 0; b < 2; ++b)
#pragma unroll
                for (int m = 0; m < 4; ++m)
#pragma unroll
                    for (int n = 0; n < 2; ++n) acc[a][b][m][n] = (f32x4){0.f, 0.f, 0.f, 0.f};
        cur = nxt; cA = nA; cB = nB; ++ui;
        if constexpr (ALIGN_EPI) { if (wr == 1) PG8_BAR; }
    }
    PG8_WAIT_V(0);
    if constexpr (!ALIGN_EPI) { if (wr == 0) PG8_BAR; }
    PG8_BAR;
    if constexpr (Epi::AFTER_DRAIN) { E.fused(acc, cur, wr, wc, fr, fq, lds, wid, lane); S.done(cur); }
#undef PG8_SA
#undef PG8_SB
#undef PG8_STAGE
#undef PG8_LDA
#undef PG8_LDB
#undef PG8_MMA
#undef PG8_WAIT_V
#undef PG8_WAIT_L
#undef PG8_BAR
#undef PG8_SCHED
}
}

#define GAS __attribute__((address_space(1)))
#define LAS __attribute__((address_space(3)))
typedef unsigned short bf16;
typedef unsigned v4u __attribute__((ext_vector_type(4)));
typedef float f32x4 __attribute__((ext_vector_type(4)));
typedef short bf16x8 __attribute__((ext_vector_type(8)));
typedef GAS unsigned gu32;
typedef GAS unsigned long long gu64;
#define RLX_AGENT __ATOMIC_RELAXED, __HIP_MEMORY_SCOPE_AGENT
#define LDS_WAIT() asm volatile("s_waitcnt lgkmcnt(0)" ::: "memory")
#define VM_WAIT() asm volatile("s_waitcnt vmcnt(0)" ::: "memory")
__device__ __forceinline__ unsigned long long rt() { return __builtin_amdgcn_s_memrealtime(); }
typedef float f32x2_t __attribute__((ext_vector_type(2))); typedef __bf16 bf16x2_t __attribute__((ext_vector_type(2)));
__device__ __forceinline__ unsigned pk2(float lo, float hi) { const f32x2_t v = {lo, hi}; const bf16x2_t b = __builtin_convertvector(v, bf16x2_t); return __builtin_bit_cast(unsigned, b); }
__device__ __forceinline__ unsigned f2bf(float f) { return pk2(f, f) & 0xffffu; }
#define XB_TMO      128
#define XB_XCNT(j)  (256  + 64 * (j))
#define XB_XSUB(j)  (1280 + 64 * (j))
#define XB_XGEN(j)  (2304 + 64 * (j))
#define XB_TOP      3328
#define XB_TOPGEN   3392
#define XCD_BAR_WORDS 3456
#define XB_SPIN_CAP (1u << 18)

__device__ __forceinline__ unsigned xb_ld(unsigned* p)              { return __hip_atomic_load(p, __ATOMIC_RELAXED, __HIP_MEMORY_SCOPE_AGENT); }
__device__ __forceinline__ unsigned xb_add(unsigned* p, unsigned v) { return __hip_atomic_fetch_add(p, v, __ATOMIC_RELAXED, __HIP_MEMORY_SCOPE_AGENT); }
__device__ __forceinline__ unsigned xb_xcc_id() { return (unsigned)__builtin_amdgcn_s_getreg((3 << 11) | 20) & 0xFu; }
#define XB_SPIN(cond, bar) do { unsigned _sp = 0; while (cond) { __builtin_amdgcn_s_sleep(1); \
    if ((++_sp & 255u) == 0u) { if (xb_ld(&(bar)[XB_TMO])) break; if (_sp > XB_SPIN_CAP) { atomicAdd(&(bar)[XB_TMO], 1u); break; } } } } while (0)

struct XcdBarrier {
    unsigned* bar; unsigned x;
    volatile LAS unsigned* st;
};

__device__ __forceinline__ XcdBarrier xcd_barrier_post(unsigned* bar, volatile LAS unsigned* st) {
    XcdBarrier b; b.bar = bar; b.x = xb_xcc_id(); b.st = st;
    if (threadIdx.x == 0) (void)xb_add(&bar[XB_XCNT(b.x)], 1u);
    return b;
}
__device__ __forceinline__ void xcd_barrier_complete(unsigned* bar, unsigned x, unsigned& nloc, unsigned& nx) {
    const unsigned G = gridDim.x * gridDim.y * gridDim.z;
    unsigned sum, cnt, mine, sp = 0u;
    for (;;) {
        sum = 0u; cnt = 0u; mine = 0u;
#pragma unroll
        for (unsigned j = 0; j < 16; ++j) { const unsigned c = xb_ld(&bar[XB_XCNT(j)]); sum += c; cnt += (c > 0u) ? 1u : 0u; mine = (j == x) ? c : mine; }
        if (sum == G) break;
        __builtin_amdgcn_s_sleep(1);
        if ((++sp & 255u) == 0u) { if (xb_ld(&bar[XB_TMO])) break; if (sp > XB_SPIN_CAP) { atomicAdd(&bar[XB_TMO], 1u); break; } }
    }
    nloc = mine > 0u ? mine : 1u; nx = cnt > 0u ? cnt : 1u;
}

__device__ __forceinline__ void xcd_barrier(const XcdBarrier& b) {
    asm volatile("s_waitcnt vmcnt(0)" ::: "memory");
    __syncthreads();
    if (threadIdx.x == 0) {
        unsigned* bar = b.bar;
        __builtin_amdgcn_s_waitcnt(0);
        unsigned nloc = b.st[0], nx = b.st[1];
        if (nloc == 0u) { xcd_barrier_complete(bar, b.x, nloc, nx); b.st[0] = nloc; b.st[1] = nx; }
        const unsigned old = xb_add(&bar[XB_XSUB(b.x)], 1u);
        const unsigned gen = old / nloc;
        if (old + 1u == (gen + 1u) * nloc) {
            __builtin_amdgcn_fence(__ATOMIC_RELEASE, "agent");
            asm volatile("s_waitcnt vmcnt(0)" ::: "memory");
            const unsigned og = xb_add(&bar[XB_TOP], 1u);
            const unsigned tg = og / nx;
            if (og + 1u == (tg + 1u) * nx) xb_add(&bar[XB_TOPGEN], 1u);
            else XB_SPIN(xb_ld(&bar[XB_TOPGEN]) == tg, bar);
            __builtin_amdgcn_fence(__ATOMIC_ACQUIRE, "agent");
            xb_add(&bar[XB_XGEN(b.x)], 1u);
            asm volatile("s_waitcnt vmcnt(0)" ::: "memory");
        } else {
            XB_SPIN(xb_ld(&bar[XB_XGEN(b.x)]) == gen, bar);
            __builtin_amdgcn_fence(__ATOMIC_ACQUIRE, "agent");
            asm volatile("s_waitcnt vmcnt(0)" ::: "memory");
        }
    }
    __syncthreads();
}


constexpr int NWAVES = 8, NTHR = 512;
constexpr int D = 1024, NB = 8, SEQ = 2048, CTXL = 256;
constexpr int M_CTX = NB * CTXL, M_LAT = NB * SEQ, M_ALL = M_CTX + M_LAT;
constexpr int RWC = 1760, MIXIN = 3312, ZLD = 3328, FF = 2816, NE = 8;
constexpr int PRV = 9 * 512;
constexpr int MOE_ROWS = 34816;
constexpr size_t MiB = 1u << 20;
constexpr size_t WS_CTL = 0, CTL_ZERO_BYTES = 1 * MiB;
constexpr size_t WS_MODS = 1 * MiB;
constexpr size_t WS_TOK = 1 * MiB + 512 * 1024;
constexpr size_t WS_WIN_T = 2 * MiB;
constexpr size_t WS_WOUT_T = WS_WIN_T + (size_t)ZLD * D * 2;
constexpr size_t WS_W13_T = WS_WOUT_T + 2 * MiB;
constexpr size_t WS_W2_T = WS_W13_T + 11 * MiB;
constexpr size_t WS_QKV_T = WS_W2_T + (size_t)D * FF * 2;
constexpr size_t WS_NAO_T = WS_QKV_T + 6 * MiB;
constexpr size_t WS_HCTX = 35 * MiB;
constexpr size_t WS_A = 43 * MiB;
constexpr size_t WS_R = 79 * MiB;
constexpr size_t WS_Z = WS_R;
constexpr size_t WS_PR = 196 * MiB;
constexpr size_t WS_PM = 358 * MiB;
constexpr size_t WS_DT = 394 * MiB;
constexpr size_t WS_BONUS = 395 * MiB + 256 * 1024;
constexpr size_t WS_GATE = 396 * MiB;
constexpr size_t WS_ZG = 414 * MiB;
constexpr size_t WS_YRW = WS_R;
constexpr size_t WS_YMB = WS_R + 36 * MiB;
constexpr size_t WS_HID = WS_R;
constexpr size_t WS_MOEW13 = 316 * MiB;
constexpr size_t WS_MOEW2 = 404 * MiB;
constexpr size_t WS_Q = WS_R, WS_K = WS_R + 36 * MiB, WS_V = WS_R + 72 * MiB;
constexpr size_t WS_O = WS_R + 108 * MiB;
constexpr size_t WS_A4 = 111 * MiB;
constexpr size_t WS_XG = 43 * MiB;
constexpr size_t WS_HIDG = 111 * MiB;
constexpr size_t WS_YG = 43 * MiB;
constexpr size_t WS_SLAB6 = WS_R;
constexpr size_t WS_SLAB9 = WS_R + 99 * MiB;
constexpr size_t WS_TAIL = 316 * MiB;
constexpr size_t WS_END = 448 * MiB;
static_assert(WS_NAO_T + 2 * MiB <= WS_HCTX && WS_ZG + 18 * MiB <= WS_END && WS_MOEW2 + 44 * MiB <= WS_END && WS_HIDG + (size_t)MOE_ROWS * FF * 2 <= WS_MOEW13, "ws map");
static_assert(WS_Z + (size_t)M_ALL * ZLD * 2 <= WS_PR && WS_PR + (size_t)M_ALL * PRV * 2 <= WS_PM && WS_XG + (size_t)MOE_ROWS * D * 2 <= WS_HIDG, "ws map 2");
constexpr int CW_TMO = 0, CW_CODE = 1, CW_BAR = 4096, CW_CNT = 8192;
constexpr int RING_BYTES = 131072, LDSCTL_OFF = RING_BYTES, MISC_OFF = LDSCTL_OFF + 320, LDS_BYTES = 147456;

typedef unsigned v2u __attribute__((ext_vector_type(2)));
typedef float v2f __attribute__((ext_vector_type(2)));
typedef short s16x4 __attribute__((ext_vector_type(4)));
typedef short v4i16_t __attribute__((ext_vector_type(4)));
__device__ __forceinline__ float bflo(unsigned u) { return __uint_as_float(u << 16); }
__device__ __forceinline__ float bfhi(unsigned u) { return __uint_as_float(u & 0xffff0000u); }
__device__ __forceinline__ float ldbf(const bf16* p) { return __uint_as_float((unsigned)(*p) << 16); }
__device__ __forceinline__ float sigm(float x) { return __builtin_amdgcn_rcpf(1.f + __expf(-x)); }
__device__ __forceinline__ bf16x8 pack8(const f32x4& a, const f32x4& b) {
    v4u w; w.x = pk2(a[0], a[1]); w.y = pk2(a[2], a[3]); w.z = pk2(b[0], b[1]); w.w = pk2(b[2], b[3]); return __builtin_bit_cast(bf16x8, w);
}
template <int CTRL> __device__ __forceinline__ float dppf(float x) { return __int_as_float(__builtin_amdgcn_update_dpp(0, __float_as_int(x), CTRL, 0xF, 0xF, true)); }
__device__ __forceinline__ float sum8(float x) { x += dppf<0xB1>(x); x += dppf<0x4E>(x); x += dppf<0x141>(x); return x; }
__device__ __forceinline__ float sum16(float x) { x = sum8(x); x += dppf<0x140>(x); return x; }
__device__ __forceinline__ float rlf(float v, int l) { return __int_as_float(__builtin_amdgcn_readlane(__float_as_int(v), l)); }
__device__ __forceinline__ float wave_sum(float v) { v = sum16(v); return (rlf(v, 0) + rlf(v, 16)) + (rlf(v, 32) + rlf(v, 48)); }
__device__ __forceinline__ float half_sum(float v, int lane) { v = sum16(v); const float lo = rlf(v, 0) + rlf(v, 16), hi = rlf(v, 32) + rlf(v, 48); return lane < 32 ? lo : hi; }

struct Frame {
    LAS unsigned char* lds;
    volatile LAS unsigned* MISC;
    gu32* ctl;
    int tid, lane, wave, G, bid;
};

__device__ __forceinline__ void tr_item(const float* W, int K, int N, bf16* WT, int drow0, int k0, int n0, LAS float* scr, int lane) {
    const int nn = n0 + (lane & 31);
    float t[32];
#pragma unroll
    for (int i = 0; i < 32; ++i) { const int kk = 2 * i + (lane >> 5); t[i] = (nn < N) ? W[(size_t)(k0 + kk) * N + nn] : 0.f; }
#pragma unroll
    for (int i = 0; i < 32; ++i) { const int kk = 2 * i + (lane >> 5); scr[kk * 33 + (lane & 31)] = t[i]; }
    LDS_WAIT(); asm volatile("" ::: "memory");
    const int c = lane & 7;
#pragma unroll
    for (int j = 0; j < 4; ++j) { const int n = (lane >> 3) + 8 * j; const LAS float* s = scr + (8 * c) * 33 + n;
        v4u o; o.x = pk2(s[0 * 33], s[1 * 33]); o.y = pk2(s[2 * 33], s[3 * 33]); o.z = pk2(s[4 * 33], s[5 * 33]); o.w = pk2(s[6 * 33], s[7 * 33]);
        *(GAS v4u*)(WT + (size_t)(drow0 + n) * K + k0 + 8 * c) = o; }
    LDS_WAIT(); asm volatile("" ::: "memory");
}
template <int MODE  >
__device__ __forceinline__ bool tr_matrix(int& it, const float* W, int K, int N, bf16* WT, LAS float* scr, int lane) {
    const int nblk = (N + 31) / 32, items = (K / 64) * nblk;
    if (it >= items) { it -= items; return false; }
    const int kb = it / nblk, nb = it % nblk, n0 = nb * 32;
    int drow0 = n0;
    if (MODE == 1) drow0 = (n0 >> 7) * 256 + (n0 & 127);
    if (MODE == 2) drow0 = (n0 >> 7) * 256 + 128 + (n0 & 127);
    tr_item(W, K, N, WT, drow0, kb * 64, n0, scr, lane);
    return true;
}

__device__ __forceinline__ void p0_phase(Frame& F, const float* c, const float* c_ctx, const float* w_ada, const float* b_ada, float* mods,
                                         const float* mix_w_in, const float* mix_w_out, const float* ffn_w1, const float* ffn_w3, const float* ffn_w2,
                                         const float* na_w_qkv, const float* na_w_out, unsigned char* ws) {
    for (int u = F.bid; u < 192; u += F.G) {
        LAS float* sc = (LAS float*)(F.lds);
        LAS float* red = (LAS float*)(F.lds + 36864);
        for (int i = F.tid; i < 9 * 1024; i += NTHR) { const int b = i >> 10, k = i & 1023; const float v = (b < 8) ? c[b * 1024 + k] : c_ctx[k]; sc[i] = v / (1.f + __expf(-v)); }
        __syncthreads();
        const int layer = u / 96, col = (u % 96) * 64 + F.lane;
        const float* W = w_ada + (size_t)layer * 1024 * 6144 + col;
        float acc[9];
#pragma unroll
        for (int b = 0; b < 9; ++b) acc[b] = 0.f;
        const int k0 = F.wave * 128;
#pragma unroll 8
        for (int k = 0; k < 128; ++k) { const float w = W[(size_t)(k0 + k) * 6144];
#pragma unroll
            for (int b = 0; b < 9; ++b) acc[b] += sc[b * 1024 + k0 + k] * w; }
#pragma unroll
        for (int b = 0; b < 9; ++b) red[(F.wave * 9 + b) * 64 + F.lane] = acc[b];
        __syncthreads();
        if (F.wave == 0) {
#pragma unroll
            for (int b = 0; b < 9; ++b) { float s = 0.f;
#pragma unroll
                for (int w = 0; w < 8; ++w) s += red[(w * 9 + b) * 64 + F.lane];
                mods[(layer * 9 + b) * 6144 + col] = s + b_ada[layer * 6144 + col]; }
        }
        __syncthreads();
    }
    LAS float* scr = (LAS float*)(F.lds + 57344 + F.wave * 8704);
    const int gw = F.bid * NWAVES + F.wave, NGW = F.G * NWAVES;
    constexpr int NITEMS = 16 * 104 + 512 + 1408 * 3 + 1536 + 512;
    for (int it0 = gw; it0 < NITEMS; it0 += NGW) {
        int it = it0;
        if (tr_matrix<0>(it, mix_w_in, 1024, MIXIN, (bf16*)(ws + WS_WIN_T), scr, F.lane)) continue;
        if (tr_matrix<0>(it, mix_w_out, 1024, 1024, (bf16*)(ws + WS_WOUT_T), scr, F.lane)) continue;
        if (tr_matrix<1>(it, ffn_w1, 1024, FF, (bf16*)(ws + WS_W13_T), scr, F.lane)) continue;
        if (tr_matrix<2>(it, ffn_w3, 1024, FF, (bf16*)(ws + WS_W13_T), scr, F.lane)) continue;
        if (tr_matrix<0>(it, ffn_w2, FF, 1024, (bf16*)(ws + WS_W2_T), scr, F.lane)) continue;
        if (tr_matrix<0>(it, na_w_qkv, 1024, 3072, (bf16*)(ws + WS_QKV_T), scr, F.lane)) continue;
        tr_matrix<0>(it, na_w_out, 1024, 1024, (bf16*)(ws + WS_NAO_T), scr, F.lane);
    }
}
constexpr int MOE_ITEMS = NE * 1408 * 3, MOE_ITEMS_P6 = 0, MOE_ITEMS_P8 = 10240, MOE_ITEMS_P9 = 23552, MOE_ITEMS_P11 = 0, MOE_ITEMS_P7 = MOE_ITEMS - MOE_ITEMS_P8 - MOE_ITEMS_P9 - MOE_ITEMS_P11;
__device__ __forceinline__ void moe_weight_phase(Frame& F, const float* w1, const float* w3, const float* w2, unsigned char* ws, int lo, int hi, int widx, int nw) {
    LAS float* scr = (LAS float*)(F.lds + 57344 + F.wave * 8704);
    const int gw = widx * NWAVES + F.wave, NGW = nw * NWAVES;
    constexpr int PER_E = 1408 * 3;
    for (int it0 = lo + gw; it0 < hi; it0 += NGW) {
        const int e = it0 / PER_E; int it = it0 % PER_E;
        bf16* w13t = (bf16*)(ws + WS_MOEW13) + (size_t)e * 5632 * 1024; bf16* w2t = (bf16*)(ws + WS_MOEW2) + (size_t)e * 1024 * FF;
        if (tr_matrix<1>(it, w1 + (size_t)e * 1024 * FF, 1024, FF, w13t, scr, F.lane)) continue;
        if (tr_matrix<2>(it, w3 + (size_t)e * 1024 * FF, 1024, FF, w13t, scr, F.lane)) continue;
        tr_matrix<0>(it, w2 + (size_t)e * 1024 * FF, FF, 1024, w2t, scr, F.lane);
    }
}

struct RowIn { f32x4 x[4], sh[4], sc[4]; };
__device__ __forceinline__ void row_fetch(RowIn& R, const float* xrow, const float* sh, const float* sc, int lane) {
#pragma unroll
    for (int j = 0; j < 4; ++j) { R.x[j] = ((const GAS f32x4*)xrow)[lane + 64 * j]; R.sh[j] = ((const GAS f32x4*)sh)[lane + 64 * j]; R.sc[j] = ((const GAS f32x4*)sc)[lane + 64 * j]; }
}
__device__ __forceinline__ void row_finish(const RowIn& R, const f32x4 (&gg)[4], bf16* orow, int lane, f32x4 (&a)[4], const float* slab = nullptr, int nslab = 0, float* wb = nullptr) {
    float ss = 0.f;
#pragma unroll
    for (int j = 0; j < 4; ++j) a[j] = R.x[j];
    for (int s = 0; s < nslab; ++s) { const GAS f32x4* sr = (const GAS f32x4*)(slab + (size_t)s * (2048 * 1024)) + lane;
#pragma unroll
        for (int j = 0; j < 4; ++j) a[j] += sr[64 * j]; }
    if (wb) { GAS f32x4* w4 = (GAS f32x4*)wb + lane;
#pragma unroll
        for (int j = 0; j < 4; ++j) w4[64 * j] = a[j]; }
#pragma unroll
    for (int j = 0; j < 4; ++j) ss += (a[j].x * a[j].x + a[j].y * a[j].y) + (a[j].z * a[j].z + a[j].w * a[j].w);
    const float rs = rsqrtf(wave_sum(ss) * (1.f / 1024.f) + 1e-6f);
    GAS unsigned long long* o8 = (GAS unsigned long long*)orow + lane;
#pragma unroll
    for (int j = 0; j < 4; ++j) {
        a[j] = (a[j] * rs) * gg[j] * (R.sc[j] + 1.f) + R.sh[j];
        o8[64 * j] = (unsigned long long)pk2(a[j].x, a[j].y) | ((unsigned long long)pk2(a[j].z, a[j].w) << 32);
    }
}
__device__ __forceinline__ void normmod_phase(Frame& F, const float* src_ctx, const float* src_lat, const float* g, const float* mods_l, int off_shift, int off_scale, bf16* dst, const float* slab = nullptr, int nslab = 0, float* wb_ctx = nullptr) {
    const int gw = F.bid * NWAVES + F.wave, NGW = F.G * NWAVES;
    f32x4 gg[4];
#pragma unroll
    for (int j = 0; j < 4; ++j) gg[j] = ((const GAS f32x4*)g)[F.lane + 64 * j];
    RowIn cur, nxt;
    int r = gw; bool have = r < M_ALL;
#define NM_FETCH(R_, r_) do { const bool ic_ = (r_) < M_CTX; const int rl_ = ic_ ? (r_) : (r_) - M_CTX; const float* mp_ = mods_l + (ic_ ? 8 : (rl_ >> 11)) * 6144; \
        row_fetch(R_, (ic_ ? src_ctx : src_lat) + (size_t)rl_ * D, mp_ + off_shift, mp_ + off_scale, F.lane); } while (0)
    if (have) NM_FETCH(cur, r);
    while (have) {
        const int rn = r + NGW; const bool hn = rn < M_ALL;
        if (hn) NM_FETCH(nxt, rn);
        const bool isctx = r < M_CTX; const int rl = isctx ? r : r - M_CTX;
        f32x4 a[4];
        if (isctx) row_finish(cur, gg, dst + (size_t)r * D, F.lane, a, slab ? slab + (size_t)rl * D : nullptr, nslab, wb_ctx ? wb_ctx + (size_t)rl * D : nullptr);
        else row_finish(cur, gg, dst + (size_t)r * D, F.lane, a);
        cur = nxt; r = rn; have = hn;
    }
#undef NM_FETCH
}

namespace pg8 {
struct EpiResGate {
    static constexpr bool PERM = false, AFTER_DRAIN = false;
    const float* base_c; const float* base_l; float* out_c; float* out_l; const float* mods_l; int gate_off; int ctx_tiles;
    __device__ __forceinline__ void operator()(const f32x4 (&acc)[2][2][4][2], const Unit& u, int wr, int wc, int fr, int fq) const {
        const bool isctx = u.pm < ctx_tiles; const int rt = isctx ? u.pm : u.pm - ctx_tiles; const int mi = isctx ? 8 : (rt >> 3);
        const float* base = isctx ? base_c : base_l; float* out = isctx ? out_c : out_l;
        const int col0 = u.pn * BM + wc * 32 + 4 * fq; const float* gp = mods_l + mi * 6144 + gate_off + col0;
        f32x4 gv[2][2];
#pragma unroll
        for (int bj = 0; bj < 2; ++bj)
#pragma unroll
            for (int n = 0; n < 2; ++n) gv[bj][n] = *(const f32x4*)(gp + bj * HALF + n * 16);
#pragma unroll
        for (int ai = 0; ai < 2; ++ai)
#pragma unroll
            for (int m = 0; m < 4; ++m) { const size_t off = (size_t)(rt * BM + ai * HALF + wr * 64 + m * 16 + fr) * 1024 + col0;
#pragma unroll
                for (int bj = 0; bj < 2; ++bj)
#pragma unroll
                    for (int n = 0; n < 2; ++n) { const f32x4 b = *(const f32x4*)(base + off + bj * HALF + n * 16); *(f32x4*)(out + off + bj * HALF + n * 16) = b + gv[bj][n] * acc[ai][bj][m][n]; } }
    }
};
struct EpiSwiGLU {
    static constexpr bool PERM = true, AFTER_DRAIN = false;
    bf16_t* O; int ldo; int nt_mod;
    __device__ __forceinline__ void operator()(const f32x4 (&acc)[2][2][4][2], const Unit& u, int wr, int wc, int fr, int fq) const {
        const int pnl = u.pn % nt_mod; const int row0 = u.pm * BM + wr * 64 + fr, col0 = pnl * HALF + wc * 32 + 8 * fq;
#pragma unroll
        for (int ai = 0; ai < 2; ++ai)
#pragma unroll
            for (int m = 0; m < 4; ++m) { bf16_t* rowp = O + (size_t)(row0 + ai * HALF + m * 16) * ldo + col0;
                float h[8];
#pragma unroll
                for (int n = 0; n < 2; ++n)
#pragma unroll
                    for (int e = 0; e < 4; ++e) { const float a = acc[ai][0][m][n][e], b = acc[ai][1][m][n][e]; h[n * 4 + e] = a * b * __builtin_amdgcn_rcpf(1.f + __expf(-a)); }
                u32x4 w; w.x = cvt_pk_bf16(h[0], h[1]); w.y = cvt_pk_bf16(h[2], h[3]); w.z = cvt_pk_bf16(h[4], h[5]); w.w = cvt_pk_bf16(h[6], h[7]);
                PG8_ST16(O, rowp, w); }
    }
};
struct EpiPlainMod {
    static constexpr bool PERM = true, AFTER_DRAIN = false;
    bf16_t* O; int ldo; int nt_mod;
    __device__ __forceinline__ void operator()(const f32x4 (&acc)[2][2][4][2], const Unit& u, int wr, int wc, int fr, int fq) const {
        const int pnl = u.pn % nt_mod; const int row0 = u.pm * BM + wr * 64 + fr, col0 = pnl * BM + wc * 32 + 8 * fq;
#pragma unroll
        for (int ai = 0; ai < 2; ++ai)
#pragma unroll
            for (int m = 0; m < 4; ++m) { bf16_t* rowp = O + (size_t)(row0 + ai * HALF + m * 16) * ldo + col0;
#pragma unroll
                for (int bj = 0; bj < 2; ++bj) { const f32x4 v0 = acc[ai][bj][m][0], v1 = acc[ai][bj][m][1];
                    u32x4 w; w.x = cvt_pk_bf16(v0[0], v0[1]); w.y = cvt_pk_bf16(v0[2], v0[3]); w.z = cvt_pk_bf16(v1[0], v1[1]); w.w = cvt_pk_bf16(v1[2], v1[3]);
                    PG8_ST16(O, rowp + bj * HALF, w); } }
    }
};
struct SplitKOrder {
    int ntm, nN, ns, kslice, G, c;
    __device__ __forceinline__ bool next(int i, Unit& u) const {
        const int L = i * G + c; if (L >= ntm * nN * ns) return false;
        const int ks = L % ns, t = L / ns; u.pn = t % nN; u.pm = t / nN; u.k0 = ks * kslice; return true;
    }
    __device__ __forceinline__ void a_ready(const Unit&) const {}
    __device__ __forceinline__ void done(const Unit&) const {}
};
struct EpiSlabGate {
    static constexpr bool PERM = false, AFTER_DRAIN = false;
    float* slab; const float* gate; int kslice;
    __device__ __forceinline__ void operator()(const f32x4 (&acc)[2][2][4][2], const Unit& u, int wr, int wc, int fr, int fq) const {
        const int col0 = u.pn * BM + wc * 32 + 4 * fq; float* out = slab + (size_t)(u.k0 / kslice) * (2048 * 1024);
        f32x4 gv[2][2];
#pragma unroll
        for (int bj = 0; bj < 2; ++bj)
#pragma unroll
            for (int n = 0; n < 2; ++n) gv[bj][n] = *(const f32x4*)(gate + col0 + bj * HALF + n * 16);
#pragma unroll
        for (int ai = 0; ai < 2; ++ai)
#pragma unroll
            for (int m = 0; m < 4; ++m) { float* op = out + (size_t)(u.pm * BM + ai * HALF + wr * 64 + m * 16 + fr) * 1024 + col0;
#pragma unroll
                for (int bj = 0; bj < 2; ++bj)
#pragma unroll
                    for (int n = 0; n < 2; ++n) *(f32x4*)(op + bj * HALF + n * 16) = gv[bj][n] * acc[ai][bj][m][n]; }
    }
};
struct MoeOrder {
    int tb[9]; int ntn, G, c; int limit = 0x7fffffff;
    __device__ __forceinline__ bool next(int i, Unit& u) const {
        const int L = i * G + c; if (L >= tb[8] * ntn || L >= limit) return false;
        const int mt = L / ntn, pn = L % ntn; int e = 0;
#pragma unroll
        for (int k = 1; k < 8; ++k) e += (mt >= tb[k]) ? 1 : 0;
        u.pm = mt; u.pn = e * ntn + pn; return true;
    }
    __device__ __forceinline__ void a_ready(const Unit&) const {}
    __device__ __forceinline__ void done(const Unit&) const {}
};
struct MoeTailOrder {
    int tb[9]; int first, ntail, G, c;
    __device__ __forceinline__ bool next(int i, Unit& u) const {
        const int L = i * G + c; if (L >= ntail * 11) return false;
        const int tu = L / 11, ks = L % 11, gu = first + tu, mt = gu >> 2, pn = gu & 3; int e = 0;
#pragma unroll
        for (int k = 1; k < 8; ++k) e += (mt >= tb[k]) ? 1 : 0;
        u.pm = mt; u.pn = e * 4 + pn; u.k0 = ks * 256; return true;
    }
    __device__ __forceinline__ void a_ready(const Unit&) const {}
    __device__ __forceinline__ void done(const Unit&) const {}
};
struct EpiTailSlab {
    static constexpr bool PERM = false, AFTER_DRAIN = false;
    float* slab; int first, ntail;
    __device__ __forceinline__ void operator()(const f32x4 (&acc)[2][2][4][2], const Unit& u, int wr, int wc, int fr, int fq) const {
        const int col0 = (u.pn & 3) * BM + wc * 32 + 4 * fq; float* out = slab + (size_t)(u.k0 >> 8) * ((size_t)(ntail >> 2) * 256 * 1024);
        const int rt = u.pm - (first >> 2);
#pragma unroll
        for (int ai = 0; ai < 2; ++ai)
#pragma unroll
            for (int m = 0; m < 4; ++m) { float* op = out + (size_t)(rt * BM + ai * HALF + wr * 64 + m * 16 + fr) * 1024 + col0;
#pragma unroll
                for (int bj = 0; bj < 2; ++bj)
#pragma unroll
                    for (int n = 0; n < 2; ++n) *(f32x4*)(op + bj * HALF + n * 16) = acc[ai][bj][m][n]; }
    }
};
}

struct PrepIn { const float *rw_mu, *rw_w0, *rw_w_up, *rw_a0, *rw_a_up, *rw_g_up, *rw_k_k, *rw_k_a, *rw_r_k, *conv_w, *conv_b, *dt_bias; };
__device__ __forceinline__ bf16x8 gather8(const float* p, int stride) {
    v4u w; w.x = pk2(p[0], p[stride]); w.y = pk2(p[2 * stride], p[3 * stride]); w.z = pk2(p[4 * stride], p[5 * stride]); w.w = pk2(p[6 * stride], p[7 * stride]); return __builtin_bit_cast(bf16x8, w);
}
constexpr int ACT_ST = 464;
__device__ __forceinline__ void prepare_phase(Frame& F, const PrepIn& P, const bf16* Z, bf16* PR, bf16* PM, float* DT, float* BONUS, bf16* GATE, bf16* ZG) {
    LAS unsigned short* zs = (LAS unsigned short*)F.lds;
    LAS unsigned char* actb = F.lds + 24576;
    LAS float* cst = (LAS float*)(F.lds + 24576 + 16 * ACT_ST);
    const int tid = F.tid, lane = F.lane, fr = lane & 15, fq = lane >> 4, w = F.wave;
    const int hf = F.bid & 1, wl = w & 3, hd = 4 * hf + wl;
    __syncthreads();
    if (tid < 256) { const int c = 256 * hf + tid; cst[tid] = P.rw_w0[c]; cst[256 + tid] = P.rw_w0[512 + c]; cst[512 + tid] = P.rw_a0[c]; cst[768 + tid] = P.rw_a0[512 + c];
      cst[1024 + tid] = P.rw_k_k[c]; cst[1280 + tid] = P.rw_k_a[c]; cst[1536 + tid] = P.rw_r_k[c]; cst[1792 + tid] = P.rw_r_k[512 + c]; }
    bf16x8 W[16];
#pragma unroll
    for (int cb = 0; cb < 4; ++cb) { const int c = 64 * hd + 4 * fr + cb;
        if (w < 4) { W[cb] = gather8(P.rw_w_up + (size_t)(8 * fq) * 512 + c, 512); W[4 + cb] = gather8(P.rw_w_up + (size_t)(32 + 8 * fq) * 512 + c, 512);
                     W[8 + cb] = gather8(P.rw_a_up + (size_t)(8 * fq) * 512 + c, 512); W[12 + cb] = gather8(P.rw_a_up + (size_t)(32 + 8 * fq) * 512 + c, 512); }
        else { W[cb] = gather8(P.rw_g_up + (size_t)(8 * fq) * 512 + c, 512); W[4 + cb] = gather8(P.rw_g_up + (size_t)(32 + 8 * fq) * 512 + c, 512); W[8 + cb] = gather8(P.rw_g_up + (size_t)(64 + 8 * fq) * 512 + c, 512); W[12 + cb] = W[cb]; } }
    const int col0 = (tid < 256) ? (256 * hf + tid) : (512 + 256 * hf + tid - 256), col1 = (tid < 256) ? (1024 + 256 * hf + tid) : ((tid < 480) ? (1536 + tid - 256) : 1536);
    const int zo0 = tid, zo1 = 512 + (tid & 255);
    const float mu00 = P.rw_mu[col0], mu10 = P.rw_mu[RWC + col0], mu01 = P.rw_mu[col1], mu11 = P.rw_mu[RWC + col1];
    float cw[5];
#pragma unroll
    for (int k = 0; k < 5; ++k) cw[k] = P.conv_w[k * 1024 + 512 * hf + tid];
    const float cbv = P.conv_b[512 * hf + tid], dtb = P.dt_bias[tid & 15];
    __syncthreads();

#ifndef PREP_REPS
#define PREP_REPS 1
#endif
    for (int rb_ = F.bid >> 1; rb_ < (M_ALL / 16) * PREP_REPS; rb_ += (F.G >> 1)) {
        const int rb = rb_ % (M_ALL / 16); const int g0 = rb * 16; const bool isctx = g0 < M_CTX; const int T = isctx ? CTXL : SEQ; const int t0 = isctx ? (g0 & (CTXL - 1)) : ((g0 - M_CTX) & (SEQ - 1));
        const bf16* zb = Z + (size_t)g0 * ZLD;
        const bool hp = t0 > 0, hn = (t0 + 16 < T), hp2 = t0 >= 2, hn2 = (t0 + 17 < T);
        float z0[18], z1[18], x[20];
        const int ccol = RWC + 512 + 512 * hf + tid;
#pragma unroll
        for (int i = 0; i < 18; ++i) { const bool ok = (i == 0) ? hp : ((i == 17) ? hn : true); z0[i] = ok ? ldbf(zb + (ptrdiff_t)(i - 1) * ZLD + col0) : 0.f; z1[i] = ok ? ldbf(zb + (ptrdiff_t)(i - 1) * ZLD + col1) : 0.f; }
#pragma unroll
        for (int i = 0; i < 20; ++i) { const bool ok = (i == 0) ? hp2 : (i == 1) ? hp : (i == 18) ? hn : (i == 19) ? hn2 : true; x[i] = ok ? ldbf(zb + (ptrdiff_t)(i - 2) * ZLD + ccol) : 0.f; }
#pragma unroll
        for (int tb = 0; tb < 16; ++tb) zs[tb * 768 + zo0] = (unsigned short)f2bf(z0[tb + 1] + mu00 * (z0[tb] - z0[tb + 1]) + mu10 * (z0[tb + 2] - z0[tb + 1]));
        {
            const int a = tid - 256;
#pragma unroll
            for (int tb = 0; tb < 16; ++tb) {
                const float zsft = z1[tb + 1] + mu01 * (z1[tb] - z1[tb + 1]) + mu11 * (z1[tb + 2] - z1[tb + 1]);
                if (tid < 256) zs[tb * 768 + zo1] = (unsigned short)f2bf(zsft);
                else if (tid < 480) { const float sg = sigm((a < 64) ? 2.f * zsft : zsft); const float av = (a < 64) ? (2.f * sg - 1.f) : ((a < 128) ? zsft : sg);
                    *(LAS unsigned short*)(actb + tb * ACT_ST + a * 2) = (unsigned short)f2bf(av); }
            }
        }
#pragma unroll
        for (int tb = 0; tb < 16; ++tb) {
            float y = cbv + cw[0] * x[tb] + cw[1] * x[tb + 1] + cw[2] * x[tb + 2] + cw[3] * x[tb + 3] + cw[4] * x[tb + 4];
            y = y * sigm(y);
            PM[(size_t)(g0 + tb) * 1024 + 512 * hf + tid] = (bf16)f2bf(y);
        }
        { const int tb = tid >> 5, cc = tid & 31;
          *(GAS v4u*)(ZG + (size_t)(g0 + tb) * 512 + 256 * hf + cc * 8) = *(const GAS v4u*)(zb + (size_t)tb * ZLD + RWC + 256 * hf + cc * 8); }
        if (hf == 0 && tid < 256) { const int tb = tid >> 4, cc = tid & 15; const float x = ldbf(zb + (size_t)tb * ZLD + RWC + 1536 + cc) + dtb; DT[(size_t)(g0 + tb) * 16 + cc] = (x > 20.f) ? x : log1pf(__expf(x)); }
        __syncthreads();
        const f32x4 zero = {0.f, 0.f, 0.f, 0.f};
        const int cl0 = 64 * wl + 4 * fr;
        if (w < 4) {
            bf16x8 Af[4];
#pragma unroll
            for (int kb = 0; kb < 4; ++kb) Af[kb] = *(const LAS bf16x8*)(actb + fr * ACT_ST + kb * 64 + fq * 16);
            f32x4 lw0[4], lw1[4], ia0[4], ia1[4];
#pragma unroll
            for (int cb = 0; cb < 4; ++cb) {
                lw0[cb] = __builtin_amdgcn_mfma_f32_16x16x32_bf16(Af[0], W[cb], zero, 0, 0, 0); lw1[cb] = __builtin_amdgcn_mfma_f32_16x16x32_bf16(Af[1], W[4 + cb], zero, 0, 0, 0);
                ia0[cb] = __builtin_amdgcn_mfma_f32_16x16x32_bf16(Af[2], W[8 + cb], zero, 0, 0, 0); ia1[cb] = __builtin_amdgcn_mfma_f32_16x16x32_bf16(Af[3], W[12 + cb], zero, 0, 0, 0);
            }
            const f32x4 w00 = *(const LAS f32x4*)(cst + cl0), w01 = *(const LAS f32x4*)(cst + 256 + cl0), a00 = *(const LAS f32x4*)(cst + 512 + cl0), a01 = *(const LAS f32x4*)(cst + 768 + cl0);
            const f32x4 kkc = *(const LAS f32x4*)(cst + 1024 + cl0), kac = *(const LAS f32x4*)(cst + 1280 + cl0), rk0 = *(const LAS f32x4*)(cst + 1536 + cl0), rk1 = *(const LAS f32x4*)(cst + 1792 + cl0);
#pragma unroll
            for (int e = 0; e < 4; ++e) {
                const int tok = 4 * fq + e; const size_t g = (size_t)(g0 + tok);
                const v2u ru = *(const LAS v2u*)(zs + tok * 768 + cl0), ku = *(const LAS v2u*)(zs + tok * 768 + 256 + cl0), vu = *(const LAS v2u*)(zs + tok * 768 + 512 + cl0);
                const f32x4 r = {bflo(ru.x), bfhi(ru.x), bflo(ru.y), bfhi(ru.y)}, k = {bflo(ku.x), bfhi(ku.x), bflo(ku.y), bfhi(ku.y)};
                const f32x4 kks = k * kkc;
                const float ssq = sum16((kks[0] * kks[0] + kks[1] * kks[1]) + (kks[2] * kks[2] + kks[3] * kks[3]));
                const float rn = __builtin_amdgcn_rcpf(fmaxf(sqrtf(ssq), 1e-12f));
                float ee0[4], ee1[4], kd0[4], kd1[4], bb0[4], bb1[4], na[4]; float bon = 0.f;
#pragma unroll
                for (int cb = 0; cb < 4; ++cb) {
                    ee0[cb] = 0.60653066f * sigm(w00[cb] + lw0[cb][e]); ee1[cb] = 0.60653066f * sigm(w01[cb] + lw1[cb][e]);
                    const float ic0 = sigm(a00[cb] + ia0[cb][e]), ic1 = sigm(a01[cb] + ia1[cb][e]);
                    const float kkn = kks[cb] * rn;
                    kd0[cb] = k[cb] * (1.f + (ic0 - 1.f) * kac[cb]); kd1[cb] = k[cb] * (1.f + (ic1 - 1.f) * kac[cb]);
                    bon += r[cb] * (kd0[cb] * rk0[cb] + kd1[cb] * rk1[cb]);
                    na[cb] = -kkn; bb0[cb] = kkn * ic0; bb1[cb] = kkn * ic1;
                }
                bon = sum16(bon); if (fr == 0) BONUS[g * 8 + hd] = bon;
                bf16* pr = PR + g * PRV + 256 * hf + cl0;
                *(GAS v2u*)(pr) = ru; *(GAS v2u*)(pr + 512) = vu;
                v2u o;
                o.x = pk2(na[0], na[1]); o.y = pk2(na[2], na[3]); *(GAS v2u*)(pr + 1024) = o;
                o.x = pk2(ee0[0], ee0[1]); o.y = pk2(ee0[2], ee0[3]); *(GAS v2u*)(pr + 1536) = o;
                o.x = pk2(kd0[0], kd0[1]); o.y = pk2(kd0[2], kd0[3]); *(GAS v2u*)(pr + 2048) = o;
                o.x = pk2(bb0[0], bb0[1]); o.y = pk2(bb0[2], bb0[3]); *(GAS v2u*)(pr + 2560) = o;
                o.x = pk2(ee1[0], ee1[1]); o.y = pk2(ee1[2], ee1[3]); *(GAS v2u*)(pr + 3072) = o;
                o.x = pk2(kd1[0], kd1[1]); o.y = pk2(kd1[2], kd1[3]); *(GAS v2u*)(pr + 3584) = o;
                o.x = pk2(bb1[0], bb1[1]); o.y = pk2(bb1[2], bb1[3]); *(GAS v2u*)(pr + 4096) = o;
            }
        } else {
            bf16x8 Af[3];
#pragma unroll
            for (int kb = 0; kb < 3; ++kb) Af[kb] = *(const LAS bf16x8*)(actb + fr * ACT_ST + (4 + kb) * 64 + fq * 16);
            f32x4 gt[4];
#pragma unroll
            for (int cb = 0; cb < 4; ++cb) {
                gt[cb] = __builtin_amdgcn_mfma_f32_16x16x32_bf16(Af[0], W[cb], zero, 0, 0, 0);
                gt[cb] = __builtin_amdgcn_mfma_f32_16x16x32_bf16(Af[1], W[4 + cb], gt[cb], 0, 0, 0); gt[cb] = __builtin_amdgcn_mfma_f32_16x16x32_bf16(Af[2], W[8 + cb], gt[cb], 0, 0, 0);
            }
#pragma unroll
            for (int e = 0; e < 4; ++e) { v2u o; o.x = pk2(gt[0][e], gt[1][e]); o.y = pk2(gt[2][e], gt[3][e]); *(GAS v2u*)(GATE + (size_t)(g0 + 4 * fq + e) * 512 + 256 * hf + cl0) = o; }
        }
        __syncthreads();
    }
}

template <int SH> __device__ __forceinline__ float dpp_shr(float x) { return __int_as_float(__builtin_amdgcn_update_dpp(0, __float_as_int(x), 0x110 + SH, 0xF, 0xF, true)); }
__device__ __forceinline__ int scan_row16(int c, int t, int b, int d) {
    const int st = c * 16 + t; const int seg = (st >= CTXL) ? 1 : 0; const int T = seg ? SEQ : CTXL; const int sl = st - seg * CTXL;
    return (seg ? (M_CTX + b * SEQ) : b * CTXL) + (d ? (T - 1 - sl) : sl);
}
__device__ __forceinline__ v4u scale8(const v4u u, float s) {
    v4u o; o.x = pk2(bflo(u.x) * s, bfhi(u.x) * s); o.y = pk2(bflo(u.y) * s, bfhi(u.y) * s); o.z = pk2(bflo(u.z) * s, bfhi(u.z) * s); o.w = pk2(bflo(u.w) * s, bfhi(u.w) * s); return o;
}
__device__ __forceinline__ bf16x8 pack4z(const f32x4& a) { v4u w; w.x = pk2(a[0], a[1]); w.y = pk2(a[2], a[3]); w.z = 0u; w.w = 0u; return __builtin_bit_cast(bf16x8, w); }
__device__ __forceinline__ bf16x8 tr4z(const LAS unsigned char* p) {
    const v2u t = __builtin_bit_cast(v2u, __builtin_amdgcn_ds_read_tr16_b64_v4i16((LAS v4i16_t*)p)); v4u w; w.x = t.x; w.y = t.y; w.z = 0u; w.w = 0u; return __builtin_bit_cast(bf16x8, w);
}
__device__ __forceinline__ bf16x8 cat44(const v2u a, const v2u b) { v4u w; w.x = a.x; w.y = a.y; w.z = b.x; w.w = b.y; return __builtin_bit_cast(bf16x8, w); }
constexpr int NCH16 = (CTXL + SEQ) / 16;
__device__ __forceinline__ f32x4 mm16(const f32x4& xT_c, const f32x4& y_c, const f32x4& acc) {
    return __builtin_amdgcn_mfma_f32_16x16x32_bf16(pack4z(xT_c), pack4z(y_c), acc, 0, 0, 0);
}
constexpr int RING_FLAGS = 122880;
constexpr int NSLOT = 6;
__device__ __forceinline__ unsigned lds_flag_ld(volatile LAS unsigned* p) { return (unsigned)__builtin_amdgcn_readfirstlane((int)*p); }
__device__ __forceinline__ void ring_wait_full(volatile LAS unsigned* fl, int s, int c) { while (lds_flag_ld(fl + s) != (unsigned)(c + 1)) __builtin_amdgcn_s_sleep(1); asm volatile("" ::: "memory"); }
__device__ __forceinline__ void ring_wait_free(volatile LAS unsigned* fl, int s, int c, int nslot = NSLOT, unsigned ncons = 4u) { const unsigned want = ncons * (unsigned)(c / nslot); while (lds_flag_ld(fl + 8 + s) < want) __builtin_amdgcn_s_sleep(1); asm volatile("" ::: "memory"); }
__device__ __forceinline__ void ring_set_full(volatile LAS unsigned* fl, int s, int c, int lane) { asm volatile("s_waitcnt lgkmcnt(0)" ::: "memory"); if (lane == 0) fl[s] = (unsigned)(c + 1); }
__device__ __forceinline__ void ring_done(volatile LAS unsigned* fl, int s, int lane) { asm volatile("s_waitcnt lgkmcnt(0)" ::: "memory"); if (lane == 0) __hip_atomic_fetch_add((LAS unsigned*)(fl + 8 + s), 1u, __ATOMIC_RELAXED, __HIP_MEMORY_SCOPE_WORKGROUP); }

constexpr int RST = 144, RIMG = 16 * RST;
constexpr int RW_SLOT = 18432;
__device__ __forceinline__ void rwkv_block(Frame& F, int unit, const bf16* PR, bf16* YRW) {
    const int d = unit & 1, h = (unit >> 1) & 7, b = unit >> 4;
    const int lane = F.lane, fr = lane & 15, fq = lane >> 4, tq = (lane & 15) >> 2, tp = lane & 3;
    volatile LAS unsigned* fl = (volatile LAS unsigned*)(F.lds + RING_FLAGS);
    __syncthreads();
    if (F.tid < 16) fl[F.tid] = 0u;
    __syncthreads();
    if (F.wave >= 4) {
        const int p = F.wave - 4;
        const int ve = (3 + 3 * d) * 512, vb = (5 + 3 * d) * 512, vk = (4 + 3 * d) * 512;
        bf16x8 Ltri; { v4u w; w.x = ((4 * fq + 0 <= fr) ? 0x3F80u : 0u) | ((4 * fq + 1 <= fr) ? 0x3F800000u : 0u); w.y = ((4 * fq + 2 <= fr) ? 0x3F80u : 0u) | ((4 * fq + 3 <= fr) ? 0x3F800000u : 0u); w.z = 0u; w.w = 0u; Ltri = __builtin_bit_cast(bf16x8, w); }
        v4u rE[2], rA[2], rB[2], rK[2], rR[2], rV[2];
#define RW_LOAD(c_) do { \
        _Pragma("unroll") for (int i = 0; i < 2; ++i) { const int id = lane + 64 * i; const bf16* src = PR + (size_t)scan_row16((c_), id >> 3, b, d) * PRV + h * 64 + (id & 7) * 8; \
            rE[i] = *(const GAS v4u*)(src + ve); rA[i] = *(const GAS v4u*)(src + 1024); rB[i] = *(const GAS v4u*)(src + vb); rK[i] = *(const GAS v4u*)(src + vk); rR[i] = *(const GAS v4u*)(src); rV[i] = *(const GAS v4u*)(src + 512); } } while (0)
        RW_LOAD(p);
        for (int c = p; c < NCH16; c += 4) {
            const int s = c % NSLOT;
            LAS unsigned char* sb = F.lds + s * RW_SLOT;
            LAS unsigned char* RE = sb; LAS unsigned char* RA = sb + RIMG; LAS unsigned char* RB = sb + 2 * RIMG; LAS unsigned char* RK = sb + 3 * RIMG; LAS unsigned char* RR = sb + 4 * RIMG;
            LAS unsigned char* RV = sb + 5 * RIMG; LAS unsigned char* FRG = sb + 6 * RIMG; LAS float* GC = (LAS float*)(sb + 6 * RIMG + 4096);
            ring_wait_free(fl, s, c);
#pragma unroll
            for (int i = 0; i < 2; ++i) { const int id = lane + 64 * i; const int o = (id >> 3) * RST + (id & 7) * 16;
                *(LAS v4u*)(RE + o) = rE[i]; *(LAS v4u*)(RA + o) = rA[i]; *(LAS v4u*)(RB + o) = rB[i]; *(LAS v4u*)(RK + o) = rK[i]; *(LAS v4u*)(RR + o) = rR[i]; *(LAS v4u*)(RV + o) = rV[i]; }
            if (c + 4 < NCH16) RW_LOAD(c + 4);
            asm volatile("s_waitcnt lgkmcnt(0)" ::: "memory");
#pragma unroll
            for (int jb = 0; jb < 4; ++jb) {
                const int tro = (4 * fq + tq) * RST + (16 * jb + 4 * tp) * 2;
                const v2u eu = __builtin_bit_cast(v2u, __builtin_amdgcn_ds_read_tr16_b64_v4i16((LAS v4i16_t*)(RE + tro)));
                const v2u au = __builtin_bit_cast(v2u, __builtin_amdgcn_ds_read_tr16_b64_v4i16((LAS v4i16_t*)(RA + tro)));
                const v2u bu = __builtin_bit_cast(v2u, __builtin_amdgcn_ds_read_tr16_b64_v4i16((LAS v4i16_t*)(RB + tro)));
                const v2u ku = __builtin_bit_cast(v2u, __builtin_amdgcn_ds_read_tr16_b64_v4i16((LAS v4i16_t*)(RK + tro)));
                const v2u ru = __builtin_bit_cast(v2u, __builtin_amdgcn_ds_read_tr16_b64_v4i16((LAS v4i16_t*)(RR + tro)));
                v4u ew; ew.x = eu.x; ew.y = eu.y; ew.z = 0u; ew.w = 0u;
                const f32x4 cum = __builtin_amdgcn_mfma_f32_16x16x32_bf16(Ltri, __builtin_bit_cast(bf16x8, ew), (f32x4){0.f, 0.f, 0.f, 0.f}, 0, 0, 0);
                const float ev[4] = {bflo(eu.x), bfhi(eu.x), bflo(eu.y), bfhi(eu.y)}, av[4] = {bflo(au.x), bfhi(au.x), bflo(au.y), bfhi(au.y)}, bv[4] = {bflo(bu.x), bfhi(bu.x), bflo(bu.y), bfhi(bu.y)};
                const float kv[4] = {bflo(ku.x), bfhi(ku.x), bflo(ku.y), bfhi(ku.y)}, rv[4] = {bflo(ru.x), bfhi(ru.x), bflo(ru.y), bfhi(ru.y)};
#pragma unroll
                for (int e = 0; e < 4; ++e) {
                    const float G = __expf(-cum[e]), Gi = __expf(cum[e]), Gx = __expf(ev[e] - cum[e]);
                    const int o = (4 * fq + e) * RST + (16 * jb + fr) * 2;
                    const unsigned ab = pk2(av[e] * Gx, bv[e] * Gi), kr = pk2(kv[e] * Gi, rv[e] * G);
                    *(LAS unsigned short*)(RA + o) = (unsigned short)ab; *(LAS unsigned short*)(RB + o) = (unsigned short)(ab >> 16);
                    *(LAS unsigned short*)(RK + o) = (unsigned short)kr; *(LAS unsigned short*)(RR + o) = (unsigned short)(kr >> 16);
                    if (e == 3 && fq == 3) GC[16 * jb + fr] = G;
                }
            }
            asm volatile("s_waitcnt lgkmcnt(0)" ::: "memory");
            f32x4 aba = {0.f, 0.f, 0.f, 0.f}, aka = aba, abr = aba, akr = aba, abaT = aba;
#pragma unroll
            for (int kb = 0; kb < 2; ++kb) {
                const int o = fr * RST + kb * 64 + fq * 16;
                const bf16x8 fb = *(const LAS bf16x8*)(RB + o), fk = *(const LAS bf16x8*)(RK + o), fa = *(const LAS bf16x8*)(RA + o), frr = *(const LAS bf16x8*)(RR + o);
                aba = __builtin_amdgcn_mfma_f32_16x16x32_bf16(fb, fa, aba, 0, 0, 0); aka = __builtin_amdgcn_mfma_f32_16x16x32_bf16(fk, fa, aka, 0, 0, 0);
                abr = __builtin_amdgcn_mfma_f32_16x16x32_bf16(fb, frr, abr, 0, 0, 0); akr = __builtin_amdgcn_mfma_f32_16x16x32_bf16(fk, frr, akr, 0, 0, 0);
                abaT = __builtin_amdgcn_mfma_f32_16x16x32_bf16(fa, fb, abaT, 0, 0, 0);
            }
            f32x4 idc;
#pragma unroll
            for (int e = 0; e < 4; ++e) { const int row = 4 * fq + e;
                aba[e] = (row < fr) ? aba[e] : 0.f; aka[e] = (row < fr) ? aka[e] : 0.f; abr[e] = (row <= fr) ? abr[e] : 0.f; akr[e] = (row <= fr) ? akr[e] : 0.f;
                abaT[e] = (fr < row) ? abaT[e] : 0.f; idc[e] = (row == fr) ? 1.f : 0.f; }
            f32x4 t_c = idc + aba, t_T = idc + abaT;
            f32x4 p_c = mm16(abaT, aba, (f32x4){0.f, 0.f, 0.f, 0.f}), p_T = mm16(aba, abaT, (f32x4){0.f, 0.f, 0.f, 0.f});
            { const f32x4 n_c = mm16(t_T, p_c, t_c), n_T = mm16(p_c, t_T, t_T); t_c = n_c; t_T = n_T; }
            { const f32x4 q_c = mm16(p_T, p_c, (f32x4){0.f, 0.f, 0.f, 0.f}), q_T = mm16(p_c, p_T, (f32x4){0.f, 0.f, 0.f, 0.f}); p_c = q_c; p_T = q_T; }
            { const f32x4 n_c = mm16(t_T, p_c, t_c), n_T = mm16(p_c, t_T, t_T); t_c = n_c; t_T = n_T; }
            { const f32x4 q_c = mm16(p_T, p_c, (f32x4){0.f, 0.f, 0.f, 0.f}); p_c = q_c; }
            const f32x4 tm_c = mm16(t_T, p_c, t_c);
            *(LAS bf16x8*)(FRG + lane * 16) = pack4z(tm_c); *(LAS bf16x8*)(FRG + 1024 + lane * 16) = pack4z(aka);
            *(LAS bf16x8*)(FRG + 2048 + lane * 16) = pack4z(abr); *(LAS bf16x8*)(FRG + 3072 + lane * 16) = pack4z(akr);
            ring_set_full(fl, s, c, lane);
        }
#undef RW_LOAD
    } else {
        const int q = F.wave;
        bf16* yout = YRW + (size_t)d * M_ALL * 512 + h * 64 + 16 * q;
        f32x4 T[4];
#pragma unroll
        for (int jb = 0; jb < 4; ++jb) T[jb] = (f32x4){0.f, 0.f, 0.f, 0.f};
        for (int c = 0; c < NCH16; ++c) {
            const int s = c % NSLOT;
            LAS unsigned char* sb = F.lds + s * RW_SLOT;
            LAS unsigned char* RA = sb + RIMG; LAS unsigned char* RB = sb + 2 * RIMG; LAS unsigned char* RK = sb + 3 * RIMG; LAS unsigned char* RR = sb + 4 * RIMG;
            LAS unsigned char* RV = sb + 5 * RIMG; LAS unsigned char* FRG = sb + 6 * RIMG; LAS float* GC = (LAS float*)(sb + 6 * RIMG + 4096);
            ring_wait_full(fl, s, c);
            const bf16x8 tmA = *(const LAS bf16x8*)(FRG + lane * 16), akaA = *(const LAS bf16x8*)(FRG + 1024 + lane * 16), abrA = *(const LAS bf16x8*)(FRG + 2048 + lane * 16), akrA = *(const LAS bf16x8*)(FRG + 3072 + lane * 16);
            const bf16x8 Vf = tr4z(RV + (4 * fq + tq) * RST + (16 * q + 4 * tp) * 2);
            f32x4 x = {0.f, 0.f, 0.f, 0.f}, y = {0.f, 0.f, 0.f, 0.f};
#pragma unroll
            for (int jp = 0; jp < 2; ++jp) {
                const int o = fr * RST + (32 * jp + 4 * fq) * 2;
                const bf16x8 tf = pack8(T[2 * jp], T[2 * jp + 1]);
                x = __builtin_amdgcn_mfma_f32_16x16x32_bf16(cat44(*(const LAS v2u*)(RA + o), *(const LAS v2u*)(RA + o + 32)), tf, x, 0, 0, 0);
                y = __builtin_amdgcn_mfma_f32_16x16x32_bf16(cat44(*(const LAS v2u*)(RR + o), *(const LAS v2u*)(RR + o + 32)), tf, y, 0, 0, 0);
            }
            x = __builtin_amdgcn_mfma_f32_16x16x32_bf16(akaA, Vf, x, 0, 0, 0);
            const f32x4 ut = __builtin_amdgcn_mfma_f32_16x16x32_bf16(tmA, pack4z(x), (f32x4){0.f, 0.f, 0.f, 0.f}, 0, 0, 0);
            y = __builtin_amdgcn_mfma_f32_16x16x32_bf16(abrA, pack4z(ut), y, 0, 0, 0);
            y = __builtin_amdgcn_mfma_f32_16x16x32_bf16(akrA, Vf, y, 0, 0, 0);
            bf16x8 UV; { const v4u vw = __builtin_bit_cast(v4u, Vf); v4u w; w.x = pk2(ut[0], ut[1]); w.y = pk2(ut[2], ut[3]); w.z = vw.x; w.w = vw.y; UV = __builtin_bit_cast(bf16x8, w); }
#pragma unroll
            for (int jb = 0; jb < 4; ++jb) {
                const int tro = (4 * fq + tq) * RST + (16 * jb + 4 * tp) * 2;
                const v2u bt = __builtin_bit_cast(v2u, __builtin_amdgcn_ds_read_tr16_b64_v4i16((LAS v4i16_t*)(RB + tro))), kt = __builtin_bit_cast(v2u, __builtin_amdgcn_ds_read_tr16_b64_v4i16((LAS v4i16_t*)(RK + tro)));
                const f32x4 gc = *(const LAS f32x4*)(GC + 16 * jb + 4 * fq);
                T[jb] = __builtin_amdgcn_mfma_f32_16x16x32_bf16(cat44(bt, kt), UV, T[jb], 0, 0, 0); T[jb] = T[jb] * gc;
            }
            ring_done(fl, s, lane);
#pragma unroll
            for (int e = 0; e < 4; ++e) yout[(size_t)scan_row16(c, 4 * fq + e, b, d) * 512 + fr] = (bf16)f2bf(y[e]);
        }
    }
}

constexpr int MST = 272, MIMG = 16 * MST;
constexpr int MB_NSLOT = 5;
constexpr int MB_SLOT = 21504;
__device__ __forceinline__ void mamba_block(Frame& F, int unit, const bf16* PM, const float* DT, const float* a_log, bf16* YMB) {
    const int d = unit & 1, h = (unit >> 1) & 7, b = unit >> 4, grp = h >> 2;
    const int lane = F.lane, fr = lane & 15, fq = lane >> 4, tq = (lane & 15) >> 2, tp = lane & 3;
    volatile LAS unsigned* fl = (volatile LAS unsigned*)(F.lds + RING_FLAGS);
    __syncthreads();
    if (F.tid < 16) fl[F.tid] = 0u;
    __syncthreads();
    if (F.wave >= 4) {
        const int p = F.wave - 4;
        const float a_neg = -__expf(a_log[d * 8 + h]);
        v4u rB[4], rC[4], rX[2]; float rdt;
#define MB_LOAD(c_) do { \
        _Pragma("unroll") for (int i = 0; i < 4; ++i) { const int t = (lane >> 4) + 4 * i; const bf16* src = PM + (size_t)scan_row16((c_), t, b, d) * 1024 + 512 + grp * 128 + (lane & 15) * 8; rB[i] = *(const GAS v4u*)src; rC[i] = *(const GAS v4u*)(src + 256); } \
        _Pragma("unroll") for (int i = 0; i < 2; ++i) { const int id = lane + 64 * i; rX[i] = *(const GAS v4u*)(PM + (size_t)scan_row16((c_), id >> 3, b, d) * 1024 + h * 64 + (id & 7) * 8); } \
        rdt = DT[(size_t)scan_row16((c_), lane & 15, b, d) * 16 + d * 8 + h]; } while (0)
        MB_LOAD(p);
        for (int c = p; c < NCH16; c += 4) {
            const int s = c % MB_NSLOT;
            LAS unsigned char* sb = F.lds + s * MB_SLOT;
            LAS unsigned char* BR = sb; LAS unsigned char* CR = sb + MIMG; LAS unsigned char* RT = sb + 2 * MIMG; LAS unsigned char* KH = sb + 3 * MIMG; LAS unsigned char* VX = sb + 4 * MIMG;
            LAS unsigned char* FRG = sb + 4 * MIMG + RIMG; LAS float* scal = (LAS float*)(sb + 4 * MIMG + RIMG + 1024);
            ring_wait_free(fl, s, c, MB_NSLOT);
            float cs = rdt * a_neg;
            cs += dpp_shr<1>(cs); cs += dpp_shr<2>(cs); cs += dpp_shr<4>(cs); cs += dpp_shr<8>(cs);
            const float cse = __int_as_float(__builtin_amdgcn_readlane(__float_as_int(cs), 15));
            if (lane < 16) { scal[16 + lane] = cs; scal[32 + lane] = __expf(cs); scal[48 + lane] = rdt; scal[64 + lane] = __expf(cse - cs); }
            if (lane == 0) scal[0] = __expf(cse);
            asm volatile("s_waitcnt lgkmcnt(0)" ::: "memory");
#pragma unroll
            for (int i = 0; i < 4; ++i) { const int t = (lane >> 4) + 4 * i; const float sk = scal[64 + t], sr = scal[32 + t]; const int o = t * MST + (lane & 15) * 16;
                *(LAS v4u*)(BR + o) = rB[i]; *(LAS v4u*)(CR + o) = rC[i]; *(LAS v4u*)(KH + o) = scale8(rB[i], sk); *(LAS v4u*)(RT + o) = scale8(rC[i], sr); }
#pragma unroll
            for (int i = 0; i < 2; ++i) { const int id = lane + 64 * i; const int t = id >> 3; *(LAS v4u*)(VX + t * RST + (id & 7) * 16) = scale8(rX[i], scal[48 + t]); }
            if (c + 4 < NCH16) MB_LOAD(c + 4);
            asm volatile("s_waitcnt lgkmcnt(0)" ::: "memory");
            f32x4 akr = {0.f, 0.f, 0.f, 0.f};
#pragma unroll
            for (int kb = 0; kb < 4; ++kb) akr = __builtin_amdgcn_mfma_f32_16x16x32_bf16(*(const LAS bf16x8*)(BR + fr * MST + kb * 64 + fq * 16), *(const LAS bf16x8*)(CR + fr * MST + kb * 64 + fq * 16), akr, 0, 0, 0);
            const float cst = scal[16 + fr]; const f32x4 css = *(const LAS f32x4*)(scal + 16 + 4 * fq);
#pragma unroll
            for (int e = 0; e < 4; ++e) akr[e] = (4 * fq + e <= fr) ? akr[e] * __expf(cst - css[e]) : 0.f;
            *(LAS bf16x8*)(FRG + lane * 16) = pack4z(akr);
            ring_set_full(fl, s, c, lane);
        }
#undef MB_LOAD
    } else {
        const int q = F.wave;
        bf16* yout = YMB + (size_t)d * M_ALL * 512 + h * 64 + 16 * q;
        f32x4 T[8];
#pragma unroll
        for (int jb = 0; jb < 8; ++jb) T[jb] = (f32x4){0.f, 0.f, 0.f, 0.f};
        for (int c = 0; c < NCH16; ++c) {
            const int s = c % MB_NSLOT;
            LAS unsigned char* sb = F.lds + s * MB_SLOT;
            LAS unsigned char* RT = sb + 2 * MIMG; LAS unsigned char* KH = sb + 3 * MIMG; LAS unsigned char* VX = sb + 4 * MIMG;
            LAS unsigned char* FRG = sb + 4 * MIMG + RIMG; LAS float* scal = (LAS float*)(sb + 4 * MIMG + RIMG + 1024);
            ring_wait_full(fl, s, c);
            const bf16x8 akrA = *(const LAS bf16x8*)(FRG + lane * 16); const float gC = scal[0];
            const bf16x8 Vf = tr4z(VX + (4 * fq + tq) * RST + (16 * q + 4 * tp) * 2);
            f32x4 y = {0.f, 0.f, 0.f, 0.f};
#pragma unroll
            for (int jp = 0; jp < 4; ++jp) {
                const LAS unsigned char* rp = RT + fr * MST + (32 * jp + 4 * fq) * 2;
                y = __builtin_amdgcn_mfma_f32_16x16x32_bf16(cat44(*(const LAS v2u*)rp, *(const LAS v2u*)(rp + 32)), pack8(T[2 * jp], T[2 * jp + 1]), y, 0, 0, 0);
            }
            y = __builtin_amdgcn_mfma_f32_16x16x32_bf16(akrA, Vf, y, 0, 0, 0);
#ifdef MB_CONS2X
            { f32x4 yd = {0.f, 0.f, 0.f, 0.f};
#pragma unroll
              for (int jp = 0; jp < 4; ++jp) { const LAS unsigned char* rp = RT + fr * MST + (32 * jp + 4 * fq) * 2 + 8;
                  yd = __builtin_amdgcn_mfma_f32_16x16x32_bf16(cat44(*(const LAS v2u*)rp, *(const LAS v2u*)(rp + 32)), pack8(T[2 * jp] * 1.0001f, T[2 * jp + 1] * 1.0001f), yd, 0, 0, 0); }
              yd = __builtin_amdgcn_mfma_f32_16x16x32_bf16(akrA, Vf, yd, 0, 0, 0);
              asm volatile("" :: "v"(yd)); }
#endif
#pragma unroll
            for (int jb = 0; jb < 8; ++jb) T[jb] = __builtin_amdgcn_mfma_f32_16x16x32_bf16(tr4z(KH + (4 * fq + tq) * MST + (16 * jb + 4 * tp) * 2), Vf, T[jb] * gC, 0, 0, 0);
            ring_done(fl, s, lane);
#pragma unroll
            for (int e = 0; e < 4; ++e) yout[(size_t)scan_row16(c, 4 * fq + e, b, d) * 512 + fr] = (bf16)f2bf(y[e]);
        }
    }
}

struct FinIn { const float *gn_w, *gn_b, *mb_d, *mb_norm_w; };
__device__ __forceinline__ void finish_phase(Frame& F, const FinIn& P, const bf16* YRW, const bf16* YMB, const bf16* PR, const bf16* PM, const float* BONUS, const bf16* GATE, const bf16* ZG, bf16* A) {
    const int gw = F.bid * NWAVES + F.wave, NGW = F.G * NWAVES; const int c0 = F.lane * 8, head = F.lane >> 3;
    float gnw[8], gnb[8], nw[8];
#pragma unroll
    for (int i = 0; i < 8; ++i) { gnw[i] = P.gn_w[c0 + i]; gnb[i] = P.gn_b[c0 + i]; nw[i] = P.mb_norm_w[c0 + i]; }
    const float dd = P.mb_d[head];
    struct FinIn9 { v4u y0, y1, vv, gg, m0, m1, xx, zz; float bon; };
    FinIn9 cur, nxt;
#define FIN_FETCH(R_, g_) do { const size_t gs_ = (size_t)(g_); \
        R_.y0 = *(const GAS v4u*)(YRW + gs_ * 512 + c0); R_.y1 = *(const GAS v4u*)(YRW + (size_t)M_ALL * 512 + gs_ * 512 + c0); R_.vv = *(const GAS v4u*)(PR + gs_ * PRV + 512 + c0); R_.gg = *(const GAS v4u*)(GATE + gs_ * 512 + c0); \
        R_.m0 = *(const GAS v4u*)(YMB + gs_ * 512 + c0); R_.m1 = *(const GAS v4u*)(YMB + (size_t)M_ALL * 512 + gs_ * 512 + c0); R_.xx = *(const GAS v4u*)(PM + gs_ * 1024 + c0); R_.zz = *(const GAS v4u*)(ZG + gs_ * 512 + c0); \
        R_.bon = BONUS[gs_ * 8 + head]; } while (0)
    if (gw < M_ALL) FIN_FETCH(cur, gw);
    for (int g = gw; g < M_ALL; g += NGW) {
        const size_t gs = (size_t)g;
        if (g + NGW < M_ALL) FIN_FETCH(nxt, g + NGW);
        const v4u y0 = cur.y0, y1 = cur.y1, vv = cur.vv, gg = cur.gg, m0 = cur.m0, m1 = cur.m1, xx = cur.xx, zz = cur.zz; const float bon = cur.bon;
        cur = nxt;
        float y[8], vf[8], gf[8];
#pragma unroll
        for (int i = 0; i < 4; ++i) { y[2 * i] = bflo(y0[i]) + bflo(y1[i]); y[2 * i + 1] = bfhi(y0[i]) + bfhi(y1[i]); vf[2 * i] = bflo(vv[i]); vf[2 * i + 1] = bfhi(vv[i]); gf[2 * i] = bflo(gg[i]); gf[2 * i + 1] = bfhi(gg[i]); }
        float s = 0.f;
#pragma unroll
        for (int i = 0; i < 8; ++i) s += y[i];
        s = sum8(s);
        const float mu = s * (1.f / 64.f); float q = 0.f;
#pragma unroll
        for (int i = 0; i < 8; ++i) { y[i] -= mu; q += y[i] * y[i]; }
        q = sum8(q);
        const float rstd = rsqrtf(q * (1.f / 64.f) + 64e-5f);
        float o[8];
#pragma unroll
        for (int i = 0; i < 8; ++i) o[i] = ((y[i] * rstd) * gnw[i] + gnb[i] + bon * vf[i]) * gf[i];
        v4u w; w.x = pk2(o[0], o[1]); w.y = pk2(o[2], o[3]); w.z = pk2(o[4], o[5]); w.w = pk2(o[6], o[7]);
        *(GAS v4u*)(A + gs * 1024 + c0) = w;
        float ym[8]; float ss = 0.f;
#pragma unroll
        for (int i = 0; i < 4; ++i) {
            const float z0 = bflo(zz[i]), z1 = bfhi(zz[i]);
            ym[2 * i] = (bflo(m0[i]) + bflo(m1[i]) + dd * bflo(xx[i])) * (z0 * sigm(z0)); ym[2 * i + 1] = (bfhi(m0[i]) + bfhi(m1[i]) + dd * bfhi(xx[i])) * (z1 * sigm(z1));
            ss += ym[2 * i] * ym[2 * i] + ym[2 * i + 1] * ym[2 * i + 1];
        }
        ss = half_sum(ss, F.lane);
        const float rr = rsqrtf(ss * (1.f / 256.f) + 1e-6f);
        v4u w2; w2.x = pk2(ym[0] * rr * nw[0], ym[1] * rr * nw[1]); w2.y = pk2(ym[2] * rr * nw[2], ym[3] * rr * nw[3]); w2.z = pk2(ym[4] * rr * nw[4], ym[5] * rr * nw[5]); w2.w = pk2(ym[6] * rr * nw[6], ym[7] * rr * nw[7]);
        *(GAS v4u*)(A + gs * 1024 + 512 + c0) = w2;
    }
#undef FIN_FETCH
}

__device__ __forceinline__ bf16x8 tr2(const LAS unsigned char* p0, const LAS unsigned char* p1) {
    const s16x4 t0 = __builtin_bit_cast(s16x4, __builtin_amdgcn_ds_read_tr16_b64_v4i16((LAS v4i16_t*)p0));
    const s16x4 t1 = __builtin_bit_cast(s16x4, __builtin_amdgcn_ds_read_tr16_b64_v4i16((LAS v4i16_t*)p1));
    bf16x8 r; r[0] = t0[0]; r[1] = t0[1]; r[2] = t0[2]; r[3] = t0[3]; r[4] = t1[0]; r[5] = t1[1]; r[6] = t1[2]; r[7] = t1[3]; return r;
}
constexpr int KST = 144;
__device__ __forceinline__ void attn_phase(Frame& F, const bf16* Q, const bf16* K, const bf16* V, const float* rpb, bf16* O) {
    LAS unsigned char* ctxK = F.lds; LAS unsigned char* ctxV = F.lds + 36864; LAS unsigned char* vst = F.lds + 73728 + F.wave * 4608; LAS float* rp = (LAS float*)(F.lds + 110592);
    const int lane = F.lane, fr = lane & 15, fq = lane >> 4, tq = (lane & 15) >> 2, tp = lane & 3;
#ifndef ATT_REPS
#define ATT_REPS 1
#endif
    for (int u_ = F.bid; u_ < 256 * ATT_REPS; u_ += F.G) {
        const int u = u_ & 255; const int bh = u >> 1, half = u & 1, b = bh >> 4, h = bh & 15;
        __syncthreads();
        {
            const int key = F.tid >> 1, hf = F.tid & 1; const size_t src = (size_t)(b * CTXL + key) * D + h * 64 + hf * 32;
#pragma unroll
            for (int i = 0; i < 4; ++i) { *(LAS v4u*)(ctxK + key * KST + hf * 64 + 16 * i) = *(const GAS v4u*)(K + src + 8 * i); *(LAS v4u*)(ctxV + key * KST + hf * 64 + 16 * i) = *(const GAS v4u*)(V + src + 8 * i); }
            if (F.tid < 465) rp[F.tid] = rpb[h * 465 + F.tid] * 1.4426950408889634f;
        }
        __syncthreads();
        for (int it = 0; it < 8; ++it) {
            const int r = 2 * (half * 8 + it) + (F.wave >> 2), j = F.wave & 3;
            const int rs = min(max(r - 4, 0), 24); const int kb = (j == 0) ? 0 : (j == 1) ? 8 : (j == 2) ? 24 : 32;
            const int qc = 16 * j + fr, wsq = min(max(qc - 8, 0), 48);
            const unsigned latbase = (unsigned)(M_CTX + b * SEQ);
            bf16x8 qf[2];
            { const bf16* qp = Q + (unsigned)((latbase + r * 64 + qc) * D + h * 64 + 8 * fq); qf[0] = *(const GAS bf16x8*)qp; qf[1] = *(const GAS bf16x8*)(qp + 32); }
            const int cv = kb + 4 * fq - wsq, cc2 = kb + 4 * fq - qc + 15;
            f32x4 sl[8][2], sc[16];
            const unsigned koff = (unsigned)((latbase + rs * 64 + kb + fr) * D + h * 64 + 8 * fq);
            const unsigned voff = (unsigned)((latbase + rs * 64 + kb + (lane >> 1)) * D + h * 64 + (lane & 1) * 32);
            bf16x8 kc[4], kn[4];
#pragma unroll
            for (int x = 0; x < 4; ++x) kc[x] = *(const GAS bf16x8*)(K + koff + (x >> 1) * 16 * D + (x & 1) * 32);
#pragma unroll
            for (int i = 0; i < 8; ++i) {
                const int brow = (rs + i - r + 7) * 31;
                if (i < 7) {
#pragma unroll
                    for (int x = 0; x < 4; ++x) kn[x] = *(const GAS bf16x8*)(K + koff + (unsigned)((i + 1) * 64 * D) + (x >> 1) * 16 * D + (x & 1) * 32);
                }
#pragma unroll
                for (int blk = 0; blk < 2; ++blk) {
                    f32x4 s = {0.f, 0.f, 0.f, 0.f};
                    s = __builtin_amdgcn_mfma_f32_16x16x32_bf16(kc[2 * blk], qf[0], s, 0, 0, 0);
                    s = __builtin_amdgcn_mfma_f32_16x16x32_bf16(kc[2 * blk + 1], qf[1], s, 0, 0, 0);
#pragma unroll
                    for (int e = 0; e < 4; ++e) s[e] = ((unsigned)(cv + 16 * blk + e) < 16u) ? (s[e] + rp[brow + min(max(cc2 + 16 * blk + e, 0), 30)]) : -INFINITY;
                    sl[i][blk] = s;
                }
#pragma unroll
                for (int x = 0; x < 4; ++x) kc[x] = kn[x];
            }
#pragma unroll
            for (int cb = 0; cb < 16; ++cb) {
                const LAS unsigned char* kp = ctxK + (16 * cb + fr) * KST + fq * 16;
                const bf16x8 k0 = *(const LAS bf16x8*)kp, k1 = *(const LAS bf16x8*)(kp + 64);
                f32x4 s = {0.f, 0.f, 0.f, 0.f};
                s = __builtin_amdgcn_mfma_f32_16x16x32_bf16(k0, qf[0], s, 0, 0, 0);
                s = __builtin_amdgcn_mfma_f32_16x16x32_bf16(k1, qf[1], s, 0, 0, 0);
                sc[cb] = s;
            }
            v4u vr[4];
#pragma unroll
            for (int x = 0; x < 4; ++x) vr[x] = *(const GAS v4u*)(V + voff + 8 * x);
            float m = -INFINITY;
#pragma unroll
            for (int i = 0; i < 8; ++i)
#pragma unroll
                for (int blk = 0; blk < 2; ++blk)
#pragma unroll
                    for (int e = 0; e < 4; ++e) m = fmaxf(m, sl[i][blk][e]);
#pragma unroll
            for (int cb = 0; cb < 16; ++cb)
#pragma unroll
                for (int e = 0; e < 4; ++e) m = fmaxf(m, sc[cb][e]);
            m = fmaxf(m, __shfl_xor(m, 16)); m = fmaxf(m, __shfl_xor(m, 32));
            float l = 0.f;
#pragma unroll
            for (int i = 0; i < 8; ++i)
#pragma unroll
                for (int blk = 0; blk < 2; ++blk)
#pragma unroll
                    for (int e = 0; e < 4; ++e) { const float p = __builtin_amdgcn_exp2f(sl[i][blk][e] - m); sl[i][blk][e] = p; l += p; }
#pragma unroll
            for (int cb = 0; cb < 16; ++cb)
#pragma unroll
                for (int e = 0; e < 4; ++e) { const float p = __builtin_amdgcn_exp2f(sc[cb][e] - m); sc[cb][e] = p; l += p; }
            l += __shfl_xor(l, 16); l += __shfl_xor(l, 32);
            const float linv = __builtin_amdgcn_rcpf(l);
            f32x4 o[4];
#pragma unroll
            for (int db = 0; db < 4; ++db) o[db] = (f32x4){0.f, 0.f, 0.f, 0.f};
#pragma unroll
            for (int i = 0; i < 8; ++i) {
                { const int key = lane >> 1, hf = lane & 1;
#pragma unroll
                  for (int x = 0; x < 4; ++x) *(LAS v4u*)(vst + key * KST + hf * 64 + 16 * x) = vr[x]; }
                if (i < 7) {
#pragma unroll
                    for (int x = 0; x < 4; ++x) vr[x] = *(const GAS v4u*)(V + voff + (unsigned)((i + 1) * 64 * D) + 8 * x);
                }
                const bf16x8 pa = pack8(sl[i][0], sl[i][1]);
#pragma unroll
                for (int db = 0; db < 4; ++db) {
                    const LAS unsigned char* a0 = vst + (4 * fq + tq) * KST + (db * 16 + 4 * tp) * 2;
                    const bf16x8 vb = tr2(a0, a0 + 16 * KST);
                    o[db] = __builtin_amdgcn_mfma_f32_16x16x32_bf16(pa, vb, o[db], 0, 0, 0);
                }
            }
#pragma unroll
            for (int cc = 0; cc < 8; ++cc) {
                const bf16x8 pa = pack8(sc[2 * cc], sc[2 * cc + 1]);
#pragma unroll
                for (int db = 0; db < 4; ++db) {
                    const LAS unsigned char* a0 = ctxV + (32 * cc + 4 * fq + tq) * KST + (db * 16 + 4 * tp) * 2;
                    const bf16x8 vb = tr2(a0, a0 + 16 * KST);
                    o[db] = __builtin_amdgcn_mfma_f32_16x16x32_bf16(pa, vb, o[db], 0, 0, 0);
                }
            }
#pragma unroll
            for (int e = 0; e < 4; ++e) {
                const float li = __shfl(linv, 4 * fq + e);
                bf16* op = O + (unsigned)((b * SEQ + r * 64 + 16 * j + 4 * fq + e) * D + h * 64 + fr);
#pragma unroll
                for (int db = 0; db < 4; ++db) op[db * 16] = (bf16)f2bf(o[db][e] * li);
            }
        }
    }
}

__device__ __forceinline__ void router_phase(Frame& F, const float* hlat, const float* g, const float* mods_l, const float* router_w, const float* router_b, bf16* A4, unsigned* tokinfo, gu32* cnt) {
    LAS int* se = (LAS int*)F.lds;
    LAS float* sg = (LAS float*)(F.lds + 512);
    LAS int* srow = (LAS int*)(F.lds + 1024);
    LAS unsigned* spos = (LAS unsigned*)(F.lds + 1280);
    const int gw = F.bid * NWAVES + F.wave, NGW = F.G * NWAVES;
    const int nbatch = (M_LAT + NGW * 8 - 1) / (NGW * 8);
    LAS float* srw = (LAS float*)(F.lds + 2048);
    __syncthreads();
    for (int i = F.tid; i < 2048; i += NTHR) ((LAS f32x4*)srw)[i] = ((const GAS f32x4*)router_w)[i];
    f32x4 gg[4];
#pragma unroll
    for (int j = 0; j < 4; ++j) gg[j] = ((const GAS f32x4*)g)[F.lane + 64 * j];
    RowIn cur, nxt;
#define RT_FETCH(R_, r_) do { const float* mp_ = mods_l + ((r_) >> 11) * 6144; row_fetch(R_, hlat + (size_t)(r_) * D, mp_ + 3072, mp_ + 4096, F.lane); } while (0)
    if (gw < M_LAT) RT_FETCH(cur, gw);
    for (int bt = 0; bt < nbatch; ++bt) {
        __syncthreads();
#pragma unroll 1
        for (int k = 0; k < 8; ++k) {
            const int r = gw + (bt * 8 + k) * NGW, slot = F.wave * 8 + k;
            if (r >= M_LAT) { if (F.lane == 0) { se[2 * slot] = -1; se[2 * slot + 1] = -1; srow[slot] = 0; } continue; }
            if (r + NGW < M_LAT) RT_FETCH(nxt, r + NGW);
            f32x4 a[4]; row_finish(cur, gg, A4 + (size_t)r * D, F.lane, a);
            cur = nxt;
            float lg[8];
#pragma unroll
            for (int e = 0; e < 8; ++e) lg[e] = 0.f;
#pragma unroll
            for (int j = 0; j < 4; ++j)
#pragma unroll
                for (int x = 0; x < 4; ++x) { const LAS float* rw = srw + ((F.lane + 64 * j) * 4 + x) * 8; const f32x4 w0 = *(const LAS f32x4*)rw, w1 = *(const LAS f32x4*)(rw + 4); const float av = a[j][x];
#pragma unroll
                    for (int e = 0; e < 4; ++e) { lg[e] += av * w0[e]; lg[4 + e] += av * w1[e]; } }
#pragma unroll
            for (int e = 0; e < 8; ++e) lg[e] = wave_sum(lg[e]) + router_b[e];
            int e0 = 0; float v0 = lg[0];
#pragma unroll
            for (int e = 1; e < 8; ++e) if (lg[e] > v0) { v0 = lg[e]; e0 = e; }
            int e1 = -1; float v1 = -INFINITY;
#pragma unroll
            for (int e = 0; e < 8; ++e) if (e != e0 && lg[e] > v1) { v1 = lg[e]; e1 = e; }
            const float g0 = 1.f / (1.f + __expf(v1 - v0)), g1 = 1.f - g0;
            if (F.lane == 0) { se[2 * slot] = e0; se[2 * slot + 1] = e1; sg[2 * slot] = g0; sg[2 * slot + 1] = g1; srow[slot] = r; }
        }
        __syncthreads();
        if (F.wave == 0) {
            const int l = F.lane; const int ea = se[l], eb = se[64 + l];
            const unsigned long long below = (l == 0) ? 0ull : (~0ull >> (64 - l));
            unsigned ra = 0u, rb = 0u, tot = 0u;
#pragma unroll
            for (int e = 0; e < 8; ++e) {
                const unsigned long long ma = __ballot(ea == e), mb = __ballot(eb == e);
                const unsigned ca = (unsigned)__popcll(ma), cb = (unsigned)__popcll(mb);
                if (ea == e) ra = (unsigned)__popcll(ma & below);
                if (eb == e) rb = ca + (unsigned)__popcll(mb & below);
                if (l == e) tot = ca + cb;
            }
            unsigned base = 0u;
            if (l < 8 && tot) base = __hip_atomic_fetch_add(cnt + 64 * l, tot, RLX_AGENT);
            unsigned ba = 0u, bb = 0u;
#pragma unroll
            for (int e = 0; e < 8; ++e) { const unsigned be = (unsigned)__builtin_amdgcn_readlane((int)base, e); if (ea == e) ba = be; if (eb == e) bb = be; }
            spos[l] = ba + ra; spos[64 + l] = bb + rb;
            asm volatile("s_waitcnt lgkmcnt(0)" ::: "memory");
            if (se[2 * l] >= 0) {
                v4u t0; t0.x = (unsigned)se[2 * l]; t0.y = spos[2 * l]; t0.z = __float_as_uint(sg[2 * l]); t0.w = (unsigned)se[2 * l + 1];
                v4u t1; t1.x = spos[2 * l + 1]; t1.y = __float_as_uint(sg[2 * l + 1]); t1.z = 0u; t1.w = 0u;
                const size_t row = (size_t)srow[l];
                *(GAS v4u*)(tokinfo + row * 8) = t0; *(GAS v4u*)(tokinfo + row * 8 + 4) = t1;
            }
        }
    }
}
#undef RT_FETCH
__device__ __forceinline__ void moe_bases(gu32* cnt, int (&tb)[9]) {
    int acc = 0;
#pragma unroll
    for (int e = 0; e < 8; ++e) { tb[e] = acc; const unsigned c = __hip_atomic_load(cnt + 64 * e, RLX_AGENT); acc += (int)((c + 255u) >> 8); }
    tb[8] = acc;
}
#ifndef MOE_TAIL_SPLIT
#define MOE_TAIL_SPLIT 1
#endif
__device__ __forceinline__ void moe_tail_split(const int (&tb)[9], int G, int& first, int& ntail) {
    const int U = tb[8] * 4; first = (U / G) * G; ntail = U - first;
    if (first == 0 || (first & 3) || ntail > 32) { first = U; ntail = 0; }
#if !MOE_TAIL_SPLIT
    first = U; ntail = 0;
#endif
}
__device__ __forceinline__ void gather_phase(Frame& F, const bf16* A4, unsigned* tokinfo, gu32* cnt, bf16* XG) {
    int tb[9]; moe_bases(cnt, tb);
    const int gw = F.bid * NWAVES + F.wave, NGW = F.G * NWAVES;
    struct GIn { v4u t0, t1, x0, x1; };
    GIn cur, nxt;
#define G_FETCH(R_, r_) do { R_.t0 = *(const GAS v4u*)(tokinfo + (size_t)(r_) * 8); R_.t1 = *(const GAS v4u*)(tokinfo + (size_t)(r_) * 8 + 4); \
        const GAS v4u* s_ = (const GAS v4u*)(A4 + (size_t)(r_) * D); R_.x0 = s_[F.lane]; R_.x1 = s_[F.lane + 64]; } while (0)
    if (gw < M_LAT) G_FETCH(cur, gw);
    for (int r = gw; r < M_LAT; r += NGW) {
        if (r + NGW < M_LAT) G_FETCH(nxt, r + NGW);
        const v4u t0 = cur.t0, t1 = cur.t1, x0 = cur.x0, x1 = cur.x1; cur = nxt;
        int tbe0 = 0, tbe1 = 0;
#pragma unroll
        for (int e = 0; e < 8; ++e) { if ((int)t0.x == e) tbe0 = tb[e]; if ((int)t0.w == e) tbe1 = tb[e]; }
        const unsigned row0 = (unsigned)tbe0 * 256u + t0.y, row1 = (unsigned)tbe1 * 256u + t1.x;
        GAS v4u* d0 = (GAS v4u*)(XG + (size_t)row0 * D); GAS v4u* d1 = (GAS v4u*)(XG + (size_t)row1 * D);
        d0[F.lane] = x0; d0[F.lane + 64] = x1; d1[F.lane] = x0; d1[F.lane + 64] = x1;
        if (F.lane == 0) { tokinfo[(size_t)r * 8 + 6] = row0; tokinfo[(size_t)r * 8 + 7] = row1; }
    }
#undef G_FETCH
}
__device__ __forceinline__ f32x4 moe_y4(const bf16* YG, const float* slab, unsigned row, int j, int lane, unsigned tailrow0, int first, int ntail) {
    if (row < tailrow0) { const v2u a = ((const GAS v2u*)(YG + (size_t)row * D) + lane)[64 * j]; return (f32x4){bflo(a.x), bfhi(a.x), bflo(a.y), bfhi(a.y)}; }
    const size_t kstride = (size_t)(ntail >> 2) * 256 * 1024; const float* p = slab + (size_t)(row - tailrow0) * 1024 + (lane + 64 * j) * 4; f32x4 s = {0.f, 0.f, 0.f, 0.f};
    for (int ks = 0; ks < 11; ++ks) s += *(const GAS f32x4*)(p + ks * kstride);
    const unsigned w0 = pk2(s[0], s[1]), w1 = pk2(s[2], s[3]);
    return (f32x4){bflo(w0), bfhi(w0), bflo(w1), bfhi(w1)};
}
__device__ __forceinline__ void final_phase(Frame& F, float* hout, const bf16* YG, const unsigned* tokinfo, const float* mods_l, const float* norm_final, const float* slab, gu32* cnt) {
    const int gw = F.bid * NWAVES + F.wave, NGW = F.G * NWAVES;
    int tb[9]; moe_bases(cnt, tb); int first, ntail; moe_tail_split(tb, F.G, first, ntail); const unsigned tailrow0 = (unsigned)(first >> 2) * 256u;
#if defined(PROF_PH) || defined(PROF_SCANWAIT)
    const float prof_scale = 1.f + sqrtf(__uint_as_float(__hip_atomic_load(F.ctl + 2, RLX_AGENT)) * 1e-5f);
#else
    const float prof_scale = 1.f;
#endif
    for (int r = gw; r < M_LAT; r += NGW) {
        const v4u t0 = *(const GAS v4u*)(tokinfo + (size_t)r * 8), t1 = *(const GAS v4u*)(tokinfo + (size_t)r * 8 + 4);
        const float g0 = __uint_as_float(t0.z), g1 = __uint_as_float(t1.y); const unsigned row0 = t1.z, row1 = t1.w;
        const float* mp = mods_l + (r >> 11) * 6144 + 5120;
        GAS f32x4* hr = (GAS f32x4*)(hout + (size_t)r * D) + F.lane;
        f32x4 v[4]; float ss = 0.f;
#pragma unroll
        for (int j = 0; j < 4; ++j) {
            const f32x4 hh = hr[64 * j], mm = ((const GAS f32x4*)mp)[F.lane + 64 * j];
            const f32x4 ya = moe_y4(YG, slab, row0, j, F.lane, tailrow0, first, ntail), yb = moe_y4(YG, slab, row1, j, F.lane, tailrow0, first, ntail);
            v[j] = hh + mm * (ya * g0 + yb * g1);
            ss += (v[j].x * v[j].x + v[j].y * v[j].y) + (v[j].z * v[j].z + v[j].w * v[j].w);
        }
        const float rs = rsqrtf(wave_sum(ss) * (1.f / 1024.f) + 1e-6f);
#pragma unroll
        for (int j = 0; j < 4; ++j) { const f32x4 gg = ((const GAS f32x4*)norm_final)[F.lane + 64 * j]; hr[64 * j] = (v[j] * (rs * prof_scale)) * gg; }
    }
}

constexpr int NPHASE = 19;
#ifndef MK_PER_PHASE
#define MK_PER_PHASE 0
#endif
__device__ __forceinline__ int fresh_lane() { int l; asm volatile("v_mbcnt_lo_u32_b32 %0, -1, 0\n\tv_mbcnt_hi_u32_b32 %0, -1, %0" : "=v"(l)); return l; }
struct Args { const float* in[39]; float* out; unsigned char* ws; int ph_lo, ph_hi; };
#define KARGP(k) (((void* const __attribute__((address_space(4)))*)__builtin_amdgcn_kernarg_segment_ptr())[k])
#define KARG(k) ((const float*)KARGP(k))
__global__ void __launch_bounds__(NWAVES * 64, 2) mk_fwd(Args args) {
    extern __shared__ __attribute__((aligned(16))) unsigned char lds[];
    Frame F;
    F.lds = (LAS unsigned char*)lds; F.MISC = (volatile LAS unsigned*)(F.lds + MISC_OFF);
    F.tid = threadIdx.x; F.lane = F.tid & 63; F.wave = __builtin_amdgcn_readfirstlane(F.tid >> 6); F.G = gridDim.x; F.bid = blockIdx.x;
    unsigned char* ws = (unsigned char*)KARGP(40); F.ctl = (gu32*)(ws + WS_CTL);
    for (int u = F.tid; u < (LDS_BYTES - LDSCTL_OFF) / 4; u += NWAVES * 64) ((LAS unsigned*)(F.lds + LDSCTL_OFF))[u] = 0u;
    __syncthreads();
    const int lo = args.ph_lo, hi = args.ph_hi;
    unsigned long long prof_t0 = 0ull; (void)prof_t0;
    XcdBarrier bar; bar.bar = (unsigned*)(F.ctl + CW_BAR); bar.x = 0; bar.st = nullptr;
    if (hi - lo > 1) bar = xcd_barrier_post((unsigned*)(F.ctl + CW_BAR), F.MISC + 8);
#ifdef PH_MASK
#define IN(k) ((((PH_MASK) >> (k)) & 1) && lo <= (k) && (k) < hi)
#else
#define IN(k) (lo <= (k) && (k) < hi)
#endif
#ifndef DUP_MASK
#define DUP_MASK 0
#endif
#ifdef PROF_PH
#define PROF_T0(k) do { if ((k) == PROF_PH && F.bid == 0 && F.tid == 0) prof_t0 = __builtin_amdgcn_s_memrealtime(); } while (0)
#define PROF_T1(k) do { if ((k) == PROF_PH && F.bid == 0 && F.tid == 0) { const unsigned long long t1_ = __builtin_amdgcn_s_memrealtime(); __hip_atomic_store(F.ctl + 2, __float_as_uint((float)(t1_ - prof_t0) * 0.01f), RLX_AGENT); } } while (0)
#else
#define PROF_T0(k) do {} while (0)
#define PROF_T1(k) do {} while (0)
#endif
#define REPS(k) (1 + (((DUP_MASK) >> (k)) & 1))
#ifdef DOUBLE_BAR
#define SEAM(k) do { if (IN(k) && IN((k) + 1)) { xcd_barrier(bar); xcd_barrier(bar); } } while (0)
#else
#define SEAM(k) do { if (IN(k) && IN((k) + 1)) xcd_barrier(bar); } while (0)
#endif
    const float* x = KARG(0); const float* ctx = KARG(2);
    float* mods = (float*)(ws + WS_MODS); float* hctx = (float*)(ws + WS_HCTX); float* hlat = (float*)KARGP(39);
    bf16* A = (bf16*)(ws + WS_A);
    const int vcu = (F.G % 8 == 0) ? (F.bid % 8) * (F.G / 8) + F.bid / 8 : F.bid;

    PROF_T0(0); if (IN(0)) for (int rep_ = 0; rep_ < REPS(0); ++rep_) { if (rep_) __syncthreads(); F.lane = fresh_lane(); F.tid = F.wave * 64 + F.lane; p0_phase(F, KARG(1), KARG(3), KARG(4), KARG(5), mods, KARG(9), KARG(10), KARG(28), KARG(29), KARG(30), KARG(31), KARG(32), ws); }
    SEAM(0); PROF_T1(0);
    PROF_T0(1); if (IN(1)) for (int rep_ = 0; rep_ < REPS(1); ++rep_) { if (rep_) __syncthreads(); F.lane = fresh_lane(); F.tid = F.wave * 64 + F.lane; normmod_phase(F, ctx, x, KARG(6), mods, 0, 1024, A); }
    SEAM(1); PROF_T1(1);
    PROF_T0(2); if (IN(2)) for (int rep_ = 0; rep_ < REPS(2); ++rep_) { if (rep_) __syncthreads(); F.lane = fresh_lane(); F.tid = F.wave * 64 + F.lane;
        pg8::Gemm g{A, (const bf16*)(ws + WS_WIN_T), M_ALL, ZLD, D}; pg8::StaticOrder S; S.init(M_ALL, ZLD, F.G, F.bid);
        pg8::EpiBf16<0> E{(bf16*)(ws + WS_Z), ZLD, nullptr, 0, 0, 1.f};
        pg8::gemm_phase<pg8::EpiBf16<0>, pg8::StaticOrder, true, true>(F.lds, g, S, E);
    }
    SEAM(2); PROF_T1(2);
    PROF_T0(3); if (IN(3)) for (int rep_ = 0; rep_ < REPS(3); ++rep_) { if (rep_) __syncthreads(); F.lane = fresh_lane(); F.tid = F.wave * 64 + F.lane;
        PrepIn P{KARG(11), KARG(12), KARG(13), KARG(14), KARG(15), KARG(16), KARG(17), KARG(18), KARG(19), KARG(22), KARG(23), KARG(24)};
        prepare_phase(F, P, (const bf16*)(ws + WS_Z), (bf16*)(ws + WS_PR), (bf16*)(ws + WS_PM), (float*)(ws + WS_DT), (float*)(ws + WS_BONUS), (bf16*)(ws + WS_GATE), (bf16*)(ws + WS_ZG));
    }
    SEAM(3); PROF_T1(3);
    PROF_T0(4); if (IN(4)) for (int rep_ = 0; rep_ < REPS(4); ++rep_) { if (rep_) __syncthreads(); F.lane = fresh_lane(); F.tid = F.wave * 64 + F.lane;
        for (int u = F.bid; u < 256; u += F.G) {
            if (u < 128) { rwkv_block(F, u, (const bf16*)(ws + WS_PR), (bf16*)(ws + WS_YRW));
#ifdef RWKV2X
                rwkv_block(F, u, (const bf16*)(ws + WS_PR), (bf16*)(ws + WS_YRW));
#endif
            }
            else { mamba_block(F, u - 128, (const bf16*)(ws + WS_PM), (const float*)(ws + WS_DT), KARG(25), (bf16*)(ws + WS_YMB));
#ifdef MAMBA2X
                   mamba_block(F, u - 128, (const bf16*)(ws + WS_PM), (const float*)(ws + WS_DT), KARG(25), (bf16*)(ws + WS_YMB));
#endif
            }
        }
    }
    SEAM(4); PROF_T1(4);
    PROF_T0(5); if (IN(5)) for (int rep_ = 0; rep_ < REPS(5); ++rep_) { if (rep_) __syncthreads(); F.lane = fresh_lane(); F.tid = F.wave * 64 + F.lane;
        FinIn P{KARG(20), KARG(21), KARG(26), KARG(27)};
        finish_phase(F, P, (const bf16*)(ws + WS_YRW), (const bf16*)(ws + WS_YMB), (const bf16*)(ws + WS_PR), (const bf16*)(ws + WS_PM), (const float*)(ws + WS_BONUS), (const bf16*)(ws + WS_GATE), (const bf16*)(ws + WS_ZG), A);
    }
    SEAM(5); PROF_T1(5);
    PROF_T0(6); if (IN(6)) for (int rep_ = 0; rep_ < REPS(6); ++rep_) { if (rep_) __syncthreads(); F.lane = fresh_lane(); F.tid = F.wave * 64 + F.lane;
        {
            pg8::Gemm g{A + (size_t)M_CTX * D, (const bf16*)(ws + WS_WOUT_T), M_LAT, D, D}; pg8::StaticOrder S; S.init(M_LAT, D, F.G, F.bid);
            pg8::EpiResGate E{x, x, hlat, hlat, mods, 2048, 0};
            pg8::gemm_phase<pg8::EpiResGate, pg8::StaticOrder, true, true>(F.lds, g, S, E);
        }
        {
            pg8::Gemm g{A, (const bf16*)(ws + WS_WOUT_T), M_CTX, D, 256, D}; pg8::SplitKOrder S{8, 4, 4, 256, F.G, F.bid};
            pg8::EpiSlabGate E{(float*)(ws + WS_SLAB6), mods + 8 * 6144 + 2048, 256};
            pg8::gemm_phase<pg8::EpiSlabGate, pg8::SplitKOrder, true, true>(F.lds, g, S, E);
        }
        { const int nsub = 8 * 4 * 4; if (F.G > nsub && F.bid >= nsub) moe_weight_phase(F, KARG(36), KARG(37), KARG(38), ws, 0, MOE_ITEMS_P6, F.bid - nsub, F.G - nsub);
          else if (F.G <= nsub) moe_weight_phase(F, KARG(36), KARG(37), KARG(38), ws, 0, MOE_ITEMS_P6, F.bid, F.G); }
    }
    SEAM(6); PROF_T1(6);
    PROF_T0(7); if (IN(7)) for (int rep_ = 0; rep_ < REPS(7); ++rep_) { if (rep_) __syncthreads(); F.lane = fresh_lane(); F.tid = F.wave * 64 + F.lane; normmod_phase(F, ctx, hlat, KARG(7), mods, 3072, 4096, A, (const float*)(ws + WS_SLAB6), 4, hctx); moe_weight_phase(F, KARG(36), KARG(37), KARG(38), ws, MOE_ITEMS_P6, MOE_ITEMS_P7, F.bid, F.G); }
    SEAM(7); PROF_T1(7);
    PROF_T0(8); if (IN(8)) for (int rep_ = 0; rep_ < REPS(8); ++rep_) { if (rep_) __syncthreads(); F.lane = fresh_lane(); F.tid = F.wave * 64 + F.lane;
        pg8::Gemm g{A, (const bf16*)(ws + WS_W13_T), M_ALL, 2 * FF, D}; pg8::StaticOrder S; S.init(M_ALL, 2 * FF, F.G, F.bid);
        pg8::EpiSwiGLU E{(bf16*)(ws + WS_HID), FF, 1 << 20};
        pg8::gemm_phase<pg8::EpiSwiGLU, pg8::StaticOrder, true, true>(F.lds, g, S, E);
        {
            const int nfull = ((M_ALL / 256) * (2 * FF / 256)) % F.G;
            if (nfull != 0 && F.bid >= nfull) moe_weight_phase(F, KARG(36), KARG(37), KARG(38), ws, MOE_ITEMS_P7, MOE_ITEMS_P7 + MOE_ITEMS_P8, F.bid - nfull, F.G - nfull);
            else if (nfull == 0) moe_weight_phase(F, KARG(36), KARG(37), KARG(38), ws, MOE_ITEMS_P7, MOE_ITEMS_P7 + MOE_ITEMS_P8, F.bid, F.G);
        }
    }
    SEAM(8); PROF_T1(8);
    PROF_T0(9); if (IN(9)) for (int rep_ = 0; rep_ < REPS(9); ++rep_) { if (rep_) __syncthreads(); F.lane = fresh_lane(); F.tid = F.wave * 64 + F.lane;
        {
            pg8::Gemm g{(const bf16*)(ws + WS_HID) + (size_t)M_CTX * FF, (const bf16*)(ws + WS_W2_T), M_LAT, D, FF}; pg8::StaticOrder S; S.init(M_LAT, D, F.G, F.bid);
            pg8::EpiResGate E{hlat, hlat, hlat, hlat, mods, 5120, 0};
            pg8::gemm_phase<pg8::EpiResGate, pg8::StaticOrder, true, true>(F.lds, g, S, E);
        }
        {
            pg8::Gemm g{(const bf16*)(ws + WS_HID), (const bf16*)(ws + WS_W2_T), M_CTX, D, 1408, FF}; pg8::SplitKOrder S{8, 4, 2, 1408, F.G, F.bid};
            pg8::EpiSlabGate E{(float*)(ws + WS_SLAB9), mods + 8 * 6144 + 5120, 1408};
            pg8::gemm_phase<pg8::EpiSlabGate, pg8::SplitKOrder, true, true>(F.lds, g, S, E);
        }
        {
            const int nsub = 8 * 4 * 2;
            if (F.G > nsub) { if (F.bid >= nsub) moe_weight_phase(F, KARG(36), KARG(37), KARG(38), ws, MOE_ITEMS_P7 + MOE_ITEMS_P8, MOE_ITEMS_P7 + MOE_ITEMS_P8 + MOE_ITEMS_P9, F.bid - nsub, F.G - nsub); }
            else moe_weight_phase(F, KARG(36), KARG(37), KARG(38), ws, MOE_ITEMS_P7 + MOE_ITEMS_P8, MOE_ITEMS_P7 + MOE_ITEMS_P8 + MOE_ITEMS_P9, F.bid, F.G);
        }
    }
    SEAM(9); PROF_T1(9);
    const float* mods1 = mods + 9 * 6144;
    PROF_T0(10); if (IN(10)) for (int rep_ = 0; rep_ < REPS(10); ++rep_) { if (rep_) __syncthreads(); F.lane = fresh_lane(); F.tid = F.wave * 64 + F.lane; normmod_phase(F, hctx, hlat, KARG(6) + D, mods1, 0, 1024, A, (const float*)(ws + WS_SLAB9), 2); }
    SEAM(10); PROF_T1(10);
    PROF_T0(11); if (IN(11)) for (int rep_ = 0; rep_ < REPS(11); ++rep_) { if (rep_) __syncthreads(); F.lane = fresh_lane(); F.tid = F.wave * 64 + F.lane;
        pg8::Gemm g{A, (const bf16*)(ws + WS_QKV_T), M_ALL, 3 * D, D}; pg8::StaticOrder S; S.init(M_ALL, 3 * D, F.G, F.bid);
        pg8::EpiBf16<0> E{(bf16*)(ws + WS_Q), D, nullptr, D, (size_t)M_ALL * D, 0.125f * 1.4426950408889634f};
        pg8::gemm_phase<pg8::EpiBf16<0>, pg8::StaticOrder, true, true>(F.lds, g, S, E);
        {
            const int nfull = ((M_ALL / 256) * (3 * D / 256)) % F.G;
            if (nfull != 0 && F.bid >= nfull) moe_weight_phase(F, KARG(36), KARG(37), KARG(38), ws, MOE_ITEMS - MOE_ITEMS_P11, MOE_ITEMS, F.bid - nfull, F.G - nfull);
            else if (nfull == 0) moe_weight_phase(F, KARG(36), KARG(37), KARG(38), ws, MOE_ITEMS - MOE_ITEMS_P11, MOE_ITEMS, F.bid, F.G);
        }
    }
    SEAM(11); PROF_T1(11);
    PROF_T0(12); if (IN(12)) for (int rep_ = 0; rep_ < REPS(12); ++rep_) { if (rep_) __syncthreads(); F.lane = fresh_lane(); F.tid = F.wave * 64 + F.lane; attn_phase(F, (const bf16*)(ws + WS_Q), (const bf16*)(ws + WS_K), (const bf16*)(ws + WS_V), KARG(33), (bf16*)(ws + WS_O)); }
    SEAM(12); PROF_T1(12);
    PROF_T0(13); if (IN(13)) for (int rep_ = 0; rep_ < REPS(13); ++rep_) { if (rep_) __syncthreads(); F.lane = fresh_lane(); F.tid = F.wave * 64 + F.lane;
        pg8::Gemm g{(const bf16*)(ws + WS_O), (const bf16*)(ws + WS_NAO_T), M_LAT, D, D}; pg8::StaticOrder S; S.init(M_LAT, D, F.G, F.bid);
        pg8::EpiResGate E{hlat, hlat, hlat, hlat, mods1, 2048, 0};
        pg8::gemm_phase<pg8::EpiResGate, pg8::StaticOrder, true, true>(F.lds, g, S, E);
    }
    SEAM(13); PROF_T1(13);
    PROF_T0(14); if (IN(14)) for (int rep_ = 0; rep_ < REPS(14); ++rep_) { if (rep_) __syncthreads(); F.lane = fresh_lane(); F.tid = F.wave * 64 + F.lane; router_phase(F, hlat, KARG(7) + D, mods1, KARG(34), KARG(35), (bf16*)(ws + WS_A4), (unsigned*)(ws + WS_TOK), F.ctl + CW_CNT); }
    SEAM(14); PROF_T1(14);
    PROF_T0(15); if (IN(15)) for (int rep_ = 0; rep_ < REPS(15); ++rep_) { if (rep_) __syncthreads(); F.lane = fresh_lane(); F.tid = F.wave * 64 + F.lane; gather_phase(F, (const bf16*)(ws + WS_A4), (unsigned*)(ws + WS_TOK), F.ctl + CW_CNT, (bf16*)(ws + WS_XG)); }
    SEAM(15); PROF_T1(15);
    PROF_T0(16); if (IN(16)) for (int rep_ = 0; rep_ < REPS(16); ++rep_) { if (rep_) __syncthreads(); F.lane = fresh_lane(); F.tid = F.wave * 64 + F.lane;
        pg8::MoeOrder S; moe_bases(F.ctl + CW_CNT, S.tb); S.ntn = 22; S.G = F.G; S.c = vcu;
        pg8::Gemm g{(const bf16*)(ws + WS_XG), (const bf16*)(ws + WS_MOEW13), MOE_ROWS, NE * 2 * FF, D};
        pg8::EpiSwiGLU E{(bf16*)(ws + WS_HIDG), FF, 22};
        pg8::gemm_phase<pg8::EpiSwiGLU, pg8::MoeOrder, true, true>(F.lds, g, S, E);
    }
    SEAM(16); PROF_T1(16);
    PROF_T0(17); if (IN(17)) for (int rep_ = 0; rep_ < REPS(17); ++rep_) { if (rep_) __syncthreads(); F.lane = fresh_lane(); F.tid = F.wave * 64 + F.lane;
        pg8::MoeOrder S; moe_bases(F.ctl + CW_CNT, S.tb); S.ntn = 4; S.G = F.G; S.c = vcu;
        int first, ntail; moe_tail_split(S.tb, F.G, first, ntail); S.limit = first;
        {
            pg8::Gemm g{(const bf16*)(ws + WS_HIDG), (const bf16*)(ws + WS_MOEW2), MOE_ROWS, NE * D, FF};
            pg8::EpiPlainMod E{(bf16*)(ws + WS_YG), D, 4};
            pg8::gemm_phase<pg8::EpiPlainMod, pg8::MoeOrder, true, true>(F.lds, g, S, E);
        }
#if MOE_TAIL_SPLIT
        if (ntail > 0) {
            pg8::MoeTailOrder ST;
#pragma unroll
            for (int k = 0; k < 9; ++k) ST.tb[k] = S.tb[k];
            ST.first = first; ST.ntail = ntail; ST.G = F.G; ST.c = vcu;
            pg8::Gemm g{(const bf16*)(ws + WS_HIDG), (const bf16*)(ws + WS_MOEW2), MOE_ROWS, NE * D, 256, FF};
            pg8::EpiTailSlab E{(float*)(ws + WS_TAIL), first, ntail};
            pg8::gemm_phase<pg8::EpiTailSlab, pg8::MoeTailOrder, true, true>(F.lds, g, ST, E);
        }
#endif
    }
    SEAM(17); PROF_T1(17);
    PROF_T0(18); if (IN(18)) for (int rep_ = 0; rep_ < REPS(18); ++rep_) { if (rep_) __syncthreads(); F.lane = fresh_lane(); F.tid = F.wave * 64 + F.lane; final_phase(F, hlat, (const bf16*)(ws + WS_YG), (const unsigned*)(ws + WS_TOK), mods1, KARG(8), (const float*)(ws + WS_TAIL), F.ctl + CW_CNT); }
#undef IN
#undef SEAM
}

extern "C" void kernel_launch(void* const* d_in, const int* in_sizes, int n_in, void* d_out, int out_size, void* d_ws, size_t ws_size, hipStream_t stream) {
    static int grid = 0;
    if (grid == 0) {
        if (n_in != 39 || out_size != M_LAT * D || ws_size < WS_END) { fprintf(stderr, "kernel_launch: unexpected shapes (n_in %d, out %d, ws %zu)\n", n_in, out_size, ws_size); grid = -1; return; }
        int dev = 0, cus = 0, per_cu = 0;
        if (hipGetDevice(&dev) != hipSuccess || hipDeviceGetAttribute(&cus, hipDeviceAttributeMultiprocessorCount, dev) != hipSuccess) { grid = -1; return; }
        if (hipFuncSetAttribute((const void*)mk_fwd, hipFuncAttributeMaxDynamicSharedMemorySize, LDS_BYTES) != hipSuccess) { fprintf(stderr, "kernel_launch: hipFuncSetAttribute failed\n"); grid = -1; return; }
        if (hipOccupancyMaxActiveBlocksPerMultiprocessor(&per_cu, (const void*)mk_fwd, NWAVES * 64, LDS_BYTES) != hipSuccess || per_cu < 1) fprintf(stderr, "kernel_launch: occupancy query says %d\n", per_cu);
        (void)hipGetLastError();
        grid = cus;
    }
    if (grid < 0) return;
    if (hipMemsetAsync((char*)d_ws + WS_CTL, 0, CTL_ZERO_BYTES, stream) != hipSuccess) return;
    Args a{};
    for (int i = 0; i < 39; ++i) a.in[i] = (const float*)d_in[i];
    a.out = (float*)d_out; a.ws = (unsigned char*)d_ws;
#if MK_PER_PHASE
    for (int p = 0; p < NPHASE; ++p) { a.ph_lo = p; a.ph_hi = p + 1; hipLaunchKernelGGL(mk_fwd, dim3(grid), dim3(NWAVES * 64), LDS_BYTES, stream, a); }
#else
    a.ph_lo = 0; a.ph_hi = NPHASE; hipLaunchKernelGGL(mk_fwd, dim3(grid), dim3(NWAVES * 64), LDS_BYTES, stream, a);
#endif
}
```

```cpp
#include <hip/hip_runtime.h>
#include <cstdio>
#include <cstdint>
#include <cmath>
#define MK_PER_PHASE 0
namespace pg8 {
#define PG8_LAS __attribute__((address_space(3)))
typedef unsigned short bf16_t;
typedef short bf16x8 __attribute__((ext_vector_type(8)));
typedef float f32x4 __attribute__((ext_vector_type(4)));
typedef unsigned u32x4 __attribute__((ext_vector_type(4)));
constexpr int BM = 256, BK = 64, HALF = 128, HTB = HALF * BK * 2  , STAGE_BYTES = 8 * HTB, NXCD = 8, WGM = 8;

__host__ __device__ __forceinline__ int lds_byte(int r, int c) { const int st = (r >> 4) * 2 + (c >> 5), rr = r & 15, cc = c & 31, ob = rr * 64 + cc * 2; return st * 1024 + (ob ^ (((ob >> 9) & 1) << 5)); }
__host__ __device__ __forceinline__ void stage_rc(int b, int& R, int& C) { const int st = b / 1024, sb = b % 1024, swz = sb ^ (((sb >> 9) & 1) << 5); R = (st >> 1) * 16 + swz / 64; C = (st & 1) * 32 + (swz % 64) / 2; }
__host__ __device__ __forceinline__ int perm32(int rho) { const int n = rho >> 4, i = rho & 15; return 8 * (i >> 2) + 4 * n + (i & 3); }

#ifndef PG8_WT
#define PG8_WT 0
#endif
#if PG8_WT
#define PG8_ST16(base_, ptr_, v_) __builtin_amdgcn_raw_buffer_store_b128((v_), __builtin_amdgcn_make_buffer_rsrc((void*)(base_), (short)0, 0x7fffffff, 0x00020000), (int)((const char*)(ptr_) - (const char*)(base_)), 0, 16)
#else
#define PG8_ST16(base_, ptr_, v_) (*(u32x4*)(ptr_) = (v_))
#endif
struct Unit { int pm, pn; int k0 = 0; };
struct Gemm { const bf16_t* A; const bf16_t* Bt; int M, N, K; int ld = 0; };

struct StaticOrder {
    int nM, nN, nwg, G, c;
    __host__ __device__ void init(int M, int N, int G_, int c_) { nM = M / BM; nN = N / BM; nwg = nM * nN; G = G_; c = c_; }
    __host__ __device__ bool next(int i, Unit& u) const {
        const long L = (long)i * G + c; if (L >= nwg) return false;
        int wgid = (int)L; { const int q = nwg / NXCD, r = nwg % NXCD, xcd = wgid % NXCD, off = wgid / NXCD; wgid = (xcd < r ? xcd * (q + 1) : r * (q + 1) + (xcd - r) * q) + off; }
        const int nig = WGM * nN, gid = wgid / nig, fm = gid * WGM, gsz = (nM - fm) < WGM ? (nM - fm) : WGM;
        u.pm = fm + ((wgid % nig) % gsz); u.pn = (wgid % nig) / gsz; return true;
    }
    __device__ __forceinline__ void a_ready(const Unit&) const {}
    __device__ __forceinline__ void done(const Unit&) const {}
};

__device__ __forceinline__ unsigned cvt_pk_bf16(float lo, float hi) { unsigned r; asm volatile("v_cvt_pk_bf16_f32 %0, %1, %2" : "=v"(r) : "v"(lo), "v"(hi)); return r; }
typedef float f32x2 __attribute__((ext_vector_type(2)));
__device__ __forceinline__ f32x2 gelu_pk(f32x2 v) {
    const f32x2 av = __builtin_elementwise_abs(v), d = av * 0.2316418882f + 1.0f;
    f32x2 t; t.x = __builtin_amdgcn_rcpf(d.x); t.y = __builtin_amdgcn_rcpf(d.y);
    f32x2 q = t * 0.5307027145f + (-0.7265760135f); q = q * t + 0.7107068705f; q = q * t + (-0.142248368f); q = q * t + 0.127414796f; q = q * t;
    const f32x2 s = (v * v) * (-0.72134752044f);
    f32x2 e; e.x = __builtin_amdgcn_exp2f(s.x); e.y = __builtin_amdgcn_exp2f(s.y);
    const f32x2 m = v * (q * e), r = v - m;
    f32x2 o; o.x = v.x < 0.f ? m.x : r.x; o.y = v.y < 0.f ? m.y : r.y; return o;
}

template <int ACT  > struct EpiBf16 {
    static constexpr bool PERM = true, AFTER_DRAIN = false; static_assert(ACT == 0 || ACT == 1, "EpiBf16: ACT is 0 (none) or 1 (gelu_pk)");
    bf16_t* O; int ldc; const float* bias; int split_cols; size_t split_stride; float scale0;
    __device__ __forceinline__ void operator()(const f32x4 (&acc)[2][2][4][2], const Unit& u, int wr, int wc, int fr, int fq) const {
        const int row0 = u.pm * BM + wr * 64 + fr; int colt = u.pn * BM; bf16_t* base = O;
        float sc = 1.f; if (split_cols) { const int t = colt / split_cols; base += (size_t)t * split_stride; colt -= t * split_cols; if (t == 0) sc = scale0; }
        const int col0 = colt + wc * 32 + 8 * fq, bcol0 = u.pn * BM + wc * 32 + 8 * fq;
        f32x4 bv[2][2];
#pragma unroll
        for (int bj = 0; bj < 2; ++bj)
#pragma unroll
            for (int n = 0; n < 2; ++n) bv[bj][n] = bias ? *(const f32x4*)(bias + bcol0 + bj * HALF + 4 * n) : (f32x4){0.f, 0.f, 0.f, 0.f};
#pragma unroll
        for (int ai = 0; ai < 2; ++ai)
#pragma unroll
            for (int m = 0; m < 4; ++m) { bf16_t* rowp = base + (size_t)(row0 + ai * HALF + m * 16) * ldc + col0;
#pragma unroll
                for (int bj = 0; bj < 2; ++bj) { f32x4 v0 = acc[ai][bj][m][0] + bv[bj][0], v1 = acc[ai][bj][m][1] + bv[bj][1];
                    if (ACT == 1) { f32x2 a = gelu_pk((f32x2){v0[0], v0[1]}), b = gelu_pk((f32x2){v0[2], v0[3]}), c = gelu_pk((f32x2){v1[0], v1[1]}), d = gelu_pk((f32x2){v1[2], v1[3]});
                        v0 = (f32x4){a.x, a.y, b.x, b.y}; v1 = (f32x4){c.x, c.y, d.x, d.y}; }
                    v0 = v0 * sc; v1 = v1 * sc; u32x4 w; w.x = cvt_pk_bf16(v0[0], v0[1]); w.y = cvt_pk_bf16(v0[2], v0[3]); w.z = cvt_pk_bf16(v1[0], v1[1]); w.w = cvt_pk_bf16(v1[2], v1[3]);
                    PG8_ST16(base, rowp + bj * HALF, w); } }
    }
};
template <class Epi, class Sched, bool ALIGN_EPI = false, bool SP2 = false>
__device__ __forceinline__ void gemm_phase(PG8_LAS unsigned char* lds, const Gemm g, const Sched& S, const Epi& E) {
    const int tid = threadIdx.x, wid = __builtin_amdgcn_readfirstlane(tid >> 6), lane = tid & 63, wr = wid >> 2, wc = wid & 3, fr = lane & 15, fq = lane >> 4;
    const int K = g.K, nt = K / BK, LD = g.ld ? g.ld : g.K;
    unsigned voffA[2], voffB[2];
#pragma unroll
    for (int i = 0; i < 2; ++i) { int R, C; stage_rc(tid * 16 + i * 8192, R, C); const int Rb = Epi::PERM ? ((R & ~31) + perm32(R & 31)) : R;
        voffA[i] = (unsigned)(R * LD + C) * 2u; voffB[i] = (unsigned)(Rb * LD + C) * 2u; }
    const size_t kstep = (size_t)(BK * 2);
    const size_t hstep = (size_t)HALF * LD * 2;
    const size_t tstep = 2 * hstep;
    const unsigned ldsw = (unsigned)wid * 1024u;
    const int aoff = lds_byte(wr * 64 + fr, fq * 8), boff = lds_byte(wc * 32 + fr, fq * 8);
#define PG8_SA(b, h) (((b) * 2 + (h)) * HTB)
#define PG8_SB(b, h) ((4 + (b) * 2 + (h)) * HTB)
#define PG8_STAGE(bufoff, gbase, voff) do { _Pragma("unroll") for (int _i = 0; _i < 2; ++_i) \
        __builtin_amdgcn_global_load_lds((const unsigned*)((const char*)(gbase) + (voff)[_i]), (PG8_LAS unsigned*)(lds + (bufoff) + ldsw + _i * 8192), 16, 0, 0); } while (0)
#define PG8_LDA(dst, b, h) do { _Pragma("unroll") for (int m = 0; m < 4; ++m) _Pragma("unroll") for (int k = 0; k < 2; ++k) dst[m][k] = *(const PG8_LAS bf16x8*)(lds + PG8_SA(b, h) + aoff + m * 2048 + k * 1024); } while (0)
#define PG8_LDB(dst, b, h) do { _Pragma("unroll") for (int n = 0; n < 2; ++n) _Pragma("unroll") for (int k = 0; k < 2; ++k) dst[n][k] = *(const PG8_LAS bf16x8*)(lds + PG8_SB(b, h) + boff + n * 2048 + k * 1024); } while (0)
#define PG8_MMA(ai, bj, At, Bt) do { __builtin_amdgcn_s_setprio(1); _Pragma("unroll") for (int m = 0; m < 4; ++m) _Pragma("unroll") for (int n = 0; n < 2; ++n) _Pragma("unroll") for (int k = 0; k < 2; ++k) \
        acc[ai][bj][m][n] = __builtin_amdgcn_mfma_f32_16x16x32_bf16(Bt[n][k], At[m][k], acc[ai][bj][m][n], 0, 0, 0); __builtin_amdgcn_s_setprio(0); } while (0)
#define PG8_WAIT_V(n) asm volatile("s_waitcnt vmcnt(" #n ")" ::: "memory")
#define PG8_WAIT_L(n) asm volatile("s_waitcnt lgkmcnt(" #n ")" ::: "memory")
#define PG8_BAR __builtin_amdgcn_s_barrier()
#define PG8_SCHED __builtin_amdgcn_sched_barrier(0)
    Unit cur, nxt; int ui = 0;
    if (!S.next(0, cur)) return;
    f32x4 acc[2][2][4][2];
#pragma unroll
    for (int a = 0; a < 2; ++a)
#pragma unroll
        for (int b = 0; b < 2; ++b)
#pragma unroll
            for (int m = 0; m < 4; ++m)
#pragma unroll
                for (int n = 0; n < 2; ++n) acc[a][b][m][n] = (f32x4){0.f, 0.f, 0.f, 0.f};
    bf16x8 At[4][2], B0[2][2], B1[2][2];
    const char* cA = (const char*)g.A + (size_t)cur.pm * tstep + (size_t)cur.k0 * 2; const char* cB = (const char*)g.Bt + (size_t)cur.pn * tstep + (size_t)cur.k0 * 2;
    S.a_ready(cur);
    if constexpr (SP2) {
        PG8_STAGE(PG8_SB(0, 0), cB, voffB); PG8_STAGE(PG8_SB(0, 1), cB + hstep, voffB); PG8_STAGE(PG8_SA(0, 0), cA, voffA); PG8_STAGE(PG8_SA(0, 1), cA + hstep, voffA);
        if (wr == 1) PG8_BAR;
        PG8_WAIT_V(2); PG8_BAR;
        PG8_STAGE(PG8_SB(1, 0), cB + kstep, voffB); PG8_STAGE(PG8_SA(1, 0), cA + kstep, voffA); PG8_STAGE(PG8_SB(1, 1), cB + hstep + kstep, voffB);
        PG8_WAIT_V(6); PG8_BAR;
    } else {
        PG8_STAGE(PG8_SB(0, 0), cB, voffB); PG8_STAGE(PG8_SA(0, 0), cA, voffA); PG8_STAGE(PG8_SB(0, 1), cB + hstep, voffB); PG8_STAGE(PG8_SA(0, 1), cA + hstep, voffA);
        if (wr == 1) PG8_BAR;
        PG8_WAIT_V(4); PG8_BAR;
        PG8_STAGE(PG8_SB(1, 0), cB + kstep, voffB); PG8_STAGE(PG8_SA(1, 0), cA + kstep, voffA); PG8_STAGE(PG8_SB(1, 1), cB + hstep + kstep, voffB);
        PG8_WAIT_V(6); PG8_BAR;
    }
    for (;;) {
        const bool has_next = S.next(ui + 1, nxt);
        const char* nA = has_next ? (const char*)g.A + (size_t)nxt.pm * tstep + (size_t)nxt.k0 * 2 : cA; const char* nB = has_next ? (const char*)g.Bt + (size_t)nxt.pn * tstep + (size_t)nxt.k0 * 2 : cB;
        for (int t = 0; t < nt; t += 2) {
            const bool last = (t == nt - 2);
            const char* a1 = cA + (size_t)(t + 1) * kstep;
            const char* a2 = last ? nA : cA + (size_t)(t + 2) * kstep; const char* b2 = last ? nB : cB + (size_t)(t + 2) * kstep;
            const char* a3 = a2 + kstep; const char* b3 = b2 + kstep;
            if (last && has_next) S.a_ready(nxt);
            if constexpr (SP2) {
            PG8_LDB(B0, 0, 0); PG8_LDB(B1, 0, 1); PG8_SCHED; PG8_LDA(At, 0, 0); PG8_STAGE(PG8_SA(1, 1), a1 + hstep, voffA);
            PG8_WAIT_V(8); PG8_WAIT_L(0); PG8_BAR; PG8_MMA(0, 0, At, B0); PG8_MMA(0, 1, At, B1); PG8_BAR; PG8_SCHED;
            PG8_LDA(At, 0, 1); PG8_STAGE(PG8_SB(0, 0), b2, voffB); PG8_STAGE(PG8_SB(0, 1), b2 + hstep, voffB); PG8_STAGE(PG8_SA(0, 0), a2, voffA);
            PG8_WAIT_V(8); PG8_WAIT_L(0); PG8_BAR; PG8_MMA(1, 0, At, B0); PG8_MMA(1, 1, At, B1); PG8_BAR; PG8_SCHED;
            PG8_LDB(B0, 1, 0); PG8_LDB(B1, 1, 1); PG8_SCHED; PG8_LDA(At, 1, 0); PG8_STAGE(PG8_SA(0, 1), a2 + hstep, voffA);
            PG8_WAIT_V(8); PG8_WAIT_L(0); PG8_BAR; PG8_MMA(0, 0, At, B0); PG8_MMA(0, 1, At, B1); PG8_BAR; PG8_SCHED;
            PG8_LDA(At, 1, 1); PG8_STAGE(PG8_SB(1, 0), b3, voffB); PG8_STAGE(PG8_SB(1, 1), b3 + hstep, voffB); PG8_STAGE(PG8_SA(1, 0), a3, voffA);
            PG8_WAIT_V(8); PG8_WAIT_L(0); PG8_BAR; PG8_MMA(1, 0, At, B0); PG8_MMA(1, 1, At, B1); PG8_BAR; PG8_SCHED;
            } else {
            PG8_LDB(B0, 0, 0); PG8_SCHED; PG8_LDA(At, 0, 0); PG8_STAGE(PG8_SA(1, 1), a1 + hstep, voffA);
            PG8_WAIT_L(8); PG8_BAR; PG8_WAIT_L(0); PG8_MMA(0, 0, At, B0); PG8_BAR; PG8_SCHED;
            PG8_LDB(B1, 0, 1); PG8_STAGE(PG8_SB(0, 0), b2, voffB);
            PG8_BAR; PG8_WAIT_L(0); PG8_MMA(0, 1, At, B1); PG8_BAR;
            PG8_LDA(At, 0, 1); PG8_STAGE(PG8_SA(0, 0), a2, voffA);
            PG8_BAR; PG8_WAIT_L(0); PG8_MMA(1, 0, At, B0); PG8_BAR; PG8_SCHED;
            PG8_STAGE(PG8_SB(0, 1), b2 + hstep, voffB);
            PG8_WAIT_V(6); PG8_BAR; PG8_MMA(1, 1, At, B1); PG8_BAR;
            PG8_LDB(B0, 1, 0); PG8_SCHED; PG8_LDA(At, 1, 0); PG8_STAGE(PG8_SA(0, 1), a2 + hstep, voffA);
            PG8_WAIT_L(8); PG8_BAR; PG8_WAIT_L(0); PG8_MMA(0, 0, At, B0); PG8_BAR; PG8_SCHED;
            PG8_LDB(B1, 1, 1); PG8_STAGE(PG8_SB(1, 0), b3, voffB);
            PG8_BAR; PG8_WAIT_L(0); PG8_MMA(0, 1, At, B1); PG8_BAR;
            PG8_LDA(At, 1, 1); PG8_STAGE(PG8_SA(1, 0), a3, voffA);
            PG8_BAR; PG8_WAIT_L(0); PG8_MMA(1, 0, At, B0); PG8_BAR; PG8_SCHED;
            PG8_STAGE(PG8_SB(1, 1), b3 + hstep, voffB);
            PG8_WAIT_V(6); PG8_BAR; PG8_MMA(1, 1, At, B1); PG8_BAR;
            }
        }
        if constexpr (ALIGN_EPI) { if (wr == 0) PG8_BAR; }
        if constexpr (!Epi::AFTER_DRAIN) { E(acc, cur, wr, wc, fr, fq); S.done(cur); }
        if (!has_next) break;
#pragma unroll
        for (int a = 0; a < 2; ++a)
#pragma unroll
            for (int b = 0; b < 2; ++b)
#pragma unroll
                for (int m = 0; m < 4; ++m)
#pragma unroll
                    for (int n = 0; n < 2; ++n) acc[a][b][m][n] = (f32x4){0.f, 0.f, 0.f, 0.f};
        cur = nxt; cA = nA; cB = nB; ++ui;
        if constexpr (ALIGN_EPI) { if (wr == 1) PG8_BAR; }
    }
    PG8_WAIT_V(0);
    if constexpr (!ALIGN_EPI) { if (wr == 0) PG8_BAR; }
    PG8_BAR;
    if constexpr (Epi::AFTER_DRAIN) { E.fused(acc, cur, wr, wc, fr, fq, lds, wid, lane); S.done(cur); }
#undef PG8_SA
#undef PG8_SB
#undef PG8_STAGE
#undef PG8_LDA
#undef PG8_LDB
#undef PG8_MMA
#undef PG8_WAIT_V
#undef PG8_WAIT_L
#undef PG8_BAR
#undef PG8_SCHED
}
}

#define GAS __attribute__((address_space(1)))
#define LAS __attribute__((address_space(3)))
typedef unsigned short bf16;
typedef unsigned v4u __attribute__((ext_vector_type(4)));
typedef float f32x4 __attribute__((ext_vector_type(4)));
typedef short bf16x8 __attribute__((ext_vector_type(8)));
typedef GAS unsigned gu32;
typedef GAS unsigned long long gu64;
#define RLX_AGENT __ATOMIC_RELAXED, __HIP_MEMORY_SCOPE_AGENT
#define LDS_WAIT() asm volatile("s_waitcnt lgkmcnt(0)" ::: "memory")
#define VM_WAIT() asm volatile("s_waitcnt vmcnt(0)" ::: "memory")
__device__ __forceinline__ unsigned long long rt() { return __builtin_amdgcn_s_memrealtime(); }
typedef float f32x2_t __attribute__((ext_vector_type(2))); typedef __bf16 bf16x2_t __attribute__((ext_vector_type(2)));
__device__ __forceinline__ unsigned pk2(float lo, float hi) { const f32x2_t v = {lo, hi}; const bf16x2_t b = __builtin_convertvector(v, bf16x2_t); return __builtin_bit_cast(unsigned, b); }
__device__ __forceinline__ unsigned f2bf(float f) { return pk2(f, f) & 0xffffu; }
#define XB_TMO      128
#define XB_XCNT(j)  (256  + 64 * (j))
#define XB_XSUB(j)  (1280 + 64 * (j))
#define XB_XGEN(j)  (2304 + 64 * (j))
#define XB_TOP      3328
#define XB_TOPGEN   3392
#define XCD_BAR_WORDS 3456
#define XB_SPIN_CAP (1u << 18)

__device__ __forceinline__ unsigned xb_ld(unsigned* p)              { return __hip_atomic_load(p, __ATOMIC_RELAXED, __HIP_MEMORY_SCOPE_AGENT); }
__device__ __forceinline__ unsigned xb_add(unsigned* p, unsigned v) { return __hip_atomic_fetch_add(p, v, __ATOMIC_RELAXED, __HIP_MEMORY_SCOPE_AGENT); }
__device__ __forceinline__ unsigned xb_xcc_id() { return (unsigned)__builtin_amdgcn_s_getreg((3 << 11) | 20) & 0xFu; }
#define XB_SPIN(cond, bar) do { unsigned _sp = 0; while (cond) { __builtin_amdgcn_s_sleep(1); \
    if ((++_sp & 255u) == 0u) { if (xb_ld(&(bar)[XB_TMO])) break; if (_sp > XB_SPIN_CAP) { atomicAdd(&(bar)[XB_TMO], 1u); break; } } } } while (0)

struct XcdBarrier {
    unsigned* bar; unsigned x;
    volatile LAS unsigned* st;
};

__device__ __forceinline__ XcdBarrier xcd_barrier_post(unsigned* bar, volatile LAS unsigned* st) {
    XcdBarrier b; b.bar = bar; b.x = xb_xcc_id(); b.st = st;
    if (threadIdx.x == 0) (void)xb_add(&bar[XB_XCNT(b.x)], 1u);
    return b;
}
__device__ __forceinline__ void xcd_barrier_complete(unsigned* bar, unsigned x, unsigned& nloc, unsigned& nx) {
    const unsigned G = gridDim.x * gridDim.y * gridDim.z;
    unsigned sum, cnt, mine, sp = 0u;
    for (;;) {
        sum = 0u; cnt = 0u; mine = 0u;
#pragma unroll
        for (unsigned j = 0; j < 16; ++j) { const unsigned c = xb_ld(&bar[XB_XCNT(j)]); sum += c; cnt += (c > 0u) ? 1u : 0u; mine = (j == x) ? c : mine; }
        if (sum == G) break;
        __builtin_amdgcn_s_sleep(1);
        if ((++sp & 255u) == 0u) { if (xb_ld(&bar[XB_TMO])) break; if (sp > XB_SPIN_CAP) { atomicAdd(&bar[XB_TMO], 1u); break; } }
    }
    nloc = mine > 0u ? mine : 1u; nx = cnt > 0u ? cnt : 1u;
}

__device__ __forceinline__ void xcd_barrier(const XcdBarrier& b) {
    asm volatile("s_waitcnt vmcnt(0)" ::: "memory");
    __syncthreads();
    if (threadIdx.x == 0) {
        unsigned* bar = b.bar;
        __builtin_amdgcn_s_waitcnt(0);
        unsigned nloc = b.st[0], nx = b.st[1];
        if (nloc == 0u) { xcd_barrier_complete(bar, b.x, nloc, nx); b.st[0] = nloc; b.st[1] = nx; }
        const unsigned old = xb_add(&bar[XB_XSUB(b.x)], 1u);
        const unsigned gen = old / nloc;
        if (old + 1u == (gen + 1u) * nloc) {
            __builtin_amdgcn_fence(__ATOMIC_RELEASE, "agent");
            asm volatile("s_waitcnt vmcnt(0)" ::: "memory");
            const unsigned og = xb_add(&bar[XB_TOP], 1u);
            const unsigned tg = og / nx;
            if (og + 1u == (tg + 1u) * nx) xb_add(&bar[XB_TOPGEN], 1u);
            else XB_SPIN(xb_ld(&bar[XB_TOPGEN]) == tg, bar);
            __builtin_amdgcn_fence(__ATOMIC_ACQUIRE, "agent");
            xb_add(&bar[XB_XGEN(b.x)], 1u);
            asm volatile("s_waitcnt vmcnt(0)" ::: "memory");
        } else {
            XB_SPIN(xb_ld(&bar[XB_XGEN(b.x)]) == gen, bar);
            __builtin_amdgcn_fence(__ATOMIC_ACQUIRE, "agent");
            asm volatile("s_waitcnt vmcnt(0)" ::: "memory");
        }
    }
    __syncthreads();
}


constexpr int NWAVES = 8, NTHR = 512;
constexpr int D = 1024, NB = 8, SEQ = 2048, CTXL = 256;
constexpr int M_CTX = NB * CTXL, M_LAT = NB * SEQ, M_ALL = M_CTX + M_LAT;
constexpr int RWC = 1760, MIXIN = 3312, ZLD = 3328, FF = 2816, NE = 8;
constexpr int PRV = 9 * 512;
constexpr int MOE_ROWS = 34816;
constexpr size_t MiB = 1u << 20;
constexpr size_t WS_CTL = 0, CTL_ZERO_BYTES = 1 * MiB;
constexpr size_t WS_MODS = 1 * MiB;
constexpr size_t WS_TOK = 1 * MiB + 512 * 1024;
constexpr size_t WS_WIN_T = 2 * MiB;
constexpr size_t WS_WOUT_T = WS_WIN_T + (size_t)ZLD * D * 2;
constexpr size_t WS_W13_T = WS_WOUT_T + 2 * MiB;
constexpr size_t WS_W2_T = WS_W13_T + 11 * MiB;
constexpr size_t WS_QKV_T = WS_W2_T + (size_t)D * FF * 2;
constexpr size_t WS_NAO_T = WS_QKV_T + 6 * MiB;
constexpr size_t WS_HCTX = 35 * MiB;
constexpr size_t WS_A = 43 * MiB;
constexpr size_t WS_R = 79 * MiB;
constexpr size_t WS_Z = WS_R;
constexpr size_t WS_PR = 196 * MiB;
constexpr size_t WS_PM = 358 * MiB;
constexpr size_t WS_DT = 394 * MiB;
constexpr size_t WS_BONUS = 395 * MiB + 256 * 1024;
constexpr size_t WS_GATE = 396 * MiB;
constexpr size_t WS_ZG = 414 * MiB;
constexpr size_t WS_YRW = WS_R;
constexpr size_t WS_YMB = WS_R + 36 * MiB;
constexpr size_t WS_HID = WS_R;
constexpr size_t WS_MOEW13 = 316 * MiB;
constexpr size_t WS_MOEW2 = 404 * MiB;
constexpr size_t WS_Q = WS_R, WS_K = WS_R + 36 * MiB, WS_V = WS_R + 72 * MiB;
constexpr size_t WS_O = WS_R + 108 * MiB;
constexpr size_t WS_A4 = 111 * MiB;
constexpr size_t WS_XG = 43 * MiB;
constexpr size_t WS_HIDG = 111 * MiB;
constexpr size_t WS_YG = 43 * MiB;
constexpr size_t WS_SLAB6 = WS_R;
constexpr size_t WS_SLAB9 = WS_R + 99 * MiB;
constexpr size_t WS_TAIL = 316 * MiB;
constexpr size_t WS_END = 448 * MiB;
static_assert(WS_NAO_T + 2 * MiB <= WS_HCTX && WS_ZG + 18 * MiB <= WS_END && WS_MOEW2 + 44 * MiB <= WS_END && WS_HIDG + (size_t)MOE_ROWS * FF * 2 <= WS_MOEW13, "ws map");
static_assert(WS_Z + (size_t)M_ALL * ZLD * 2 <= WS_PR && WS_PR + (size_t)M_ALL * PRV * 2 <= WS_PM && WS_XG + (size_t)MOE_ROWS * D * 2 <= WS_HIDG, "ws map 2");
constexpr int CW_TMO = 0, CW_CODE = 1, CW_BAR = 4096, CW_CNT = 8192, CW_CNTB = 16384;
constexpr int RING_BYTES = 131072, LDSCTL_OFF = RING_BYTES, MISC_OFF = LDSCTL_OFF + 320, LDS_BYTES = 147456;

typedef unsigned v2u __attribute__((ext_vector_type(2)));
typedef float v2f __attribute__((ext_vector_type(2)));
typedef short s16x4 __attribute__((ext_vector_type(4)));
typedef short v4i16_t __attribute__((ext_vector_type(4)));
__device__ __forceinline__ float bflo(unsigned u) { return __uint_as_float(u << 16); }
__device__ __forceinline__ float bfhi(unsigned u) { return __uint_as_float(u & 0xffff0000u); }
__device__ __forceinline__ float ldbf(const bf16* p) { return __uint_as_float((unsigned)(*p) << 16); }
__device__ __forceinline__ float sigm(float x) { return __builtin_amdgcn_rcpf(1.f + __expf(-x)); }
__device__ __forceinline__ bf16x8 pack8(const f32x4& a, const f32x4& b) {
    v4u w; w.x = pk2(a[0], a[1]); w.y = pk2(a[2], a[3]); w.z = pk2(b[0], b[1]); w.w = pk2(b[2], b[3]); return __builtin_bit_cast(bf16x8, w);
}
template <int CTRL> __device__ __forceinline__ float dppf(float x) { return __int_as_float(__builtin_amdgcn_update_dpp(0, __float_as_int(x), CTRL, 0xF, 0xF, true)); }
__device__ __forceinline__ float sum8(float x) { x += dppf<0xB1>(x); x += dppf<0x4E>(x); x += dppf<0x141>(x); return x; }
__device__ __forceinline__ float sum16(float x) { x = sum8(x); x += dppf<0x140>(x); return x; }
__device__ __forceinline__ float rlf(float v, int l) { return __int_as_float(__builtin_amdgcn_readlane(__float_as_int(v), l)); }
__device__ __forceinline__ float wave_sum(float v) { v = sum16(v); return (rlf(v, 0) + rlf(v, 16)) + (rlf(v, 32) + rlf(v, 48)); }
__device__ __forceinline__ float half_sum(float v, int lane) { v = sum16(v); const float lo = rlf(v, 0) + rlf(v, 16), hi = rlf(v, 32) + rlf(v, 48); return lane < 32 ? lo : hi; }

struct Frame {
    LAS unsigned char* lds;
    volatile LAS unsigned* MISC;
    gu32* ctl;
    int tid, lane, wave, G, bid;
};

__device__ __forceinline__ void tr_item(const float* W, int K, int N, bf16* WT, int drow0, int k0, int n0, LAS float* scr, int lane) {
    const int nn = n0 + (lane & 31);
    float t[32];
#pragma unroll
    for (int i = 0; i < 32; ++i) { const int kk = 2 * i + (lane >> 5); t[i] = (nn < N) ? W[(size_t)(k0 + kk) * N + nn] : 0.f; }
#pragma unroll
    for (int i = 0; i < 32; ++i) { const int kk = 2 * i + (lane >> 5); scr[kk * 33 + (lane & 31)] = t[i]; }
    LDS_WAIT(); asm volatile("" ::: "memory");
    const int c = lane & 7;
#pragma unroll
    for (int j = 0; j < 4; ++j) { const int n = (lane >> 3) + 8 * j; const LAS float* s = scr + (8 * c) * 33 + n;
        v4u o; o.x = pk2(s[0 * 33], s[1 * 33]); o.y = pk2(s[2 * 33], s[3 * 33]); o.z = pk2(s[4 * 33], s[5 * 33]); o.w = pk2(s[6 * 33], s[7 * 33]);
        *(GAS v4u*)(WT + (size_t)(drow0 + n) * K + k0 + 8 * c) = o; }
    LDS_WAIT(); asm volatile("" ::: "memory");
}
template <int MODE  >
__device__ __forceinline__ bool tr_matrix(int& it, const float* W, int K, int N, bf16* WT, LAS float* scr, int lane) {
    const int nblk = (N + 31) / 32, items = (K / 64) * nblk;
    if (it >= items) { it -= items; return false; }
    const int kb = it / nblk, nb = it % nblk, n0 = nb * 32;
    int drow0 = n0;
    if (MODE == 1) drow0 = (n0 >> 7) * 256 + (n0 & 127);
    if (MODE == 2) drow0 = (n0 >> 7) * 256 + 128 + (n0 & 127);
    tr_item(W, K, N, WT, drow0, kb * 64, n0, scr, lane);
    return true;
}

__device__ __forceinline__ void p0_phase(Frame& F, const float* c, const float* c_ctx, const float* w_ada, const float* b_ada, float* mods,
                                         const float* mix_w_in, const float* mix_w_out, const float* ffn_w1, const float* ffn_w3, const float* ffn_w2,
                                         const float* na_w_qkv, const float* na_w_out, unsigned char* ws) {
    for (int u = F.bid; u < 192; u += F.G) {
        LAS float* sc = (LAS float*)(F.lds);
        LAS float* red = (LAS float*)(F.lds + 36864);
        for (int i = F.tid; i < 9 * 1024; i += NTHR) { const int b = i >> 10, k = i & 1023; const float v = (b < 8) ? c[b * 1024 + k] : c_ctx[k]; sc[i] = v / (1.f + __expf(-v)); }
        __syncthreads();
        const int layer = u / 96, col = (u % 96) * 64 + F.lane;
        const float* W = w_ada + (size_t)layer * 1024 * 6144 + col;
        float acc[9];
#pragma unroll
        for (int b = 0; b < 9; ++b) acc[b] = 0.f;
        const int k0 = F.wave * 128;
#pragma unroll 8
        for (int k = 0; k < 128; ++k) { const float w = W[(size_t)(k0 + k) * 6144];
#pragma unroll
            for (int b = 0; b < 9; ++b) acc[b] += sc[b * 1024 + k0 + k] * w; }
#pragma unroll
        for (int b = 0; b < 9; ++b) red[(F.wave * 9 + b) * 64 + F.lane] = acc[b];
        __syncthreads();
        if (F.wave == 0) {
#pragma unroll
            for (int b = 0; b < 9; ++b) { float s = 0.f;
#pragma unroll
                for (int w = 0; w < 8; ++w) s += red[(w * 9 + b) * 64 + F.lane];
                mods[(layer * 9 + b) * 6144 + col] = s + b_ada[layer * 6144 + col]; }
        }
        __syncthreads();
    }
    LAS float* scr = (LAS float*)(F.lds + 57344 + F.wave * 8704);
    const int gw = F.bid * NWAVES + F.wave, NGW = F.G * NWAVES;
    constexpr int NITEMS = 16 * 104 + 512 + 1408 * 3 + 1536 + 512;
    for (int it0 = gw; it0 < NITEMS; it0 += NGW) {
        int it = it0;
        if (tr_matrix<0>(it, mix_w_in, 1024, MIXIN, (bf16*)(ws + WS_WIN_T), scr, F.lane)) continue;
        if (tr_matrix<0>(it, mix_w_out, 1024, 1024, (bf16*)(ws + WS_WOUT_T), scr, F.lane)) continue;
        if (tr_matrix<1>(it, ffn_w1, 1024, FF, (bf16*)(ws + WS_W13_T), scr, F.lane)) continue;
        if (tr_matrix<2>(it, ffn_w3, 1024, FF, (bf16*)(ws + WS_W13_T), scr, F.lane)) continue;
        if (tr_matrix<0>(it, ffn_w2, FF, 1024, (bf16*)(ws + WS_W2_T), scr, F.lane)) continue;
        if (tr_matrix<0>(it, na_w_qkv, 1024, 3072, (bf16*)(ws + WS_QKV_T), scr, F.lane)) continue;
        tr_matrix<0>(it, na_w_out, 1024, 1024, (bf16*)(ws + WS_NAO_T), scr, F.lane);
    }
}
constexpr int MOE_ITEMS = NE * 1408 * 3, MOE_ITEMS_P6 = 0, MOE_ITEMS_P8 = 10240, MOE_ITEMS_P9 = 23552, MOE_ITEMS_P11 = 0, MOE_ITEMS_P7 = MOE_ITEMS - MOE_ITEMS_P8 - MOE_ITEMS_P9 - MOE_ITEMS_P11;
__device__ __forceinline__ void moe_weight_phase(Frame& F, const float* w1, const float* w3, const float* w2, unsigned char* ws, int lo, int hi, int widx, int nw) {
    LAS float* scr = (LAS float*)(F.lds + 57344 + F.wave * 8704);
    const int gw = widx * NWAVES + F.wave, NGW = nw * NWAVES;
    constexpr int PER_E = 1408 * 3;
    for (int it0 = lo + gw; it0 < hi; it0 += NGW) {
        const int e = it0 / PER_E; int it = it0 % PER_E;
        bf16* w13t = (bf16*)(ws + WS_MOEW13) + (size_t)e * 5632 * 1024; bf16* w2t = (bf16*)(ws + WS_MOEW2) + (size_t)e * 1024 * FF;
        if (tr_matrix<1>(it, w1 + (size_t)e * 1024 * FF, 1024, FF, w13t, scr, F.lane)) continue;
        if (tr_matrix<2>(it, w3 + (size_t)e * 1024 * FF, 1024, FF, w13t, scr, F.lane)) continue;
        tr_matrix<0>(it, w2 + (size_t)e * 1024 * FF, FF, 1024, w2t, scr, F.lane);
    }
}

struct RowIn { f32x4 x[4], sh[4], sc[4]; };
__device__ __forceinline__ void row_fetch(RowIn& R, const float* xrow, const float* sh, const float* sc, int lane) {
#pragma unroll
    for (int j = 0; j < 4; ++j) { R.x[j] = ((const GAS f32x4*)xrow)[lane + 64 * j]; R.sh[j] = ((const GAS f32x4*)sh)[lane + 64 * j]; R.sc[j] = ((const GAS f32x4*)sc)[lane + 64 * j]; }
}
__device__ __forceinline__ void row_finish(const RowIn& R, const f32x4 (&gg)[4], bf16* orow, int lane, f32x4 (&a)[4], const float* slab = nullptr, int nslab = 0, float* wb = nullptr) {
    float ss = 0.f;
#pragma unroll
    for (int j = 0; j < 4; ++j) a[j] = R.x[j];
    for (int s = 0; s < nslab; ++s) { const GAS f32x4* sr = (const GAS f32x4*)(slab + (size_t)s * (2048 * 1024)) + lane;
#pragma unroll
        for (int j = 0; j < 4; ++j) a[j] += sr[64 * j]; }
    if (wb) { GAS f32x4* w4 = (GAS f32x4*)wb + lane;
#pragma unroll
        for (int j = 0; j < 4; ++j) w4[64 * j] = a[j]; }
#pragma unroll
    for (int j = 0; j < 4; ++j) ss += (a[j].x * a[j].x + a[j].y * a[j].y) + (a[j].z * a[j].z + a[j].w * a[j].w);
    const float rs = rsqrtf(wave_sum(ss) * (1.f / 1024.f) + 1e-6f);
    GAS unsigned long long* o8 = (GAS unsigned long long*)orow + lane;
#pragma unroll
    for (int j = 0; j < 4; ++j) {
        a[j] = (a[j] * rs) * gg[j] * (R.sc[j] + 1.f) + R.sh[j];
        o8[64 * j] = (unsigned long long)pk2(a[j].x, a[j].y) | ((unsigned long long)pk2(a[j].z, a[j].w) << 32);
    }
}
__device__ __forceinline__ void normmod_phase(Frame& F, const float* src_ctx, const float* src_lat, const float* g, const float* mods_l, int off_shift, int off_scale, bf16* dst, const float* slab = nullptr, int nslab = 0, float* wb_ctx = nullptr) {
    const int gw = F.bid * NWAVES + F.wave, NGW = F.G * NWAVES;
    f32x4 gg[4];
#pragma unroll
    for (int j = 0; j < 4; ++j) gg[j] = ((const GAS f32x4*)g)[F.lane + 64 * j];
    RowIn cur, nxt;
    int r = gw; bool have = r < M_ALL;
#define NM_FETCH(R_, r_) do { const bool ic_ = (r_) < M_CTX; const int rl_ = ic_ ? (r_) : (r_) - M_CTX; const float* mp_ = mods_l + (ic_ ? 8 : (rl_ >> 11)) * 6144; \
        row_fetch(R_, (ic_ ? src_ctx : src_lat) + (size_t)rl_ * D, mp_ + off_shift, mp_ + off_scale, F.lane); } while (0)
    if (have) NM_FETCH(cur, r);
    while (have) {
        const int rn = r + NGW; const bool hn = rn < M_ALL;
        if (hn) NM_FETCH(nxt, rn);
        const bool isctx = r < M_CTX; const int rl = isctx ? r : r - M_CTX;
        f32x4 a[4];
        if (isctx) row_finish(cur, gg, dst + (size_t)r * D, F.lane, a, slab ? slab + (size_t)rl * D : nullptr, nslab, wb_ctx ? wb_ctx + (size_t)rl * D : nullptr);
        else row_finish(cur, gg, dst + (size_t)r * D, F.lane, a);
        cur = nxt; r = rn; have = hn;
    }
#undef NM_FETCH
}

namespace pg8 {
struct EpiResGate {
    static constexpr bool PERM = false, AFTER_DRAIN = false;
    const float* base_c; const float* base_l; float* out_c; float* out_l; const float* mods_l; int gate_off; int ctx_tiles;
    __device__ __forceinline__ void operator()(const f32x4 (&acc)[2][2][4][2], const Unit& u, int wr, int wc, int fr, int fq) const {
        const bool isctx = u.pm < ctx_tiles; const int rt = isctx ? u.pm : u.pm - ctx_tiles; const int mi = isctx ? 8 : (rt >> 3);
        const float* base = isctx ? base_c : base_l; float* out = isctx ? out_c : out_l;
        const int col0 = u.pn * BM + wc * 32 + 4 * fq; const float* gp = mods_l + mi * 6144 + gate_off + col0;
        f32x4 gv[2][2];
#pragma unroll
        for (int bj = 0; bj < 2; ++bj)
#pragma unroll
            for (int n = 0; n < 2; ++n) gv[bj][n] = *(const f32x4*)(gp + bj * HALF + n * 16);
#pragma unroll
        for (int ai = 0; ai < 2; ++ai)
#pragma unroll
            for (int m = 0; m < 4; ++m) { const size_t off = (size_t)(rt * BM + ai * HALF + wr * 64 + m * 16 + fr) * 1024 + col0;
#pragma unroll
                for (int bj = 0; bj < 2; ++bj)
#pragma unroll
                    for (int n = 0; n < 2; ++n) { const f32x4 b = *(const f32x4*)(base + off + bj * HALF + n * 16); *(f32x4*)(out + off + bj * HALF + n * 16) = b + gv[bj][n] * acc[ai][bj][m][n]; } }
    }
};
struct EpiSwiGLU {
    static constexpr bool PERM = true, AFTER_DRAIN = false;
    bf16_t* O; int ldo; int nt_mod;
    __device__ __forceinline__ void operator()(const f32x4 (&acc)[2][2][4][2], const Unit& u, int wr, int wc, int fr, int fq) const {
        const int pnl = u.pn % nt_mod; const int row0 = u.pm * BM + wr * 64 + fr, col0 = pnl * HALF + wc * 32 + 8 * fq;
#pragma unroll
        for (int ai = 0; ai < 2; ++ai)
#pragma unroll
            for (int m = 0; m < 4; ++m) { bf16_t* rowp = O + (size_t)(row0 + ai * HALF + m * 16) * ldo + col0;
                float h[8];
#pragma unroll
                for (int n = 0; n < 2; ++n)
#pragma unroll
                    for (int e = 0; e < 4; ++e) { const float a = acc[ai][0][m][n][e], b = acc[ai][1][m][n][e]; h[n * 4 + e] = a * b * __builtin_amdgcn_rcpf(1.f + __expf(-a)); }
                u32x4 w; w.x = cvt_pk_bf16(h[0], h[1]); w.y = cvt_pk_bf16(h[2], h[3]); w.z = cvt_pk_bf16(h[4], h[5]); w.w = cvt_pk_bf16(h[6], h[7]);
                PG8_ST16(O, rowp, w); }
    }
};
struct EpiPlainMod {
    static constexpr bool PERM = true, AFTER_DRAIN = false;
    bf16_t* O; int ldo; int nt_mod;
    __device__ __forceinline__ void operator()(const f32x4 (&acc)[2][2][4][2], const Unit& u, int wr, int wc, int fr, int fq) const {
        const int pnl = u.pn % nt_mod; const int row0 = u.pm * BM + wr * 64 + fr, col0 = pnl * BM + wc * 32 + 8 * fq;
#pragma unroll
        for (int ai = 0; ai < 2; ++ai)
#pragma unroll
            for (int m = 0; m < 4; ++m) { bf16_t* rowp = O + (size_t)(row0 + ai * HALF + m * 16) * ldo + col0;
#pragma unroll
                for (int bj = 0; bj < 2; ++bj) { const f32x4 v0 = acc[ai][bj][m][0], v1 = acc[ai][bj][m][1];
                    u32x4 w; w.x = cvt_pk_bf16(v0[0], v0[1]); w.y = cvt_pk_bf16(v0[2], v0[3]); w.z = cvt_pk_bf16(v1[0], v1[1]); w.w = cvt_pk_bf16(v1[2], v1[3]);
                    PG8_ST16(O, rowp + bj * HALF, w); } }
    }
};
struct SplitKOrder {
    int ntm, nN, ns, kslice, G, c;
    __device__ __forceinline__ bool next(int i, Unit& u) const {
        const int L = i * G + c; if (L >= ntm * nN * ns) return false;
        const int ks = L % ns, t = L / ns; u.pn = t % nN; u.pm = t / nN; u.k0 = ks * kslice; return true;
    }
    __device__ __forceinline__ void a_ready(const Unit&) const {}
    __device__ __forceinline__ void done(const Unit&) const {}
};
struct EpiSlabGate {
    static constexpr bool PERM = false, AFTER_DRAIN = false;
    float* slab; const float* gate; int kslice;
    __device__ __forceinline__ void operator()(const f32x4 (&acc)[2][2][4][2], const Unit& u, int wr, int wc, int fr, int fq) const {
        const int col0 = u.pn * BM + wc * 32 + 4 * fq; float* out = slab + (size_t)(u.k0 / kslice) * (2048 * 1024);
        f32x4 gv[2][2];
#pragma unroll
        for (int bj = 0; bj < 2; ++bj)
#pragma unroll
            for (int n = 0; n < 2; ++n) gv[bj][n] = *(const f32x4*)(gate + col0 + bj * HALF + n * 16);
#pragma unroll
        for (int ai = 0; ai < 2; ++ai)
#pragma unroll
            for (int m = 0; m < 4; ++m) { float* op = out + (size_t)(u.pm * BM + ai * HALF + wr * 64 + m * 16 + fr) * 1024 + col0;
#pragma unroll
                for (int bj = 0; bj < 2; ++bj)
#pragma unroll
                    for (int n = 0; n < 2; ++n) *(f32x4*)(op + bj * HALF + n * 16) = gv[bj][n] * acc[ai][bj][m][n]; }
    }
};
struct MoeOrder {
    int tb[9]; int ntn, G, c; int limit = 0x7fffffff;
    __device__ __forceinline__ bool next(int i, Unit& u) const {
        const int L = i * G + c; if (L >= tb[8] * ntn || L >= limit) return false;
        const int mt = L / ntn, pn = L % ntn; int e = 0;
#pragma unroll
        for (int k = 1; k < 8; ++k) e += (mt >= tb[k]) ? 1 : 0;
        u.pm = mt; u.pn = e * ntn + pn; return true;
    }
    __device__ __forceinline__ void a_ready(const Unit&) const {}
    __device__ __forceinline__ void done(const Unit&) const {}
};
struct MoeTailOrder {
    int tb[9]; int first, ntail, G, c;
    __device__ __forceinline__ bool next(int i, Unit& u) const {
        const int L = i * G + c; if (L >= ntail * 11) return false;
        const int tu = L / 11, ks = L % 11, gu = first + tu, mt = gu >> 2, pn = gu & 3; int e = 0;
#pragma unroll
        for (int k = 1; k < 8; ++k) e += (mt >= tb[k]) ? 1 : 0;
        u.pm = mt; u.pn = e * 4 + pn; u.k0 = ks * 256; return true;
    }
    __device__ __forceinline__ void a_ready(const Unit&) const {}
    __device__ __forceinline__ void done(const Unit&) const {}
};
struct EpiTailSlab {
    static constexpr bool PERM = false, AFTER_DRAIN = false;
    float* slab; int first, ntail;
    __device__ __forceinline__ void operator()(const f32x4 (&acc)[2][2][4][2], const Unit& u, int wr, int wc, int fr, int fq) const {
        const int col0 = (u.pn & 3) * BM + wc * 32 + 4 * fq; float* out = slab + (size_t)(u.k0 >> 8) * ((size_t)(ntail >> 2) * 256 * 1024);
        const int rt = u.pm - (first >> 2);
#pragma unroll
        for (int ai = 0; ai < 2; ++ai)
#pragma unroll
            for (int m = 0; m < 4; ++m) { float* op = out + (size_t)(rt * BM + ai * HALF + wr * 64 + m * 16 + fr) * 1024 + col0;
#pragma unroll
                for (int bj = 0; bj < 2; ++bj)
#pragma unroll
                    for (int n = 0; n < 2; ++n) *(f32x4*)(op + bj * HALF + n * 16) = acc[ai][bj][m][n]; }
    }
};
}

struct PrepIn { const float *rw_mu, *rw_w0, *rw_w_up, *rw_a0, *rw_a_up, *rw_g_up, *rw_k_k, *rw_k_a, *rw_r_k, *conv_w, *conv_b, *dt_bias; };
__device__ __forceinline__ bf16x8 gather8(const float* p, int stride) {
    v4u w; w.x = pk2(p[0], p[stride]); w.y = pk2(p[2 * stride], p[3 * stride]); w.z = pk2(p[4 * stride], p[5 * stride]); w.w = pk2(p[6 * stride], p[7 * stride]); return __builtin_bit_cast(bf16x8, w);
}
constexpr int ACT_ST = 464;
__device__ __forceinline__ void prepare_phase(Frame& F, const PrepIn& P, const bf16* Z, bf16* PR, bf16* PM, float* DT, float* BONUS, bf16* GATE, bf16* ZG) {
    LAS unsigned short* zs = (LAS unsigned short*)F.lds;
    LAS unsigned char* actb = F.lds + 24576;
    LAS float* cst = (LAS float*)(F.lds + 24576 + 16 * ACT_ST);
    const int tid = F.tid, lane = F.lane, fr = lane & 15, fq = lane >> 4, w = F.wave;
    const int hf = F.bid & 1, wl = w & 3, hd = 4 * hf + wl;
    __syncthreads();
    if (tid < 256) { const int c = 256 * hf + tid; cst[tid] = P.rw_w0[c]; cst[256 + tid] = P.rw_w0[512 + c]; cst[512 + tid] = P.rw_a0[c]; cst[768 + tid] = P.rw_a0[512 + c];
      cst[1024 + tid] = P.rw_k_k[c]; cst[1280 + tid] = P.rw_k_a[c]; cst[1536 + tid] = P.rw_r_k[c]; cst[1792 + tid] = P.rw_r_k[512 + c]; }
    bf16x8 W[16];
#pragma unroll
    for (int cb = 0; cb < 4; ++cb) { const int c = 64 * hd + 4 * fr + cb;
        if (w < 4) { W[cb] = gather8(P.rw_w_up + (size_t)(8 * fq) * 512 + c, 512); W[4 + cb] = gather8(P.rw_w_up + (size_t)(32 + 8 * fq) * 512 + c, 512);
                     W[8 + cb] = gather8(P.rw_a_up + (size_t)(8 * fq) * 512 + c, 512); W[12 + cb] = gather8(P.rw_a_up + (size_t)(32 + 8 * fq) * 512 + c, 512); }
        else { W[cb] = gather8(P.rw_g_up + (size_t)(8 * fq) * 512 + c, 512); W[4 + cb] = gather8(P.rw_g_up + (size_t)(32 + 8 * fq) * 512 + c, 512); W[8 + cb] = gather8(P.rw_g_up + (size_t)(64 + 8 * fq) * 512 + c, 512); W[12 + cb] = W[cb]; } }
    const int col0 = (tid < 256) ? (256 * hf + tid) : (512 + 256 * hf + tid - 256), col1 = (tid < 256) ? (1024 + 256 * hf + tid) : ((tid < 480) ? (1536 + tid - 256) : 1536);
    const int zo0 = tid, zo1 = 512 + (tid & 255);
    const float mu00 = P.rw_mu[col0], mu10 = P.rw_mu[RWC + col0], mu01 = P.rw_mu[col1], mu11 = P.rw_mu[RWC + col1];
    float cw[5];
#pragma unroll
    for (int k = 0; k < 5; ++k) cw[k] = P.conv_w[k * 1024 + 512 * hf + tid];
    const float cbv = P.conv_b[512 * hf + tid], dtb = P.dt_bias[tid & 15];
    __syncthreads();

#ifndef PREP_REPS
#define PREP_REPS 1
#endif
    for (int rb_ = F.bid >> 1; rb_ < (M_ALL / 16) * PREP_REPS; rb_ += (F.G >> 1)) {
        const int rb = rb_ % (M_ALL / 16); const int g0 = rb * 16; const bool isctx = g0 < M_CTX; const int T = isctx ? CTXL : SEQ; const int t0 = isctx ? (g0 & (CTXL - 1)) : ((g0 - M_CTX) & (SEQ - 1));
        const bf16* zb = Z + (size_t)g0 * ZLD;
        const bool hp = t0 > 0, hn = (t0 + 16 < T), hp2 = t0 >= 2, hn2 = (t0 + 17 < T);
        float z0[18], z1[18], x[20];
        const int ccol = RWC + 512 + 512 * hf + tid;
#pragma unroll
        for (int i = 0; i < 18; ++i) { const bool ok = (i == 0) ? hp : ((i == 17) ? hn : true); z0[i] = ok ? ldbf(zb + (ptrdiff_t)(i - 1) * ZLD + col0) : 0.f; z1[i] = ok ? ldbf(zb + (ptrdiff_t)(i - 1) * ZLD + col1) : 0.f; }
#pragma unroll
        for (int i = 0; i < 20; ++i) { const bool ok = (i == 0) ? hp2 : (i == 1) ? hp : (i == 18) ? hn : (i == 19) ? hn2 : true; x[i] = ok ? ldbf(zb + (ptrdiff_t)(i - 2) * ZLD + ccol) : 0.f; }
#pragma unroll
        for (int tb = 0; tb < 16; ++tb) zs[tb * 768 + zo0] = (unsigned short)f2bf(z0[tb + 1] + mu00 * (z0[tb] - z0[tb + 1]) + mu10 * (z0[tb + 2] - z0[tb + 1]));
        {
            const int a = tid - 256;
#pragma unroll
            for (int tb = 0; tb < 16; ++tb) {
                const float zsft = z1[tb + 1] + mu01 * (z1[tb] - z1[tb + 1]) + mu11 * (z1[tb + 2] - z1[tb + 1]);
                if (tid < 256) zs[tb * 768 + zo1] = (unsigned short)f2bf(zsft);
                else if (tid < 480) { const float sg = sigm((a < 64) ? 2.f * zsft : zsft); const float av = (a < 64) ? (2.f * sg - 1.f) : ((a < 128) ? zsft : sg);
                    *(LAS unsigned short*)(actb + tb * ACT_ST + a * 2) = (unsigned short)f2bf(av); }
            }
        }
#pragma unroll
        for (int tb = 0; tb < 16; ++tb) {
            float y = cbv + cw[0] * x[tb] + cw[1] * x[tb + 1] + cw[2] * x[tb + 2] + cw[3] * x[tb + 3] + cw[4] * x[tb + 4];
            y = y * sigm(y);
            PM[(size_t)(g0 + tb) * 1024 + 512 * hf + tid] = (bf16)f2bf(y);
        }
        { const int tb = tid >> 5, cc = tid & 31;
          *(GAS v4u*)(ZG + (size_t)(g0 + tb) * 512 + 256 * hf + cc * 8) = *(const GAS v4u*)(zb + (size_t)tb * ZLD + RWC + 256 * hf + cc * 8); }
        if (hf == 0 && tid < 256) { const int tb = tid >> 4, cc = tid & 15; const float x = ldbf(zb + (size_t)tb * ZLD + RWC + 1536 + cc) + dtb; DT[(size_t)(g0 + tb) * 16 + cc] = (x > 20.f) ? x : log1pf(__expf(x)); }
        __syncthreads();
        const f32x4 zero = {0.f, 0.f, 0.f, 0.f};
        const int cl0 = 64 * wl + 4 * fr;
        if (w < 4) {
            bf16x8 Af[4];
#pragma unroll
            for (int kb = 0; kb < 4; ++kb) Af[kb] = *(const LAS bf16x8*)(actb + fr * ACT_ST + kb * 64 + fq * 16);
            f32x4 lw0[4], lw1[4], ia0[4], ia1[4];
#pragma unroll
            for (int cb = 0; cb < 4; ++cb) {
                lw0[cb] = __builtin_amdgcn_mfma_f32_16x16x32_bf16(Af[0], W[cb], zero, 0, 0, 0); lw1[cb] = __builtin_amdgcn_mfma_f32_16x16x32_bf16(Af[1], W[4 + cb], zero, 0, 0, 0);
                ia0[cb] = __builtin_amdgcn_mfma_f32_16x16x32_bf16(Af[2], W[8 + cb], zero, 0, 0, 0); ia1[cb] = __builtin_amdgcn_mfma_f32_16x16x32_bf16(Af[3], W[12 + cb], zero, 0, 0, 0);
            }
            const f32x4 w00 = *(const LAS f32x4*)(cst + cl0), w01 = *(const LAS f32x4*)(cst + 256 + cl0), a00 = *(const LAS f32x4*)(cst + 512 + cl0), a01 = *(const LAS f32x4*)(cst + 768 + cl0);
            const f32x4 kkc = *(const LAS f32x4*)(cst + 1024 + cl0), kac = *(const LAS f32x4*)(cst + 1280 + cl0), rk0 = *(const LAS f32x4*)(cst + 1536 + cl0), rk1 = *(const LAS f32x4*)(cst + 1792 + cl0);
#pragma unroll
            for (int e = 0; e < 4; ++e) {
                const int tok = 4 * fq + e; const size_t g = (size_t)(g0 + tok);
                const v2u ru = *(const LAS v2u*)(zs + tok * 768 + cl0), ku = *(const LAS v2u*)(zs + tok * 768 + 256 + cl0), vu = *(const LAS v2u*)(zs + tok * 768 + 512 + cl0);
                const f32x4 r = {bflo(ru.x), bfhi(ru.x), bflo(ru.y), bfhi(ru.y)}, k = {bflo(ku.x), bfhi(ku.x), bflo(ku.y), bfhi(ku.y)};
                const f32x4 kks = k * kkc;
                const float ssq = sum16((kks[0] * kks[0] + kks[1] * kks[1]) + (kks[2] * kks[2] + kks[3] * kks[3]));
                const float rn = __builtin_amdgcn_rcpf(fmaxf(sqrtf(ssq), 1e-12f));
                float ee0[4], ee1[4], kd0[4], kd1[4], bb0[4], bb1[4], na[4]; float bon = 0.f;
#pragma unroll
                for (int cb = 0; cb < 4; ++cb) {
                    ee0[cb] = 0.60653066f * sigm(w00[cb] + lw0[cb][e]); ee1[cb] = 0.60653066f * sigm(w01[cb] + lw1[cb][e]);
                    const float ic0 = sigm(a00[cb] + ia0[cb][e]), ic1 = sigm(a01[cb] + ia1[cb][e]);
                    const float kkn = kks[cb] * rn;
                    kd0[cb] = k[cb] * (1.f + (ic0 - 1.f) * kac[cb]); kd1[cb] = k[cb] * (1.f + (ic1 - 1.f) * kac[cb]);
                    bon += r[cb] * (kd0[cb] * rk0[cb] + kd1[cb] * rk1[cb]);
                    na[cb] = -kkn; bb0[cb] = kkn * ic0; bb1[cb] = kkn * ic1;
                }
                bon = sum16(bon); if (fr == 0) BONUS[g * 8 + hd] = bon;
                bf16* pr = PR + g * PRV + 256 * hf + cl0;
                *(GAS v2u*)(pr) = ru; *(GAS v2u*)(pr + 512) = vu;
                v2u o;
                o.x = pk2(na[0], na[1]); o.y = pk2(na[2], na[3]); *(GAS v2u*)(pr + 1024) = o;
                o.x = pk2(ee0[0], ee0[1]); o.y = pk2(ee0[2], ee0[3]); *(GAS v2u*)(pr + 1536) = o;
                o.x = pk2(kd0[0], kd0[1]); o.y = pk2(kd0[2], kd0[3]); *(GAS v2u*)(pr + 2048) = o;
                o.x = pk2(bb0[0], bb0[1]); o.y = pk2(bb0[2], bb0[3]); *(GAS v2u*)(pr + 2560) = o;
                o.x = pk2(ee1[0], ee1[1]); o.y = pk2(ee1[2], ee1[3]); *(GAS v2u*)(pr + 3072) = o;
                o.x = pk2(kd1[0], kd1[1]); o.y = pk2(kd1[2], kd1[3]); *(GAS v2u*)(pr + 3584) = o;
                o.x = pk2(bb1[0], bb1[1]); o.y = pk2(bb1[2], bb1[3]); *(GAS v2u*)(pr + 4096) = o;
            }
        } else {
            bf16x8 Af[3];
#pragma unroll
            for (int kb = 0; kb < 3; ++kb) Af[kb] = *(const LAS bf16x8*)(actb + fr * ACT_ST + (4 + kb) * 64 + fq * 16);
            f32x4 gt[4];
#pragma unroll
            for (int cb = 0; cb < 4; ++cb) {
                gt[cb] = __builtin_amdgcn_mfma_f32_16x16x32_bf16(Af[0], W[cb], zero, 0, 0, 0);
                gt[cb] = __builtin_amdgcn_mfma_f32_16x16x32_bf16(Af[1], W[4 + cb], gt[cb], 0, 0, 0); gt[cb] = __builtin_amdgcn_mfma_f32_16x16x32_bf16(Af[2], W[8 + cb], gt[cb], 0, 0, 0);
            }
#pragma unroll
            for (int e = 0; e < 4; ++e) { v2u o; o.x = pk2(gt[0][e], gt[1][e]); o.y = pk2(gt[2][e], gt[3][e]); *(GAS v2u*)(GATE + (size_t)(g0 + 4 * fq + e) * 512 + 256 * hf + cl0) = o; }
        }
        __syncthreads();
    }
}

template <int SH> __device__ __forceinline__ float dpp_shr(float x) { return __int_as_float(__builtin_amdgcn_update_dpp(0, __float_as_int(x), 0x110 + SH, 0xF, 0xF, true)); }
__device__ __forceinline__ int scan_row16(int c, int t, int b, int d) {
    const int st = c * 16 + t; const int seg = (st >= CTXL) ? 1 : 0; const int T = seg ? SEQ : CTXL; const int sl = st - seg * CTXL;
    return (seg ? (M_CTX + b * SEQ) : b * CTXL) + (d ? (T - 1 - sl) : sl);
}
__device__ __forceinline__ v4u scale8(const v4u u, float s) {
    v4u o; o.x = pk2(bflo(u.x) * s, bfhi(u.x) * s); o.y = pk2(bflo(u.y) * s, bfhi(u.y) * s); o.z = pk2(bflo(u.z) * s, bfhi(u.z) * s); o.w = pk2(bflo(u.w) * s, bfhi(u.w) * s); return o;
}
__device__ __forceinline__ bf16x8 pack4z(const f32x4& a) { v4u w; w.x = pk2(a[0], a[1]); w.y = pk2(a[2], a[3]); w.z = 0u; w.w = 0u; return __builtin_bit_cast(bf16x8, w); }
__device__ __forceinline__ bf16x8 tr4z(const LAS unsigned char* p) {
    const v2u t = __builtin_bit_cast(v2u, __builtin_amdgcn_ds_read_tr16_b64_v4i16((LAS v4i16_t*)p)); v4u w; w.x = t.x; w.y = t.y; w.z = 0u; w.w = 0u; return __builtin_bit_cast(bf16x8, w);
}
__device__ __forceinline__ bf16x8 cat44(const v2u a, const v2u b) { v4u w; w.x = a.x; w.y = a.y; w.z = b.x; w.w = b.y; return __builtin_bit_cast(bf16x8, w); }
constexpr int NCH16 = (CTXL + SEQ) / 16;
__device__ __forceinline__ f32x4 mm16(const f32x4& xT_c, const f32x4& y_c, const f32x4& acc) {
    return __builtin_amdgcn_mfma_f32_16x16x32_bf16(pack4z(xT_c), pack4z(y_c), acc, 0, 0, 0);
}
constexpr int RING_FLAGS = 122880;
constexpr int NSLOT = 6;
__device__ __forceinline__ unsigned lds_flag_ld(volatile LAS unsigned* p) { return (unsigned)__builtin_amdgcn_readfirstlane((int)*p); }
__device__ __forceinline__ void ring_wait_full(volatile LAS unsigned* fl, int s, int c) { while (lds_flag_ld(fl + s) != (unsigned)(c + 1)) __builtin_amdgcn_s_sleep(1); asm volatile("" ::: "memory"); }
__device__ __forceinline__ void ring_wait_free(volatile LAS unsigned* fl, int s, int c, int nslot = NSLOT, unsigned ncons = 4u) { const unsigned want = ncons * (unsigned)(c / nslot); while (lds_flag_ld(fl + 8 + s) < want) __builtin_amdgcn_s_sleep(1); asm volatile("" ::: "memory"); }
__device__ __forceinline__ void ring_set_full(volatile LAS unsigned* fl, int s, int c, int lane) { asm volatile("s_waitcnt lgkmcnt(0)" ::: "memory"); if (lane == 0) fl[s] = (unsigned)(c + 1); }
__device__ __forceinline__ void ring_done(volatile LAS unsigned* fl, int s, int lane) { asm volatile("s_waitcnt lgkmcnt(0)" ::: "memory"); if (lane == 0) __hip_atomic_fetch_add((LAS unsigned*)(fl + 8 + s), 1u, __ATOMIC_RELAXED, __HIP_MEMORY_SCOPE_WORKGROUP); }

constexpr int RST = 144, RIMG = 16 * RST;
constexpr int RW_SLOT = 18432;
__device__ __forceinline__ void rwkv_block(Frame& F, int unit, const bf16* PR, bf16* YRW) {
    const int d = unit & 1, h = (unit >> 1) & 7, b = unit >> 4;
    const int lane = F.lane, fr = lane & 15, fq = lane >> 4, tq = (lane & 15) >> 2, tp = lane & 3;
    volatile LAS unsigned* fl = (volatile LAS unsigned*)(F.lds + RING_FLAGS);
    __syncthreads();
    if (F.tid < 16) fl[F.tid] = 0u;
    __syncthreads();
    if (F.wave >= 4) {
        const int p = F.wave - 4;
        const int ve = (3 + 3 * d) * 512, vb = (5 + 3 * d) * 512, vk = (4 + 3 * d) * 512;
        bf16x8 Ltri; { v4u w; w.x = ((4 * fq + 0 <= fr) ? 0x3F80u : 0u) | ((4 * fq + 1 <= fr) ? 0x3F800000u : 0u); w.y = ((4 * fq + 2 <= fr) ? 0x3F80u : 0u) | ((4 * fq + 3 <= fr) ? 0x3F800000u : 0u); w.z = 0u; w.w = 0u; Ltri = __builtin_bit_cast(bf16x8, w); }
        v4u rE[2], rA[2], rB[2], rK[2], rR[2], rV[2];
#define RW_LOAD(c_) do { \
        _Pragma("unroll") for (int i = 0; i < 2; ++i) { const int id = lane + 64 * i; const bf16* src = PR + (size_t)scan_row16((c_), id >> 3, b, d) * PRV + h * 64 + (id & 7) * 8; \
            rE[i] = *(const GAS v4u*)(src + ve); rA[i] = *(const GAS v4u*)(src + 1024); rB[i] = *(const GAS v4u*)(src + vb); rK[i] = *(const GAS v4u*)(src + vk); rR[i] = *(const GAS v4u*)(src); rV[i] = *(const GAS v4u*)(src + 512); } } while (0)
        RW_LOAD(p);
        for (int c = p; c < NCH16; c += 4) {
            const int s = c % NSLOT;
            LAS unsigned char* sb = F.lds + s * RW_SLOT;
            LAS unsigned char* RE = sb; LAS unsigned char* RA = sb + RIMG; LAS unsigned char* RB = sb + 2 * RIMG; LAS unsigned char* RK = sb + 3 * RIMG; LAS unsigned char* RR = sb + 4 * RIMG;
            LAS unsigned char* RV = sb + 5 * RIMG; LAS unsigned char* FRG = sb + 6 * RIMG; LAS float* GC = (LAS float*)(sb + 6 * RIMG + 4096);
            ring_wait_free(fl, s, c);
#pragma unroll
            for (int i = 0; i < 2; ++i) { const int id = lane + 64 * i; const int o = (id >> 3) * RST + (id & 7) * 16;
                *(LAS v4u*)(RE + o) = rE[i]; *(LAS v4u*)(RA + o) = rA[i]; *(LAS v4u*)(RB + o) = rB[i]; *(LAS v4u*)(RK + o) = rK[i]; *(LAS v4u*)(RR + o) = rR[i]; *(LAS v4u*)(RV + o) = rV[i]; }
            if (c + 4 < NCH16) RW_LOAD(c + 4);
            asm volatile("s_waitcnt lgkmcnt(0)" ::: "memory");
#pragma unroll
            for (int jb = 0; jb < 4; ++jb) {
                const int tro = (4 * fq + tq) * RST + (16 * jb + 4 * tp) * 2;
                const v2u eu = __builtin_bit_cast(v2u, __builtin_amdgcn_ds_read_tr16_b64_v4i16((LAS v4i16_t*)(RE + tro)));
                const v2u au = __builtin_bit_cast(v2u, __builtin_amdgcn_ds_read_tr16_b64_v4i16((LAS v4i16_t*)(RA + tro)));
                const v2u bu = __builtin_bit_cast(v2u, __builtin_amdgcn_ds_read_tr16_b64_v4i16((LAS v4i16_t*)(RB + tro)));
                const v2u ku = __builtin_bit_cast(v2u, __builtin_amdgcn_ds_read_tr16_b64_v4i16((LAS v4i16_t*)(RK + tro)));
                const v2u ru = __builtin_bit_cast(v2u, __builtin_amdgcn_ds_read_tr16_b64_v4i16((LAS v4i16_t*)(RR + tro)));
                v4u ew; ew.x = eu.x; ew.y = eu.y; ew.z = 0u; ew.w = 0u;
                const f32x4 cum = __builtin_amdgcn_mfma_f32_16x16x32_bf16(Ltri, __builtin_bit_cast(bf16x8, ew), (f32x4){0.f, 0.f, 0.f, 0.f}, 0, 0, 0);
                const float ev[4] = {bflo(eu.x), bfhi(eu.x), bflo(eu.y), bfhi(eu.y)}, av[4] = {bflo(au.x), bfhi(au.x), bflo(au.y), bfhi(au.y)}, bv[4] = {bflo(bu.x), bfhi(bu.x), bflo(bu.y), bfhi(bu.y)};
                const float kv[4] = {bflo(ku.x), bfhi(ku.x), bflo(ku.y), bfhi(ku.y)}, rv[4] = {bflo(ru.x), bfhi(ru.x), bflo(ru.y), bfhi(ru.y)};
#pragma unroll
                for (int e = 0; e < 4; ++e) {
                    const float G = __expf(-cum[e]), Gi = __expf(cum[e]), Gx = __expf(ev[e] - cum[e]);
                    const int o = (4 * fq + e) * RST + (16 * jb + fr) * 2;
                    const unsigned ab = pk2(av[e] * Gx, bv[e] * Gi), kr = pk2(kv[e] * Gi, rv[e] * G);
                    *(LAS unsigned short*)(RA + o) = (unsigned short)ab; *(LAS unsigned short*)(RB + o) = (unsigned short)(ab >> 16);
                    *(LAS unsigned short*)(RK + o) = (unsigned short)kr; *(LAS unsigned short*)(RR + o) = (unsigned short)(kr >> 16);
                    if (e == 3 && fq == 3) GC[16 * jb + fr] = G;
                }
            }
            asm volatile("s_waitcnt lgkmcnt(0)" ::: "memory");
            f32x4 aba = {0.f, 0.f, 0.f, 0.f}, aka = aba, abr = aba, akr = aba, abaT = aba;
#pragma unroll
            for (int kb = 0; kb < 2; ++kb) {
                const int o = fr * RST + kb * 64 + fq * 16;
                const bf16x8 fb = *(const LAS bf16x8*)(RB + o), fk = *(const LAS bf16x8*)(RK + o), fa = *(const LAS bf16x8*)(RA + o), frr = *(const LAS bf16x8*)(RR + o);
                aba = __builtin_amdgcn_mfma_f32_16x16x32_bf16(fb, fa, aba, 0, 0, 0); aka = __builtin_amdgcn_mfma_f32_16x16x32_bf16(fk, fa, aka, 0, 0, 0);
                abr = __builtin_amdgcn_mfma_f32_16x16x32_bf16(fb, frr, abr, 0, 0, 0); akr = __builtin_amdgcn_mfma_f32_16x16x32_bf16(fk, frr, akr, 0, 0, 0);
                abaT = __builtin_amdgcn_mfma_f32_16x16x32_bf16(fa, fb, abaT, 0, 0, 0);
            }
            f32x4 idc;
#pragma unroll
            for (int e = 0; e < 4; ++e) { const int row = 4 * fq + e;
                aba[e] = (row < fr) ? aba[e] : 0.f; aka[e] = (row < fr) ? aka[e] : 0.f; abr[e] = (row <= fr) ? abr[e] : 0.f; akr[e] = (row <= fr) ? akr[e] : 0.f;
                abaT[e] = (fr < row) ? abaT[e] : 0.f; idc[e] = (row == fr) ? 1.f : 0.f; }
            f32x4 t_c = idc + aba, t_T = idc + abaT;
            f32x4 p_c = mm16(abaT, aba, (f32x4){0.f, 0.f, 0.f, 0.f}), p_T = mm16(aba, abaT, (f32x4){0.f, 0.f, 0.f, 0.f});
            { const f32x4 n_c = mm16(t_T, p_c, t_c), n_T = mm16(p_c, t_T, t_T); t_c = n_c; t_T = n_T; }
            { const f32x4 q_c = mm16(p_T, p_c, (f32x4){0.f, 0.f, 0.f, 0.f}), q_T = mm16(p_c, p_T, (f32x4){0.f, 0.f, 0.f, 0.f}); p_c = q_c; p_T = q_T; }
            { const f32x4 n_c = mm16(t_T, p_c, t_c), n_T = mm16(p_c, t_T, t_T); t_c = n_c; t_T = n_T; }
            { const f32x4 q_c = mm16(p_T, p_c, (f32x4){0.f, 0.f, 0.f, 0.f}); p_c = q_c; }
            const f32x4 tm_c = mm16(t_T, p_c, t_c);
            *(LAS bf16x8*)(FRG + lane * 16) = pack4z(tm_c); *(LAS bf16x8*)(FRG + 1024 + lane * 16) = pack4z(aka);
            *(LAS bf16x8*)(FRG + 2048 + lane * 16) = pack4z(abr); *(LAS bf16x8*)(FRG + 3072 + lane * 16) = pack4z(akr);
            ring_set_full(fl, s, c, lane);
        }
#undef RW_LOAD
    } else {
        const int q = F.wave;
        __builtin_amdgcn_s_setprio(3);
        bf16* yout = YRW + (size_t)d * M_ALL * 512 + h * 64 + 16 * q;
        f32x4 T[4];
#pragma unroll
        for (int jb = 0; jb < 4; ++jb) T[jb] = (f32x4){0.f, 0.f, 0.f, 0.f};
        for (int c = 0; c < NCH16; ++c) {
            const int s = c % NSLOT;
            LAS unsigned char* sb = F.lds + s * RW_SLOT;
            LAS unsigned char* RA = sb + RIMG; LAS unsigned char* RB = sb + 2 * RIMG; LAS unsigned char* RK = sb + 3 * RIMG; LAS unsigned char* RR = sb + 4 * RIMG;
            LAS unsigned char* RV = sb + 5 * RIMG; LAS unsigned char* FRG = sb + 6 * RIMG; LAS float* GC = (LAS float*)(sb + 6 * RIMG + 4096);
            ring_wait_full(fl, s, c);
            const bf16x8 tmA = *(const LAS bf16x8*)(FRG + lane * 16), akaA = *(const LAS bf16x8*)(FRG + 1024 + lane * 16), abrA = *(const LAS bf16x8*)(FRG + 2048 + lane * 16), akrA = *(const LAS bf16x8*)(FRG + 3072 + lane * 16);
            const bf16x8 Vf = tr4z(RV + (4 * fq + tq) * RST + (16 * q + 4 * tp) * 2);
            f32x4 x = {0.f, 0.f, 0.f, 0.f}, y = {0.f, 0.f, 0.f, 0.f};
#pragma unroll
            for (int jp = 0; jp < 2; ++jp) {
                const int o = fr * RST + (32 * jp + 4 * fq) * 2;
                const bf16x8 tf = pack8(T[2 * jp], T[2 * jp + 1]);
                x = __builtin_amdgcn_mfma_f32_16x16x32_bf16(cat44(*(const LAS v2u*)(RA + o), *(const LAS v2u*)(RA + o + 32)), tf, x, 0, 0, 0);
                y = __builtin_amdgcn_mfma_f32_16x16x32_bf16(cat44(*(const LAS v2u*)(RR + o), *(const LAS v2u*)(RR + o + 32)), tf, y, 0, 0, 0);
            }
            x = __builtin_amdgcn_mfma_f32_16x16x32_bf16(akaA, Vf, x, 0, 0, 0);
            const f32x4 ut = __builtin_amdgcn_mfma_f32_16x16x32_bf16(tmA, pack4z(x), (f32x4){0.f, 0.f, 0.f, 0.f}, 0, 0, 0);
            y = __builtin_amdgcn_mfma_f32_16x16x32_bf16(abrA, pack4z(ut), y, 0, 0, 0);
            y = __builtin_amdgcn_mfma_f32_16x16x32_bf16(akrA, Vf, y, 0, 0, 0);
            bf16x8 UV; { const v4u vw = __builtin_bit_cast(v4u, Vf); v4u w; w.x = pk2(ut[0], ut[1]); w.y = pk2(ut[2], ut[3]); w.z = vw.x; w.w = vw.y; UV = __builtin_bit_cast(bf16x8, w); }
#pragma unroll
            for (int jb = 0; jb < 4; ++jb) {
                const int tro = (4 * fq + tq) * RST + (16 * jb + 4 * tp) * 2;
                const v2u bt = __builtin_bit_cast(v2u, __builtin_amdgcn_ds_read_tr16_b64_v4i16((LAS v4i16_t*)(RB + tro))), kt = __builtin_bit_cast(v2u, __builtin_amdgcn_ds_read_tr16_b64_v4i16((LAS v4i16_t*)(RK + tro)));
                const f32x4 gc = *(const LAS f32x4*)(GC + 16 * jb + 4 * fq);
                T[jb] = __builtin_amdgcn_mfma_f32_16x16x32_bf16(cat44(bt, kt), UV, T[jb], 0, 0, 0); T[jb] = T[jb] * gc;
            }
            ring_done(fl, s, lane);
            { const int row0 = scan_row16(c, 0, b, d), stp = d ? -1 : 1;
#pragma unroll
              for (int e = 0; e < 4; ++e) yout[(size_t)(row0 + stp * (4 * fq + e)) * 512 + fr] = (bf16)f2bf(y[e]); }
        }
        __builtin_amdgcn_s_setprio(0);
    }
}

constexpr int MST = 272, MIMG = 16 * MST;
constexpr int MB_NSLOT = 5;
constexpr int MB_SLOT = 21504;
__device__ __forceinline__ void mamba_block(Frame& F, int unit, const bf16* PM, const float* DT, const float* a_log, bf16* YMB) {
    const int d = unit & 1, h = (unit >> 1) & 7, b = unit >> 4, grp = h >> 2;
    const int lane = F.lane, fr = lane & 15, fq = lane >> 4, tq = (lane & 15) >> 2, tp = lane & 3;
    volatile LAS unsigned* fl = (volatile LAS unsigned*)(F.lds + RING_FLAGS);
    __syncthreads();
    if (F.tid < 16) fl[F.tid] = 0u;
    __syncthreads();
    if (F.wave >= 4) {
        const int p = F.wave - 4;
        const float a_neg = -__expf(a_log[d * 8 + h]);
        v4u rB[4], rC[4], rX[2]; float rdt;
#define MB_LOAD(c_) do { \
        _Pragma("unroll") for (int i = 0; i < 4; ++i) { const int t = (lane >> 4) + 4 * i; const bf16* src = PM + (size_t)scan_row16((c_), t, b, d) * 1024 + 512 + grp * 128 + (lane & 15) * 8; rB[i] = *(const GAS v4u*)src; rC[i] = *(const GAS v4u*)(src + 256); } \
        _Pragma("unroll") for (int i = 0; i < 2; ++i) { const int id = lane + 64 * i; rX[i] = *(const GAS v4u*)(PM + (size_t)scan_row16((c_), id >> 3, b, d) * 1024 + h * 64 + (id & 7) * 8); } \
        rdt = DT[(size_t)scan_row16((c_), lane & 15, b, d) * 16 + d * 8 + h]; } while (0)
        MB_LOAD(p);
        for (int c = p; c < NCH16; c += 4) {
            const int s = c % MB_NSLOT;
            LAS unsigned char* sb = F.lds + s * MB_SLOT;
            LAS unsigned char* BR = sb; LAS unsigned char* CR = sb + MIMG; LAS unsigned char* RT = sb + 2 * MIMG; LAS unsigned char* KH = sb + 3 * MIMG; LAS unsigned char* VX = sb + 4 * MIMG;
            LAS unsigned char* FRG = sb + 4 * MIMG + RIMG; LAS float* scal = (LAS float*)(sb + 4 * MIMG + RIMG + 1024);
            ring_wait_free(fl, s, c, MB_NSLOT);
            float cs = rdt * a_neg;
            cs += dpp_shr<1>(cs); cs += dpp_shr<2>(cs); cs += dpp_shr<4>(cs); cs += dpp_shr<8>(cs);
            const float cse = __int_as_float(__builtin_amdgcn_readlane(__float_as_int(cs), 15));
            if (lane < 16) { scal[16 + lane] = cs; scal[32 + lane] = __expf(cs); scal[48 + lane] = rdt; scal[64 + lane] = __expf(cse - cs); }
            if (lane == 0) scal[0] = __expf(cse);
            asm volatile("s_waitcnt lgkmcnt(0)" ::: "memory");
#pragma unroll
            for (int i = 0; i < 4; ++i) { const int t = (lane >> 4) + 4 * i; const float sk = scal[64 + t], sr = scal[32 + t]; const int o = t * MST + (lane & 15) * 16;
                *(LAS v4u*)(BR + o) = rB[i]; *(LAS v4u*)(CR + o) = rC[i]; *(LAS v4u*)(KH + o) = scale8(rB[i], sk); *(LAS v4u*)(RT + o) = scale8(rC[i], sr); }
#pragma unroll
            for (int i = 0; i < 2; ++i) { const int id = lane + 64 * i; const int t = id >> 3; *(LAS v4u*)(VX + t * RST + (id & 7) * 16) = scale8(rX[i], scal[48 + t]); }
            if (c + 4 < NCH16) MB_LOAD(c + 4);
            asm volatile("s_waitcnt lgkmcnt(0)" ::: "memory");
            f32x4 akr = {0.f, 0.f, 0.f, 0.f};
#pragma unroll
            for (int kb = 0; kb < 4; ++kb) akr = __builtin_amdgcn_mfma_f32_16x16x32_bf16(*(const LAS bf16x8*)(BR + fr * MST + kb * 64 + fq * 16), *(const LAS bf16x8*)(CR + fr * MST + kb * 64 + fq * 16), akr, 0, 0, 0);
            const float cst = scal[16 + fr]; const f32x4 css = *(const LAS f32x4*)(scal + 16 + 4 * fq);
#pragma unroll
            for (int e = 0; e < 4; ++e) akr[e] = (4 * fq + e <= fr) ? akr[e] * __expf(cst - css[e]) : 0.f;
            *(LAS bf16x8*)(FRG + lane * 16) = pack4z(akr);
            ring_set_full(fl, s, c, lane);
        }
#undef MB_LOAD
    } else {
        const int q = F.wave;
        __builtin_amdgcn_s_setprio(3);
        bf16* yout = YMB + (size_t)d * M_ALL * 512 + h * 64 + 16 * q;
        unsigned long long prof_wait = 0ull; (void)prof_wait;
        f32x4 T[8];
#pragma unroll
        for (int jb = 0; jb < 8; ++jb) T[jb] = (f32x4){0.f, 0.f, 0.f, 0.f};
        for (int c = 0; c < NCH16; ++c) {
            const int s = c % MB_NSLOT;
            LAS unsigned char* sb = F.lds + s * MB_SLOT;
            LAS unsigned char* RT = sb + 2 * MIMG; LAS unsigned char* KH = sb + 3 * MIMG; LAS unsigned char* VX = sb + 4 * MIMG;
            LAS unsigned char* FRG = sb + 4 * MIMG + RIMG; LAS float* scal = (LAS float*)(sb + 4 * MIMG + RIMG + 1024);
#ifdef PROF_MBWAIT
            const unsigned long long tw0_ = __builtin_amdgcn_s_memrealtime();
#endif
            ring_wait_full(fl, s, c);
#ifdef PROF_MBWAIT
            prof_wait += __builtin_amdgcn_s_memrealtime() - tw0_;
#endif
            const bf16x8 akrA = *(const LAS bf16x8*)(FRG + lane * 16); const float gC = scal[0];
            const bf16x8 Vf = tr4z(VX + (4 * fq + tq) * RST + (16 * q + 4 * tp) * 2);
            f32x4 ya = {0.f, 0.f, 0.f, 0.f}, yb = __builtin_amdgcn_mfma_f32_16x16x32_bf16(akrA, Vf, (f32x4){0.f, 0.f, 0.f, 0.f}, 0, 0, 0);
#pragma unroll
            for (int jp = 0; jp < 4; ++jp) {
                const LAS unsigned char* rp = RT + fr * MST + (32 * jp + 4 * fq) * 2;
                const bf16x8 ra = cat44(*(const LAS v2u*)rp, *(const LAS v2u*)(rp + 32)), tf = pack8(T[2 * jp], T[2 * jp + 1]);
                if (jp & 1) yb = __builtin_amdgcn_mfma_f32_16x16x32_bf16(ra, tf, yb, 0, 0, 0); else ya = __builtin_amdgcn_mfma_f32_16x16x32_bf16(ra, tf, ya, 0, 0, 0);
            }
            const f32x4 y = ya + yb;
#ifdef MB_CONS2X
            { f32x4 yd = {0.f, 0.f, 0.f, 0.f};
#pragma unroll
              for (int jp = 0; jp < 4; ++jp) { const LAS unsigned char* rp = RT + fr * MST + (32 * jp + 4 * fq) * 2 + 8;
                  yd = __builtin_amdgcn_mfma_f32_16x16x32_bf16(cat44(*(const LAS v2u*)rp, *(const LAS v2u*)(rp + 32)), pack8(T[2 * jp] * 1.0001f, T[2 * jp + 1] * 1.0001f), yd, 0, 0, 0); }
              yd = __builtin_amdgcn_mfma_f32_16x16x32_bf16(akrA, Vf, yd, 0, 0, 0);
              asm volatile("" :: "v"(yd)); }
#endif
#pragma unroll
            for (int jb = 0; jb < 8; ++jb) T[jb] = __builtin_amdgcn_mfma_f32_16x16x32_bf16(tr4z(KH + (4 * fq + tq) * MST + (16 * jb + 4 * tp) * 2), Vf, T[jb] * gC, 0, 0, 0);
            ring_done(fl, s, lane);
            { const int row0 = scan_row16(c, 0, b, d), stp = d ? -1 : 1;
#pragma unroll
              for (int e = 0; e < 4; ++e) yout[(size_t)(row0 + stp * (4 * fq + e)) * 512 + fr] = (bf16)f2bf(y[e]); }
        }
#ifdef PROF_MBWAIT
        if (F.bid == 128 && F.tid == 0) __hip_atomic_store(F.ctl + 2, __float_as_uint((float)prof_wait * 0.01f), RLX_AGENT);
#endif
        __builtin_amdgcn_s_setprio(0);
    }
}

struct FinIn { const float *gn_w, *gn_b, *mb_d, *mb_norm_w; };
__device__ __forceinline__ void finish_phase(Frame& F, const FinIn& P, const bf16* YRW, const bf16* YMB, const bf16* PR, const bf16* PM, const float* BONUS, const bf16* GATE, const bf16* ZG, bf16* A) {
    const int gw = F.bid * NWAVES + F.wave, NGW = F.G * NWAVES; const int c0 = F.lane * 8, head = F.lane >> 3;
    float gnw[8], gnb[8], nw[8];
#pragma unroll
    for (int i = 0; i < 8; ++i) { gnw[i] = P.gn_w[c0 + i]; gnb[i] = P.gn_b[c0 + i]; nw[i] = P.mb_norm_w[c0 + i]; }
    const float dd = P.mb_d[head];
    struct FinIn9 { v4u y0, y1, vv, gg, m0, m1, xx, zz; float bon; };
    FinIn9 cur, nxt;
#define FIN_FETCH(R_, g_) do { const size_t gs_ = (size_t)(g_); \
        R_.y0 = *(const GAS v4u*)(YRW + gs_ * 512 + c0); R_.y1 = *(const GAS v4u*)(YRW + (size_t)M_ALL * 512 + gs_ * 512 + c0); R_.vv = *(const GAS v4u*)(PR + gs_ * PRV + 512 + c0); R_.gg = *(const GAS v4u*)(GATE + gs_ * 512 + c0); \
        R_.m0 = *(const GAS v4u*)(YMB + gs_ * 512 + c0); R_.m1 = *(const GAS v4u*)(YMB + (size_t)M_ALL * 512 + gs_ * 512 + c0); R_.xx = *(const GAS v4u*)(PM + gs_ * 1024 + c0); R_.zz = *(const GAS v4u*)(ZG + gs_ * 512 + c0); \
        R_.bon = BONUS[gs_ * 8 + head]; } while (0)
    if (gw < M_ALL) FIN_FETCH(cur, gw);
    for (int g = gw; g < M_ALL; g += NGW) {
        const size_t gs = (size_t)g;
        if (g + NGW < M_ALL) FIN_FETCH(nxt, g + NGW);
        const v4u y0 = cur.y0, y1 = cur.y1, vv = cur.vv, gg = cur.gg, m0 = cur.m0, m1 = cur.m1, xx = cur.xx, zz = cur.zz; const float bon = cur.bon;
        cur = nxt;
        float y[8], vf[8], gf[8];
#pragma unroll
        for (int i = 0; i < 4; ++i) { y[2 * i] = bflo(y0[i]) + bflo(y1[i]); y[2 * i + 1] = bfhi(y0[i]) + bfhi(y1[i]); vf[2 * i] = bflo(vv[i]); vf[2 * i + 1] = bfhi(vv[i]); gf[2 * i] = bflo(gg[i]); gf[2 * i + 1] = bfhi(gg[i]); }
        float s = 0.f;
#pragma unroll
        for (int i = 0; i < 8; ++i) s += y[i];
        s = sum8(s);
        const float mu = s * (1.f / 64.f); float q = 0.f;
#pragma unroll
        for (int i = 0; i < 8; ++i) { y[i] -= mu; q += y[i] * y[i]; }
        q = sum8(q);
        const float rstd = rsqrtf(q * (1.f / 64.f) + 64e-5f);
        float o[8];
#pragma unroll
        for (int i = 0; i < 8; ++i) o[i] = ((y[i] * rstd) * gnw[i] + gnb[i] + bon * vf[i]) * gf[i];
        v4u w; w.x = pk2(o[0], o[1]); w.y = pk2(o[2], o[3]); w.z = pk2(o[4], o[5]); w.w = pk2(o[6], o[7]);
        *(GAS v4u*)(A + gs * 1024 + c0) = w;
        float ym[8]; float ss = 0.f;
#pragma unroll
        for (int i = 0; i < 4; ++i) {
            const float z0 = bflo(zz[i]), z1 = bfhi(zz[i]);
            ym[2 * i] = (bflo(m0[i]) + bflo(m1[i]) + dd * bflo(xx[i])) * (z0 * sigm(z0)); ym[2 * i + 1] = (bfhi(m0[i]) + bfhi(m1[i]) + dd * bfhi(xx[i])) * (z1 * sigm(z1));
            ss += ym[2 * i] * ym[2 * i] + ym[2 * i + 1] * ym[2 * i + 1];
        }
        ss = half_sum(ss, F.lane);
        const float rr = rsqrtf(ss * (1.f / 256.f) + 1e-6f);
        v4u w2; w2.x = pk2(ym[0] * rr * nw[0], ym[1] * rr * nw[1]); w2.y = pk2(ym[2] * rr * nw[2], ym[3] * rr * nw[3]); w2.z = pk2(ym[4] * rr * nw[4], ym[5] * rr * nw[5]); w2.w = pk2(ym[6] * rr * nw[6], ym[7] * rr * nw[7]);
        *(GAS v4u*)(A + gs * 1024 + 512 + c0) = w2;
    }
#undef FIN_FETCH
}

__device__ __forceinline__ bf16x8 tr2(const LAS unsigned char* p0, const LAS unsigned char* p1) {
    const s16x4 t0 = __builtin_bit_cast(s16x4, __builtin_amdgcn_ds_read_tr16_b64_v4i16((LAS v4i16_t*)p0));
    const s16x4 t1 = __builtin_bit_cast(s16x4, __builtin_amdgcn_ds_read_tr16_b64_v4i16((LAS v4i16_t*)p1));
    bf16x8 r; r[0] = t0[0]; r[1] = t0[1]; r[2] = t0[2]; r[3] = t0[3]; r[4] = t1[0]; r[5] = t1[1]; r[6] = t1[2]; r[7] = t1[3]; return r;
}
constexpr int KST = 144;
__device__ __forceinline__ void attn_phase(Frame& F, const bf16* Q, const bf16* K, const bf16* V, const float* rpb, bf16* O) {
    LAS unsigned char* ctxK = F.lds; LAS unsigned char* ctxV = F.lds + 36864; LAS unsigned char* vst = F.lds + 73728 + F.wave * 4608; LAS float* rp = (LAS float*)(F.lds + 110592);
    const int lane = F.lane, fr = lane & 15, fq = lane >> 4, tq = (lane & 15) >> 2, tp = lane & 3;
#ifndef ATT_REPS
#define ATT_REPS 1
#endif
    const int avcu = (F.G % 8 == 0) ? (F.bid % 8) * (F.G / 8) + F.bid / 8 : F.bid;
    for (int u_ = avcu; u_ < 256 * ATT_REPS; u_ += F.G) {
        const int u = u_ & 255; const int bh = u >> 1, half = u & 1, b = bh >> 4, h = bh & 15;
        __syncthreads();
        {
            const int key = F.tid >> 1, hf = F.tid & 1; const size_t src = (size_t)(b * CTXL + key) * D + h * 64 + hf * 32;
#pragma unroll
            for (int i = 0; i < 4; ++i) { *(LAS v4u*)(ctxK + key * KST + hf * 64 + 16 * i) = *(const GAS v4u*)(K + src + 8 * i); *(LAS v4u*)(ctxV + key * KST + hf * 64 + 16 * i) = *(const GAS v4u*)(V + src + 8 * i); }
            if (F.tid < 465) rp[F.tid] = rpb[h * 465 + F.tid] * 1.4426950408889634f;
        }
        __syncthreads();
        for (int it = 0; it < 8; ++it) {
            const int r = 2 * (half * 8 + it) + (F.wave >> 2), j = F.wave & 3;
            const int rs = min(max(r - 4, 0), 24); const int kb = (j == 0) ? 0 : (j == 1) ? 8 : (j == 2) ? 24 : 32;
            const int qc = 16 * j + fr, wsq = min(max(qc - 8, 0), 48);
            const unsigned latbase = (unsigned)(M_CTX + b * SEQ);
            bf16x8 qf[2];
            { const bf16* qp = Q + (unsigned)((latbase + r * 64 + qc) * D + h * 64 + 8 * fq); qf[0] = *(const GAS bf16x8*)qp; qf[1] = *(const GAS bf16x8*)(qp + 32); }
            const int cv = kb + 4 * fq - wsq, cc2 = kb + 4 * fq - qc + 15;
            f32x4 sl[8][2], sc[16];
            const unsigned koff = (unsigned)((latbase + rs * 64 + kb + fr) * D + h * 64 + 8 * fq);
            const unsigned voff = (unsigned)((latbase + rs * 64 + kb + (lane >> 1)) * D + h * 64 + (lane & 1) * 32);
            bf16x8 kc[4], kn[4];
#pragma unroll
            for (int x = 0; x < 4; ++x) kc[x] = *(const GAS bf16x8*)(K + koff + (x >> 1) * 16 * D + (x & 1) * 32);
#pragma unroll
            for (int i = 0; i < 8; ++i) {
                const int brow = (rs + i - r + 7) * 31;
                if (i < 7) {
#pragma unroll
                    for (int x = 0; x < 4; ++x) kn[x] = *(const GAS bf16x8*)(K + koff + (unsigned)((i + 1) * 64 * D) + (x >> 1) * 16 * D + (x & 1) * 32);
                }
#pragma unroll
                for (int blk = 0; blk < 2; ++blk) {
                    f32x4 s = {0.f, 0.f, 0.f, 0.f};
                    s = __builtin_amdgcn_mfma_f32_16x16x32_bf16(kc[2 * blk], qf[0], s, 0, 0, 0);
                    s = __builtin_amdgcn_mfma_f32_16x16x32_bf16(kc[2 * blk + 1], qf[1], s, 0, 0, 0);
#pragma unroll
                    for (int e = 0; e < 4; ++e) s[e] = ((unsigned)(cv + 16 * blk + e) < 16u) ? (s[e] + rp[brow + min(max(cc2 + 16 * blk + e, 0), 30)]) : -INFINITY;
                    sl[i][blk] = s;
                }
#pragma unroll
                for (int x = 0; x < 4; ++x) kc[x] = kn[x];
            }
#pragma unroll
            for (int cb = 0; cb < 16; ++cb) {
                const LAS unsigned char* kp = ctxK + (16 * cb + fr) * KST + fq * 16;
                const bf16x8 k0 = *(const LAS bf16x8*)kp, k1 = *(const LAS bf16x8*)(kp + 64);
                f32x4 s = {0.f, 0.f, 0.f, 0.f};
                s = __builtin_amdgcn_mfma_f32_16x16x32_bf16(k0, qf[0], s, 0, 0, 0);
                s = __builtin_amdgcn_mfma_f32_16x16x32_bf16(k1, qf[1], s, 0, 0, 0);
                sc[cb] = s;
            }
            v4u vr[4];
#pragma unroll
            for (int x = 0; x < 4; ++x) vr[x] = *(const GAS v4u*)(V + voff + 8 * x);
            float m = -INFINITY;
#pragma unroll
            for (int i = 0; i < 8; ++i)
#pragma unroll
                for (int blk = 0; blk < 2; ++blk)
#pragma unroll
                    for (int e = 0; e < 4; ++e) m = fmaxf(m, sl[i][blk][e]);
#pragma unroll
            for (int cb = 0; cb < 16; ++cb)
#pragma unroll
                for (int e = 0; e < 4; ++e) m = fmaxf(m, sc[cb][e]);
            m = fmaxf(m, __shfl_xor(m, 16)); m = fmaxf(m, __shfl_xor(m, 32));
            float l = 0.f;
#pragma unroll
            for (int i = 0; i < 8; ++i)
#pragma unroll
                for (int blk = 0; blk < 2; ++blk)
#pragma unroll
                    for (int e = 0; e < 4; ++e) { const float p = __builtin_amdgcn_exp2f(sl[i][blk][e] - m); sl[i][blk][e] = p; l += p; }
#pragma unroll
            for (int cb = 0; cb < 16; ++cb)
#pragma unroll
                for (int e = 0; e < 4; ++e) { const float p = __builtin_amdgcn_exp2f(sc[cb][e] - m); sc[cb][e] = p; l += p; }
            l += __shfl_xor(l, 16); l += __shfl_xor(l, 32);
            const float linv = __builtin_amdgcn_rcpf(l);
            f32x4 o[4];
#pragma unroll
            for (int db = 0; db < 4; ++db) o[db] = (f32x4){0.f, 0.f, 0.f, 0.f};
#pragma unroll
            for (int i = 0; i < 8; ++i) {
                { const int key = lane >> 1, hf = lane & 1;
#pragma unroll
                  for (int x = 0; x < 4; ++x) *(LAS v4u*)(vst + key * KST + hf * 64 + 16 * x) = vr[x]; }
                if (i < 7) {
#pragma unroll
                    for (int x = 0; x < 4; ++x) vr[x] = *(const GAS v4u*)(V + voff + (unsigned)((i + 1) * 64 * D) + 8 * x);
                }
                const bf16x8 pa = pack8(sl[i][0], sl[i][1]);
#pragma unroll
                for (int db = 0; db < 4; ++db) {
                    const LAS unsigned char* a0 = vst + (4 * fq + tq) * KST + (db * 16 + 4 * tp) * 2;
                    const bf16x8 vb = tr2(a0, a0 + 16 * KST);
                    o[db] = __builtin_amdgcn_mfma_f32_16x16x32_bf16(pa, vb, o[db], 0, 0, 0);
                }
            }
#pragma unroll
            for (int cc = 0; cc < 8; ++cc) {
                const bf16x8 pa = pack8(sc[2 * cc], sc[2 * cc + 1]);
#pragma unroll
                for (int db = 0; db < 4; ++db) {
                    const LAS unsigned char* a0 = ctxV + (32 * cc + 4 * fq + tq) * KST + (db * 16 + 4 * tp) * 2;
                    const bf16x8 vb = tr2(a0, a0 + 16 * KST);
                    o[db] = __builtin_amdgcn_mfma_f32_16x16x32_bf16(pa, vb, o[db], 0, 0, 0);
                }
            }
#pragma unroll
            for (int e = 0; e < 4; ++e) {
                const float li = __shfl(linv, 4 * fq + e);
                bf16* op = O + (unsigned)((b * SEQ + r * 64 + 16 * j + 4 * fq + e) * D + h * 64 + fr);
#pragma unroll
                for (int db = 0; db < 4; ++db) op[db * 16] = (bf16)f2bf(o[db][e] * li);
            }
        }
    }
}

__device__ __forceinline__ void router_phase(Frame& F, const float* hlat, const float* g, const float* mods_l, const float* router_w, const float* router_b, bf16* A4, unsigned* tokinfo, gu32* cntb) {
    LAS int* se = (LAS int*)F.lds;
    LAS float* sg = (LAS float*)(F.lds + 512);
    LAS int* srow = (LAS int*)(F.lds + 1024);
    LAS unsigned* spos = (LAS unsigned*)(F.lds + 1280);
    const int gw = F.bid * NWAVES + F.wave, NGW = F.G * NWAVES;
    const int nbatch = (M_LAT + NGW * 8 - 1) / (NGW * 8);
    LAS float* srw = (LAS float*)(F.lds + 2048);
    __syncthreads();
    for (int i = F.tid; i < 2048; i += NTHR) ((LAS f32x4*)srw)[i] = ((const GAS f32x4*)router_w)[i];
    f32x4 gg[4];
#pragma unroll
    for (int j = 0; j < 4; ++j) gg[j] = ((const GAS f32x4*)g)[F.lane + 64 * j];
    RowIn cur, nxt;
#define RT_FETCH(R_, r_) do { const float* mp_ = mods_l + ((r_) >> 11) * 6144; row_fetch(R_, hlat + (size_t)(r_) * D, mp_ + 3072, mp_ + 4096, F.lane); } while (0)
    if (gw < M_LAT) RT_FETCH(cur, gw);
    for (int bt = 0; bt < nbatch; ++bt) {
        __syncthreads();
#pragma unroll 1
        for (int k = 0; k < 8; ++k) {
            const int r = gw + (bt * 8 + k) * NGW, slot = F.wave * 8 + k;
            if (r >= M_LAT) { if (F.lane == 0) { se[2 * slot] = -1; se[2 * slot + 1] = -1; srow[slot] = 0; } continue; }
            if (r + NGW < M_LAT) RT_FETCH(nxt, r + NGW);
            f32x4 a[4]; row_finish(cur, gg, A4 + (size_t)r * D, F.lane, a);
            cur = nxt;
            float lg[8];
#pragma unroll
            for (int e = 0; e < 8; ++e) lg[e] = 0.f;
#pragma unroll
            for (int j = 0; j < 4; ++j)
#pragma unroll
                for (int x = 0; x < 4; ++x) { const LAS float* rw = srw + ((F.lane + 64 * j) * 4 + x) * 8; const f32x4 w0 = *(const LAS f32x4*)rw, w1 = *(const LAS f32x4*)(rw + 4); const float av = a[j][x];
#pragma unroll
                    for (int e = 0; e < 4; ++e) { lg[e] += av * w0[e]; lg[4 + e] += av * w1[e]; } }
#pragma unroll
            for (int e = 0; e < 8; ++e) lg[e] = wave_sum(lg[e]) + router_b[e];
            int e0 = 0; float v0 = lg[0];
#pragma unroll
            for (int e = 1; e < 8; ++e) if (lg[e] > v0) { v0 = lg[e]; e0 = e; }
            int e1 = -1; float v1 = -INFINITY;
#pragma unroll
            for (int e = 0; e < 8; ++e) if (e != e0 && lg[e] > v1) { v1 = lg[e]; e1 = e; }
            const float g0 = 1.f / (1.f + __expf(v1 - v0)), g1 = 1.f - g0;
            if (F.lane == 0) { se[2 * slot] = e0; se[2 * slot + 1] = e1; sg[2 * slot] = g0; sg[2 * slot + 1] = g1; srow[slot] = r; }
        }
        __syncthreads();
        if (F.wave == 0) {
            const int l = F.lane; const int ea = se[l], eb = se[64 + l];
            const unsigned long long below = (l == 0) ? 0ull : (~0ull >> (64 - l));
            unsigned ra = 0u, rb = 0u, tot = 0u;
#pragma unroll
            for (int e = 0; e < 8; ++e) {
                const unsigned long long ma = __ballot(ea == e), mb = __ballot(eb == e);
                const unsigned ca = (unsigned)__popcll(ma), cb = (unsigned)__popcll(mb);
                if (ea == e) ra = (unsigned)__popcll(ma & below);
                if (eb == e) rb = ca + (unsigned)__popcll(mb & below);
                if (l == e) tot = ca + cb;
            }
            if (l < 8) cntb[(size_t)(bt * F.G + F.bid) * 8 + l] = tot;
            spos[l] = ra; spos[64 + l] = rb;
            asm volatile("s_waitcnt lgkmcnt(0)" ::: "memory");
            if (se[2 * l] >= 0) {
                v4u t0; t0.x = (unsigned)se[2 * l]; t0.y = spos[2 * l]; t0.z = __float_as_uint(sg[2 * l]); t0.w = (unsigned)se[2 * l + 1];
                v4u t1; t1.x = spos[2 * l + 1]; t1.y = __float_as_uint(sg[2 * l + 1]); t1.z = 0u; t1.w = 0u;
                const size_t row = (size_t)srow[l];
                *(GAS v4u*)(tokinfo + row * 8) = t0; *(GAS v4u*)(tokinfo + row * 8 + 4) = t1;
            }
        }
    }
}
#undef RT_FETCH
__device__ __forceinline__ void moe_bases(gu32* cnt, int (&tb)[9]) {
    int acc = 0;
#pragma unroll
    for (int e = 0; e < 8; ++e) { tb[e] = acc; const unsigned c = __hip_atomic_load(cnt + 64 * e, RLX_AGENT); acc += (int)((c + 255u) >> 8); }
    tb[8] = acc;
}
#ifndef MOE_TAIL_SPLIT
#define MOE_TAIL_SPLIT 1
#endif
__device__ __forceinline__ void moe_tail_split(const int (&tb)[9], int G, int& first, int& ntail) {
    const int U = tb[8] * 4; first = (U / G) * G; ntail = U - first;
    if (first == 0 || (first & 3) || ntail > 32) { first = U; ntail = 0; }
#if !MOE_TAIL_SPLIT
    first = U; ntail = 0;
#endif
}
__device__ __forceinline__ void gather_phase(Frame& F, const bf16* A4, unsigned* tokinfo, gu32* cnt, const gu32* cntb, bf16* XG) {
    const int gw = F.bid * NWAVES + F.wave, NGW = F.G * NWAVES;
    const int nbatch = (M_LAT + NGW * 8 - 1) / (NGW * 8), nent = nbatch * F.G;
    LAS float* sred = (LAS float*)F.lds;
    __syncthreads();
    if (F.wave == 0) {
        float tot[8];
#pragma unroll
        for (int e = 0; e < 8; ++e) tot[e] = 0.f;
        for (int i = F.lane; i < nent; i += 64) { const v4u a = *(const GAS v4u*)(cntb + (size_t)i * 8), b = *(const GAS v4u*)(cntb + (size_t)i * 8 + 4);
            tot[0] += (float)a.x; tot[1] += (float)a.y; tot[2] += (float)a.z; tot[3] += (float)a.w; tot[4] += (float)b.x; tot[5] += (float)b.y; tot[6] += (float)b.z; tot[7] += (float)b.w; }
#pragma unroll
        for (int e = 0; e < 8; ++e) { const float s = wave_sum(tot[e]); if (F.lane == 0) sred[e] = s; }
        for (int bt = 0; bt < nbatch; ++bt) {
            const int mine = bt * F.G + F.bid; float pre[8];
#pragma unroll
            for (int e = 0; e < 8; ++e) pre[e] = 0.f;
            for (int i = F.lane; i < mine; i += 64) { const v4u a = *(const GAS v4u*)(cntb + (size_t)i * 8), b = *(const GAS v4u*)(cntb + (size_t)i * 8 + 4);
                pre[0] += (float)a.x; pre[1] += (float)a.y; pre[2] += (float)a.z; pre[3] += (float)a.w; pre[4] += (float)b.x; pre[5] += (float)b.y; pre[6] += (float)b.z; pre[7] += (float)b.w; }
#pragma unroll
            for (int e = 0; e < 8; ++e) { const float s = wave_sum(pre[e]); if (F.lane == 0) sred[8 + 8 * bt + e] = s; }
        }
    }
    __syncthreads();
    int tb[9]; { int acc = 0;
#pragma unroll
        for (int e = 0; e < 8; ++e) { tb[e] = acc; const unsigned c = (unsigned)sred[e]; acc += (int)((c + 255u) >> 8); if (F.bid == 0 && F.tid == 0) __hip_atomic_store(cnt + 64 * e, c, RLX_AGENT); }
        tb[8] = acc; }
    struct GIn { v4u t0, t1, x0, x1; };
    GIn cur, nxt;
#define G_FETCH(R_, r_) do { R_.t0 = *(const GAS v4u*)(tokinfo + (size_t)(r_) * 8); R_.t1 = *(const GAS v4u*)(tokinfo + (size_t)(r_) * 8 + 4); \
        const GAS v4u* s_ = (const GAS v4u*)(A4 + (size_t)(r_) * D); R_.x0 = s_[F.lane]; R_.x1 = s_[F.lane + 64]; } while (0)
    if (gw < M_LAT) G_FETCH(cur, gw);
    int k = 0;
    for (int r = gw; r < M_LAT; r += NGW, ++k) {
        if (r + NGW < M_LAT) G_FETCH(nxt, r + NGW);
        const v4u t0 = cur.t0, t1 = cur.t1, x0 = cur.x0, x1 = cur.x1; cur = nxt;
        const LAS float* pre = sred + 8 + 8 * (k >> 3);
        int tbe0 = 0, tbe1 = 0; unsigned pr0 = 0u, pr1 = 0u;
#pragma unroll
        for (int e = 0; e < 8; ++e) { if ((int)t0.x == e) { tbe0 = tb[e]; pr0 = (unsigned)pre[e]; } if ((int)t0.w == e) { tbe1 = tb[e]; pr1 = (unsigned)pre[e]; } }
        const unsigned row0 = (unsigned)tbe0 * 256u + pr0 + t0.y, row1 = (unsigned)tbe1 * 256u + pr1 + t1.x;
        GAS v4u* d0 = (GAS v4u*)(XG + (size_t)row0 * D); GAS v4u* d1 = (GAS v4u*)(XG + (size_t)row1 * D);
        d0[F.lane] = x0; d0[F.lane + 64] = x1; d1[F.lane] = x0; d1[F.lane + 64] = x1;
        if (F.lane == 0) { tokinfo[(size_t)r * 8 + 6] = row0; tokinfo[(size_t)r * 8 + 7] = row1; }
    }
#undef G_FETCH
}
__device__ __forceinline__ f32x4 moe_y4(const bf16* YG, const float* slab, unsigned row, int j, int lane, unsigned tailrow0, int first, int ntail) {
    if (row < tailrow0) { const v2u a = ((const GAS v2u*)(YG + (size_t)row * D) + lane)[64 * j]; return (f32x4){bflo(a.x), bfhi(a.x), bflo(a.y), bfhi(a.y)}; }
    const size_t kstride = (size_t)(ntail >> 2) * 256 * 1024; const float* p = slab + (size_t)(row - tailrow0) * 1024 + (lane + 64 * j) * 4; f32x4 s = {0.f, 0.f, 0.f, 0.f};
    for (int ks = 0; ks < 11; ++ks) s += *(const GAS f32x4*)(p + ks * kstride);
    const unsigned w0 = pk2(s[0], s[1]), w1 = pk2(s[2], s[3]);
    return (f32x4){bflo(w0), bfhi(w0), bflo(w1), bfhi(w1)};
}
__device__ __forceinline__ void final_phase(Frame& F, float* hout, const bf16* YG, const unsigned* tokinfo, const float* mods_l, const float* norm_final, const float* slab, gu32* cnt) {
    const int gw = F.bid * NWAVES + F.wave, NGW = F.G * NWAVES;
    int tb[9]; moe_bases(cnt, tb); int first, ntail; moe_tail_split(tb, F.G, first, ntail); const unsigned tailrow0 = (unsigned)(first >> 2) * 256u;
#if defined(PROF_PH) || defined(PROF_SCANWAIT) || defined(PROF_MBWAIT)
    const float prof_scale = 1.f + sqrtf(__uint_as_float(__hip_atomic_load(F.ctl + 2, RLX_AGENT)) * 1e-5f);
#else
    const float prof_scale = 1.f;
#endif
    for (int r = gw; r < M_LAT; r += NGW) {
        const v4u t0 = *(const GAS v4u*)(tokinfo + (size_t)r * 8), t1 = *(const GAS v4u*)(tokinfo + (size_t)r * 8 + 4);
        const float g0 = __uint_as_float(t0.z), g1 = __uint_as_float(t1.y); const unsigned row0 = t1.z, row1 = t1.w;
        const float* mp = mods_l + (r >> 11) * 6144 + 5120;
        GAS f32x4* hr = (GAS f32x4*)(hout + (size_t)r * D) + F.lane;
        f32x4 v[4]; float ss = 0.f;
#pragma unroll
        for (int j = 0; j < 4; ++j) {
            const f32x4 hh = hr[64 * j], mm = ((const GAS f32x4*)mp)[F.lane + 64 * j];
            const f32x4 ya = moe_y4(YG, slab, row0, j, F.lane, tailrow0, first, ntail), yb = moe_y4(YG, slab, row1, j, F.lane, tailrow0, first, ntail);
            v[j] = hh + mm * (ya * g0 + yb * g1);
            ss += (v[j].x * v[j].x + v[j].y * v[j].y) + (v[j].z * v[j].z + v[j].w * v[j].w);
        }
        const float rs = rsqrtf(wave_sum(ss) * (1.f / 1024.f) + 1e-6f);
#pragma unroll
        for (int j = 0; j < 4; ++j) { const f32x4 gg = ((const GAS f32x4*)norm_final)[F.lane + 64 * j]; hr[64 * j] = (v[j] * (rs * prof_scale)) * gg; }
    }
}

constexpr int NPHASE = 19;
#ifndef MK_PER_PHASE
#define MK_PER_PHASE 0
#endif
__device__ __forceinline__ int fresh_lane() { int l; asm volatile("v_mbcnt_lo_u32_b32 %0, -1, 0\n\tv_mbcnt_hi_u32_b32 %0, -1, %0" : "=v"(l)); return l; }
struct Args { const float* in[39]; float* out; unsigned char* ws; int ph_lo, ph_hi; };
#define KARGP(k) (((void* const __attribute__((address_space(4)))*)__builtin_amdgcn_kernarg_segment_ptr())[k])
#define KARG(k) ((const float*)KARGP(k))
__global__ void __launch_bounds__(NWAVES * 64, 2) mk_fwd(Args args) {
    extern __shared__ __attribute__((aligned(16))) unsigned char lds[];
    Frame F;
    F.lds = (LAS unsigned char*)lds; F.MISC = (volatile LAS unsigned*)(F.lds + MISC_OFF);
    F.tid = threadIdx.x; F.lane = F.tid & 63; F.wave = __builtin_amdgcn_readfirstlane(F.tid >> 6); F.G = gridDim.x; F.bid = blockIdx.x;
    unsigned char* ws = (unsigned char*)KARGP(40); F.ctl = (gu32*)(ws + WS_CTL);
    for (int u = F.tid; u < (LDS_BYTES - LDSCTL_OFF) / 4; u += NWAVES * 64) ((LAS unsigned*)(F.lds + LDSCTL_OFF))[u] = 0u;
    __syncthreads();
    const int lo = args.ph_lo, hi = args.ph_hi;
    unsigned long long prof_t0 = 0ull; (void)prof_t0;
    XcdBarrier bar; bar.bar = (unsigned*)(F.ctl + CW_BAR); bar.x = 0; bar.st = nullptr;
    if (hi - lo > 1) bar = xcd_barrier_post((unsigned*)(F.ctl + CW_BAR), F.MISC + 8);
#ifdef PH_MASK
#define IN(k) ((((PH_MASK) >> (k)) & 1) && lo <= (k) && (k) < hi)
#else
#define IN(k) (lo <= (k) && (k) < hi)
#endif
#ifndef DUP_MASK
#define DUP_MASK 0
#endif
#ifdef PROF_PH
#define PROF_T0(k) do { if ((k) == PROF_PH && F.bid == 0 && F.tid == 0) prof_t0 = __builtin_amdgcn_s_memrealtime(); } while (0)
#define PROF_T1(k) do { if ((k) == PROF_PH && F.bid == 0 && F.tid == 0) { const unsigned long long t1_ = __builtin_amdgcn_s_memrealtime(); __hip_atomic_store(F.ctl + 2, __float_as_uint((float)(t1_ - prof_t0) * 0.01f), RLX_AGENT); } } while (0)
#else
#define PROF_T0(k) do {} while (0)
#define PROF_T1(k) do {} while (0)
#endif
#define REPS(k) (1 + (((DUP_MASK) >> (k)) & 1))
#ifdef DOUBLE_BAR
#define SEAM(k) do { if (IN(k) && IN((k) + 1)) { xcd_barrier(bar); xcd_barrier(bar); } } while (0)
#else
#define SEAM(k) do { if (IN(k) && IN((k) + 1)) xcd_barrier(bar); } while (0)
#endif
    const float* x = KARG(0); const float* ctx = KARG(2);
    float* mods = (float*)(ws + WS_MODS); float* hctx = (float*)(ws + WS_HCTX); float* hlat = (float*)KARGP(39);
    bf16* A = (bf16*)(ws + WS_A);
    const int vcu = (F.G % 8 == 0) ? (F.bid % 8) * (F.G / 8) + F.bid / 8 : F.bid;

    PROF_T0(0); if (IN(0)) for (int rep_ = 0; rep_ < REPS(0); ++rep_) { if (rep_) __syncthreads(); F.lane = fresh_lane(); F.tid = F.wave * 64 + F.lane; p0_phase(F, KARG(1), KARG(3), KARG(4), KARG(5), mods, KARG(9), KARG(10), KARG(28), KARG(29), KARG(30), KARG(31), KARG(32), ws); }
    SEAM(0); PROF_T1(0);
    PROF_T0(1); if (IN(1)) for (int rep_ = 0; rep_ < REPS(1); ++rep_) { if (rep_) __syncthreads(); F.lane = fresh_lane(); F.tid = F.wave * 64 + F.lane; normmod_phase(F, ctx, x, KARG(6), mods, 0, 1024, A); }
    SEAM(1); PROF_T1(1);
    PROF_T0(2); if (IN(2)) for (int rep_ = 0; rep_ < REPS(2); ++rep_) { if (rep_) __syncthreads(); F.lane = fresh_lane(); F.tid = F.wave * 64 + F.lane;
        pg8::Gemm g{A, (const bf16*)(ws + WS_WIN_T), M_ALL, ZLD, D}; pg8::StaticOrder S; S.init(M_ALL, ZLD, F.G, F.bid);
        pg8::EpiBf16<0> E{(bf16*)(ws + WS_Z), ZLD, nullptr, 0, 0, 1.f};
        pg8::gemm_phase<pg8::EpiBf16<0>, pg8::StaticOrder, true, true>(F.lds, g, S, E);
    }
    SEAM(2); PROF_T1(2);
    PROF_T0(3); if (IN(3)) for (int rep_ = 0; rep_ < REPS(3); ++rep_) { if (rep_) __syncthreads(); F.lane = fresh_lane(); F.tid = F.wave * 64 + F.lane;
        PrepIn P{KARG(11), KARG(12), KARG(13), KARG(14), KARG(15), KARG(16), KARG(17), KARG(18), KARG(19), KARG(22), KARG(23), KARG(24)};
        prepare_phase(F, P, (const bf16*)(ws + WS_Z), (bf16*)(ws + WS_PR), (bf16*)(ws + WS_PM), (float*)(ws + WS_DT), (float*)(ws + WS_BONUS), (bf16*)(ws + WS_GATE), (bf16*)(ws + WS_ZG));
    }
    SEAM(3); PROF_T1(3);
    PROF_T0(4); if (IN(4)) for (int rep_ = 0; rep_ < REPS(4); ++rep_) { if (rep_) __syncthreads(); F.lane = fresh_lane(); F.tid = F.wave * 64 + F.lane;
        for (int u = F.bid; u < 256; u += F.G) {
            if (u < 128) { rwkv_block(F, u, (const bf16*)(ws + WS_PR), (bf16*)(ws + WS_YRW));
#ifdef RWKV2X
                rwkv_block(F, u, (const bf16*)(ws + WS_PR), (bf16*)(ws + WS_YRW));
#endif
            }
            else { mamba_block(F, u - 128, (const bf16*)(ws + WS_PM), (const float*)(ws + WS_DT), KARG(25), (bf16*)(ws + WS_YMB));
#ifdef MAMBA2X
                   mamba_block(F, u - 128, (const bf16*)(ws + WS_PM), (const float*)(ws + WS_DT), KARG(25), (bf16*)(ws + WS_YMB));
#endif
            }
        }
    }
    SEAM(4); PROF_T1(4);
    PROF_T0(5); if (IN(5)) for (int rep_ = 0; rep_ < REPS(5); ++rep_) { if (rep_) __syncthreads(); F.lane = fresh_lane(); F.tid = F.wave * 64 + F.lane;
        FinIn P{KARG(20), KARG(21), KARG(26), KARG(27)};
        finish_phase(F, P, (const bf16*)(ws + WS_YRW), (const bf16*)(ws + WS_YMB), (const bf16*)(ws + WS_PR), (const bf16*)(ws + WS_PM), (const float*)(ws + WS_BONUS), (const bf16*)(ws + WS_GATE), (const bf16*)(ws + WS_ZG), A);
    }
    SEAM(5); PROF_T1(5);
    PROF_T0(6); if (IN(6)) for (int rep_ = 0; rep_ < REPS(6); ++rep_) { if (rep_) __syncthreads(); F.lane = fresh_lane(); F.tid = F.wave * 64 + F.lane;
        {
            pg8::Gemm g{A + (size_t)M_CTX * D, (const bf16*)(ws + WS_WOUT_T), M_LAT, D, D}; pg8::StaticOrder S; S.init(M_LAT, D, F.G, F.bid);
            pg8::EpiResGate E{x, x, hlat, hlat, mods, 2048, 0};
            pg8::gemm_phase<pg8::EpiResGate, pg8::StaticOrder, true, true>(F.lds, g, S, E);
        }
        {
            pg8::Gemm g{A, (const bf16*)(ws + WS_WOUT_T), M_CTX, D, 256, D}; pg8::SplitKOrder S{8, 4, 4, 256, F.G, F.bid};
            pg8::EpiSlabGate E{(float*)(ws + WS_SLAB6), mods + 8 * 6144 + 2048, 256};
            pg8::gemm_phase<pg8::EpiSlabGate, pg8::SplitKOrder, true, true>(F.lds, g, S, E);
        }
        { const int nsub = 8 * 4 * 4; if (F.G > nsub && F.bid >= nsub) moe_weight_phase(F, KARG(36), KARG(37), KARG(38), ws, 0, MOE_ITEMS_P6, F.bid - nsub, F.G - nsub);
          else if (F.G <= nsub) moe_weight_phase(F, KARG(36), KARG(37), KARG(38), ws, 0, MOE_ITEMS_P6, F.bid, F.G); }
    }
    SEAM(6); PROF_T1(6);
    PROF_T0(7); if (IN(7)) for (int rep_ = 0; rep_ < REPS(7); ++rep_) { if (rep_) __syncthreads(); F.lane = fresh_lane(); F.tid = F.wave * 64 + F.lane; normmod_phase(F, ctx, hlat, KARG(7), mods, 3072, 4096, A, (const float*)(ws + WS_SLAB6), 4, hctx); moe_weight_phase(F, KARG(36), KARG(37), KARG(38), ws, MOE_ITEMS_P6, MOE_ITEMS_P7, F.bid, F.G); }
    SEAM(7); PROF_T1(7);
    PROF_T0(8); if (IN(8)) for (int rep_ = 0; rep_ < REPS(8); ++rep_) { if (rep_) __syncthreads(); F.lane = fresh_lane(); F.tid = F.wave * 64 + F.lane;
        pg8::Gemm g{A, (const bf16*)(ws + WS_W13_T), M_ALL, 2 * FF, D}; pg8::StaticOrder S; S.init(M_ALL, 2 * FF, F.G, F.bid);
        pg8::EpiSwiGLU E{(bf16*)(ws + WS_HID), FF, 1 << 20};
        pg8::gemm_phase<pg8::EpiSwiGLU, pg8::StaticOrder, true, true>(F.lds, g, S, E);
        {
            const int nfull = ((M_ALL / 256) * (2 * FF / 256)) % F.G;
            if (nfull != 0 && F.bid >= nfull) moe_weight_phase(F, KARG(36), KARG(37), KARG(38), ws, MOE_ITEMS_P7, MOE_ITEMS_P7 + MOE_ITEMS_P8, F.bid - nfull, F.G - nfull);
            else if (nfull == 0) moe_weight_phase(F, KARG(36), KARG(37), KARG(38), ws, MOE_ITEMS_P7, MOE_ITEMS_P7 + MOE_ITEMS_P8, F.bid, F.G);
        }
    }
    SEAM(8); PROF_T1(8);
    PROF_T0(9); if (IN(9)) for (int rep_ = 0; rep_ < REPS(9); ++rep_) { if (rep_) __syncthreads(); F.lane = fresh_lane(); F.tid = F.wave * 64 + F.lane;
        {
            pg8::Gemm g{(const bf16*)(ws + WS_HID) + (size_t)M_CTX * FF, (const bf16*)(ws + WS_W2_T), M_LAT, D, FF}; pg8::StaticOrder S; S.init(M_LAT, D, F.G, F.bid);
            pg8::EpiResGate E{hlat, hlat, hlat, hlat, mods, 5120, 0};
            pg8::gemm_phase<pg8::EpiResGate, pg8::StaticOrder, true, true>(F.lds, g, S, E);
        }
        {
            pg8::Gemm g{(const bf16*)(ws + WS_HID), (const bf16*)(ws + WS_W2_T), M_CTX, D, 1408, FF}; pg8::SplitKOrder S{8, 4, 2, 1408, F.G, F.bid};
            pg8::EpiSlabGate E{(float*)(ws + WS_SLAB9), mods + 8 * 6144 + 5120, 1408};
            pg8::gemm_phase<pg8::EpiSlabGate, pg8::SplitKOrder, true, true>(F.lds, g, S, E);
        }
        {
            const int nsub = 8 * 4 * 2;
            if (F.G > nsub) { if (F.bid >= nsub) moe_weight_phase(F, KARG(36), KARG(37), KARG(38), ws, MOE_ITEMS_P7 + MOE_ITEMS_P8, MOE_ITEMS_P7 + MOE_ITEMS_P8 + MOE_ITEMS_P9, F.bid - nsub, F.G - nsub); }
            else moe_weight_phase(F, KARG(36), KARG(37), KARG(38), ws, MOE_ITEMS_P7 + MOE_ITEMS_P8, MOE_ITEMS_P7 + MOE_ITEMS_P8 + MOE_ITEMS_P9, F.bid, F.G);
        }
    }
    SEAM(9); PROF_T1(9);
    const float* mods1 = mods + 9 * 6144;
    PROF_T0(10); if (IN(10)) for (int rep_ = 0; rep_ < REPS(10); ++rep_) { if (rep_) __syncthreads(); F.lane = fresh_lane(); F.tid = F.wave * 64 + F.lane; normmod_phase(F, hctx, hlat, KARG(6) + D, mods1, 0, 1024, A, (const float*)(ws + WS_SLAB9), 2); }
    SEAM(10); PROF_T1(10);
    PROF_T0(11); if (IN(11)) for (int rep_ = 0; rep_ < REPS(11); ++rep_) { if (rep_) __syncthreads(); F.lane = fresh_lane(); F.tid = F.wave * 64 + F.lane;
        pg8::Gemm g{A, (const bf16*)(ws + WS_QKV_T), M_ALL, 3 * D, D}; pg8::StaticOrder S; S.init(M_ALL, 3 * D, F.G, F.bid);
        pg8::EpiBf16<0> E{(bf16*)(ws + WS_Q), D, nullptr, D, (size_t)M_ALL * D, 0.125f * 1.4426950408889634f};
        pg8::gemm_phase<pg8::EpiBf16<0>, pg8::StaticOrder, true, true>(F.lds, g, S, E);
        {
            const int nfull = ((M_ALL / 256) * (3 * D / 256)) % F.G;
            if (nfull != 0 && F.bid >= nfull) moe_weight_phase(F, KARG(36), KARG(37), KARG(38), ws, MOE_ITEMS - MOE_ITEMS_P11, MOE_ITEMS, F.bid - nfull, F.G - nfull);
            else if (nfull == 0) moe_weight_phase(F, KARG(36), KARG(37), KARG(38), ws, MOE_ITEMS - MOE_ITEMS_P11, MOE_ITEMS, F.bid, F.G);
        }
    }
    SEAM(11); PROF_T1(11);
    PROF_T0(12); if (IN(12)) for (int rep_ = 0; rep_ < REPS(12); ++rep_) { if (rep_) __syncthreads(); F.lane = fresh_lane(); F.tid = F.wave * 64 + F.lane; attn_phase(F, (const bf16*)(ws + WS_Q), (const bf16*)(ws + WS_K), (const bf16*)(ws + WS_V), KARG(33), (bf16*)(ws + WS_O)); }
    SEAM(12); PROF_T1(12);
    PROF_T0(13); if (IN(13)) for (int rep_ = 0; rep_ < REPS(13); ++rep_) { if (rep_) __syncthreads(); F.lane = fresh_lane(); F.tid = F.wave * 64 + F.lane;
        pg8::Gemm g{(const bf16*)(ws + WS_O), (const bf16*)(ws + WS_NAO_T), M_LAT, D, D}; pg8::StaticOrder S; S.init(M_LAT, D, F.G, F.bid);
        pg8::EpiResGate E{hlat, hlat, hlat, hlat, mods1, 2048, 0};
        pg8::gemm_phase<pg8::EpiResGate, pg8::StaticOrder, true, true>(F.lds, g, S, E);
    }
    SEAM(13); PROF_T1(13);
    PROF_T0(14); if (IN(14)) for (int rep_ = 0; rep_ < REPS(14); ++rep_) { if (rep_) __syncthreads(); F.lane = fresh_lane(); F.tid = F.wave * 64 + F.lane; router_phase(F, hlat, KARG(7) + D, mods1, KARG(34), KARG(35), (bf16*)(ws + WS_A4), (unsigned*)(ws + WS_TOK), F.ctl + CW_CNTB); }
    SEAM(14); PROF_T1(14);
    PROF_T0(15); if (IN(15)) for (int rep_ = 0; rep_ < REPS(15); ++rep_) { if (rep_) __syncthreads(); F.lane = fresh_lane(); F.tid = F.wave * 64 + F.lane; gather_phase(F, (const bf16*)(ws + WS_A4), (unsigned*)(ws + WS_TOK), F.ctl + CW_CNT, F.ctl + CW_CNTB, (bf16*)(ws + WS_XG)); }
    SEAM(15); PROF_T1(15);
    PROF_T0(16); if (IN(16)) for (int rep_ = 0; rep_ < REPS(16); ++rep_) { if (rep_) __syncthreads(); F.lane = fresh_lane(); F.tid = F.wave * 64 + F.lane;
        pg8::MoeOrder S; moe_bases(F.ctl + CW_CNT, S.tb); S.ntn = 22; S.G = F.G; S.c = vcu;
        pg8::Gemm g{(const bf16*)(ws + WS_XG), (const bf16*)(ws + WS_MOEW13), MOE_ROWS, NE * 2 * FF, D};
        pg8::EpiSwiGLU E{(bf16*)(ws + WS_HIDG), FF, 22};
        pg8::gemm_phase<pg8::EpiSwiGLU, pg8::MoeOrder, true, true>(F.lds, g, S, E);
    }
    SEAM(16); PROF_T1(16);
    PROF_T0(17); if (IN(17)) for (int rep_ = 0; rep_ < REPS(17); ++rep_) { if (rep_) __syncthreads(); F.lane = fresh_lane(); F.tid = F.wave * 64 + F.lane;
        pg8::MoeOrder S; moe_bases(F.ctl + CW_CNT, S.tb); S.ntn = 4; S.G = F.G; S.c = vcu;
        int first, ntail; moe_tail_split(S.tb, F.G, first, ntail); S.limit = first;
        {
            pg8::Gemm g{(const bf16*)(ws + WS_HIDG), (const bf16*)(ws + WS_MOEW2), MOE_ROWS, NE * D, FF};
            pg8::EpiPlainMod E{(bf16*)(ws + WS_YG), D, 4};
            pg8::gemm_phase<pg8::EpiPlainMod, pg8::MoeOrder, true, true>(F.lds, g, S, E);
        }
#if MOE_TAIL_SPLIT
        if (ntail > 0) {
            pg8::MoeTailOrder ST;
#pragma unroll
            for (int k = 0; k < 9; ++k) ST.tb[k] = S.tb[k];
            ST.first = first; ST.ntail = ntail; ST.G = F.G; ST.c = vcu;
            pg8::Gemm g{(const bf16*)(ws + WS_HIDG), (const bf16*)(ws + WS_MOEW2), MOE_ROWS, NE * D, 256, FF};
            pg8::EpiTailSlab E{(float*)(ws + WS_TAIL), first, ntail};
            pg8::gemm_phase<pg8::EpiTailSlab, pg8::MoeTailOrder, true, true>(F.lds, g, ST, E);
        }
#endif
    }
    SEAM(17); PROF_T1(17);
    PROF_T0(18); if (IN(18)) for (int rep_ = 0; rep_ < REPS(18); ++rep_) { if (rep_) __syncthreads(); F.lane = fresh_lane(); F.tid = F.wave * 64 + F.lane; final_phase(F, hlat, (const bf16*)(ws + WS_YG), (const unsigned*)(ws + WS_TOK), mods1, KARG(8), (const float*)(ws + WS_TAIL), F.ctl + CW_CNT); }
#undef IN
#undef SEAM
}

extern "C" void kernel_launch(void* const* d_in, const int* in_sizes, int n_in, void* d_out, int out_size, void* d_ws, size_t ws_size, hipStream_t stream) {
    static int grid = 0;
    if (grid == 0) {
        if (n_in != 39 || out_size != M_LAT * D || ws_size < WS_END) { fprintf(stderr, "kernel_launch: unexpected shapes (n_in %d, out %d, ws %zu)\n", n_in, out_size, ws_size); grid = -1; return; }
        int dev = 0, cus = 0, per_cu = 0;
        if (hipGetDevice(&dev) != hipSuccess || hipDeviceGetAttribute(&cus, hipDeviceAttributeMultiprocessorCount, dev) != hipSuccess) { grid = -1; return; }
        if (hipFuncSetAttribute((const void*)mk_fwd, hipFuncAttributeMaxDynamicSharedMemorySize, LDS_BYTES) != hipSuccess) { fprintf(stderr, "kernel_launch: hipFuncSetAttribute failed\n"); grid = -1; return; }
        if (hipOccupancyMaxActiveBlocksPerMultiprocessor(&per_cu, (const void*)mk_fwd, NWAVES * 64, LDS_BYTES) != hipSuccess || per_cu < 1) fprintf(stderr, "kernel_launch: occupancy query says %d\n", per_cu);
        (void)hipGetLastError();
        grid = cus;
    }
    if (grid < 0) return;
    if (hipMemsetAsync((char*)d_ws + WS_CTL, 0, CTL_ZERO_BYTES, stream) != hipSuccess) return;
    Args a{};
    for (int i = 0; i < 39; ++i) a.in[i] = (const float*)d_in[i];
    a.out = (float*)d_out; a.ws = (unsigned char*)d_ws;
#if MK_PER_PHASE
    for (int p = 0; p < NPHASE; ++p) { a.ph_lo = p; a.ph_hi = p + 1; hipLaunchKernelGGL(mk_fwd, dim3(grid), dim3(NWAVES * 64), LDS_BYTES, stream, a); }
#else
    a.ph_lo = 0; a.ph_hi = NPHASE; hipLaunchKernelGGL(mk_fwd, dim3(grid), dim3(NWAVES * 64), LDS_BYTES, stream, a);
#endif
}
```

```cpp
#include <hip/hip_runtime.h>
#include <cstdio>
#include <cstdint>
#include <cmath>
#define MK_PER_PHASE 0
namespace pg8 {
#define PG8_LAS __attribute__((address_space(3)))
typedef unsigned short bf16_t;
typedef short bf16x8 __attribute__((ext_vector_type(8)));
typedef float f32x4 __attribute__((ext_vector_type(4)));
typedef unsigned u32x4 __attribute__((ext_vector_type(4)));
constexpr int BM = 256, BK = 64, HALF = 128, HTB = HALF * BK * 2  , STAGE_BYTES = 8 * HTB, NXCD = 8, WGM = 8;

__host__ __device__ __forceinline__ int lds_byte(int r, int c) { const int st = (r >> 4) * 2 + (c >> 5), rr = r & 15, cc = c & 31, ob = rr * 64 + cc * 2; return st * 1024 + (ob ^ (((ob >> 9) & 1) << 5)); }
__host__ __device__ __forceinline__ void stage_rc(int b, int& R, int& C) { const int st = b / 1024, sb = b % 1024, swz = sb ^ (((sb >> 9) & 1) << 5); R = (st >> 1) * 16 + swz / 64; C = (st & 1) * 32 + (swz % 64) / 2; }
__host__ __device__ __forceinline__ int perm32(int rho) { const int n = rho >> 4, i = rho & 15; return 8 * (i >> 2) + 4 * n + (i & 3); }

#ifndef PG8_WT
#define PG8_WT 0
#endif
#if PG8_WT
#define PG8_ST16(base_, ptr_, v_) __builtin_amdgcn_raw_buffer_store_b128((v_), __builtin_amdgcn_make_buffer_rsrc((void*)(base_), (short)0, 0x7fffffff, 0x00020000), (int)((const char*)(ptr_) - (const char*)(base_)), 0, 16)
#else
#define PG8_ST16(base_, ptr_, v_) (*(u32x4*)(ptr_) = (v_))
#endif
struct Unit { int pm, pn; int k0 = 0; };
struct Gemm { const bf16_t* A; const bf16_t* Bt; int M, N, K; int ld = 0; };

struct StaticOrder {
    int nM, nN, nwg, G, c;
    __host__ __device__ void init(int M, int N, int G_, int c_) { nM = M / BM; nN = N / BM; nwg = nM * nN; G = G_; c = c_; }
    __host__ __device__ bool next(int i, Unit& u) const {
        const long L = (long)i * G + c; if (L >= nwg) return false;
        int wgid = (int)L; { const int q = nwg / NXCD, r = nwg % NXCD, xcd = wgid % NXCD, off = wgid / NXCD; wgid = (xcd < r ? xcd * (q + 1) : r * (q + 1) + (xcd - r) * q) + off; }
        const int nig = WGM * nN, gid = wgid / nig, fm = gid * WGM, gsz = (nM - fm) < WGM ? (nM - fm) : WGM;
        u.pm = fm + ((wgid % nig) % gsz); u.pn = (wgid % nig) / gsz; return true;
    }
    __device__ __forceinline__ void a_ready(const Unit&) const {}
    __device__ __forceinline__ void done(const Unit&) const {}
};

__device__ __forceinline__ unsigned cvt_pk_bf16(float lo, float hi) { unsigned r; asm volatile("v_cvt_pk_bf16_f32 %0, %1, %2" : "=v"(r) : "v"(lo), "v"(hi)); return r; }
typedef float f32x2 __attribute__((ext_vector_type(2)));
__device__ __forceinline__ f32x2 gelu_pk(f32x2 v) {
    const f32x2 av = __builtin_elementwise_abs(v), d = av * 0.2316418882f + 1.0f;
    f32x2 t; t.x = __builtin_amdgcn_rcpf(d.x); t.y = __builtin_amdgcn_rcpf(d.y);
    f32x2 q = t * 0.5307027145f + (-0.7265760135f); q = q * t + 0.7107068705f; q = q * t + (-0.142248368f); q = q * t + 0.127414796f; q = q * t;
    const f32x2 s = (v * v) * (-0.72134752044f);
    f32x2 e; e.x = __builtin_amdgcn_exp2f(s.x); e.y = __builtin_amdgcn_exp2f(s.y);
    const f32x2 m = v * (q * e), r = v - m;
    f32x2 o; o.x = v.x < 0.f ? m.x : r.x; o.y = v.y < 0.f ? m.y : r.y; return o;
}

template <int ACT  > struct EpiBf16 {
    static constexpr bool PERM = true, AFTER_DRAIN = false; static_assert(ACT == 0 || ACT == 1, "EpiBf16: ACT is 0 (none) or 1 (gelu_pk)");
    bf16_t* O; int ldc; const float* bias; int split_cols; size_t split_stride; float scale0;
    __device__ __forceinline__ void operator()(const f32x4 (&acc)[2][2][4][2], const Unit& u, int wr, int wc, int fr, int fq) const {
        const int row0 = u.pm * BM + wr * 64 + fr; int colt = u.pn * BM; bf16_t* base = O;
        float sc = 1.f; if (split_cols) { const int t = colt / split_cols; base += (size_t)t * split_stride; colt -= t * split_cols; if (t == 0) sc = scale0; }
        const int col0 = colt + wc * 32 + 8 * fq, bcol0 = u.pn * BM + wc * 32 + 8 * fq;
        f32x4 bv[2][2];
#pragma unroll
        for (int bj = 0; bj < 2; ++bj)
#pragma unroll
            for (int n = 0; n < 2; ++n) bv[bj][n] = bias ? *(const f32x4*)(bias + bcol0 + bj * HALF + 4 * n) : (f32x4){0.f, 0.f, 0.f, 0.f};
#pragma unroll
        for (int ai = 0; ai < 2; ++ai)
#pragma unroll
            for (int m = 0; m < 4; ++m) { bf16_t* rowp = base + (size_t)(row0 + ai * HALF + m * 16) * ldc + col0;
#pragma unroll
                for (int bj = 0; bj < 2; ++bj) { f32x4 v0 = acc[ai][bj][m][0] + bv[bj][0], v1 = acc[ai][bj][m][1] + bv[bj][1];
                    if (ACT == 1) { f32x2 a = gelu_pk((f32x2){v0[0], v0[1]}), b = gelu_pk((f32x2){v0[2], v0[3]}), c = gelu_pk((f32x2){v1[0], v1[1]}), d = gelu_pk((f32x2){v1[2], v1[3]});
                        v0 = (f32x4){a.x, a.y, b.x, b.y}; v1 = (f32x4){c.x, c.y, d.x, d.y}; }
                    v0 = v0 * sc; v1 = v1 * sc; u32x4 w; w.x = cvt_pk_bf16(v0[0], v0[1]); w.y = cvt_pk_bf16(v0[2], v0[3]); w.z = cvt_pk_bf16(v1[0], v1[1]); w.w = cvt_pk_bf16(v1[2], v1[3]);
                    PG8_ST16(base, rowp + bj * HALF, w); } }
    }
};
template <class Epi, class Sched, bool ALIGN_EPI = false, bool SP2 = false>
__device__ __forceinline__ void gemm_phase(PG8_LAS unsigned char* lds, const Gemm g, const Sched& S, const Epi& E) {
    const int tid = threadIdx.x, wid = __builtin_amdgcn_readfirstlane(tid >> 6), lane = tid & 63, wr = wid >> 2, wc = wid & 3, fr = lane & 15, fq = lane >> 4;
    const int K = g.K, nt = K / BK, LD = g.ld ? g.ld : g.K;
    unsigned voffA[2], voffB[2];
#pragma unroll
    for (int i = 0; i < 2; ++i) { int R, C; stage_rc(tid * 16 + i * 8192, R, C); const int Rb = Epi::PERM ? ((R & ~31) + perm32(R & 31)) : R;
        voffA[i] = (unsigned)(R * LD + C) * 2u; voffB[i] = (unsigned)(Rb * LD + C) * 2u; }
    const size_t kstep = (size_t)(BK * 2);
    const size_t hstep = (size_t)HALF * LD * 2;
    const size_t tstep = 2 * hstep;
    const unsigned ldsw = (unsigned)wid * 1024u;
    const int aoff = lds_byte(wr * 64 + fr, fq * 8), boff = lds_byte(wc * 32 + fr, fq * 8);
#define PG8_SA(b, h) (((b) * 2 + (h)) * HTB)
#define PG8_SB(b, h) ((4 + (b) * 2 + (h)) * HTB)
#define PG8_STAGE(bufoff, gbase, voff) do { _Pragma("unroll") for (int _i = 0; _i < 2; ++_i) \
        __builtin_amdgcn_global_load_lds((const unsigned*)((const char*)(gbase) + (voff)[_i]), (PG8_LAS unsigned*)(lds + (bufoff) + ldsw + _i * 8192), 16, 0, 0); } while (0)
#define PG8_LDA(dst, b, h) do { _Pragma("unroll") for (int m = 0; m < 4; ++m) _Pragma("unroll") for (int k = 0; k < 2; ++k) dst[m][k] = *(const PG8_LAS bf16x8*)(lds + PG8_SA(b, h) + aoff + m * 2048 + k * 1024); } while (0)
#define PG8_LDB(dst, b, h) do { _Pragma("unroll") for (int n = 0; n < 2; ++n) _Pragma("unroll") for (int k = 0; k < 2; ++k) dst[n][k] = *(const PG8_LAS bf16x8*)(lds + PG8_SB(b, h) + boff + n * 2048 + k * 1024); } while (0)
#define PG8_MMA(ai, bj, At, Bt) do { __builtin_amdgcn_s_setprio(1); _Pragma("unroll") for (int m = 0; m < 4; ++m) _Pragma("unroll") for (int n = 0; n < 2; ++n) _Pragma("unroll") for (int k = 0; k < 2; ++k) \
        acc[ai][bj][m][n] = __builtin_amdgcn_mfma_f32_16x16x32_bf16(Bt[n][k], At[m][k], acc[ai][bj][m][n], 0, 0, 0); __builtin_amdgcn_s_setprio(0); } while (0)
#define PG8_WAIT_V(n) asm volatile("s_waitcnt vmcnt(" #n ")" ::: "memory")
#define PG8_WAIT_L(n) asm volatile("s_waitcnt lgkmcnt(" #n ")" ::: "memory")
#define PG8_BAR __builtin_amdgcn_s_barrier()
#define PG8_SCHED __builtin_amdgcn_sched_barrier(0)
    Unit cur, nxt; int ui = 0;
    if (!S.next(0, cur)) return;
    f32x4 acc[2][2][4][2];
#pragma unroll
    for (int a = 0; a < 2; ++a)
#pragma unroll
        for (int b = 0; b < 2; ++b)
#pragma unroll
            for (int m = 0; m < 4; ++m)
#pragma unroll
                for (int n = 0; n < 2; ++n) acc[a][b][m][n] = (f32x4){0.f, 0.f, 0.f, 0.f};
    bf16x8 At[4][2], B0[2][2], B1[2][2];
    const char* cA = (const char*)g.A + (size_t)cur.pm * tstep + (size_t)cur.k0 * 2; const char* cB = (const char*)g.Bt + (size_t)cur.pn * tstep + (size_t)cur.k0 * 2;
    S.a_ready(cur);
    if constexpr (SP2) {
        PG8_STAGE(PG8_SB(0, 0), cB, voffB); PG8_STAGE(PG8_SB(0, 1), cB + hstep, voffB); PG8_STAGE(PG8_SA(0, 0), cA, voffA); PG8_STAGE(PG8_SA(0, 1), cA + hstep, voffA);
        if (wr == 1) PG8_BAR;
        PG8_WAIT_V(2); PG8_BAR;
        PG8_STAGE(PG8_SB(1, 0), cB + kstep, voffB); PG8_STAGE(PG8_SA(1, 0), cA + kstep, voffA); PG8_STAGE(PG8_SB(1, 1), cB + hstep + kstep, voffB);
        PG8_WAIT_V(6); PG8_BAR;
    } else {
        PG8_STAGE(PG8_SB(0, 0), cB, voffB); PG8_STAGE(PG8_SA(0, 0), cA, voffA); PG8_STAGE(PG8_SB(0, 1), cB + hstep, voffB); PG8_STAGE(PG8_SA(0, 1), cA + hstep, voffA);
        if (wr == 1) PG8_BAR;
        PG8_WAIT_V(4); PG8_BAR;
        PG8_STAGE(PG8_SB(1, 0), cB + kstep, voffB); PG8_STAGE(PG8_SA(1, 0), cA + kstep, voffA); PG8_STAGE(PG8_SB(1, 1), cB + hstep + kstep, voffB);
        PG8_WAIT_V(6); PG8_BAR;
    }
    for (;;) {
        const bool has_next = S.next(ui + 1, nxt);
        const char* nA = has_next ? (const char*)g.A + (size_t)nxt.pm * tstep + (size_t)nxt.k0 * 2 : cA; const char* nB = has_next ? (const char*)g.Bt + (size_t)nxt.pn * tstep + (size_t)nxt.k0 * 2 : cB;
        for (int t = 0; t < nt; t += 2) {
            const bool last = (t == nt - 2);
            const char* a1 = cA + (size_t)(t + 1) * kstep;
            const char* a2 = last ? nA : cA + (size_t)(t + 2) * kstep; const char* b2 = last ? nB : cB + (size_t)(t + 2) * kstep;
            const char* a3 = a2 + kstep; const char* b3 = b2 + kstep;
            if (last && has_next) S.a_ready(nxt);
            if constexpr (SP2) {
            PG8_LDB(B0, 0, 0); PG8_LDB(B1, 0, 1); PG8_SCHED; PG8_LDA(At, 0, 0); PG8_STAGE(PG8_SA(1, 1), a1 + hstep, voffA);
            PG8_WAIT_V(8); PG8_WAIT_L(0); PG8_BAR; PG8_MMA(0, 0, At, B0); PG8_MMA(0, 1, At, B1); PG8_BAR; PG8_SCHED;
            PG8_LDA(At, 0, 1); PG8_STAGE(PG8_SB(0, 0), b2, voffB); PG8_STAGE(PG8_SB(0, 1), b2 + hstep, voffB); PG8_STAGE(PG8_SA(0, 0), a2, voffA);
            PG8_WAIT_V(8); PG8_WAIT_L(0); PG8_BAR; PG8_MMA(1, 0, At, B0); PG8_MMA(1, 1, At, B1); PG8_BAR; PG8_SCHED;
            PG8_LDB(B0, 1, 0); PG8_LDB(B1, 1, 1); PG8_SCHED; PG8_LDA(At, 1, 0); PG8_STAGE(PG8_SA(0, 1), a2 + hstep, voffA);
            PG8_WAIT_V(8); PG8_WAIT_L(0); PG8_BAR; PG8_MMA(0, 0, At, B0); PG8_MMA(0, 1, At, B1); PG8_BAR; PG8_SCHED;
            PG8_LDA(At, 1, 1); PG8_STAGE(PG8_SB(1, 0), b3, voffB); PG8_STAGE(PG8_SB(1, 1), b3 + hstep, voffB); PG8_STAGE(PG8_SA(1, 0), a3, voffA);
            PG8_WAIT_V(8); PG8_WAIT_L(0); PG8_BAR; PG8_MMA(1, 0, At, B0); PG8_MMA(1, 1, At, B1); PG8_BAR; PG8_SCHED;
            } else {
            PG8_LDB(B0, 0, 0); PG8_SCHED; PG8_LDA(At, 0, 0); PG8_STAGE(PG8_SA(1, 1), a1 + hstep, voffA);
            PG8_WAIT_L(8); PG8_BAR; PG8_WAIT_L(0); PG8_MMA(0, 0, At, B0); PG8_BAR; PG8_SCHED;
            PG8_LDB(B1, 0, 1); PG8_STAGE(PG8_SB(0, 0), b2, voffB);
            PG8_BAR; PG8_WAIT_L(0); PG8_MMA(0, 1, At, B1); PG8_BAR;
            PG8_LDA(At, 0, 1); PG8_STAGE(PG8_SA(0, 0), a2, voffA);
            PG8_BAR; PG8_WAIT_L(0); PG8_MMA(1, 0, At, B0); PG8_BAR; PG8_SCHED;
            PG8_STAGE(PG8_SB(0, 1), b2 + hstep, voffB);
            PG8_WAIT_V(6); PG8_BAR; PG8_MMA(1, 1, At, B1); PG8_BAR;
            PG8_LDB(B0, 1, 0); PG8_SCHED; PG8_LDA(At, 1, 0); PG8_STAGE(PG8_SA(0, 1), a2 + hstep, voffA);
            PG8_WAIT_L(8); PG8_BAR; PG8_WAIT_L(0); PG8_MMA(0, 0, At, B0); PG8_BAR; PG8_SCHED;
            PG8_LDB(B1, 1, 1); PG8_STAGE(PG8_SB(1, 0), b3, voffB);
            PG8_BAR; PG8_WAIT_L(0); PG8_MMA(0, 1, At, B1); PG8_BAR;
            PG8_LDA(At, 1, 1); PG8_STAGE(PG8_SA(1, 0), a3, voffA);
            PG8_BAR; PG8_WAIT_L(0); PG8_MMA(1, 0, At, B0); PG8_BAR; PG8_SCHED;
            PG8_STAGE(PG8_SB(1, 1), b3 + hstep, voffB);
            PG8_WAIT_V(6); PG8_BAR; PG8_MMA(1, 1, At, B1); PG8_BAR;
            }
        }
        if constexpr (ALIGN_EPI) { if (wr == 0) PG8_BAR; }
        if constexpr (!Epi::AFTER_DRAIN) { E(acc, cur, wr, wc, fr, fq); S.done(cur); }
        if (!has_next) break;
#pragma unroll
        for (int a = 0; a < 2; ++a)
#pragma unroll
            for (int b = 0; b < 2; ++b)
#pragma unroll
                for (int m = 0; m < 4; ++m)
#pragma unroll
                    for (int n = 0; n < 2; ++n) acc[a][b][m][n] = (f32x4){0.f, 0.f, 0.f, 0.f};
        cur = nxt; cA = nA; cB = nB; ++ui;
        if constexpr (ALIGN_EPI) { if (wr == 1) PG8_BAR; }
    }
    PG8_WAIT_V(0);
    if constexpr (!ALIGN_EPI) { if (wr == 0) PG8_BAR; }
    PG8_BAR;
    if constexpr (Epi::AFTER_DRAIN) { E.fused(acc, cur, wr, wc, fr, fq, lds, wid, lane); S.done(cur); }
#undef PG8_SA
#undef PG8_SB
#undef PG8_STAGE
#undef PG8_LDA
#undef PG8_LDB
#undef PG8_MMA
#undef PG8_WAIT_V
#undef PG8_WAIT_L
#undef PG8_BAR
#undef PG8_SCHED
}
}

#define GAS __attribute__((address_space(1)))
#define LAS __attribute__((address_space(3)))
typedef unsigned short bf16;
typedef unsigned v4u __attribute__((ext_vector_type(4)));
typedef float f32x4 __attribute__((ext_vector_type(4)));
typedef short bf16x8 __attribute__((ext_vector_type(8)));
typedef GAS unsigned gu32;
typedef GAS unsigned long long gu64;
#define RLX_AGENT __ATOMIC_RELAXED, __HIP_MEMORY_SCOPE_AGENT
#define LDS_WAIT() asm volatile("s_waitcnt lgkmcnt(0)" ::: "memory")
#define VM_WAIT() asm volatile("s_waitcnt vmcnt(0)" ::: "memory")
__device__ __forceinline__ unsigned long long rt() { return __builtin_amdgcn_s_memrealtime(); }
typedef float f32x2_t __attribute__((ext_vector_type(2))); typedef __bf16 bf16x2_t __attribute__((ext_vector_type(2)));
__device__ __forceinline__ unsigned pk2(float lo, float hi) { const f32x2_t v = {lo, hi}; const bf16x2_t b = __builtin_convertvector(v, bf16x2_t); return __builtin_bit_cast(unsigned, b); }
__device__ __forceinline__ unsigned f2bf(float f) { return pk2(f, f) & 0xffffu; }
#define XB_TMO      128
#define XB_XCNT(j)  (256  + 64 * (j))
#define XB_XSUB(j)  (1280 + 64 * (j))
#define XB_XGEN(j)  (2304 + 64 * (j))
#define XB_TOP      3328
#define XB_TOPGEN   3392
#define XCD_BAR_WORDS 3456
#define XB_SPIN_CAP (1u << 18)

__device__ __forceinline__ unsigned xb_ld(unsigned* p)              { return __hip_atomic_load(p, __ATOMIC_RELAXED, __HIP_MEMORY_SCOPE_AGENT); }
__device__ __forceinline__ unsigned xb_add(unsigned* p, unsigned v) { return __hip_atomic_fetch_add(p, v, __ATOMIC_RELAXED, __HIP_MEMORY_SCOPE_AGENT); }
__device__ __forceinline__ unsigned xb_xcc_id() { return (unsigned)__builtin_amdgcn_s_getreg((3 << 11) | 20) & 0xFu; }
#define XB_SPIN(cond, bar) do { unsigned _sp = 0; while (cond) { __builtin_amdgcn_s_sleep(1); \
    if ((++_sp & 255u) == 0u) { if (xb_ld(&(bar)[XB_TMO])) break; if (_sp > XB_SPIN_CAP) { atomicAdd(&(bar)[XB_TMO], 1u); break; } } } } while (0)

struct XcdBarrier {
    unsigned* bar; unsigned x;
    volatile LAS unsigned* st;
};

__device__ __forceinline__ XcdBarrier xcd_barrier_post(unsigned* bar, volatile LAS unsigned* st) {
    XcdBarrier b; b.bar = bar; b.x = xb_xcc_id(); b.st = st;
    if (threadIdx.x == 0) (void)xb_add(&bar[XB_XCNT(b.x)], 1u);
    return b;
}
__device__ __forceinline__ void xcd_barrier_complete(unsigned* bar, unsigned x, unsigned& nloc, unsigned& nx) {
    const unsigned G = gridDim.x * gridDim.y * gridDim.z;
    unsigned sum, cnt, mine, sp = 0u;
    for (;;) {
        sum = 0u; cnt = 0u; mine = 0u;
#pragma unroll
        for (unsigned j = 0; j < 16; ++j) { const unsigned c = xb_ld(&bar[XB_XCNT(j)]); sum += c; cnt += (c > 0u) ? 1u : 0u; mine = (j == x) ? c : mine; }
        if (sum == G) break;
        __builtin_amdgcn_s_sleep(1);
        if ((++sp & 255u) == 0u) { if (xb_ld(&bar[XB_TMO])) break; if (sp > XB_SPIN_CAP) { atomicAdd(&bar[XB_TMO], 1u); break; } }
    }
    nloc = mine > 0u ? mine : 1u; nx = cnt > 0u ? cnt : 1u;
}

__device__ __forceinline__ void xcd_barrier(const XcdBarrier& b) {
    asm volatile("s_waitcnt vmcnt(0)" ::: "memory");
    __syncthreads();
    if (threadIdx.x == 0) {
        unsigned* bar = b.bar;
        __builtin_amdgcn_s_waitcnt(0);
        unsigned nloc = b.st[0], nx = b.st[1];
        if (nloc == 0u) { xcd_barrier_complete(bar, b.x, nloc, nx); b.st[0] = nloc; b.st[1] = nx; }
        const unsigned old = xb_add(&bar[XB_XSUB(b.x)], 1u);
        const unsigned gen = old / nloc;
        if (old + 1u == (gen + 1u) * nloc) {
            __builtin_amdgcn_fence(__ATOMIC_RELEASE, "agent");
            asm volatile("s_waitcnt vmcnt(0)" ::: "memory");
            const unsigned og = xb_add(&bar[XB_TOP], 1u);
            const unsigned tg = og / nx;
            if (og + 1u == (tg + 1u) * nx) xb_add(&bar[XB_TOPGEN], 1u);
            else XB_SPIN(xb_ld(&bar[XB_TOPGEN]) == tg, bar);
            __builtin_amdgcn_fence(__ATOMIC_ACQUIRE, "agent");
            xb_add(&bar[XB_XGEN(b.x)], 1u);
            asm volatile("s_waitcnt vmcnt(0)" ::: "memory");
        } else {
            XB_SPIN(xb_ld(&bar[XB_XGEN(b.x)]) == gen, bar);
            __builtin_amdgcn_fence(__ATOMIC_ACQUIRE, "agent");
            asm volatile("s_waitcnt vmcnt(0)" ::: "memory");
        }
    }
    __syncthreads();
}


constexpr int NWAVES = 8, NTHR = 512;
constexpr int D = 1024, NB = 8, SEQ = 2048, CTXL = 256;
constexpr int M_CTX = NB * CTXL, M_LAT = NB * SEQ, M_ALL = M_CTX + M_LAT;
constexpr int RWC = 1760, MIXIN = 3312, ZLD = 3328, FF = 2816, NE = 8;
constexpr int PRV = 9 * 512;
constexpr int MOE_ROWS = 34816;
constexpr size_t MiB = 1u << 20;
constexpr size_t WS_CTL = 0, CTL_ZERO_BYTES = 1 * MiB;
constexpr size_t WS_MODS = 1 * MiB;
constexpr size_t WS_TOK = 1 * MiB + 512 * 1024;
constexpr size_t WS_WIN_T = 2 * MiB;
constexpr size_t WS_WOUT_T = WS_WIN_T + (size_t)ZLD * D * 2;
constexpr size_t WS_W13_T = WS_WOUT_T + 2 * MiB;
constexpr size_t WS_W2_T = WS_W13_T + 11 * MiB;
constexpr size_t WS_QKV_T = WS_W2_T + (size_t)D * FF * 2;
constexpr size_t WS_NAO_T = WS_QKV_T + 6 * MiB;
constexpr size_t WS_HCTX = 35 * MiB;
constexpr size_t WS_A = 43 * MiB;
constexpr size_t WS_R = 79 * MiB;
constexpr size_t WS_Z = WS_R;
constexpr size_t WS_PR = 196 * MiB;
constexpr size_t WS_PM = 358 * MiB;
constexpr size_t WS_DT = 394 * MiB;
constexpr size_t WS_BONUS = 395 * MiB + 256 * 1024;
constexpr size_t WS_GATE = 396 * MiB;
constexpr size_t WS_ZG = 414 * MiB;
constexpr size_t WS_YRW = WS_R;
constexpr size_t WS_YMB = WS_R + 36 * MiB;
constexpr size_t WS_HID = WS_R;
constexpr size_t WS_MOEW13 = 316 * MiB;
constexpr size_t WS_MOEW2 = 404 * MiB;
constexpr size_t WS_Q = WS_R, WS_K = WS_R + 36 * MiB, WS_V = WS_R + 72 * MiB;
constexpr size_t WS_O = WS_R + 108 * MiB;
constexpr size_t WS_A4 = 111 * MiB;
constexpr size_t WS_XG = 43 * MiB;
constexpr size_t WS_HIDG = 111 * MiB;
constexpr size_t WS_YG = 43 * MiB;
constexpr size_t WS_SLAB6 = WS_R;
constexpr size_t WS_SLAB9 = WS_R + 99 * MiB;
constexpr size_t WS_TAIL = 316 * MiB;
constexpr size_t WS_END = 448 * MiB;
static_assert(WS_NAO_T + 2 * MiB <= WS_HCTX && WS_ZG + 18 * MiB <= WS_END && WS_MOEW2 + 44 * MiB <= WS_END && WS_HIDG + (size_t)MOE_ROWS * FF * 2 <= WS_MOEW13, "ws map");
static_assert(WS_Z + (size_t)M_ALL * ZLD * 2 <= WS_PR && WS_PR + (size_t)M_ALL * PRV * 2 <= WS_PM && WS_XG + (size_t)MOE_ROWS * D * 2 <= WS_HIDG, "ws map 2");
constexpr int CW_TMO = 0, CW_CODE = 1, CW_BAR = 4096, CW_CNT = 8192, CW_CNTB = 16384;
constexpr int RING_BYTES = 131072, LDSCTL_OFF = RING_BYTES, MISC_OFF = LDSCTL_OFF + 320, LDS_BYTES = 147456;

typedef unsigned v2u __attribute__((ext_vector_type(2)));
typedef float v2f __attribute__((ext_vector_type(2)));
typedef short s16x4 __attribute__((ext_vector_type(4)));
typedef short v4i16_t __attribute__((ext_vector_type(4)));
__device__ __forceinline__ float bflo(unsigned u) { return __uint_as_float(u << 16); }
__device__ __forceinline__ float bfhi(unsigned u) { return __uint_as_float(u & 0xffff0000u); }
__device__ __forceinline__ float ldbf(const bf16* p) { return __uint_as_float((unsigned)(*p) << 16); }
__device__ __forceinline__ float sigm(float x) { return __builtin_amdgcn_rcpf(1.f + __expf(-x)); }
__device__ __forceinline__ bf16x8 pack8(const f32x4& a, const f32x4& b) {
    v4u w; w.x = pk2(a[0], a[1]); w.y = pk2(a[2], a[3]); w.z = pk2(b[0], b[1]); w.w = pk2(b[2], b[3]); return __builtin_bit_cast(bf16x8, w);
}
template <int CTRL> __device__ __forceinline__ float dppf(float x) { return __int_as_float(__builtin_amdgcn_update_dpp(0, __float_as_int(x), CTRL, 0xF, 0xF, true)); }
__device__ __forceinline__ float sum8(float x) { x += dppf<0xB1>(x); x += dppf<0x4E>(x); x += dppf<0x141>(x); return x; }
__device__ __forceinline__ float sum16(float x) { x = sum8(x); x += dppf<0x140>(x); return x; }
__device__ __forceinline__ float rlf(float v, int l) { return __int_as_float(__builtin_amdgcn_readlane(__float_as_int(v), l)); }
__device__ __forceinline__ float wave_sum(float v) { v = sum16(v); return (rlf(v, 0) + rlf(v, 16)) + (rlf(v, 32) + rlf(v, 48)); }
__device__ __forceinline__ float half_sum(float v, int lane) { v = sum16(v); const float lo = rlf(v, 0) + rlf(v, 16), hi = rlf(v, 32) + rlf(v, 48); return lane < 32 ? lo : hi; }

struct Frame {
    LAS unsigned char* lds;
    volatile LAS unsigned* MISC;
    gu32* ctl;
    int tid, lane, wave, G, bid;
};

__device__ __forceinline__ void tr_item(const float* W, int K, int N, bf16* WT, int drow0, int k0, int n0, LAS float* scr, int lane) {
    const int nn = n0 + (lane & 31);
    float t[32];
#pragma unroll
    for (int i = 0; i < 32; ++i) { const int kk = 2 * i + (lane >> 5); t[i] = (nn < N) ? W[(size_t)(k0 + kk) * N + nn] : 0.f; }
#pragma unroll
    for (int i = 0; i < 32; ++i) { const int kk = 2 * i + (lane >> 5); scr[kk * 33 + (lane & 31)] = t[i]; }
    LDS_WAIT(); asm volatile("" ::: "memory");
    const int c = lane & 7;
#pragma unroll
    for (int j = 0; j < 4; ++j) { const int n = (lane >> 3) + 8 * j; const LAS float* s = scr + (8 * c) * 33 + n;
        v4u o; o.x = pk2(s[0 * 33], s[1 * 33]); o.y = pk2(s[2 * 33], s[3 * 33]); o.z = pk2(s[4 * 33], s[5 * 33]); o.w = pk2(s[6 * 33], s[7 * 33]);
        *(GAS v4u*)(WT + (size_t)(drow0 + n) * K + k0 + 8 * c) = o; }
    LDS_WAIT(); asm volatile("" ::: "memory");
}
template <int MODE  >
__device__ __forceinline__ bool tr_matrix(int& it, const float* W, int K, int N, bf16* WT, LAS float* scr, int lane) {
    const int nblk = (N + 31) / 32, items = (K / 64) * nblk;
    if (it >= items) { it -= items; return false; }
    const int kb = it / nblk, nb = it % nblk, n0 = nb * 32;
    int drow0 = n0;
    if (MODE == 1) drow0 = (n0 >> 7) * 256 + (n0 & 127);
    if (MODE == 2) drow0 = (n0 >> 7) * 256 + 128 + (n0 & 127);
    tr_item(W, K, N, WT, drow0, kb * 64, n0, scr, lane);
    return true;
}

__device__ __forceinline__ void p0_phase(Frame& F, const float* c, const float* c_ctx, const float* w_ada, const float* b_ada, float* mods,
                                         const float* mix_w_in, const float* mix_w_out, const float* ffn_w1, const float* ffn_w3, const float* ffn_w2,
                                         const float* na_w_qkv, const float* na_w_out, unsigned char* ws) {
    for (int u = F.bid; u < 192; u += F.G) {
        LAS float* sc = (LAS float*)(F.lds);
        LAS float* red = (LAS float*)(F.lds + 36864);
        for (int i = F.tid; i < 9 * 1024; i += NTHR) { const int b = i >> 10, k = i & 1023; const float v = (b < 8) ? c[b * 1024 + k] : c_ctx[k]; sc[i] = v / (1.f + __expf(-v)); }
        __syncthreads();
        const int layer = u / 96, col = (u % 96) * 64 + F.lane;
        const float* W = w_ada + (size_t)layer * 1024 * 6144 + col;
        float acc[9];
#pragma unroll
        for (int b = 0; b < 9; ++b) acc[b] = 0.f;
        const int k0 = F.wave * 128;
#pragma unroll 8
        for (int k = 0; k < 128; ++k) { const float w = W[(size_t)(k0 + k) * 6144];
#pragma unroll
            for (int b = 0; b < 9; ++b) acc[b] += sc[b * 1024 + k0 + k] * w; }
#pragma unroll
        for (int b = 0; b < 9; ++b) red[(F.wave * 9 + b) * 64 + F.lane] = acc[b];
        __syncthreads();
        if (F.wave == 0) {
#pragma unroll
            for (int b = 0; b < 9; ++b) { float s = 0.f;
#pragma unroll
                for (int w = 0; w < 8; ++w) s += red[(w * 9 + b) * 64 + F.lane];
                mods[(layer * 9 + b) * 6144 + col] = s + b_ada[layer * 6144 + col]; }
        }
        __syncthreads();
    }
    LAS float* scr = (LAS float*)(F.lds + 57344 + F.wave * 8704);
    const int gw = F.bid * NWAVES + F.wave, NGW = F.G * NWAVES;
    constexpr int NITEMS = 16 * 104 + 512 + 1408 * 3 + 1536 + 512;
    for (int it0 = gw; it0 < NITEMS; it0 += NGW) {
        int it = it0;
        if (tr_matrix<0>(it, mix_w_in, 1024, MIXIN, (bf16*)(ws + WS_WIN_T), scr, F.lane)) continue;
        if (tr_matrix<0>(it, mix_w_out, 1024, 1024, (bf16*)(ws + WS_WOUT_T), scr, F.lane)) continue;
        if (tr_matrix<1>(it, ffn_w1, 1024, FF, (bf16*)(ws + WS_W13_T), scr, F.lane)) continue;
        if (tr_matrix<2>(it, ffn_w3, 1024, FF, (bf16*)(ws + WS_W13_T), scr, F.lane)) continue;
        if (tr_matrix<0>(it, ffn_w2, FF, 1024, (bf16*)(ws + WS_W2_T), scr, F.lane)) continue;
        if (tr_matrix<0>(it, na_w_qkv, 1024, 3072, (bf16*)(ws + WS_QKV_T), scr, F.lane)) continue;
        tr_matrix<0>(it, na_w_out, 1024, 1024, (bf16*)(ws + WS_NAO_T), scr, F.lane);
    }
}
constexpr int MOE_ITEMS = NE * 1408 * 3, MOE_W13_ITEMS = NE * 2816, MOE_ITEMS_P6 = 0, MOE_ITEMS_P8 = 10240, MOE_ITEMS_P9 = 16384, MOE_ITEMS_P11 = 0, MOE_ITEMS_P16 = 7168, MOE_ITEMS_P7 = MOE_ITEMS - MOE_ITEMS_P8 - MOE_ITEMS_P9 - MOE_ITEMS_P11 - MOE_ITEMS_P16;
static_assert(MOE_ITEMS - MOE_ITEMS_P16 >= MOE_W13_ITEMS, "the items left for P16's idle workgroups must all be w2 items (the w1|w3 copies are read by P16 itself)");
__device__ __forceinline__ void moe_weight_phase(Frame& F, const float* w1, const float* w3, const float* w2, unsigned char* ws, int lo, int hi, int widx, int nw) {
    LAS float* scr = (LAS float*)(F.lds + 57344 + F.wave * 8704);
    const int gw = widx * NWAVES + F.wave, NGW = nw * NWAVES;
    for (int it0 = lo + gw; it0 < hi; it0 += NGW) {
        const bool isw2 = it0 >= MOE_W13_ITEMS; const int e = isw2 ? (it0 - MOE_W13_ITEMS) / 1408 : it0 / 2816; int it = isw2 ? 2816 + (it0 - MOE_W13_ITEMS) % 1408 : it0 % 2816;
        bf16* w13t = (bf16*)(ws + WS_MOEW13) + (size_t)e * 5632 * 1024; bf16* w2t = (bf16*)(ws + WS_MOEW2) + (size_t)e * 1024 * FF;
        if (tr_matrix<1>(it, w1 + (size_t)e * 1024 * FF, 1024, FF, w13t, scr, F.lane)) continue;
        if (tr_matrix<2>(it, w3 + (size_t)e * 1024 * FF, 1024, FF, w13t, scr, F.lane)) continue;
        tr_matrix<0>(it, w2 + (size_t)e * 1024 * FF, FF, 1024, w2t, scr, F.lane);
    }
}

struct RowIn { f32x4 x[4], sh[4], sc[4]; };
__device__ __forceinline__ void row_fetch(RowIn& R, const float* xrow, const float* sh, const float* sc, int lane) {
#pragma unroll
    for (int j = 0; j < 4; ++j) { R.x[j] = ((const GAS f32x4*)xrow)[lane + 64 * j]; R.sh[j] = ((const GAS f32x4*)sh)[lane + 64 * j]; R.sc[j] = ((const GAS f32x4*)sc)[lane + 64 * j]; }
}
__device__ __forceinline__ void row_finish(const RowIn& R, const f32x4 (&gg)[4], bf16* orow, int lane, f32x4 (&a)[4], const float* slab = nullptr, int nslab = 0, float* wb = nullptr) {
    float ss = 0.f;
#pragma unroll
    for (int j = 0; j < 4; ++j) a[j] = R.x[j];
    for (int s = 0; s < nslab; ++s) { const GAS f32x4* sr = (const GAS f32x4*)(slab + (size_t)s * (2048 * 1024)) + lane;
#pragma unroll
        for (int j = 0; j < 4; ++j) a[j] += sr[64 * j]; }
    if (wb) { GAS f32x4* w4 = (GAS f32x4*)wb + lane;
#pragma unroll
        for (int j = 0; j < 4; ++j) w4[64 * j] = a[j]; }
#pragma unroll
    for (int j = 0; j < 4; ++j) ss += (a[j].x * a[j].x + a[j].y * a[j].y) + (a[j].z * a[j].z + a[j].w * a[j].w);
    const float rs = rsqrtf(wave_sum(ss) * (1.f / 1024.f) + 1e-6f);
    GAS unsigned long long* o8 = (GAS unsigned long long*)orow + lane;
#pragma unroll
    for (int j = 0; j < 4; ++j) {
        a[j] = (a[j] * rs) * gg[j] * (R.sc[j] + 1.f) + R.sh[j];
        o8[64 * j] = (unsigned long long)pk2(a[j].x, a[j].y) | ((unsigned long long)pk2(a[j].z, a[j].w) << 32);
    }
}
__device__ __forceinline__ void normmod_phase(Frame& F, const float* src_ctx, const float* src_lat, const float* g, const float* mods_l, int off_shift, int off_scale, bf16* dst, const float* slab = nullptr, int nslab = 0, float* wb_ctx = nullptr) {
    const int gw = F.bid * NWAVES + F.wave, NGW = F.G * NWAVES;
    f32x4 gg[4];
#pragma unroll
    for (int j = 0; j < 4; ++j) gg[j] = ((const GAS f32x4*)g)[F.lane + 64 * j];
    RowIn cur, nxt;
    int r = gw; bool have = r < M_ALL;
#define NM_FETCH(R_, r_) do { const bool ic_ = (r_) < M_CTX; const int rl_ = ic_ ? (r_) : (r_) - M_CTX; const float* mp_ = mods_l + (ic_ ? 8 : (rl_ >> 11)) * 6144; \
        row_fetch(R_, (ic_ ? src_ctx : src_lat) + (size_t)rl_ * D, mp_ + off_shift, mp_ + off_scale, F.lane); } while (0)
    if (have) NM_FETCH(cur, r);
    while (have) {
        const int rn = r + NGW; const bool hn = rn < M_ALL;
        if (hn) NM_FETCH(nxt, rn);
        const bool isctx = r < M_CTX; const int rl = isctx ? r : r - M_CTX;
        f32x4 a[4];
        if (isctx) row_finish(cur, gg, dst + (size_t)r * D, F.lane, a, slab ? slab + (size_t)rl * D : nullptr, nslab, wb_ctx ? wb_ctx + (size_t)rl * D : nullptr);
        else row_finish(cur, gg, dst + (size_t)r * D, F.lane, a);
        cur = nxt; r = rn; have = hn;
    }
#undef NM_FETCH
}

namespace pg8 {
struct EpiResGate {
    static constexpr bool PERM = false, AFTER_DRAIN = false;
    const float* base_c; const float* base_l; float* out_c; float* out_l; const float* mods_l; int gate_off; int ctx_tiles;
    __device__ __forceinline__ void operator()(const f32x4 (&acc)[2][2][4][2], const Unit& u, int wr, int wc, int fr, int fq) const {
        const bool isctx = u.pm < ctx_tiles; const int rt = isctx ? u.pm : u.pm - ctx_tiles; const int mi = isctx ? 8 : (rt >> 3);
        const float* base = isctx ? base_c : base_l; float* out = isctx ? out_c : out_l;
        const int col0 = u.pn * BM + wc * 32 + 4 * fq; const float* gp = mods_l + mi * 6144 + gate_off + col0;
        f32x4 gv[2][2];
#pragma unroll
        for (int bj = 0; bj < 2; ++bj)
#pragma unroll
            for (int n = 0; n < 2; ++n) gv[bj][n] = *(const f32x4*)(gp + bj * HALF + n * 16);
#pragma unroll
        for (int ai = 0; ai < 2; ++ai)
#pragma unroll
            for (int m = 0; m < 4; ++m) { const size_t off = (size_t)(rt * BM + ai * HALF + wr * 64 + m * 16 + fr) * 1024 + col0;
#pragma unroll
                for (int bj = 0; bj < 2; ++bj)
#pragma unroll
                    for (int n = 0; n < 2; ++n) { const f32x4 b = *(const f32x4*)(base + off + bj * HALF + n * 16); *(f32x4*)(out + off + bj * HALF + n * 16) = b + gv[bj][n] * acc[ai][bj][m][n]; } }
    }
};
struct EpiSwiGLU {
    static constexpr bool PERM = true, AFTER_DRAIN = false;
    bf16_t* O; int ldo; int nt_mod;
    __device__ __forceinline__ void operator()(const f32x4 (&acc)[2][2][4][2], const Unit& u, int wr, int wc, int fr, int fq) const {
        const int pnl = u.pn % nt_mod; const int row0 = u.pm * BM + wr * 64 + fr, col0 = pnl * HALF + wc * 32 + 8 * fq;
#pragma unroll
        for (int ai = 0; ai < 2; ++ai)
#pragma unroll
            for (int m = 0; m < 4; ++m) { bf16_t* rowp = O + (size_t)(row0 + ai * HALF + m * 16) * ldo + col0;
                float h[8];
#pragma unroll
                for (int n = 0; n < 2; ++n)
#pragma unroll
                    for (int e = 0; e < 4; ++e) { const float a = acc[ai][0][m][n][e], b = acc[ai][1][m][n][e]; h[n * 4 + e] = a * b * __builtin_amdgcn_rcpf(1.f + __expf(-a)); }
                u32x4 w; w.x = cvt_pk_bf16(h[0], h[1]); w.y = cvt_pk_bf16(h[2], h[3]); w.z = cvt_pk_bf16(h[4], h[5]); w.w = cvt_pk_bf16(h[6], h[7]);
                PG8_ST16(O, rowp, w); }
    }
};
struct EpiPlainMod {
    static constexpr bool PERM = true, AFTER_DRAIN = false;
    bf16_t* O; int ldo; int nt_mod;
    __device__ __forceinline__ void operator()(const f32x4 (&acc)[2][2][4][2], const Unit& u, int wr, int wc, int fr, int fq) const {
        const int pnl = u.pn % nt_mod; const int row0 = u.pm * BM + wr * 64 + fr, col0 = pnl * BM + wc * 32 + 8 * fq;
#pragma unroll
        for (int ai = 0; ai < 2; ++ai)
#pragma unroll
            for (int m = 0; m < 4; ++m) { bf16_t* rowp = O + (size_t)(row0 + ai * HALF + m * 16) * ldo + col0;
#pragma unroll
                for (int bj = 0; bj < 2; ++bj) { const f32x4 v0 = acc[ai][bj][m][0], v1 = acc[ai][bj][m][1];
                    u32x4 w; w.x = cvt_pk_bf16(v0[0], v0[1]); w.y = cvt_pk_bf16(v0[2], v0[3]); w.z = cvt_pk_bf16(v1[0], v1[1]); w.w = cvt_pk_bf16(v1[2], v1[3]);
                    PG8_ST16(O, rowp + bj * HALF, w); } }
    }
};
struct SplitKOrder {
    int ntm, nN, ns, kslice, G, c;
    __device__ __forceinline__ bool next(int i, Unit& u) const {
        const int L = i * G + c; if (L >= ntm * nN * ns) return false;
        const int ks = L % ns, t = L / ns; u.pn = t % nN; u.pm = t / nN; u.k0 = ks * kslice; return true;
    }
    __device__ __forceinline__ void a_ready(const Unit&) const {}
    __device__ __forceinline__ void done(const Unit&) const {}
};
struct EpiSlabGate {
    static constexpr bool PERM = false, AFTER_DRAIN = false;
    float* slab; const float* gate; int kslice;
    __device__ __forceinline__ void operator()(const f32x4 (&acc)[2][2][4][2], const Unit& u, int wr, int wc, int fr, int fq) const {
        const int col0 = u.pn * BM + wc * 32 + 4 * fq; float* out = slab + (size_t)(u.k0 / kslice) * (2048 * 1024);
        f32x4 gv[2][2];
#pragma unroll
        for (int bj = 0; bj < 2; ++bj)
#pragma unroll
            for (int n = 0; n < 2; ++n) gv[bj][n] = *(const f32x4*)(gate + col0 + bj * HALF + n * 16);
#pragma unroll
        for (int ai = 0; ai < 2; ++ai)
#pragma unroll
            for (int m = 0; m < 4; ++m) { float* op = out + (size_t)(u.pm * BM + ai * HALF + wr * 64 + m * 16 + fr) * 1024 + col0;
#pragma unroll
                for (int bj = 0; bj < 2; ++bj)
#pragma unroll
                    for (int n = 0; n < 2; ++n) *(f32x4*)(op + bj * HALF + n * 16) = gv[bj][n] * acc[ai][bj][m][n]; }
    }
};
struct MoeOrder {
    int tb[9]; int ntn, G, c; int limit = 0x7fffffff;
    __device__ __forceinline__ bool next(int i, Unit& u) const {
        const int L = i * G + c; if (L >= tb[8] * ntn || L >= limit) return false;
        const int mt = L / ntn, pn = L % ntn; int e = 0;
#pragma unroll
        for (int k = 1; k < 8; ++k) e += (mt >= tb[k]) ? 1 : 0;
        u.pm = mt; u.pn = e * ntn + pn; return true;
    }
    __device__ __forceinline__ void a_ready(const Unit&) const {}
    __device__ __forceinline__ void done(const Unit&) const {}
};
struct MoeTailOrder {
    int tb[9]; int first, ntail, G, c;
    __device__ __forceinline__ bool next(int i, Unit& u) const {
        const int L = i * G + c; if (L >= ntail * 11) return false;
        const int tu = L / 11, ks = L % 11, gu = first + tu, mt = gu >> 2, pn = gu & 3; int e = 0;
#pragma unroll
        for (int k = 1; k < 8; ++k) e += (mt >= tb[k]) ? 1 : 0;
        u.pm = mt; u.pn = e * 4 + pn; u.k0 = ks * 256; return true;
    }
    __device__ __forceinline__ void a_ready(const Unit&) const {}
    __device__ __forceinline__ void done(const Unit&) const {}
};
struct EpiTailSlab {
    static constexpr bool PERM = false, AFTER_DRAIN = false;
    float* slab; int first, ntail;
    __device__ __forceinline__ void operator()(const f32x4 (&acc)[2][2][4][2], const Unit& u, int wr, int wc, int fr, int fq) const {
        const int col0 = (u.pn & 3) * BM + wc * 32 + 4 * fq; float* out = slab + (size_t)(u.k0 >> 8) * ((size_t)(ntail >> 2) * 256 * 1024);
        const int rt = u.pm - (first >> 2);
#pragma unroll
        for (int ai = 0; ai < 2; ++ai)
#pragma unroll
            for (int m = 0; m < 4; ++m) { float* op = out + (size_t)(rt * BM + ai * HALF + wr * 64 + m * 16 + fr) * 1024 + col0;
#pragma unroll
                for (int bj = 0; bj < 2; ++bj)
#pragma unroll
                    for (int n = 0; n < 2; ++n) *(f32x4*)(op + bj * HALF + n * 16) = acc[ai][bj][m][n]; }
    }
};
}

struct PrepIn { const float *rw_mu, *rw_w0, *rw_w_up, *rw_a0, *rw_a_up, *rw_g_up, *rw_k_k, *rw_k_a, *rw_r_k, *conv_w, *conv_b, *dt_bias; };
__device__ __forceinline__ bf16x8 gather8(const float* p, int stride) {
    v4u w; w.x = pk2(p[0], p[stride]); w.y = pk2(p[2 * stride], p[3 * stride]); w.z = pk2(p[4 * stride], p[5 * stride]); w.w = pk2(p[6 * stride], p[7 * stride]); return __builtin_bit_cast(bf16x8, w);
}
constexpr int ACT_ST = 464;
__device__ __forceinline__ void prepare_phase(Frame& F, const PrepIn& P, const bf16* Z, bf16* PR, bf16* PM, float* DT, float* BONUS, bf16* GATE, bf16* ZG) {
    LAS unsigned short* zs = (LAS unsigned short*)F.lds;
    LAS unsigned char* actb = F.lds + 24576;
    LAS float* cst = (LAS float*)(F.lds + 24576 + 16 * ACT_ST);
    const int tid = F.tid, lane = F.lane, fr = lane & 15, fq = lane >> 4, w = F.wave;
    const int hf = F.bid & 1, wl = w & 3, hd = 4 * hf + wl;
    __syncthreads();
    if (tid < 256) { const int c = 256 * hf + tid; cst[tid] = P.rw_w0[c]; cst[256 + tid] = P.rw_w0[512 + c]; cst[512 + tid] = P.rw_a0[c]; cst[768 + tid] = P.rw_a0[512 + c];
      cst[1024 + tid] = P.rw_k_k[c]; cst[1280 + tid] = P.rw_k_a[c]; cst[1536 + tid] = P.rw_r_k[c]; cst[1792 + tid] = P.rw_r_k[512 + c]; }
    bf16x8 W[16];
#pragma unroll
    for (int cb = 0; cb < 4; ++cb) { const int c = 64 * hd + 4 * fr + cb;
        if (w < 4) { W[cb] = gather8(P.rw_w_up + (size_t)(8 * fq) * 512 + c, 512); W[4 + cb] = gather8(P.rw_w_up + (size_t)(32 + 8 * fq) * 512 + c, 512);
                     W[8 + cb] = gather8(P.rw_a_up + (size_t)(8 * fq) * 512 + c, 512); W[12 + cb] = gather8(P.rw_a_up + (size_t)(32 + 8 * fq) * 512 + c, 512); }
        else { W[cb] = gather8(P.rw_g_up + (size_t)(8 * fq) * 512 + c, 512); W[4 + cb] = gather8(P.rw_g_up + (size_t)(32 + 8 * fq) * 512 + c, 512); W[8 + cb] = gather8(P.rw_g_up + (size_t)(64 + 8 * fq) * 512 + c, 512); W[12 + cb] = W[cb]; } }
    const int col0 = (tid < 256) ? (256 * hf + tid) : (512 + 256 * hf + tid - 256), col1 = (tid < 256) ? (1024 + 256 * hf + tid) : ((tid < 480) ? (1536 + tid - 256) : 1536);
    const int zo0 = tid, zo1 = 512 + (tid & 255);
    const float mu00 = P.rw_mu[col0], mu10 = P.rw_mu[RWC + col0], mu01 = P.rw_mu[col1], mu11 = P.rw_mu[RWC + col1];
    float cw[5];
#pragma unroll
    for (int k = 0; k < 5; ++k) cw[k] = P.conv_w[k * 1024 + 512 * hf + tid];
    const float cbv = P.conv_b[512 * hf + tid], dtb = P.dt_bias[tid & 15];
    __syncthreads();

#ifndef PREP_REPS
#define PREP_REPS 1
#endif
    for (int rb_ = F.bid >> 1; rb_ < (M_ALL / 16) * PREP_REPS; rb_ += (F.G >> 1)) {
        const int rb = rb_ % (M_ALL / 16); const int g0 = rb * 16; const bool isctx = g0 < M_CTX; const int T = isctx ? CTXL : SEQ; const int t0 = isctx ? (g0 & (CTXL - 1)) : ((g0 - M_CTX) & (SEQ - 1));
        const bf16* zb = Z + (size_t)g0 * ZLD;
        const bool hp = t0 > 0, hn = (t0 + 16 < T), hp2 = t0 >= 2, hn2 = (t0 + 17 < T);
        float z0[18], z1[18], x[20];
        const int ccol = RWC + 512 + 512 * hf + tid;
#pragma unroll
        for (int i = 0; i < 18; ++i) { const bool ok = (i == 0) ? hp : ((i == 17) ? hn : true); z0[i] = ok ? ldbf(zb + (ptrdiff_t)(i - 1) * ZLD + col0) : 0.f; z1[i] = ok ? ldbf(zb + (ptrdiff_t)(i - 1) * ZLD + col1) : 0.f; }
#pragma unroll
        for (int i = 0; i < 20; ++i) { const bool ok = (i == 0) ? hp2 : (i == 1) ? hp : (i == 18) ? hn : (i == 19) ? hn2 : true; x[i] = ok ? ldbf(zb + (ptrdiff_t)(i - 2) * ZLD + ccol) : 0.f; }
#pragma unroll
        for (int tb = 0; tb < 16; ++tb) zs[tb * 768 + zo0] = (unsigned short)f2bf(z0[tb + 1] + mu00 * (z0[tb] - z0[tb + 1]) + mu10 * (z0[tb + 2] - z0[tb + 1]));
        {
            const int a = tid - 256;
#pragma unroll
            for (int tb = 0; tb < 16; ++tb) {
                const float zsft = z1[tb + 1] + mu01 * (z1[tb] - z1[tb + 1]) + mu11 * (z1[tb + 2] - z1[tb + 1]);
                if (tid < 256) zs[tb * 768 + zo1] = (unsigned short)f2bf(zsft);
                else if (tid < 480) { const float sg = sigm((a < 64) ? 2.f * zsft : zsft); const float av = (a < 64) ? (2.f * sg - 1.f) : ((a < 128) ? zsft : sg);
                    *(LAS unsigned short*)(actb + tb * ACT_ST + a * 2) = (unsigned short)f2bf(av); }
            }
        }
#pragma unroll
        for (int tb = 0; tb < 16; ++tb) {
            float y = cbv + cw[0] * x[tb] + cw[1] * x[tb + 1] + cw[2] * x[tb + 2] + cw[3] * x[tb + 3] + cw[4] * x[tb + 4];
            y = y * sigm(y);
            PM[(size_t)(g0 + tb) * 1024 + 512 * hf + tid] = (bf16)f2bf(y);
        }
        { const int tb = tid >> 5, cc = tid & 31;
          *(GAS v4u*)(ZG + (size_t)(g0 + tb) * 512 + 256 * hf + cc * 8) = *(const GAS v4u*)(zb + (size_t)tb * ZLD + RWC + 256 * hf + cc * 8); }
        if (hf == 0 && tid < 256) { const int tb = tid >> 4, cc = tid & 15; const float x = ldbf(zb + (size_t)tb * ZLD + RWC + 1536 + cc) + dtb; DT[(size_t)(g0 + tb) * 16 + cc] = (x > 20.f) ? x : log1pf(__expf(x)); }
        __syncthreads();
        const f32x4 zero = {0.f, 0.f, 0.f, 0.f};
        const int cl0 = 64 * wl + 4 * fr;
        if (w < 4) {
            bf16x8 Af[4];
#pragma unroll
            for (int kb = 0; kb < 4; ++kb) Af[kb] = *(const LAS bf16x8*)(actb + fr * ACT_ST + kb * 64 + fq * 16);
            f32x4 lw0[4], lw1[4], ia0[4], ia1[4];
#pragma unroll
            for (int cb = 0; cb < 4; ++cb) {
                lw0[cb] = __builtin_amdgcn_mfma_f32_16x16x32_bf16(Af[0], W[cb], zero, 0, 0, 0); lw1[cb] = __builtin_amdgcn_mfma_f32_16x16x32_bf16(Af[1], W[4 + cb], zero, 0, 0, 0);
                ia0[cb] = __builtin_amdgcn_mfma_f32_16x16x32_bf16(Af[2], W[8 + cb], zero, 0, 0, 0); ia1[cb] = __builtin_amdgcn_mfma_f32_16x16x32_bf16(Af[3], W[12 + cb], zero, 0, 0, 0);
            }
            const f32x4 w00 = *(const LAS f32x4*)(cst + cl0), w01 = *(const LAS f32x4*)(cst + 256 + cl0), a00 = *(const LAS f32x4*)(cst + 512 + cl0), a01 = *(const LAS f32x4*)(cst + 768 + cl0);
            const f32x4 kkc = *(const LAS f32x4*)(cst + 1024 + cl0), kac = *(const LAS f32x4*)(cst + 1280 + cl0), rk0 = *(const LAS f32x4*)(cst + 1536 + cl0), rk1 = *(const LAS f32x4*)(cst + 1792 + cl0);
#pragma unroll
            for (int e = 0; e < 4; ++e) {
                const int tok = 4 * fq + e; const size_t g = (size_t)(g0 + tok);
                const v2u ru = *(const LAS v2u*)(zs + tok * 768 + cl0), ku = *(const LAS v2u*)(zs + tok * 768 + 256 + cl0), vu = *(const LAS v2u*)(zs + tok * 768 + 512 + cl0);
                const f32x4 r = {bflo(ru.x), bfhi(ru.x), bflo(ru.y), bfhi(ru.y)}, k = {bflo(ku.x), bfhi(ku.x), bflo(ku.y), bfhi(ku.y)};
                const f32x4 kks = k * kkc;
                const float ssq = sum16((kks[0] * kks[0] + kks[1] * kks[1]) + (kks[2] * kks[2] + kks[3] * kks[3]));
                const float rn = __builtin_amdgcn_rcpf(fmaxf(sqrtf(ssq), 1e-12f));
                float ee0[4], ee1[4], kd0[4], kd1[4], bb0[4], bb1[4], na[4]; float bon = 0.f;
#pragma unroll
                for (int cb = 0; cb < 4; ++cb) {
                    ee0[cb] = 0.60653066f * sigm(w00[cb] + lw0[cb][e]); ee1[cb] = 0.60653066f * sigm(w01[cb] + lw1[cb][e]);
                    const float ic0 = sigm(a00[cb] + ia0[cb][e]), ic1 = sigm(a01[cb] + ia1[cb][e]);
                    const float kkn = kks[cb] * rn;
                    kd0[cb] = k[cb] * (1.f + (ic0 - 1.f) * kac[cb]); kd1[cb] = k[cb] * (1.f + (ic1 - 1.f) * kac[cb]);
                    bon += r[cb] * (kd0[cb] * rk0[cb] + kd1[cb] * rk1[cb]);
                    na[cb] = -kkn; bb0[cb] = kkn * ic0; bb1[cb] = kkn * ic1;
                }
                bon = sum16(bon); if (fr == 0) BONUS[g * 8 + hd] = bon;
                bf16* pr = PR + g * PRV + 256 * hf + cl0;
                *(GAS v2u*)(pr) = ru; *(GAS v2u*)(pr + 512) = vu;
                v2u o;
                o.x = pk2(na[0], na[1]); o.y = pk2(na[2], na[3]); *(GAS v2u*)(pr + 1024) = o;
                o.x = pk2(ee0[0], ee0[1]); o.y = pk2(ee0[2], ee0[3]); *(GAS v2u*)(pr + 1536) = o;
                o.x = pk2(kd0[0], kd0[1]); o.y = pk2(kd0[2], kd0[3]); *(GAS v2u*)(pr + 2048) = o;
                o.x = pk2(bb0[0], bb0[1]); o.y = pk2(bb0[2], bb0[3]); *(GAS v2u*)(pr + 2560) = o;
                o.x = pk2(ee1[0], ee1[1]); o.y = pk2(ee1[2], ee1[3]); *(GAS v2u*)(pr + 3072) = o;
                o.x = pk2(kd1[0], kd1[1]); o.y = pk2(kd1[2], kd1[3]); *(GAS v2u*)(pr + 3584) = o;
                o.x = pk2(bb1[0], bb1[1]); o.y = pk2(bb1[2], bb1[3]); *(GAS v2u*)(pr + 4096) = o;
            }
        } else {
            bf16x8 Af[3];
#pragma unroll
            for (int kb = 0; kb < 3; ++kb) Af[kb] = *(const LAS bf16x8*)(actb + fr * ACT_ST + (4 + kb) * 64 + fq * 16);
            f32x4 gt[4];
#pragma unroll
            for (int cb = 0; cb < 4; ++cb) {
                gt[cb] = __builtin_amdgcn_mfma_f32_16x16x32_bf16(Af[0], W[cb], zero, 0, 0, 0);
                gt[cb] = __builtin_amdgcn_mfma_f32_16x16x32_bf16(Af[1], W[4 + cb], gt[cb], 0, 0, 0); gt[cb] = __builtin_amdgcn_mfma_f32_16x16x32_bf16(Af[2], W[8 + cb], gt[cb], 0, 0, 0);
            }
#pragma unroll
            for (int e = 0; e < 4; ++e) { v2u o; o.x = pk2(gt[0][e], gt[1][e]); o.y = pk2(gt[2][e], gt[3][e]); *(GAS v2u*)(GATE + (size_t)(g0 + 4 * fq + e) * 512 + 256 * hf + cl0) = o; }
        }
        __syncthreads();
    }
}

template <int SH> __device__ __forceinline__ float dpp_shr(float x) { return __int_as_float(__builtin_amdgcn_update_dpp(0, __float_as_int(x), 0x110 + SH, 0xF, 0xF, true)); }
__device__ __forceinline__ int scan_row16(int c, int t, int b, int d) {
    const int st = c * 16 + t; const int seg = (st >= CTXL) ? 1 : 0; const int T = seg ? SEQ : CTXL; const int sl = st - seg * CTXL;
    return (seg ? (M_CTX + b * SEQ) : b * CTXL) + (d ? (T - 1 - sl) : sl);
}
__device__ __forceinline__ v4u scale8(const v4u u, float s) {
    v4u o; o.x = pk2(bflo(u.x) * s, bfhi(u.x) * s); o.y = pk2(bflo(u.y) * s, bfhi(u.y) * s); o.z = pk2(bflo(u.z) * s, bfhi(u.z) * s); o.w = pk2(bflo(u.w) * s, bfhi(u.w) * s); return o;
}
__device__ __forceinline__ bf16x8 pack4z(const f32x4& a) { v4u w; w.x = pk2(a[0], a[1]); w.y = pk2(a[2], a[3]); w.z = 0u; w.w = 0u; return __builtin_bit_cast(bf16x8, w); }
__device__ __forceinline__ bf16x8 tr4z(const LAS unsigned char* p) {
    const v2u t = __builtin_bit_cast(v2u, __builtin_amdgcn_ds_read_tr16_b64_v4i16((LAS v4i16_t*)p)); v4u w; w.x = t.x; w.y = t.y; w.z = 0u; w.w = 0u; return __builtin_bit_cast(bf16x8, w);
}
__device__ __forceinline__ bf16x8 cat44(const v2u a, const v2u b) { v4u w; w.x = a.x; w.y = a.y; w.z = b.x; w.w = b.y; return __builtin_bit_cast(bf16x8, w); }
constexpr int NCH16 = (CTXL + SEQ) / 16;
__device__ __forceinline__ f32x4 mm16(const f32x4& xT_c, const f32x4& y_c, const f32x4& acc) {
    return __builtin_amdgcn_mfma_f32_16x16x32_bf16(pack4z(xT_c), pack4z(y_c), acc, 0, 0, 0);
}
constexpr int RING_FLAGS = 122880;
constexpr int NSLOT = 6;
__device__ __forceinline__ unsigned lds_flag_ld(volatile LAS unsigned* p) { return (unsigned)__builtin_amdgcn_readfirstlane((int)*p); }
__device__ __forceinline__ void ring_wait_full(volatile LAS unsigned* fl, int s, int c) { while (lds_flag_ld(fl + s) != (unsigned)(c + 1)) __builtin_amdgcn_s_sleep(1); asm volatile("" ::: "memory"); }
__device__ __forceinline__ void ring_wait_free(volatile LAS unsigned* fl, int s, int c, int nslot = NSLOT, unsigned ncons = 4u) { const unsigned want = ncons * (unsigned)(c / nslot); while (lds_flag_ld(fl + 8 + s) < want) __builtin_amdgcn_s_sleep(1); asm volatile("" ::: "memory"); }
__device__ __forceinline__ void ring_set_full(volatile LAS unsigned* fl, int s, int c, int lane) { asm volatile("s_waitcnt lgkmcnt(0)" ::: "memory"); if (lane == 0) fl[s] = (unsigned)(c + 1); }
__device__ __forceinline__ void ring_done(volatile LAS unsigned* fl, int s, int lane) { asm volatile("s_waitcnt lgkmcnt(0)" ::: "memory"); if (lane == 0) __hip_atomic_fetch_add((LAS unsigned*)(fl + 8 + s), 1u, __ATOMIC_RELAXED, __HIP_MEMORY_SCOPE_WORKGROUP); }

constexpr int RST = 144, RIMG = 16 * RST;
constexpr int RW_SLOT = 18432;
__device__ __forceinline__ void rwkv_block(Frame& F, int unit, const bf16* PR, bf16* YRW) {
    const int d = unit & 1, h = (unit >> 1) & 7, b = unit >> 4;
    const int lane = F.lane, fr = lane & 15, fq = lane >> 4, tq = (lane & 15) >> 2, tp = lane & 3;
    volatile LAS unsigned* fl = (volatile LAS unsigned*)(F.lds + RING_FLAGS);
    __syncthreads();
    if (F.tid < 16) fl[F.tid] = 0u;
    __syncthreads();
    if (F.wave >= 4) {
        const int p = F.wave - 4;
        const int ve = (3 + 3 * d) * 512, vb = (5 + 3 * d) * 512, vk = (4 + 3 * d) * 512;
        bf16x8 Ltri; { v4u w; w.x = ((4 * fq + 0 <= fr) ? 0x3F80u : 0u) | ((4 * fq + 1 <= fr) ? 0x3F800000u : 0u); w.y = ((4 * fq + 2 <= fr) ? 0x3F80u : 0u) | ((4 * fq + 3 <= fr) ? 0x3F800000u : 0u); w.z = 0u; w.w = 0u; Ltri = __builtin_bit_cast(bf16x8, w); }
        v4u rE[2], rA[2], rB[2], rK[2], rR[2], rV[2];
#define RW_LOAD(c_) do { \
        _Pragma("unroll") for (int i = 0; i < 2; ++i) { const int id = lane + 64 * i; const bf16* src = PR + (size_t)scan_row16((c_), id >> 3, b, d) * PRV + h * 64 + (id & 7) * 8; \
            rE[i] = *(const GAS v4u*)(src + ve); rA[i] = *(const GAS v4u*)(src + 1024); rB[i] = *(const GAS v4u*)(src + vb); rK[i] = *(const GAS v4u*)(src + vk); rR[i] = *(const GAS v4u*)(src); rV[i] = *(const GAS v4u*)(src + 512); } } while (0)
        RW_LOAD(p);
        for (int c = p; c < NCH16; c += 4) {
            const int s = c % NSLOT;
            LAS unsigned char* sb = F.lds + s * RW_SLOT;
            LAS unsigned char* RE = sb; LAS unsigned char* RA = sb + RIMG; LAS unsigned char* RB = sb + 2 * RIMG; LAS unsigned char* RK = sb + 3 * RIMG; LAS unsigned char* RR = sb + 4 * RIMG;
            LAS unsigned char* RV = sb + 5 * RIMG; LAS unsigned char* FRG = sb + 6 * RIMG; LAS float* GC = (LAS float*)(sb + 6 * RIMG + 4096);
            ring_wait_free(fl, s, c);
#pragma unroll
            for (int i = 0; i < 2; ++i) { const int id = lane + 64 * i; const int o = (id >> 3) * RST + (id & 7) * 16;
                *(LAS v4u*)(RE + o) = rE[i]; *(LAS v4u*)(RA + o) = rA[i]; *(LAS v4u*)(RB + o) = rB[i]; *(LAS v4u*)(RK + o) = rK[i]; *(LAS v4u*)(RR + o) = rR[i]; *(LAS v4u*)(RV + o) = rV[i]; }
            if (c + 4 < NCH16) RW_LOAD(c + 4);
            asm volatile("s_waitcnt lgkmcnt(0)" ::: "memory");
#pragma unroll
            for (int jb = 0; jb < 4; ++jb) {
                const int tro = (4 * fq + tq) * RST + (16 * jb + 4 * tp) * 2;
                const v2u eu = __builtin_bit_cast(v2u, __builtin_amdgcn_ds_read_tr16_b64_v4i16((LAS v4i16_t*)(RE + tro)));
                const v2u au = __builtin_bit_cast(v2u, __builtin_amdgcn_ds_read_tr16_b64_v4i16((LAS v4i16_t*)(RA + tro)));
                const v2u bu = __builtin_bit_cast(v2u, __builtin_amdgcn_ds_read_tr16_b64_v4i16((LAS v4i16_t*)(RB + tro)));
                const v2u ku = __builtin_bit_cast(v2u, __builtin_amdgcn_ds_read_tr16_b64_v4i16((LAS v4i16_t*)(RK + tro)));
                const v2u ru = __builtin_bit_cast(v2u, __builtin_amdgcn_ds_read_tr16_b64_v4i16((LAS v4i16_t*)(RR + tro)));
                v4u ew; ew.x = eu.x; ew.y = eu.y; ew.z = 0u; ew.w = 0u;
                const f32x4 cum = __builtin_amdgcn_mfma_f32_16x16x32_bf16(Ltri, __builtin_bit_cast(bf16x8, ew), (f32x4){0.f, 0.f, 0.f, 0.f}, 0, 0, 0);
                const float ev[4] = {bflo(eu.x), bfhi(eu.x), bflo(eu.y), bfhi(eu.y)}, av[4] = {bflo(au.x), bfhi(au.x), bflo(au.y), bfhi(au.y)}, bv[4] = {bflo(bu.x), bfhi(bu.x), bflo(bu.y), bfhi(bu.y)};
                const float kv[4] = {bflo(ku.x), bfhi(ku.x), bflo(ku.y), bfhi(ku.y)}, rv[4] = {bflo(ru.x), bfhi(ru.x), bflo(ru.y), bfhi(ru.y)};
#pragma unroll
                for (int e = 0; e < 4; ++e) {
                    const float G = __expf(-cum[e]), Gi = __expf(cum[e]), Gx = __expf(ev[e] - cum[e]);
                    const int o = (4 * fq + e) * RST + (16 * jb + fr) * 2;
                    const unsigned ab = pk2(av[e] * Gx, bv[e] * Gi), kr = pk2(kv[e] * Gi, rv[e] * G);
                    *(LAS unsigned short*)(RA + o) = (unsigned short)ab; *(LAS unsigned short*)(RB + o) = (unsigned short)(ab >> 16);
                    *(LAS unsigned short*)(RK + o) = (unsigned short)kr; *(LAS unsigned short*)(RR + o) = (unsigned short)(kr >> 16);
                    if (e == 3 && fq == 3) GC[16 * jb + fr] = G;
                }
            }
            asm volatile("s_waitcnt lgkmcnt(0)" ::: "memory");
            f32x4 aba = {0.f, 0.f, 0.f, 0.f}, aka = aba, abr = aba, akr = aba, abaT = aba;
#pragma unroll
            for (int kb = 0; kb < 2; ++kb) {
                const int o = fr * RST + kb * 64 + fq * 16;
                const bf16x8 fb = *(const LAS bf16x8*)(RB + o), fk = *(const LAS bf16x8*)(RK + o), fa = *(const LAS bf16x8*)(RA + o), frr = *(const LAS bf16x8*)(RR + o);
                aba = __builtin_amdgcn_mfma_f32_16x16x32_bf16(fb, fa, aba, 0, 0, 0); aka = __builtin_amdgcn_mfma_f32_16x16x32_bf16(fk, fa, aka, 0, 0, 0);
                abr = __builtin_amdgcn_mfma_f32_16x16x32_bf16(fb, frr, abr, 0, 0, 0); akr = __builtin_amdgcn_mfma_f32_16x16x32_bf16(fk, frr, akr, 0, 0, 0);
                abaT = __builtin_amdgcn_mfma_f32_16x16x32_bf16(fa, fb, abaT, 0, 0, 0);
            }
            f32x4 idc;
#pragma unroll
            for (int e = 0; e < 4; ++e) { const int row = 4 * fq + e;
                aba[e] = (row < fr) ? aba[e] : 0.f; aka[e] = (row < fr) ? aka[e] : 0.f; abr[e] = (row <= fr) ? abr[e] : 0.f; akr[e] = (row <= fr) ? akr[e] : 0.f;
                abaT[e] = (fr < row) ? abaT[e] : 0.f; idc[e] = (row == fr) ? 1.f : 0.f; }
            f32x4 t_c = idc + aba, t_T = idc + abaT;
            f32x4 p_c = mm16(abaT, aba, (f32x4){0.f, 0.f, 0.f, 0.f}), p_T = mm16(aba, abaT, (f32x4){0.f, 0.f, 0.f, 0.f});
            { const f32x4 n_c = mm16(t_T, p_c, t_c), n_T = mm16(p_c, t_T, t_T); t_c = n_c; t_T = n_T; }
            { const f32x4 q_c = mm16(p_T, p_c, (f32x4){0.f, 0.f, 0.f, 0.f}), q_T = mm16(p_c, p_T, (f32x4){0.f, 0.f, 0.f, 0.f}); p_c = q_c; p_T = q_T; }
            { const f32x4 n_c = mm16(t_T, p_c, t_c), n_T = mm16(p_c, t_T, t_T); t_c = n_c; t_T = n_T; }
            { const f32x4 q_c = mm16(p_T, p_c, (f32x4){0.f, 0.f, 0.f, 0.f}); p_c = q_c; }
            const f32x4 tm_c = mm16(t_T, p_c, t_c);
            *(LAS bf16x8*)(FRG + lane * 16) = pack4z(tm_c); *(LAS bf16x8*)(FRG + 1024 + lane * 16) = pack4z(aka);
            *(LAS bf16x8*)(FRG + 2048 + lane * 16) = pack4z(abr); *(LAS bf16x8*)(FRG + 3072 + lane * 16) = pack4z(akr);
            ring_set_full(fl, s, c, lane);
        }
#undef RW_LOAD
    } else {
        const int q = F.wave;
        __builtin_amdgcn_s_setprio(3);
        bf16* yout = YRW + (size_t)d * M_ALL * 512 + h * 64 + 16 * q;
        f32x4 T[4];
#pragma unroll
        for (int jb = 0; jb < 4; ++jb) T[jb] = (f32x4){0.f, 0.f, 0.f, 0.f};
        for (int c = 0; c < NCH16; ++c) {
            const int s = c % NSLOT;
            LAS unsigned char* sb = F.lds + s * RW_SLOT;
            LAS unsigned char* RA = sb + RIMG; LAS unsigned char* RB = sb + 2 * RIMG; LAS unsigned char* RK = sb + 3 * RIMG; LAS unsigned char* RR = sb + 4 * RIMG;
            LAS unsigned char* RV = sb + 5 * RIMG; LAS unsigned char* FRG = sb + 6 * RIMG; LAS float* GC = (LAS float*)(sb + 6 * RIMG + 4096);
            ring_wait_full(fl, s, c);
            const bf16x8 tmA = *(const LAS bf16x8*)(FRG + lane * 16), akaA = *(const LAS bf16x8*)(FRG + 1024 + lane * 16), abrA = *(const LAS bf16x8*)(FRG + 2048 + lane * 16), akrA = *(const LAS bf16x8*)(FRG + 3072 + lane * 16);
            const bf16x8 Vf = tr4z(RV + (4 * fq + tq) * RST + (16 * q + 4 * tp) * 2);
            f32x4 x = {0.f, 0.f, 0.f, 0.f}, y = {0.f, 0.f, 0.f, 0.f};
#pragma unroll
            for (int jp = 0; jp < 2; ++jp) {
                const int o = fr * RST + (32 * jp + 4 * fq) * 2;
                const bf16x8 tf = pack8(T[2 * jp], T[2 * jp + 1]);
                x = __builtin_amdgcn_mfma_f32_16x16x32_bf16(cat44(*(const LAS v2u*)(RA + o), *(const LAS v2u*)(RA + o + 32)), tf, x, 0, 0, 0);
                y = __builtin_amdgcn_mfma_f32_16x16x32_bf16(cat44(*(const LAS v2u*)(RR + o), *(const LAS v2u*)(RR + o + 32)), tf, y, 0, 0, 0);
            }
            x = __builtin_amdgcn_mfma_f32_16x16x32_bf16(akaA, Vf, x, 0, 0, 0);
            const f32x4 ut = __builtin_amdgcn_mfma_f32_16x16x32_bf16(tmA, pack4z(x), (f32x4){0.f, 0.f, 0.f, 0.f}, 0, 0, 0);
            y = __builtin_amdgcn_mfma_f32_16x16x32_bf16(abrA, pack4z(ut), y, 0, 0, 0);
            y = __builtin_amdgcn_mfma_f32_16x16x32_bf16(akrA, Vf, y, 0, 0, 0);
            bf16x8 UV; { const v4u vw = __builtin_bit_cast(v4u, Vf); v4u w; w.x = pk2(ut[0], ut[1]); w.y = pk2(ut[2], ut[3]); w.z = vw.x; w.w = vw.y; UV = __builtin_bit_cast(bf16x8, w); }
#pragma unroll
            for (int jb = 0; jb < 4; ++jb) {
                const int tro = (4 * fq + tq) * RST + (16 * jb + 4 * tp) * 2;
                const v2u bt = __builtin_bit_cast(v2u, __builtin_amdgcn_ds_read_tr16_b64_v4i16((LAS v4i16_t*)(RB + tro))), kt = __builtin_bit_cast(v2u, __builtin_amdgcn_ds_read_tr16_b64_v4i16((LAS v4i16_t*)(RK + tro)));
                const f32x4 gc = *(const LAS f32x4*)(GC + 16 * jb + 4 * fq);
                T[jb] = __builtin_amdgcn_mfma_f32_16x16x32_bf16(cat44(bt, kt), UV, T[jb], 0, 0, 0); T[jb] = T[jb] * gc;
            }
            ring_done(fl, s, lane);
            { const int row0 = scan_row16(c, 0, b, d), stp = d ? -1 : 1;
#pragma unroll
              for (int e = 0; e < 4; ++e) yout[(size_t)(row0 + stp * (4 * fq + e)) * 512 + fr] = (bf16)f2bf(y[e]); }
        }
        __builtin_amdgcn_s_setprio(0);
    }
}

constexpr int MST = 272, MIMG = 16 * MST;
constexpr int MB_NSLOT = 5;
constexpr int MB_SLOT = 21504;
__device__ __forceinline__ void mamba_block(Frame& F, int unit, const bf16* PM, const float* DT, const float* a_log, bf16* YMB) {
    const int d = unit & 1, h = (unit >> 1) & 7, b = unit >> 4, grp = h >> 2;
    const int lane = F.lane, fr = lane & 15, fq = lane >> 4, tq = (lane & 15) >> 2, tp = lane & 3;
    volatile LAS unsigned* fl = (volatile LAS unsigned*)(F.lds + RING_FLAGS);
    __syncthreads();
    if (F.tid < 16) fl[F.tid] = 0u;
    __syncthreads();
    if (F.wave >= 4) {
        const int p = F.wave - 4;
        const float a_neg = -__expf(a_log[d * 8 + h]);
        v4u rB[4], rC[4], rX[2]; float rdt;
#define MB_LOAD(c_) do { \
        _Pragma("unroll") for (int i = 0; i < 4; ++i) { const int t = (lane >> 4) + 4 * i; const bf16* src = PM + (size_t)scan_row16((c_), t, b, d) * 1024 + 512 + grp * 128 + (lane & 15) * 8; rB[i] = *(const GAS v4u*)src; rC[i] = *(const GAS v4u*)(src + 256); } \
        _Pragma("unroll") for (int i = 0; i < 2; ++i) { const int id = lane + 64 * i; rX[i] = *(const GAS v4u*)(PM + (size_t)scan_row16((c_), id >> 3, b, d) * 1024 + h * 64 + (id & 7) * 8); } \
        rdt = DT[(size_t)scan_row16((c_), lane & 15, b, d) * 16 + d * 8 + h]; } while (0)
        MB_LOAD(p);
        for (int c = p; c < NCH16; c += 4) {
            const int s = c % MB_NSLOT;
            LAS unsigned char* sb = F.lds + s * MB_SLOT;
            LAS unsigned char* BR = sb; LAS unsigned char* CR = sb + MIMG; LAS unsigned char* RT = sb + 2 * MIMG; LAS unsigned char* KH = sb + 3 * MIMG; LAS unsigned char* VX = sb + 4 * MIMG;
            LAS unsigned char* FRG = sb + 4 * MIMG + RIMG; LAS float* scal = (LAS float*)(sb + 4 * MIMG + RIMG + 1024);
            ring_wait_free(fl, s, c, MB_NSLOT);
            float cs = rdt * a_neg;
            cs += dpp_shr<1>(cs); cs += dpp_shr<2>(cs); cs += dpp_shr<4>(cs); cs += dpp_shr<8>(cs);
            const float cse = __int_as_float(__builtin_amdgcn_readlane(__float_as_int(cs), 15));
            if (lane < 16) { scal[16 + lane] = cs; scal[32 + lane] = __expf(cs); scal[48 + lane] = rdt; scal[64 + lane] = __expf(cse - cs); }
            if (lane == 0) scal[0] = __expf(cse);
            asm volatile("s_waitcnt lgkmcnt(0)" ::: "memory");
#pragma unroll
            for (int i = 0; i < 4; ++i) { const int t = (lane >> 4) + 4 * i; const float sk = scal[64 + t], sr = scal[32 + t]; const int o = t * MST + (lane & 15) * 16;
                *(LAS v4u*)(BR + o) = rB[i]; *(LAS v4u*)(CR + o) = rC[i]; *(LAS v4u*)(KH + o) = scale8(rB[i], sk); *(LAS v4u*)(RT + o) = scale8(rC[i], sr); }
#pragma unroll
            for (int i = 0; i < 2; ++i) { const int id = lane + 64 * i; const int t = id >> 3; *(LAS v4u*)(VX + t * RST + (id & 7) * 16) = scale8(rX[i], scal[48 + t]); }
            if (c + 4 < NCH16) MB_LOAD(c + 4);
            asm volatile("s_waitcnt lgkmcnt(0)" ::: "memory");
            f32x4 akr = {0.f, 0.f, 0.f, 0.f};
#pragma unroll
            for (int kb = 0; kb < 4; ++kb) akr = __builtin_amdgcn_mfma_f32_16x16x32_bf16(*(const LAS bf16x8*)(BR + fr * MST + kb * 64 + fq * 16), *(const LAS bf16x8*)(CR + fr * MST + kb * 64 + fq * 16), akr, 0, 0, 0);
            const float cst = scal[16 + fr]; const f32x4 css = *(const LAS f32x4*)(scal + 16 + 4 * fq);
#pragma unroll
            for (int e = 0; e < 4; ++e) akr[e] = (4 * fq + e <= fr) ? akr[e] * __expf(cst - css[e]) : 0.f;
            *(LAS bf16x8*)(FRG + lane * 16) = pack4z(akr);
            ring_set_full(fl, s, c, lane);
        }
#undef MB_LOAD
    } else {
        const int q = F.wave;
        __builtin_amdgcn_s_setprio(3);
        bf16* yout = YMB + (size_t)d * M_ALL * 512 + h * 64 + 16 * q;
        unsigned long long prof_wait = 0ull; (void)prof_wait;
        f32x4 T[8];
#pragma unroll
        for (int jb = 0; jb < 8; ++jb) T[jb] = (f32x4){0.f, 0.f, 0.f, 0.f};
        for (int c = 0; c < NCH16; ++c) {
            const int s = c % MB_NSLOT;
            LAS unsigned char* sb = F.lds + s * MB_SLOT;
            LAS unsigned char* RT = sb + 2 * MIMG; LAS unsigned char* KH = sb + 3 * MIMG; LAS unsigned char* VX = sb + 4 * MIMG;
            LAS unsigned char* FRG = sb + 4 * MIMG + RIMG; LAS float* scal = (LAS float*)(sb + 4 * MIMG + RIMG + 1024);
#ifdef PROF_MBWAIT
            const unsigned long long tw0_ = __builtin_amdgcn_s_memrealtime();
#endif
            ring_wait_full(fl, s, c);
#ifdef PROF_MBWAIT
            prof_wait += __builtin_amdgcn_s_memrealtime() - tw0_;
#endif
#ifdef PROF_MBSEG
            unsigned long long ts0_ = __builtin_amdgcn_s_memrealtime();
#endif
            const bf16x8 akrA = *(const LAS bf16x8*)(FRG + lane * 16); const float gC = scal[0];
            const bf16x8 Vf = tr4z(VX + (4 * fq + tq) * RST + (16 * q + 4 * tp) * 2);
            f32x4 ya = {0.f, 0.f, 0.f, 0.f}, yb = __builtin_amdgcn_mfma_f32_16x16x32_bf16(akrA, Vf, (f32x4){0.f, 0.f, 0.f, 0.f}, 0, 0, 0);
#pragma unroll
            for (int jp = 0; jp < 4; ++jp) {
                const LAS unsigned char* rp = RT + fr * MST + (32 * jp + 4 * fq) * 2;
                const bf16x8 ra = cat44(*(const LAS v2u*)rp, *(const LAS v2u*)(rp + 32)), tf = pack8(T[2 * jp], T[2 * jp + 1]);
                if (jp & 1) yb = __builtin_amdgcn_mfma_f32_16x16x32_bf16(ra, tf, yb, 0, 0, 0); else ya = __builtin_amdgcn_mfma_f32_16x16x32_bf16(ra, tf, ya, 0, 0, 0);
            }
            const f32x4 y = ya + yb;
#ifdef PROF_MBSEG
            asm volatile("" :: "v"(y)); { const unsigned long long t_ = __builtin_amdgcn_s_memrealtime(); if (PROF_MBSEG == 1) prof_wait += t_ - ts0_; ts0_ = t_; }
#endif
#ifdef MB_CONS2X
            { f32x4 yd = {0.f, 0.f, 0.f, 0.f};
#pragma unroll
              for (int jp = 0; jp < 4; ++jp) { const LAS unsigned char* rp = RT + fr * MST + (32 * jp + 4 * fq) * 2 + 8;
                  yd = __builtin_amdgcn_mfma_f32_16x16x32_bf16(cat44(*(const LAS v2u*)rp, *(const LAS v2u*)(rp + 32)), pack8(T[2 * jp] * 1.0001f, T[2 * jp + 1] * 1.0001f), yd, 0, 0, 0); }
              yd = __builtin_amdgcn_mfma_f32_16x16x32_bf16(akrA, Vf, yd, 0, 0, 0);
              asm volatile("" :: "v"(yd)); }
#endif
#pragma unroll
            for (int jb = 0; jb < 8; ++jb) T[jb] = __builtin_amdgcn_mfma_f32_16x16x32_bf16(tr4z(KH + (4 * fq + tq) * MST + (16 * jb + 4 * tp) * 2), Vf, T[jb] * gC, 0, 0, 0);
#ifdef PROF_MBSEG
            asm volatile("" :: "v"(T[0]), "v"(T[7])); { const unsigned long long t_ = __builtin_amdgcn_s_memrealtime(); if (PROF_MBSEG == 2) prof_wait += t_ - ts0_; ts0_ = t_; }
#endif
            ring_done(fl, s, lane);
#ifdef PROF_MBSEG
            { const unsigned long long t_ = __builtin_amdgcn_s_memrealtime(); if (PROF_MBSEG == 3) prof_wait += t_ - ts0_; ts0_ = t_; }
#endif
            { const int row0 = scan_row16(c, 0, b, d), stp = d ? -1 : 1;
#pragma unroll
              for (int e = 0; e < 4; ++e) yout[(size_t)(row0 + stp * (4 * fq + e)) * 512 + fr] = (bf16)f2bf(y[e]); }
#ifdef PROF_MBSEG
            { const unsigned long long t_ = __builtin_amdgcn_s_memrealtime(); if (PROF_MBSEG == 4) prof_wait += t_ - ts0_; ts0_ = t_; }
#endif
        }
#if defined(PROF_MBWAIT) || defined(PROF_MBSEG)
        if (F.bid == 128 && F.tid == 0) __hip_atomic_store(F.ctl + 2, __float_as_uint((float)prof_wait * 0.01f), RLX_AGENT);
#endif
        __builtin_amdgcn_s_setprio(0);
    }
}

struct FinIn { const float *gn_w, *gn_b, *mb_d, *mb_norm_w; };
__device__ __forceinline__ void finish_phase(Frame& F, const FinIn& P, const bf16* YRW, const bf16* YMB, const bf16* PR, const bf16* PM, const float* BONUS, const bf16* GATE, const bf16* ZG, bf16* A) {
    const int gw = F.bid * NWAVES + F.wave, NGW = F.G * NWAVES; const int c0 = F.lane * 8, head = F.lane >> 3;
    float gnw[8], gnb[8], nw[8];
#pragma unroll
    for (int i = 0; i < 8; ++i) { gnw[i] = P.gn_w[c0 + i]; gnb[i] = P.gn_b[c0 + i]; nw[i] = P.mb_norm_w[c0 + i]; }
    const float dd = P.mb_d[head];
    struct FinIn9 { v4u y0, y1, vv, gg, m0, m1, xx, zz; float bon; };
    FinIn9 cur, nxt;
#define FIN_FETCH(R_, g_) do { const size_t gs_ = (size_t)(g_); \
        R_.y0 = *(const GAS v4u*)(YRW + gs_ * 512 + c0); R_.y1 = *(const GAS v4u*)(YRW + (size_t)M_ALL * 512 + gs_ * 512 + c0); R_.vv = *(const GAS v4u*)(PR + gs_ * PRV + 512 + c0); R_.gg = *(const GAS v4u*)(GATE + gs_ * 512 + c0); \
        R_.m0 = *(const GAS v4u*)(YMB + gs_ * 512 + c0); R_.m1 = *(const GAS v4u*)(YMB + (size_t)M_ALL * 512 + gs_ * 512 + c0); R_.xx = *(const GAS v4u*)(PM + gs_ * 1024 + c0); R_.zz = *(const GAS v4u*)(ZG + gs_ * 512 + c0); \
        R_.bon = BONUS[gs_ * 8 + head]; } while (0)
    if (gw < M_ALL) FIN_FETCH(cur, gw);
    for (int g = gw; g < M_ALL; g += NGW) {
        const size_t gs = (size_t)g;
        if (g + NGW < M_ALL) FIN_FETCH(nxt, g + NGW);
        const v4u y0 = cur.y0, y1 = cur.y1, vv = cur.vv, gg = cur.gg, m0 = cur.m0, m1 = cur.m1, xx = cur.xx, zz = cur.zz; const float bon = cur.bon;
        cur = nxt;
        float y[8], vf[8], gf[8];
#pragma unroll
        for (int i = 0; i < 4; ++i) { y[2 * i] = bflo(y0[i]) + bflo(y1[i]); y[2 * i + 1] = bfhi(y0[i]) + bfhi(y1[i]); vf[2 * i] = bflo(vv[i]); vf[2 * i + 1] = bfhi(vv[i]); gf[2 * i] = bflo(gg[i]); gf[2 * i + 1] = bfhi(gg[i]); }
        float s = 0.f;
#pragma unroll
        for (int i = 0; i < 8; ++i) s += y[i];
        s = sum8(s);
        const float mu = s * (1.f / 64.f); float q = 0.f;
#pragma unroll
        for (int i = 0; i < 8; ++i) { y[i] -= mu; q += y[i] * y[i]; }
        q = sum8(q);
        const float rstd = rsqrtf(q * (1.f / 64.f) + 64e-5f);
        float o[8];
#pragma unroll
        for (int i = 0; i < 8; ++i) o[i] = ((y[i] * rstd) * gnw[i] + gnb[i] + bon * vf[i]) * gf[i];
        v4u w; w.x = pk2(o[0], o[1]); w.y = pk2(o[2], o[3]); w.z = pk2(o[4], o[5]); w.w = pk2(o[6], o[7]);
        *(GAS v4u*)(A + gs * 1024 + c0) = w;
        float ym[8]; float ss = 0.f;
#pragma unroll
        for (int i = 0; i < 4; ++i) {
            const float z0 = bflo(zz[i]), z1 = bfhi(zz[i]);
            ym[2 * i] = (bflo(m0[i]) + bflo(m1[i]) + dd * bflo(xx[i])) * (z0 * sigm(z0)); ym[2 * i + 1] = (bfhi(m0[i]) + bfhi(m1[i]) + dd * bfhi(xx[i])) * (z1 * sigm(z1));
            ss += ym[2 * i] * ym[2 * i] + ym[2 * i + 1] * ym[2 * i + 1];
        }
        ss = half_sum(ss, F.lane);
        const float rr = rsqrtf(ss * (1.f / 256.f) + 1e-6f);
        v4u w2; w2.x = pk2(ym[0] * rr * nw[0], ym[1] * rr * nw[1]); w2.y = pk2(ym[2] * rr * nw[2], ym[3] * rr * nw[3]); w2.z = pk2(ym[4] * rr * nw[4], ym[5] * rr * nw[5]); w2.w = pk2(ym[6] * rr * nw[6], ym[7] * rr * nw[7]);
        *(GAS v4u*)(A + gs * 1024 + 512 + c0) = w2;
    }
#undef FIN_FETCH
}

__device__ __forceinline__ bf16x8 tr2(const LAS unsigned char* p0, const LAS unsigned char* p1) {
    const s16x4 t0 = __builtin_bit_cast(s16x4, __builtin_amdgcn_ds_read_tr16_b64_v4i16((LAS v4i16_t*)p0));
    const s16x4 t1 = __builtin_bit_cast(s16x4, __builtin_amdgcn_ds_read_tr16_b64_v4i16((LAS v4i16_t*)p1));
    bf16x8 r; r[0] = t0[0]; r[1] = t0[1]; r[2] = t0[2]; r[3] = t0[3]; r[4] = t1[0]; r[5] = t1[1]; r[6] = t1[2]; r[7] = t1[3]; return r;
}
constexpr int KST = 144;
__device__ __forceinline__ void attn_phase(Frame& F, const bf16* Q, const bf16* K, const bf16* V, const float* rpb, bf16* O) {
    LAS unsigned char* ctxK = F.lds; LAS unsigned char* ctxV = F.lds + 36864; LAS unsigned char* vst = F.lds + 73728 + F.wave * 4608; LAS float* rp = (LAS float*)(F.lds + 110592);
    const int lane = F.lane, fr = lane & 15, fq = lane >> 4, tq = (lane & 15) >> 2, tp = lane & 3;
#ifndef ATT_REPS
#define ATT_REPS 1
#endif
    const int avcu = (F.G % 8 == 0) ? (F.bid % 8) * (F.G / 8) + F.bid / 8 : F.bid;
    for (int u_ = avcu; u_ < 256 * ATT_REPS; u_ += F.G) {
        const int u = u_ & 255; const int bh = u >> 1, half = u & 1, b = bh >> 4, h = bh & 15;
        __syncthreads();
        {
            const int key = F.tid >> 1, hf = F.tid & 1; const size_t src = (size_t)(b * CTXL + key) * D + h * 64 + hf * 32;
#pragma unroll
            for (int i = 0; i < 4; ++i) { *(LAS v4u*)(ctxK + key * KST + hf * 64 + 16 * i) = *(const GAS v4u*)(K + src + 8 * i); *(LAS v4u*)(ctxV + key * KST + hf * 64 + 16 * i) = *(const GAS v4u*)(V + src + 8 * i); }
            if (F.tid < 465) rp[F.tid] = rpb[h * 465 + F.tid] * 1.4426950408889634f;
        }
        __syncthreads();
        for (int it = 0; it < 8; ++it) {
            const int r = 2 * (half * 8 + it) + (F.wave >> 2), j = F.wave & 3;
            const int rs = min(max(r - 4, 0), 24); const int kb = (j == 0) ? 0 : (j == 1) ? 8 : (j == 2) ? 24 : 32;
            const int qc = 16 * j + fr, wsq = min(max(qc - 8, 0), 48);
            const unsigned latbase = (unsigned)(M_CTX + b * SEQ);
            bf16x8 qf[2];
            { const bf16* qp = Q + (unsigned)((latbase + r * 64 + qc) * D + h * 64 + 8 * fq); qf[0] = *(const GAS bf16x8*)qp; qf[1] = *(const GAS bf16x8*)(qp + 32); }
            const int cv = kb + 4 * fq - wsq, cc2 = kb + 4 * fq - qc + 15;
            f32x4 sl[8][2], sc[16];
            const unsigned koff = (unsigned)((latbase + rs * 64 + kb + fr) * D + h * 64 + 8 * fq);
            const unsigned voff = (unsigned)((latbase + rs * 64 + kb + (lane >> 1)) * D + h * 64 + (lane & 1) * 32);
            bf16x8 kc[4], kn[4];
#pragma unroll
            for (int x = 0; x < 4; ++x) kc[x] = *(const GAS bf16x8*)(K + koff + (x >> 1) * 16 * D + (x & 1) * 32);
#pragma unroll
            for (int i = 0; i < 8; ++i) {
                const int brow = (rs + i - r + 7) * 31;
                if (i < 7) {
#pragma unroll
                    for (int x = 0; x < 4; ++x) kn[x] = *(const GAS bf16x8*)(K + koff + (unsigned)((i + 1) * 64 * D) + (x >> 1) * 16 * D + (x & 1) * 32);
                }
#pragma unroll
                for (int blk = 0; blk < 2; ++blk) {
                    f32x4 s = {0.f, 0.f, 0.f, 0.f};
                    s = __builtin_amdgcn_mfma_f32_16x16x32_bf16(kc[2 * blk], qf[0], s, 0, 0, 0);
                    s = __builtin_amdgcn_mfma_f32_16x16x32_bf16(kc[2 * blk + 1], qf[1], s, 0, 0, 0);
#pragma unroll
                    for (int e = 0; e < 4; ++e) s[e] = ((unsigned)(cv + 16 * blk + e) < 16u) ? (s[e] + rp[brow + min(max(cc2 + 16 * blk + e, 0), 30)]) : -INFINITY;
                    sl[i][blk] = s;
                }
#pragma unroll
                for (int x = 0; x < 4; ++x) kc[x] = kn[x];
            }
#pragma unroll
            for (int cb = 0; cb < 16; ++cb) {
                const LAS unsigned char* kp = ctxK + (16 * cb + fr) * KST + fq * 16;
                const bf16x8 k0 = *(const LAS bf16x8*)kp, k1 = *(const LAS bf16x8*)(kp + 64);
                f32x4 s = {0.f, 0.f, 0.f, 0.f};
                s = __builtin_amdgcn_mfma_f32_16x16x32_bf16(k0, qf[0], s, 0, 0, 0);
                s = __builtin_amdgcn_mfma_f32_16x16x32_bf16(k1, qf[1], s, 0, 0, 0);
                sc[cb] = s;
            }
            v4u vr[4];
#pragma unroll
            for (int x = 0; x < 4; ++x) vr[x] = *(const GAS v4u*)(V + voff + 8 * x);
            float m = -INFINITY;
#pragma unroll
            for (int i = 0; i < 8; ++i)
#pragma unroll
                for (int blk = 0; blk < 2; ++blk)
#pragma unroll
                    for (int e = 0; e < 4; ++e) m = fmaxf(m, sl[i][blk][e]);
#pragma unroll
            for (int cb = 0; cb < 16; ++cb)
#pragma unroll
                for (int e = 0; e < 4; ++e) m = fmaxf(m, sc[cb][e]);
            m = fmaxf(m, __shfl_xor(m, 16)); m = fmaxf(m, __shfl_xor(m, 32));
            float l = 0.f;
#pragma unroll
            for (int i = 0; i < 8; ++i)
#pragma unroll
                for (int blk = 0; blk < 2; ++blk)
#pragma unroll
                    for (int e = 0; e < 4; ++e) { const float p = __builtin_amdgcn_exp2f(sl[i][blk][e] - m); sl[i][blk][e] = p; l += p; }
#pragma unroll
            for (int cb = 0; cb < 16; ++cb)
#pragma unroll
                for (int e = 0; e < 4; ++e) { const float p = __builtin_amdgcn_exp2f(sc[cb][e] - m); sc[cb][e] = p; l += p; }
            l += __shfl_xor(l, 16); l += __shfl_xor(l, 32);
            const float linv = __builtin_amdgcn_rcpf(l);
            f32x4 o[4];
#pragma unroll
            for (int db = 0; db < 4; ++db) o[db] = (f32x4){0.f, 0.f, 0.f, 0.f};
#pragma unroll
            for (int i = 0; i < 8; ++i) {
                { const int key = lane >> 1, hf = lane & 1;
#pragma unroll
                  for (int x = 0; x < 4; ++x) *(LAS v4u*)(vst + key * KST + hf * 64 + 16 * x) = vr[x]; }
                if (i < 7) {
#pragma unroll
                    for (int x = 0; x < 4; ++x) vr[x] = *(const GAS v4u*)(V + voff + (unsigned)((i + 1) * 64 * D) + 8 * x);
                }
                const bf16x8 pa = pack8(sl[i][0], sl[i][1]);
#pragma unroll
                for (int db = 0; db < 4; ++db) {
                    const LAS unsigned char* a0 = vst + (4 * fq + tq) * KST + (db * 16 + 4 * tp) * 2;
                    const bf16x8 vb = tr2(a0, a0 + 16 * KST);
                    o[db] = __builtin_amdgcn_mfma_f32_16x16x32_bf16(pa, vb, o[db], 0, 0, 0);
                }
            }
#pragma unroll
            for (int cc = 0; cc < 8; ++cc) {
                const bf16x8 pa = pack8(sc[2 * cc], sc[2 * cc + 1]);
#pragma unroll
                for (int db = 0; db < 4; ++db) {
                    const LAS unsigned char* a0 = ctxV + (32 * cc + 4 * fq + tq) * KST + (db * 16 + 4 * tp) * 2;
                    const bf16x8 vb = tr2(a0, a0 + 16 * KST);
                    o[db] = __builtin_amdgcn_mfma_f32_16x16x32_bf16(pa, vb, o[db], 0, 0, 0);
                }
            }
#pragma unroll
            for (int e = 0; e < 4; ++e) {
                const float li = __shfl(linv, 4 * fq + e);
                bf16* op = O + (unsigned)((b * SEQ + r * 64 + 16 * j + 4 * fq + e) * D + h * 64 + fr);
#pragma unroll
                for (int db = 0; db < 4; ++db) op[db * 16] = (bf16)f2bf(o[db][e] * li);
            }
        }
    }
}

__device__ __forceinline__ void router_phase(Frame& F, const float* hlat, const float* g, const float* mods_l, const float* router_w, const float* router_b, bf16* A4, unsigned* tokinfo, gu32* cntb) {
    LAS int* se = (LAS int*)F.lds;
    LAS float* sg = (LAS float*)(F.lds + 512);
    LAS int* srow = (LAS int*)(F.lds + 1024);
    LAS unsigned* spos = (LAS unsigned*)(F.lds + 1280);
    const int gw = F.bid * NWAVES + F.wave, NGW = F.G * NWAVES;
    const int nbatch = (M_LAT + NGW * 8 - 1) / (NGW * 8);
    LAS float* srw = (LAS float*)(F.lds + 2048);
    __syncthreads();
    for (int i = F.tid; i < 2048; i += NTHR) ((LAS f32x4*)srw)[i] = ((const GAS f32x4*)router_w)[i];
    f32x4 gg[4];
#pragma unroll
    for (int j = 0; j < 4; ++j) gg[j] = ((const GAS f32x4*)g)[F.lane + 64 * j];
    RowIn cur, nxt;
#define RT_FETCH(R_, r_) do { const float* mp_ = mods_l + ((r_) >> 11) * 6144; row_fetch(R_, hlat + (size_t)(r_) * D, mp_ + 3072, mp_ + 4096, F.lane); } while (0)
    if (gw < M_LAT) RT_FETCH(cur, gw);
    for (int bt = 0; bt < nbatch; ++bt) {
        __syncthreads();
#pragma unroll 1
        for (int k = 0; k < 8; ++k) {
            const int r = gw + (bt * 8 + k) * NGW, slot = F.wave * 8 + k;
            if (r >= M_LAT) { if (F.lane == 0) { se[2 * slot] = -1; se[2 * slot + 1] = -1; srow[slot] = 0; } continue; }
            if (r + NGW < M_LAT) RT_FETCH(nxt, r + NGW);
            f32x4 a[4]; row_finish(cur, gg, A4 + (size_t)r * D, F.lane, a);
            cur = nxt;
            float lg[8];
#pragma unroll
            for (int e = 0; e < 8; ++e) lg[e] = 0.f;
#pragma unroll
            for (int j = 0; j < 4; ++j)
#pragma unroll
                for (int x = 0; x < 4; ++x) { const LAS float* rw = srw + ((F.lane + 64 * j) * 4 + x) * 8; const f32x4 w0 = *(const LAS f32x4*)rw, w1 = *(const LAS f32x4*)(rw + 4); const float av = a[j][x];
#pragma unroll
                    for (int e = 0; e < 4; ++e) { lg[e] += av * w0[e]; lg[4 + e] += av * w1[e]; } }
#pragma unroll
            for (int e = 0; e < 8; ++e) lg[e] = wave_sum(lg[e]) + router_b[e];
            int e0 = 0; float v0 = lg[0];
#pragma unroll
            for (int e = 1; e < 8; ++e) if (lg[e] > v0) { v0 = lg[e]; e0 = e; }
            int e1 = -1; float v1 = -INFINITY;
#pragma unroll
            for (int e = 0; e < 8; ++e) if (e != e0 && lg[e] > v1) { v1 = lg[e]; e1 = e; }
            const float g0 = 1.f / (1.f + __expf(v1 - v0)), g1 = 1.f - g0;
            if (F.lane == 0) { se[2 * slot] = e0; se[2 * slot + 1] = e1; sg[2 * slot] = g0; sg[2 * slot + 1] = g1; srow[slot] = r; }
        }
        __syncthreads();
        if (F.wave == 0) {
            const int l = F.lane; const int ea = se[l], eb = se[64 + l];
            const unsigned long long below = (l == 0) ? 0ull : (~0ull >> (64 - l));
            unsigned ra = 0u, rb = 0u, tot = 0u;
#pragma unroll
            for (int e = 0; e < 8; ++e) {
                const unsigned long long ma = __ballot(ea == e), mb = __ballot(eb == e);
                const unsigned ca = (unsigned)__popcll(ma), cb = (unsigned)__popcll(mb);
                if (ea == e) ra = (unsigned)__popcll(ma & below);
                if (eb == e) rb = ca + (unsigned)__popcll(mb & below);
                if (l == e) tot = ca + cb;
            }
            if (l < 8) cntb[(size_t)(bt * F.G + F.bid) * 8 + l] = tot;
            spos[l] = ra; spos[64 + l] = rb;
            asm volatile("s_waitcnt lgkmcnt(0)" ::: "memory");
            if (se[2 * l] >= 0) {
                v4u t0; t0.x = (unsigned)se[2 * l]; t0.y = spos[2 * l]; t0.z = __float_as_uint(sg[2 * l]); t0.w = (unsigned)se[2 * l + 1];
                v4u t1; t1.x = spos[2 * l + 1]; t1.y = __float_as_uint(sg[2 * l + 1]); t1.z = 0u; t1.w = 0u;
                const size_t row = (size_t)srow[l];
                *(GAS v4u*)(tokinfo + row * 8) = t0; *(GAS v4u*)(tokinfo + row * 8 + 4) = t1;
            }
        }
    }
}
#undef RT_FETCH
__device__ __forceinline__ void moe_bases(gu32* cnt, int (&tb)[9]) {
    int acc = 0;
#pragma unroll
    for (int e = 0; e < 8; ++e) { tb[e] = acc; const unsigned c = __hip_atomic_load(cnt + 64 * e, RLX_AGENT); acc += (int)((c + 255u) >> 8); }
    tb[8] = acc;
}
#ifndef MOE_TAIL_SPLIT
#define MOE_TAIL_SPLIT 1
#endif
__device__ __forceinline__ void moe_tail_split(const int (&tb)[9], int G, int& first, int& ntail) {
    const int U = tb[8] * 4; first = (U / G) * G; ntail = U - first;
    if (first == 0 || (first & 3) || ntail > 32) { first = U; ntail = 0; }
#if !MOE_TAIL_SPLIT
    first = U; ntail = 0;
#endif
}
__device__ __forceinline__ void gather_phase(Frame& F, const bf16* A4, unsigned* tokinfo, gu32* cnt, const gu32* cntb, bf16* XG) {
    const int gw = F.bid * NWAVES + F.wave, NGW = F.G * NWAVES;
    const int nbatch = (M_LAT + NGW * 8 - 1) / (NGW * 8), nent = nbatch * F.G;
    LAS float* sred = (LAS float*)F.lds;
    __syncthreads();
    if (F.wave == 0) {
        float tot[8];
#pragma unroll
        for (int e = 0; e < 8; ++e) tot[e] = 0.f;
        for (int i = F.lane; i < nent; i += 64) { const v4u a = *(const GAS v4u*)(cntb + (size_t)i * 8), b = *(const GAS v4u*)(cntb + (size_t)i * 8 + 4);
            tot[0] += (float)a.x; tot[1] += (float)a.y; tot[2] += (float)a.z; tot[3] += (float)a.w; tot[4] += (float)b.x; tot[5] += (float)b.y; tot[6] += (float)b.z; tot[7] += (float)b.w; }
#pragma unroll
        for (int e = 0; e < 8; ++e) { const float s = wave_sum(tot[e]); if (F.lane == 0) sred[e] = s; }
        for (int bt = 0; bt < nbatch; ++bt) {
            const int mine = bt * F.G + F.bid; float pre[8];
#pragma unroll
            for (int e = 0; e < 8; ++e) pre[e] = 0.f;
            for (int i = F.lane; i < mine; i += 64) { const v4u a = *(const GAS v4u*)(cntb + (size_t)i * 8), b = *(const GAS v4u*)(cntb + (size_t)i * 8 + 4);
                pre[0] += (float)a.x; pre[1] += (float)a.y; pre[2] += (float)a.z; pre[3] += (float)a.w; pre[4] += (float)b.x; pre[5] += (float)b.y; pre[6] += (float)b.z; pre[7] += (float)b.w; }
#pragma unroll
            for (int e = 0; e < 8; ++e) { const float s = wave_sum(pre[e]); if (F.lane == 0) sred[8 + 8 * bt + e] = s; }
        }
    }
    __syncthreads();
    int tb[9]; { int acc = 0;
#pragma unroll
        for (int e = 0; e < 8; ++e) { tb[e] = acc; const unsigned c = (unsigned)sred[e]; acc += (int)((c + 255u) >> 8); if (F.bid == 0 && F.tid == 0) __hip_atomic_store(cnt + 64 * e, c, RLX_AGENT); }
        tb[8] = acc; }
    struct GIn { v4u t0, t1, x0, x1; };
    GIn cur, nxt;
#define G_FETCH(R_, r_) do { R_.t0 = *(const GAS v4u*)(tokinfo + (size_t)(r_) * 8); R_.t1 = *(const GAS v4u*)(tokinfo + (size_t)(r_) * 8 + 4); \
        const GAS v4u* s_ = (const GAS v4u*)(A4 + (size_t)(r_) * D); R_.x0 = s_[F.lane]; R_.x1 = s_[F.lane + 64]; } while (0)
    if (gw < M_LAT) G_FETCH(cur, gw);
    int k = 0;
    for (int r = gw; r < M_LAT; r += NGW, ++k) {
        if (r + NGW < M_LAT) G_FETCH(nxt, r + NGW);
        const v4u t0 = cur.t0, t1 = cur.t1, x0 = cur.x0, x1 = cur.x1; cur = nxt;
        const LAS float* pre = sred + 8 + 8 * (k >> 3);
        int tbe0 = 0, tbe1 = 0; unsigned pr0 = 0u, pr1 = 0u;
#pragma unroll
        for (int e = 0; e < 8; ++e) { if ((int)t0.x == e) { tbe0 = tb[e]; pr0 = (unsigned)pre[e]; } if ((int)t0.w == e) { tbe1 = tb[e]; pr1 = (unsigned)pre[e]; } }
        const unsigned row0 = (unsigned)tbe0 * 256u + pr0 + t0.y, row1 = (unsigned)tbe1 * 256u + pr1 + t1.x;
        GAS v4u* d0 = (GAS v4u*)(XG + (size_t)row0 * D); GAS v4u* d1 = (GAS v4u*)(XG + (size_t)row1 * D);
        d0[F.lane] = x0; d0[F.lane + 64] = x1; d1[F.lane] = x0; d1[F.lane + 64] = x1;
        if (F.lane == 0) { tokinfo[(size_t)r * 8 + 6] = row0; tokinfo[(size_t)r * 8 + 7] = row1; }
    }
#undef G_FETCH
}
__device__ __forceinline__ f32x4 moe_y4(const bf16* YG, const float* slab, unsigned row, int j, int lane, unsigned tailrow0, int first, int ntail) {
    if (row < tailrow0) { const v2u a = ((const GAS v2u*)(YG + (size_t)row * D) + lane)[64 * j]; return (f32x4){bflo(a.x), bfhi(a.x), bflo(a.y), bfhi(a.y)}; }
    const size_t kstride = (size_t)(ntail >> 2) * 256 * 1024; const float* p = slab + (size_t)(row - tailrow0) * 1024 + (lane + 64 * j) * 4; f32x4 s = {0.f, 0.f, 0.f, 0.f};
    for (int ks = 0; ks < 11; ++ks) s += *(const GAS f32x4*)(p + ks * kstride);
    const unsigned w0 = pk2(s[0], s[1]), w1 = pk2(s[2], s[3]);
    return (f32x4){bflo(w0), bfhi(w0), bflo(w1), bfhi(w1)};
}
__device__ __forceinline__ void final_phase(Frame& F, float* hout, const bf16* YG, const unsigned* tokinfo, const float* mods_l, const float* norm_final, const float* slab, gu32* cnt) {
    const int gw = F.bid * NWAVES + F.wave, NGW = F.G * NWAVES;
    int tb[9]; moe_bases(cnt, tb); int first, ntail; moe_tail_split(tb, F.G, first, ntail); const unsigned tailrow0 = (unsigned)(first >> 2) * 256u;
#if defined(PROF_PH) || defined(PROF_SCANWAIT) || defined(PROF_MBWAIT) || defined(PROF_MBSEG)
    const float prof_scale = 1.f + sqrtf(__uint_as_float(__hip_atomic_load(F.ctl + 2, RLX_AGENT)) * 1e-5f);
#else
    const float prof_scale = 1.f;
#endif
    for (int r = gw; r < M_LAT; r += NGW) {
        const v4u t0 = *(const GAS v4u*)(tokinfo + (size_t)r * 8), t1 = *(const GAS v4u*)(tokinfo + (size_t)r * 8 + 4);
        const float g0 = __uint_as_float(t0.z), g1 = __uint_as_float(t1.y); const unsigned row0 = t1.z, row1 = t1.w;
        const float* mp = mods_l + (r >> 11) * 6144 + 5120;
        GAS f32x4* hr = (GAS f32x4*)(hout + (size_t)r * D) + F.lane;
        f32x4 v[4]; float ss = 0.f;
#pragma unroll
        for (int j = 0; j < 4; ++j) {
            const f32x4 hh = hr[64 * j], mm = ((const GAS f32x4*)mp)[F.lane + 64 * j];
            const f32x4 ya = moe_y4(YG, slab, row0, j, F.lane, tailrow0, first, ntail), yb = moe_y4(YG, slab, row1, j, F.lane, tailrow0, first, ntail);
            v[j] = hh + mm * (ya * g0 + yb * g1);
            ss += (v[j].x * v[j].x + v[j].y * v[j].y) + (v[j].z * v[j].z + v[j].w * v[j].w);
        }
        const float rs = rsqrtf(wave_sum(ss) * (1.f / 1024.f) + 1e-6f);
#pragma unroll
        for (int j = 0; j < 4; ++j) { const f32x4 gg = ((const GAS f32x4*)norm_final)[F.lane + 64 * j]; hr[64 * j] = (v[j] * (rs * prof_scale)) * gg; }
    }
}

constexpr int NPHASE = 19;
#ifndef MK_PER_PHASE
#define MK_PER_PHASE 0
#endif
__device__ __forceinline__ int fresh_lane() { int l; asm volatile("v_mbcnt_lo_u32_b32 %0, -1, 0\n\tv_mbcnt_hi_u32_b32 %0, -1, %0" : "=v"(l)); return l; }
struct Args { const float* in[39]; float* out; unsigned char* ws; int ph_lo, ph_hi; };
#define KARGP(k) (((void* const __attribute__((address_space(4)))*)__builtin_amdgcn_kernarg_segment_ptr())[k])
#define KARG(k) ((const float*)KARGP(k))
__global__ void __launch_bounds__(NWAVES * 64, 2) mk_fwd(Args args) {
    extern __shared__ __attribute__((aligned(16))) unsigned char lds[];
    Frame F;
    F.lds = (LAS unsigned char*)lds; F.MISC = (volatile LAS unsigned*)(F.lds + MISC_OFF);
    F.tid = threadIdx.x; F.lane = F.tid & 63; F.wave = __builtin_amdgcn_readfirstlane(F.tid >> 6); F.G = gridDim.x; F.bid = blockIdx.x;
    unsigned char* ws = (unsigned char*)KARGP(40); F.ctl = (gu32*)(ws + WS_CTL);
    for (int u = F.tid; u < (LDS_BYTES - LDSCTL_OFF) / 4; u += NWAVES * 64) ((LAS unsigned*)(F.lds + LDSCTL_OFF))[u] = 0u;
    __syncthreads();
    const int lo = args.ph_lo, hi = args.ph_hi;
    unsigned long long prof_t0 = 0ull; (void)prof_t0;
    XcdBarrier bar; bar.bar = (unsigned*)(F.ctl + CW_BAR); bar.x = 0; bar.st = nullptr;
    if (hi - lo > 1) bar = xcd_barrier_post((unsigned*)(F.ctl + CW_BAR), F.MISC + 8);
#ifdef PH_MASK
#define IN(k) ((((PH_MASK) >> (k)) & 1) && lo <= (k) && (k) < hi)
#else
#define IN(k) (lo <= (k) && (k) < hi)
#endif
#ifndef DUP_MASK
#define DUP_MASK 0
#endif
#ifdef PROF_PH
#define PROF_T0(k) do { if ((k) == PROF_PH && F.bid == 0 && F.tid == 0) prof_t0 = __builtin_amdgcn_s_memrealtime(); } while (0)
#define PROF_T1(k) do { if ((k) == PROF_PH && F.bid == 0 && F.tid == 0) { const unsigned long long t1_ = __builtin_amdgcn_s_memrealtime(); __hip_atomic_store(F.ctl + 2, __float_as_uint((float)(t1_ - prof_t0) * 0.01f), RLX_AGENT); } } while (0)
#else
#define PROF_T0(k) do {} while (0)
#define PROF_T1(k) do {} while (0)
#endif
#define REPS(k) (1 + (((DUP_MASK) >> (k)) & 1))
#ifdef DOUBLE_BAR
#define SEAM(k) do { if (IN(k) && IN((k) + 1)) { xcd_barrier(bar); xcd_barrier(bar); } } while (0)
#else
#define SEAM(k) do { if (IN(k) && IN((k) + 1)) xcd_barrier(bar); } while (0)
#endif
    const float* x = KARG(0); const float* ctx = KARG(2);
    float* mods = (float*)(ws + WS_MODS); float* hctx = (float*)(ws + WS_HCTX); float* hlat = (float*)KARGP(39);
    bf16* A = (bf16*)(ws + WS_A);
    const int vcu = (F.G % 8 == 0) ? (F.bid % 8) * (F.G / 8) + F.bid / 8 : F.bid;

    PROF_T0(0); if (IN(0)) for (int rep_ = 0; rep_ < REPS(0); ++rep_) { if (rep_) __syncthreads(); F.lane = fresh_lane(); F.tid = F.wave * 64 + F.lane; p0_phase(F, KARG(1), KARG(3), KARG(4), KARG(5), mods, KARG(9), KARG(10), KARG(28), KARG(29), KARG(30), KARG(31), KARG(32), ws); }
    SEAM(0); PROF_T1(0);
    PROF_T0(1); if (IN(1)) for (int rep_ = 0; rep_ < REPS(1); ++rep_) { if (rep_) __syncthreads(); F.lane = fresh_lane(); F.tid = F.wave * 64 + F.lane; normmod_phase(F, ctx, x, KARG(6), mods, 0, 1024, A); }
    SEAM(1); PROF_T1(1);
    PROF_T0(2); if (IN(2)) for (int rep_ = 0; rep_ < REPS(2); ++rep_) { if (rep_) __syncthreads(); F.lane = fresh_lane(); F.tid = F.wave * 64 + F.lane;
        pg8::Gemm g{A, (const bf16*)(ws + WS_WIN_T), M_ALL, ZLD, D}; pg8::StaticOrder S; S.init(M_ALL, ZLD, F.G, F.bid);
        pg8::EpiBf16<0> E{(bf16*)(ws + WS_Z), ZLD, nullptr, 0, 0, 1.f};
        pg8::gemm_phase<pg8::EpiBf16<0>, pg8::StaticOrder, true, true>(F.lds, g, S, E);
    }
    SEAM(2); PROF_T1(2);
    PROF_T0(3); if (IN(3)) for (int rep_ = 0; rep_ < REPS(3); ++rep_) { if (rep_) __syncthreads(); F.lane = fresh_lane(); F.tid = F.wave * 64 + F.lane;
        PrepIn P{KARG(11), KARG(12), KARG(13), KARG(14), KARG(15), KARG(16), KARG(17), KARG(18), KARG(19), KARG(22), KARG(23), KARG(24)};
        prepare_phase(F, P, (const bf16*)(ws + WS_Z), (bf16*)(ws + WS_PR), (bf16*)(ws + WS_PM), (float*)(ws + WS_DT), (float*)(ws + WS_BONUS), (bf16*)(ws + WS_GATE), (bf16*)(ws + WS_ZG));
    }
    SEAM(3); PROF_T1(3);
    PROF_T0(4); if (IN(4)) for (int rep_ = 0; rep_ < REPS(4); ++rep_) { if (rep_) __syncthreads(); F.lane = fresh_lane(); F.tid = F.wave * 64 + F.lane;
        for (int u = F.bid; u < 256; u += F.G) {
            if (u < 128) { rwkv_block(F, u, (const bf16*)(ws + WS_PR), (bf16*)(ws + WS_YRW));
#ifdef RWKV2X
                rwkv_block(F, u, (const bf16*)(ws + WS_PR), (bf16*)(ws + WS_YRW));
#endif
            }
            else { mamba_block(F, u - 128, (const bf16*)(ws + WS_PM), (const float*)(ws + WS_DT), KARG(25), (bf16*)(ws + WS_YMB));
#ifdef MAMBA2X
                   mamba_block(F, u - 128, (const bf16*)(ws + WS_PM), (const float*)(ws + WS_DT), KARG(25), (bf16*)(ws + WS_YMB));
#endif
            }
        }
    }
    SEAM(4); PROF_T1(4);
    PROF_T0(5); if (IN(5)) for (int rep_ = 0; rep_ < REPS(5); ++rep_) { if (rep_) __syncthreads(); F.lane = fresh_lane(); F.tid = F.wave * 64 + F.lane;
        FinIn P{KARG(20), KARG(21), KARG(26), KARG(27)};
        finish_phase(F, P, (const bf16*)(ws + WS_YRW), (const bf16*)(ws + WS_YMB), (const bf16*)(ws + WS_PR), (const bf16*)(ws + WS_PM), (const float*)(ws + WS_BONUS), (const bf16*)(ws + WS_GATE), (const bf16*)(ws + WS_ZG), A);
    }
    SEAM(5); PROF_T1(5);
    PROF_T0(6); if (IN(6)) for (int rep_ = 0; rep_ < REPS(6); ++rep_) { if (rep_) __syncthreads(); F.lane = fresh_lane(); F.tid = F.wave * 64 + F.lane;
        {
            pg8::Gemm g{A + (size_t)M_CTX * D, (const bf16*)(ws + WS_WOUT_T), M_LAT, D, D}; pg8::StaticOrder S; S.init(M_LAT, D, F.G, F.bid);
            pg8::EpiResGate E{x, x, hlat, hlat, mods, 2048, 0};
            pg8::gemm_phase<pg8::EpiResGate, pg8::StaticOrder, true, true>(F.lds, g, S, E);
        }
        {
            pg8::Gemm g{A, (const bf16*)(ws + WS_WOUT_T), M_CTX, D, 256, D}; pg8::SplitKOrder S{8, 4, 4, 256, F.G, F.bid};
            pg8::EpiSlabGate E{(float*)(ws + WS_SLAB6), mods + 8 * 6144 + 2048, 256};
            pg8::gemm_phase<pg8::EpiSlabGate, pg8::SplitKOrder, true, true>(F.lds, g, S, E);
        }
        { const int nsub = 8 * 4 * 4; if (F.G > nsub && F.bid >= nsub) moe_weight_phase(F, KARG(36), KARG(37), KARG(38), ws, 0, MOE_ITEMS_P6, F.bid - nsub, F.G - nsub);
          else if (F.G <= nsub) moe_weight_phase(F, KARG(36), KARG(37), KARG(38), ws, 0, MOE_ITEMS_P6, F.bid, F.G); }
    }
    SEAM(6); PROF_T1(6);
    PROF_T0(7); if (IN(7)) for (int rep_ = 0; rep_ < REPS(7); ++rep_) { if (rep_) __syncthreads(); F.lane = fresh_lane(); F.tid = F.wave * 64 + F.lane; normmod_phase(F, ctx, hlat, KARG(7), mods, 3072, 4096, A, (const float*)(ws + WS_SLAB6), 4, hctx); moe_weight_phase(F, KARG(36), KARG(37), KARG(38), ws, MOE_ITEMS_P6, MOE_ITEMS_P7, F.bid, F.G); }
    SEAM(7); PROF_T1(7);
    PROF_T0(8); if (IN(8)) for (int rep_ = 0; rep_ < REPS(8); ++rep_) { if (rep_) __syncthreads(); F.lane = fresh_lane(); F.tid = F.wave * 64 + F.lane;
        pg8::Gemm g{A, (const bf16*)(ws + WS_W13_T), M_ALL, 2 * FF, D}; pg8::StaticOrder S; S.init(M_ALL, 2 * FF, F.G, F.bid);
        pg8::EpiSwiGLU E{(bf16*)(ws + WS_HID), FF, 1 << 20};
        pg8::gemm_phase<pg8::EpiSwiGLU, pg8::StaticOrder, true, true>(F.lds, g, S, E);
        {
            const int nfull = ((M_ALL / 256) * (2 * FF / 256)) % F.G;
            if (nfull != 0 && F.bid >= nfull) moe_weight_phase(F, KARG(36), KARG(37), KARG(38), ws, MOE_ITEMS_P7, MOE_ITEMS_P7 + MOE_ITEMS_P8, F.bid - nfull, F.G - nfull);
            else if (nfull == 0) moe_weight_phase(F, KARG(36), KARG(37), KARG(38), ws, MOE_ITEMS_P7, MOE_ITEMS_P7 + MOE_ITEMS_P8, F.bid, F.G);
        }
    }
    SEAM(8); PROF_T1(8);
    PROF_T0(9); if (IN(9)) for (int rep_ = 0; rep_ < REPS(9); ++rep_) { if (rep_) __syncthreads(); F.lane = fresh_lane(); F.tid = F.wave * 64 + F.lane;
        {
            pg8::Gemm g{(const bf16*)(ws + WS_HID) + (size_t)M_CTX * FF, (const bf16*)(ws + WS_W2_T), M_LAT, D, FF}; pg8::StaticOrder S; S.init(M_LAT, D, F.G, F.bid);
            pg8::EpiResGate E{hlat, hlat, hlat, hlat, mods, 5120, 0};
            pg8::gemm_phase<pg8::EpiResGate, pg8::StaticOrder, true, true>(F.lds, g, S, E);
        }
        {
            pg8::Gemm g{(const bf16*)(ws + WS_HID), (const bf16*)(ws + WS_W2_T), M_CTX, D, 1408, FF}; pg8::SplitKOrder S{8, 4, 2, 1408, F.G, F.bid};
            pg8::EpiSlabGate E{(float*)(ws + WS_SLAB9), mods + 8 * 6144 + 5120, 1408};
            pg8::gemm_phase<pg8::EpiSlabGate, pg8::SplitKOrder, true, true>(F.lds, g, S, E);
        }
        {
            const int nsub = 8 * 4 * 2;
            if (F.G > nsub) { if (F.bid >= nsub) moe_weight_phase(F, KARG(36), KARG(37), KARG(38), ws, MOE_ITEMS_P7 + MOE_ITEMS_P8, MOE_ITEMS_P7 + MOE_ITEMS_P8 + MOE_ITEMS_P9, F.bid - nsub, F.G - nsub); }
            else moe_weight_phase(F, KARG(36), KARG(37), KARG(38), ws, MOE_ITEMS_P7 + MOE_ITEMS_P8, MOE_ITEMS_P7 + MOE_ITEMS_P8 + MOE_ITEMS_P9, F.bid, F.G);
        }
    }
    SEAM(9); PROF_T1(9);
    const float* mods1 = mods + 9 * 6144;
    PROF_T0(10); if (IN(10)) for (int rep_ = 0; rep_ < REPS(10); ++rep_) { if (rep_) __syncthreads(); F.lane = fresh_lane(); F.tid = F.wave * 64 + F.lane; normmod_phase(F, hctx, hlat, KARG(6) + D, mods1, 0, 1024, A, (const float*)(ws + WS_SLAB9), 2); }
    SEAM(10); PROF_T1(10);
    PROF_T0(11); if (IN(11)) for (int rep_ = 0; rep_ < REPS(11); ++rep_) { if (rep_) __syncthreads(); F.lane = fresh_lane(); F.tid = F.wave * 64 + F.lane;
        pg8::Gemm g{A, (const bf16*)(ws + WS_QKV_T), M_ALL, 3 * D, D}; pg8::StaticOrder S; S.init(M_ALL, 3 * D, F.G, F.bid);
        pg8::EpiBf16<0> E{(bf16*)(ws + WS_Q), D, nullptr, D, (size_t)M_ALL * D, 0.125f * 1.4426950408889634f};
        pg8::gemm_phase<pg8::EpiBf16<0>, pg8::StaticOrder, true, true>(F.lds, g, S, E);
        {
            const int nfull = ((M_ALL / 256) * (3 * D / 256)) % F.G;
            if (nfull != 0 && F.bid >= nfull) moe_weight_phase(F, KARG(36), KARG(37), KARG(38), ws, MOE_ITEMS - MOE_ITEMS_P16 - MOE_ITEMS_P11, MOE_ITEMS - MOE_ITEMS_P16, F.bid - nfull, F.G - nfull);
            else if (nfull == 0) moe_weight_phase(F, KARG(36), KARG(37), KARG(38), ws, MOE_ITEMS - MOE_ITEMS_P16 - MOE_ITEMS_P11, MOE_ITEMS - MOE_ITEMS_P16, F.bid, F.G);
        }
    }
    SEAM(11); PROF_T1(11);
    PROF_T0(12); if (IN(12)) for (int rep_ = 0; rep_ < REPS(12); ++rep_) { if (rep_) __syncthreads(); F.lane = fresh_lane(); F.tid = F.wave * 64 + F.lane; attn_phase(F, (const bf16*)(ws + WS_Q), (const bf16*)(ws + WS_K), (const bf16*)(ws + WS_V), KARG(33), (bf16*)(ws + WS_O)); }
    SEAM(12); PROF_T1(12);
    PROF_T0(13); if (IN(13)) for (int rep_ = 0; rep_ < REPS(13); ++rep_) { if (rep_) __syncthreads(); F.lane = fresh_lane(); F.tid = F.wave * 64 + F.lane;
        pg8::Gemm g{(const bf16*)(ws + WS_O), (const bf16*)(ws + WS_NAO_T), M_LAT, D, D}; pg8::StaticOrder S; S.init(M_LAT, D, F.G, F.bid);
        pg8::EpiResGate E{hlat, hlat, hlat, hlat, mods1, 2048, 0};
        pg8::gemm_phase<pg8::EpiResGate, pg8::StaticOrder, true, true>(F.lds, g, S, E);
    }
    SEAM(13); PROF_T1(13);
    PROF_T0(14); if (IN(14)) for (int rep_ = 0; rep_ < REPS(14); ++rep_) { if (rep_) __syncthreads(); F.lane = fresh_lane(); F.tid = F.wave * 64 + F.lane; router_phase(F, hlat, KARG(7) + D, mods1, KARG(34), KARG(35), (bf16*)(ws + WS_A4), (unsigned*)(ws + WS_TOK), F.ctl + CW_CNTB); }
    SEAM(14); PROF_T1(14);
    PROF_T0(15); if (IN(15)) for (int rep_ = 0; rep_ < REPS(15); ++rep_) { if (rep_) __syncthreads(); F.lane = fresh_lane(); F.tid = F.wave * 64 + F.lane; gather_phase(F, (const bf16*)(ws + WS_A4), (unsigned*)(ws + WS_TOK), F.ctl + CW_CNT, F.ctl + CW_CNTB, (bf16*)(ws + WS_XG)); }
    SEAM(15); PROF_T1(15);
    PROF_T0(16); if (IN(16)) for (int rep_ = 0; rep_ < REPS(16); ++rep_) { if (rep_) __syncthreads(); F.lane = fresh_lane(); F.tid = F.wave * 64 + F.lane;
        pg8::MoeOrder S; moe_bases(F.ctl + CW_CNT, S.tb); S.ntn = 22; S.G = F.G; S.c = vcu;
        pg8::Gemm g{(const bf16*)(ws + WS_XG), (const bf16*)(ws + WS_MOEW13), MOE_ROWS, NE * 2 * FF, D};
        pg8::EpiSwiGLU E{(bf16*)(ws + WS_HIDG), FF, 22};
        pg8::gemm_phase<pg8::EpiSwiGLU, pg8::MoeOrder, true, true>(F.lds, g, S, E);
        {
            const int nlast = (S.tb[8] * 22) % F.G;
            if (nlast != 0 && vcu >= nlast) moe_weight_phase(F, KARG(36), KARG(37), KARG(38), ws, MOE_ITEMS - MOE_ITEMS_P16, MOE_ITEMS, vcu - nlast, F.G - nlast);
            else if (nlast == 0) moe_weight_phase(F, KARG(36), KARG(37), KARG(38), ws, MOE_ITEMS - MOE_ITEMS_P16, MOE_ITEMS, F.bid, F.G);
        }
    }
    SEAM(16); PROF_T1(16);
    PROF_T0(17); if (IN(17)) for (int rep_ = 0; rep_ < REPS(17); ++rep_) { if (rep_) __syncthreads(); F.lane = fresh_lane(); F.tid = F.wave * 64 + F.lane;
        pg8::MoeOrder S; moe_bases(F.ctl + CW_CNT, S.tb); S.ntn = 4; S.G = F.G; S.c = vcu;
        int first, ntail; moe_tail_split(S.tb, F.G, first, ntail); S.limit = first;
        {
            pg8::Gemm g{(const bf16*)(ws + WS_HIDG), (const bf16*)(ws + WS_MOEW2), MOE_ROWS, NE * D, FF};
            pg8::EpiPlainMod E{(bf16*)(ws + WS_YG), D, 4};
            pg8::gemm_phase<pg8::EpiPlainMod, pg8::MoeOrder, true, true>(F.lds, g, S, E);
        }
#if MOE_TAIL_SPLIT
        if (ntail > 0) {
            pg8::MoeTailOrder ST;
#pragma unroll
            for (int k = 0; k < 9; ++k) ST.tb[k] = S.tb[k];
            ST.first = first; ST.ntail = ntail; ST.G = F.G; ST.c = vcu;
            pg8::Gemm g{(const bf16*)(ws + WS_HIDG), (const bf16*)(ws + WS_MOEW2), MOE_ROWS, NE * D, 256, FF};
            pg8::EpiTailSlab E{(float*)(ws + WS_TAIL), first, ntail};
            pg8::gemm_phase<pg8::EpiTailSlab, pg8::MoeTailOrder, true, true>(F.lds, g, ST, E);
        }
#endif
    }
    SEAM(17); PROF_T1(17);
    PROF_T0(18); if (IN(18)) for (int rep_ = 0; rep_ < REPS(18); ++rep_) { if (rep_) __syncthreads(); F.lane = fresh_lane(); F.tid = F.wave * 64 + F.lane; final_phase(F, hlat, (const bf16*)(ws + WS_YG), (const unsigned*)(ws + WS_TOK), mods1, KARG(8), (const float*)(ws + WS_TAIL), F.ctl + CW_CNT); }
#undef IN
#undef SEAM
}

extern "C" void kernel_launch(void* const* d_in, const int* in_sizes, int n_in, void* d_out, int out_size, void* d_ws, size_t ws_size, hipStream_t stream) {
    static int grid = 0;
    if (grid == 0) {
        if (n_in != 39 || out_size != M_LAT * D || ws_size < WS_END) { fprintf(stderr, "kernel_launch: unexpected shapes (n_in %d, out %d, ws %zu)\n", n_in, out_size, ws_size); grid = -1; return; }
        int dev = 0, cus = 0, per_cu = 0;
        if (hipGetDevice(&dev) != hipSuccess || hipDeviceGetAttribute(&cus, hipDeviceAttributeMultiprocessorCount, dev) != hipSuccess) { grid = -1; return; }
        if (hipFuncSetAttribute((const void*)mk_fwd, hipFuncAttributeMaxDynamicSharedMemorySize, LDS_BYTES) != hipSuccess) { fprintf(stderr, "kernel_launch: hipFuncSetAttribute failed\n"); grid = -1; return; }
        if (hipOccupancyMaxActiveBlocksPerMultiprocessor(&per_cu, (const void*)mk_fwd, NWAVES * 64, LDS_BYTES) != hipSuccess || per_cu < 1) fprintf(stderr, "kernel_launch: occupancy query says %d\n", per_cu);
        (void)hipGetLastError();
        grid = cus;
    }
    if (grid < 0) return;
    if (hipMemsetAsync((char*)d_ws + WS_CTL, 0, CTL_ZERO_BYTES, stream) != hipSuccess) return;
    Args a{};
    for (int i = 0; i < 39; ++i) a.in[i] = (const float*)d_in[i];
    a.out = (float*)d_out; a.ws = (unsigned char*)d_ws;
#if MK_PER_PHASE
    for (int p = 0; p < NPHASE; ++p) { a.ph_lo = p; a.ph_hi = p + 1; hipLaunchKernelGGL(mk_fwd, dim3(grid), dim3(NWAVES * 64), LDS_BYTES, stream, a); }
#else
    a.ph_lo = 0; a.ph_hi = NPHASE; hipLaunchKernelGGL(mk_fwd, dim3(grid), dim3(NWAVES * 64), LDS_BYTES, stream, a);
#endif
}
```

```cpp
#include <hip/hip_runtime.h>
#include <cstdio>
#include <cstdint>
#include <cmath>
#define MK_PER_PHASE 0
namespace pg8 {
#define PG8_LAS __attribute__((address_space(3)))
typedef unsigned short bf16_t;
typedef short bf16x8 __attribute__((ext_vector_type(8)));
typedef float f32x4 __attribute__((ext_vector_type(4)));
typedef unsigned u32x4 __attribute__((ext_vector_type(4)));
constexpr int BM = 256, BK = 64, HALF = 128, HTB = HALF * BK * 2  , STAGE_BYTES = 8 * HTB, NXCD = 8, WGM = 8;

__host__ __device__ __forceinline__ int lds_byte(int r, int c) { const int st = (r >> 4) * 2 + (c >> 5), rr = r & 15, cc = c & 31, ob = rr * 64 + cc * 2; return st * 1024 + (ob ^ (((ob >> 9) & 1) << 5)); }
__host__ __device__ __forceinline__ void stage_rc(int b, int& R, int& C) { const int st = b / 1024, sb = b % 1024, swz = sb ^ (((sb >> 9) & 1) << 5); R = (st >> 1) * 16 + swz / 64; C = (st & 1) * 32 + (swz % 64) / 2; }
__host__ __device__ __forceinline__ int perm32(int rho) { const int n = rho >> 4, i = rho & 15; return 8 * (i >> 2) + 4 * n + (i & 3); }

#ifndef PG8_WT
#define PG8_WT 0
#endif
#if PG8_WT
#define PG8_ST16(base_, ptr_, v_) __builtin_amdgcn_raw_buffer_store_b128((v_), __builtin_amdgcn_make_buffer_rsrc((void*)(base_), (short)0, 0x7fffffff, 0x00020000), (int)((const char*)(ptr_) - (const char*)(base_)), 0, 16)
#else
#define PG8_ST16(base_, ptr_, v_) (*(u32x4*)(ptr_) = (v_))
#endif
struct Unit { int pm, pn; int k0 = 0; };
struct Gemm { const bf16_t* A; const bf16_t* Bt; int M, N, K; int ld = 0; };

struct StaticOrder {
    int nM, nN, nwg, G, c;
    __host__ __device__ void init(int M, int N, int G_, int c_) { nM = M / BM; nN = N / BM; nwg = nM * nN; G = G_; c = c_; }
    __host__ __device__ bool next(int i, Unit& u) const {
        const long L = (long)i * G + c; if (L >= nwg) return false;
        int wgid = (int)L; { const int q = nwg / NXCD, r = nwg % NXCD, xcd = wgid % NXCD, off = wgid / NXCD; wgid = (xcd < r ? xcd * (q + 1) : r * (q + 1) + (xcd - r) * q) + off; }
        const int nig = WGM * nN, gid = wgid / nig, fm = gid * WGM, gsz = (nM - fm) < WGM ? (nM - fm) : WGM;
        u.pm = fm + ((wgid % nig) % gsz); u.pn = (wgid % nig) / gsz; return true;
    }
    __device__ __forceinline__ void a_ready(const Unit&) const {}
    __device__ __forceinline__ void done(const Unit&) const {}
};

__device__ __forceinline__ unsigned cvt_pk_bf16(float lo, float hi) { unsigned r; asm volatile("v_cvt_pk_bf16_f32 %0, %1, %2" : "=v"(r) : "v"(lo), "v"(hi)); return r; }
typedef float f32x2 __attribute__((ext_vector_type(2)));
__device__ __forceinline__ f32x2 gelu_pk(f32x2 v) {
    const f32x2 av = __builtin_elementwise_abs(v), d = av * 0.2316418882f + 1.0f;
    f32x2 t; t.x = __builtin_amdgcn_rcpf(d.x); t.y = __builtin_amdgcn_rcpf(d.y);
    f32x2 q = t * 0.5307027145f + (-0.7265760135f); q = q * t + 0.7107068705f; q = q * t + (-0.142248368f); q = q * t + 0.127414796f; q = q * t;
    const f32x2 s = (v * v) * (-0.72134752044f);
    f32x2 e; e.x = __builtin_amdgcn_exp2f(s.x); e.y = __builtin_amdgcn_exp2f(s.y);
    const f32x2 m = v * (q * e), r = v - m;
    f32x2 o; o.x = v.x < 0.f ? m.x : r.x; o.y = v.y < 0.f ? m.y : r.y; return o;
}

template <int ACT  > struct EpiBf16 {
    static constexpr bool PERM = true, AFTER_DRAIN = false; static_assert(ACT == 0 || ACT == 1, "EpiBf16: ACT is 0 (none) or 1 (gelu_pk)");
    bf16_t* O; int ldc; const float* bias; int split_cols; size_t split_stride; float scale0;
    __device__ __forceinline__ void operator()(const f32x4 (&acc)[2][2][4][2], const Unit& u, int wr, int wc, int fr, int fq) const {
        const int row0 = u.pm * BM + wr * 64 + fr; int colt = u.pn * BM; bf16_t* base = O;
        float sc = 1.f; if (split_cols) { const int t = colt / split_cols; base += (size_t)t * split_stride; colt -= t * split_cols; if (t == 0) sc = scale0; }
        const int col0 = colt + wc * 32 + 8 * fq, bcol0 = u.pn * BM + wc * 32 + 8 * fq;
        f32x4 bv[2][2];
#pragma unroll
        for (int bj = 0; bj < 2; ++bj)
#pragma unroll
            for (int n = 0; n < 2; ++n) bv[bj][n] = bias ? *(const f32x4*)(bias + bcol0 + bj * HALF + 4 * n) : (f32x4){0.f, 0.f, 0.f, 0.f};
#pragma unroll
        for (int ai = 0; ai < 2; ++ai)
#pragma unroll
            for (int m = 0; m < 4; ++m) { bf16_t* rowp = base + (size_t)(row0 + ai * HALF + m * 16) * ldc + col0;
#pragma unroll
                for (int bj = 0; bj < 2; ++bj) { f32x4 v0 = acc[ai][bj][m][0] + bv[bj][0], v1 = acc[ai][bj][m][1] + bv[bj][1];
                    if (ACT == 1) { f32x2 a = gelu_pk((f32x2){v0[0], v0[1]}), b = gelu_pk((f32x2){v0[2], v0[3]}), c = gelu_pk((f32x2){v1[0], v1[1]}), d = gelu_pk((f32x2){v1[2], v1[3]});
                        v0 = (f32x4){a.x, a.y, b.x, b.y}; v1 = (f32x4){c.x, c.y, d.x, d.y}; }
                    v0 = v0 * sc; v1 = v1 * sc; u32x4 w; w.x = cvt_pk_bf16(v0[0], v0[1]); w.y = cvt_pk_bf16(v0[2], v0[3]); w.z = cvt_pk_bf16(v1[0], v1[1]); w.w = cvt_pk_bf16(v1[2], v1[3]);
                    PG8_ST16(base, rowp + bj * HALF, w); } }
    }
};
template <class Epi, class Sched, bool ALIGN_EPI = false, bool SP2 = false>
__device__ __forceinline__ void gemm_phase(PG8_LAS unsigned char* lds, const Gemm g, const Sched& S, const Epi& E) {
    const int tid = threadIdx.x, wid = __builtin_amdgcn_readfirstlane(tid >> 6), lane = tid & 63, wr = wid >> 2, wc = wid & 3, fr = lane & 15, fq = lane >> 4;
    const int K = g.K, nt = K / BK, LD = g.ld ? g.ld : g.K;
    unsigned voffA[2], voffB[2];
#pragma unroll
    for (int i = 0; i < 2; ++i) { int R, C; stage_rc(tid * 16 + i * 8192, R, C); const int Rb = Epi::PERM ? ((R & ~31) + perm32(R & 31)) : R;
        voffA[i] = (unsigned)(R * LD + C) * 2u; voffB[i] = (unsigned)(Rb * LD + C) * 2u; }
    const size_t kstep = (size_t)(BK * 2);
    const size_t hstep = (size_t)HALF * LD * 2;
    const size_t tstep = 2 * hstep;
    const unsigned ldsw = (unsigned)wid * 1024u;
    const int aoff = lds_byte(wr * 64 + fr, fq * 8), boff = lds_byte(wc * 32 + fr, fq * 8);
#define PG8_SA(b, h) (((b) * 2 + (h)) * HTB)
#define PG8_SB(b, h) ((4 + (b) * 2 + (h)) * HTB)
#define PG8_STAGE(bufoff, gbase, voff) do { _Pragma("unroll") for (int _i = 0; _i < 2; ++_i) \
        __builtin_amdgcn_global_load_lds((const unsigned*)((const char*)(gbase) + (voff)[_i]), (PG8_LAS unsigned*)(lds + (bufoff) + ldsw + _i * 8192), 16, 0, 0); } while (0)
#define PG8_LDA(dst, b, h) do { _Pragma("unroll") for (int m = 0; m < 4; ++m) _Pragma("unroll") for (int k = 0; k < 2; ++k) dst[m][k] = *(const PG8_LAS bf16x8*)(lds + PG8_SA(b, h) + aoff + m * 2048 + k * 1024); } while (0)
#define PG8_LDB(dst, b, h) do { _Pragma("unroll") for (int n = 0; n < 2; ++n) _Pragma("unroll") for (int k = 0; k < 2; ++k) dst[n][k] = *(const PG8_LAS bf16x8*)(lds + PG8_SB(b, h) + boff + n * 2048 + k * 1024); } while (0)
#define PG8_MMA(ai, bj, At, Bt) do { __builtin_amdgcn_s_setprio(1); _Pragma("unroll") for (int m = 0; m < 4; ++m) _Pragma("unroll") for (int n = 0; n < 2; ++n) _Pragma("unroll") for (int k = 0; k < 2; ++k) \
        acc[ai][bj][m][n] = __builtin_amdgcn_mfma_f32_16x16x32_bf16(Bt[n][k], At[m][k], acc[ai][bj][m][n], 0, 0, 0); __builtin_amdgcn_s_setprio(0); } while (0)
#define PG8_WAIT_V(n) asm volatile("s_waitcnt vmcnt(" #n ")" ::: "memory")
#define PG8_WAIT_L(n) asm volatile("s_waitcnt lgkmcnt(" #n ")" ::: "memory")
#define PG8_BAR __builtin_amdgcn_s_barrier()
#define PG8_SCHED __builtin_amdgcn_sched_barrier(0)
    Unit cur, nxt; int ui = 0;
    if (!S.next(0, cur)) return;
    f32x4 acc[2][2][4][2];
#pragma unroll
    for (int a = 0; a < 2; ++a)
#pragma unroll
        for (int b = 0; b < 2; ++b)
#pragma unroll
            for (int m = 0; m < 4; ++m)
#pragma unroll
                for (int n = 0; n < 2; ++n) acc[a][b][m][n] = (f32x4){0.f, 0.f, 0.f, 0.f};
    bf16x8 At[4][2], B0[2][2], B1[2][2];
    const char* cA = (const char*)g.A + (size_t)cur.pm * tstep + (size_t)cur.k0 * 2; const char* cB = (const char*)g.Bt + (size_t)cur.pn * tstep + (size_t)cur.k0 * 2;
    S.a_ready(cur);
    if constexpr (SP2) {
        PG8_STAGE(PG8_SB(0, 0), cB, voffB); PG8_STAGE(PG8_SB(0, 1), cB + hstep, voffB); PG8_STAGE(PG8_SA(0, 0), cA, voffA); PG8_STAGE(PG8_SA(0, 1), cA + hstep, voffA);
        if (wr == 1) PG8_BAR;
        PG8_WAIT_V(2); PG8_BAR;
        PG8_STAGE(PG8_SB(1, 0), cB + kstep, voffB); PG8_STAGE(PG8_SA(1, 0), cA + kstep, voffA); PG8_STAGE(PG8_SB(1, 1), cB + hstep + kstep, voffB);
        PG8_WAIT_V(6); PG8_BAR;
    } else {
        PG8_STAGE(PG8_SB(0, 0), cB, voffB); PG8_STAGE(PG8_SA(0, 0), cA, voffA); PG8_STAGE(PG8_SB(0, 1), cB + hstep, voffB); PG8_STAGE(PG8_SA(0, 1), cA + hstep, voffA);
        if (wr == 1) PG8_BAR;
        PG8_WAIT_V(4); PG8_BAR;
        PG8_STAGE(PG8_SB(1, 0), cB + kstep, voffB); PG8_STAGE(PG8_SA(1, 0), cA + kstep, voffA); PG8_STAGE(PG8_SB(1, 1), cB + hstep + kstep, voffB);
        PG8_WAIT_V(6); PG8_BAR;
    }
    for (;;) {
        const bool has_next = S.next(ui + 1, nxt);
        const char* nA = has_next ? (const char*)g.A + (size_t)nxt.pm * tstep + (size_t)nxt.k0 * 2 : cA; const char* nB = has_next ? (const char*)g.Bt + (size_t)nxt.pn * tstep + (size_t)nxt.k0 * 2 : cB;
        for (int t = 0; t < nt; t += 2) {
            const bool last = (t == nt - 2);
            const char* a1 = cA + (size_t)(t + 1) * kstep;
            const char* a2 = last ? nA : cA + (size_t)(t + 2) * kstep; const char* b2 = last ? nB : cB + (size_t)(t + 2) * kstep;
            const char* a3 = a2 + kstep; const char* b3 = b2 + kstep;
            if (last && has_next) S.a_ready(nxt);
            if constexpr (SP2) {
            PG8_LDB(B0, 0, 0); PG8_LDB(B1, 0, 1); PG8_SCHED; PG8_LDA(At, 0, 0); PG8_STAGE(PG8_SA(1, 1), a1 + hstep, voffA);
            PG8_WAIT_V(8); PG8_WAIT_L(0); PG8_BAR; PG8_MMA(0, 0, At, B0); PG8_MMA(0, 1, At, B1); PG8_BAR; PG8_SCHED;
            PG8_LDA(At, 0, 1); PG8_STAGE(PG8_SB(0, 0), b2, voffB); PG8_STAGE(PG8_SB(0, 1), b2 + hstep, voffB); PG8_STAGE(PG8_SA(0, 0), a2, voffA);
            PG8_WAIT_V(8); PG8_WAIT_L(0); PG8_BAR; PG8_MMA(1, 0, At, B0); PG8_MMA(1, 1, At, B1); PG8_BAR; PG8_SCHED;
            PG8_LDB(B0, 1, 0); PG8_LDB(B1, 1, 1); PG8_SCHED; PG8_LDA(At, 1, 0); PG8_STAGE(PG8_SA(0, 1), a2 + hstep, voffA);
            PG8_WAIT_V(8); PG8_WAIT_L(0); PG8_BAR; PG8_MMA(0, 0, At, B0); PG8_MMA(0, 1, At, B1); PG8_BAR; PG8_SCHED;
            PG8_LDA(At, 1, 1); PG8_STAGE(PG8_SB(1, 0), b3, voffB); PG8_STAGE(PG8_SB(1, 1), b3 + hstep, voffB); PG8_STAGE(PG8_SA(1, 0), a3, voffA);
            PG8_WAIT_V(8); PG8_WAIT_L(0); PG8_BAR; PG8_MMA(1, 0, At, B0); PG8_MMA(1, 1, At, B1); PG8_BAR; PG8_SCHED;
            } else {
            PG8_LDB(B0, 0, 0); PG8_SCHED; PG8_LDA(At, 0, 0); PG8_STAGE(PG8_SA(1, 1), a1 + hstep, voffA);
            PG8_WAIT_L(8); PG8_BAR; PG8_WAIT_L(0); PG8_MMA(0, 0, At, B0); PG8_BAR; PG8_SCHED;
            PG8_LDB(B1, 0, 1); PG8_STAGE(PG8_SB(0, 0), b2, voffB);
            PG8_BAR; PG8_WAIT_L(0); PG8_MMA(0, 1, At, B1); PG8_BAR;
            PG8_LDA(At, 0, 1); PG8_STAGE(PG8_SA(0, 0), a2, voffA);
            PG8_BAR; PG8_WAIT_L(0); PG8_MMA(1, 0, At, B0); PG8_BAR; PG8_SCHED;
            PG8_STAGE(PG8_SB(0, 1), b2 + hstep, voffB);
            PG8_WAIT_V(6); PG8_BAR; PG8_MMA(1, 1, At, B1); PG8_BAR;
            PG8_LDB(B0, 1, 0); PG8_SCHED; PG8_LDA(At, 1, 0); PG8_STAGE(PG8_SA(0, 1), a2 + hstep, voffA);
            PG8_WAIT_L(8); PG8_BAR; PG8_WAIT_L(0); PG8_MMA(0, 0, At, B0); PG8_BAR; PG8_SCHED;
            PG8_LDB(B1, 1, 1); PG8_STAGE(PG8_SB(1, 0), b3, voffB);
            PG8_BAR; PG8_WAIT_L(0); PG8_MMA(0, 1, At, B1); PG8_BAR;
            PG8_LDA(At, 1, 1); PG8_STAGE(PG8_SA(1, 0), a3, voffA);
            PG8_BAR; PG8_WAIT_L(0); PG8_MMA(1, 0, At, B0); PG8_BAR; PG8_SCHED;
            PG8_STAGE(PG8_SB(1, 1), b3 + hstep, voffB);
            PG8_WAIT_V(6); PG8_BAR; PG8_MMA(1, 1, At, B1); PG8_BAR;
            }
        }
        if constexpr (ALIGN_EPI) { if (wr == 0) PG8_BAR; }
        if constexpr (!Epi::AFTER_DRAIN) { E(acc, cur, wr, wc, fr, fq); S.done(cur); }
        if (!has_next) break;
#pragma unroll
        for (int a = 0; a < 2; ++a)
#pragma unroll
            for (int b = 0; b < 2; ++b)
#pragma unroll
                for (int m = 0; m < 4; ++m)
#pragma unroll
                    for (int n = 0; n < 2; ++n) acc[a][b][m][n] = (f32x4){0.f, 0.f, 0.f, 0.f};
        cur = nxt; cA = nA; cB = nB; ++ui;
        if constexpr (ALIGN_EPI) { if (wr == 1) PG8_BAR; }
    }
    PG8_WAIT_V(0);
    if constexpr (!ALIGN_EPI) { if (wr == 0) PG8_BAR; }
    PG8_BAR;
    if constexpr (Epi::AFTER_DRAIN) { E.fused(acc, cur, wr, wc, fr, fq, lds, wid, lane); S.done(cur); }
#undef PG8_SA
#undef PG8_SB
#undef PG8_STAGE
#undef PG8_LDA
#undef PG8_LDB
#undef PG8_MMA
#undef PG8_WAIT_V
#undef PG8_WAIT_L
#undef PG8_BAR
#undef PG8_SCHED
}
}

#define GAS __attribute__((address_space(1)))
#define LAS __attribute__((address_space(3)))
typedef unsigned short bf16;
typedef unsigned v4u __attribute__((ext_vector_type(4)));
typedef float f32x4 __attribute__((ext_vector_type(4)));
typedef short bf16x8 __attribute__((ext_vector_type(8)));
typedef GAS unsigned gu32;
typedef GAS unsigned long long gu64;
#define RLX_AGENT __ATOMIC_RELAXED, __HIP_MEMORY_SCOPE_AGENT
#define LDS_WAIT() asm volatile("s_waitcnt lgkmcnt(0)" ::: "memory")
#define VM_WAIT() asm volatile("s_waitcnt vmcnt(0)" ::: "memory")
__device__ __forceinline__ unsigned long long rt() { return __builtin_amdgcn_s_memrealtime(); }
typedef float f32x2_t __attribute__((ext_vector_type(2))); typedef __bf16 bf16x2_t __attribute__((ext_vector_type(2)));
__device__ __forceinline__ unsigned pk2(float lo, float hi) { const f32x2_t v = {lo, hi}; const bf16x2_t b = __builtin_convertvector(v, bf16x2_t); return __builtin_bit_cast(unsigned, b); }
__device__ __forceinline__ unsigned f2bf(float f) { return pk2(f, f) & 0xffffu; }
#define XB_TMO      128
#define XB_XCNT(j)  (256  + 64 * (j))
#define XB_XSUB(j)  (1280 + 64 * (j))
#define XB_XGEN(j)  (2304 + 64 * (j))
#define XB_TOP      3328
#define XB_TOPGEN   3392
#define XCD_BAR_WORDS 3456
#define XB_SPIN_CAP (1u << 18)

__device__ __forceinline__ unsigned xb_ld(unsigned* p)              { return __hip_atomic_load(p, __ATOMIC_RELAXED, __HIP_MEMORY_SCOPE_AGENT); }
__device__ __forceinline__ unsigned xb_add(unsigned* p, unsigned v) { return __hip_atomic_fetch_add(p, v, __ATOMIC_RELAXED, __HIP_MEMORY_SCOPE_AGENT); }
__device__ __forceinline__ unsigned xb_xcc_id() { return (unsigned)__builtin_amdgcn_s_getreg((3 << 11) | 20) & 0xFu; }
#define XB_SPIN(cond, bar) do { unsigned _sp = 0; while (cond) { __builtin_amdgcn_s_sleep(1); \
    if ((++_sp & 255u) == 0u) { if (xb_ld(&(bar)[XB_TMO])) break; if (_sp > XB_SPIN_CAP) { atomicAdd(&(bar)[XB_TMO], 1u); break; } } } } while (0)

struct XcdBarrier {
    unsigned* bar; unsigned x;
    volatile LAS unsigned* st;
};

__device__ __forceinline__ XcdBarrier xcd_barrier_post(unsigned* bar, volatile LAS unsigned* st) {
    XcdBarrier b; b.bar = bar; b.x = xb_xcc_id(); b.st = st;
    if (threadIdx.x == 0) (void)xb_add(&bar[XB_XCNT(b.x)], 1u);
    return b;
}
__device__ __forceinline__ void xcd_barrier_complete(unsigned* bar, unsigned x, unsigned& nloc, unsigned& nx) {
    const unsigned G = gridDim.x * gridDim.y * gridDim.z;
    unsigned sum, cnt, mine, sp = 0u;
    for (;;) {
        sum = 0u; cnt = 0u; mine = 0u;
#pragma unroll
        for (unsigned j = 0; j < 16; ++j) { const unsigned c = xb_ld(&bar[XB_XCNT(j)]); sum += c; cnt += (c > 0u) ? 1u : 0u; mine = (j == x) ? c : mine; }
        if (sum == G) break;
        __builtin_amdgcn_s_sleep(1);
        if ((++sp & 255u) == 0u) { if (xb_ld(&bar[XB_TMO])) break; if (sp > XB_SPIN_CAP) { atomicAdd(&bar[XB_TMO], 1u); break; } }
    }
    nloc = mine > 0u ? mine : 1u; nx = cnt > 0u ? cnt : 1u;
}

__device__ __forceinline__ void xcd_barrier(const XcdBarrier& b) {
    asm volatile("s_waitcnt vmcnt(0)" ::: "memory");
    __syncthreads();
    if (threadIdx.x == 0) {
        unsigned* bar = b.bar;
        __builtin_amdgcn_s_waitcnt(0);
        unsigned nloc = b.st[0], nx = b.st[1];
        if (nloc == 0u) { xcd_barrier_complete(bar, b.x, nloc, nx); b.st[0] = nloc; b.st[1] = nx; }
        const unsigned old = xb_add(&bar[XB_XSUB(b.x)], 1u);
        const unsigned gen = old / nloc;
        if (old + 1u == (gen + 1u) * nloc) {
            __builtin_amdgcn_fence(__ATOMIC_RELEASE, "agent");
            asm volatile("s_waitcnt vmcnt(0)" ::: "memory");
            const unsigned og = xb_add(&bar[XB_TOP], 1u);
            const unsigned tg = og / nx;
            if (og + 1u == (tg + 1u) * nx) xb_add(&bar[XB_TOPGEN], 1u);
            else XB_SPIN(xb_ld(&bar[XB_TOPGEN]) == tg, bar);
            __builtin_amdgcn_fence(__ATOMIC_ACQUIRE, "agent");
            xb_add(&bar[XB_XGEN(b.x)], 1u);
            asm volatile("s_waitcnt vmcnt(0)" ::: "memory");
        } else {
            XB_SPIN(xb_ld(&bar[XB_XGEN(b.x)]) == gen, bar);
            __builtin_amdgcn_fence(__ATOMIC_ACQUIRE, "agent");
            asm volatile("s_waitcnt vmcnt(0)" ::: "memory");
        }
    }
    __syncthreads();
}


constexpr int NWAVES = 8, NTHR = 512;
constexpr int D = 1024, NB = 8, SEQ = 2048, CTXL = 256;
constexpr int M_CTX = NB * CTXL, M_LAT = NB * SEQ, M_ALL = M_CTX + M_LAT;
constexpr int RWC = 1760, MIXIN = 3312, ZLD = 3328, FF = 2816, NE = 8;
constexpr int PRV = 9 * 512;
constexpr int MOE_ROWS = 34816;
constexpr size_t MiB = 1u << 20;
constexpr size_t WS_CTL = 0, CTL_ZERO_BYTES = 1 * MiB;
constexpr size_t WS_MODS = 1 * MiB;
constexpr size_t WS_TOK = 1 * MiB + 512 * 1024;
constexpr size_t WS_WIN_T = 2 * MiB;
constexpr size_t WS_WOUT_T = WS_WIN_T + (size_t)ZLD * D * 2;
constexpr size_t WS_W13_T = WS_WOUT_T + 2 * MiB;
constexpr size_t WS_W2_T = WS_W13_T + 11 * MiB;
constexpr size_t WS_QKV_T = WS_W2_T + (size_t)D * FF * 2;
constexpr size_t WS_NAO_T = WS_QKV_T + 6 * MiB;
constexpr size_t WS_HCTX = 35 * MiB;
constexpr size_t WS_A = 43 * MiB;
constexpr size_t WS_R = 79 * MiB;
constexpr size_t WS_Z = WS_R;
constexpr size_t WS_PR = 196 * MiB;
constexpr size_t WS_PM = 358 * MiB;
constexpr size_t WS_DT = 394 * MiB;
constexpr size_t WS_BONUS = 395 * MiB + 256 * 1024;
constexpr size_t WS_GATE = 396 * MiB;
constexpr size_t WS_ZG = 414 * MiB;
constexpr size_t WS_YRW = WS_R;
constexpr size_t WS_YMB = WS_R + 36 * MiB;
constexpr size_t WS_HID = WS_R;
constexpr size_t WS_MOEW13 = 316 * MiB;
constexpr size_t WS_MOEW2 = 404 * MiB;
constexpr size_t WS_Q = WS_R, WS_K = WS_R + 36 * MiB, WS_V = WS_R + 72 * MiB;
constexpr size_t WS_O = WS_R + 108 * MiB;
constexpr size_t WS_A4 = 111 * MiB;
constexpr size_t WS_XG = 43 * MiB;
constexpr size_t WS_HIDG = 111 * MiB;
constexpr size_t WS_YG = 43 * MiB;
constexpr size_t WS_SLAB6 = WS_R;
constexpr size_t WS_SLAB9 = WS_R + 99 * MiB;
constexpr size_t WS_TAIL = 316 * MiB;
constexpr size_t WS_END = 448 * MiB;
static_assert(WS_NAO_T + 2 * MiB <= WS_HCTX && WS_ZG + 18 * MiB <= WS_END && WS_MOEW2 + 44 * MiB <= WS_END && WS_HIDG + (size_t)MOE_ROWS * FF * 2 <= WS_MOEW13, "ws map");
static_assert(WS_Z + (size_t)M_ALL * ZLD * 2 <= WS_PR && WS_PR + (size_t)M_ALL * PRV * 2 <= WS_PM && WS_XG + (size_t)MOE_ROWS * D * 2 <= WS_HIDG, "ws map 2");
constexpr int CW_TMO = 0, CW_CODE = 1, CW_BAR = 4096, CW_CNT = 8192, CW_CNTB = 16384;
constexpr int RING_BYTES = 131072, LDSCTL_OFF = 145408, MISC_OFF = LDSCTL_OFF + 320, LDS_BYTES = 147456;

typedef unsigned v2u __attribute__((ext_vector_type(2)));
typedef float v2f __attribute__((ext_vector_type(2)));
typedef short s16x4 __attribute__((ext_vector_type(4)));
typedef short v4i16_t __attribute__((ext_vector_type(4)));
__device__ __forceinline__ float bflo(unsigned u) { return __uint_as_float(u << 16); }
__device__ __forceinline__ float bfhi(unsigned u) { return __uint_as_float(u & 0xffff0000u); }
__device__ __forceinline__ float ldbf(const bf16* p) { return __uint_as_float((unsigned)(*p) << 16); }
__device__ __forceinline__ float sigm(float x) { return __builtin_amdgcn_rcpf(1.f + __expf(-x)); }
__device__ __forceinline__ bf16x8 pack8(const f32x4& a, const f32x4& b) {
    v4u w; w.x = pk2(a[0], a[1]); w.y = pk2(a[2], a[3]); w.z = pk2(b[0], b[1]); w.w = pk2(b[2], b[3]); return __builtin_bit_cast(bf16x8, w);
}
template <int CTRL> __device__ __forceinline__ float dppf(float x) { return __int_as_float(__builtin_amdgcn_update_dpp(0, __float_as_int(x), CTRL, 0xF, 0xF, true)); }
__device__ __forceinline__ float sum8(float x) { x += dppf<0xB1>(x); x += dppf<0x4E>(x); x += dppf<0x141>(x); return x; }
__device__ __forceinline__ float sum16(float x) { x = sum8(x); x += dppf<0x140>(x); return x; }
__device__ __forceinline__ float rlf(float v, int l) { return __int_as_float(__builtin_amdgcn_readlane(__float_as_int(v), l)); }
__device__ __forceinline__ float wave_sum(float v) { v = sum16(v); return (rlf(v, 0) + rlf(v, 16)) + (rlf(v, 32) + rlf(v, 48)); }
__device__ __forceinline__ float half_sum(float v, int lane) { v = sum16(v); const float lo = rlf(v, 0) + rlf(v, 16), hi = rlf(v, 32) + rlf(v, 48); return lane < 32 ? lo : hi; }

struct Frame {
    LAS unsigned char* lds;
    volatile LAS unsigned* MISC;
    gu32* ctl;
    int tid, lane, wave, G, bid;
};

__device__ __forceinline__ void tr_item(const float* W, int K, int N, bf16* WT, int drow0, int k0, int n0, LAS float* scr, int lane) {
    const int nn = n0 + (lane & 31);
    float t[32];
#pragma unroll
    for (int i = 0; i < 32; ++i) { const int kk = 2 * i + (lane >> 5); t[i] = (nn < N) ? W[(size_t)(k0 + kk) * N + nn] : 0.f; }
#pragma unroll
    for (int i = 0; i < 32; ++i) { const int kk = 2 * i + (lane >> 5); scr[kk * 33 + (lane & 31)] = t[i]; }
    LDS_WAIT(); asm volatile("" ::: "memory");
    const int c = lane & 7;
#pragma unroll
    for (int j = 0; j < 4; ++j) { const int n = (lane >> 3) + 8 * j; const LAS float* s = scr + (8 * c) * 33 + n;
        v4u o; o.x = pk2(s[0 * 33], s[1 * 33]); o.y = pk2(s[2 * 33], s[3 * 33]); o.z = pk2(s[4 * 33], s[5 * 33]); o.w = pk2(s[6 * 33], s[7 * 33]);
        *(GAS v4u*)(WT + (size_t)(drow0 + n) * K + k0 + 8 * c) = o; }
    LDS_WAIT(); asm volatile("" ::: "memory");
}
template <int MODE  >
__device__ __forceinline__ bool tr_matrix(int& it, const float* W, int K, int N, bf16* WT, LAS float* scr, int lane) {
    const int nblk = (N + 31) / 32, items = (K / 64) * nblk;
    if (it >= items) { it -= items; return false; }
    const int kb = it / nblk, nb = it % nblk, n0 = nb * 32;
    int drow0 = n0;
    if (MODE == 1) drow0 = (n0 >> 7) * 256 + (n0 & 127);
    if (MODE == 2) drow0 = (n0 >> 7) * 256 + 128 + (n0 & 127);
    tr_item(W, K, N, WT, drow0, kb * 64, n0, scr, lane);
    return true;
}

__device__ __forceinline__ void p0_phase(Frame& F, const float* c, const float* c_ctx, const float* w_ada, const float* b_ada, float* mods,
                                         const float* mix_w_in, const float* mix_w_out, const float* ffn_w1, const float* ffn_w3, const float* ffn_w2,
                                         const float* na_w_qkv, const float* na_w_out, unsigned char* ws) {
    for (int u = F.bid; u < 192; u += F.G) {
        LAS float* sc = (LAS float*)(F.lds);
        LAS float* red = (LAS float*)(F.lds + 36864);
        for (int i = F.tid; i < 9 * 1024; i += NTHR) { const int b = i >> 10, k = i & 1023; const float v = (b < 8) ? c[b * 1024 + k] : c_ctx[k]; sc[i] = v / (1.f + __expf(-v)); }
        __syncthreads();
        const int layer = u / 96, col = (u % 96) * 64 + F.lane;
        const float* W = w_ada + (size_t)layer * 1024 * 6144 + col;
        float acc[9];
#pragma unroll
        for (int b = 0; b < 9; ++b) acc[b] = 0.f;
        const int k0 = F.wave * 128;
#pragma unroll 8
        for (int k = 0; k < 128; ++k) { const float w = W[(size_t)(k0 + k) * 6144];
#pragma unroll
            for (int b = 0; b < 9; ++b) acc[b] += sc[b * 1024 + k0 + k] * w; }
#pragma unroll
        for (int b = 0; b < 9; ++b) red[(F.wave * 9 + b) * 64 + F.lane] = acc[b];
        __syncthreads();
        if (F.wave == 0) {
#pragma unroll
            for (int b = 0; b < 9; ++b) { float s = 0.f;
#pragma unroll
                for (int w = 0; w < 8; ++w) s += red[(w * 9 + b) * 64 + F.lane];
                mods[(layer * 9 + b) * 6144 + col] = s + b_ada[layer * 6144 + col]; }
        }
        __syncthreads();
    }
    LAS float* scr = (LAS float*)(F.lds + 57344 + F.wave * 8704);
    const int gw = F.bid * NWAVES + F.wave, NGW = F.G * NWAVES;
    constexpr int NITEMS = 16 * 104 + 512 + 1408 * 3 + 1536 + 512;
    for (int it0 = gw; it0 < NITEMS; it0 += NGW) {
        int it = it0;
        if (tr_matrix<0>(it, mix_w_in, 1024, MIXIN, (bf16*)(ws + WS_WIN_T), scr, F.lane)) continue;
        if (tr_matrix<0>(it, mix_w_out, 1024, 1024, (bf16*)(ws + WS_WOUT_T), scr, F.lane)) continue;
        if (tr_matrix<1>(it, ffn_w1, 1024, FF, (bf16*)(ws + WS_W13_T), scr, F.lane)) continue;
        if (tr_matrix<2>(it, ffn_w3, 1024, FF, (bf16*)(ws + WS_W13_T), scr, F.lane)) continue;
        if (tr_matrix<0>(it, ffn_w2, FF, 1024, (bf16*)(ws + WS_W2_T), scr, F.lane)) continue;
        if (tr_matrix<0>(it, na_w_qkv, 1024, 3072, (bf16*)(ws + WS_QKV_T), scr, F.lane)) continue;
        tr_matrix<0>(it, na_w_out, 1024, 1024, (bf16*)(ws + WS_NAO_T), scr, F.lane);
    }
}
constexpr int MOE_ITEMS = NE * 1408 * 3, MOE_W13_ITEMS = NE * 2816, MOE_ITEMS_P6 = 0, MOE_ITEMS_P8 = 10240, MOE_ITEMS_P9 = 16384, MOE_ITEMS_P11 = 0, MOE_ITEMS_P16 = 7168, MOE_ITEMS_P7 = MOE_ITEMS - MOE_ITEMS_P8 - MOE_ITEMS_P9 - MOE_ITEMS_P11 - MOE_ITEMS_P16;
static_assert(MOE_ITEMS - MOE_ITEMS_P16 >= MOE_W13_ITEMS, "the items left for P16's idle workgroups must all be w2 items (the w1|w3 copies are read by P16 itself)");
__device__ __forceinline__ void moe_weight_phase(Frame& F, const float* w1, const float* w3, const float* w2, unsigned char* ws, int lo, int hi, int widx, int nw) {
    LAS float* scr = (LAS float*)(F.lds + 57344 + F.wave * 8704);
    const int gw = widx * NWAVES + F.wave, NGW = nw * NWAVES;
    for (int it0 = lo + gw; it0 < hi; it0 += NGW) {
        const bool isw2 = it0 >= MOE_W13_ITEMS; const int e = isw2 ? (it0 - MOE_W13_ITEMS) / 1408 : it0 / 2816; int it = isw2 ? 2816 + (it0 - MOE_W13_ITEMS) % 1408 : it0 % 2816;
        bf16* w13t = (bf16*)(ws + WS_MOEW13) + (size_t)e * 5632 * 1024; bf16* w2t = (bf16*)(ws + WS_MOEW2) + (size_t)e * 1024 * FF;
        if (tr_matrix<1>(it, w1 + (size_t)e * 1024 * FF, 1024, FF, w13t, scr, F.lane)) continue;
        if (tr_matrix<2>(it, w3 + (size_t)e * 1024 * FF, 1024, FF, w13t, scr, F.lane)) continue;
        tr_matrix<0>(it, w2 + (size_t)e * 1024 * FF, FF, 1024, w2t, scr, F.lane);
    }
}

struct RowIn { f32x4 x[4], sh[4], sc[4]; };
__device__ __forceinline__ void row_fetch(RowIn& R, const float* xrow, const float* sh, const float* sc, int lane) {
#pragma unroll
    for (int j = 0; j < 4; ++j) { R.x[j] = ((const GAS f32x4*)xrow)[lane + 64 * j]; R.sh[j] = ((const GAS f32x4*)sh)[lane + 64 * j]; R.sc[j] = ((const GAS f32x4*)sc)[lane + 64 * j]; }
}
__device__ __forceinline__ void row_finish(const RowIn& R, const f32x4 (&gg)[4], bf16* orow, int lane, f32x4 (&a)[4], const float* slab = nullptr, int nslab = 0, float* wb = nullptr) {
    float ss = 0.f;
#pragma unroll
    for (int j = 0; j < 4; ++j) a[j] = R.x[j];
    for (int s = 0; s < nslab; ++s) { const GAS f32x4* sr = (const GAS f32x4*)(slab + (size_t)s * (2048 * 1024)) + lane;
#pragma unroll
        for (int j = 0; j < 4; ++j) a[j] += sr[64 * j]; }
    if (wb) { GAS f32x4* w4 = (GAS f32x4*)wb + lane;
#pragma unroll
        for (int j = 0; j < 4; ++j) w4[64 * j] = a[j]; }
#pragma unroll
    for (int j = 0; j < 4; ++j) ss += (a[j].x * a[j].x + a[j].y * a[j].y) + (a[j].z * a[j].z + a[j].w * a[j].w);
    const float rs = rsqrtf(wave_sum(ss) * (1.f / 1024.f) + 1e-6f);
    GAS unsigned long long* o8 = (GAS unsigned long long*)orow + lane;
#pragma unroll
    for (int j = 0; j < 4; ++j) {
        a[j] = (a[j] * rs) * gg[j] * (R.sc[j] + 1.f) + R.sh[j];
        o8[64 * j] = (unsigned long long)pk2(a[j].x, a[j].y) | ((unsigned long long)pk2(a[j].z, a[j].w) << 32);
    }
}
__device__ __forceinline__ void normmod_phase(Frame& F, const float* src_ctx, const float* src_lat, const float* g, const float* mods_l, int off_shift, int off_scale, bf16* dst, const float* slab = nullptr, int nslab = 0, float* wb_ctx = nullptr) {
    const int gw = F.bid * NWAVES + F.wave, NGW = F.G * NWAVES;
    f32x4 gg[4];
#pragma unroll
    for (int j = 0; j < 4; ++j) gg[j] = ((const GAS f32x4*)g)[F.lane + 64 * j];
    RowIn cur, nxt;
    int r = gw; bool have = r < M_ALL;
#define NM_FETCH(R_, r_) do { const bool ic_ = (r_) < M_CTX; const int rl_ = ic_ ? (r_) : (r_) - M_CTX; const float* mp_ = mods_l + (ic_ ? 8 : (rl_ >> 11)) * 6144; \
        row_fetch(R_, (ic_ ? src_ctx : src_lat) + (size_t)rl_ * D, mp_ + off_shift, mp_ + off_scale, F.lane); } while (0)
    if (have) NM_FETCH(cur, r);
    while (have) {
        const int rn = r + NGW; const bool hn = rn < M_ALL;
        if (hn) NM_FETCH(nxt, rn);
        const bool isctx = r < M_CTX; const int rl = isctx ? r : r - M_CTX;
        f32x4 a[4];
        if (isctx) row_finish(cur, gg, dst + (size_t)r * D, F.lane, a, slab ? slab + (size_t)rl * D : nullptr, nslab, wb_ctx ? wb_ctx + (size_t)rl * D : nullptr);
        else row_finish(cur, gg, dst + (size_t)r * D, F.lane, a);
        cur = nxt; r = rn; have = hn;
    }
#undef NM_FETCH
}

namespace pg8 {
struct EpiResGate {
    static constexpr bool PERM = false, AFTER_DRAIN = false;
    const float* base_c; const float* base_l; float* out_c; float* out_l; const float* mods_l; int gate_off; int ctx_tiles;
    __device__ __forceinline__ void operator()(const f32x4 (&acc)[2][2][4][2], const Unit& u, int wr, int wc, int fr, int fq) const {
        const bool isctx = u.pm < ctx_tiles; const int rt = isctx ? u.pm : u.pm - ctx_tiles; const int mi = isctx ? 8 : (rt >> 3);
        const float* base = isctx ? base_c : base_l; float* out = isctx ? out_c : out_l;
        const int col0 = u.pn * BM + wc * 32 + 4 * fq; const float* gp = mods_l + mi * 6144 + gate_off + col0;
        f32x4 gv[2][2];
#pragma unroll
        for (int bj = 0; bj < 2; ++bj)
#pragma unroll
            for (int n = 0; n < 2; ++n) gv[bj][n] = *(const f32x4*)(gp + bj * HALF + n * 16);
#pragma unroll
        for (int ai = 0; ai < 2; ++ai)
#pragma unroll
            for (int m = 0; m < 4; ++m) { const size_t off = (size_t)(rt * BM + ai * HALF + wr * 64 + m * 16 + fr) * 1024 + col0;
#pragma unroll
                for (int bj = 0; bj < 2; ++bj)
#pragma unroll
                    for (int n = 0; n < 2; ++n) { const f32x4 b = *(const f32x4*)(base + off + bj * HALF + n * 16); *(f32x4*)(out + off + bj * HALF + n * 16) = b + gv[bj][n] * acc[ai][bj][m][n]; } }
    }
};
struct EpiSwiGLU {
    static constexpr bool PERM = true, AFTER_DRAIN = false;
    bf16_t* O; int ldo; int nt_mod;
    __device__ __forceinline__ void operator()(const f32x4 (&acc)[2][2][4][2], const Unit& u, int wr, int wc, int fr, int fq) const {
        const int pnl = u.pn % nt_mod; const int row0 = u.pm * BM + wr * 64 + fr, col0 = pnl * HALF + wc * 32 + 8 * fq;
#pragma unroll
        for (int ai = 0; ai < 2; ++ai)
#pragma unroll
            for (int m = 0; m < 4; ++m) { bf16_t* rowp = O + (size_t)(row0 + ai * HALF + m * 16) * ldo + col0;
                float h[8];
#pragma unroll
                for (int n = 0; n < 2; ++n)
#pragma unroll
                    for (int e = 0; e < 4; ++e) { const float a = acc[ai][0][m][n][e], b = acc[ai][1][m][n][e]; h[n * 4 + e] = a * b * __builtin_amdgcn_rcpf(1.f + __expf(-a)); }
                u32x4 w; w.x = cvt_pk_bf16(h[0], h[1]); w.y = cvt_pk_bf16(h[2], h[3]); w.z = cvt_pk_bf16(h[4], h[5]); w.w = cvt_pk_bf16(h[6], h[7]);
                PG8_ST16(O, rowp, w); }
    }
};
struct EpiPlainMod {
    static constexpr bool PERM = true, AFTER_DRAIN = false;
    bf16_t* O; int ldo; int nt_mod;
    __device__ __forceinline__ void operator()(const f32x4 (&acc)[2][2][4][2], const Unit& u, int wr, int wc, int fr, int fq) const {
        const int pnl = u.pn % nt_mod; const int row0 = u.pm * BM + wr * 64 + fr, col0 = pnl * BM + wc * 32 + 8 * fq;
#pragma unroll
        for (int ai = 0; ai < 2; ++ai)
#pragma unroll
            for (int m = 0; m < 4; ++m) { bf16_t* rowp = O + (size_t)(row0 + ai * HALF + m * 16) * ldo + col0;
#pragma unroll
                for (int bj = 0; bj < 2; ++bj) { const f32x4 v0 = acc[ai][bj][m][0], v1 = acc[ai][bj][m][1];
                    u32x4 w; w.x = cvt_pk_bf16(v0[0], v0[1]); w.y = cvt_pk_bf16(v0[2], v0[3]); w.z = cvt_pk_bf16(v1[0], v1[1]); w.w = cvt_pk_bf16(v1[2], v1[3]);
                    PG8_ST16(O, rowp + bj * HALF, w); } }
    }
};
struct SplitKOrder {
    int ntm, nN, ns, kslice, G, c;
    __device__ __forceinline__ bool next(int i, Unit& u) const {
        const int L = i * G + c; if (L >= ntm * nN * ns) return false;
        const int ks = L % ns, t = L / ns; u.pn = t % nN; u.pm = t / nN; u.k0 = ks * kslice; return true;
    }
    __device__ __forceinline__ void a_ready(const Unit&) const {}
    __device__ __forceinline__ void done(const Unit&) const {}
};
struct EpiSlabGate {
    static constexpr bool PERM = false, AFTER_DRAIN = false;
    float* slab; const float* gate; int kslice;
    __device__ __forceinline__ void operator()(const f32x4 (&acc)[2][2][4][2], const Unit& u, int wr, int wc, int fr, int fq) const {
        const int col0 = u.pn * BM + wc * 32 + 4 * fq; float* out = slab + (size_t)(u.k0 / kslice) * (2048 * 1024);
        f32x4 gv[2][2];
#pragma unroll
        for (int bj = 0; bj < 2; ++bj)
#pragma unroll
            for (int n = 0; n < 2; ++n) gv[bj][n] = *(const f32x4*)(gate + col0 + bj * HALF + n * 16);
#pragma unroll
        for (int ai = 0; ai < 2; ++ai)
#pragma unroll
            for (int m = 0; m < 4; ++m) { float* op = out + (size_t)(u.pm * BM + ai * HALF + wr * 64 + m * 16 + fr) * 1024 + col0;
#pragma unroll
                for (int bj = 0; bj < 2; ++bj)
#pragma unroll
                    for (int n = 0; n < 2; ++n) *(f32x4*)(op + bj * HALF + n * 16) = gv[bj][n] * acc[ai][bj][m][n]; }
    }
};
struct MoeOrder {
    int tb[9]; int ntn, G, c; int limit = 0x7fffffff;
    __device__ __forceinline__ bool next(int i, Unit& u) const {
        const int L = i * G + c; if (L >= tb[8] * ntn || L >= limit) return false;
        const int mt = L / ntn, pn = L % ntn; int e = 0;
#pragma unroll
        for (int k = 1; k < 8; ++k) e += (mt >= tb[k]) ? 1 : 0;
        u.pm = mt; u.pn = e * ntn + pn; return true;
    }
    __device__ __forceinline__ void a_ready(const Unit&) const {}
    __device__ __forceinline__ void done(const Unit&) const {}
};
struct MoeTailOrder {
    int tb[9]; int first, ntail, G, c;
    __device__ __forceinline__ bool next(int i, Unit& u) const {
        const int L = i * G + c; if (L >= ntail * 11) return false;
        const int tu = L / 11, ks = L % 11, gu = first + tu, mt = gu >> 2, pn = gu & 3; int e = 0;
#pragma unroll
        for (int k = 1; k < 8; ++k) e += (mt >= tb[k]) ? 1 : 0;
        u.pm = mt; u.pn = e * 4 + pn; u.k0 = ks * 256; return true;
    }
    __device__ __forceinline__ void a_ready(const Unit&) const {}
    __device__ __forceinline__ void done(const Unit&) const {}
};
struct EpiTailSlab {
    static constexpr bool PERM = false, AFTER_DRAIN = false;
    float* slab; int first, ntail;
    __device__ __forceinline__ void operator()(const f32x4 (&acc)[2][2][4][2], const Unit& u, int wr, int wc, int fr, int fq) const {
        const int col0 = (u.pn & 3) * BM + wc * 32 + 4 * fq; float* out = slab + (size_t)(u.k0 >> 8) * ((size_t)(ntail >> 2) * 256 * 1024);
        const int rt = u.pm - (first >> 2);
#pragma unroll
        for (int ai = 0; ai < 2; ++ai)
#pragma unroll
            for (int m = 0; m < 4; ++m) { float* op = out + (size_t)(rt * BM + ai * HALF + wr * 64 + m * 16 + fr) * 1024 + col0;
#pragma unroll
                for (int bj = 0; bj < 2; ++bj)
#pragma unroll
                    for (int n = 0; n < 2; ++n) *(f32x4*)(op + bj * HALF + n * 16) = acc[ai][bj][m][n]; }
    }
};
}

struct PrepIn { const float *rw_mu, *rw_w0, *rw_w_up, *rw_a0, *rw_a_up, *rw_g_up, *rw_k_k, *rw_k_a, *rw_r_k, *conv_w, *conv_b, *dt_bias; };
__device__ __forceinline__ bf16x8 gather8(const float* p, int stride) {
    v4u w; w.x = pk2(p[0], p[stride]); w.y = pk2(p[2 * stride], p[3 * stride]); w.z = pk2(p[4 * stride], p[5 * stride]); w.w = pk2(p[6 * stride], p[7 * stride]); return __builtin_bit_cast(bf16x8, w);
}
constexpr int ACT_ST = 464;
__device__ __forceinline__ void prepare_phase(Frame& F, const PrepIn& P, const bf16* Z, bf16* PR, bf16* PM, float* DT, float* BONUS, bf16* GATE, bf16* ZG) {
    LAS unsigned short* zs = (LAS unsigned short*)F.lds;
    LAS unsigned char* actb = F.lds + 24576;
    LAS float* cst = (LAS float*)(F.lds + 24576 + 16 * ACT_ST);
    const int tid = F.tid, lane = F.lane, fr = lane & 15, fq = lane >> 4, w = F.wave;
    const int hf = F.bid & 1, wl = w & 3, hd = 4 * hf + wl;
    __syncthreads();
    if (tid < 256) { const int c = 256 * hf + tid; cst[tid] = P.rw_w0[c]; cst[256 + tid] = P.rw_w0[512 + c]; cst[512 + tid] = P.rw_a0[c]; cst[768 + tid] = P.rw_a0[512 + c];
      cst[1024 + tid] = P.rw_k_k[c]; cst[1280 + tid] = P.rw_k_a[c]; cst[1536 + tid] = P.rw_r_k[c]; cst[1792 + tid] = P.rw_r_k[512 + c]; }
    bf16x8 W[16];
#pragma unroll
    for (int cb = 0; cb < 4; ++cb) { const int c = 64 * hd + 4 * fr + cb;
        if (w < 4) { W[cb] = gather8(P.rw_w_up + (size_t)(8 * fq) * 512 + c, 512); W[4 + cb] = gather8(P.rw_w_up + (size_t)(32 + 8 * fq) * 512 + c, 512);
                     W[8 + cb] = gather8(P.rw_a_up + (size_t)(8 * fq) * 512 + c, 512); W[12 + cb] = gather8(P.rw_a_up + (size_t)(32 + 8 * fq) * 512 + c, 512); }
        else { W[cb] = gather8(P.rw_g_up + (size_t)(8 * fq) * 512 + c, 512); W[4 + cb] = gather8(P.rw_g_up + (size_t)(32 + 8 * fq) * 512 + c, 512); W[8 + cb] = gather8(P.rw_g_up + (size_t)(64 + 8 * fq) * 512 + c, 512); W[12 + cb] = W[cb]; } }
    const int col0 = (tid < 256) ? (256 * hf + tid) : (512 + 256 * hf + tid - 256), col1 = (tid < 256) ? (1024 + 256 * hf + tid) : ((tid < 480) ? (1536 + tid - 256) : 1536);
    const int zo0 = tid, zo1 = 512 + (tid & 255);
    const float mu00 = P.rw_mu[col0], mu10 = P.rw_mu[RWC + col0], mu01 = P.rw_mu[col1], mu11 = P.rw_mu[RWC + col1];
    float cw[5];
#pragma unroll
    for (int k = 0; k < 5; ++k) cw[k] = P.conv_w[k * 1024 + 512 * hf + tid];
    const float cbv = P.conv_b[512 * hf + tid], dtb = P.dt_bias[tid & 15];
    __syncthreads();

#ifndef PREP_REPS
#define PREP_REPS 1
#endif
    for (int rb_ = F.bid >> 1; rb_ < (M_ALL / 16) * PREP_REPS; rb_ += (F.G >> 1)) {
        const int rb = rb_ % (M_ALL / 16); const int g0 = rb * 16; const bool isctx = g0 < M_CTX; const int T = isctx ? CTXL : SEQ; const int t0 = isctx ? (g0 & (CTXL - 1)) : ((g0 - M_CTX) & (SEQ - 1));
        const bf16* zb = Z + (size_t)g0 * ZLD;
        const bool hp = t0 > 0, hn = (t0 + 16 < T), hp2 = t0 >= 2, hn2 = (t0 + 17 < T);
        float z0[18], z1[18], x[20];
        const int ccol = RWC + 512 + 512 * hf + tid;
#pragma unroll
        for (int i = 0; i < 18; ++i) { const bool ok = (i == 0) ? hp : ((i == 17) ? hn : true); z0[i] = ok ? ldbf(zb + (ptrdiff_t)(i - 1) * ZLD + col0) : 0.f; z1[i] = ok ? ldbf(zb + (ptrdiff_t)(i - 1) * ZLD + col1) : 0.f; }
#pragma unroll
        for (int i = 0; i < 20; ++i) { const bool ok = (i == 0) ? hp2 : (i == 1) ? hp : (i == 18) ? hn : (i == 19) ? hn2 : true; x[i] = ok ? ldbf(zb + (ptrdiff_t)(i - 2) * ZLD + ccol) : 0.f; }
#pragma unroll
        for (int tb = 0; tb < 16; ++tb) zs[tb * 768 + zo0] = (unsigned short)f2bf(z0[tb + 1] + mu00 * (z0[tb] - z0[tb + 1]) + mu10 * (z0[tb + 2] - z0[tb + 1]));
        {
            const int a = tid - 256;
#pragma unroll
            for (int tb = 0; tb < 16; ++tb) {
                const float zsft = z1[tb + 1] + mu01 * (z1[tb] - z1[tb + 1]) + mu11 * (z1[tb + 2] - z1[tb + 1]);
                if (tid < 256) zs[tb * 768 + zo1] = (unsigned short)f2bf(zsft);
                else if (tid < 480) { const float sg = sigm((a < 64) ? 2.f * zsft : zsft); const float av = (a < 64) ? (2.f * sg - 1.f) : ((a < 128) ? zsft : sg);
                    *(LAS unsigned short*)(actb + tb * ACT_ST + a * 2) = (unsigned short)f2bf(av); }
            }
        }
#pragma unroll
        for (int tb = 0; tb < 16; ++tb) {
            float y = cbv + cw[0] * x[tb] + cw[1] * x[tb + 1] + cw[2] * x[tb + 2] + cw[3] * x[tb + 3] + cw[4] * x[tb + 4];
            y = y * sigm(y);
            PM[(size_t)(g0 + tb) * 1024 + 512 * hf + tid] = (bf16)f2bf(y);
        }
        { const int tb = tid >> 5, cc = tid & 31;
          *(GAS v4u*)(ZG + (size_t)(g0 + tb) * 512 + 256 * hf + cc * 8) = *(const GAS v4u*)(zb + (size_t)tb * ZLD + RWC + 256 * hf + cc * 8); }
        if (hf == 0 && tid < 256) { const int tb = tid >> 4, cc = tid & 15; const float x = ldbf(zb + (size_t)tb * ZLD + RWC + 1536 + cc) + dtb; DT[(size_t)(g0 + tb) * 16 + cc] = (x > 20.f) ? x : log1pf(__expf(x)); }
        __syncthreads();
        const f32x4 zero = {0.f, 0.f, 0.f, 0.f};
        const int cl0 = 64 * wl + 4 * fr;
        if (w < 4) {
            bf16x8 Af[4];
#pragma unroll
            for (int kb = 0; kb < 4; ++kb) Af[kb] = *(const LAS bf16x8*)(actb + fr * ACT_ST + kb * 64 + fq * 16);
            f32x4 lw0[4], lw1[4], ia0[4], ia1[4];
#pragma unroll
            for (int cb = 0; cb < 4; ++cb) {
                lw0[cb] = __builtin_amdgcn_mfma_f32_16x16x32_bf16(Af[0], W[cb], zero, 0, 0, 0); lw1[cb] = __builtin_amdgcn_mfma_f32_16x16x32_bf16(Af[1], W[4 + cb], zero, 0, 0, 0);
                ia0[cb] = __builtin_amdgcn_mfma_f32_16x16x32_bf16(Af[2], W[8 + cb], zero, 0, 0, 0); ia1[cb] = __builtin_amdgcn_mfma_f32_16x16x32_bf16(Af[3], W[12 + cb], zero, 0, 0, 0);
            }
            const f32x4 w00 = *(const LAS f32x4*)(cst + cl0), w01 = *(const LAS f32x4*)(cst + 256 + cl0), a00 = *(const LAS f32x4*)(cst + 512 + cl0), a01 = *(const LAS f32x4*)(cst + 768 + cl0);
            const f32x4 kkc = *(const LAS f32x4*)(cst + 1024 + cl0), kac = *(const LAS f32x4*)(cst + 1280 + cl0), rk0 = *(const LAS f32x4*)(cst + 1536 + cl0), rk1 = *(const LAS f32x4*)(cst + 1792 + cl0);
#pragma unroll
            for (int e = 0; e < 4; ++e) {
                const int tok = 4 * fq + e; const size_t g = (size_t)(g0 + tok);
                const v2u ru = *(const LAS v2u*)(zs + tok * 768 + cl0), ku = *(const LAS v2u*)(zs + tok * 768 + 256 + cl0), vu = *(const LAS v2u*)(zs + tok * 768 + 512 + cl0);
                const f32x4 r = {bflo(ru.x), bfhi(ru.x), bflo(ru.y), bfhi(ru.y)}, k = {bflo(ku.x), bfhi(ku.x), bflo(ku.y), bfhi(ku.y)};
                const f32x4 kks = k * kkc;
                const float ssq = sum16((kks[0] * kks[0] + kks[1] * kks[1]) + (kks[2] * kks[2] + kks[3] * kks[3]));
                const float rn = __builtin_amdgcn_rcpf(fmaxf(sqrtf(ssq), 1e-12f));
                float ee0[4], ee1[4], kd0[4], kd1[4], bb0[4], bb1[4], na[4]; float bon = 0.f;
#pragma unroll
                for (int cb = 0; cb < 4; ++cb) {
                    ee0[cb] = 0.60653066f * sigm(w00[cb] + lw0[cb][e]); ee1[cb] = 0.60653066f * sigm(w01[cb] + lw1[cb][e]);
                    const float ic0 = sigm(a00[cb] + ia0[cb][e]), ic1 = sigm(a01[cb] + ia1[cb][e]);
                    const float kkn = kks[cb] * rn;
                    kd0[cb] = k[cb] * (1.f + (ic0 - 1.f) * kac[cb]); kd1[cb] = k[cb] * (1.f + (ic1 - 1.f) * kac[cb]);
                    bon += r[cb] * (kd0[cb] * rk0[cb] + kd1[cb] * rk1[cb]);
                    na[cb] = -kkn; bb0[cb] = kkn * ic0; bb1[cb] = kkn * ic1;
                }
                bon = sum16(bon); if (fr == 0) BONUS[g * 8 + hd] = bon;
                bf16* pr = PR + g * PRV + 256 * hf + cl0;
                *(GAS v2u*)(pr) = ru; *(GAS v2u*)(pr + 512) = vu;
                v2u o;
                o.x = pk2(na[0], na[1]); o.y = pk2(na[2], na[3]); *(GAS v2u*)(pr + 1024) = o;
                o.x = pk2(ee0[0], ee0[1]); o.y = pk2(ee0[2], ee0[3]); *(GAS v2u*)(pr + 1536) = o;
                o.x = pk2(kd0[0], kd0[1]); o.y = pk2(kd0[2], kd0[3]); *(GAS v2u*)(pr + 2048) = o;
                o.x = pk2(bb0[0], bb0[1]); o.y = pk2(bb0[2], bb0[3]); *(GAS v2u*)(pr + 2560) = o;
                o.x = pk2(ee1[0], ee1[1]); o.y = pk2(ee1[2], ee1[3]); *(GAS v2u*)(pr + 3072) = o;
                o.x = pk2(kd1[0], kd1[1]); o.y = pk2(kd1[2], kd1[3]); *(GAS v2u*)(pr + 3584) = o;
                o.x = pk2(bb1[0], bb1[1]); o.y = pk2(bb1[2], bb1[3]); *(GAS v2u*)(pr + 4096) = o;
            }
        } else {
            bf16x8 Af[3];
#pragma unroll
            for (int kb = 0; kb < 3; ++kb) Af[kb] = *(const LAS bf16x8*)(actb + fr * ACT_ST + (4 + kb) * 64 + fq * 16);
            f32x4 gt[4];
#pragma unroll
            for (int cb = 0; cb < 4; ++cb) {
                gt[cb] = __builtin_amdgcn_mfma_f32_16x16x32_bf16(Af[0], W[cb], zero, 0, 0, 0);
                gt[cb] = __builtin_amdgcn_mfma_f32_16x16x32_bf16(Af[1], W[4 + cb], gt[cb], 0, 0, 0); gt[cb] = __builtin_amdgcn_mfma_f32_16x16x32_bf16(Af[2], W[8 + cb], gt[cb], 0, 0, 0);
            }
#pragma unroll
            for (int e = 0; e < 4; ++e) { v2u o; o.x = pk2(gt[0][e], gt[1][e]); o.y = pk2(gt[2][e], gt[3][e]); *(GAS v2u*)(GATE + (size_t)(g0 + 4 * fq + e) * 512 + 256 * hf + cl0) = o; }
        }
        __syncthreads();
    }
}

template <int SH> __device__ __forceinline__ float dpp_shr(float x) { return __int_as_float(__builtin_amdgcn_update_dpp(0, __float_as_int(x), 0x110 + SH, 0xF, 0xF, true)); }
__device__ __forceinline__ int scan_row16(int c, int t, int b, int d) {
    const int st = c * 16 + t; const int seg = (st >= CTXL) ? 1 : 0; const int T = seg ? SEQ : CTXL; const int sl = st - seg * CTXL;
    return (seg ? (M_CTX + b * SEQ) : b * CTXL) + (d ? (T - 1 - sl) : sl);
}
__device__ __forceinline__ v4u scale8(const v4u u, float s) {
    v4u o; o.x = pk2(bflo(u.x) * s, bfhi(u.x) * s); o.y = pk2(bflo(u.y) * s, bfhi(u.y) * s); o.z = pk2(bflo(u.z) * s, bfhi(u.z) * s); o.w = pk2(bflo(u.w) * s, bfhi(u.w) * s); return o;
}
__device__ __forceinline__ bf16x8 pack4z(const f32x4& a) { v4u w; w.x = pk2(a[0], a[1]); w.y = pk2(a[2], a[3]); w.z = 0u; w.w = 0u; return __builtin_bit_cast(bf16x8, w); }
__device__ __forceinline__ bf16x8 tr4z(const LAS unsigned char* p) {
    const v2u t = __builtin_bit_cast(v2u, __builtin_amdgcn_ds_read_tr16_b64_v4i16((LAS v4i16_t*)p)); v4u w; w.x = t.x; w.y = t.y; w.z = 0u; w.w = 0u; return __builtin_bit_cast(bf16x8, w);
}
__device__ __forceinline__ bf16x8 cat44(const v2u a, const v2u b) { v4u w; w.x = a.x; w.y = a.y; w.z = b.x; w.w = b.y; return __builtin_bit_cast(bf16x8, w); }
constexpr int NCH16 = (CTXL + SEQ) / 16;
__device__ __forceinline__ f32x4 mm16(const f32x4& xT_c, const f32x4& y_c, const f32x4& acc) {
    return __builtin_amdgcn_mfma_f32_16x16x32_bf16(pack4z(xT_c), pack4z(y_c), acc, 0, 0, 0);
}
constexpr int RING_FLAGS = 122880;
constexpr int NSLOT = 6;
__device__ __forceinline__ unsigned lds_flag_ld(volatile LAS unsigned* p) { return (unsigned)__builtin_amdgcn_readfirstlane((int)*p); }
__device__ __forceinline__ void ring_wait_full(volatile LAS unsigned* fl, int s, int c) { while (lds_flag_ld(fl + s) != (unsigned)(c + 1)) __builtin_amdgcn_s_sleep(1); asm volatile("" ::: "memory"); }
__device__ __forceinline__ void ring_wait_free(volatile LAS unsigned* fl, int s, int c, int nslot = NSLOT, unsigned ncons = 4u) { const unsigned want = ncons * (unsigned)(c / nslot); while (lds_flag_ld(fl + 8 + s) < want) __builtin_amdgcn_s_sleep(1); asm volatile("" ::: "memory"); }
__device__ __forceinline__ void ring_set_full(volatile LAS unsigned* fl, int s, int c, int lane) { asm volatile("s_waitcnt lgkmcnt(0)" ::: "memory"); if (lane == 0) fl[s] = (unsigned)(c + 1); }
__device__ __forceinline__ void ring_done(volatile LAS unsigned* fl, int s, int lane) { asm volatile("s_waitcnt lgkmcnt(0)" ::: "memory"); if (lane == 0) __hip_atomic_fetch_add((LAS unsigned*)(fl + 8 + s), 1u, __ATOMIC_RELAXED, __HIP_MEMORY_SCOPE_WORKGROUP); }

constexpr int RST = 144, RIMG = 16 * RST;
constexpr int RW_SLOT = 18432;
__device__ __forceinline__ void rwkv_block(Frame& F, int unit, const bf16* PR, bf16* YRW) {
    const int d = unit & 1, h = (unit >> 1) & 7, b = unit >> 4;
    const int lane = F.lane, fr = lane & 15, fq = lane >> 4, tq = (lane & 15) >> 2, tp = lane & 3;
    volatile LAS unsigned* fl = (volatile LAS unsigned*)(F.lds + RING_FLAGS);
    __syncthreads();
    if (F.tid < 16) fl[F.tid] = 0u;
    __syncthreads();
    if (F.wave >= 4) {
        const int p = F.wave - 4;
        const int ve = (3 + 3 * d) * 512, vb = (5 + 3 * d) * 512, vk = (4 + 3 * d) * 512;
        bf16x8 Ltri; { v4u w; w.x = ((4 * fq + 0 <= fr) ? 0x3F80u : 0u) | ((4 * fq + 1 <= fr) ? 0x3F800000u : 0u); w.y = ((4 * fq + 2 <= fr) ? 0x3F80u : 0u) | ((4 * fq + 3 <= fr) ? 0x3F800000u : 0u); w.z = 0u; w.w = 0u; Ltri = __builtin_bit_cast(bf16x8, w); }
        v4u rE[2], rA[2], rB[2], rK[2], rR[2], rV[2];
#define RW_LOAD(c_) do { \
        _Pragma("unroll") for (int i = 0; i < 2; ++i) { const int id = lane + 64 * i; const bf16* src = PR + (size_t)scan_row16((c_), id >> 3, b, d) * PRV + h * 64 + (id & 7) * 8; \
            rE[i] = *(const GAS v4u*)(src + ve); rA[i] = *(const GAS v4u*)(src + 1024); rB[i] = *(const GAS v4u*)(src + vb); rK[i] = *(const GAS v4u*)(src + vk); rR[i] = *(const GAS v4u*)(src); rV[i] = *(const GAS v4u*)(src + 512); } } while (0)
        RW_LOAD(p);
        for (int c = p; c < NCH16; c += 4) {
            const int s = c % NSLOT;
            LAS unsigned char* sb = F.lds + s * RW_SLOT;
            LAS unsigned char* RE = sb; LAS unsigned char* RA = sb + RIMG; LAS unsigned char* RB = sb + 2 * RIMG; LAS unsigned char* RK = sb + 3 * RIMG; LAS unsigned char* RR = sb + 4 * RIMG;
            LAS unsigned char* RV = sb + 5 * RIMG; LAS unsigned char* FRG = sb + 6 * RIMG; LAS float* GC = (LAS float*)(sb + 6 * RIMG + 4096);
            ring_wait_free(fl, s, c);
#pragma unroll
            for (int i = 0; i < 2; ++i) { const int id = lane + 64 * i; const int o = (id >> 3) * RST + (id & 7) * 16;
                *(LAS v4u*)(RE + o) = rE[i]; *(LAS v4u*)(RA + o) = rA[i]; *(LAS v4u*)(RB + o) = rB[i]; *(LAS v4u*)(RK + o) = rK[i]; *(LAS v4u*)(RR + o) = rR[i]; *(LAS v4u*)(RV + o) = rV[i]; }
            if (c + 4 < NCH16) RW_LOAD(c + 4);
            asm volatile("s_waitcnt lgkmcnt(0)" ::: "memory");
#pragma unroll
            for (int jb = 0; jb < 4; ++jb) {
                const int tro = (4 * fq + tq) * RST + (16 * jb + 4 * tp) * 2;
                const v2u eu = __builtin_bit_cast(v2u, __builtin_amdgcn_ds_read_tr16_b64_v4i16((LAS v4i16_t*)(RE + tro)));
                const v2u au = __builtin_bit_cast(v2u, __builtin_amdgcn_ds_read_tr16_b64_v4i16((LAS v4i16_t*)(RA + tro)));
                const v2u bu = __builtin_bit_cast(v2u, __builtin_amdgcn_ds_read_tr16_b64_v4i16((LAS v4i16_t*)(RB + tro)));
                const v2u ku = __builtin_bit_cast(v2u, __builtin_amdgcn_ds_read_tr16_b64_v4i16((LAS v4i16_t*)(RK + tro)));
                const v2u ru = __builtin_bit_cast(v2u, __builtin_amdgcn_ds_read_tr16_b64_v4i16((LAS v4i16_t*)(RR + tro)));
                v4u ew; ew.x = eu.x; ew.y = eu.y; ew.z = 0u; ew.w = 0u;
                const f32x4 cum = __builtin_amdgcn_mfma_f32_16x16x32_bf16(Ltri, __builtin_bit_cast(bf16x8, ew), (f32x4){0.f, 0.f, 0.f, 0.f}, 0, 0, 0);
                const float ev[4] = {bflo(eu.x), bfhi(eu.x), bflo(eu.y), bfhi(eu.y)}, av[4] = {bflo(au.x), bfhi(au.x), bflo(au.y), bfhi(au.y)}, bv[4] = {bflo(bu.x), bfhi(bu.x), bflo(bu.y), bfhi(bu.y)};
                const float kv[4] = {bflo(ku.x), bfhi(ku.x), bflo(ku.y), bfhi(ku.y)}, rv[4] = {bflo(ru.x), bfhi(ru.x), bflo(ru.y), bfhi(ru.y)};
#pragma unroll
                for (int e = 0; e < 4; ++e) {
                    const float G = __expf(-cum[e]), Gi = __expf(cum[e]), Gx = __expf(ev[e] - cum[e]);
                    const int o = (4 * fq + e) * RST + (16 * jb + fr) * 2;
                    const unsigned ab = pk2(av[e] * Gx, bv[e] * Gi), kr = pk2(kv[e] * Gi, rv[e] * G);
                    *(LAS unsigned short*)(RA + o) = (unsigned short)ab; *(LAS unsigned short*)(RB + o) = (unsigned short)(ab >> 16);
                    *(LAS unsigned short*)(RK + o) = (unsigned short)kr; *(LAS unsigned short*)(RR + o) = (unsigned short)(kr >> 16);
                    if (e == 3 && fq == 3) GC[16 * jb + fr] = G;
                }
            }
            asm volatile("s_waitcnt lgkmcnt(0)" ::: "memory");
            f32x4 aba = {0.f, 0.f, 0.f, 0.f}, aka = aba, abr = aba, akr = aba, abaT = aba;
#pragma unroll
            for (int kb = 0; kb < 2; ++kb) {
                const int o = fr * RST + kb * 64 + fq * 16;
                const bf16x8 fb = *(const LAS bf16x8*)(RB + o), fk = *(const LAS bf16x8*)(RK + o), fa = *(const LAS bf16x8*)(RA + o), frr = *(const LAS bf16x8*)(RR + o);
                aba = __builtin_amdgcn_mfma_f32_16x16x32_bf16(fb, fa, aba, 0, 0, 0); aka = __builtin_amdgcn_mfma_f32_16x16x32_bf16(fk, fa, aka, 0, 0, 0);
                abr = __builtin_amdgcn_mfma_f32_16x16x32_bf16(fb, frr, abr, 0, 0, 0); akr = __builtin_amdgcn_mfma_f32_16x16x32_bf16(fk, frr, akr, 0, 0, 0);
                abaT = __builtin_amdgcn_mfma_f32_16x16x32_bf16(fa, fb, abaT, 0, 0, 0);
            }
            f32x4 idc;
#pragma unroll
            for (int e = 0; e < 4; ++e) { const int row = 4 * fq + e;
                aba[e] = (row < fr) ? aba[e] : 0.f; aka[e] = (row < fr) ? aka[e] : 0.f; abr[e] = (row <= fr) ? abr[e] : 0.f; akr[e] = (row <= fr) ? akr[e] : 0.f;
                abaT[e] = (fr < row) ? abaT[e] : 0.f; idc[e] = (row == fr) ? 1.f : 0.f; }
            f32x4 t_c = idc + aba, t_T = idc + abaT;
            f32x4 p_c = mm16(abaT, aba, (f32x4){0.f, 0.f, 0.f, 0.f}), p_T = mm16(aba, abaT, (f32x4){0.f, 0.f, 0.f, 0.f});
            { const f32x4 n_c = mm16(t_T, p_c, t_c), n_T = mm16(p_c, t_T, t_T); t_c = n_c; t_T = n_T; }
            { const f32x4 q_c = mm16(p_T, p_c, (f32x4){0.f, 0.f, 0.f, 0.f}), q_T = mm16(p_c, p_T, (f32x4){0.f, 0.f, 0.f, 0.f}); p_c = q_c; p_T = q_T; }
            { const f32x4 n_c = mm16(t_T, p_c, t_c), n_T = mm16(p_c, t_T, t_T); t_c = n_c; t_T = n_T; }
            { const f32x4 q_c = mm16(p_T, p_c, (f32x4){0.f, 0.f, 0.f, 0.f}); p_c = q_c; }
            const f32x4 tm_c = mm16(t_T, p_c, t_c);
            *(LAS bf16x8*)(FRG + lane * 16) = pack4z(tm_c); *(LAS bf16x8*)(FRG + 1024 + lane * 16) = pack4z(aka);
            *(LAS bf16x8*)(FRG + 2048 + lane * 16) = pack4z(abr); *(LAS bf16x8*)(FRG + 3072 + lane * 16) = pack4z(akr);
            ring_set_full(fl, s, c, lane);
        }
#undef RW_LOAD
    } else {
        const int q = F.wave;
        __builtin_amdgcn_s_setprio(3);
        bf16* yout = YRW + (size_t)d * M_ALL * 512 + h * 64 + 16 * q;
        f32x4 T[4];
#pragma unroll
        for (int jb = 0; jb < 4; ++jb) T[jb] = (f32x4){0.f, 0.f, 0.f, 0.f};
        for (int c = 0; c < NCH16; ++c) {
            const int s = c % NSLOT;
            LAS unsigned char* sb = F.lds + s * RW_SLOT;
            LAS unsigned char* RA = sb + RIMG; LAS unsigned char* RB = sb + 2 * RIMG; LAS unsigned char* RK = sb + 3 * RIMG; LAS unsigned char* RR = sb + 4 * RIMG;
            LAS unsigned char* RV = sb + 5 * RIMG; LAS unsigned char* FRG = sb + 6 * RIMG; LAS float* GC = (LAS float*)(sb + 6 * RIMG + 4096);
            ring_wait_full(fl, s, c);
            const bf16x8 tmA = *(const LAS bf16x8*)(FRG + lane * 16), akaA = *(const LAS bf16x8*)(FRG + 1024 + lane * 16), abrA = *(const LAS bf16x8*)(FRG + 2048 + lane * 16), akrA = *(const LAS bf16x8*)(FRG + 3072 + lane * 16);
            const bf16x8 Vf = tr4z(RV + (4 * fq + tq) * RST + (16 * q + 4 * tp) * 2);
            f32x4 x = {0.f, 0.f, 0.f, 0.f}, y = {0.f, 0.f, 0.f, 0.f};
#pragma unroll
            for (int jp = 0; jp < 2; ++jp) {
                const int o = fr * RST + (32 * jp + 4 * fq) * 2;
                const bf16x8 tf = pack8(T[2 * jp], T[2 * jp + 1]);
                x = __builtin_amdgcn_mfma_f32_16x16x32_bf16(cat44(*(const LAS v2u*)(RA + o), *(const LAS v2u*)(RA + o + 32)), tf, x, 0, 0, 0);
                y = __builtin_amdgcn_mfma_f32_16x16x32_bf16(cat44(*(const LAS v2u*)(RR + o), *(const LAS v2u*)(RR + o + 32)), tf, y, 0, 0, 0);
            }
            x = __builtin_amdgcn_mfma_f32_16x16x32_bf16(akaA, Vf, x, 0, 0, 0);
            const f32x4 ut = __builtin_amdgcn_mfma_f32_16x16x32_bf16(tmA, pack4z(x), (f32x4){0.f, 0.f, 0.f, 0.f}, 0, 0, 0);
            y = __builtin_amdgcn_mfma_f32_16x16x32_bf16(abrA, pack4z(ut), y, 0, 0, 0);
            y = __builtin_amdgcn_mfma_f32_16x16x32_bf16(akrA, Vf, y, 0, 0, 0);
            bf16x8 UV; { const v4u vw = __builtin_bit_cast(v4u, Vf); v4u w; w.x = pk2(ut[0], ut[1]); w.y = pk2(ut[2], ut[3]); w.z = vw.x; w.w = vw.y; UV = __builtin_bit_cast(bf16x8, w); }
#pragma unroll
            for (int jb = 0; jb < 4; ++jb) {
                const int tro = (4 * fq + tq) * RST + (16 * jb + 4 * tp) * 2;
                const v2u bt = __builtin_bit_cast(v2u, __builtin_amdgcn_ds_read_tr16_b64_v4i16((LAS v4i16_t*)(RB + tro))), kt = __builtin_bit_cast(v2u, __builtin_amdgcn_ds_read_tr16_b64_v4i16((LAS v4i16_t*)(RK + tro)));
                const f32x4 gc = *(const LAS f32x4*)(GC + 16 * jb + 4 * fq);
                T[jb] = __builtin_amdgcn_mfma_f32_16x16x32_bf16(cat44(bt, kt), UV, T[jb], 0, 0, 0); T[jb] = T[jb] * gc;
            }
            ring_done(fl, s, lane);
            { const int row0 = scan_row16(c, 0, b, d), stp = d ? -1 : 1;
#pragma unroll
              for (int e = 0; e < 4; ++e) yout[(size_t)(row0 + stp * (4 * fq + e)) * 512 + fr] = (bf16)f2bf(y[e]); }
        }
        __builtin_amdgcn_s_setprio(0);
    }
}

constexpr int MST = 272, MIMG = 16 * MST;
constexpr int MB_NSLOT = 5;
constexpr int MB_SLOT = 21504;
__device__ __forceinline__ void mamba_block(Frame& F, int unit, const bf16* PM, const float* DT, const float* a_log, bf16* YMB) {
    const int d = unit & 1, h = (unit >> 1) & 7, b = unit >> 4, grp = h >> 2;
    const int lane = F.lane, fr = lane & 15, fq = lane >> 4, tq = (lane & 15) >> 2, tp = lane & 3;
    volatile LAS unsigned* fl = (volatile LAS unsigned*)(F.lds + RING_FLAGS);
    __syncthreads();
    if (F.tid < 16) fl[F.tid] = 0u;
    __syncthreads();
    if (F.wave >= 4) {
        const int p = F.wave - 4;
        const float a_neg = -__expf(a_log[d * 8 + h]);
        v4u rB[4], rC[4], rX[2]; float rdt;
#define MB_LOAD(c_) do { \
        _Pragma("unroll") for (int i = 0; i < 4; ++i) { const int t = (lane >> 4) + 4 * i; const bf16* src = PM + (size_t)scan_row16((c_), t, b, d) * 1024 + 512 + grp * 128 + (lane & 15) * 8; rB[i] = *(const GAS v4u*)src; rC[i] = *(const GAS v4u*)(src + 256); } \
        _Pragma("unroll") for (int i = 0; i < 2; ++i) { const int id = lane + 64 * i; rX[i] = *(const GAS v4u*)(PM + (size_t)scan_row16((c_), id >> 3, b, d) * 1024 + h * 64 + (id & 7) * 8); } \
        rdt = DT[(size_t)scan_row16((c_), lane & 15, b, d) * 16 + d * 8 + h]; } while (0)
        MB_LOAD(p);
        for (int c = p; c < NCH16; c += 4) {
            const int s = c % MB_NSLOT;
            LAS unsigned char* sb = F.lds + s * MB_SLOT;
            LAS unsigned char* BR = sb; LAS unsigned char* CR = sb + MIMG; LAS unsigned char* RT = sb + 2 * MIMG; LAS unsigned char* KH = sb + 3 * MIMG; LAS unsigned char* VX = sb + 4 * MIMG;
            LAS unsigned char* FRG = sb + 4 * MIMG + RIMG; LAS float* scal = (LAS float*)(sb + 4 * MIMG + RIMG + 1024);
            ring_wait_free(fl, s, c, MB_NSLOT);
            float cs = rdt * a_neg;
            cs += dpp_shr<1>(cs); cs += dpp_shr<2>(cs); cs += dpp_shr<4>(cs); cs += dpp_shr<8>(cs);
            const float cse = __int_as_float(__builtin_amdgcn_readlane(__float_as_int(cs), 15));
            if (lane < 16) { scal[16 + lane] = cs; scal[32 + lane] = __expf(cs); scal[48 + lane] = rdt; scal[64 + lane] = __expf(cse - cs); }
            if (lane == 0) scal[0] = __expf(cse);
            asm volatile("s_waitcnt lgkmcnt(0)" ::: "memory");
#pragma unroll
            for (int i = 0; i < 4; ++i) { const int t = (lane >> 4) + 4 * i; const float sk = scal[64 + t], sr = scal[32 + t]; const int o = t * MST + (lane & 15) * 16;
                *(LAS v4u*)(BR + o) = rB[i]; *(LAS v4u*)(CR + o) = rC[i]; *(LAS v4u*)(KH + o) = scale8(rB[i], sk); *(LAS v4u*)(RT + o) = scale8(rC[i], sr); }
#pragma unroll
            for (int i = 0; i < 2; ++i) { const int id = lane + 64 * i; const int t = id >> 3; *(LAS v4u*)(VX + t * RST + (id & 7) * 16) = scale8(rX[i], scal[48 + t]); }
            if (c + 4 < NCH16) MB_LOAD(c + 4);
            asm volatile("s_waitcnt lgkmcnt(0)" ::: "memory");
            f32x4 akr = {0.f, 0.f, 0.f, 0.f};
#pragma unroll
            for (int kb = 0; kb < 4; ++kb) akr = __builtin_amdgcn_mfma_f32_16x16x32_bf16(*(const LAS bf16x8*)(BR + fr * MST + kb * 64 + fq * 16), *(const LAS bf16x8*)(CR + fr * MST + kb * 64 + fq * 16), akr, 0, 0, 0);
            const float cst = scal[16 + fr]; const f32x4 css = *(const LAS f32x4*)(scal + 16 + 4 * fq);
#pragma unroll
            for (int e = 0; e < 4; ++e) akr[e] = (4 * fq + e <= fr) ? akr[e] * __expf(cst - css[e]) : 0.f;
            *(LAS bf16x8*)(FRG + lane * 16) = pack4z(akr);
            ring_set_full(fl, s, c, lane);
        }
#undef MB_LOAD
    } else {
        const int q = F.wave;
        __builtin_amdgcn_s_setprio(3);
        bf16* yout = YMB + (size_t)d * M_ALL * 512 + h * 64 + 16 * q;
        unsigned long long prof_wait = 0ull; (void)prof_wait;
        f32x4 T[8];
#pragma unroll
        for (int jb = 0; jb < 8; ++jb) T[jb] = (f32x4){0.f, 0.f, 0.f, 0.f};
        for (int c = 0; c < NCH16; ++c) {
            const int s = c % MB_NSLOT;
            LAS unsigned char* sb = F.lds + s * MB_SLOT;
            LAS unsigned char* RT = sb + 2 * MIMG; LAS unsigned char* KH = sb + 3 * MIMG; LAS unsigned char* VX = sb + 4 * MIMG;
            LAS unsigned char* FRG = sb + 4 * MIMG + RIMG; LAS float* scal = (LAS float*)(sb + 4 * MIMG + RIMG + 1024);
#ifdef PROF_MBWAIT
            const unsigned long long tw0_ = __builtin_amdgcn_s_memrealtime();
#endif
            ring_wait_full(fl, s, c);
#ifdef PROF_MBWAIT
            prof_wait += __builtin_amdgcn_s_memrealtime() - tw0_;
#endif
#ifdef PROF_MBSEG
            unsigned long long ts0_ = __builtin_amdgcn_s_memrealtime();
#endif
            const bf16x8 akrA = *(const LAS bf16x8*)(FRG + lane * 16); const float gC = scal[0];
            const bf16x8 Vf = tr4z(VX + (4 * fq + tq) * RST + (16 * q + 4 * tp) * 2);
            f32x4 ya = {0.f, 0.f, 0.f, 0.f}, yb = __builtin_amdgcn_mfma_f32_16x16x32_bf16(akrA, Vf, (f32x4){0.f, 0.f, 0.f, 0.f}, 0, 0, 0);
#pragma unroll
            for (int jp = 0; jp < 4; ++jp) {
                const LAS unsigned char* rp = RT + fr * MST + (32 * jp + 4 * fq) * 2;
                const bf16x8 ra = cat44(*(const LAS v2u*)rp, *(const LAS v2u*)(rp + 32)), tf = pack8(T[2 * jp], T[2 * jp + 1]);
                if (jp & 1) yb = __builtin_amdgcn_mfma_f32_16x16x32_bf16(ra, tf, yb, 0, 0, 0); else ya = __builtin_amdgcn_mfma_f32_16x16x32_bf16(ra, tf, ya, 0, 0, 0);
            }
            const f32x4 y = ya + yb;
#ifdef PROF_MBSEG
            asm volatile("" :: "v"(y)); { const unsigned long long t_ = __builtin_amdgcn_s_memrealtime(); if (PROF_MBSEG == 1) prof_wait += t_ - ts0_; ts0_ = t_; }
#endif
#ifdef MB_CONS2X
            { f32x4 yd = {0.f, 0.f, 0.f, 0.f};
#pragma unroll
              for (int jp = 0; jp < 4; ++jp) { const LAS unsigned char* rp = RT + fr * MST + (32 * jp + 4 * fq) * 2 + 8;
                  yd = __builtin_amdgcn_mfma_f32_16x16x32_bf16(cat44(*(const LAS v2u*)rp, *(const LAS v2u*)(rp + 32)), pack8(T[2 * jp] * 1.0001f, T[2 * jp + 1] * 1.0001f), yd, 0, 0, 0); }
              yd = __builtin_amdgcn_mfma_f32_16x16x32_bf16(akrA, Vf, yd, 0, 0, 0);
              asm volatile("" :: "v"(yd)); }
#endif
#pragma unroll
            for (int jb = 0; jb < 8; ++jb) T[jb] = __builtin_amdgcn_mfma_f32_16x16x32_bf16(tr4z(KH + (4 * fq + tq) * MST + (16 * jb + 4 * tp) * 2), Vf, T[jb] * gC, 0, 0, 0);
#ifdef PROF_MBSEG
            asm volatile("" :: "v"(T[0]), "v"(T[7])); { const unsigned long long t_ = __builtin_amdgcn_s_memrealtime(); if (PROF_MBSEG == 2) prof_wait += t_ - ts0_; ts0_ = t_; }
#endif
            ring_done(fl, s, lane);
#ifdef PROF_MBSEG
            { const unsigned long long t_ = __builtin_amdgcn_s_memrealtime(); if (PROF_MBSEG == 3) prof_wait += t_ - ts0_; ts0_ = t_; }
#endif
            { const int row0 = scan_row16(c, 0, b, d), stp = d ? -1 : 1;
#pragma unroll
              for (int e = 0; e < 4; ++e) yout[(size_t)(row0 + stp * (4 * fq + e)) * 512 + fr] = (bf16)f2bf(y[e]); }
#ifdef PROF_MBSEG
            { const unsigned long long t_ = __builtin_amdgcn_s_memrealtime(); if (PROF_MBSEG == 4) prof_wait += t_ - ts0_; ts0_ = t_; }
#endif
        }
#if defined(PROF_MBWAIT) || defined(PROF_MBSEG)
        if (F.bid == 128 && F.tid == 0) __hip_atomic_store(F.ctl + 2, __float_as_uint((float)prof_wait * 0.01f), RLX_AGENT);
#endif
        __builtin_amdgcn_s_setprio(0);
    }
}

struct FinIn { const float *gn_w, *gn_b, *mb_d, *mb_norm_w; };
__device__ __forceinline__ void finish_phase(Frame& F, const FinIn& P, const bf16* YRW, const bf16* YMB, const bf16* PR, const bf16* PM, const float* BONUS, const bf16* GATE, const bf16* ZG, bf16* A) {
    const int gw = F.bid * NWAVES + F.wave, NGW = F.G * NWAVES; const int c0 = F.lane * 8, head = F.lane >> 3;
    float gnw[8], gnb[8], nw[8];
#pragma unroll
    for (int i = 0; i < 8; ++i) { gnw[i] = P.gn_w[c0 + i]; gnb[i] = P.gn_b[c0 + i]; nw[i] = P.mb_norm_w[c0 + i]; }
    const float dd = P.mb_d[head];
    struct FinIn9 { v4u y0, y1, vv, gg, m0, m1, xx, zz; float bon; };
    FinIn9 cur, nxt;
#define FIN_FETCH(R_, g_) do { const size_t gs_ = (size_t)(g_); \
        R_.y0 = *(const GAS v4u*)(YRW + gs_ * 512 + c0); R_.y1 = *(const GAS v4u*)(YRW + (size_t)M_ALL * 512 + gs_ * 512 + c0); R_.vv = *(const GAS v4u*)(PR + gs_ * PRV + 512 + c0); R_.gg = *(const GAS v4u*)(GATE + gs_ * 512 + c0); \
        R_.m0 = *(const GAS v4u*)(YMB + gs_ * 512 + c0); R_.m1 = *(const GAS v4u*)(YMB + (size_t)M_ALL * 512 + gs_ * 512 + c0); R_.xx = *(const GAS v4u*)(PM + gs_ * 1024 + c0); R_.zz = *(const GAS v4u*)(ZG + gs_ * 512 + c0); \
        R_.bon = BONUS[gs_ * 8 + head]; } while (0)
    if (gw < M_ALL) FIN_FETCH(cur, gw);
    for (int g = gw; g < M_ALL; g += NGW) {
        const size_t gs = (size_t)g;
        if (g + NGW < M_ALL) FIN_FETCH(nxt, g + NGW);
        const v4u y0 = cur.y0, y1 = cur.y1, vv = cur.vv, gg = cur.gg, m0 = cur.m0, m1 = cur.m1, xx = cur.xx, zz = cur.zz; const float bon = cur.bon;
        cur = nxt;
        float y[8], vf[8], gf[8];
#pragma unroll
        for (int i = 0; i < 4; ++i) { y[2 * i] = bflo(y0[i]) + bflo(y1[i]); y[2 * i + 1] = bfhi(y0[i]) + bfhi(y1[i]); vf[2 * i] = bflo(vv[i]); vf[2 * i + 1] = bfhi(vv[i]); gf[2 * i] = bflo(gg[i]); gf[2 * i + 1] = bfhi(gg[i]); }
        float s = 0.f;
#pragma unroll
        for (int i = 0; i < 8; ++i) s += y[i];
        s = sum8(s);
        const float mu = s * (1.f / 64.f); float q = 0.f;
#pragma unroll
        for (int i = 0; i < 8; ++i) { y[i] -= mu; q += y[i] * y[i]; }
        q = sum8(q);
        const float rstd = rsqrtf(q * (1.f / 64.f) + 64e-5f);
        float o[8];
#pragma unroll
        for (int i = 0; i < 8; ++i) o[i] = ((y[i] * rstd) * gnw[i] + gnb[i] + bon * vf[i]) * gf[i];
        v4u w; w.x = pk2(o[0], o[1]); w.y = pk2(o[2], o[3]); w.z = pk2(o[4], o[5]); w.w = pk2(o[6], o[7]);
        *(GAS v4u*)(A + gs * 1024 + c0) = w;
        float ym[8]; float ss = 0.f;
#pragma unroll
        for (int i = 0; i < 4; ++i) {
            const float z0 = bflo(zz[i]), z1 = bfhi(zz[i]);
            ym[2 * i] = (bflo(m0[i]) + bflo(m1[i]) + dd * bflo(xx[i])) * (z0 * sigm(z0)); ym[2 * i + 1] = (bfhi(m0[i]) + bfhi(m1[i]) + dd * bfhi(xx[i])) * (z1 * sigm(z1));
            ss += ym[2 * i] * ym[2 * i] + ym[2 * i + 1] * ym[2 * i + 1];
        }
        ss = half_sum(ss, F.lane);
        const float rr = rsqrtf(ss * (1.f / 256.f) + 1e-6f);
        v4u w2; w2.x = pk2(ym[0] * rr * nw[0], ym[1] * rr * nw[1]); w2.y = pk2(ym[2] * rr * nw[2], ym[3] * rr * nw[3]); w2.z = pk2(ym[4] * rr * nw[4], ym[5] * rr * nw[5]); w2.w = pk2(ym[6] * rr * nw[6], ym[7] * rr * nw[7]);
        *(GAS v4u*)(A + gs * 1024 + 512 + c0) = w2;
    }
#undef FIN_FETCH
}

__device__ __forceinline__ bf16x8 tr2(const LAS unsigned char* p0, const LAS unsigned char* p1) {
    const s16x4 t0 = __builtin_bit_cast(s16x4, __builtin_amdgcn_ds_read_tr16_b64_v4i16((LAS v4i16_t*)p0));
    const s16x4 t1 = __builtin_bit_cast(s16x4, __builtin_amdgcn_ds_read_tr16_b64_v4i16((LAS v4i16_t*)p1));
    bf16x8 r; r[0] = t0[0]; r[1] = t0[1]; r[2] = t0[2]; r[3] = t0[3]; r[4] = t1[0]; r[5] = t1[1]; r[6] = t1[2]; r[7] = t1[3]; return r;
}
__device__ __forceinline__ int swz(int row, int chunk) { return row * 128 + ((chunk ^ (row & 7)) << 4); }
constexpr int AT_CTXK = 0, AT_CTXV = 32768, AT_VRING = 65536, AT_NSLOT = 9, AT_RPB = AT_VRING + AT_NSLOT * 8192;
__device__ __forceinline__ void attn_phase(Frame& F, const bf16* Q, const bf16* K, const bf16* V, const float* rpb, bf16* O) {
    LAS unsigned char* ctxK = F.lds + AT_CTXK; LAS unsigned char* ctxV = F.lds + AT_CTXV; LAS unsigned char* vring = F.lds + AT_VRING; LAS float* rp = (LAS float*)(F.lds + AT_RPB);
    const int lane = F.lane, fr = lane & 15, fq = lane >> 4, tq = (lane & 15) >> 2, tp = lane & 3;
#ifndef ATT_REPS
#define ATT_REPS 1
#endif
    const int avcu = (F.G % 8 == 0) ? (F.bid % 8) * (F.G / 8) + F.bid / 8 : F.bid;
    for (int u_ = avcu; u_ < 256 * ATT_REPS; u_ += F.G) {
        const int u = u_ & 255; const int bh = u >> 1, half = u & 1, b = bh >> 4, h = bh & 15;
        const unsigned latbase = (unsigned)(M_CTX + b * SEQ);
        const int vcol = F.tid >> 3, vch = F.tid & 7;
        const unsigned vsrc = (unsigned)((latbase + vcol) * D + h * 64 + vch * 8);
        const int vdst = vcol * 128 + ((vch ^ (vcol & 7)) << 4);
        __syncthreads();
        {
            const int key = F.tid >> 1, hf = F.tid & 1; const size_t src = (size_t)(b * CTXL + key) * D + h * 64 + hf * 32;
#pragma unroll
            for (int i = 0; i < 4; ++i) { *(LAS v4u*)(ctxK + swz(key, hf * 4 + i)) = *(const GAS v4u*)(K + src + 8 * i); *(LAS v4u*)(ctxV + swz(key, hf * 4 + i)) = *(const GAS v4u*)(V + src + 8 * i); }
            if (F.tid < 465) rp[F.tid] = rpb[h * 465 + F.tid] * 1.4426950408889634f;
            const int r0 = 16 * half, lo0 = min(max(r0 - 4, 0), 24), hi0 = min(max(r0 + 1 - 4, 0), 24) + 7;
            for (int kr = lo0; kr <= hi0; ++kr) *(LAS v4u*)(vring + (kr % AT_NSLOT) * 8192 + vdst) = *(const GAS v4u*)(V + vsrc + (unsigned)(kr * 64 * D));
        }
        __syncthreads();
        for (int it = 0; it < 8; ++it) {
            const int ra = 16 * half + 2 * it;
            const int r = ra + (F.wave >> 2), j = F.wave & 3;
            const int rs = min(max(r - 4, 0), 24); const int kb = (j == 0) ? 0 : (j == 1) ? 8 : (j == 2) ? 24 : 32;
            const int qc = 16 * j + fr, wsq = min(max(qc - 8, 0), 48);
            const int hi = min(max(ra + 1 - 4, 0), 24) + 7, hin = (it < 7) ? (min(max(ra + 3 - 4, 0), 24) + 7) : hi;
            bf16x8 qf[2];
            { const bf16* qp = Q + (unsigned)((latbase + r * 64 + qc) * D + h * 64 + 8 * fq); qf[0] = *(const GAS bf16x8*)qp; qf[1] = *(const GAS bf16x8*)(qp + 32); }
            const int cv = kb + 4 * fq - wsq, cc2 = kb + 4 * fq - qc + 15;
            f32x4 sl[8][2], sc[16];
            const unsigned koff = (unsigned)((latbase + rs * 64 + kb + fr) * D + h * 64 + 8 * fq);
            bf16x8 kc[4], kn[4];
#pragma unroll
            for (int x = 0; x < 4; ++x) kc[x] = *(const GAS bf16x8*)(K + koff + (x >> 1) * 16 * D + (x & 1) * 32);
#pragma unroll
            for (int i = 0; i < 8; ++i) {
                const int brow = (rs + i - r + 7) * 31;
                if (i < 7) {
#pragma unroll
                    for (int x = 0; x < 4; ++x) kn[x] = *(const GAS bf16x8*)(K + koff + (unsigned)((i + 1) * 64 * D) + (x >> 1) * 16 * D + (x & 1) * 32);
                }
#pragma unroll
                for (int blk = 0; blk < 2; ++blk) {
                    f32x4 s = {0.f, 0.f, 0.f, 0.f};
                    s = __builtin_amdgcn_mfma_f32_16x16x32_bf16(kc[2 * blk], qf[0], s, 0, 0, 0);
                    s = __builtin_amdgcn_mfma_f32_16x16x32_bf16(kc[2 * blk + 1], qf[1], s, 0, 0, 0);
#pragma unroll
                    for (int e = 0; e < 4; ++e) s[e] = ((unsigned)(cv + 16 * blk + e) < 16u) ? (s[e] + rp[brow + min(max(cc2 + 16 * blk + e, 0), 30)]) : -INFINITY;
                    sl[i][blk] = s;
                }
#pragma unroll
                for (int x = 0; x < 4; ++x) kc[x] = kn[x];
            }
#pragma unroll
            for (int cb = 0; cb < 16; ++cb) {
                const int key = 16 * cb + fr;
                const bf16x8 k0 = *(const LAS bf16x8*)(ctxK + swz(key, fq)), k1 = *(const LAS bf16x8*)(ctxK + swz(key, 4 + fq));
                f32x4 s = {0.f, 0.f, 0.f, 0.f};
                s = __builtin_amdgcn_mfma_f32_16x16x32_bf16(k0, qf[0], s, 0, 0, 0);
                s = __builtin_amdgcn_mfma_f32_16x16x32_bf16(k1, qf[1], s, 0, 0, 0);
                sc[cb] = s;
            }
            v4u vnew[2];
#pragma unroll
            for (int n = 0; n < 2; ++n) if (hi + 1 + n <= hin) vnew[n] = *(const GAS v4u*)(V + vsrc + (unsigned)((hi + 1 + n) * 64 * D));
            float m = -INFINITY;
#pragma unroll
            for (int i = 0; i < 8; ++i)
#pragma unroll
                for (int blk = 0; blk < 2; ++blk)
#pragma unroll
                    for (int e = 0; e < 4; ++e) m = fmaxf(m, sl[i][blk][e]);
#pragma unroll
            for (int cb = 0; cb < 16; ++cb)
#pragma unroll
                for (int e = 0; e < 4; ++e) m = fmaxf(m, sc[cb][e]);
            m = fmaxf(m, __shfl_xor(m, 16)); m = fmaxf(m, __shfl_xor(m, 32));
            float l = 0.f;
#pragma unroll
            for (int i = 0; i < 8; ++i)
#pragma unroll
                for (int blk = 0; blk < 2; ++blk)
#pragma unroll
                    for (int e = 0; e < 4; ++e) { const float p = __builtin_amdgcn_exp2f(sl[i][blk][e] - m); sl[i][blk][e] = p; l += p; }
#pragma unroll
            for (int cb = 0; cb < 16; ++cb)
#pragma unroll
                for (int e = 0; e < 4; ++e) { const float p = __builtin_amdgcn_exp2f(sc[cb][e] - m); sc[cb][e] = p; l += p; }
            l += __shfl_xor(l, 16); l += __shfl_xor(l, 32);
            const float linv = __builtin_amdgcn_rcpf(l);
            f32x4 o[4];
#pragma unroll
            for (int db = 0; db < 4; ++db) o[db] = (f32x4){0.f, 0.f, 0.f, 0.f};
#pragma unroll
            for (int i = 0; i < 8; ++i) {
                const LAS unsigned char* vrow = vring + ((rs + i) % AT_NSLOT) * 8192;
                const bf16x8 pa = pack8(sl[i][0], sl[i][1]);
                const int c0 = kb + 4 * fq + tq, c1 = c0 + 16;
#pragma unroll
                for (int db = 0; db < 4; ++db) {
                    const int ch = 2 * db + (tp >> 1), wi = 8 * (tp & 1);
                    const bf16x8 vb = tr2(vrow + swz(c0, ch) + wi, vrow + swz(c1, ch) + wi);
                    o[db] = __builtin_amdgcn_mfma_f32_16x16x32_bf16(pa, vb, o[db], 0, 0, 0);
                }
            }
#pragma unroll
            for (int cc = 0; cc < 8; ++cc) {
                const bf16x8 pa = pack8(sc[2 * cc], sc[2 * cc + 1]);
                const int k0 = 32 * cc + 4 * fq + tq, k1 = k0 + 16;
#pragma unroll
                for (int db = 0; db < 4; ++db) {
                    const int ch = 2 * db + (tp >> 1), wi = 8 * (tp & 1);
                    const bf16x8 vb = tr2(ctxV + swz(k0, ch) + wi, ctxV + swz(k1, ch) + wi);
                    o[db] = __builtin_amdgcn_mfma_f32_16x16x32_bf16(pa, vb, o[db], 0, 0, 0);
                }
            }
#pragma unroll
            for (int e = 0; e < 4; ++e) {
                const float li = __shfl(linv, 4 * fq + e);
                bf16* op = O + (unsigned)((b * SEQ + r * 64 + 16 * j + 4 * fq + e) * D + h * 64 + fr);
#pragma unroll
                for (int db = 0; db < 4; ++db) op[db * 16] = (bf16)f2bf(o[db][e] * li);
            }
            __syncthreads();
#pragma unroll
            for (int n = 0; n < 2; ++n) if (hi + 1 + n <= hin) *(LAS v4u*)(vring + ((hi + 1 + n) % AT_NSLOT) * 8192 + vdst) = vnew[n];
            __syncthreads();
        }
    }
}

__device__ __forceinline__ void router_phase(Frame& F, const float* hlat, const float* g, const float* mods_l, const float* router_w, const float* router_b, bf16* A4, unsigned* tokinfo, gu32* cntb) {
    LAS int* se = (LAS int*)F.lds;
    LAS float* sg = (LAS float*)(F.lds + 512);
    LAS int* srow = (LAS int*)(F.lds + 1024);
    LAS unsigned* spos = (LAS unsigned*)(F.lds + 1280);
    const int gw = F.bid * NWAVES + F.wave, NGW = F.G * NWAVES;
    const int nbatch = (M_LAT + NGW * 8 - 1) / (NGW * 8);
    LAS float* srw = (LAS float*)(F.lds + 2048);
    __syncthreads();
    for (int i = F.tid; i < 2048; i += NTHR) ((LAS f32x4*)srw)[i] = ((const GAS f32x4*)router_w)[i];
    f32x4 gg[4];
#pragma unroll
    for (int j = 0; j < 4; ++j) gg[j] = ((const GAS f32x4*)g)[F.lane + 64 * j];
    RowIn cur, nxt;
#define RT_FETCH(R_, r_) do { const float* mp_ = mods_l + ((r_) >> 11) * 6144; row_fetch(R_, hlat + (size_t)(r_) * D, mp_ + 3072, mp_ + 4096, F.lane); } while (0)
    if (gw < M_LAT) RT_FETCH(cur, gw);
    for (int bt = 0; bt < nbatch; ++bt) {
        __syncthreads();
#pragma unroll 1
        for (int k = 0; k < 8; ++k) {
            const int r = gw + (bt * 8 + k) * NGW, slot = F.wave * 8 + k;
            if (r >= M_LAT) { if (F.lane == 0) { se[2 * slot] = -1; se[2 * slot + 1] = -1; srow[slot] = 0; } continue; }
            if (r + NGW < M_LAT) RT_FETCH(nxt, r + NGW);
            f32x4 a[4]; row_finish(cur, gg, A4 + (size_t)r * D, F.lane, a);
            cur = nxt;
            float lg[8];
#pragma unroll
            for (int e = 0; e < 8; ++e) lg[e] = 0.f;
#pragma unroll
            for (int j = 0; j < 4; ++j)
#pragma unroll
                for (int x = 0; x < 4; ++x) { const LAS float* rw = srw + ((F.lane + 64 * j) * 4 + x) * 8; const f32x4 w0 = *(const LAS f32x4*)rw, w1 = *(const LAS f32x4*)(rw + 4); const float av = a[j][x];
#pragma unroll
                    for (int e = 0; e < 4; ++e) { lg[e] += av * w0[e]; lg[4 + e] += av * w1[e]; } }
#pragma unroll
            for (int e = 0; e < 8; ++e) lg[e] = wave_sum(lg[e]) + router_b[e];
            int e0 = 0; float v0 = lg[0];
#pragma unroll
            for (int e = 1; e < 8; ++e) if (lg[e] > v0) { v0 = lg[e]; e0 = e; }
            int e1 = -1; float v1 = -INFINITY;
#pragma unroll
            for (int e = 0; e < 8; ++e) if (e != e0 && lg[e] > v1) { v1 = lg[e]; e1 = e; }
            const float g0 = 1.f / (1.f + __expf(v1 - v0)), g1 = 1.f - g0;
            if (F.lane == 0) { se[2 * slot] = e0; se[2 * slot + 1] = e1; sg[2 * slot] = g0; sg[2 * slot + 1] = g1; srow[slot] = r; }
        }
        __syncthreads();
        if (F.wave == 0) {
            const int l = F.lane; const int ea = se[l], eb = se[64 + l];
            const unsigned long long below = (l == 0) ? 0ull : (~0ull >> (64 - l));
            unsigned ra = 0u, rb = 0u, tot = 0u;
#pragma unroll
            for (int e = 0; e < 8; ++e) {
                const unsigned long long ma = __ballot(ea == e), mb = __ballot(eb == e);
                const unsigned ca = (unsigned)__popcll(ma), cb = (unsigned)__popcll(mb);
                if (ea == e) ra = (unsigned)__popcll(ma & below);
                if (eb == e) rb = ca + (unsigned)__popcll(mb & below);
                if (l == e) tot = ca + cb;
            }
            if (l < 8) cntb[(size_t)(bt * F.G + F.bid) * 8 + l] = tot;
            spos[l] = ra; spos[64 + l] = rb;
            asm volatile("s_waitcnt lgkmcnt(0)" ::: "memory");
            if (se[2 * l] >= 0) {
                v4u t0; t0.x = (unsigned)se[2 * l]; t0.y = spos[2 * l]; t0.z = __float_as_uint(sg[2 * l]); t0.w = (unsigned)se[2 * l + 1];
                v4u t1; t1.x = spos[2 * l + 1]; t1.y = __float_as_uint(sg[2 * l + 1]); t1.z = 0u; t1.w = 0u;
                const size_t row = (size_t)srow[l];
                *(GAS v4u*)(tokinfo + row * 8) = t0; *(GAS v4u*)(tokinfo + row * 8 + 4) = t1;
            }
        }
    }
}
#undef RT_FETCH
__device__ __forceinline__ void moe_bases(gu32* cnt, int (&tb)[9]) {
    int acc = 0;
#pragma unroll
    for (int e = 0; e < 8; ++e) { tb[e] = acc; const unsigned c = __hip_atomic_load(cnt + 64 * e, RLX_AGENT); acc += (int)((c + 255u) >> 8); }
    tb[8] = acc;
}
#ifndef MOE_TAIL_SPLIT
#define MOE_TAIL_SPLIT 1
#endif
__device__ __forceinline__ void moe_tail_split(const int (&tb)[9], int G, int& first, int& ntail) {
    const int U = tb[8] * 4; first = (U / G) * G; ntail = U - first;
    if (first == 0 || (first & 3) || ntail > 32) { first = U; ntail = 0; }
#if !MOE_TAIL_SPLIT
    first = U; ntail = 0;
#endif
}
__device__ __forceinline__ void gather_phase(Frame& F, const bf16* A4, unsigned* tokinfo, gu32* cnt, const gu32* cntb, bf16* XG) {
    const int gw = F.bid * NWAVES + F.wave, NGW = F.G * NWAVES;
    const int nbatch = (M_LAT + NGW * 8 - 1) / (NGW * 8), nent = nbatch * F.G;
    LAS float* sred = (LAS float*)F.lds;
    __syncthreads();
    if (F.wave == 0) {
        float tot[8];
#pragma unroll
        for (int e = 0; e < 8; ++e) tot[e] = 0.f;
        for (int i = F.lane; i < nent; i += 64) { const v4u a = *(const GAS v4u*)(cntb + (size_t)i * 8), b = *(const GAS v4u*)(cntb + (size_t)i * 8 + 4);
            tot[0] += (float)a.x; tot[1] += (float)a.y; tot[2] += (float)a.z; tot[3] += (float)a.w; tot[4] += (float)b.x; tot[5] += (float)b.y; tot[6] += (float)b.z; tot[7] += (float)b.w; }
#pragma unroll
        for (int e = 0; e < 8; ++e) { const float s = wave_sum(tot[e]); if (F.lane == 0) sred[e] = s; }
        for (int bt = 0; bt < nbatch; ++bt) {
            const int mine = bt * F.G + F.bid; float pre[8];
#pragma unroll
            for (int e = 0; e < 8; ++e) pre[e] = 0.f;
            for (int i = F.lane; i < mine; i += 64) { const v4u a = *(const GAS v4u*)(cntb + (size_t)i * 8), b = *(const GAS v4u*)(cntb + (size_t)i * 8 + 4);
                pre[0] += (float)a.x; pre[1] += (float)a.y; pre[2] += (float)a.z; pre[3] += (float)a.w; pre[4] += (float)b.x; pre[5] += (float)b.y; pre[6] += (float)b.z; pre[7] += (float)b.w; }
#pragma unroll
            for (int e = 0; e < 8; ++e) { const float s = wave_sum(pre[e]); if (F.lane == 0) sred[8 + 8 * bt + e] = s; }
        }
    }
    __syncthreads();
    int tb[9]; { int acc = 0;
#pragma unroll
        for (int e = 0; e < 8; ++e) { tb[e] = acc; const unsigned c = (unsigned)sred[e]; acc += (int)((c + 255u) >> 8); if (F.bid == 0 && F.tid == 0) __hip_atomic_store(cnt + 64 * e, c, RLX_AGENT); }
        tb[8] = acc; }
    struct GIn { v4u t0, t1, x0, x1; };
    GIn cur, nxt;
#define G_FETCH(R_, r_) do { R_.t0 = *(const GAS v4u*)(tokinfo + (size_t)(r_) * 8); R_.t1 = *(const GAS v4u*)(tokinfo + (size_t)(r_) * 8 + 4); \
        const GAS v4u* s_ = (const GAS v4u*)(A4 + (size_t)(r_) * D); R_.x0 = s_[F.lane]; R_.x1 = s_[F.lane + 64]; } while (0)
    if (gw < M_LAT) G_FETCH(cur, gw);
    int k = 0;
    for (int r = gw; r < M_LAT; r += NGW, ++k) {
        if (r + NGW < M_LAT) G_FETCH(nxt, r + NGW);
        const v4u t0 = cur.t0, t1 = cur.t1, x0 = cur.x0, x1 = cur.x1; cur = nxt;
        const LAS float* pre = sred + 8 + 8 * (k >> 3);
        int tbe0 = 0, tbe1 = 0; unsigned pr0 = 0u, pr1 = 0u;
#pragma unroll
        for (int e = 0; e < 8; ++e) { if ((int)t0.x == e) { tbe0 = tb[e]; pr0 = (unsigned)pre[e]; } if ((int)t0.w == e) { tbe1 = tb[e]; pr1 = (unsigned)pre[e]; } }
        const unsigned row0 = (unsigned)tbe0 * 256u + pr0 + t0.y, row1 = (unsigned)tbe1 * 256u + pr1 + t1.x;
        GAS v4u* d0 = (GAS v4u*)(XG + (size_t)row0 * D); GAS v4u* d1 = (GAS v4u*)(XG + (size_t)row1 * D);
        d0[F.lane] = x0; d0[F.lane + 64] = x1; d1[F.lane] = x0; d1[F.lane + 64] = x1;
        if (F.lane == 0) { tokinfo[(size_t)r * 8 + 6] = row0; tokinfo[(size_t)r * 8 + 7] = row1; }
    }
#undef G_FETCH
}
__device__ __forceinline__ f32x4 moe_y4(const bf16* YG, const float* slab, unsigned row, int j, int lane, unsigned tailrow0, int first, int ntail) {
    if (row < tailrow0) { const v2u a = ((const GAS v2u*)(YG + (size_t)row * D) + lane)[64 * j]; return (f32x4){bflo(a.x), bfhi(a.x), bflo(a.y), bfhi(a.y)}; }
    const size_t kstride = (size_t)(ntail >> 2) * 256 * 1024; const float* p = slab + (size_t)(row - tailrow0) * 1024 + (lane + 64 * j) * 4; f32x4 s = {0.f, 0.f, 0.f, 0.f};
    for (int ks = 0; ks < 11; ++ks) s += *(const GAS f32x4*)(p + ks * kstride);
    const unsigned w0 = pk2(s[0], s[1]), w1 = pk2(s[2], s[3]);
    return (f32x4){bflo(w0), bfhi(w0), bflo(w1), bfhi(w1)};
}
__device__ __forceinline__ void final_phase(Frame& F, float* hout, const bf16* YG, const unsigned* tokinfo, const float* mods_l, const float* norm_final, const float* slab, gu32* cnt) {
    const int gw = F.bid * NWAVES + F.wave, NGW = F.G * NWAVES;
    int tb[9]; moe_bases(cnt, tb); int first, ntail; moe_tail_split(tb, F.G, first, ntail); const unsigned tailrow0 = (unsigned)(first >> 2) * 256u;
#if defined(PROF_PH) || defined(PROF_SCANWAIT) || defined(PROF_MBWAIT) || defined(PROF_MBSEG)
    const float prof_scale = 1.f + sqrtf(__uint_as_float(__hip_atomic_load(F.ctl + 2, RLX_AGENT)) * 1e-5f);
#else
    const float prof_scale = 1.f;
#endif
    for (int r = gw; r < M_LAT; r += NGW) {
        const v4u t0 = *(const GAS v4u*)(tokinfo + (size_t)r * 8), t1 = *(const GAS v4u*)(tokinfo + (size_t)r * 8 + 4);
        const float g0 = __uint_as_float(t0.z), g1 = __uint_as_float(t1.y); const unsigned row0 = t1.z, row1 = t1.w;
        const float* mp = mods_l + (r >> 11) * 6144 + 5120;
        GAS f32x4* hr = (GAS f32x4*)(hout + (size_t)r * D) + F.lane;
        f32x4 v[4]; float ss = 0.f;
#pragma unroll
        for (int j = 0; j < 4; ++j) {
            const f32x4 hh = hr[64 * j], mm = ((const GAS f32x4*)mp)[F.lane + 64 * j];
            const f32x4 ya = moe_y4(YG, slab, row0, j, F.lane, tailrow0, first, ntail), yb = moe_y4(YG, slab, row1, j, F.lane, tailrow0, first, ntail);
            v[j] = hh + mm * (ya * g0 + yb * g1);
            ss += (v[j].x * v[j].x + v[j].y * v[j].y) + (v[j].z * v[j].z + v[j].w * v[j].w);
        }
        const float rs = rsqrtf(wave_sum(ss) * (1.f / 1024.f) + 1e-6f);
#pragma unroll
        for (int j = 0; j < 4; ++j) { const f32x4 gg = ((const GAS f32x4*)norm_final)[F.lane + 64 * j]; hr[64 * j] = (v[j] * (rs * prof_scale)) * gg; }
    }
}

constexpr int NPHASE = 19;
#ifndef MK_PER_PHASE
#define MK_PER_PHASE 0
#endif
__device__ __forceinline__ int fresh_lane() { int l; asm volatile("v_mbcnt_lo_u32_b32 %0, -1, 0\n\tv_mbcnt_hi_u32_b32 %0, -1, %0" : "=v"(l)); return l; }
struct Args { const float* in[39]; float* out; unsigned char* ws; int ph_lo, ph_hi; };
#define KARGP(k) (((void* const __attribute__((address_space(4)))*)__builtin_amdgcn_kernarg_segment_ptr())[k])
#define KARG(k) ((const float*)KARGP(k))
__global__ void __launch_bounds__(NWAVES * 64, 2) mk_fwd(Args args) {
    extern __shared__ __attribute__((aligned(16))) unsigned char lds[];
    Frame F;
    F.lds = (LAS unsigned char*)lds; F.MISC = (volatile LAS unsigned*)(F.lds + MISC_OFF);
    F.tid = threadIdx.x; F.lane = F.tid & 63; F.wave = __builtin_amdgcn_readfirstlane(F.tid >> 6); F.G = gridDim.x; F.bid = blockIdx.x;
    unsigned char* ws = (unsigned char*)KARGP(40); F.ctl = (gu32*)(ws + WS_CTL);
    for (int u = F.tid; u < (LDS_BYTES - LDSCTL_OFF) / 4; u += NWAVES * 64) ((LAS unsigned*)(F.lds + LDSCTL_OFF))[u] = 0u;
    __syncthreads();
    const int lo = args.ph_lo, hi = args.ph_hi;
    unsigned long long prof_t0 = 0ull; (void)prof_t0;
    XcdBarrier bar; bar.bar = (unsigned*)(F.ctl + CW_BAR); bar.x = 0; bar.st = nullptr;
    if (hi - lo > 1) bar = xcd_barrier_post((unsigned*)(F.ctl + CW_BAR), F.MISC + 8);
#ifdef PH_MASK
#define IN(k) ((((PH_MASK) >> (k)) & 1) && lo <= (k) && (k) < hi)
#else
#define IN(k) (lo <= (k) && (k) < hi)
#endif
#ifndef DUP_MASK
#define DUP_MASK 0
#endif
#ifdef PROF_PH
#define PROF_T0(k) do { if ((k) == PROF_PH && F.bid == 0 && F.tid == 0) prof_t0 = __builtin_amdgcn_s_memrealtime(); } while (0)
#define PROF_T1(k) do { if ((k) == PROF_PH && F.bid == 0 && F.tid == 0) { const unsigned long long t1_ = __builtin_amdgcn_s_memrealtime(); __hip_atomic_store(F.ctl + 2, __float_as_uint((float)(t1_ - prof_t0) * 0.01f), RLX_AGENT); } } while (0)
#else
#define PROF_T0(k) do {} while (0)
#define PROF_T1(k) do {} while (0)
#endif
#define REPS(k) (1 + (((DUP_MASK) >> (k)) & 1))
#ifdef DOUBLE_BAR
#define SEAM(k) do { if (IN(k) && IN((k) + 1)) { xcd_barrier(bar); xcd_barrier(bar); } } while (0)
#else
#define SEAM(k) do { if (IN(k) && IN((k) + 1)) xcd_barrier(bar); } while (0)
#endif
    const float* x = KARG(0); const float* ctx = KARG(2);
    float* mods = (float*)(ws + WS_MODS); float* hctx = (float*)(ws + WS_HCTX); float* hlat = (float*)KARGP(39);
    bf16* A = (bf16*)(ws + WS_A);
    const int vcu = (F.G % 8 == 0) ? (F.bid % 8) * (F.G / 8) + F.bid / 8 : F.bid;

    PROF_T0(0); if (IN(0)) for (int rep_ = 0; rep_ < REPS(0); ++rep_) { if (rep_) __syncthreads(); F.lane = fresh_lane(); F.tid = F.wave * 64 + F.lane; p0_phase(F, KARG(1), KARG(3), KARG(4), KARG(5), mods, KARG(9), KARG(10), KARG(28), KARG(29), KARG(30), KARG(31), KARG(32), ws); }
    SEAM(0); PROF_T1(0);
    PROF_T0(1); if (IN(1)) for (int rep_ = 0; rep_ < REPS(1); ++rep_) { if (rep_) __syncthreads(); F.lane = fresh_lane(); F.tid = F.wave * 64 + F.lane; normmod_phase(F, ctx, x, KARG(6), mods, 0, 1024, A); }
    SEAM(1); PROF_T1(1);
    PROF_T0(2); if (IN(2)) for (int rep_ = 0; rep_ < REPS(2); ++rep_) { if (rep_) __syncthreads(); F.lane = fresh_lane(); F.tid = F.wave * 64 + F.lane;
        pg8::Gemm g{A, (const bf16*)(ws + WS_WIN_T), M_ALL, ZLD, D}; pg8::StaticOrder S; S.init(M_ALL, ZLD, F.G, F.bid);
        pg8::EpiBf16<0> E{(bf16*)(ws + WS_Z), ZLD, nullptr, 0, 0, 1.f};
        pg8::gemm_phase<pg8::EpiBf16<0>, pg8::StaticOrder, true, true>(F.lds, g, S, E);
    }
    SEAM(2); PROF_T1(2);
    PROF_T0(3); if (IN(3)) for (int rep_ = 0; rep_ < REPS(3); ++rep_) { if (rep_) __syncthreads(); F.lane = fresh_lane(); F.tid = F.wave * 64 + F.lane;
        PrepIn P{KARG(11), KARG(12), KARG(13), KARG(14), KARG(15), KARG(16), KARG(17), KARG(18), KARG(19), KARG(22), KARG(23), KARG(24)};
        prepare_phase(F, P, (const bf16*)(ws + WS_Z), (bf16*)(ws + WS_PR), (bf16*)(ws + WS_PM), (float*)(ws + WS_DT), (float*)(ws + WS_BONUS), (bf16*)(ws + WS_GATE), (bf16*)(ws + WS_ZG));
    }
    SEAM(3); PROF_T1(3);
    PROF_T0(4); if (IN(4)) for (int rep_ = 0; rep_ < REPS(4); ++rep_) { if (rep_) __syncthreads(); F.lane = fresh_lane(); F.tid = F.wave * 64 + F.lane;
        for (int u = F.bid; u < 256; u += F.G) {
            if (u < 128) { rwkv_block(F, u, (const bf16*)(ws + WS_PR), (bf16*)(ws + WS_YRW));
#ifdef RWKV2X
                rwkv_block(F, u, (const bf16*)(ws + WS_PR), (bf16*)(ws + WS_YRW));
#endif
            }
            else { mamba_block(F, u - 128, (const bf16*)(ws + WS_PM), (const float*)(ws + WS_DT), KARG(25), (bf16*)(ws + WS_YMB));
#ifdef MAMBA2X
                   mamba_block(F, u - 128, (const bf16*)(ws + WS_PM), (const float*)(ws + WS_DT), KARG(25), (bf16*)(ws + WS_YMB));
#endif
            }
        }
    }
    SEAM(4); PROF_T1(4);
    PROF_T0(5); if (IN(5)) for (int rep_ = 0; rep_ < REPS(5); ++rep_) { if (rep_) __syncthreads(); F.lane = fresh_lane(); F.tid = F.wave * 64 + F.lane;
        FinIn P{KARG(20), KARG(21), KARG(26), KARG(27)};
        finish_phase(F, P, (const bf16*)(ws + WS_YRW), (const bf16*)(ws + WS_YMB), (const bf16*)(ws + WS_PR), (const bf16*)(ws + WS_PM), (const float*)(ws + WS_BONUS), (const bf16*)(ws + WS_GATE), (const bf16*)(ws + WS_ZG), A);
    }
    SEAM(5); PROF_T1(5);
    PROF_T0(6); if (IN(6)) for (int rep_ = 0; rep_ < REPS(6); ++rep_) { if (rep_) __syncthreads(); F.lane = fresh_lane(); F.tid = F.wave * 64 + F.lane;
        {
            pg8::Gemm g{A + (size_t)M_CTX * D, (const bf16*)(ws + WS_WOUT_T), M_LAT, D, D}; pg8::StaticOrder S; S.init(M_LAT, D, F.G, F.bid);
            pg8::EpiResGate E{x, x, hlat, hlat, mods, 2048, 0};
            pg8::gemm_phase<pg8::EpiResGate, pg8::StaticOrder, true, true>(F.lds, g, S, E);
        }
        {
            pg8::Gemm g{A, (const bf16*)(ws + WS_WOUT_T), M_CTX, D, 256, D}; pg8::SplitKOrder S{8, 4, 4, 256, F.G, F.bid};
            pg8::EpiSlabGate E{(float*)(ws + WS_SLAB6), mods + 8 * 6144 + 2048, 256};
            pg8::gemm_phase<pg8::EpiSlabGate, pg8::SplitKOrder, true, true>(F.lds, g, S, E);
        }
        { const int nsub = 8 * 4 * 4; if (F.G > nsub && F.bid >= nsub) moe_weight_phase(F, KARG(36), KARG(37), KARG(38), ws, 0, MOE_ITEMS_P6, F.bid - nsub, F.G - nsub);
          else if (F.G <= nsub) moe_weight_phase(F, KARG(36), KARG(37), KARG(38), ws, 0, MOE_ITEMS_P6, F.bid, F.G); }
    }
    SEAM(6); PROF_T1(6);
    PROF_T0(7); if (IN(7)) for (int rep_ = 0; rep_ < REPS(7); ++rep_) { if (rep_) __syncthreads(); F.lane = fresh_lane(); F.tid = F.wave * 64 + F.lane; normmod_phase(F, ctx, hlat, KARG(7), mods, 3072, 4096, A, (const float*)(ws + WS_SLAB6), 4, hctx); moe_weight_phase(F, KARG(36), KARG(37), KARG(38), ws, MOE_ITEMS_P6, MOE_ITEMS_P7, F.bid, F.G); }
    SEAM(7); PROF_T1(7);
    PROF_T0(8); if (IN(8)) for (int rep_ = 0; rep_ < REPS(8); ++rep_) { if (rep_) __syncthreads(); F.lane = fresh_lane(); F.tid = F.wave * 64 + F.lane;
        pg8::Gemm g{A, (const bf16*)(ws + WS_W13_T), M_ALL, 2 * FF, D}; pg8::StaticOrder S; S.init(M_ALL, 2 * FF, F.G, F.bid);
        pg8::EpiSwiGLU E{(bf16*)(ws + WS_HID), FF, 1 << 20};
        pg8::gemm_phase<pg8::EpiSwiGLU, pg8::StaticOrder, true, true>(F.lds, g, S, E);
        {
            const int nfull = ((M_ALL / 256) * (2 * FF / 256)) % F.G;
            if (nfull != 0 && F.bid >= nfull) moe_weight_phase(F, KARG(36), KARG(37), KARG(38), ws, MOE_ITEMS_P7, MOE_ITEMS_P7 + MOE_ITEMS_P8, F.bid - nfull, F.G - nfull);
            else if (nfull == 0) moe_weight_phase(F, KARG(36), KARG(37), KARG(38), ws, MOE_ITEMS_P7, MOE_ITEMS_P7 + MOE_ITEMS_P8, F.bid, F.G);
        }
    }
    SEAM(8); PROF_T1(8);
    PROF_T0(9); if (IN(9)) for (int rep_ = 0; rep_ < REPS(9); ++rep_) { if (rep_) __syncthreads(); F.lane = fresh_lane(); F.tid = F.wave * 64 + F.lane;
        {
            pg8::Gemm g{(const bf16*)(ws + WS_HID) + (size_t)M_CTX * FF, (const bf16*)(ws + WS_W2_T), M_LAT, D, FF}; pg8::StaticOrder S; S.init(M_LAT, D, F.G, F.bid);
            pg8::EpiResGate E{hlat, hlat, hlat, hlat, mods, 5120, 0};
            pg8::gemm_phase<pg8::EpiResGate, pg8::StaticOrder, true, true>(F.lds, g, S, E);
        }
        {
            pg8::Gemm g{(const bf16*)(ws + WS_HID), (const bf16*)(ws + WS_W2_T), M_CTX, D, 1408, FF}; pg8::SplitKOrder S{8, 4, 2, 1408, F.G, F.bid};
            pg8::EpiSlabGate E{(float*)(ws + WS_SLAB9), mods + 8 * 6144 + 5120, 1408};
            pg8::gemm_phase<pg8::EpiSlabGate, pg8::SplitKOrder, true, true>(F.lds, g, S, E);
        }
        {
            const int nsub = 8 * 4 * 2;
            if (F.G > nsub) { if (F.bid >= nsub) moe_weight_phase(F, KARG(36), KARG(37), KARG(38), ws, MOE_ITEMS_P7 + MOE_ITEMS_P8, MOE_ITEMS_P7 + MOE_ITEMS_P8 + MOE_ITEMS_P9, F.bid - nsub, F.G - nsub); }
            else moe_weight_phase(F, KARG(36), KARG(37), KARG(38), ws, MOE_ITEMS_P7 + MOE_ITEMS_P8, MOE_ITEMS_P7 + MOE_ITEMS_P8 + MOE_ITEMS_P9, F.bid, F.G);
        }
    }
    SEAM(9); PROF_T1(9);
    const float* mods1 = mods + 9 * 6144;
    PROF_T0(10); if (IN(10)) for (int rep_ = 0; rep_ < REPS(10); ++rep_) { if (rep_) __syncthreads(); F.lane = fresh_lane(); F.tid = F.wave * 64 + F.lane; normmod_phase(F, hctx, hlat, KARG(6) + D, mods1, 0, 1024, A, (const float*)(ws + WS_SLAB9), 2); }
    SEAM(10); PROF_T1(10);
    PROF_T0(11); if (IN(11)) for (int rep_ = 0; rep_ < REPS(11); ++rep_) { if (rep_) __syncthreads(); F.lane = fresh_lane(); F.tid = F.wave * 64 + F.lane;
        pg8::Gemm g{A, (const bf16*)(ws + WS_QKV_T), M_ALL, 3 * D, D}; pg8::StaticOrder S; S.init(M_ALL, 3 * D, F.G, F.bid);
        pg8::EpiBf16<0> E{(bf16*)(ws + WS_Q), D, nullptr, D, (size_t)M_ALL * D, 0.125f * 1.4426950408889634f};
        pg8::gemm_phase<pg8::EpiBf16<0>, pg8::StaticOrder, true, true>(F.lds, g, S, E);
        {
            const int nfull = ((M_ALL / 256) * (3 * D / 256)) % F.G;
            if (nfull != 0 && F.bid >= nfull) moe_weight_phase(F, KARG(36), KARG(37), KARG(38), ws, MOE_ITEMS - MOE_ITEMS_P16 - MOE_ITEMS_P11, MOE_ITEMS - MOE_ITEMS_P16, F.bid - nfull, F.G - nfull);
            else if (nfull == 0) moe_weight_phase(F, KARG(36), KARG(37), KARG(38), ws, MOE_ITEMS - MOE_ITEMS_P16 - MOE_ITEMS_P11, MOE_ITEMS - MOE_ITEMS_P16, F.bid, F.G);
        }
    }
    SEAM(11); PROF_T1(11);
    PROF_T0(12); if (IN(12)) for (int rep_ = 0; rep_ < REPS(12); ++rep_) { if (rep_) __syncthreads(); F.lane = fresh_lane(); F.tid = F.wave * 64 + F.lane; attn_phase(F, (const bf16*)(ws + WS_Q), (const bf16*)(ws + WS_K), (const bf16*)(ws + WS_V), KARG(33), (bf16*)(ws + WS_O)); }
    SEAM(12); PROF_T1(12);
    PROF_T0(13); if (IN(13)) for (int rep_ = 0; rep_ < REPS(13); ++rep_) { if (rep_) __syncthreads(); F.lane = fresh_lane(); F.tid = F.wave * 64 + F.lane;
        pg8::Gemm g{(const bf16*)(ws + WS_O), (const bf16*)(ws + WS_NAO_T), M_LAT, D, D}; pg8::StaticOrder S; S.init(M_LAT, D, F.G, F.bid);
        pg8::EpiResGate E{hlat, hlat, hlat, hlat, mods1, 2048, 0};
        pg8::gemm_phase<pg8::EpiResGate, pg8::StaticOrder, true, true>(F.lds, g, S, E);
    }
    SEAM(13); PROF_T1(13);
    PROF_T0(14); if (IN(14)) for (int rep_ = 0; rep_ < REPS(14); ++rep_) { if (rep_) __syncthreads(); F.lane = fresh_lane(); F.tid = F.wave * 64 + F.lane; router_phase(F, hlat, KARG(7) + D, mods1, KARG(34), KARG(35), (bf16*)(ws + WS_A4), (unsigned*)(ws + WS_TOK), F.ctl + CW_CNTB); }
    SEAM(14); PROF_T1(14);
    PROF_T0(15); if (IN(15)) for (int rep_ = 0; rep_ < REPS(15); ++rep_) { if (rep_) __syncthreads(); F.lane = fresh_lane(); F.tid = F.wave * 64 + F.lane; gather_phase(F, (const bf16*)(ws + WS_A4), (unsigned*)(ws + WS_TOK), F.ctl + CW_CNT, F.ctl + CW_CNTB, (bf16*)(ws + WS_XG)); }
    SEAM(15); PROF_T1(15);
    PROF_T0(16); if (IN(16)) for (int rep_ = 0; rep_ < REPS(16); ++rep_) { if (rep_) __syncthreads(); F.lane = fresh_lane(); F.tid = F.wave * 64 + F.lane;
        pg8::MoeOrder S; moe_bases(F.ctl + CW_CNT, S.tb); S.ntn = 22; S.G = F.G; S.c = vcu;
        pg8::Gemm g{(const bf16*)(ws + WS_XG), (const bf16*)(ws + WS_MOEW13), MOE_ROWS, NE * 2 * FF, D};
        pg8::EpiSwiGLU E{(bf16*)(ws + WS_HIDG), FF, 22};
        pg8::gemm_phase<pg8::EpiSwiGLU, pg8::MoeOrder, true, true>(F.lds, g, S, E);
        {
            const int nlast = (S.tb[8] * 22) % F.G;
            if (nlast != 0 && vcu >= nlast) moe_weight_phase(F, KARG(36), KARG(37), KARG(38), ws, MOE_ITEMS - MOE_ITEMS_P16, MOE_ITEMS, vcu - nlast, F.G - nlast);
            else if (nlast == 0) moe_weight_phase(F, KARG(36), KARG(37), KARG(38), ws, MOE_ITEMS - MOE_ITEMS_P16, MOE_ITEMS, F.bid, F.G);
        }
    }
    SEAM(16); PROF_T1(16);
    PROF_T0(17); if (IN(17)) for (int rep_ = 0; rep_ < REPS(17); ++rep_) { if (rep_) __syncthreads(); F.lane = fresh_lane(); F.tid = F.wave * 64 + F.lane;
        pg8::MoeOrder S; moe_bases(F.ctl + CW_CNT, S.tb); S.ntn = 4; S.G = F.G; S.c = vcu;
        int first, ntail; moe_tail_split(S.tb, F.G, first, ntail); S.limit = first;
        {
            pg8::Gemm g{(const bf16*)(ws + WS_HIDG), (const bf16*)(ws + WS_MOEW2), MOE_ROWS, NE * D, FF};
            pg8::EpiPlainMod E{(bf16*)(ws + WS_YG), D, 4};
            pg8::gemm_phase<pg8::EpiPlainMod, pg8::MoeOrder, true, true>(F.lds, g, S, E);
        }
#if MOE_TAIL_SPLIT
        if (ntail > 0) {
            pg8::MoeTailOrder ST;
#pragma unroll
            for (int k = 0; k < 9; ++k) ST.tb[k] = S.tb[k];
            ST.first = first; ST.ntail = ntail; ST.G = F.G; ST.c = vcu;
            pg8::Gemm g{(const bf16*)(ws + WS_HIDG), (const bf16*)(ws + WS_MOEW2), MOE_ROWS, NE * D, 256, FF};
            pg8::EpiTailSlab E{(float*)(ws + WS_TAIL), first, ntail};
            pg8::gemm_phase<pg8::EpiTailSlab, pg8::MoeTailOrder, true, true>(F.lds, g, ST, E);
        }
#endif
    }
    SEAM(17); PROF_T1(17);
    PROF_T0(18); if (IN(18)) for (int rep_ = 0; rep_ < REPS(18); ++rep_) { if (rep_) __syncthreads(); F.lane = fresh_lane(); F.tid = F.wave * 64 + F.lane; final_phase(F, hlat, (const bf16*)(ws + WS_YG), (const unsigned*)(ws + WS_TOK), mods1, KARG(8), (const float*)(ws + WS_TAIL), F.ctl + CW_CNT); }
#undef IN
#undef SEAM
}

extern "C" void kernel_launch(void* const* d_in, const int* in_sizes, int n_in, void* d_out, int out_size, void* d_ws, size_t ws_size, hipStream_t stream) {
    static int grid = 0;
    if (grid == 0) {
        if (n_in != 39 || out_size != M_LAT * D || ws_size < WS_END) { fprintf(stderr, "kernel_launch: unexpected shapes (n_in %d, out %d, ws %zu)\n", n_in, out_size, ws_size); grid = -1; return; }
        int dev = 0, cus = 0, per_cu = 0;
        if (hipGetDevice(&dev) != hipSuccess || hipDeviceGetAttribute(&cus, hipDeviceAttributeMultiprocessorCount, dev) != hipSuccess) { grid = -1; return; }
        if (hipFuncSetAttribute((const void*)mk_fwd, hipFuncAttributeMaxDynamicSharedMemorySize, LDS_BYTES) != hipSuccess) { fprintf(stderr, "kernel_launch: hipFuncSetAttribute failed\n"); grid = -1; return; }
        if (hipOccupancyMaxActiveBlocksPerMultiprocessor(&per_cu, (const void*)mk_fwd, NWAVES * 64, LDS_BYTES) != hipSuccess || per_cu < 1) fprintf(stderr, "kernel_launch: occupancy query says %d\n", per_cu);
        (void)hipGetLastError();
        grid = cus;
    }
    if (grid < 0) return;
    if (hipMemsetAsync((char*)d_ws + WS_CTL, 0, CTL_ZERO_BYTES, stream) != hipSuccess) return;
    Args a{};
    for (int i = 0; i < 39; ++i) a.in[i] = (const float*)d_in[i];
    a.out = (float*)d_out; a.ws = (unsigned char*)d_ws;
#if MK_PER_PHASE
    for (int p = 0; p < NPHASE; ++p) { a.ph_lo = p; a.ph_hi = p + 1; hipLaunchKernelGGL(mk_fwd, dim3(grid), dim3(NWAVES * 64), LDS_BYTES, stream, a); }
#else
    a.ph_lo = 0; a.ph_hi = NPHASE; hipLaunchKernelGGL(mk_fwd, dim3(grid), dim3(NWAVES * 64), LDS_BYTES, stream, a);
#endif
}
```

```cpp
#include <hip/hip_runtime.h>
#include <cstdio>
#include <cstdint>
#include <cmath>
#define MK_PER_PHASE 0
namespace pg8 {
#define PG8_LAS __attribute__((address_space(3)))
typedef unsigned short bf16_t;
typedef short bf16x8 __attribute__((ext_vector_type(8)));
typedef float f32x4 __attribute__((ext_vector_type(4)));
typedef unsigned u32x4 __attribute__((ext_vector_type(4)));
constexpr int BM = 256, BK = 64, HALF = 128, HTB = HALF * BK * 2  , STAGE_BYTES = 8 * HTB, NXCD = 8, WGM = 8;

__host__ __device__ __forceinline__ int lds_byte(int r, int c) { const int st = (r >> 4) * 2 + (c >> 5), rr = r & 15, cc = c & 31, ob = rr * 64 + cc * 2; return st * 1024 + (ob ^ (((ob >> 9) & 1) << 5)); }
__host__ __device__ __forceinline__ void stage_rc(int b, int& R, int& C) { const int st = b / 1024, sb = b % 1024, swz = sb ^ (((sb >> 9) & 1) << 5); R = (st >> 1) * 16 + swz / 64; C = (st & 1) * 32 + (swz % 64) / 2; }
__host__ __device__ __forceinline__ int perm32(int rho) { const int n = rho >> 4, i = rho & 15; return 8 * (i >> 2) + 4 * n + (i & 3); }

#ifndef PG8_WT
#define PG8_WT 0
#endif
#if PG8_WT
#define PG8_ST16(base_, ptr_, v_) __builtin_amdgcn_raw_buffer_store_b128((v_), __builtin_amdgcn_make_buffer_rsrc((void*)(base_), (short)0, 0x7fffffff, 0x00020000), (int)((const char*)(ptr_) - (const char*)(base_)), 0, 16)
#else
#define PG8_ST16(base_, ptr_, v_) (*(u32x4*)(ptr_) = (v_))
#endif
struct Unit { int pm, pn; int k0 = 0; };
struct Gemm { const bf16_t* A; const bf16_t* Bt; int M, N, K; int ld = 0; };

struct StaticOrder {
    int nM, nN, nwg, G, c;
    __host__ __device__ void init(int M, int N, int G_, int c_) { nM = M / BM; nN = N / BM; nwg = nM * nN; G = G_; c = c_; }
    __host__ __device__ bool next(int i, Unit& u) const {
        const long L = (long)i * G + c; if (L >= nwg) return false;
        int wgid = (int)L; { const int q = nwg / NXCD, r = nwg % NXCD, xcd = wgid % NXCD, off = wgid / NXCD; wgid = (xcd < r ? xcd * (q + 1) : r * (q + 1) + (xcd - r) * q) + off; }
        const int nig = WGM * nN, gid = wgid / nig, fm = gid * WGM, gsz = (nM - fm) < WGM ? (nM - fm) : WGM;
        u.pm = fm + ((wgid % nig) % gsz); u.pn = (wgid % nig) / gsz; return true;
    }
    __device__ __forceinline__ void a_ready(const Unit&) const {}
    __device__ __forceinline__ void done(const Unit&) const {}
};

__device__ __forceinline__ unsigned cvt_pk_bf16(float lo, float hi) { unsigned r; asm volatile("v_cvt_pk_bf16_f32 %0, %1, %2" : "=v"(r) : "v"(lo), "v"(hi)); return r; }
typedef float f32x2 __attribute__((ext_vector_type(2)));
__device__ __forceinline__ f32x2 gelu_pk(f32x2 v) {
    const f32x2 av = __builtin_elementwise_abs(v), d = av * 0.2316418882f + 1.0f;
    f32x2 t; t.x = __builtin_amdgcn_rcpf(d.x); t.y = __builtin_amdgcn_rcpf(d.y);
    f32x2 q = t * 0.5307027145f + (-0.7265760135f); q = q * t + 0.7107068705f; q = q * t + (-0.142248368f); q = q * t + 0.127414796f; q = q * t;
    const f32x2 s = (v * v) * (-0.72134752044f);
    f32x2 e; e.x = __builtin_amdgcn_exp2f(s.x); e.y = __builtin_amdgcn_exp2f(s.y);
    const f32x2 m = v * (q * e), r = v - m;
    f32x2 o; o.x = v.x < 0.f ? m.x : r.x; o.y = v.y < 0.f ? m.y : r.y; return o;
}

template <int ACT  > struct EpiBf16 {
    static constexpr bool PERM = true, AFTER_DRAIN = false; static_assert(ACT == 0 || ACT == 1, "EpiBf16: ACT is 0 (none) or 1 (gelu_pk)");
    bf16_t* O; int ldc; const float* bias; int split_cols; size_t split_stride; float scale0;
    __device__ __forceinline__ void operator()(const f32x4 (&acc)[2][2][4][2], const Unit& u, int wr, int wc, int fr, int fq) const {
        const int row0 = u.pm * BM + wr * 64 + fr; int colt = u.pn * BM; bf16_t* base = O;
        float sc = 1.f; if (split_cols) { const int t = colt / split_cols; base += (size_t)t * split_stride; colt -= t * split_cols; if (t == 0) sc = scale0; }
        const int col0 = colt + wc * 32 + 8 * fq, bcol0 = u.pn * BM + wc * 32 + 8 * fq;
        f32x4 bv[2][2];
#pragma unroll
        for (int bj = 0; bj < 2; ++bj)
#pragma unroll
            for (int n = 0; n < 2; ++n) bv[bj][n] = bias ? *(const f32x4*)(bias + bcol0 + bj * HALF + 4 * n) : (f32x4){0.f, 0.f, 0.f, 0.f};
#pragma unroll
        for (int ai = 0; ai < 2; ++ai)
#pragma unroll
            for (int m = 0; m < 4; ++m) { bf16_t* rowp = base + (size_t)(row0 + ai * HALF + m * 16) * ldc + col0;
#pragma unroll
                for (int bj = 0; bj < 2; ++bj) { f32x4 v0 = acc[ai][bj][m][0] + bv[bj][0], v1 = acc[ai][bj][m][1] + bv[bj][1];
                    if (ACT == 1) { f32x2 a = gelu_pk((f32x2){v0[0], v0[1]}), b = gelu_pk((f32x2){v0[2], v0[3]}), c = gelu_pk((f32x2){v1[0], v1[1]}), d = gelu_pk((f32x2){v1[2], v1[3]});
                        v0 = (f32x4){a.x, a.y, b.x, b.y}; v1 = (f32x4){c.x, c.y, d.x, d.y}; }
                    v0 = v0 * sc; v1 = v1 * sc; u32x4 w; w.x = cvt_pk_bf16(v0[0], v0[1]); w.y = cvt_pk_bf16(v0[2], v0[3]); w.z = cvt_pk_bf16(v1[0], v1[1]); w.w = cvt_pk_bf16(v1[2], v1[3]);
                    PG8_ST16(base, rowp + bj * HALF, w); } }
    }
};
template <class Epi, class Sched, bool ALIGN_EPI = false, bool SP2 = false>
__device__ __forceinline__ void gemm_phase(PG8_LAS unsigned char* lds, const Gemm g, const Sched& S, const Epi& E) {
    int tid_ = threadIdx.x; asm volatile("" : "+v"(tid_) :: "memory");
    const int tid = tid_, wid = __builtin_amdgcn_readfirstlane(tid >> 6), lane = tid & 63, wr = wid >> 2, wc = wid & 3, fr = lane & 15, fq = lane >> 4;
    const int K = g.K, nt = K / BK, LD = g.ld ? g.ld : g.K;
    unsigned voffA[2], voffB[2];
#pragma unroll
    for (int i = 0; i < 2; ++i) { int R, C; stage_rc(tid * 16 + i * 8192, R, C); const int Rb = Epi::PERM ? ((R & ~31) + perm32(R & 31)) : R;
        voffA[i] = (unsigned)(R * LD + C) * 2u; voffB[i] = (unsigned)(Rb * LD + C) * 2u; }
    const size_t kstep = (size_t)(BK * 2);
    const size_t hstep = (size_t)HALF * LD * 2;
    const size_t tstep = 2 * hstep;
    const unsigned ldsw = (unsigned)wid * 1024u;
    const int aoff = lds_byte(wr * 64 + fr, fq * 8), boff = lds_byte(wc * 32 + fr, fq * 8);
#define PG8_SA(b, h) (((b) * 2 + (h)) * HTB)
#define PG8_SB(b, h) ((4 + (b) * 2 + (h)) * HTB)
#define PG8_STAGE(bufoff, gbase, voff) do { _Pragma("unroll") for (int _i = 0; _i < 2; ++_i) \
        __builtin_amdgcn_global_load_lds((const unsigned*)((const char*)(gbase) + (voff)[_i]), (PG8_LAS unsigned*)(lds + (bufoff) + ldsw + _i * 8192), 16, 0, 0); } while (0)
#define PG8_LDA(dst, b, h) do { _Pragma("unroll") for (int m = 0; m < 4; ++m) _Pragma("unroll") for (int k = 0; k < 2; ++k) dst[m][k] = *(const PG8_LAS bf16x8*)(lds + PG8_SA(b, h) + aoff + m * 2048 + k * 1024); } while (0)
#define PG8_LDB(dst, b, h) do { _Pragma("unroll") for (int n = 0; n < 2; ++n) _Pragma("unroll") for (int k = 0; k < 2; ++k) dst[n][k] = *(const PG8_LAS bf16x8*)(lds + PG8_SB(b, h) + boff + n * 2048 + k * 1024); } while (0)
#define PG8_MMA(ai, bj, At, Bt) do { __builtin_amdgcn_s_setprio(1); _Pragma("unroll") for (int m = 0; m < 4; ++m) _Pragma("unroll") for (int n = 0; n < 2; ++n) _Pragma("unroll") for (int k = 0; k < 2; ++k) \
        acc[ai][bj][m][n] = __builtin_amdgcn_mfma_f32_16x16x32_bf16(Bt[n][k], At[m][k], acc[ai][bj][m][n], 0, 0, 0); __builtin_amdgcn_s_setprio(0); } while (0)
#define PG8_WAIT_V(n) asm volatile("s_waitcnt vmcnt(" #n ")" ::: "memory")
#define PG8_WAIT_L(n) asm volatile("s_waitcnt lgkmcnt(" #n ")" ::: "memory")
#define PG8_BAR __builtin_amdgcn_s_barrier()
#define PG8_SCHED __builtin_amdgcn_sched_barrier(0)
    Unit cur, nxt; int ui = 0;
    if (!S.next(0, cur)) return;
    f32x4 acc[2][2][4][2];
#pragma unroll
    for (int a = 0; a < 2; ++a)
#pragma unroll
        for (int b = 0; b < 2; ++b)
#pragma unroll
            for (int m = 0; m < 4; ++m)
#pragma unroll
                for (int n = 0; n < 2; ++n) acc[a][b][m][n] = (f32x4){0.f, 0.f, 0.f, 0.f};
    bf16x8 At[4][2], B0[2][2], B1[2][2];
    const char* cA = (const char*)g.A + (size_t)cur.pm * tstep + (size_t)cur.k0 * 2; const char* cB = (const char*)g.Bt + (size_t)cur.pn * tstep + (size_t)cur.k0 * 2;
    S.a_ready(cur);
    if constexpr (SP2) {
        PG8_STAGE(PG8_SB(0, 0), cB, voffB); PG8_STAGE(PG8_SB(0, 1), cB + hstep, voffB); PG8_STAGE(PG8_SA(0, 0), cA, voffA); PG8_STAGE(PG8_SA(0, 1), cA + hstep, voffA);
        if (wr == 1) PG8_BAR;
        PG8_WAIT_V(2); PG8_BAR;
        PG8_STAGE(PG8_SB(1, 0), cB + kstep, voffB); PG8_STAGE(PG8_SA(1, 0), cA + kstep, voffA); PG8_STAGE(PG8_SB(1, 1), cB + hstep + kstep, voffB);
        PG8_WAIT_V(6); PG8_BAR;
    } else {
        PG8_STAGE(PG8_SB(0, 0), cB, voffB); PG8_STAGE(PG8_SA(0, 0), cA, voffA); PG8_STAGE(PG8_SB(0, 1), cB + hstep, voffB); PG8_STAGE(PG8_SA(0, 1), cA + hstep, voffA);
        if (wr == 1) PG8_BAR;
        PG8_WAIT_V(4); PG8_BAR;
        PG8_STAGE(PG8_SB(1, 0), cB + kstep, voffB); PG8_STAGE(PG8_SA(1, 0), cA + kstep, voffA); PG8_STAGE(PG8_SB(1, 1), cB + hstep + kstep, voffB);
        PG8_WAIT_V(6); PG8_BAR;
    }
    for (;;) {
        const bool has_next = S.next(ui + 1, nxt);
        const char* nA = has_next ? (const char*)g.A + (size_t)nxt.pm * tstep + (size_t)nxt.k0 * 2 : cA; const char* nB = has_next ? (const char*)g.Bt + (size_t)nxt.pn * tstep + (size_t)nxt.k0 * 2 : cB;
        for (int t = 0; t < nt; t += 2) {
            const bool last = (t == nt - 2);
            const char* a1 = cA + (size_t)(t + 1) * kstep;
            const char* a2 = last ? nA : cA + (size_t)(t + 2) * kstep; const char* b2 = last ? nB : cB + (size_t)(t + 2) * kstep;
            const char* a3 = a2 + kstep; const char* b3 = b2 + kstep;
            if (last && has_next) S.a_ready(nxt);
            if constexpr (SP2) {
            PG8_LDB(B0, 0, 0); PG8_LDB(B1, 0, 1); PG8_SCHED; PG8_LDA(At, 0, 0); PG8_STAGE(PG8_SA(1, 1), a1 + hstep, voffA);
            PG8_WAIT_V(8); PG8_WAIT_L(0); PG8_BAR; PG8_MMA(0, 0, At, B0); PG8_MMA(0, 1, At, B1); PG8_BAR; PG8_SCHED;
            PG8_LDA(At, 0, 1); PG8_STAGE(PG8_SB(0, 0), b2, voffB); PG8_STAGE(PG8_SB(0, 1), b2 + hstep, voffB); PG8_STAGE(PG8_SA(0, 0), a2, voffA);
            PG8_WAIT_V(8); PG8_WAIT_L(0); PG8_BAR; PG8_MMA(1, 0, At, B0); PG8_MMA(1, 1, At, B1); PG8_BAR; PG8_SCHED;
            PG8_LDB(B0, 1, 0); PG8_LDB(B1, 1, 1); PG8_SCHED; PG8_LDA(At, 1, 0); PG8_STAGE(PG8_SA(0, 1), a2 + hstep, voffA);
            PG8_WAIT_V(8); PG8_WAIT_L(0); PG8_BAR; PG8_MMA(0, 0, At, B0); PG8_MMA(0, 1, At, B1); PG8_BAR; PG8_SCHED;
            PG8_LDA(At, 1, 1); PG8_STAGE(PG8_SB(1, 0), b3, voffB); PG8_STAGE(PG8_SB(1, 1), b3 + hstep, voffB); PG8_STAGE(PG8_SA(1, 0), a3, voffA);
            PG8_WAIT_V(8); PG8_WAIT_L(0); PG8_BAR; PG8_MMA(1, 0, At, B0); PG8_MMA(1, 1, At, B1); PG8_BAR; PG8_SCHED;
            } else {
            PG8_LDB(B0, 0, 0); PG8_SCHED; PG8_LDA(At, 0, 0); PG8_STAGE(PG8_SA(1, 1), a1 + hstep, voffA);
            PG8_WAIT_L(8); PG8_BAR; PG8_WAIT_L(0); PG8_MMA(0, 0, At, B0); PG8_BAR; PG8_SCHED;
            PG8_LDB(B1, 0, 1); PG8_STAGE(PG8_SB(0, 0), b2, voffB);
            PG8_BAR; PG8_WAIT_L(0); PG8_MMA(0, 1, At, B1); PG8_BAR;
            PG8_LDA(At, 0, 1); PG8_STAGE(PG8_SA(0, 0), a2, voffA);
            PG8_BAR; PG8_WAIT_L(0); PG8_MMA(1, 0, At, B0); PG8_BAR; PG8_SCHED;
            PG8_STAGE(PG8_SB(0, 1), b2 + hstep, voffB);
            PG8_WAIT_V(6); PG8_BAR; PG8_MMA(1, 1, At, B1); PG8_BAR;
            PG8_LDB(B0, 1, 0); PG8_SCHED; PG8_LDA(At, 1, 0); PG8_STAGE(PG8_SA(0, 1), a2 + hstep, voffA);
            PG8_WAIT_L(8); PG8_BAR; PG8_WAIT_L(0); PG8_MMA(0, 0, At, B0); PG8_BAR; PG8_SCHED;
            PG8_LDB(B1, 1, 1); PG8_STAGE(PG8_SB(1, 0), b3, voffB);
            PG8_BAR; PG8_WAIT_L(0); PG8_MMA(0, 1, At, B1); PG8_BAR;
            PG8_LDA(At, 1, 1); PG8_STAGE(PG8_SA(1, 0), a3, voffA);
            PG8_BAR; PG8_WAIT_L(0); PG8_MMA(1, 0, At, B0); PG8_BAR; PG8_SCHED;
            PG8_STAGE(PG8_SB(1, 1), b3 + hstep, voffB);
            PG8_WAIT_V(6); PG8_BAR; PG8_MMA(1, 1, At, B1); PG8_BAR;
            }
        }
        if constexpr (ALIGN_EPI) { if (wr == 0) PG8_BAR; }
        if constexpr (!Epi::AFTER_DRAIN) { E(acc, cur, wr, wc, fr, fq); S.done(cur); }
        if (!has_next) break;
#pragma unroll
        for (int a = 0; a < 2; ++a)
#pragma unroll
            for (int b = 0; b < 2; ++b)
#pragma unroll
                for (int m = 0; m < 4; ++m)
#pragma unroll
                    for (int n = 0; n < 2; ++n) acc[a][b][m][n] = (f32x4){0.f, 0.f, 0.f, 0.f};
        cur = nxt; cA = nA; cB = nB; ++ui;
        if constexpr (ALIGN_EPI) { if (wr == 1) PG8_BAR; }
    }
    PG8_WAIT_V(0);
    if constexpr (!ALIGN_EPI) { if (wr == 0) PG8_BAR; }
    PG8_BAR;
    if constexpr (Epi::AFTER_DRAIN) { E.fused(acc, cur, wr, wc, fr, fq, lds, wid, lane); S.done(cur); }
#undef PG8_SA
#undef PG8_SB
#undef PG8_STAGE
#undef PG8_LDA
#undef PG8_LDB
#undef PG8_MMA
#undef PG8_WAIT_V
#undef PG8_WAIT_L
#undef PG8_BAR
#undef PG8_SCHED
}
}

#define GAS __attribute__((address_space(1)))
#define LAS __attribute__((address_space(3)))
typedef unsigned short bf16;
typedef unsigned v4u __attribute__((ext_vector_type(4)));
typedef float f32x4 __attribute__((ext_vector_type(4)));
typedef short bf16x8 __attribute__((ext_vector_type(8)));
typedef GAS unsigned gu32;
typedef GAS unsigned long long gu64;
#define RLX_AGENT __ATOMIC_RELAXED, __HIP_MEMORY_SCOPE_AGENT
#define LDS_WAIT() asm volatile("s_waitcnt lgkmcnt(0)" ::: "memory")
#define VM_WAIT() asm volatile("s_waitcnt vmcnt(0)" ::: "memory")
__device__ __forceinline__ unsigned long long rt() { return __builtin_amdgcn_s_memrealtime(); }
typedef float f32x2_t __attribute__((ext_vector_type(2))); typedef __bf16 bf16x2_t __attribute__((ext_vector_type(2)));
__device__ __forceinline__ unsigned pk2(float lo, float hi) { const f32x2_t v = {lo, hi}; const bf16x2_t b = __builtin_convertvector(v, bf16x2_t); return __builtin_bit_cast(unsigned, b); }
__device__ __forceinline__ unsigned f2bf(float f) { return pk2(f, f) & 0xffffu; }
#define XB_TMO      128
#define XB_XCNT(j)  (256  + 64 * (j))
#define XB_XSUB(j)  (1280 + 64 * (j))
#define XB_XGEN(j)  (2304 + 64 * (j))
#define XB_TOP      3328
#define XB_TOPGEN   3392
#define XCD_BAR_WORDS 3456
#define XB_SPIN_CAP (1u << 18)

__device__ __forceinline__ unsigned xb_ld(unsigned* p)              { return __hip_atomic_load(p, __ATOMIC_RELAXED, __HIP_MEMORY_SCOPE_AGENT); }
__device__ __forceinline__ unsigned xb_add(unsigned* p, unsigned v) { return __hip_atomic_fetch_add(p, v, __ATOMIC_RELAXED, __HIP_MEMORY_SCOPE_AGENT); }
__device__ __forceinline__ unsigned xb_xcc_id() { return (unsigned)__builtin_amdgcn_s_getreg((3 << 11) | 20) & 0xFu; }
#define XB_SPIN(cond, bar) do { unsigned _sp = 0; while (cond) { __builtin_amdgcn_s_sleep(1); \
    if ((++_sp & 255u) == 0u) { if (xb_ld(&(bar)[XB_TMO])) break; if (_sp > XB_SPIN_CAP) { atomicAdd(&(bar)[XB_TMO], 1u); break; } } } } while (0)

struct XcdBarrier {
    unsigned* bar; unsigned x;
    volatile LAS unsigned* st;
};

__device__ __forceinline__ XcdBarrier xcd_barrier_post(unsigned* bar, volatile LAS unsigned* st) {
    XcdBarrier b; b.bar = bar; b.x = xb_xcc_id(); b.st = st;
    if (threadIdx.x == 0) (void)xb_add(&bar[XB_XCNT(b.x)], 1u);
    return b;
}
__device__ __forceinline__ void xcd_barrier_complete(unsigned* bar, unsigned x, unsigned& nloc, unsigned& nx) {
    const unsigned G = gridDim.x * gridDim.y * gridDim.z;
    unsigned sum, cnt, mine, sp = 0u;
    for (;;) {
        sum = 0u; cnt = 0u; mine = 0u;
#pragma unroll
        for (unsigned j = 0; j < 16; ++j) { const unsigned c = xb_ld(&bar[XB_XCNT(j)]); sum += c; cnt += (c > 0u) ? 1u : 0u; mine = (j == x) ? c : mine; }
        if (sum == G) break;
        __builtin_amdgcn_s_sleep(1);
        if ((++sp & 255u) == 0u) { if (xb_ld(&bar[XB_TMO])) break; if (sp > XB_SPIN_CAP) { atomicAdd(&bar[XB_TMO], 1u); break; } }
    }
    nloc = mine > 0u ? mine : 1u; nx = cnt > 0u ? cnt : 1u;
}

__device__ __forceinline__ void xcd_barrier(const XcdBarrier& b) {
    asm volatile("s_waitcnt vmcnt(0)" ::: "memory");
    __syncthreads();
    if (threadIdx.x == 0) {
        unsigned* bar = b.bar;
        __builtin_amdgcn_s_waitcnt(0);
        unsigned nloc = b.st[0], nx = b.st[1];
        if (nloc == 0u) { xcd_barrier_complete(bar, b.x, nloc, nx); b.st[0] = nloc; b.st[1] = nx; }
        const unsigned old = xb_add(&bar[XB_XSUB(b.x)], 1u);
        const unsigned gen = old / nloc;
        if (old + 1u == (gen + 1u) * nloc) {
            __builtin_amdgcn_fence(__ATOMIC_RELEASE, "agent");
            asm volatile("s_waitcnt vmcnt(0)" ::: "memory");
            const unsigned og = xb_add(&bar[XB_TOP], 1u);
            const unsigned tg = og / nx;
            if (og + 1u == (tg + 1u) * nx) xb_add(&bar[XB_TOPGEN], 1u);
            else XB_SPIN(xb_ld(&bar[XB_TOPGEN]) == tg, bar);
            __builtin_amdgcn_fence(__ATOMIC_ACQUIRE, "agent");
            xb_add(&bar[XB_XGEN(b.x)], 1u);
            asm volatile("s_waitcnt vmcnt(0)" ::: "memory");
        } else {
            XB_SPIN(xb_ld(&bar[XB_XGEN(b.x)]) == gen, bar);
            __builtin_amdgcn_fence(__ATOMIC_ACQUIRE, "agent");
            asm volatile("s_waitcnt vmcnt(0)" ::: "memory");
        }
    }
    __syncthreads();
}


constexpr int NWAVES = 8, NTHR = 512;
constexpr int D = 1024, NB = 8, SEQ = 2048, CTXL = 256;
constexpr int M_CTX = NB * CTXL, M_LAT = NB * SEQ, M_ALL = M_CTX + M_LAT;
constexpr int RWC = 1760, MIXIN = 3312, ZLD = 3328, FF = 2816, NE = 8;
constexpr int PRV = 9 * 512;
constexpr int MOE_ROWS = 34816;
constexpr size_t MiB = 1u << 20;
constexpr size_t WS_CTL = 0, CTL_ZERO_BYTES = 1 * MiB;
constexpr size_t WS_MODS = 1 * MiB;
constexpr size_t WS_TOK = 1 * MiB + 512 * 1024;
constexpr size_t WS_WIN_T = 2 * MiB;
constexpr size_t WS_WOUT_T = WS_WIN_T + (size_t)ZLD * D * 2;
constexpr size_t WS_W13_T = WS_WOUT_T + 2 * MiB;
constexpr size_t WS_W2_T = WS_W13_T + 11 * MiB;
constexpr size_t WS_QKV_T = WS_W2_T + (size_t)D * FF * 2;
constexpr size_t WS_NAO_T = WS_QKV_T + 6 * MiB;
constexpr size_t WS_HCTX = 35 * MiB;
constexpr size_t WS_A = 43 * MiB;
constexpr size_t WS_R = 79 * MiB;
constexpr size_t WS_Z = WS_R;
constexpr size_t WS_PR = 196 * MiB;
constexpr size_t WS_PM = 358 * MiB;
constexpr size_t WS_DT = 394 * MiB;
constexpr size_t WS_BONUS = 395 * MiB + 256 * 1024;
constexpr size_t WS_GATE = 396 * MiB;
constexpr size_t WS_ZG = 414 * MiB;
constexpr size_t WS_YRW = WS_R;
constexpr size_t WS_YMB = WS_R + 36 * MiB;
constexpr size_t WS_HID = WS_R;
constexpr size_t WS_MOEW13 = 316 * MiB;
constexpr size_t WS_MOEW2 = 404 * MiB;
constexpr size_t WS_Q = WS_R, WS_K = WS_R + 36 * MiB, WS_V = WS_R + 72 * MiB;
constexpr size_t WS_O = WS_R + 108 * MiB;
constexpr size_t WS_A4 = 111 * MiB;
constexpr size_t WS_XG = 43 * MiB;
constexpr size_t WS_HIDG = 111 * MiB;
constexpr size_t WS_YG = 43 * MiB;
constexpr size_t WS_SLAB6 = WS_R;
constexpr size_t WS_SLAB9 = WS_R + 99 * MiB;
constexpr size_t WS_TAIL = 316 * MiB;
constexpr size_t WS_A2 = 196 * MiB;
constexpr size_t WS_XBUF = 300 * MiB;
constexpr size_t WS_END = 448 * MiB;
static_assert(WS_NAO_T + 2 * MiB <= WS_HCTX && WS_ZG + 18 * MiB <= WS_END && WS_MOEW2 + 44 * MiB <= WS_END && WS_HIDG + (size_t)MOE_ROWS * FF * 2 <= WS_MOEW13, "ws map");
static_assert(WS_Z + (size_t)M_ALL * ZLD * 2 <= WS_PR && WS_PR + (size_t)M_ALL * PRV * 2 <= WS_PM && WS_XG + (size_t)MOE_ROWS * D * 2 <= WS_HIDG, "ws map 2");
constexpr int CW_TMO = 0, CW_CODE = 1, CW_BAR = 4096, CW_CNT = 8192, CW_CNTB = 16384, CW_XCNT = 131072;
constexpr int RING_BYTES = 131072, LDSCTL_OFF = 145408, MISC_OFF = LDSCTL_OFF + 320, LDS_BYTES = 147456;

typedef unsigned v2u __attribute__((ext_vector_type(2)));
typedef float v2f __attribute__((ext_vector_type(2)));
typedef short s16x4 __attribute__((ext_vector_type(4)));
typedef short v4i16_t __attribute__((ext_vector_type(4)));
__device__ __forceinline__ float bflo(unsigned u) { return __uint_as_float(u << 16); }
__device__ __forceinline__ float bfhi(unsigned u) { return __uint_as_float(u & 0xffff0000u); }
__device__ __forceinline__ float ldbf(const bf16* p) { return __uint_as_float((unsigned)(*p) << 16); }
__device__ __forceinline__ float sigm(float x) { return __builtin_amdgcn_rcpf(1.f + __expf(-x)); }
__device__ __forceinline__ bf16x8 pack8(const f32x4& a, const f32x4& b) {
    v4u w; w.x = pk2(a[0], a[1]); w.y = pk2(a[2], a[3]); w.z = pk2(b[0], b[1]); w.w = pk2(b[2], b[3]); return __builtin_bit_cast(bf16x8, w);
}
template <int CTRL> __device__ __forceinline__ float dppf(float x) { return __int_as_float(__builtin_amdgcn_update_dpp(0, __float_as_int(x), CTRL, 0xF, 0xF, true)); }
__device__ __forceinline__ float sum8(float x) { x += dppf<0xB1>(x); x += dppf<0x4E>(x); x += dppf<0x141>(x); return x; }
__device__ __forceinline__ float sum16(float x) { x = sum8(x); x += dppf<0x140>(x); return x; }
__device__ __forceinline__ float rlf(float v, int l) { return __int_as_float(__builtin_amdgcn_readlane(__float_as_int(v), l)); }
__device__ __forceinline__ float wave_sum(float v) { v = sum16(v); return (rlf(v, 0) + rlf(v, 16)) + (rlf(v, 32) + rlf(v, 48)); }
__device__ __forceinline__ float half_sum(float v, int lane) { v = sum16(v); const float lo = rlf(v, 0) + rlf(v, 16), hi = rlf(v, 32) + rlf(v, 48); return lane < 32 ? lo : hi; }

struct Frame {
    LAS unsigned char* lds;
    volatile LAS unsigned* MISC;
    gu32* ctl;
    int tid, lane, wave, G, bid;
};

__device__ __forceinline__ void tr_item(const float* W, int K, int N, bf16* WT, int drow0, int k0, int n0, LAS float* scr, int lane) {
    const int nn = n0 + (lane & 31);
    float t[32];
#pragma unroll
    for (int i = 0; i < 32; ++i) { const int kk = 2 * i + (lane >> 5); t[i] = (nn < N) ? W[(size_t)(k0 + kk) * N + nn] : 0.f; }
#pragma unroll
    for (int i = 0; i < 32; ++i) { const int kk = 2 * i + (lane >> 5); scr[kk * 33 + (lane & 31)] = t[i]; }
    LDS_WAIT(); asm volatile("" ::: "memory");
    const int c = lane & 7;
#pragma unroll
    for (int j = 0; j < 4; ++j) { const int n = (lane >> 3) + 8 * j; const LAS float* s = scr + (8 * c) * 33 + n;
        v4u o; o.x = pk2(s[0 * 33], s[1 * 33]); o.y = pk2(s[2 * 33], s[3 * 33]); o.z = pk2(s[4 * 33], s[5 * 33]); o.w = pk2(s[6 * 33], s[7 * 33]);
        *(GAS v4u*)(WT + (size_t)(drow0 + n) * K + k0 + 8 * c) = o; }
    LDS_WAIT(); asm volatile("" ::: "memory");
}
template <int MODE  >
__device__ __forceinline__ bool tr_matrix(int& it, const float* W, int K, int N, bf16* WT, LAS float* scr, int lane) {
    const int nblk = (N + 31) / 32, items = (K / 64) * nblk;
    if (it >= items) { it -= items; return false; }
    const int kb = it / nblk, nb = it % nblk, n0 = nb * 32;
    int drow0 = n0;
    if (MODE == 1) drow0 = (n0 >> 7) * 256 + (n0 & 127);
    if (MODE == 2) drow0 = (n0 >> 7) * 256 + 128 + (n0 & 127);
    tr_item(W, K, N, WT, drow0, kb * 64, n0, scr, lane);
    return true;
}

__device__ __forceinline__ void p0_phase(Frame& F, const float* c, const float* c_ctx, const float* w_ada, const float* b_ada, float* mods,
                                         const float* mix_w_in, const float* mix_w_out, const float* ffn_w1, const float* ffn_w3, const float* ffn_w2,
                                         const float* na_w_qkv, const float* na_w_out, unsigned char* ws) {
    for (int u = F.bid; u < 192; u += F.G) {
        LAS float* sc = (LAS float*)(F.lds);
        LAS float* red = (LAS float*)(F.lds + 36864);
        for (int i = F.tid; i < 9 * 1024; i += NTHR) { const int b = i >> 10, k = i & 1023; const float v = (b < 8) ? c[b * 1024 + k] : c_ctx[k]; sc[i] = v / (1.f + __expf(-v)); }
        __syncthreads();
        const int layer = u / 96, col = (u % 96) * 64 + F.lane;
        const float* W = w_ada + (size_t)layer * 1024 * 6144 + col;
        float acc[9];
#pragma unroll
        for (int b = 0; b < 9; ++b) acc[b] = 0.f;
        const int k0 = F.wave * 128;
#pragma unroll 8
        for (int k = 0; k < 128; ++k) { const float w = W[(size_t)(k0 + k) * 6144];
#pragma unroll
            for (int b = 0; b < 9; ++b) acc[b] += sc[b * 1024 + k0 + k] * w; }
#pragma unroll
        for (int b = 0; b < 9; ++b) red[(F.wave * 9 + b) * 64 + F.lane] = acc[b];
        __syncthreads();
        if (F.wave == 0) {
#pragma unroll
            for (int b = 0; b < 9; ++b) { float s = 0.f;
#pragma unroll
                for (int w = 0; w < 8; ++w) s += red[(w * 9 + b) * 64 + F.lane];
                mods[(layer * 9 + b) * 6144 + col] = s + b_ada[layer * 6144 + col]; }
        }
        __syncthreads();
    }
    LAS float* scr = (LAS float*)(F.lds + 57344 + F.wave * 8704);
    const int gw = F.bid * NWAVES + F.wave, NGW = F.G * NWAVES;
    constexpr int NITEMS = 16 * 104 + 512 + 1408 * 3 + 1536 + 512;
    for (int it0 = gw; it0 < NITEMS; it0 += NGW) {
        int it = it0;
        if (tr_matrix<0>(it, mix_w_in, 1024, MIXIN, (bf16*)(ws + WS_WIN_T), scr, F.lane)) continue;
        if (tr_matrix<0>(it, mix_w_out, 1024, 1024, (bf16*)(ws + WS_WOUT_T), scr, F.lane)) continue;
        if (tr_matrix<1>(it, ffn_w1, 1024, FF, (bf16*)(ws + WS_W13_T), scr, F.lane)) continue;
        if (tr_matrix<2>(it, ffn_w3, 1024, FF, (bf16*)(ws + WS_W13_T), scr, F.lane)) continue;
        if (tr_matrix<0>(it, ffn_w2, FF, 1024, (bf16*)(ws + WS_W2_T), scr, F.lane)) continue;
        if (tr_matrix<0>(it, na_w_qkv, 1024, 3072, (bf16*)(ws + WS_QKV_T), scr, F.lane)) continue;
        tr_matrix<0>(it, na_w_out, 1024, 1024, (bf16*)(ws + WS_NAO_T), scr, F.lane);
    }
}
constexpr int MOE_ITEMS = NE * 1408 * 3, MOE_W13_ITEMS = NE * 2816, MOE_ITEMS_P6 = 0, MOE_ITEMS_P8 = 10240, MOE_ITEMS_P9 = 16384, MOE_ITEMS_P11 = 0, MOE_ITEMS_P16 = 7168, MOE_ITEMS_P7 = MOE_ITEMS - MOE_ITEMS_P8 - MOE_ITEMS_P9 - MOE_ITEMS_P11 - MOE_ITEMS_P16;
static_assert(MOE_ITEMS - MOE_ITEMS_P16 >= MOE_W13_ITEMS, "the items left for P16's idle workgroups must all be w2 items (the w1|w3 copies are read by P16 itself)");
__device__ __forceinline__ void moe_weight_phase(Frame& F, const float* w1, const float* w3, const float* w2, unsigned char* ws, int lo, int hi, int widx, int nw) {
    LAS float* scr = (LAS float*)(F.lds + 57344 + F.wave * 8704);
    const int gw = widx * NWAVES + F.wave, NGW = nw * NWAVES;
    for (int it0 = lo + gw; it0 < hi; it0 += NGW) {
        const bool isw2 = it0 >= MOE_W13_ITEMS; const int e = isw2 ? (it0 - MOE_W13_ITEMS) / 1408 : it0 / 2816; int it = isw2 ? 2816 + (it0 - MOE_W13_ITEMS) % 1408 : it0 % 2816;
        bf16* w13t = (bf16*)(ws + WS_MOEW13) + (size_t)e * 5632 * 1024; bf16* w2t = (bf16*)(ws + WS_MOEW2) + (size_t)e * 1024 * FF;
        if (tr_matrix<1>(it, w1 + (size_t)e * 1024 * FF, 1024, FF, w13t, scr, F.lane)) continue;
        if (tr_matrix<2>(it, w3 + (size_t)e * 1024 * FF, 1024, FF, w13t, scr, F.lane)) continue;
        tr_matrix<0>(it, w2 + (size_t)e * 1024 * FF, FF, 1024, w2t, scr, F.lane);
    }
}

struct RowIn { f32x4 x[4], sh[4], sc[4]; };
__device__ __forceinline__ void row_fetch(RowIn& R, const float* xrow, const float* sh, const float* sc, int lane) {
#pragma unroll
    for (int j = 0; j < 4; ++j) { R.x[j] = ((const GAS f32x4*)xrow)[lane + 64 * j]; R.sh[j] = ((const GAS f32x4*)sh)[lane + 64 * j]; R.sc[j] = ((const GAS f32x4*)sc)[lane + 64 * j]; }
}
__device__ __forceinline__ void row_finish(const RowIn& R, const f32x4 (&gg)[4], bf16* orow, int lane, f32x4 (&a)[4], const float* slab = nullptr, int nslab = 0, float* wb = nullptr) {
    float ss = 0.f;
#pragma unroll
    for (int j = 0; j < 4; ++j) a[j] = R.x[j];
    for (int s = 0; s < nslab; ++s) { const GAS f32x4* sr = (const GAS f32x4*)(slab + (size_t)s * (2048 * 1024)) + lane;
#pragma unroll
        for (int j = 0; j < 4; ++j) a[j] += sr[64 * j]; }
    if (wb) { GAS f32x4* w4 = (GAS f32x4*)wb + lane;
#pragma unroll
        for (int j = 0; j < 4; ++j) w4[64 * j] = a[j]; }
#pragma unroll
    for (int j = 0; j < 4; ++j) ss += (a[j].x * a[j].x + a[j].y * a[j].y) + (a[j].z * a[j].z + a[j].w * a[j].w);
    const float rs = rsqrtf(wave_sum(ss) * (1.f / 1024.f) + 1e-6f);
    GAS unsigned long long* o8 = (GAS unsigned long long*)orow + lane;
#pragma unroll
    for (int j = 0; j < 4; ++j) {
        a[j] = (a[j] * rs) * gg[j] * (R.sc[j] + 1.f) + R.sh[j];
        o8[64 * j] = (unsigned long long)pk2(a[j].x, a[j].y) | ((unsigned long long)pk2(a[j].z, a[j].w) << 32);
    }
}
__device__ __forceinline__ void normmod_phase(Frame& F, const float* src_ctx, const float* src_lat, const float* g, const float* mods_l, int off_shift, int off_scale, bf16* dst, const float* slab = nullptr, int nslab = 0, float* wb_ctx = nullptr, int m_end = M_ALL) {
    const int gw = F.bid * NWAVES + F.wave, NGW = F.G * NWAVES;
    f32x4 gg[4];
#pragma unroll
    for (int j = 0; j < 4; ++j) gg[j] = ((const GAS f32x4*)g)[F.lane + 64 * j];
    RowIn cur, nxt;
    int r = gw; bool have = r < m_end;
#define NM_FETCH(R_, r_) do { const bool ic_ = (r_) < M_CTX; const int rl_ = ic_ ? (r_) : (r_) - M_CTX; const float* mp_ = mods_l + (ic_ ? 8 : (rl_ >> 11)) * 6144; \
        row_fetch(R_, (ic_ ? src_ctx : src_lat) + (size_t)rl_ * D, mp_ + off_shift, mp_ + off_scale, F.lane); } while (0)
    if (have) NM_FETCH(cur, r);
    while (have) {
        const int rn = r + NGW; const bool hn = rn < m_end;
        if (hn) NM_FETCH(nxt, rn);
        const bool isctx = r < M_CTX; const int rl = isctx ? r : r - M_CTX;
        f32x4 a[4];
        if (isctx) row_finish(cur, gg, dst + (size_t)r * D, F.lane, a, slab ? slab + (size_t)rl * D : nullptr, nslab, wb_ctx ? wb_ctx + (size_t)rl * D : nullptr);
        else row_finish(cur, gg, dst + (size_t)r * D, F.lane, a);
        cur = nxt; r = rn; have = hn;
    }
#undef NM_FETCH
}

namespace pg8 {
struct EpiResGate {
    static constexpr bool PERM = false, AFTER_DRAIN = false;
    const float* base_c; const float* base_l; float* out_c; float* out_l; const float* mods_l; int gate_off; int ctx_tiles;
    __device__ __forceinline__ void operator()(const f32x4 (&acc)[2][2][4][2], const Unit& u, int wr, int wc, int fr, int fq) const {
        const bool isctx = u.pm < ctx_tiles; const int rt = isctx ? u.pm : u.pm - ctx_tiles; const int mi = isctx ? 8 : (rt >> 3);
        const float* base = isctx ? base_c : base_l; float* out = isctx ? out_c : out_l;
        const int col0 = u.pn * BM + wc * 32 + 4 * fq; const float* gp = mods_l + mi * 6144 + gate_off + col0;
        f32x4 gv[2][2];
#pragma unroll
        for (int bj = 0; bj < 2; ++bj)
#pragma unroll
            for (int n = 0; n < 2; ++n) gv[bj][n] = *(const f32x4*)(gp + bj * HALF + n * 16);
#pragma unroll
        for (int ai = 0; ai < 2; ++ai)
#pragma unroll
            for (int m = 0; m < 4; ++m) { const size_t off = (size_t)(rt * BM + ai * HALF + wr * 64 + m * 16 + fr) * 1024 + col0;
#pragma unroll
                for (int bj = 0; bj < 2; ++bj)
#pragma unroll
                    for (int n = 0; n < 2; ++n) { const f32x4 b = *(const f32x4*)(base + off + bj * HALF + n * 16); *(f32x4*)(out + off + bj * HALF + n * 16) = b + gv[bj][n] * acc[ai][bj][m][n]; } }
    }
};
struct EpiResGateNorm {
    static constexpr bool PERM = false, AFTER_DRAIN = true;
    const float* base; float* out; const float* mods_l; int gate_off;
    const float* g; int off_shift, off_scale; bf16_t* dst;
    float* xbuf; unsigned* cnt;
    __device__ __forceinline__ void operator()(const f32x4 (&)[2][2][4][2], const Unit&, int, int, int, int) const {}
    __device__ __forceinline__ void fused(f32x4 (&acc)[2][2][4][2], const Unit& u, int wr, int wc, int fr, int fq, PG8_LAS unsigned char* lds, int wid, int lane) const {
        PG8_LAS float* P = (PG8_LAS float*)lds;
        PG8_LAS float* S = (PG8_LAS float*)(lds + 4096);
        const int rt = u.pm, col0 = u.pn * BM + wc * 32 + 4 * fq; const float* mp = mods_l + (rt >> 3) * 6144 + col0;
        const unsigned r0 = (unsigned)((rt * BM + wr * 64 + fr) * 1024 + col0) * 4u;
        unsigned rb = r0; constexpr int NB = 12;
#define ERN_IDX(i) const int bj_ = (i) >> 4, n_ = ((i) >> 3) & 1, ai_ = ((i) >> 2) & 1, m_ = (i) & 3
#pragma unroll
        for (int b0 = 0; b0 < 32; b0 += NB) { f32x4 bv[NB];
            if (b0) {
#pragma unroll
                for (int i = b0 - NB; i < b0; ++i) { ERN_IDX(i); asm volatile("" : "+v"(rb) : "v"(acc[ai_][bj_][m_][n_][3])); } }
#pragma unroll
            for (int i = b0; i < b0 + NB && i < 32; ++i) { ERN_IDX(i); bv[i - b0] = *(const f32x4*)((const char*)base + (rb + (unsigned)(((ai_ * HALF + m_ * 16) * 1024 + bj_ * HALF + n_ * 16) * 4))); }
#pragma unroll
            for (int i = b0; i < b0 + NB && i < 32; ++i) { ERN_IDX(i); const f32x4 gv = *(const f32x4*)(mp + gate_off + bj_ * HALF + n_ * 16); acc[ai_][bj_][m_][n_] = bv[i - b0] + gv * acc[ai_][bj_][m_][n_]; } }
#undef ERN_IDX
#pragma unroll
        for (int ai = 0; ai < 2; ++ai)
#pragma unroll
            for (int m = 0; m < 4; ++m) { float s = 0.f;
#pragma unroll
                for (int bj = 0; bj < 2; ++bj)
#pragma unroll
                    for (int n = 0; n < 2; ++n) { const f32x4 x = acc[ai][bj][m][n]; s += (x[0] * x[0] + x[1] * x[1]) + (x[2] * x[2] + x[3] * x[3]); }
                s += __shfl_xor(s, 16); s += __shfl_xor(s, 32);
                if (fq == 0) P[(ai * HALF + wr * 64 + m * 16 + fr) * 4 + wc] = s; }
        asm volatile("s_waitcnt lgkmcnt(0)" ::: "memory"); __builtin_amdgcn_s_barrier(); asm volatile("" ::: "memory");
        const int row = wid * 32 + (lane & 31);
        if (lane < 32) { const float t = (P[row * 4 + 0] + P[row * 4 + 1]) + (P[row * 4 + 2] + P[row * 4 + 3]);
            __hip_atomic_store(xbuf + (size_t)(rt * BM + row) * 4 + u.pn, t, __ATOMIC_RELAXED, __HIP_MEMORY_SCOPE_AGENT); }
        asm volatile("s_waitcnt vmcnt(0)" ::: "memory");
        if (lane == 0) __hip_atomic_fetch_add(cnt + 64 * rt, 1u, __ATOMIC_RELAXED, __HIP_MEMORY_SCOPE_AGENT);
#pragma unroll
        for (int ai = 0; ai < 2; ++ai)
#pragma unroll
            for (int m = 0; m < 4; ++m)
#pragma unroll
                for (int bj = 0; bj < 2; ++bj)
#pragma unroll
                    for (int n = 0; n < 2; ++n) *(f32x4*)((char*)out + (r0 + (unsigned)(((ai * HALF + m * 16) * 1024 + bj * HALF + n * 16) * 4))) = acc[ai][bj][m][n];
        if (wid == 0) {
            while ((unsigned)__builtin_amdgcn_readfirstlane(__hip_atomic_load(cnt + 64 * rt, __ATOMIC_RELAXED, __HIP_MEMORY_SCOPE_AGENT)) < 32u) __builtin_amdgcn_s_sleep(2);
            __builtin_amdgcn_fence(__ATOMIC_ACQUIRE, "agent");
        }
        asm volatile("s_waitcnt lgkmcnt(0)" ::: "memory"); __builtin_amdgcn_s_barrier(); asm volatile("" ::: "memory");
        if (lane < 32) { const float* sl = xbuf + (size_t)(rt * BM + row) * 4;
            const float t = (__hip_atomic_load(sl + 0, __ATOMIC_RELAXED, __HIP_MEMORY_SCOPE_AGENT) + __hip_atomic_load(sl + 1, __ATOMIC_RELAXED, __HIP_MEMORY_SCOPE_AGENT))
                          + (__hip_atomic_load(sl + 2, __ATOMIC_RELAXED, __HIP_MEMORY_SCOPE_AGENT) + __hip_atomic_load(sl + 3, __ATOMIC_RELAXED, __HIP_MEMORY_SCOPE_AGENT));
            S[row] = rsqrtf(t * (1.f / 1024.f) + 1e-6f); }
        asm volatile("s_waitcnt vmcnt(0) lgkmcnt(0)" ::: "memory"); __builtin_amdgcn_s_barrier(); asm volatile("" ::: "memory");
        float rs[2][4]; int fr2; asm volatile("v_mbcnt_lo_u32_b32 %0, -1, 0\n\tv_mbcnt_hi_u32_b32 %0, -1, %0" : "=v"(fr2)); fr2 &= 15;
#pragma unroll
        for (int ai = 0; ai < 2; ++ai)
#pragma unroll
            for (int m = 0; m < 4; ++m) rs[ai][m] = S[ai * HALF + wr * 64 + m * 16 + fr2];
        asm volatile("s_waitcnt lgkmcnt(0)" ::: "memory"); __builtin_amdgcn_s_barrier(); asm volatile("" ::: "memory");
#pragma unroll
        for (int bj = 0; bj < 2; ++bj)
#pragma unroll
            for (int n = 0; n < 2; ++n) { const int c = bj * HALF + n * 16;
                const f32x4 gg = *(const f32x4*)(g + col0 + c), sc = *(const f32x4*)(mp + off_scale + c) + 1.f, sh = *(const f32x4*)(mp + off_shift + c);
#pragma unroll
                for (int ai = 0; ai < 2; ++ai)
#pragma unroll
                    for (int m = 0; m < 4; ++m) { const f32x4 v = ((acc[ai][bj][m][n] * rs[ai][m]) * gg) * sc + sh;
                        *(unsigned long long*)((char*)dst + ((r0 >> 1) + (unsigned)(((ai * HALF + m * 16) * 1024 + c) * 2))) = (unsigned long long)cvt_pk_bf16(v[0], v[1]) | ((unsigned long long)cvt_pk_bf16(v[2], v[3]) << 32); } }
    }
};
struct EpiSwiGLU {
    static constexpr bool PERM = true, AFTER_DRAIN = false;
    bf16_t* O; int ldo; int nt_mod;
    __device__ __forceinline__ void operator()(const f32x4 (&acc)[2][2][4][2], const Unit& u, int wr, int wc, int fr, int fq) const {
        const int pnl = u.pn % nt_mod; const int row0 = u.pm * BM + wr * 64 + fr, col0 = pnl * HALF + wc * 32 + 8 * fq;
#pragma unroll
        for (int ai = 0; ai < 2; ++ai)
#pragma unroll
            for (int m = 0; m < 4; ++m) { bf16_t* rowp = O + (size_t)(row0 + ai * HALF + m * 16) * ldo + col0;
                float h[8];
#pragma unroll
                for (int n = 0; n < 2; ++n)
#pragma unroll
                    for (int e = 0; e < 4; ++e) { const float a = acc[ai][0][m][n][e], b = acc[ai][1][m][n][e]; h[n * 4 + e] = a * b * __builtin_amdgcn_rcpf(1.f + __expf(-a)); }
                u32x4 w; w.x = cvt_pk_bf16(h[0], h[1]); w.y = cvt_pk_bf16(h[2], h[3]); w.z = cvt_pk_bf16(h[4], h[5]); w.w = cvt_pk_bf16(h[6], h[7]);
                PG8_ST16(O, rowp, w); }
    }
};
struct EpiPlainMod {
    static constexpr bool PERM = true, AFTER_DRAIN = false;
    bf16_t* O; int ldo; int nt_mod;
    __device__ __forceinline__ void operator()(const f32x4 (&acc)[2][2][4][2], const Unit& u, int wr, int wc, int fr, int fq) const {
        const int pnl = u.pn % nt_mod; const int row0 = u.pm * BM + wr * 64 + fr, col0 = pnl * BM + wc * 32 + 8 * fq;
#pragma unroll
        for (int ai = 0; ai < 2; ++ai)
#pragma unroll
            for (int m = 0; m < 4; ++m) { bf16_t* rowp = O + (size_t)(row0 + ai * HALF + m * 16) * ldo + col0;
#pragma unroll
                for (int bj = 0; bj < 2; ++bj) { const f32x4 v0 = acc[ai][bj][m][0], v1 = acc[ai][bj][m][1];
                    u32x4 w; w.x = cvt_pk_bf16(v0[0], v0[1]); w.y = cvt_pk_bf16(v0[2], v0[3]); w.z = cvt_pk_bf16(v1[0], v1[1]); w.w = cvt_pk_bf16(v1[2], v1[3]);
                    PG8_ST16(O, rowp + bj * HALF, w); } }
    }
};
struct SplitKOrder {
    int ntm, nN, ns, kslice, G, c;
    __device__ __forceinline__ bool next(int i, Unit& u) const {
        const int L = i * G + c; if (L >= ntm * nN * ns) return false;
        const int ks = L % ns, t = L / ns; u.pn = t % nN; u.pm = t / nN; u.k0 = ks * kslice; return true;
    }
    __device__ __forceinline__ void a_ready(const Unit&) const {}
    __device__ __forceinline__ void done(const Unit&) const {}
};
struct EpiSlabGate {
    static constexpr bool PERM = false, AFTER_DRAIN = false;
    float* slab; const float* gate; int kslice;
    __device__ __forceinline__ void operator()(const f32x4 (&acc)[2][2][4][2], const Unit& u, int wr, int wc, int fr, int fq) const {
        const int col0 = u.pn * BM + wc * 32 + 4 * fq; float* out = slab + (size_t)(u.k0 / kslice) * (2048 * 1024);
        f32x4 gv[2][2];
#pragma unroll
        for (int bj = 0; bj < 2; ++bj)
#pragma unroll
            for (int n = 0; n < 2; ++n) gv[bj][n] = *(const f32x4*)(gate + col0 + bj * HALF + n * 16);
#pragma unroll
        for (int ai = 0; ai < 2; ++ai)
#pragma unroll
            for (int m = 0; m < 4; ++m) { float* op = out + (size_t)(u.pm * BM + ai * HALF + wr * 64 + m * 16 + fr) * 1024 + col0;
#pragma unroll
                for (int bj = 0; bj < 2; ++bj)
#pragma unroll
                    for (int n = 0; n < 2; ++n) *(f32x4*)(op + bj * HALF + n * 16) = gv[bj][n] * acc[ai][bj][m][n]; }
    }
};
struct MoeOrder {
    int tb[9]; int ntn, G, c; int limit = 0x7fffffff;
    __device__ __forceinline__ bool next(int i, Unit& u) const {
        const int L = i * G + c; if (L >= tb[8] * ntn || L >= limit) return false;
        const int mt = L / ntn, pn = L % ntn; int e = 0;
#pragma unroll
        for (int k = 1; k < 8; ++k) e += (mt >= tb[k]) ? 1 : 0;
        u.pm = mt; u.pn = e * ntn + pn; return true;
    }
    __device__ __forceinline__ void a_ready(const Unit&) const {}
    __device__ __forceinline__ void done(const Unit&) const {}
};
struct MoeTailOrder {
    int tb[9]; int first, ntail, G, c;
    __device__ __forceinline__ bool next(int i, Unit& u) const {
        const int L = i * G + c; if (L >= ntail * 11) return false;
        const int tu = L / 11, ks = L % 11, gu = first + tu, mt = gu >> 2, pn = gu & 3; int e = 0;
#pragma unroll
        for (int k = 1; k < 8; ++k) e += (mt >= tb[k]) ? 1 : 0;
        u.pm = mt; u.pn = e * 4 + pn; u.k0 = ks * 256; return true;
    }
    __device__ __forceinline__ void a_ready(const Unit&) const {}
    __device__ __forceinline__ void done(const Unit&) const {}
};
struct EpiTailSlab {
    static constexpr bool PERM = false, AFTER_DRAIN = false;
    float* slab; int first, ntail;
    __device__ __forceinline__ void operator()(const f32x4 (&acc)[2][2][4][2], const Unit& u, int wr, int wc, int fr, int fq) const {
        const int col0 = (u.pn & 3) * BM + wc * 32 + 4 * fq; float* out = slab + (size_t)(u.k0 >> 8) * ((size_t)(ntail >> 2) * 256 * 1024);
        const int rt = u.pm - (first >> 2);
#pragma unroll
        for (int ai = 0; ai < 2; ++ai)
#pragma unroll
            for (int m = 0; m < 4; ++m) { float* op = out + (size_t)(rt * BM + ai * HALF + wr * 64 + m * 16 + fr) * 1024 + col0;
#pragma unroll
                for (int bj = 0; bj < 2; ++bj)
#pragma unroll
                    for (int n = 0; n < 2; ++n) *(f32x4*)(op + bj * HALF + n * 16) = acc[ai][bj][m][n]; }
    }
};
}

struct PrepIn { const float *rw_mu, *rw_w0, *rw_w_up, *rw_a0, *rw_a_up, *rw_g_up, *rw_k_k, *rw_k_a, *rw_r_k, *conv_w, *conv_b, *dt_bias; };
__device__ __forceinline__ bf16x8 gather8(const float* p, int stride) {
    v4u w; w.x = pk2(p[0], p[stride]); w.y = pk2(p[2 * stride], p[3 * stride]); w.z = pk2(p[4 * stride], p[5 * stride]); w.w = pk2(p[6 * stride], p[7 * stride]); return __builtin_bit_cast(bf16x8, w);
}
constexpr int ACT_ST = 464;
__device__ __forceinline__ void prepare_phase(Frame& F, const PrepIn& P, const bf16* Z, bf16* PR, bf16* PM, float* DT, float* BONUS, bf16* GATE, bf16* ZG) {
    LAS unsigned short* zs = (LAS unsigned short*)F.lds;
    LAS unsigned char* actb = F.lds + 24576;
    LAS float* cst = (LAS float*)(F.lds + 24576 + 16 * ACT_ST);
    const int tid = F.tid, lane = F.lane, fr = lane & 15, fq = lane >> 4, w = F.wave;
    const int hf = F.bid & 1, wl = w & 3, hd = 4 * hf + wl;
    __syncthreads();
    if (tid < 256) { const int c = 256 * hf + tid; cst[tid] = P.rw_w0[c]; cst[256 + tid] = P.rw_w0[512 + c]; cst[512 + tid] = P.rw_a0[c]; cst[768 + tid] = P.rw_a0[512 + c];
      cst[1024 + tid] = P.rw_k_k[c]; cst[1280 + tid] = P.rw_k_a[c]; cst[1536 + tid] = P.rw_r_k[c]; cst[1792 + tid] = P.rw_r_k[512 + c]; }
    bf16x8 W[16];
#pragma unroll
    for (int cb = 0; cb < 4; ++cb) { const int c = 64 * hd + 4 * fr + cb;
        if (w < 4) { W[cb] = gather8(P.rw_w_up + (size_t)(8 * fq) * 512 + c, 512); W[4 + cb] = gather8(P.rw_w_up + (size_t)(32 + 8 * fq) * 512 + c, 512);
                     W[8 + cb] = gather8(P.rw_a_up + (size_t)(8 * fq) * 512 + c, 512); W[12 + cb] = gather8(P.rw_a_up + (size_t)(32 + 8 * fq) * 512 + c, 512); }
        else { W[cb] = gather8(P.rw_g_up + (size_t)(8 * fq) * 512 + c, 512); W[4 + cb] = gather8(P.rw_g_up + (size_t)(32 + 8 * fq) * 512 + c, 512); W[8 + cb] = gather8(P.rw_g_up + (size_t)(64 + 8 * fq) * 512 + c, 512); W[12 + cb] = W[cb]; } }
    const int col0 = (tid < 256) ? (256 * hf + tid) : (512 + 256 * hf + tid - 256), col1 = (tid < 256) ? (1024 + 256 * hf + tid) : ((tid < 480) ? (1536 + tid - 256) : 1536);
    const int zo0 = tid, zo1 = 512 + (tid & 255);
    const float mu00 = P.rw_mu[col0], mu10 = P.rw_mu[RWC + col0], mu01 = P.rw_mu[col1], mu11 = P.rw_mu[RWC + col1];
    float cw[5];
#pragma unroll
    for (int k = 0; k < 5; ++k) cw[k] = P.conv_w[k * 1024 + 512 * hf + tid];
    const float cbv = P.conv_b[512 * hf + tid], dtb = P.dt_bias[tid & 15];
    __syncthreads();

#ifndef PREP_REPS
#define PREP_REPS 1
#endif
    for (int rb_ = F.bid >> 1; rb_ < (M_ALL / 16) * PREP_REPS; rb_ += (F.G >> 1)) {
        const int rb = rb_ % (M_ALL / 16); const int g0 = rb * 16; const bool isctx = g0 < M_CTX; const int T = isctx ? CTXL : SEQ; const int t0 = isctx ? (g0 & (CTXL - 1)) : ((g0 - M_CTX) & (SEQ - 1));
        const bf16* zb = Z + (size_t)g0 * ZLD;
        const bool hp = t0 > 0, hn = (t0 + 16 < T), hp2 = t0 >= 2, hn2 = (t0 + 17 < T);
        float z0[18], z1[18], x[20];
        const int ccol = RWC + 512 + 512 * hf + tid;
#pragma unroll
        for (int i = 0; i < 18; ++i) { const bool ok = (i == 0) ? hp : ((i == 17) ? hn : true); z0[i] = ok ? ldbf(zb + (ptrdiff_t)(i - 1) * ZLD + col0) : 0.f; z1[i] = ok ? ldbf(zb + (ptrdiff_t)(i - 1) * ZLD + col1) : 0.f; }
#pragma unroll
        for (int i = 0; i < 20; ++i) { const bool ok = (i == 0) ? hp2 : (i == 1) ? hp : (i == 18) ? hn : (i == 19) ? hn2 : true; x[i] = ok ? ldbf(zb + (ptrdiff_t)(i - 2) * ZLD + ccol) : 0.f; }
#pragma unroll
        for (int tb = 0; tb < 16; ++tb) zs[tb * 768 + zo0] = (unsigned short)f2bf(z0[tb + 1] + mu00 * (z0[tb] - z0[tb + 1]) + mu10 * (z0[tb + 2] - z0[tb + 1]));
        {
            const int a = tid - 256;
#pragma unroll
            for (int tb = 0; tb < 16; ++tb) {
                const float zsft = z1[tb + 1] + mu01 * (z1[tb] - z1[tb + 1]) + mu11 * (z1[tb + 2] - z1[tb + 1]);
                if (tid < 256) zs[tb * 768 + zo1] = (unsigned short)f2bf(zsft);
                else if (tid < 480) { const float sg = sigm((a < 64) ? 2.f * zsft : zsft); const float av = (a < 64) ? (2.f * sg - 1.f) : ((a < 128) ? zsft : sg);
                    *(LAS unsigned short*)(actb + tb * ACT_ST + a * 2) = (unsigned short)f2bf(av); }
            }
        }
#pragma unroll
        for (int tb = 0; tb < 16; ++tb) {
            float y = cbv + cw[0] * x[tb] + cw[1] * x[tb + 1] + cw[2] * x[tb + 2] + cw[3] * x[tb + 3] + cw[4] * x[tb + 4];
            y = y * sigm(y);
            PM[(size_t)(g0 + tb) * 1024 + 512 * hf + tid] = (bf16)f2bf(y);
        }
        { const int tb = tid >> 5, cc = tid & 31;
          *(GAS v4u*)(ZG + (size_t)(g0 + tb) * 512 + 256 * hf + cc * 8) = *(const GAS v4u*)(zb + (size_t)tb * ZLD + RWC + 256 * hf + cc * 8); }
        if (hf == 0 && tid < 256) { const int tb = tid >> 4, cc = tid & 15; const float x = ldbf(zb + (size_t)tb * ZLD + RWC + 1536 + cc) + dtb; DT[(size_t)(g0 + tb) * 16 + cc] = (x > 20.f) ? x : log1pf(__expf(x)); }
        __syncthreads();
        const f32x4 zero = {0.f, 0.f, 0.f, 0.f};
        const int cl0 = 64 * wl + 4 * fr;
        if (w < 4) {
            bf16x8 Af[4];
#pragma unroll
            for (int kb = 0; kb < 4; ++kb) Af[kb] = *(const LAS bf16x8*)(actb + fr * ACT_ST + kb * 64 + fq * 16);
            f32x4 lw0[4], lw1[4], ia0[4], ia1[4];
#pragma unroll
            for (int cb = 0; cb < 4; ++cb) {
                lw0[cb] = __builtin_amdgcn_mfma_f32_16x16x32_bf16(Af[0], W[cb], zero, 0, 0, 0); lw1[cb] = __builtin_amdgcn_mfma_f32_16x16x32_bf16(Af[1], W[4 + cb], zero, 0, 0, 0);
                ia0[cb] = __builtin_amdgcn_mfma_f32_16x16x32_bf16(Af[2], W[8 + cb], zero, 0, 0, 0); ia1[cb] = __builtin_amdgcn_mfma_f32_16x16x32_bf16(Af[3], W[12 + cb], zero, 0, 0, 0);
            }
            const f32x4 w00 = *(const LAS f32x4*)(cst + cl0), w01 = *(const LAS f32x4*)(cst + 256 + cl0), a00 = *(const LAS f32x4*)(cst + 512 + cl0), a01 = *(const LAS f32x4*)(cst + 768 + cl0);
            const f32x4 kkc = *(const LAS f32x4*)(cst + 1024 + cl0), kac = *(const LAS f32x4*)(cst + 1280 + cl0), rk0 = *(const LAS f32x4*)(cst + 1536 + cl0), rk1 = *(const LAS f32x4*)(cst + 1792 + cl0);
#pragma unroll
            for (int e = 0; e < 4; ++e) {
                const int tok = 4 * fq + e; const size_t g = (size_t)(g0 + tok);
                const v2u ru = *(const LAS v2u*)(zs + tok * 768 + cl0), ku = *(const LAS v2u*)(zs + tok * 768 + 256 + cl0), vu = *(const LAS v2u*)(zs + tok * 768 + 512 + cl0);
                const f32x4 r = {bflo(ru.x), bfhi(ru.x), bflo(ru.y), bfhi(ru.y)}, k = {bflo(ku.x), bfhi(ku.x), bflo(ku.y), bfhi(ku.y)};
                const f32x4 kks = k * kkc;
                const float ssq = sum16((kks[0] * kks[0] + kks[1] * kks[1]) + (kks[2] * kks[2] + kks[3] * kks[3]));
                const float rn = __builtin_amdgcn_rcpf(fmaxf(sqrtf(ssq), 1e-12f));
                float ee0[4], ee1[4], kd0[4], kd1[4], bb0[4], bb1[4], na[4]; float bon = 0.f;
#pragma unroll
                for (int cb = 0; cb < 4; ++cb) {
                    ee0[cb] = 0.60653066f * sigm(w00[cb] + lw0[cb][e]); ee1[cb] = 0.60653066f * sigm(w01[cb] + lw1[cb][e]);
                    const float ic0 = sigm(a00[cb] + ia0[cb][e]), ic1 = sigm(a01[cb] + ia1[cb][e]);
                    const float kkn = kks[cb] * rn;
                    kd0[cb] = k[cb] * (1.f + (ic0 - 1.f) * kac[cb]); kd1[cb] = k[cb] * (1.f + (ic1 - 1.f) * kac[cb]);
                    bon += r[cb] * (kd0[cb] * rk0[cb] + kd1[cb] * rk1[cb]);
                    na[cb] = -kkn; bb0[cb] = kkn * ic0; bb1[cb] = kkn * ic1;
                }
                bon = sum16(bon); if (fr == 0) BONUS[g * 8 + hd] = bon;
                bf16* pr = PR + g * PRV + 256 * hf + cl0;
                *(GAS v2u*)(pr) = ru; *(GAS v2u*)(pr + 512) = vu;
                v2u o;
                o.x = pk2(na[0], na[1]); o.y = pk2(na[2], na[3]); *(GAS v2u*)(pr + 1024) = o;
                o.x = pk2(ee0[0], ee0[1]); o.y = pk2(ee0[2], ee0[3]); *(GAS v2u*)(pr + 1536) = o;
                o.x = pk2(kd0[0], kd0[1]); o.y = pk2(kd0[2], kd0[3]); *(GAS v2u*)(pr + 2048) = o;
                o.x = pk2(bb0[0], bb0[1]); o.y = pk2(bb0[2], bb0[3]); *(GAS v2u*)(pr + 2560) = o;
                o.x = pk2(ee1[0], ee1[1]); o.y = pk2(ee1[2], ee1[3]); *(GAS v2u*)(pr + 3072) = o;
                o.x = pk2(kd1[0], kd1[1]); o.y = pk2(kd1[2], kd1[3]); *(GAS v2u*)(pr + 3584) = o;
                o.x = pk2(bb1[0], bb1[1]); o.y = pk2(bb1[2], bb1[3]); *(GAS v2u*)(pr + 4096) = o;
            }
        } else {
            bf16x8 Af[3];
#pragma unroll
            for (int kb = 0; kb < 3; ++kb) Af[kb] = *(const LAS bf16x8*)(actb + fr * ACT_ST + (4 + kb) * 64 + fq * 16);
            f32x4 gt[4];
#pragma unroll
            for (int cb = 0; cb < 4; ++cb) {
                gt[cb] = __builtin_amdgcn_mfma_f32_16x16x32_bf16(Af[0], W[cb], zero, 0, 0, 0);
                gt[cb] = __builtin_amdgcn_mfma_f32_16x16x32_bf16(Af[1], W[4 + cb], gt[cb], 0, 0, 0); gt[cb] = __builtin_amdgcn_mfma_f32_16x16x32_bf16(Af[2], W[8 + cb], gt[cb], 0, 0, 0);
            }
#pragma unroll
            for (int e = 0; e < 4; ++e) { v2u o; o.x = pk2(gt[0][e], gt[1][e]); o.y = pk2(gt[2][e], gt[3][e]); *(GAS v2u*)(GATE + (size_t)(g0 + 4 * fq + e) * 512 + 256 * hf + cl0) = o; }
        }
        __syncthreads();
    }
}

template <int SH> __device__ __forceinline__ float dpp_shr(float x) { return __int_as_float(__builtin_amdgcn_update_dpp(0, __float_as_int(x), 0x110 + SH, 0xF, 0xF, true)); }
__device__ __forceinline__ int scan_row16(int c, int t, int b, int d) {
    const int st = c * 16 + t; const int seg = (st >= CTXL) ? 1 : 0; const int T = seg ? SEQ : CTXL; const int sl = st - seg * CTXL;
    return (seg ? (M_CTX + b * SEQ) : b * CTXL) + (d ? (T - 1 - sl) : sl);
}
__device__ __forceinline__ v4u scale8(const v4u u, float s) {
    v4u o; o.x = pk2(bflo(u.x) * s, bfhi(u.x) * s); o.y = pk2(bflo(u.y) * s, bfhi(u.y) * s); o.z = pk2(bflo(u.z) * s, bfhi(u.z) * s); o.w = pk2(bflo(u.w) * s, bfhi(u.w) * s); return o;
}
__device__ __forceinline__ bf16x8 pack4z(const f32x4& a) { v4u w; w.x = pk2(a[0], a[1]); w.y = pk2(a[2], a[3]); w.z = 0u; w.w = 0u; return __builtin_bit_cast(bf16x8, w); }
__device__ __forceinline__ bf16x8 tr4z(const LAS unsigned char* p) {
    const v2u t = __builtin_bit_cast(v2u, __builtin_amdgcn_ds_read_tr16_b64_v4i16((LAS v4i16_t*)p)); v4u w; w.x = t.x; w.y = t.y; w.z = 0u; w.w = 0u; return __builtin_bit_cast(bf16x8, w);
}
__device__ __forceinline__ bf16x8 cat44(const v2u a, const v2u b) { v4u w; w.x = a.x; w.y = a.y; w.z = b.x; w.w = b.y; return __builtin_bit_cast(bf16x8, w); }
constexpr int NCH16 = (CTXL + SEQ) / 16;
__device__ __forceinline__ f32x4 mm16(const f32x4& xT_c, const f32x4& y_c, const f32x4& acc) {
    return __builtin_amdgcn_mfma_f32_16x16x32_bf16(pack4z(xT_c), pack4z(y_c), acc, 0, 0, 0);
}
constexpr int RING_FLAGS = 122880;
constexpr int NSLOT = 6;
__device__ __forceinline__ unsigned lds_flag_ld(volatile LAS unsigned* p) { return (unsigned)__builtin_amdgcn_readfirstlane((int)*p); }
__device__ __forceinline__ void ring_wait_full(volatile LAS unsigned* fl, int s, int c) { while (lds_flag_ld(fl + s) != (unsigned)(c + 1)) __builtin_amdgcn_s_sleep(1); asm volatile("" ::: "memory"); }
__device__ __forceinline__ void ring_wait_free(volatile LAS unsigned* fl, int s, int c, int nslot = NSLOT, unsigned ncons = 4u) { const unsigned want = ncons * (unsigned)(c / nslot); while (lds_flag_ld(fl + 8 + s) < want) __builtin_amdgcn_s_sleep(1); asm volatile("" ::: "memory"); }
__device__ __forceinline__ void ring_set_full(volatile LAS unsigned* fl, int s, int c, int lane) { asm volatile("s_waitcnt lgkmcnt(0)" ::: "memory"); if (lane == 0) fl[s] = (unsigned)(c + 1); }
__device__ __forceinline__ void ring_done(volatile LAS unsigned* fl, int s, int lane) { asm volatile("s_waitcnt lgkmcnt(0)" ::: "memory"); if (lane == 0) __hip_atomic_fetch_add((LAS unsigned*)(fl + 8 + s), 1u, __ATOMIC_RELAXED, __HIP_MEMORY_SCOPE_WORKGROUP); }

constexpr int RST = 144, RIMG = 16 * RST;
constexpr int RW_SLOT = 18432;
__device__ __forceinline__ void rwkv_block(Frame& F, int unit, const bf16* PR, bf16* YRW) {
    const int d = unit & 1, h = (unit >> 1) & 7, b = unit >> 4;
    const int lane = F.lane, fr = lane & 15, fq = lane >> 4, tq = (lane & 15) >> 2, tp = lane & 3;
    volatile LAS unsigned* fl = (volatile LAS unsigned*)(F.lds + RING_FLAGS);
    __syncthreads();
    if (F.tid < 16) fl[F.tid] = 0u;
    __syncthreads();
    if (F.wave >= 4) {
        const int p = F.wave - 4;
        const int ve = (3 + 3 * d) * 512, vb = (5 + 3 * d) * 512, vk = (4 + 3 * d) * 512;
        bf16x8 Ltri; { v4u w; w.x = ((4 * fq + 0 <= fr) ? 0x3F80u : 0u) | ((4 * fq + 1 <= fr) ? 0x3F800000u : 0u); w.y = ((4 * fq + 2 <= fr) ? 0x3F80u : 0u) | ((4 * fq + 3 <= fr) ? 0x3F800000u : 0u); w.z = 0u; w.w = 0u; Ltri = __builtin_bit_cast(bf16x8, w); }
        v4u rE[2], rA[2], rB[2], rK[2], rR[2], rV[2];
#define RW_LOAD(c_) do { \
        _Pragma("unroll") for (int i = 0; i < 2; ++i) { const int id = lane + 64 * i; const bf16* src = PR + (size_t)scan_row16((c_), id >> 3, b, d) * PRV + h * 64 + (id & 7) * 8; \
            rE[i] = *(const GAS v4u*)(src + ve); rA[i] = *(const GAS v4u*)(src + 1024); rB[i] = *(const GAS v4u*)(src + vb); rK[i] = *(const GAS v4u*)(src + vk); rR[i] = *(const GAS v4u*)(src); rV[i] = *(const GAS v4u*)(src + 512); } } while (0)
        RW_LOAD(p);
        for (int c = p; c < NCH16; c += 4) {
            const int s = c % NSLOT;
            LAS unsigned char* sb = F.lds + s * RW_SLOT;
            LAS unsigned char* RE = sb; LAS unsigned char* RA = sb + RIMG; LAS unsigned char* RB = sb + 2 * RIMG; LAS unsigned char* RK = sb + 3 * RIMG; LAS unsigned char* RR = sb + 4 * RIMG;
            LAS unsigned char* RV = sb + 5 * RIMG; LAS unsigned char* FRG = sb + 6 * RIMG; LAS float* GC = (LAS float*)(sb + 6 * RIMG + 4096);
            ring_wait_free(fl, s, c);
#pragma unroll
            for (int i = 0; i < 2; ++i) { const int id = lane + 64 * i; const int o = (id >> 3) * RST + (id & 7) * 16;
                *(LAS v4u*)(RE + o) = rE[i]; *(LAS v4u*)(RA + o) = rA[i]; *(LAS v4u*)(RB + o) = rB[i]; *(LAS v4u*)(RK + o) = rK[i]; *(LAS v4u*)(RR + o) = rR[i]; *(LAS v4u*)(RV + o) = rV[i]; }
            if (c + 4 < NCH16) RW_LOAD(c + 4);
            asm volatile("s_waitcnt lgkmcnt(0)" ::: "memory");
#pragma unroll
            for (int jb = 0; jb < 4; ++jb) {
                const int tro = (4 * fq + tq) * RST + (16 * jb + 4 * tp) * 2;
                const v2u eu = __builtin_bit_cast(v2u, __builtin_amdgcn_ds_read_tr16_b64_v4i16((LAS v4i16_t*)(RE + tro)));
                const v2u au = __builtin_bit_cast(v2u, __builtin_amdgcn_ds_read_tr16_b64_v4i16((LAS v4i16_t*)(RA + tro)));
                const v2u bu = __builtin_bit_cast(v2u, __builtin_amdgcn_ds_read_tr16_b64_v4i16((LAS v4i16_t*)(RB + tro)));
                const v2u ku = __builtin_bit_cast(v2u, __builtin_amdgcn_ds_read_tr16_b64_v4i16((LAS v4i16_t*)(RK + tro)));
                const v2u ru = __builtin_bit_cast(v2u, __builtin_amdgcn_ds_read_tr16_b64_v4i16((LAS v4i16_t*)(RR + tro)));
                v4u ew; ew.x = eu.x; ew.y = eu.y; ew.z = 0u; ew.w = 0u;
                const f32x4 cum = __builtin_amdgcn_mfma_f32_16x16x32_bf16(Ltri, __builtin_bit_cast(bf16x8, ew), (f32x4){0.f, 0.f, 0.f, 0.f}, 0, 0, 0);
                const float ev[4] = {bflo(eu.x), bfhi(eu.x), bflo(eu.y), bfhi(eu.y)}, av[4] = {bflo(au.x), bfhi(au.x), bflo(au.y), bfhi(au.y)}, bv[4] = {bflo(bu.x), bfhi(bu.x), bflo(bu.y), bfhi(bu.y)};
                const float kv[4] = {bflo(ku.x), bfhi(ku.x), bflo(ku.y), bfhi(ku.y)}, rv[4] = {bflo(ru.x), bfhi(ru.x), bflo(ru.y), bfhi(ru.y)};
#pragma unroll
                for (int e = 0; e < 4; ++e) {
                    const float G = __expf(-cum[e]), Gi = __expf(cum[e]), Gx = __expf(ev[e] - cum[e]);
                    const int o = (4 * fq + e) * RST + (16 * jb + fr) * 2;
                    const unsigned ab = pk2(av[e] * Gx, bv[e] * Gi), kr = pk2(kv[e] * Gi, rv[e] * G);
                    *(LAS unsigned short*)(RA + o) = (unsigned short)ab; *(LAS unsigned short*)(RB + o) = (unsigned short)(ab >> 16);
                    *(LAS unsigned short*)(RK + o) = (unsigned short)kr; *(LAS unsigned short*)(RR + o) = (unsigned short)(kr >> 16);
                    if (e == 3 && fq == 3) GC[16 * jb + fr] = G;
                }
            }
            asm volatile("s_waitcnt lgkmcnt(0)" ::: "memory");
            f32x4 aba = {0.f, 0.f, 0.f, 0.f}, aka = aba, abr = aba, akr = aba, abaT = aba;
#pragma unroll
            for (int kb = 0; kb < 2; ++kb) {
                const int o = fr * RST + kb * 64 + fq * 16;
                const bf16x8 fb = *(const LAS bf16x8*)(RB + o), fk = *(const LAS bf16x8*)(RK + o), fa = *(const LAS bf16x8*)(RA + o), frr = *(const LAS bf16x8*)(RR + o);
                aba = __builtin_amdgcn_mfma_f32_16x16x32_bf16(fb, fa, aba, 0, 0, 0); aka = __builtin_amdgcn_mfma_f32_16x16x32_bf16(fk, fa, aka, 0, 0, 0);
                abr = __builtin_amdgcn_mfma_f32_16x16x32_bf16(fb, frr, abr, 0, 0, 0); akr = __builtin_amdgcn_mfma_f32_16x16x32_bf16(fk, frr, akr, 0, 0, 0);
                abaT = __builtin_amdgcn_mfma_f32_16x16x32_bf16(fa, fb, abaT, 0, 0, 0);
            }
            f32x4 idc;
#pragma unroll
            for (int e = 0; e < 4; ++e) { const int row = 4 * fq + e;
                aba[e] = (row < fr) ? aba[e] : 0.f; aka[e] = (row < fr) ? aka[e] : 0.f; abr[e] = (row <= fr) ? abr[e] : 0.f; akr[e] = (row <= fr) ? akr[e] : 0.f;
                abaT[e] = (fr < row) ? abaT[e] : 0.f; idc[e] = (row == fr) ? 1.f : 0.f; }
            f32x4 t_c = idc + aba, t_T = idc + abaT;
            f32x4 p_c = mm16(abaT, aba, (f32x4){0.f, 0.f, 0.f, 0.f}), p_T = mm16(aba, abaT, (f32x4){0.f, 0.f, 0.f, 0.f});
            { const f32x4 n_c = mm16(t_T, p_c, t_c), n_T = mm16(p_c, t_T, t_T); t_c = n_c; t_T = n_T; }
            { const f32x4 q_c = mm16(p_T, p_c, (f32x4){0.f, 0.f, 0.f, 0.f}), q_T = mm16(p_c, p_T, (f32x4){0.f, 0.f, 0.f, 0.f}); p_c = q_c; p_T = q_T; }
            { const f32x4 n_c = mm16(t_T, p_c, t_c), n_T = mm16(p_c, t_T, t_T); t_c = n_c; t_T = n_T; }
            { const f32x4 q_c = mm16(p_T, p_c, (f32x4){0.f, 0.f, 0.f, 0.f}); p_c = q_c; }
            const f32x4 tm_c = mm16(t_T, p_c, t_c);
            *(LAS bf16x8*)(FRG + lane * 16) = pack4z(tm_c); *(LAS bf16x8*)(FRG + 1024 + lane * 16) = pack4z(aka);
            *(LAS bf16x8*)(FRG + 2048 + lane * 16) = pack4z(abr); *(LAS bf16x8*)(FRG + 3072 + lane * 16) = pack4z(akr);
            ring_set_full(fl, s, c, lane);
        }
#undef RW_LOAD
    } else {
        const int q = F.wave;
        __builtin_amdgcn_s_setprio(3);
        bf16* yout = YRW + (size_t)d * M_ALL * 512 + h * 64 + 16 * q;
        f32x4 T[4];
#pragma unroll
        for (int jb = 0; jb < 4; ++jb) T[jb] = (f32x4){0.f, 0.f, 0.f, 0.f};
        for (int c = 0; c < NCH16; ++c) {
            const int s = c % NSLOT;
            LAS unsigned char* sb = F.lds + s * RW_SLOT;
            LAS unsigned char* RA = sb + RIMG; LAS unsigned char* RB = sb + 2 * RIMG; LAS unsigned char* RK = sb + 3 * RIMG; LAS unsigned char* RR = sb + 4 * RIMG;
            LAS unsigned char* RV = sb + 5 * RIMG; LAS unsigned char* FRG = sb + 6 * RIMG; LAS float* GC = (LAS float*)(sb + 6 * RIMG + 4096);
            ring_wait_full(fl, s, c);
            const bf16x8 tmA = *(const LAS bf16x8*)(FRG + lane * 16), akaA = *(const LAS bf16x8*)(FRG + 1024 + lane * 16), abrA = *(const LAS bf16x8*)(FRG + 2048 + lane * 16), akrA = *(const LAS bf16x8*)(FRG + 3072 + lane * 16);
            const bf16x8 Vf = tr4z(RV + (4 * fq + tq) * RST + (16 * q + 4 * tp) * 2);
            f32x4 x = {0.f, 0.f, 0.f, 0.f}, y = {0.f, 0.f, 0.f, 0.f};
#pragma unroll
            for (int jp = 0; jp < 2; ++jp) {
                const int o = fr * RST + (32 * jp + 4 * fq) * 2;
                const bf16x8 tf = pack8(T[2 * jp], T[2 * jp + 1]);
                x = __builtin_amdgcn_mfma_f32_16x16x32_bf16(cat44(*(const LAS v2u*)(RA + o), *(const LAS v2u*)(RA + o + 32)), tf, x, 0, 0, 0);
                y = __builtin_amdgcn_mfma_f32_16x16x32_bf16(cat44(*(const LAS v2u*)(RR + o), *(const LAS v2u*)(RR + o + 32)), tf, y, 0, 0, 0);
            }
            x = __builtin_amdgcn_mfma_f32_16x16x32_bf16(akaA, Vf, x, 0, 0, 0);
            const f32x4 ut = __builtin_amdgcn_mfma_f32_16x16x32_bf16(tmA, pack4z(x), (f32x4){0.f, 0.f, 0.f, 0.f}, 0, 0, 0);
            y = __builtin_amdgcn_mfma_f32_16x16x32_bf16(abrA, pack4z(ut), y, 0, 0, 0);
            y = __builtin_amdgcn_mfma_f32_16x16x32_bf16(akrA, Vf, y, 0, 0, 0);
            bf16x8 UV; { const v4u vw = __builtin_bit_cast(v4u, Vf); v4u w; w.x = pk2(ut[0], ut[1]); w.y = pk2(ut[2], ut[3]); w.z = vw.x; w.w = vw.y; UV = __builtin_bit_cast(bf16x8, w); }
#pragma unroll
            for (int jb = 0; jb < 4; ++jb) {
                const int tro = (4 * fq + tq) * RST + (16 * jb + 4 * tp) * 2;
                const v2u bt = __builtin_bit_cast(v2u, __builtin_amdgcn_ds_read_tr16_b64_v4i16((LAS v4i16_t*)(RB + tro))), kt = __builtin_bit_cast(v2u, __builtin_amdgcn_ds_read_tr16_b64_v4i16((LAS v4i16_t*)(RK + tro)));
                const f32x4 gc = *(const LAS f32x4*)(GC + 16 * jb + 4 * fq);
                T[jb] = __builtin_amdgcn_mfma_f32_16x16x32_bf16(cat44(bt, kt), UV, T[jb], 0, 0, 0); T[jb] = T[jb] * gc;
            }
            ring_done(fl, s, lane);
            { const int row0 = scan_row16(c, 0, b, d), stp = d ? -1 : 1;
#pragma unroll
              for (int e = 0; e < 4; ++e) yout[(size_t)(row0 + stp * (4 * fq + e)) * 512 + fr] = (bf16)f2bf(y[e]); }
        }
        __builtin_amdgcn_s_setprio(0);
    }
}

constexpr int MST = 272, MIMG = 16 * MST;
constexpr int MB_NSLOT = 5;
constexpr int MB_SLOT = 21504;
__device__ __forceinline__ void mamba_block(Frame& F, int unit, const bf16* PM, const float* DT, const float* a_log, bf16* YMB) {
    const int d = unit & 1, h = (unit >> 1) & 7, b = unit >> 4, grp = h >> 2;
    const int lane = F.lane, fr = lane & 15, fq = lane >> 4, tq = (lane & 15) >> 2, tp = lane & 3;
    volatile LAS unsigned* fl = (volatile LAS unsigned*)(F.lds + RING_FLAGS);
    __syncthreads();
    if (F.tid < 16) fl[F.tid] = 0u;
    __syncthreads();
    if (F.wave >= 4) {
        const int p = F.wave - 4;
        const float a_neg = -__expf(a_log[d * 8 + h]);
        v4u rB[4], rC[4], rX[2]; float rdt;
#define MB_LOAD(c_) do { \
        _Pragma("unroll") for (int i = 0; i < 4; ++i) { const int t = (lane >> 4) + 4 * i; const bf16* src = PM + (size_t)scan_row16((c_), t, b, d) * 1024 + 512 + grp * 128 + (lane & 15) * 8; rB[i] = *(const GAS v4u*)src; rC[i] = *(const GAS v4u*)(src + 256); } \
        _Pragma("unroll") for (int i = 0; i < 2; ++i) { const int id = lane + 64 * i; rX[i] = *(const GAS v4u*)(PM + (size_t)scan_row16((c_), id >> 3, b, d) * 1024 + h * 64 + (id & 7) * 8); } \
        rdt = DT[(size_t)scan_row16((c_), lane & 15, b, d) * 16 + d * 8 + h]; } while (0)
        MB_LOAD(p);
        for (int c = p; c < NCH16; c += 4) {
            const int s = c % MB_NSLOT;
            LAS unsigned char* sb = F.lds + s * MB_SLOT;
            LAS unsigned char* BR = sb; LAS unsigned char* CR = sb + MIMG; LAS unsigned char* RT = sb + 2 * MIMG; LAS unsigned char* KH = sb + 3 * MIMG; LAS unsigned char* VX = sb + 4 * MIMG;
            LAS unsigned char* FRG = sb + 4 * MIMG + RIMG; LAS float* scal = (LAS float*)(sb + 4 * MIMG + RIMG + 1024);
            ring_wait_free(fl, s, c, MB_NSLOT);
            float cs = rdt * a_neg;
            cs += dpp_shr<1>(cs); cs += dpp_shr<2>(cs); cs += dpp_shr<4>(cs); cs += dpp_shr<8>(cs);
            const float cse = __int_as_float(__builtin_amdgcn_readlane(__float_as_int(cs), 15));
            if (lane < 16) { scal[16 + lane] = cs; scal[32 + lane] = __expf(cs); scal[48 + lane] = rdt; scal[64 + lane] = __expf(cse - cs); }
            if (lane == 0) scal[0] = __expf(cse);
            asm volatile("s_waitcnt lgkmcnt(0)" ::: "memory");
#pragma unroll
            for (int i = 0; i < 4; ++i) { const int t = (lane >> 4) + 4 * i; const float sk = scal[64 + t], sr = scal[32 + t]; const int o = t * MST + (lane & 15) * 16;
                *(LAS v4u*)(BR + o) = rB[i]; *(LAS v4u*)(CR + o) = rC[i]; *(LAS v4u*)(KH + o) = scale8(rB[i], sk); *(LAS v4u*)(RT + o) = scale8(rC[i], sr); }
#pragma unroll
            for (int i = 0; i < 2; ++i) { const int id = lane + 64 * i; const int t = id >> 3; *(LAS v4u*)(VX + t * RST + (id & 7) * 16) = scale8(rX[i], scal[48 + t]); }
            if (c + 4 < NCH16) MB_LOAD(c + 4);
            asm volatile("s_waitcnt lgkmcnt(0)" ::: "memory");
            f32x4 akr = {0.f, 0.f, 0.f, 0.f};
#pragma unroll
            for (int kb = 0; kb < 4; ++kb) akr = __builtin_amdgcn_mfma_f32_16x16x32_bf16(*(const LAS bf16x8*)(BR + fr * MST + kb * 64 + fq * 16), *(const LAS bf16x8*)(CR + fr * MST + kb * 64 + fq * 16), akr, 0, 0, 0);
            const float cst = scal[16 + fr]; const f32x4 css = *(const LAS f32x4*)(scal + 16 + 4 * fq);
#pragma unroll
            for (int e = 0; e < 4; ++e) akr[e] = (4 * fq + e <= fr) ? akr[e] * __expf(cst - css[e]) : 0.f;
            *(LAS bf16x8*)(FRG + lane * 16) = pack4z(akr);
            ring_set_full(fl, s, c, lane);
        }
#undef MB_LOAD
    } else {
        const int q = F.wave;
        __builtin_amdgcn_s_setprio(3);
        bf16* yout = YMB + (size_t)d * M_ALL * 512 + h * 64 + 16 * q;
        unsigned long long prof_wait = 0ull; (void)prof_wait;
        f32x4 T[8];
#pragma unroll
        for (int jb = 0; jb < 8; ++jb) T[jb] = (f32x4){0.f, 0.f, 0.f, 0.f};
        for (int c = 0; c < NCH16; ++c) {
            const int s = c % MB_NSLOT;
            LAS unsigned char* sb = F.lds + s * MB_SLOT;
            LAS unsigned char* RT = sb + 2 * MIMG; LAS unsigned char* KH = sb + 3 * MIMG; LAS unsigned char* VX = sb + 4 * MIMG;
            LAS unsigned char* FRG = sb + 4 * MIMG + RIMG; LAS float* scal = (LAS float*)(sb + 4 * MIMG + RIMG + 1024);
#ifdef PROF_MBWAIT
            const unsigned long long tw0_ = __builtin_amdgcn_s_memrealtime();
#endif
            ring_wait_full(fl, s, c);
#ifdef PROF_MBWAIT
            prof_wait += __builtin_amdgcn_s_memrealtime() - tw0_;
#endif
#ifdef PROF_MBSEG
            unsigned long long ts0_ = __builtin_amdgcn_s_memrealtime();
#endif
            const bf16x8 akrA = *(const LAS bf16x8*)(FRG + lane * 16); const float gC = scal[0];
            const bf16x8 Vf = tr4z(VX + (4 * fq + tq) * RST + (16 * q + 4 * tp) * 2);
            f32x4 ya = {0.f, 0.f, 0.f, 0.f}, yb = __builtin_amdgcn_mfma_f32_16x16x32_bf16(akrA, Vf, (f32x4){0.f, 0.f, 0.f, 0.f}, 0, 0, 0);
#pragma unroll
            for (int jp = 0; jp < 4; ++jp) {
                const LAS unsigned char* rp = RT + fr * MST + (32 * jp + 4 * fq) * 2;
                const bf16x8 ra = cat44(*(const LAS v2u*)rp, *(const LAS v2u*)(rp + 32)), tf = pack8(T[2 * jp], T[2 * jp + 1]);
                if (jp & 1) yb = __builtin_amdgcn_mfma_f32_16x16x32_bf16(ra, tf, yb, 0, 0, 0); else ya = __builtin_amdgcn_mfma_f32_16x16x32_bf16(ra, tf, ya, 0, 0, 0);
            }
            const f32x4 y = ya + yb;
#ifdef PROF_MBSEG
            asm volatile("" :: "v"(y)); { const unsigned long long t_ = __builtin_amdgcn_s_memrealtime(); if (PROF_MBSEG == 1) prof_wait += t_ - ts0_; ts0_ = t_; }
#endif
#ifdef MB_CONS2X
            { f32x4 yd = {0.f, 0.f, 0.f, 0.f};
#pragma unroll
              for (int jp = 0; jp < 4; ++jp) { const LAS unsigned char* rp = RT + fr * MST + (32 * jp + 4 * fq) * 2 + 8;
                  yd = __builtin_amdgcn_mfma_f32_16x16x32_bf16(cat44(*(const LAS v2u*)rp, *(const LAS v2u*)(rp + 32)), pack8(T[2 * jp] * 1.0001f, T[2 * jp + 1] * 1.0001f), yd, 0, 0, 0); }
              yd = __builtin_amdgcn_mfma_f32_16x16x32_bf16(akrA, Vf, yd, 0, 0, 0);
              asm volatile("" :: "v"(yd)); }
#endif
#pragma unroll
            for (int jb = 0; jb < 8; ++jb) T[jb] = __builtin_amdgcn_mfma_f32_16x16x32_bf16(tr4z(KH + (4 * fq + tq) * MST + (16 * jb + 4 * tp) * 2), Vf, T[jb] * gC, 0, 0, 0);
#ifdef PROF_MBSEG
            asm volatile("" :: "v"(T[0]), "v"(T[7])); { const unsigned long long t_ = __builtin_amdgcn_s_memrealtime(); if (PROF_MBSEG == 2) prof_wait += t_ - ts0_; ts0_ = t_; }
#endif
            ring_done(fl, s, lane);
#ifdef PROF_MBSEG
            { const unsigned long long t_ = __builtin_amdgcn_s_memrealtime(); if (PROF_MBSEG == 3) prof_wait += t_ - ts0_; ts0_ = t_; }
#endif
            { const int row0 = scan_row16(c, 0, b, d), stp = d ? -1 : 1;
#pragma unroll
              for (int e = 0; e < 4; ++e) yout[(size_t)(row0 + stp * (4 * fq + e)) * 512 + fr] = (bf16)f2bf(y[e]); }
#ifdef PROF_MBSEG
            { const unsigned long long t_ = __builtin_amdgcn_s_memrealtime(); if (PROF_MBSEG == 4) prof_wait += t_ - ts0_; ts0_ = t_; }
#endif
        }
#if defined(PROF_MBWAIT) || defined(PROF_MBSEG)
        if (F.bid == 128 && F.tid == 0) __hip_atomic_store(F.ctl + 2, __float_as_uint((float)prof_wait * 0.01f), RLX_AGENT);
#endif
        __builtin_amdgcn_s_setprio(0);
    }
}

struct FinIn { const float *gn_w, *gn_b, *mb_d, *mb_norm_w; };
__device__ __forceinline__ void finish_phase(Frame& F, const FinIn& P, const bf16* YRW, const bf16* YMB, const bf16* PR, const bf16* PM, const float* BONUS, const bf16* GATE, const bf16* ZG, bf16* A) {
    const int gw = F.bid * NWAVES + F.wave, NGW = F.G * NWAVES; const int c0 = F.lane * 8, head = F.lane >> 3;
    float gnw[8], gnb[8], nw[8];
#pragma unroll
    for (int i = 0; i < 8; ++i) { gnw[i] = P.gn_w[c0 + i]; gnb[i] = P.gn_b[c0 + i]; nw[i] = P.mb_norm_w[c0 + i]; }
    const float dd = P.mb_d[head];
    struct FinIn9 { v4u y0, y1, vv, gg, m0, m1, xx, zz; float bon; };
    FinIn9 cur, nxt;
#define FIN_FETCH(R_, g_) do { const size_t gs_ = (size_t)(g_); \
        R_.y0 = *(const GAS v4u*)(YRW + gs_ * 512 + c0); R_.y1 = *(const GAS v4u*)(YRW + (size_t)M_ALL * 512 + gs_ * 512 + c0); R_.vv = *(const GAS v4u*)(PR + gs_ * PRV + 512 + c0); R_.gg = *(const GAS v4u*)(GATE + gs_ * 512 + c0); \
        R_.m0 = *(const GAS v4u*)(YMB + gs_ * 512 + c0); R_.m1 = *(const GAS v4u*)(YMB + (size_t)M_ALL * 512 + gs_ * 512 + c0); R_.xx = *(const GAS v4u*)(PM + gs_ * 1024 + c0); R_.zz = *(const GAS v4u*)(ZG + gs_ * 512 + c0); \
        R_.bon = BONUS[gs_ * 8 + head]; } while (0)
    if (gw < M_ALL) FIN_FETCH(cur, gw);
    for (int g = gw; g < M_ALL; g += NGW) {
        const size_t gs = (size_t)g;
        if (g + NGW < M_ALL) FIN_FETCH(nxt, g + NGW);
        const v4u y0 = cur.y0, y1 = cur.y1, vv = cur.vv, gg = cur.gg, m0 = cur.m0, m1 = cur.m1, xx = cur.xx, zz = cur.zz; const float bon = cur.bon;
        cur = nxt;
        float y[8], vf[8], gf[8];
#pragma unroll
        for (int i = 0; i < 4; ++i) { y[2 * i] = bflo(y0[i]) + bflo(y1[i]); y[2 * i + 1] = bfhi(y0[i]) + bfhi(y1[i]); vf[2 * i] = bflo(vv[i]); vf[2 * i + 1] = bfhi(vv[i]); gf[2 * i] = bflo(gg[i]); gf[2 * i + 1] = bfhi(gg[i]); }
        float s = 0.f;
#pragma unroll
        for (int i = 0; i < 8; ++i) s += y[i];
        s = sum8(s);
        const float mu = s * (1.f / 64.f); float q = 0.f;
#pragma unroll
        for (int i = 0; i < 8; ++i) { y[i] -= mu; q += y[i] * y[i]; }
        q = sum8(q);
        const float rstd = rsqrtf(q * (1.f / 64.f) + 64e-5f);
        float o[8];
#pragma unroll
        for (int i = 0; i < 8; ++i) o[i] = ((y[i] * rstd) * gnw[i] + gnb[i] + bon * vf[i]) * gf[i];
        v4u w; w.x = pk2(o[0], o[1]); w.y = pk2(o[2], o[3]); w.z = pk2(o[4], o[5]); w.w = pk2(o[6], o[7]);
        *(GAS v4u*)(A + gs * 1024 + c0) = w;
        float ym[8]; float ss = 0.f;
#pragma unroll
        for (int i = 0; i < 4; ++i) {
            const float z0 = bflo(zz[i]), z1 = bfhi(zz[i]);
            ym[2 * i] = (bflo(m0[i]) + bflo(m1[i]) + dd * bflo(xx[i])) * (z0 * sigm(z0)); ym[2 * i + 1] = (bfhi(m0[i]) + bfhi(m1[i]) + dd * bfhi(xx[i])) * (z1 * sigm(z1));
            ss += ym[2 * i] * ym[2 * i] + ym[2 * i + 1] * ym[2 * i + 1];
        }
        ss = half_sum(ss, F.lane);
        const float rr = rsqrtf(ss * (1.f / 256.f) + 1e-6f);
        v4u w2; w2.x = pk2(ym[0] * rr * nw[0], ym[1] * rr * nw[1]); w2.y = pk2(ym[2] * rr * nw[2], ym[3] * rr * nw[3]); w2.z = pk2(ym[4] * rr * nw[4], ym[5] * rr * nw[5]); w2.w = pk2(ym[6] * rr * nw[6], ym[7] * rr * nw[7]);
        *(GAS v4u*)(A + gs * 1024 + 512 + c0) = w2;
    }
#undef FIN_FETCH
}
#ifndef PROF_K
#define PROF_K 1e-5f
#endif
#ifndef PROF_PH0
#define PROF_PH0 PROF_PH
#endif
#ifndef PROF_OFF
#define PROF_OFF 0.f
#endif

__device__ __forceinline__ bf16x8 tr2(const LAS unsigned char* p0, const LAS unsigned char* p1) {
    const s16x4 t0 = __builtin_bit_cast(s16x4, __builtin_amdgcn_ds_read_tr16_b64_v4i16((LAS v4i16_t*)p0));
    const s16x4 t1 = __builtin_bit_cast(s16x4, __builtin_amdgcn_ds_read_tr16_b64_v4i16((LAS v4i16_t*)p1));
    bf16x8 r; r[0] = t0[0]; r[1] = t0[1]; r[2] = t0[2]; r[3] = t0[3]; r[4] = t1[0]; r[5] = t1[1]; r[6] = t1[2]; r[7] = t1[3]; return r;
}
__device__ __forceinline__ int swz(int row, int chunk) { return row * 128 + ((chunk ^ (row & 7)) << 4); }
constexpr int AT_CTXK = 0, AT_CTXV = 32768, AT_VRING = 65536, AT_NSLOT = 9, AT_RPB = AT_VRING + AT_NSLOT * 8192;
__device__ __forceinline__ void attn_phase(Frame& F, const bf16* Q, const bf16* K, const bf16* V, const float* rpb, bf16* O) {
    LAS unsigned char* ctxK = F.lds + AT_CTXK; LAS unsigned char* ctxV = F.lds + AT_CTXV; LAS unsigned char* vring = F.lds + AT_VRING; LAS float* rp = (LAS float*)(F.lds + AT_RPB);
    const int lane = F.lane, fr = lane & 15, fq = lane >> 4, tq = (lane & 15) >> 2, tp = lane & 3;
#ifndef ATT_REPS
#define ATT_REPS 1
#endif
    const int avcu = (F.G % 8 == 0) ? (F.bid % 8) * (F.G / 8) + F.bid / 8 : F.bid;
    for (int u_ = avcu; u_ < 256 * ATT_REPS; u_ += F.G) {
        const int u = u_ & 255; const int bh = u >> 1, half = u & 1, b = bh >> 4, h = bh & 15;
        const unsigned latbase = (unsigned)(M_CTX + b * SEQ);
        const int vcol = F.tid >> 3, vch = F.tid & 7;
        const unsigned vsrc = (unsigned)((latbase + vcol) * D + h * 64 + vch * 8);
        const int vdst = vcol * 128 + ((vch ^ (vcol & 7)) << 4);
        __syncthreads();
        {
            const int key = F.tid >> 1, hf = F.tid & 1; const size_t src = (size_t)(b * CTXL + key) * D + h * 64 + hf * 32;
#pragma unroll
            for (int i = 0; i < 4; ++i) { *(LAS v4u*)(ctxK + swz(key, hf * 4 + i)) = *(const GAS v4u*)(K + src + 8 * i); *(LAS v4u*)(ctxV + swz(key, hf * 4 + i)) = *(const GAS v4u*)(V + src + 8 * i); }
            if (F.tid < 465) rp[F.tid] = rpb[h * 465 + F.tid] * 1.4426950408889634f;
            const int r0 = 16 * half, lo0 = min(max(r0 - 4, 0), 24), hi0 = min(max(r0 + 1 - 4, 0), 24) + 7;
            for (int kr = lo0; kr <= hi0; ++kr) *(LAS v4u*)(vring + (kr % AT_NSLOT) * 8192 + vdst) = *(const GAS v4u*)(V + vsrc + (unsigned)(kr * 64 * D));
        }
        __syncthreads();
        for (int it = 0; it < 8; ++it) {
            const int ra = 16 * half + 2 * it;
            const int r = ra + (F.wave >> 2), j = F.wave & 3;
            const int rs = min(max(r - 4, 0), 24); const int kb = (j == 0) ? 0 : (j == 1) ? 8 : (j == 2) ? 24 : 32;
            const int qc = 16 * j + fr, wsq = min(max(qc - 8, 0), 48);
            const int hi = min(max(ra + 1 - 4, 0), 24) + 7, hin = (it < 7) ? (min(max(ra + 3 - 4, 0), 24) + 7) : hi;
            bf16x8 qf[2];
            { const bf16* qp = Q + (unsigned)((latbase + r * 64 + qc) * D + h * 64 + 8 * fq); qf[0] = *(const GAS bf16x8*)qp; qf[1] = *(const GAS bf16x8*)(qp + 32); }
            const int cv = kb + 4 * fq - wsq, cc2 = kb + 4 * fq - qc + 15;
            f32x4 sl[8][2], sc[16];
            const unsigned koff = (unsigned)((latbase + rs * 64 + kb + fr) * D + h * 64 + 8 * fq);
            bf16x8 kc[4], kn[4];
#pragma unroll
            for (int x = 0; x < 4; ++x) kc[x] = *(const GAS bf16x8*)(K + koff + (x >> 1) * 16 * D + (x & 1) * 32);
#pragma unroll
            for (int i = 0; i < 8; ++i) {
                const int brow = (rs + i - r + 7) * 31;
                if (i < 7) {
#pragma unroll
                    for (int x = 0; x < 4; ++x) kn[x] = *(const GAS bf16x8*)(K + koff + (unsigned)((i + 1) * 64 * D) + (x >> 1) * 16 * D + (x & 1) * 32);
                }
#pragma unroll
                for (int blk = 0; blk < 2; ++blk) {
                    f32x4 s = {0.f, 0.f, 0.f, 0.f};
                    s = __builtin_amdgcn_mfma_f32_16x16x32_bf16(kc[2 * blk], qf[0], s, 0, 0, 0);
                    s = __builtin_amdgcn_mfma_f32_16x16x32_bf16(kc[2 * blk + 1], qf[1], s, 0, 0, 0);
#pragma unroll
                    for (int e = 0; e < 4; ++e) s[e] = ((unsigned)(cv + 16 * blk + e) < 16u) ? (s[e] + rp[brow + min(max(cc2 + 16 * blk + e, 0), 30)]) : -INFINITY;
                    sl[i][blk] = s;
                }
#pragma unroll
                for (int x = 0; x < 4; ++x) kc[x] = kn[x];
            }
#pragma unroll
            for (int cb = 0; cb < 16; ++cb) {
                const int key = 16 * cb + fr;
                const bf16x8 k0 = *(const LAS bf16x8*)(ctxK + swz(key, fq)), k1 = *(const LAS bf16x8*)(ctxK + swz(key, 4 + fq));
                f32x4 s = {0.f, 0.f, 0.f, 0.f};
                s = __builtin_amdgcn_mfma_f32_16x16x32_bf16(k0, qf[0], s, 0, 0, 0);
                s = __builtin_amdgcn_mfma_f32_16x16x32_bf16(k1, qf[1], s, 0, 0, 0);
                sc[cb] = s;
            }
            v4u vnew[2];
#pragma unroll
            for (int n = 0; n < 2; ++n) if (hi + 1 + n <= hin) vnew[n] = *(const GAS v4u*)(V + vsrc + (unsigned)((hi + 1 + n) * 64 * D));
            float m = -INFINITY;
#pragma unroll
            for (int i = 0; i < 8; ++i)
#pragma unroll
                for (int blk = 0; blk < 2; ++blk)
#pragma unroll
                    for (int e = 0; e < 4; ++e) m = fmaxf(m, sl[i][blk][e]);
#pragma unroll
            for (int cb = 0; cb < 16; ++cb)
#pragma unroll
                for (int e = 0; e < 4; ++e) m = fmaxf(m, sc[cb][e]);
            m = fmaxf(m, __shfl_xor(m, 16)); m = fmaxf(m, __shfl_xor(m, 32));
            float l = 0.f;
#pragma unroll
            for (int i = 0; i < 8; ++i)
#pragma unroll
                for (int blk = 0; blk < 2; ++blk)
#pragma unroll
                    for (int e = 0; e < 4; ++e) { const float p = __builtin_amdgcn_exp2f(sl[i][blk][e] - m); sl[i][blk][e] = p; l += p; }
#pragma unroll
            for (int cb = 0; cb < 16; ++cb)
#pragma unroll
                for (int e = 0; e < 4; ++e) { const float p = __builtin_amdgcn_exp2f(sc[cb][e] - m); sc[cb][e] = p; l += p; }
            l += __shfl_xor(l, 16); l += __shfl_xor(l, 32);
            const float linv = __builtin_amdgcn_rcpf(l);
            f32x4 o[4];
#pragma unroll
            for (int db = 0; db < 4; ++db) o[db] = (f32x4){0.f, 0.f, 0.f, 0.f};
#pragma unroll
            for (int i = 0; i < 8; ++i) {
                const LAS unsigned char* vrow = vring + ((rs + i) % AT_NSLOT) * 8192;
                const bf16x8 pa = pack8(sl[i][0], sl[i][1]);
                const int c0 = kb + 4 * fq + tq, c1 = c0 + 16;
#pragma unroll
                for (int db = 0; db < 4; ++db) {
                    const int ch = 2 * db + (tp >> 1), wi = 8 * (tp & 1);
                    const bf16x8 vb = tr2(vrow + swz(c0, ch) + wi, vrow + swz(c1, ch) + wi);
                    o[db] = __builtin_amdgcn_mfma_f32_16x16x32_bf16(pa, vb, o[db], 0, 0, 0);
                }
            }
#pragma unroll
            for (int cc = 0; cc < 8; ++cc) {
                const bf16x8 pa = pack8(sc[2 * cc], sc[2 * cc + 1]);
                const int k0 = 32 * cc + 4 * fq + tq, k1 = k0 + 16;
#pragma unroll
                for (int db = 0; db < 4; ++db) {
                    const int ch = 2 * db + (tp >> 1), wi = 8 * (tp & 1);
                    const bf16x8 vb = tr2(ctxV + swz(k0, ch) + wi, ctxV + swz(k1, ch) + wi);
                    o[db] = __builtin_amdgcn_mfma_f32_16x16x32_bf16(pa, vb, o[db], 0, 0, 0);
                }
            }
#pragma unroll
            for (int e = 0; e < 4; ++e) {
                const float li = __shfl(linv, 4 * fq + e);
                bf16* op = O + (unsigned)((b * SEQ + r * 64 + 16 * j + 4 * fq + e) * D + h * 64 + fr);
#pragma unroll
                for (int db = 0; db < 4; ++db) op[db * 16] = (bf16)f2bf(o[db][e] * li);
            }
            __syncthreads();
#pragma unroll
            for (int n = 0; n < 2; ++n) if (hi + 1 + n <= hin) *(LAS v4u*)(vring + ((hi + 1 + n) % AT_NSLOT) * 8192 + vdst) = vnew[n];
            __syncthreads();
        }
    }
}

__device__ __forceinline__ void router_phase(Frame& F, const float* hlat, const float* g, const float* mods_l, const float* router_w, const float* router_b, bf16* A4, unsigned* tokinfo, gu32* cntb) {
    LAS int* se = (LAS int*)F.lds;
    LAS float* sg = (LAS float*)(F.lds + 512);
    LAS int* srow = (LAS int*)(F.lds + 1024);
    LAS unsigned* spos = (LAS unsigned*)(F.lds + 1280);
    const int gw = F.bid * NWAVES + F.wave, NGW = F.G * NWAVES;
    const int nbatch = (M_LAT + NGW * 8 - 1) / (NGW * 8);
    LAS float* srw = (LAS float*)(F.lds + 2048);
    __syncthreads();
    for (int i = F.tid; i < 2048; i += NTHR) ((LAS f32x4*)srw)[i] = ((const GAS f32x4*)router_w)[i];
    f32x4 gg[4];
#pragma unroll
    for (int j = 0; j < 4; ++j) gg[j] = ((const GAS f32x4*)g)[F.lane + 64 * j];
    RowIn cur, nxt;
#define RT_FETCH(R_, r_) do { const float* mp_ = mods_l + ((r_) >> 11) * 6144; row_fetch(R_, hlat + (size_t)(r_) * D, mp_ + 3072, mp_ + 4096, F.lane); } while (0)
    if (gw < M_LAT) RT_FETCH(cur, gw);
    for (int bt = 0; bt < nbatch; ++bt) {
        __syncthreads();
#pragma unroll 1
        for (int k = 0; k < 8; ++k) {
            const int r = gw + (bt * 8 + k) * NGW, slot = F.wave * 8 + k;
            if (r >= M_LAT) { if (F.lane == 0) { se[2 * slot] = -1; se[2 * slot + 1] = -1; srow[slot] = 0; } continue; }
            if (r + NGW < M_LAT) RT_FETCH(nxt, r + NGW);
            f32x4 a[4]; row_finish(cur, gg, A4 + (size_t)r * D, F.lane, a);
            cur = nxt;
            float lg[8];
#pragma unroll
            for (int e = 0; e < 8; ++e) lg[e] = 0.f;
#pragma unroll
            for (int j = 0; j < 4; ++j)
#pragma unroll
                for (int x = 0; x < 4; ++x) { const LAS float* rw = srw + ((F.lane + 64 * j) * 4 + x) * 8; const f32x4 w0 = *(const LAS f32x4*)rw, w1 = *(const LAS f32x4*)(rw + 4); const float av = a[j][x];
#pragma unroll
                    for (int e = 0; e < 4; ++e) { lg[e] += av * w0[e]; lg[4 + e] += av * w1[e]; } }
#pragma unroll
            for (int e = 0; e < 8; ++e) lg[e] = wave_sum(lg[e]) + router_b[e];
            int e0 = 0; float v0 = lg[0];
#pragma unroll
            for (int e = 1; e < 8; ++e) if (lg[e] > v0) { v0 = lg[e]; e0 = e; }
            int e1 = -1; float v1 = -INFINITY;
#pragma unroll
            for (int e = 0; e < 8; ++e) if (e != e0 && lg[e] > v1) { v1 = lg[e]; e1 = e; }
            const float g0 = 1.f / (1.f + __expf(v1 - v0)), g1 = 1.f - g0;
            if (F.lane == 0) { se[2 * slot] = e0; se[2 * slot + 1] = e1; sg[2 * slot] = g0; sg[2 * slot + 1] = g1; srow[slot] = r; }
        }
        __syncthreads();
        if (F.wave == 0) {
            const int l = F.lane; const int ea = se[l], eb = se[64 + l];
            const unsigned long long below = (l == 0) ? 0ull : (~0ull >> (64 - l));
            unsigned ra = 0u, rb = 0u, tot = 0u;
#pragma unroll
            for (int e = 0; e < 8; ++e) {
                const unsigned long long ma = __ballot(ea == e), mb = __ballot(eb == e);
                const unsigned ca = (unsigned)__popcll(ma), cb = (unsigned)__popcll(mb);
                if (ea == e) ra = (unsigned)__popcll(ma & below);
                if (eb == e) rb = ca + (unsigned)__popcll(mb & below);
                if (l == e) tot = ca + cb;
            }
            if (l < 8) cntb[(size_t)(bt * F.G + F.bid) * 8 + l] = tot;
            spos[l] = ra; spos[64 + l] = rb;
            asm volatile("s_waitcnt lgkmcnt(0)" ::: "memory");
            if (se[2 * l] >= 0) {
                v4u t0; t0.x = (unsigned)se[2 * l]; t0.y = spos[2 * l]; t0.z = __float_as_uint(sg[2 * l]); t0.w = (unsigned)se[2 * l + 1];
                v4u t1; t1.x = spos[2 * l + 1]; t1.y = __float_as_uint(sg[2 * l + 1]); t1.z = 0u; t1.w = 0u;
                const size_t row = (size_t)srow[l];
                *(GAS v4u*)(tokinfo + row * 8) = t0; *(GAS v4u*)(tokinfo + row * 8 + 4) = t1;
            }
        }
    }
}
#undef RT_FETCH
__device__ __forceinline__ void moe_bases(gu32* cnt, int (&tb)[9]) {
    int acc = 0;
#pragma unroll
    for (int e = 0; e < 8; ++e) { tb[e] = acc; const unsigned c = __hip_atomic_load(cnt + 64 * e, RLX_AGENT); acc += (int)((c + 255u) >> 8); }
    tb[8] = acc;
}
#ifndef MOE_TAIL_SPLIT
#define MOE_TAIL_SPLIT 1
#endif
__device__ __forceinline__ void moe_tail_split(const int (&tb)[9], int G, int& first, int& ntail) {
    const int U = tb[8] * 4; first = (U / G) * G; ntail = U - first;
    if (first == 0 || (first & 3) || ntail > 32) { first = U; ntail = 0; }
#if !MOE_TAIL_SPLIT
    first = U; ntail = 0;
#endif
}
__device__ __forceinline__ void gather_phase(Frame& F, const bf16* A4, unsigned* tokinfo, gu32* cnt, const gu32* cntb, bf16* XG) {
    const int gw = F.bid * NWAVES + F.wave, NGW = F.G * NWAVES;
    const int nbatch = (M_LAT + NGW * 8 - 1) / (NGW * 8), nent = nbatch * F.G;
    LAS float* sred = (LAS float*)F.lds;
    __syncthreads();
    if (F.wave == 0) {
        float tot[8];
#pragma unroll
        for (int e = 0; e < 8; ++e) tot[e] = 0.f;
        for (int i = F.lane; i < nent; i += 64) { const v4u a = *(const GAS v4u*)(cntb + (size_t)i * 8), b = *(const GAS v4u*)(cntb + (size_t)i * 8 + 4);
            tot[0] += (float)a.x; tot[1] += (float)a.y; tot[2] += (float)a.z; tot[3] += (float)a.w; tot[4] += (float)b.x; tot[5] += (float)b.y; tot[6] += (float)b.z; tot[7] += (float)b.w; }
#pragma unroll
        for (int e = 0; e < 8; ++e) { const float s = wave_sum(tot[e]); if (F.lane == 0) sred[e] = s; }
        for (int bt = 0; bt < nbatch; ++bt) {
            const int mine = bt * F.G + F.bid; float pre[8];
#pragma unroll
            for (int e = 0; e < 8; ++e) pre[e] = 0.f;
            for (int i = F.lane; i < mine; i += 64) { const v4u a = *(const GAS v4u*)(cntb + (size_t)i * 8), b = *(const GAS v4u*)(cntb + (size_t)i * 8 + 4);
                pre[0] += (float)a.x; pre[1] += (float)a.y; pre[2] += (float)a.z; pre[3] += (float)a.w; pre[4] += (float)b.x; pre[5] += (float)b.y; pre[6] += (float)b.z; pre[7] += (float)b.w; }
#pragma unroll
            for (int e = 0; e < 8; ++e) { const float s = wave_sum(pre[e]); if (F.lane == 0) sred[8 + 8 * bt + e] = s; }
        }
    }
    __syncthreads();
    int tb[9]; { int acc = 0;
#pragma unroll
        for (int e = 0; e < 8; ++e) { tb[e] = acc; const unsigned c = (unsigned)sred[e]; acc += (int)((c + 255u) >> 8); if (F.bid == 0 && F.tid == 0) __hip_atomic_store(cnt + 64 * e, c, RLX_AGENT); }
        tb[8] = acc; }
    struct GIn { v4u t0, t1, x0, x1; };
    GIn cur, nxt;
#define G_FETCH(R_, r_) do { R_.t0 = *(const GAS v4u*)(tokinfo + (size_t)(r_) * 8); R_.t1 = *(const GAS v4u*)(tokinfo + (size_t)(r_) * 8 + 4); \
        const GAS v4u* s_ = (const GAS v4u*)(A4 + (size_t)(r_) * D); R_.x0 = s_[F.lane]; R_.x1 = s_[F.lane + 64]; } while (0)
    if (gw < M_LAT) G_FETCH(cur, gw);
    int k = 0;
    for (int r = gw; r < M_LAT; r += NGW, ++k) {
        if (r + NGW < M_LAT) G_FETCH(nxt, r + NGW);
        const v4u t0 = cur.t0, t1 = cur.t1, x0 = cur.x0, x1 = cur.x1; cur = nxt;
        const LAS float* pre = sred + 8 + 8 * (k >> 3);
        int tbe0 = 0, tbe1 = 0; unsigned pr0 = 0u, pr1 = 0u;
#pragma unroll
        for (int e = 0; e < 8; ++e) { if ((int)t0.x == e) { tbe0 = tb[e]; pr0 = (unsigned)pre[e]; } if ((int)t0.w == e) { tbe1 = tb[e]; pr1 = (unsigned)pre[e]; } }
        const unsigned row0 = (unsigned)tbe0 * 256u + pr0 + t0.y, row1 = (unsigned)tbe1 * 256u + pr1 + t1.x;
        GAS v4u* d0 = (GAS v4u*)(XG + (size_t)row0 * D); GAS v4u* d1 = (GAS v4u*)(XG + (size_t)row1 * D);
        d0[F.lane] = x0; d0[F.lane + 64] = x1; d1[F.lane] = x0; d1[F.lane + 64] = x1;
        if (F.lane == 0) { tokinfo[(size_t)r * 8 + 6] = row0; tokinfo[(size_t)r * 8 + 7] = row1; }
    }
#undef G_FETCH
}
__device__ __forceinline__ f32x4 moe_y4(const bf16* YG, const float* slab, unsigned row, int j, int lane, unsigned tailrow0, int first, int ntail) {
    if (row < tailrow0) { const v2u a = ((const GAS v2u*)(YG + (size_t)row * D) + lane)[64 * j]; return (f32x4){bflo(a.x), bfhi(a.x), bflo(a.y), bfhi(a.y)}; }
    const size_t kstride = (size_t)(ntail >> 2) * 256 * 1024; const float* p = slab + (size_t)(row - tailrow0) * 1024 + (lane + 64 * j) * 4; f32x4 s = {0.f, 0.f, 0.f, 0.f};
    for (int ks = 0; ks < 11; ++ks) s += *(const GAS f32x4*)(p + ks * kstride);
    const unsigned w0 = pk2(s[0], s[1]), w1 = pk2(s[2], s[3]);
    return (f32x4){bflo(w0), bfhi(w0), bflo(w1), bfhi(w1)};
}
__device__ __forceinline__ void final_phase(Frame& F, float* hout, const bf16* YG, const unsigned* tokinfo, const float* mods_l, const float* norm_final, const float* slab, gu32* cnt) {
    const int gw = F.bid * NWAVES + F.wave, NGW = F.G * NWAVES;
    int tb[9]; moe_bases(cnt, tb); int first, ntail; moe_tail_split(tb, F.G, first, ntail); const unsigned tailrow0 = (unsigned)(first >> 2) * 256u;
#if defined(PROF_PH) || defined(PROF_SCANWAIT) || defined(PROF_MBWAIT) || defined(PROF_MBSEG)
    const float prof_scale = 1.f + sqrtf(__uint_as_float(__hip_atomic_load(F.ctl + 2, RLX_AGENT)) * PROF_K);
#else
    const float prof_scale = 1.f;
#endif
    for (int r = gw; r < M_LAT; r += NGW) {
        const v4u t0 = *(const GAS v4u*)(tokinfo + (size_t)r * 8), t1 = *(const GAS v4u*)(tokinfo + (size_t)r * 8 + 4);
        const float g0 = __uint_as_float(t0.z), g1 = __uint_as_float(t1.y); const unsigned row0 = t1.z, row1 = t1.w;
        const float* mp = mods_l + (r >> 11) * 6144 + 5120;
        GAS f32x4* hr = (GAS f32x4*)(hout + (size_t)r * D) + F.lane;
        f32x4 v[4]; float ss = 0.f;
#pragma unroll
        for (int j = 0; j < 4; ++j) {
            const f32x4 hh = hr[64 * j], mm = ((const GAS f32x4*)mp)[F.lane + 64 * j];
            const f32x4 ya = moe_y4(YG, slab, row0, j, F.lane, tailrow0, first, ntail), yb = moe_y4(YG, slab, row1, j, F.lane, tailrow0, first, ntail);
            v[j] = hh + mm * (ya * g0 + yb * g1);
            ss += (v[j].x * v[j].x + v[j].y * v[j].y) + (v[j].z * v[j].z + v[j].w * v[j].w);
        }
        const float rs = rsqrtf(wave_sum(ss) * (1.f / 1024.f) + 1e-6f);
#pragma unroll
        for (int j = 0; j < 4; ++j) { const f32x4 gg = ((const GAS f32x4*)norm_final)[F.lane + 64 * j]; hr[64 * j] = (v[j] * (rs * prof_scale)) * gg; }
    }
}

constexpr int NPHASE = 19;
#ifndef MK_PER_PHASE
#define MK_PER_PHASE 0
#endif
__device__ __forceinline__ int fresh_lane() { int l; asm volatile("v_mbcnt_lo_u32_b32 %0, -1, 0\n\tv_mbcnt_hi_u32_b32 %0, -1, %0" : "=v"(l)); return l; }
struct Args { const float* in[39]; float* out; unsigned char* ws; int ph_lo, ph_hi; };
#define KARGP(k) (((void* const __attribute__((address_space(4)))*)__builtin_amdgcn_kernarg_segment_ptr())[k])
#define KARG(k) ((const float*)KARGP(k))
__global__ void __launch_bounds__(NWAVES * 64, 2) mk_fwd(Args args) {
    extern __shared__ __attribute__((aligned(16))) unsigned char lds[];
    Frame F;
    F.lds = (LAS unsigned char*)lds; F.MISC = (volatile LAS unsigned*)(F.lds + MISC_OFF);
    F.tid = threadIdx.x; F.lane = F.tid & 63; F.wave = __builtin_amdgcn_readfirstlane(F.tid >> 6); F.G = gridDim.x; F.bid = blockIdx.x;
    unsigned char* ws = (unsigned char*)KARGP(40); F.ctl = (gu32*)(ws + WS_CTL);
    for (int u = F.tid; u < (LDS_BYTES - LDSCTL_OFF) / 4; u += NWAVES * 64) ((LAS unsigned*)(F.lds + LDSCTL_OFF))[u] = 0u;
    __syncthreads();
    const int lo = args.ph_lo, hi = args.ph_hi;
    unsigned long long prof_t0 = 0ull; (void)prof_t0;
    XcdBarrier bar; bar.bar = (unsigned*)(F.ctl + CW_BAR); bar.x = 0; bar.st = nullptr;
    if (hi - lo > 1) bar = xcd_barrier_post((unsigned*)(F.ctl + CW_BAR), F.MISC + 8);
#ifdef PH_MASK
#define IN(k) ((((PH_MASK) >> (k)) & 1) && lo <= (k) && (k) < hi)
#else
#define IN(k) (lo <= (k) && (k) < hi)
#endif
#ifndef DUP_MASK
#define DUP_MASK 0
#endif
#ifdef PROF_PH
#define PROF_T0(k) do { if ((k) == PROF_PH0 && F.bid == 0 && F.tid == 0) __hip_atomic_store(F.ctl + 4, (unsigned)__builtin_amdgcn_s_memrealtime(), RLX_AGENT); } while (0)
#define PROF_T1(k) do { if ((k) == PROF_PH && F.bid == 0 && F.tid == 0) { const unsigned t1_ = (unsigned)__builtin_amdgcn_s_memrealtime(); __hip_atomic_store(F.ctl + 2, __float_as_uint(fmaxf((float)(t1_ - __hip_atomic_load(F.ctl + 4, RLX_AGENT)) * 0.01f - (PROF_OFF), 0.f)), RLX_AGENT); } } while (0)
#else
#define PROF_T0(k) do {} while (0)
#define PROF_T1(k) do {} while (0)
#endif
#define REPS(k) (1 + (((DUP_MASK) >> (k)) & 1))
#ifdef DOUBLE_BAR
#define SEAM(k) do { if (IN(k) && IN((k) + 1)) { xcd_barrier(bar); xcd_barrier(bar); } } while (0)
#else
#define SEAM(k) do { if (IN(k) && IN((k) + 1)) xcd_barrier(bar); } while (0)
#endif
    const float* x = KARG(0); const float* ctx = KARG(2);
    float* mods = (float*)(ws + WS_MODS); float* hctx = (float*)(ws + WS_HCTX); float* hlat = (float*)KARGP(39);
    bf16* A = (bf16*)(ws + WS_A);
    const int vcu = (F.G % 8 == 0) ? (F.bid % 8) * (F.G / 8) + F.bid / 8 : F.bid;

    PROF_T0(0); if (IN(0)) for (int rep_ = 0; rep_ < REPS(0); ++rep_) { if (rep_) __syncthreads(); F.lane = fresh_lane(); F.tid = F.wave * 64 + F.lane; p0_phase(F, KARG(1), KARG(3), KARG(4), KARG(5), mods, KARG(9), KARG(10), KARG(28), KARG(29), KARG(30), KARG(31), KARG(32), ws); }
    SEAM(0); PROF_T1(0);
    PROF_T0(1); if (IN(1)) for (int rep_ = 0; rep_ < REPS(1); ++rep_) { if (rep_) __syncthreads(); F.lane = fresh_lane(); F.tid = F.wave * 64 + F.lane; normmod_phase(F, ctx, x, KARG(6), mods, 0, 1024, A); }
    SEAM(1); PROF_T1(1);
    PROF_T0(2); if (IN(2)) for (int rep_ = 0; rep_ < REPS(2); ++rep_) { if (rep_) __syncthreads(); F.lane = fresh_lane(); F.tid = F.wave * 64 + F.lane;
        pg8::Gemm g{A, (const bf16*)(ws + WS_WIN_T), M_ALL, ZLD, D}; pg8::StaticOrder S; S.init(M_ALL, ZLD, F.G, F.bid);
        pg8::EpiBf16<0> E{(bf16*)(ws + WS_Z), ZLD, nullptr, 0, 0, 1.f};
        pg8::gemm_phase<pg8::EpiBf16<0>, pg8::StaticOrder, true, true>(F.lds, g, S, E);
    }
    SEAM(2); PROF_T1(2);
    PROF_T0(3); if (IN(3)) for (int rep_ = 0; rep_ < REPS(3); ++rep_) { if (rep_) __syncthreads(); F.lane = fresh_lane(); F.tid = F.wave * 64 + F.lane;
        PrepIn P{KARG(11), KARG(12), KARG(13), KARG(14), KARG(15), KARG(16), KARG(17), KARG(18), KARG(19), KARG(22), KARG(23), KARG(24)};
        prepare_phase(F, P, (const bf16*)(ws + WS_Z), (bf16*)(ws + WS_PR), (bf16*)(ws + WS_PM), (float*)(ws + WS_DT), (float*)(ws + WS_BONUS), (bf16*)(ws + WS_GATE), (bf16*)(ws + WS_ZG));
    }
    SEAM(3); PROF_T1(3);
    PROF_T0(4); if (IN(4)) for (int rep_ = 0; rep_ < REPS(4); ++rep_) { if (rep_) __syncthreads(); F.lane = fresh_lane(); F.tid = F.wave * 64 + F.lane;
        for (int u = F.bid; u < 256; u += F.G) {
            if (u < 128) { rwkv_block(F, u, (const bf16*)(ws + WS_PR), (bf16*)(ws + WS_YRW));
#ifdef RWKV2X
                rwkv_block(F, u, (const bf16*)(ws + WS_PR), (bf16*)(ws + WS_YRW));
#endif
            }
            else { mamba_block(F, u - 128, (const bf16*)(ws + WS_PM), (const float*)(ws + WS_DT), KARG(25), (bf16*)(ws + WS_YMB));
#ifdef MAMBA2X
                   mamba_block(F, u - 128, (const bf16*)(ws + WS_PM), (const float*)(ws + WS_DT), KARG(25), (bf16*)(ws + WS_YMB));
#endif
            }
        }
    }
    SEAM(4); PROF_T1(4);
    PROF_T0(5); if (IN(5)) for (int rep_ = 0; rep_ < REPS(5); ++rep_) { if (rep_) __syncthreads(); F.lane = fresh_lane(); F.tid = F.wave * 64 + F.lane;
        FinIn P{KARG(20), KARG(21), KARG(26), KARG(27)};
        finish_phase(F, P, (const bf16*)(ws + WS_YRW), (const bf16*)(ws + WS_YMB), (const bf16*)(ws + WS_PR), (const bf16*)(ws + WS_PM), (const float*)(ws + WS_BONUS), (const bf16*)(ws + WS_GATE), (const bf16*)(ws + WS_ZG), A);
    }
    SEAM(5); PROF_T1(5);
    PROF_T0(6); if (IN(6)) for (int rep_ = 0; rep_ < REPS(6); ++rep_) { if (rep_) __syncthreads(); F.lane = fresh_lane(); F.tid = F.wave * 64 + F.lane;
        {
            pg8::Gemm g{A + (size_t)M_CTX * D, (const bf16*)(ws + WS_WOUT_T), M_LAT, D, D}; pg8::StaticOrder S; S.init(M_LAT, D, F.G, F.bid);
            if (F.G == 256) { pg8::EpiResGateNorm E{x, hlat, mods, 2048, KARG(7), 3072, 4096, (bf16*)(ws + WS_A2) + (size_t)M_CTX * D, (float*)(ws + WS_XBUF), (unsigned*)(F.ctl + CW_XCNT)};
                pg8::gemm_phase<pg8::EpiResGateNorm, pg8::StaticOrder, true, true>(F.lds, g, S, E); }
            else { pg8::EpiResGate E{x, x, hlat, hlat, mods, 2048, 0};
                pg8::gemm_phase<pg8::EpiResGate, pg8::StaticOrder, true, true>(F.lds, g, S, E); }
        }
        { int l_; asm volatile("v_mbcnt_lo_u32_b32 %0, -1, 0\n\tv_mbcnt_hi_u32_b32 %0, -1, %0" : "=v"(l_) :: "memory"); F.lane = l_; F.tid = F.wave * 64 + F.lane; }
        {
            pg8::Gemm g{A, (const bf16*)(ws + WS_WOUT_T), M_CTX, D, 256, D}; pg8::SplitKOrder S{8, 4, 4, 256, F.G, F.bid};
            pg8::EpiSlabGate E{(float*)(ws + WS_SLAB6), mods + 8 * 6144 + 2048, 256};
            pg8::gemm_phase<pg8::EpiSlabGate, pg8::SplitKOrder, true, true>(F.lds, g, S, E);
        }
        { const int nsub = 8 * 4 * 4; if (F.G > nsub && F.bid >= nsub) moe_weight_phase(F, KARG(36), KARG(37), KARG(38), ws, 0, MOE_ITEMS_P6, F.bid - nsub, F.G - nsub);
          else if (F.G <= nsub) moe_weight_phase(F, KARG(36), KARG(37), KARG(38), ws, 0, MOE_ITEMS_P6, F.bid, F.G); }
    }
    SEAM(6); PROF_T1(6);
    PROF_T0(7); if (IN(7)) for (int rep_ = 0; rep_ < REPS(7); ++rep_) { if (rep_) __syncthreads(); F.lane = fresh_lane(); F.tid = F.wave * 64 + F.lane; normmod_phase(F, ctx, hlat, KARG(7), mods, 3072, 4096, (bf16*)(ws + WS_A2), (const float*)(ws + WS_SLAB6), 4, hctx, F.G == 256 ? M_CTX : M_ALL); moe_weight_phase(F, KARG(36), KARG(37), KARG(38), ws, MOE_ITEMS_P6, MOE_ITEMS_P7, F.bid, F.G); }
    SEAM(7); PROF_T1(7);
    PROF_T0(8); if (IN(8)) for (int rep_ = 0; rep_ < REPS(8); ++rep_) { if (rep_) __syncthreads(); F.lane = fresh_lane(); F.tid = F.wave * 64 + F.lane;
        pg8::Gemm g{(const bf16*)(ws + WS_A2), (const bf16*)(ws + WS_W13_T), M_ALL, 2 * FF, D}; pg8::StaticOrder S; S.init(M_ALL, 2 * FF, F.G, F.bid);
        pg8::EpiSwiGLU E{(bf16*)(ws + WS_HID), FF, 1 << 20};
        pg8::gemm_phase<pg8::EpiSwiGLU, pg8::StaticOrder, true, true>(F.lds, g, S, E);
        {
            const int nfull = ((M_ALL / 256) * (2 * FF / 256)) % F.G;
            if (nfull != 0 && F.bid >= nfull) moe_weight_phase(F, KARG(36), KARG(37), KARG(38), ws, MOE_ITEMS_P7, MOE_ITEMS_P7 + MOE_ITEMS_P8, F.bid - nfull, F.G - nfull);
            else if (nfull == 0) moe_weight_phase(F, KARG(36), KARG(37), KARG(38), ws, MOE_ITEMS_P7, MOE_ITEMS_P7 + MOE_ITEMS_P8, F.bid, F.G);
        }
    }
    SEAM(8); PROF_T1(8);
    PROF_T0(9); if (IN(9)) for (int rep_ = 0; rep_ < REPS(9); ++rep_) { if (rep_) __syncthreads(); F.lane = fresh_lane(); F.tid = F.wave * 64 + F.lane;
        {
            pg8::Gemm g{(const bf16*)(ws + WS_HID) + (size_t)M_CTX * FF, (const bf16*)(ws + WS_W2_T), M_LAT, D, FF}; pg8::StaticOrder S; S.init(M_LAT, D, F.G, F.bid);
            if (F.G == 256) { pg8::EpiResGateNorm E{hlat, hlat, mods, 5120, KARG(6) + D, 0, 1024, A + (size_t)M_CTX * D, (float*)(ws + WS_XBUF) + 65536, (unsigned*)(F.ctl + CW_XCNT + 4096)};
                E.mods_l = mods; E.off_shift = 9 * 6144; E.off_scale = 9 * 6144 + 1024;
                pg8::gemm_phase<pg8::EpiResGateNorm, pg8::StaticOrder, true, true>(F.lds, g, S, E); }
            else { pg8::EpiResGate E{hlat, hlat, hlat, hlat, mods, 5120, 0};
                pg8::gemm_phase<pg8::EpiResGate, pg8::StaticOrder, true, true>(F.lds, g, S, E); }
        }
        { int l_; asm volatile("v_mbcnt_lo_u32_b32 %0, -1, 0\n\tv_mbcnt_hi_u32_b32 %0, -1, %0" : "=v"(l_) :: "memory"); F.lane = l_; F.tid = F.wave * 64 + F.lane; }
        {
            pg8::Gemm g{(const bf16*)(ws + WS_HID), (const bf16*)(ws + WS_W2_T), M_CTX, D, 1408, FF}; pg8::SplitKOrder S{8, 4, 2, 1408, F.G, F.bid};
            pg8::EpiSlabGate E{(float*)(ws + WS_SLAB9), mods + 8 * 6144 + 5120, 1408};
            pg8::gemm_phase<pg8::EpiSlabGate, pg8::SplitKOrder, true, true>(F.lds, g, S, E);
        }
        {
            const int nsub = 8 * 4 * 2;
            if (F.G > nsub) { if (F.bid >= nsub) moe_weight_phase(F, KARG(36), KARG(37), KARG(38), ws, MOE_ITEMS_P7 + MOE_ITEMS_P8, MOE_ITEMS_P7 + MOE_ITEMS_P8 + MOE_ITEMS_P9, F.bid - nsub, F.G - nsub); }
            else moe_weight_phase(F, KARG(36), KARG(37), KARG(38), ws, MOE_ITEMS_P7 + MOE_ITEMS_P8, MOE_ITEMS_P7 + MOE_ITEMS_P8 + MOE_ITEMS_P9, F.bid, F.G);
        }
    }
    SEAM(9); PROF_T1(9);
    const float* mods1 = mods + 9 * 6144;
    PROF_T0(10); if (IN(10)) for (int rep_ = 0; rep_ < REPS(10); ++rep_) { if (rep_) __syncthreads(); F.lane = fresh_lane(); F.tid = F.wave * 64 + F.lane; normmod_phase(F, hctx, hlat, KARG(6) + D, mods1, 0, 1024, A, (const float*)(ws + WS_SLAB9), 2, nullptr, F.G == 256 ? M_CTX : M_ALL); }
    SEAM(10); PROF_T1(10);
    PROF_T0(11); if (IN(11)) for (int rep_ = 0; rep_ < REPS(11); ++rep_) { if (rep_) __syncthreads(); F.lane = fresh_lane(); F.tid = F.wave * 64 + F.lane;
        pg8::Gemm g{A, (const bf16*)(ws + WS_QKV_T), M_ALL, 3 * D, D}; pg8::StaticOrder S; S.init(M_ALL, 3 * D, F.G, F.bid);
        pg8::EpiBf16<0> E{(bf16*)(ws + WS_Q), D, nullptr, D, (size_t)M_ALL * D, 0.125f * 1.4426950408889634f};
        pg8::gemm_phase<pg8::EpiBf16<0>, pg8::StaticOrder, true, true>(F.lds, g, S, E);
        {
            const int nfull = ((M_ALL / 256) * (3 * D / 256)) % F.G;
            if (nfull != 0 && F.bid >= nfull) moe_weight_phase(F, KARG(36), KARG(37), KARG(38), ws, MOE_ITEMS - MOE_ITEMS_P16 - MOE_ITEMS_P11, MOE_ITEMS - MOE_ITEMS_P16, F.bid - nfull, F.G - nfull);
            else if (nfull == 0) moe_weight_phase(F, KARG(36), KARG(37), KARG(38), ws, MOE_ITEMS - MOE_ITEMS_P16 - MOE_ITEMS_P11, MOE_ITEMS - MOE_ITEMS_P16, F.bid, F.G);
        }
    }
    SEAM(11); PROF_T1(11);
    PROF_T0(12); if (IN(12)) for (int rep_ = 0; rep_ < REPS(12); ++rep_) { if (rep_) __syncthreads(); F.lane = fresh_lane(); F.tid = F.wave * 64 + F.lane; attn_phase(F, (const bf16*)(ws + WS_Q), (const bf16*)(ws + WS_K), (const bf16*)(ws + WS_V), KARG(33), (bf16*)(ws + WS_O)); }
    SEAM(12); PROF_T1(12);
    PROF_T0(13); if (IN(13)) for (int rep_ = 0; rep_ < REPS(13); ++rep_) { if (rep_) __syncthreads(); F.lane = fresh_lane(); F.tid = F.wave * 64 + F.lane;
        pg8::Gemm g{(const bf16*)(ws + WS_O), (const bf16*)(ws + WS_NAO_T), M_LAT, D, D}; pg8::StaticOrder S; S.init(M_LAT, D, F.G, F.bid);
        pg8::EpiResGate E{hlat, hlat, hlat, hlat, mods1, 2048, 0};
        pg8::gemm_phase<pg8::EpiResGate, pg8::StaticOrder, true, true>(F.lds, g, S, E);
    }
    SEAM(13); PROF_T1(13);
    PROF_T0(14); if (IN(14)) for (int rep_ = 0; rep_ < REPS(14); ++rep_) { if (rep_) __syncthreads(); F.lane = fresh_lane(); F.tid = F.wave * 64 + F.lane; router_phase(F, hlat, KARG(7) + D, mods1, KARG(34), KARG(35), (bf16*)(ws + WS_A4), (unsigned*)(ws + WS_TOK), F.ctl + CW_CNTB); }
    SEAM(14); PROF_T1(14);
    PROF_T0(15); if (IN(15)) for (int rep_ = 0; rep_ < REPS(15); ++rep_) { if (rep_) __syncthreads(); F.lane = fresh_lane(); F.tid = F.wave * 64 + F.lane; gather_phase(F, (const bf16*)(ws + WS_A4), (unsigned*)(ws + WS_TOK), F.ctl + CW_CNT, F.ctl + CW_CNTB, (bf16*)(ws + WS_XG)); }
    SEAM(15); PROF_T1(15);
    PROF_T0(16); if (IN(16)) for (int rep_ = 0; rep_ < REPS(16); ++rep_) { if (rep_) __syncthreads(); F.lane = fresh_lane(); F.tid = F.wave * 64 + F.lane;
        pg8::MoeOrder S; moe_bases(F.ctl + CW_CNT, S.tb); S.ntn = 22; S.G = F.G; S.c = vcu;
        pg8::Gemm g{(const bf16*)(ws + WS_XG), (const bf16*)(ws + WS_MOEW13), MOE_ROWS, NE * 2 * FF, D};
        pg8::EpiSwiGLU E{(bf16*)(ws + WS_HIDG), FF, 22};
        pg8::gemm_phase<pg8::EpiSwiGLU, pg8::MoeOrder, true, true>(F.lds, g, S, E);
        {
            const int nlast = (S.tb[8] * 22) % F.G;
            if (nlast != 0 && vcu >= nlast) moe_weight_phase(F, KARG(36), KARG(37), KARG(38), ws, MOE_ITEMS - MOE_ITEMS_P16, MOE_ITEMS, vcu - nlast, F.G - nlast);
            else if (nlast == 0) moe_weight_phase(F, KARG(36), KARG(37), KARG(38), ws, MOE_ITEMS - MOE_ITEMS_P16, MOE_ITEMS, F.bid, F.G);
        }
    }
    SEAM(16); PROF_T1(16);
    PROF_T0(17); if (IN(17)) for (int rep_ = 0; rep_ < REPS(17); ++rep_) { if (rep_) __syncthreads(); F.lane = fresh_lane(); F.tid = F.wave * 64 + F.lane;
        pg8::MoeOrder S; moe_bases(F.ctl + CW_CNT, S.tb); S.ntn = 4; S.G = F.G; S.c = vcu;
        int first, ntail; moe_tail_split(S.tb, F.G, first, ntail); S.limit = first;
        {
            pg8::Gemm g{(const bf16*)(ws + WS_HIDG), (const bf16*)(ws + WS_MOEW2), MOE_ROWS, NE * D, FF};
            pg8::EpiPlainMod E{(bf16*)(ws + WS_YG), D, 4};
            pg8::gemm_phase<pg8::EpiPlainMod, pg8::MoeOrder, true, true>(F.lds, g, S, E);
        }
#if MOE_TAIL_SPLIT
        if (ntail > 0) {
            pg8::MoeTailOrder ST;
#pragma unroll
            for (int k = 0; k < 9; ++k) ST.tb[k] = S.tb[k];
            ST.first = first; ST.ntail = ntail; ST.G = F.G; ST.c = vcu;
            pg8::Gemm g{(const bf16*)(ws + WS_HIDG), (const bf16*)(ws + WS_MOEW2), MOE_ROWS, NE * D, 256, FF};
            pg8::EpiTailSlab E{(float*)(ws + WS_TAIL), first, ntail};
            pg8::gemm_phase<pg8::EpiTailSlab, pg8::MoeTailOrder, true, true>(F.lds, g, ST, E);
        }
#endif
    }
    SEAM(17); PROF_T1(17);
    PROF_T0(18); if (IN(18)) for (int rep_ = 0; rep_ < REPS(18); ++rep_) { if (rep_) __syncthreads(); F.lane = fresh_lane(); F.tid = F.wave * 64 + F.lane; final_phase(F, hlat, (const bf16*)(ws + WS_YG), (const unsigned*)(ws + WS_TOK), mods1, KARG(8), (const float*)(ws + WS_TAIL), F.ctl + CW_CNT); }
#undef IN
#undef SEAM
}

extern "C" void kernel_launch(void* const* d_in, const int* in_sizes, int n_in, void* d_out, int out_size, void* d_ws, size_t ws_size, hipStream_t stream) {
    static int grid = 0;
    if (grid == 0) {
        if (n_in != 39 || out_size != M_LAT * D || ws_size < WS_END) { fprintf(stderr, "kernel_launch: unexpected shapes (n_in %d, out %d, ws %zu)\n", n_in, out_size, ws_size); grid = -1; return; }
        int dev = 0, cus = 0, per_cu = 0;
        if (hipGetDevice(&dev) != hipSuccess || hipDeviceGetAttribute(&cus, hipDeviceAttributeMultiprocessorCount, dev) != hipSuccess) { grid = -1; return; }
        if (hipFuncSetAttribute((const void*)mk_fwd, hipFuncAttributeMaxDynamicSharedMemorySize, LDS_BYTES) != hipSuccess) { fprintf(stderr, "kernel_launch: hipFuncSetAttribute failed\n"); grid = -1; return; }
        if (hipOccupancyMaxActiveBlocksPerMultiprocessor(&per_cu, (const void*)mk_fwd, NWAVES * 64, LDS_BYTES) != hipSuccess || per_cu < 1) fprintf(stderr, "kernel_launch: occupancy query says %d\n", per_cu);
        (void)hipGetLastError();
        grid = cus;
    }
    if (grid < 0) return;
    if (hipMemsetAsync((char*)d_ws + WS_CTL, 0, CTL_ZERO_BYTES, stream) != hipSuccess) return;
    Args a{};
    for (int i = 0; i < 39; ++i) a.in[i] = (const float*)d_in[i];
    a.out = (float*)d_out; a.ws = (unsigned char*)d_ws;
#if MK_PER_PHASE
    for (int p = 0; p < NPHASE; ++p) { a.ph_lo = p; a.ph_hi = p + 1; hipLaunchKernelGGL(mk_fwd, dim3(grid), dim3(NWAVES * 64), LDS_BYTES, stream, a); }
#else
    a.ph_lo = 0; a.ph_hi = NPHASE; hipLaunchKernelGGL(mk_fwd, dim3(grid), dim3(NWAVES * 64), LDS_BYTES, stream, a);
#endif
}
```

```cpp
#include <hip/hip_runtime.h>
#include <cstdio>
#include <cstdint>
#include <cmath>
#define MK_PER_PHASE 0
namespace pg8 {
#define PG8_LAS __attribute__((address_space(3)))
typedef unsigned short bf16_t;
typedef short bf16x8 __attribute__((ext_vector_type(8)));
typedef float f32x4 __attribute__((ext_vector_type(4)));
typedef unsigned u32x4 __attribute__((ext_vector_type(4)));
constexpr int BM = 256, BK = 64, HALF = 128, HTB = HALF * BK * 2  , STAGE_BYTES = 8 * HTB, NXCD = 8, WGM = 8;

__host__ __device__ __forceinline__ int lds_byte(int r, int c) { const int st = (r >> 4) * 2 + (c >> 5), rr = r & 15, cc = c & 31, ob = rr * 64 + cc * 2; return st * 1024 + (ob ^ (((ob >> 9) & 1) << 5)); }
__host__ __device__ __forceinline__ void stage_rc(int b, int& R, int& C) { const int st = b / 1024, sb = b % 1024, swz = sb ^ (((sb >> 9) & 1) << 5); R = (st >> 1) * 16 + swz / 64; C = (st & 1) * 32 + (swz % 64) / 2; }
__host__ __device__ __forceinline__ int perm32(int rho) { const int n = rho >> 4, i = rho & 15; return 8 * (i >> 2) + 4 * n + (i & 3); }

#ifndef PG8_WT
#define PG8_WT 0
#endif
#if PG8_WT
#define PG8_ST16(base_, ptr_, v_) __builtin_amdgcn_raw_buffer_store_b128((v_), __builtin_amdgcn_make_buffer_rsrc((void*)(base_), (short)0, 0x7fffffff, 0x00020000), (int)((const char*)(ptr_) - (const char*)(base_)), 0, 16)
#else
#define PG8_ST16(base_, ptr_, v_) (*(u32x4*)(ptr_) = (v_))
#endif
struct Unit { int pm, pn; int k0 = 0; };
struct Gemm { const bf16_t* A; const bf16_t* Bt; int M, N, K; int ld = 0; };

struct StaticOrder {
    int nM, nN, nwg, G, c;
    __host__ __device__ void init(int M, int N, int G_, int c_) { nM = M / BM; nN = N / BM; nwg = nM * nN; G = G_; c = c_; }
    __host__ __device__ bool next(int i, Unit& u) const {
        const long L = (long)i * G + c; if (L >= nwg) return false;
        int wgid = (int)L; { const int q = nwg / NXCD, r = nwg % NXCD, xcd = wgid % NXCD, off = wgid / NXCD; wgid = (xcd < r ? xcd * (q + 1) : r * (q + 1) + (xcd - r) * q) + off; }
        const int nig = WGM * nN, gid = wgid / nig, fm = gid * WGM, gsz = (nM - fm) < WGM ? (nM - fm) : WGM;
        u.pm = fm + ((wgid % nig) % gsz); u.pn = (wgid % nig) / gsz; return true;
    }
    __device__ __forceinline__ void a_ready(const Unit&) const {}
    __device__ __forceinline__ void done(const Unit&) const {}
};

__device__ __forceinline__ unsigned cvt_pk_bf16(float lo, float hi) { unsigned r; asm volatile("v_cvt_pk_bf16_f32 %0, %1, %2" : "=v"(r) : "v"(lo), "v"(hi)); return r; }
typedef float f32x2 __attribute__((ext_vector_type(2)));
__device__ __forceinline__ f32x2 gelu_pk(f32x2 v) {
    const f32x2 av = __builtin_elementwise_abs(v), d = av * 0.2316418882f + 1.0f;
    f32x2 t; t.x = __builtin_amdgcn_rcpf(d.x); t.y = __builtin_amdgcn_rcpf(d.y);
    f32x2 q = t * 0.5307027145f + (-0.7265760135f); q = q * t + 0.7107068705f; q = q * t + (-0.142248368f); q = q * t + 0.127414796f; q = q * t;
    const f32x2 s = (v * v) * (-0.72134752044f);
    f32x2 e; e.x = __builtin_amdgcn_exp2f(s.x); e.y = __builtin_amdgcn_exp2f(s.y);
    const f32x2 m = v * (q * e), r = v - m;
    f32x2 o; o.x = v.x < 0.f ? m.x : r.x; o.y = v.y < 0.f ? m.y : r.y; return o;
}

template <int ACT  > struct EpiBf16 {
    static constexpr bool PERM = true, AFTER_DRAIN = false; static_assert(ACT == 0 || ACT == 1, "EpiBf16: ACT is 0 (none) or 1 (gelu_pk)");
    bf16_t* O; int ldc; const float* bias; int split_cols; size_t split_stride; float scale0;
    __device__ __forceinline__ void operator()(const f32x4 (&acc)[2][2][4][2], const Unit& u, int wr, int wc, int fr, int fq) const {
        const int row0 = u.pm * BM + wr * 64 + fr; int colt = u.pn * BM; bf16_t* base = O;
        float sc = 1.f; if (split_cols) { const int t = colt / split_cols; base += (size_t)t * split_stride; colt -= t * split_cols; if (t == 0) sc = scale0; }
        const int col0 = colt + wc * 32 + 8 * fq, bcol0 = u.pn * BM + wc * 32 + 8 * fq;
        f32x4 bv[2][2];
#pragma unroll
        for (int bj = 0; bj < 2; ++bj)
#pragma unroll
            for (int n = 0; n < 2; ++n) bv[bj][n] = bias ? *(const f32x4*)(bias + bcol0 + bj * HALF + 4 * n) : (f32x4){0.f, 0.f, 0.f, 0.f};
#pragma unroll
        for (int ai = 0; ai < 2; ++ai)
#pragma unroll
            for (int m = 0; m < 4; ++m) { bf16_t* rowp = base + (size_t)(row0 + ai * HALF + m * 16) * ldc + col0;
#pragma unroll
                for (int bj = 0; bj < 2; ++bj) { f32x4 v0 = acc[ai][bj][m][0] + bv[bj][0], v1 = acc[ai][bj][m][1] + bv[bj][1];
                    if (ACT == 1) { f32x2 a = gelu_pk((f32x2){v0[0], v0[1]}), b = gelu_pk((f32x2){v0[2], v0[3]}), c = gelu_pk((f32x2){v1[0], v1[1]}), d = gelu_pk((f32x2){v1[2], v1[3]});
                        v0 = (f32x4){a.x, a.y, b.x, b.y}; v1 = (f32x4){c.x, c.y, d.x, d.y}; }
                    v0 = v0 * sc; v1 = v1 * sc; u32x4 w; w.x = cvt_pk_bf16(v0[0], v0[1]); w.y = cvt_pk_bf16(v0[2], v0[3]); w.z = cvt_pk_bf16(v1[0], v1[1]); w.w = cvt_pk_bf16(v1[2], v1[3]);
                    PG8_ST16(base, rowp + bj * HALF, w); } }
    }
};
template <class Epi, class Sched, bool ALIGN_EPI = false, bool SP2 = false>
__device__ __forceinline__ void gemm_phase(PG8_LAS unsigned char* lds, const Gemm g, const Sched& S, const Epi& E) {
    int tid_ = threadIdx.x; asm volatile("" : "+v"(tid_) :: "memory");
    const int tid = tid_, wid = __builtin_amdgcn_readfirstlane(tid >> 6), lane = tid & 63, wr = wid >> 2, wc = wid & 3, fr = lane & 15, fq = lane >> 4;
    const int K = g.K, nt = K / BK, LD = g.ld ? g.ld : g.K;
    unsigned voffA[2], voffB[2];
#pragma unroll
    for (int i = 0; i < 2; ++i) { int R, C; stage_rc(tid * 16 + i * 8192, R, C); const int Rb = Epi::PERM ? ((R & ~31) + perm32(R & 31)) : R;
        voffA[i] = (unsigned)(R * LD + C) * 2u; voffB[i] = (unsigned)(Rb * LD + C) * 2u; }
    const size_t kstep = (size_t)(BK * 2);
    const size_t hstep = (size_t)HALF * LD * 2;
    const size_t tstep = 2 * hstep;
    const unsigned ldsw = (unsigned)wid * 1024u;
    const int aoff = lds_byte(wr * 64 + fr, fq * 8), boff = lds_byte(wc * 32 + fr, fq * 8);
#define PG8_SA(b, h) (((b) * 2 + (h)) * HTB)
#define PG8_SB(b, h) ((4 + (b) * 2 + (h)) * HTB)
#define PG8_STAGE(bufoff, gbase, voff) do { _Pragma("unroll") for (int _i = 0; _i < 2; ++_i) \
        __builtin_amdgcn_global_load_lds((const unsigned*)((const char*)(gbase) + (voff)[_i]), (PG8_LAS unsigned*)(lds + (bufoff) + ldsw + _i * 8192), 16, 0, 0); } while (0)
#define PG8_LDA(dst, b, h) do { _Pragma("unroll") for (int m = 0; m < 4; ++m) _Pragma("unroll") for (int k = 0; k < 2; ++k) dst[m][k] = *(const PG8_LAS bf16x8*)(lds + PG8_SA(b, h) + aoff + m * 2048 + k * 1024); } while (0)
#define PG8_LDB(dst, b, h) do { _Pragma("unroll") for (int n = 0; n < 2; ++n) _Pragma("unroll") for (int k = 0; k < 2; ++k) dst[n][k] = *(const PG8_LAS bf16x8*)(lds + PG8_SB(b, h) + boff + n * 2048 + k * 1024); } while (0)
#define PG8_MMA(ai, bj, At, Bt) do { __builtin_amdgcn_s_setprio(1); _Pragma("unroll") for (int m = 0; m < 4; ++m) _Pragma("unroll") for (int n = 0; n < 2; ++n) _Pragma("unroll") for (int k = 0; k < 2; ++k) \
        acc[ai][bj][m][n] = __builtin_amdgcn_mfma_f32_16x16x32_bf16(Bt[n][k], At[m][k], acc[ai][bj][m][n], 0, 0, 0); __builtin_amdgcn_s_setprio(0); } while (0)
#define PG8_WAIT_V(n) asm volatile("s_waitcnt vmcnt(" #n ")" ::: "memory")
#define PG8_WAIT_L(n) asm volatile("s_waitcnt lgkmcnt(" #n ")" ::: "memory")
#define PG8_BAR __builtin_amdgcn_s_barrier()
#define PG8_SCHED __builtin_amdgcn_sched_barrier(0)
    Unit cur, nxt; int ui = 0;
    if (!S.next(0, cur)) return;
    f32x4 acc[2][2][4][2];
#pragma unroll
    for (int a = 0; a < 2; ++a)
#pragma unroll
        for (int b = 0; b < 2; ++b)
#pragma unroll
            for (int m = 0; m < 4; ++m)
#pragma unroll
                for (int n = 0; n < 2; ++n) acc[a][b][m][n] = (f32x4){0.f, 0.f, 0.f, 0.f};
    bf16x8 At[4][2], B0[2][2], B1[2][2];
    const char* cA = (const char*)g.A + (size_t)cur.pm * tstep + (size_t)cur.k0 * 2; const char* cB = (const char*)g.Bt + (size_t)cur.pn * tstep + (size_t)cur.k0 * 2;
    S.a_ready(cur);
    if constexpr (SP2) {
        PG8_STAGE(PG8_SB(0, 0), cB, voffB); PG8_STAGE(PG8_SB(0, 1), cB + hstep, voffB); PG8_STAGE(PG8_SA(0, 0), cA, voffA); PG8_STAGE(PG8_SA(0, 1), cA + hstep, voffA);
        if (wr == 1) PG8_BAR;
        PG8_WAIT_V(2); PG8_BAR;
        PG8_STAGE(PG8_SB(1, 0), cB + kstep, voffB); PG8_STAGE(PG8_SA(1, 0), cA + kstep, voffA); PG8_STAGE(PG8_SB(1, 1), cB + hstep + kstep, voffB);
        PG8_WAIT_V(6); PG8_BAR;
    } else {
        PG8_STAGE(PG8_SB(0, 0), cB, voffB); PG8_STAGE(PG8_SA(0, 0), cA, voffA); PG8_STAGE(PG8_SB(0, 1), cB + hstep, voffB); PG8_STAGE(PG8_SA(0, 1), cA + hstep, voffA);
        if (wr == 1) PG8_BAR;
        PG8_WAIT_V(4); PG8_BAR;
        PG8_STAGE(PG8_SB(1, 0), cB + kstep, voffB); PG8_STAGE(PG8_SA(1, 0), cA + kstep, voffA); PG8_STAGE(PG8_SB(1, 1), cB + hstep + kstep, voffB);
        PG8_WAIT_V(6); PG8_BAR;
    }
    for (;;) {
        const bool has_next = S.next(ui + 1, nxt);
        const char* nA = has_next ? (const char*)g.A + (size_t)nxt.pm * tstep + (size_t)nxt.k0 * 2 : cA; const char* nB = has_next ? (const char*)g.Bt + (size_t)nxt.pn * tstep + (size_t)nxt.k0 * 2 : cB;
        for (int t = 0; t < nt; t += 2) {
            const bool last = (t == nt - 2);
            const char* a1 = cA + (size_t)(t + 1) * kstep;
            const char* a2 = last ? nA : cA + (size_t)(t + 2) * kstep; const char* b2 = last ? nB : cB + (size_t)(t + 2) * kstep;
            const char* a3 = a2 + kstep; const char* b3 = b2 + kstep;
            if (last && has_next) S.a_ready(nxt);
            if constexpr (SP2) {
            PG8_LDB(B0, 0, 0); PG8_LDB(B1, 0, 1); PG8_SCHED; PG8_LDA(At, 0, 0); PG8_STAGE(PG8_SA(1, 1), a1 + hstep, voffA);
            PG8_WAIT_V(8); PG8_WAIT_L(0); PG8_BAR; PG8_MMA(0, 0, At, B0); PG8_MMA(0, 1, At, B1); PG8_BAR; PG8_SCHED;
            PG8_LDA(At, 0, 1); PG8_STAGE(PG8_SB(0, 0), b2, voffB); PG8_STAGE(PG8_SB(0, 1), b2 + hstep, voffB); PG8_STAGE(PG8_SA(0, 0), a2, voffA);
            PG8_WAIT_V(8); PG8_WAIT_L(0); PG8_BAR; PG8_MMA(1, 0, At, B0); PG8_MMA(1, 1, At, B1); PG8_BAR; PG8_SCHED;
            PG8_LDB(B0, 1, 0); PG8_LDB(B1, 1, 1); PG8_SCHED; PG8_LDA(At, 1, 0); PG8_STAGE(PG8_SA(0, 1), a2 + hstep, voffA);
            PG8_WAIT_V(8); PG8_WAIT_L(0); PG8_BAR; PG8_MMA(0, 0, At, B0); PG8_MMA(0, 1, At, B1); PG8_BAR; PG8_SCHED;
            PG8_LDA(At, 1, 1); PG8_STAGE(PG8_SB(1, 0), b3, voffB); PG8_STAGE(PG8_SB(1, 1), b3 + hstep, voffB); PG8_STAGE(PG8_SA(1, 0), a3, voffA);
            PG8_WAIT_V(8); PG8_WAIT_L(0); PG8_BAR; PG8_MMA(1, 0, At, B0); PG8_MMA(1, 1, At, B1); PG8_BAR; PG8_SCHED;
            } else {
            PG8_LDB(B0, 0, 0); PG8_SCHED; PG8_LDA(At, 0, 0); PG8_STAGE(PG8_SA(1, 1), a1 + hstep, voffA);
            PG8_WAIT_L(8); PG8_BAR; PG8_WAIT_L(0); PG8_MMA(0, 0, At, B0); PG8_BAR; PG8_SCHED;
            PG8_LDB(B1, 0, 1); PG8_STAGE(PG8_SB(0, 0), b2, voffB);
            PG8_BAR; PG8_WAIT_L(0); PG8_MMA(0, 1, At, B1); PG8_BAR;
            PG8_LDA(At, 0, 1); PG8_STAGE(PG8_SA(0, 0), a2, voffA);
            PG8_BAR; PG8_WAIT_L(0); PG8_MMA(1, 0, At, B0); PG8_BAR; PG8_SCHED;
            PG8_STAGE(PG8_SB(0, 1), b2 + hstep, voffB);
            PG8_WAIT_V(6); PG8_BAR; PG8_MMA(1, 1, At, B1); PG8_BAR;
            PG8_LDB(B0, 1, 0); PG8_SCHED; PG8_LDA(At, 1, 0); PG8_STAGE(PG8_SA(0, 1), a2 + hstep, voffA);
            PG8_WAIT_L(8); PG8_BAR; PG8_WAIT_L(0); PG8_MMA(0, 0, At, B0); PG8_BAR; PG8_SCHED;
            PG8_LDB(B1, 1, 1); PG8_STAGE(PG8_SB(1, 0), b3, voffB);
            PG8_BAR; PG8_WAIT_L(0); PG8_MMA(0, 1, At, B1); PG8_BAR;
            PG8_LDA(At, 1, 1); PG8_STAGE(PG8_SA(1, 0), a3, voffA);
            PG8_BAR; PG8_WAIT_L(0); PG8_MMA(1, 0, At, B0); PG8_BAR; PG8_SCHED;
            PG8_STAGE(PG8_SB(1, 1), b3 + hstep, voffB);
            PG8_WAIT_V(6); PG8_BAR; PG8_MMA(1, 1, At, B1); PG8_BAR;
            }
        }
        if constexpr (ALIGN_EPI) { if (wr == 0) PG8_BAR; }
        if constexpr (!Epi::AFTER_DRAIN) { E(acc, cur, wr, wc, fr, fq); S.done(cur); }
        if (!has_next) break;
#pragma unroll
        for (int a = 0; a < 2; ++a)
#pragma unroll
            for (int b = 0; b < 2; ++b)
#pragma unroll
                for (int m = 0; m < 4; ++m)
#pragma unroll
                    for (int n = 0; n < 2; ++n) acc[a][b][m][n] = (f32x4){0.f, 0.f, 0.f, 0.f};
        cur = nxt; cA = nA; cB = nB; ++ui;
        if constexpr (ALIGN_EPI) { if (wr == 1) PG8_BAR; }
    }
    PG8_WAIT_V(0);
    if constexpr (!ALIGN_EPI) { if (wr == 0) PG8_BAR; }
    PG8_BAR;
    if constexpr (Epi::AFTER_DRAIN) { E.fused(acc, cur, wr, wc, fr, fq, lds, wid, lane); S.done(cur); }
#undef PG8_SA
#undef PG8_SB
#undef PG8_STAGE
#undef PG8_LDA
#undef PG8_LDB
#undef PG8_MMA
#undef PG8_WAIT_V
#undef PG8_WAIT_L
#undef PG8_BAR
#undef PG8_SCHED
}
}

#define GAS __attribute__((address_space(1)))
#define LAS __attribute__((address_space(3)))
typedef unsigned short bf16;
typedef unsigned v4u __attribute__((ext_vector_type(4)));
typedef float f32x4 __attribute__((ext_vector_type(4)));
typedef short bf16x8 __attribute__((ext_vector_type(8)));
typedef GAS unsigned gu32;
typedef GAS unsigned long long gu64;
#define RLX_AGENT __ATOMIC_RELAXED, __HIP_MEMORY_SCOPE_AGENT
#define LDS_WAIT() asm volatile("s_waitcnt lgkmcnt(0)" ::: "memory")
#define VM_WAIT() asm volatile("s_waitcnt vmcnt(0)" ::: "memory")
__device__ __forceinline__ unsigned long long rt() { return __builtin_amdgcn_s_memrealtime(); }
typedef float f32x2_t __attribute__((ext_vector_type(2))); typedef __bf16 bf16x2_t __attribute__((ext_vector_type(2)));
__device__ __forceinline__ unsigned pk2(float lo, float hi) { const f32x2_t v = {lo, hi}; const bf16x2_t b = __builtin_convertvector(v, bf16x2_t); return __builtin_bit_cast(unsigned, b); }
__device__ __forceinline__ unsigned f2bf(float f) { return pk2(f, f) & 0xffffu; }
#define XB_TMO      128
#define XB_XCNT(j)  (256  + 64 * (j))
#define XB_XSUB(j)  (1280 + 64 * (j))
#define XB_XGEN(j)  (2304 + 64 * (j))
#define XB_TOP      3328
#define XB_TOPGEN   3392
#define XCD_BAR_WORDS 3456
#define XB_SPIN_CAP (1u << 18)

__device__ __forceinline__ unsigned xb_ld(unsigned* p)              { return __hip_atomic_load(p, __ATOMIC_RELAXED, __HIP_MEMORY_SCOPE_AGENT); }
__device__ __forceinline__ unsigned xb_add(unsigned* p, unsigned v) { return __hip_atomic_fetch_add(p, v, __ATOMIC_RELAXED, __HIP_MEMORY_SCOPE_AGENT); }
__device__ __forceinline__ unsigned xb_xcc_id() { return (unsigned)__builtin_amdgcn_s_getreg((3 << 11) | 20) & 0xFu; }
#define XB_SPIN(cond, bar) do { unsigned _sp = 0; while (cond) { __builtin_amdgcn_s_sleep(1); \
    if ((++_sp & 255u) == 0u) { if (xb_ld(&(bar)[XB_TMO])) break; if (_sp > XB_SPIN_CAP) { atomicAdd(&(bar)[XB_TMO], 1u); break; } } } } while (0)

struct XcdBarrier {
    unsigned* bar; unsigned x;
    volatile LAS unsigned* st;
};

__device__ __forceinline__ XcdBarrier xcd_barrier_post(unsigned* bar, volatile LAS unsigned* st) {
    XcdBarrier b; b.bar = bar; b.x = xb_xcc_id(); b.st = st;
    if (threadIdx.x == 0) (void)xb_add(&bar[XB_XCNT(b.x)], 1u);
    return b;
}
__device__ __forceinline__ void xcd_barrier_complete(unsigned* bar, unsigned x, unsigned& nloc, unsigned& nx) {
    const unsigned G = gridDim.x * gridDim.y * gridDim.z;
    unsigned sum, cnt, mine, sp = 0u;
    for (;;) {
        sum = 0u; cnt = 0u; mine = 0u;
#pragma unroll
        for (unsigned j = 0; j < 16; ++j) { const unsigned c = xb_ld(&bar[XB_XCNT(j)]); sum += c; cnt += (c > 0u) ? 1u : 0u; mine = (j == x) ? c : mine; }
        if (sum == G) break;
        __builtin_amdgcn_s_sleep(1);
        if ((++sp & 255u) == 0u) { if (xb_ld(&bar[XB_TMO])) break; if (sp > XB_SPIN_CAP) { atomicAdd(&bar[XB_TMO], 1u); break; } }
    }
    nloc = mine > 0u ? mine : 1u; nx = cnt > 0u ? cnt : 1u;
}

__device__ __forceinline__ void xcd_barrier(const XcdBarrier& b) {
    asm volatile("s_waitcnt vmcnt(0)" ::: "memory");
    __syncthreads();
    if (threadIdx.x == 0) {
        unsigned* bar = b.bar;
        __builtin_amdgcn_s_waitcnt(0);
        unsigned nloc = b.st[0], nx = b.st[1];
        if (nloc == 0u) { xcd_barrier_complete(bar, b.x, nloc, nx); b.st[0] = nloc; b.st[1] = nx; }
        const unsigned old = xb_add(&bar[XB_XSUB(b.x)], 1u);
        const unsigned gen = old / nloc;
        if (old + 1u == (gen + 1u) * nloc) {
            __builtin_amdgcn_fence(__ATOMIC_RELEASE, "agent");
            asm volatile("s_waitcnt vmcnt(0)" ::: "memory");
            const unsigned og = xb_add(&bar[XB_TOP], 1u);
            const unsigned tg = og / nx;
            if (og + 1u == (tg + 1u) * nx) xb_add(&bar[XB_TOPGEN], 1u);
            else XB_SPIN(xb_ld(&bar[XB_TOPGEN]) == tg, bar);
            __builtin_amdgcn_fence(__ATOMIC_ACQUIRE, "agent");
            xb_add(&bar[XB_XGEN(b.x)], 1u);
            asm volatile("s_waitcnt vmcnt(0)" ::: "memory");
        } else {
            XB_SPIN(xb_ld(&bar[XB_XGEN(b.x)]) == gen, bar);
            __builtin_amdgcn_fence(__ATOMIC_ACQUIRE, "agent");
            asm volatile("s_waitcnt vmcnt(0)" ::: "memory");
        }
    }
    __syncthreads();
}


constexpr int NWAVES = 8, NTHR = 512;
constexpr int D = 1024, NB = 8, SEQ = 2048, CTXL = 256;
constexpr int M_CTX = NB * CTXL, M_LAT = NB * SEQ, M_ALL = M_CTX + M_LAT;
constexpr int RWC = 1760, MIXIN = 3312, ZLD = 3328, FF = 2816, NE = 8;
constexpr int PRV = 9 * 512;
constexpr int MOE_ROWS = 34816;
constexpr size_t MiB = 1u << 20;
constexpr size_t WS_CTL = 0, CTL_ZERO_BYTES = 1 * MiB;
constexpr size_t WS_MODS = 1 * MiB;
constexpr size_t WS_TOK = 1 * MiB + 512 * 1024;
constexpr size_t WS_WIN_T = 2 * MiB;
constexpr size_t WS_WOUT_T = WS_WIN_T + (size_t)ZLD * D * 2;
constexpr size_t WS_W13_T = WS_WOUT_T + 2 * MiB;
constexpr size_t WS_W2_T = WS_W13_T + 11 * MiB;
constexpr size_t WS_QKV_T = WS_W2_T + (size_t)D * FF * 2;
constexpr size_t WS_NAO_T = WS_QKV_T + 6 * MiB;
constexpr size_t WS_HCTX = 35 * MiB;
constexpr size_t WS_A = 43 * MiB;
constexpr size_t WS_R = 79 * MiB;
constexpr size_t WS_Z = WS_R;
constexpr size_t WS_PR = 196 * MiB;
constexpr size_t WS_PM = 358 * MiB;
constexpr size_t WS_DT = 394 * MiB;
constexpr size_t WS_BONUS = 395 * MiB + 256 * 1024;
constexpr size_t WS_GATE = 396 * MiB;
constexpr size_t WS_ZG = 414 * MiB;
constexpr size_t WS_YRW = WS_R;
constexpr size_t WS_YMB = WS_R + 36 * MiB;
constexpr size_t WS_HID = WS_R;
constexpr size_t WS_MOEW13 = 316 * MiB;
constexpr size_t WS_MOEW2 = 404 * MiB;
constexpr size_t WS_Q = WS_R, WS_K = WS_R + 36 * MiB, WS_V = WS_R + 72 * MiB;
constexpr size_t WS_O = WS_R + 108 * MiB;
constexpr size_t WS_A4 = 111 * MiB;
constexpr size_t WS_XG = 43 * MiB;
constexpr size_t WS_HIDG = 111 * MiB;
constexpr size_t WS_YG = 43 * MiB;
constexpr size_t WS_SLAB6 = WS_R;
constexpr size_t WS_SLAB9 = WS_R + 99 * MiB;
constexpr size_t WS_TAIL = 316 * MiB;
constexpr size_t WS_A2 = 196 * MiB;
constexpr size_t WS_XBUF = 300 * MiB;
constexpr size_t WS_PLOG = 301 * MiB;
constexpr size_t WS_END = 448 * MiB;
static_assert(WS_NAO_T + 2 * MiB <= WS_HCTX && WS_ZG + 18 * MiB <= WS_END && WS_MOEW2 + 44 * MiB <= WS_END && WS_HIDG + (size_t)MOE_ROWS * FF * 2 <= WS_MOEW13, "ws map");
static_assert(WS_Z + (size_t)M_ALL * ZLD * 2 <= WS_PR && WS_PR + (size_t)M_ALL * PRV * 2 <= WS_PM && WS_XG + (size_t)MOE_ROWS * D * 2 <= WS_HIDG, "ws map 2");
constexpr int CW_TMO = 0, CW_CODE = 1, CW_BAR = 4096, CW_CNT = 8192, CW_CNTB = 16384, CW_XCNT = 131072;
constexpr int RING_BYTES = 131072, LDSCTL_OFF = 145408, MISC_OFF = LDSCTL_OFF + 320, LDS_BYTES = 147456;

typedef unsigned v2u __attribute__((ext_vector_type(2)));
typedef float v2f __attribute__((ext_vector_type(2)));
typedef short s16x4 __attribute__((ext_vector_type(4)));
typedef short v4i16_t __attribute__((ext_vector_type(4)));
__device__ __forceinline__ float bflo(unsigned u) { return __uint_as_float(u << 16); }
__device__ __forceinline__ float bfhi(unsigned u) { return __uint_as_float(u & 0xffff0000u); }
__device__ __forceinline__ float ldbf(const bf16* p) { return __uint_as_float((unsigned)(*p) << 16); }
__device__ __forceinline__ float sigm(float x) { return __builtin_amdgcn_rcpf(1.f + __expf(-x)); }
__device__ __forceinline__ bf16x8 pack8(const f32x4& a, const f32x4& b) {
    v4u w; w.x = pk2(a[0], a[1]); w.y = pk2(a[2], a[3]); w.z = pk2(b[0], b[1]); w.w = pk2(b[2], b[3]); return __builtin_bit_cast(bf16x8, w);
}
template <int CTRL> __device__ __forceinline__ float dppf(float x) { return __int_as_float(__builtin_amdgcn_update_dpp(0, __float_as_int(x), CTRL, 0xF, 0xF, true)); }
__device__ __forceinline__ float sum8(float x) { x += dppf<0xB1>(x); x += dppf<0x4E>(x); x += dppf<0x141>(x); return x; }
__device__ __forceinline__ float sum16(float x) { x = sum8(x); x += dppf<0x140>(x); return x; }
__device__ __forceinline__ float rlf(float v, int l) { return __int_as_float(__builtin_amdgcn_readlane(__float_as_int(v), l)); }
__device__ __forceinline__ float wave_sum(float v) { v = sum16(v); return (rlf(v, 0) + rlf(v, 16)) + (rlf(v, 32) + rlf(v, 48)); }
__device__ __forceinline__ float half_sum(float v, int lane) { v = sum16(v); const float lo = rlf(v, 0) + rlf(v, 16), hi = rlf(v, 32) + rlf(v, 48); return lane < 32 ? lo : hi; }

struct Frame {
    LAS unsigned char* lds;
    volatile LAS unsigned* MISC;
    gu32* ctl;
    int tid, lane, wave, G, bid;
};

__device__ __forceinline__ void tr_item(const float* W, int K, int N, bf16* WT, int drow0, int k0, int n0, LAS float* scr, int lane) {
    const int nn = n0 + (lane & 31);
    float t[32];
#pragma unroll
    for (int i = 0; i < 32; ++i) { const int kk = 2 * i + (lane >> 5); t[i] = (nn < N) ? W[(size_t)(k0 + kk) * N + nn] : 0.f; }
#pragma unroll
    for (int i = 0; i < 32; ++i) { const int kk = 2 * i + (lane >> 5); scr[kk * 33 + (lane & 31)] = t[i]; }
    LDS_WAIT(); asm volatile("" ::: "memory");
    const int c = lane & 7;
#pragma unroll
    for (int j = 0; j < 4; ++j) { const int n = (lane >> 3) + 8 * j; const LAS float* s = scr + (8 * c) * 33 + n;
        v4u o; o.x = pk2(s[0 * 33], s[1 * 33]); o.y = pk2(s[2 * 33], s[3 * 33]); o.z = pk2(s[4 * 33], s[5 * 33]); o.w = pk2(s[6 * 33], s[7 * 33]);
        *(GAS v4u*)(WT + (size_t)(drow0 + n) * K + k0 + 8 * c) = o; }
    LDS_WAIT(); asm volatile("" ::: "memory");
}
template <int MODE  >
__device__ __forceinline__ bool tr_matrix(int& it, const float* W, int K, int N, bf16* WT, LAS float* scr, int lane) {
    const int nblk = (N + 31) / 32, items = (K / 64) * nblk;
    if (it >= items) { it -= items; return false; }
    const int kb = it / nblk, nb = it % nblk, n0 = nb * 32;
    int drow0 = n0;
    if (MODE == 1) drow0 = (n0 >> 7) * 256 + (n0 & 127);
    if (MODE == 2) drow0 = (n0 >> 7) * 256 + 128 + (n0 & 127);
    tr_item(W, K, N, WT, drow0, kb * 64, n0, scr, lane);
    return true;
}

__device__ __forceinline__ void p0_phase(Frame& F, const float* c, const float* c_ctx, const float* w_ada, const float* b_ada, float* mods,
                                         const float* mix_w_in, const float* mix_w_out, const float* ffn_w1, const float* ffn_w3, const float* ffn_w2,
                                         const float* na_w_qkv, const float* na_w_out, unsigned char* ws) {
    for (int u = F.bid; u < 192; u += F.G) {
        LAS float* sc = (LAS float*)(F.lds);
        LAS float* red = (LAS float*)(F.lds + 36864);
        for (int i = F.tid; i < 9 * 1024; i += NTHR) { const int b = i >> 10, k = i & 1023; const float v = (b < 8) ? c[b * 1024 + k] : c_ctx[k]; sc[i] = v / (1.f + __expf(-v)); }
        __syncthreads();
        const int layer = u / 96, col = (u % 96) * 64 + F.lane;
        const float* W = w_ada + (size_t)layer * 1024 * 6144 + col;
        float acc[9];
#pragma unroll
        for (int b = 0; b < 9; ++b) acc[b] = 0.f;
        const int k0 = F.wave * 128;
#pragma unroll 8
        for (int k = 0; k < 128; ++k) { const float w = W[(size_t)(k0 + k) * 6144];
#pragma unroll
            for (int b = 0; b < 9; ++b) acc[b] += sc[b * 1024 + k0 + k] * w; }
#pragma unroll
        for (int b = 0; b < 9; ++b) red[(F.wave * 9 + b) * 64 + F.lane] = acc[b];
        __syncthreads();
        if (F.wave == 0) {
#pragma unroll
            for (int b = 0; b < 9; ++b) { float s = 0.f;
#pragma unroll
                for (int w = 0; w < 8; ++w) s += red[(w * 9 + b) * 64 + F.lane];
                mods[(layer * 9 + b) * 6144 + col] = s + b_ada[layer * 6144 + col]; }
        }
        __syncthreads();
    }
    LAS float* scr = (LAS float*)(F.lds + 57344 + F.wave * 8704);
    const int gw = F.bid * NWAVES + F.wave, NGW = F.G * NWAVES;
    constexpr int NITEMS = 16 * 104 + 512 + 1408 * 3 + 1536 + 512;
    for (int it0 = gw; it0 < NITEMS; it0 += NGW) {
        int it = it0;
        if (tr_matrix<0>(it, mix_w_in, 1024, MIXIN, (bf16*)(ws + WS_WIN_T), scr, F.lane)) continue;
        if (tr_matrix<0>(it, mix_w_out, 1024, 1024, (bf16*)(ws + WS_WOUT_T), scr, F.lane)) continue;
        if (tr_matrix<1>(it, ffn_w1, 1024, FF, (bf16*)(ws + WS_W13_T), scr, F.lane)) continue;
        if (tr_matrix<2>(it, ffn_w3, 1024, FF, (bf16*)(ws + WS_W13_T), scr, F.lane)) continue;
        if (tr_matrix<0>(it, ffn_w2, FF, 1024, (bf16*)(ws + WS_W2_T), scr, F.lane)) continue;
        if (tr_matrix<0>(it, na_w_qkv, 1024, 3072, (bf16*)(ws + WS_QKV_T), scr, F.lane)) continue;
        tr_matrix<0>(it, na_w_out, 1024, 1024, (bf16*)(ws + WS_NAO_T), scr, F.lane);
    }
}
constexpr int MOE_ITEMS = NE * 1408 * 3, MOE_W13_ITEMS = NE * 2816, MOE_ITEMS_P6 = 0, MOE_ITEMS_P8 = 10240, MOE_ITEMS_P9 = 16384, MOE_ITEMS_P11 = 0, MOE_ITEMS_P16 = 7168, MOE_ITEMS_P7 = MOE_ITEMS - MOE_ITEMS_P8 - MOE_ITEMS_P9 - MOE_ITEMS_P11 - MOE_ITEMS_P16;
static_assert(MOE_ITEMS - MOE_ITEMS_P16 >= MOE_W13_ITEMS, "the items left for P16's idle workgroups must all be w2 items (the w1|w3 copies are read by P16 itself)");
__device__ __forceinline__ void moe_weight_phase(Frame& F, const float* w1, const float* w3, const float* w2, unsigned char* ws, int lo, int hi, int widx, int nw) {
    LAS float* scr = (LAS float*)(F.lds + 57344 + F.wave * 8704);
    const int gw = widx * NWAVES + F.wave, NGW = nw * NWAVES;
    for (int it0 = lo + gw; it0 < hi; it0 += NGW) {
        const bool isw2 = it0 >= MOE_W13_ITEMS; const int e = isw2 ? (it0 - MOE_W13_ITEMS) / 1408 : it0 / 2816; int it = isw2 ? 2816 + (it0 - MOE_W13_ITEMS) % 1408 : it0 % 2816;
        bf16* w13t = (bf16*)(ws + WS_MOEW13) + (size_t)e * 5632 * 1024; bf16* w2t = (bf16*)(ws + WS_MOEW2) + (size_t)e * 1024 * FF;
        if (tr_matrix<1>(it, w1 + (size_t)e * 1024 * FF, 1024, FF, w13t, scr, F.lane)) continue;
        if (tr_matrix<2>(it, w3 + (size_t)e * 1024 * FF, 1024, FF, w13t, scr, F.lane)) continue;
        tr_matrix<0>(it, w2 + (size_t)e * 1024 * FF, FF, 1024, w2t, scr, F.lane);
    }
}

struct RowIn { f32x4 x[4], sh[4], sc[4]; };
__device__ __forceinline__ void row_fetch(RowIn& R, const float* xrow, const float* sh, const float* sc, int lane) {
#pragma unroll
    for (int j = 0; j < 4; ++j) { R.x[j] = ((const GAS f32x4*)xrow)[lane + 64 * j]; R.sh[j] = ((const GAS f32x4*)sh)[lane + 64 * j]; R.sc[j] = ((const GAS f32x4*)sc)[lane + 64 * j]; }
}
__device__ __forceinline__ void row_finish(const RowIn& R, const f32x4 (&gg)[4], bf16* orow, int lane, f32x4 (&a)[4], const float* slab = nullptr, int nslab = 0, float* wb = nullptr) {
    float ss = 0.f;
#pragma unroll
    for (int j = 0; j < 4; ++j) a[j] = R.x[j];
    for (int s = 0; s < nslab; ++s) { const GAS f32x4* sr = (const GAS f32x4*)(slab + (size_t)s * (2048 * 1024)) + lane;
#pragma unroll
        for (int j = 0; j < 4; ++j) a[j] += sr[64 * j]; }
    if (wb) { GAS f32x4* w4 = (GAS f32x4*)wb + lane;
#pragma unroll
        for (int j = 0; j < 4; ++j) w4[64 * j] = a[j]; }
#pragma unroll
    for (int j = 0; j < 4; ++j) ss += (a[j].x * a[j].x + a[j].y * a[j].y) + (a[j].z * a[j].z + a[j].w * a[j].w);
    const float rs = rsqrtf(wave_sum(ss) * (1.f / 1024.f) + 1e-6f);
    GAS unsigned long long* o8 = (GAS unsigned long long*)orow + lane;
#pragma unroll
    for (int j = 0; j < 4; ++j) {
        a[j] = (a[j] * rs) * gg[j] * (R.sc[j] + 1.f) + R.sh[j];
        o8[64 * j] = (unsigned long long)pk2(a[j].x, a[j].y) | ((unsigned long long)pk2(a[j].z, a[j].w) << 32);
    }
}
__device__ __forceinline__ void normmod_phase(Frame& F, const float* src_ctx, const float* src_lat, const float* g, const float* mods_l, int off_shift, int off_scale, bf16* dst, const float* slab = nullptr, int nslab = 0, float* wb_ctx = nullptr, int m_end = M_ALL) {
    const int gw = F.bid * NWAVES + F.wave, NGW = F.G * NWAVES;
    f32x4 gg[4];
#pragma unroll
    for (int j = 0; j < 4; ++j) gg[j] = ((const GAS f32x4*)g)[F.lane + 64 * j];
    RowIn cur, nxt;
    int r = gw; bool have = r < m_end;
#define NM_FETCH(R_, r_) do { const bool ic_ = (r_) < M_CTX; const int rl_ = ic_ ? (r_) : (r_) - M_CTX; const float* mp_ = mods_l + (ic_ ? 8 : (rl_ >> 11)) * 6144; \
        row_fetch(R_, (ic_ ? src_ctx : src_lat) + (size_t)rl_ * D, mp_ + off_shift, mp_ + off_scale, F.lane); } while (0)
    if (have) NM_FETCH(cur, r);
    while (have) {
        const int rn = r + NGW; const bool hn = rn < m_end;
        if (hn) NM_FETCH(nxt, rn);
        const bool isctx = r < M_CTX; const int rl = isctx ? r : r - M_CTX;
        f32x4 a[4];
        if (isctx) row_finish(cur, gg, dst + (size_t)r * D, F.lane, a, slab ? slab + (size_t)rl * D : nullptr, nslab, wb_ctx ? wb_ctx + (size_t)rl * D : nullptr);
        else row_finish(cur, gg, dst + (size_t)r * D, F.lane, a);
        cur = nxt; r = rn; have = hn;
    }
#undef NM_FETCH
}

namespace pg8 {
struct EpiResGate {
    static constexpr bool PERM = false, AFTER_DRAIN = false;
    const float* base_c; const float* base_l; float* out_c; float* out_l; const float* mods_l; int gate_off; int ctx_tiles;
    __device__ __forceinline__ void operator()(const f32x4 (&acc)[2][2][4][2], const Unit& u, int wr, int wc, int fr, int fq) const {
        const bool isctx = u.pm < ctx_tiles; const int rt = isctx ? u.pm : u.pm - ctx_tiles; const int mi = isctx ? 8 : (rt >> 3);
        const float* base = isctx ? base_c : base_l; float* out = isctx ? out_c : out_l;
        const int col0 = u.pn * BM + wc * 32 + 4 * fq; const float* gp = mods_l + mi * 6144 + gate_off + col0;
        f32x4 gv[2][2];
#pragma unroll
        for (int bj = 0; bj < 2; ++bj)
#pragma unroll
            for (int n = 0; n < 2; ++n) gv[bj][n] = *(const f32x4*)(gp + bj * HALF + n * 16);
#pragma unroll
        for (int ai = 0; ai < 2; ++ai)
#pragma unroll
            for (int m = 0; m < 4; ++m) { const size_t off = (size_t)(rt * BM + ai * HALF + wr * 64 + m * 16 + fr) * 1024 + col0;
#pragma unroll
                for (int bj = 0; bj < 2; ++bj)
#pragma unroll
                    for (int n = 0; n < 2; ++n) { const f32x4 b = *(const f32x4*)(base + off + bj * HALF + n * 16); *(f32x4*)(out + off + bj * HALF + n * 16) = b + gv[bj][n] * acc[ai][bj][m][n]; } }
    }
};
template <bool ROUTER> struct EpiResGateNormT {
    static constexpr bool PERM = false, AFTER_DRAIN = true;
    const float* base; float* out; const float* mods_l; int gate_off;
    const float* g; int off_shift, off_scale; bf16_t* dst;
    float* xbuf; unsigned* cnt;
    const float* rw; float* plog;
    __device__ __forceinline__ void operator()(const f32x4 (&)[2][2][4][2], const Unit&, int, int, int, int) const {}
    __device__ __forceinline__ void fused(f32x4 (&acc)[2][2][4][2], const Unit& u, int wr, int wc, int fr, int fq, PG8_LAS unsigned char* lds, int wid, int lane) const {
        PG8_LAS float* P = (PG8_LAS float*)lds;
        PG8_LAS float* S = (PG8_LAS float*)(lds + 4096);
        const int rt = u.pm, col0 = u.pn * BM + wc * 32 + 4 * fq; const float* mp = mods_l + (rt >> 3) * 6144 + col0;
        const unsigned r0 = (unsigned)((rt * BM + wr * 64 + fr) * 1024 + col0) * 4u;
        unsigned rb = r0; constexpr int NB = ROUTER ? 8 : 12;
#define ERN_IDX(i) const int bj_ = (i) >> 4, n_ = ((i) >> 3) & 1, ai_ = ((i) >> 2) & 1, m_ = (i) & 3
#pragma unroll
        for (int b0 = 0; b0 < 32; b0 += NB) { f32x4 bv[NB];
            if (b0) {
#pragma unroll
                for (int i = b0 - NB; i < b0; ++i) { ERN_IDX(i); asm volatile("" : "+v"(rb) : "v"(acc[ai_][bj_][m_][n_][3])); } }
#pragma unroll
            for (int i = b0; i < b0 + NB && i < 32; ++i) { ERN_IDX(i); bv[i - b0] = *(const f32x4*)((const char*)base + (rb + (unsigned)(((ai_ * HALF + m_ * 16) * 1024 + bj_ * HALF + n_ * 16) * 4))); }
#pragma unroll
            for (int i = b0; i < b0 + NB && i < 32; ++i) { ERN_IDX(i); const f32x4 gv = *(const f32x4*)(mp + gate_off + bj_ * HALF + n_ * 16); acc[ai_][bj_][m_][n_] = bv[i - b0] + gv * acc[ai_][bj_][m_][n_]; } }
#undef ERN_IDX
#pragma unroll
        for (int ai = 0; ai < 2; ++ai)
#pragma unroll
            for (int m = 0; m < 4; ++m) { float s = 0.f;
#pragma unroll
                for (int bj = 0; bj < 2; ++bj)
#pragma unroll
                    for (int n = 0; n < 2; ++n) { const f32x4 x = acc[ai][bj][m][n]; s += (x[0] * x[0] + x[1] * x[1]) + (x[2] * x[2] + x[3] * x[3]); }
                s += __shfl_xor(s, 16); s += __shfl_xor(s, 32);
                if (fq == 0) P[(ai * HALF + wr * 64 + m * 16 + fr) * 4 + wc] = s; }
        asm volatile("s_waitcnt lgkmcnt(0)" ::: "memory"); __builtin_amdgcn_s_barrier(); asm volatile("" ::: "memory");
        const int row = wid * 32 + (lane & 31);
        if (lane < 32) { const float t = (P[row * 4 + 0] + P[row * 4 + 1]) + (P[row * 4 + 2] + P[row * 4 + 3]);
            __hip_atomic_store(xbuf + (size_t)(rt * BM + row) * 4 + u.pn, t, __ATOMIC_RELAXED, __HIP_MEMORY_SCOPE_AGENT); }
        asm volatile("s_waitcnt vmcnt(0)" ::: "memory");
        if (lane == 0) __hip_atomic_fetch_add(cnt + 64 * rt, 1u, __ATOMIC_RELAXED, __HIP_MEMORY_SCOPE_AGENT);
#pragma unroll
        for (int ai = 0; ai < 2; ++ai)
#pragma unroll
            for (int m = 0; m < 4; ++m)
#pragma unroll
                for (int bj = 0; bj < 2; ++bj)
#pragma unroll
                    for (int n = 0; n < 2; ++n) *(f32x4*)((char*)out + (r0 + (unsigned)(((ai * HALF + m * 16) * 1024 + bj * HALF + n * 16) * 4))) = acc[ai][bj][m][n];
        if (wid == 0) {
            while ((unsigned)__builtin_amdgcn_readfirstlane(__hip_atomic_load(cnt + 64 * rt, __ATOMIC_RELAXED, __HIP_MEMORY_SCOPE_AGENT)) < 32u) __builtin_amdgcn_s_sleep(2);
            __builtin_amdgcn_fence(__ATOMIC_ACQUIRE, "agent");
        }
        asm volatile("s_waitcnt lgkmcnt(0)" ::: "memory"); __builtin_amdgcn_s_barrier(); asm volatile("" ::: "memory");
        if (lane < 32) { const float* sl = xbuf + (size_t)(rt * BM + row) * 4;
            const float t = (__hip_atomic_load(sl + 0, __ATOMIC_RELAXED, __HIP_MEMORY_SCOPE_AGENT) + __hip_atomic_load(sl + 1, __ATOMIC_RELAXED, __HIP_MEMORY_SCOPE_AGENT))
                          + (__hip_atomic_load(sl + 2, __ATOMIC_RELAXED, __HIP_MEMORY_SCOPE_AGENT) + __hip_atomic_load(sl + 3, __ATOMIC_RELAXED, __HIP_MEMORY_SCOPE_AGENT));
            S[row] = rsqrtf(t * (1.f / 1024.f) + 1e-6f); }
        asm volatile("s_waitcnt vmcnt(0) lgkmcnt(0)" ::: "memory"); __builtin_amdgcn_s_barrier(); asm volatile("" ::: "memory");
        float rs[2][4]; int fr2; asm volatile("v_mbcnt_lo_u32_b32 %0, -1, 0\n\tv_mbcnt_hi_u32_b32 %0, -1, %0" : "=v"(fr2)); fr2 &= 15;
#pragma unroll
        for (int ai = 0; ai < 2; ++ai)
#pragma unroll
            for (int m = 0; m < 4; ++m) rs[ai][m] = S[ai * HALF + wr * 64 + m * 16 + fr2];
        asm volatile("s_waitcnt lgkmcnt(0)" ::: "memory"); __builtin_amdgcn_s_barrier(); asm volatile("" ::: "memory");
        f32x4 dl[2][4];
        if constexpr (ROUTER) {
#pragma unroll
            for (int ai = 0; ai < 2; ++ai)
#pragma unroll
                for (int m = 0; m < 4; ++m) dl[ai][m] = (f32x4){0.f, 0.f, 0.f, 0.f}; }
#pragma unroll
        for (int bj = 0; bj < 2; ++bj)
#pragma unroll
            for (int n = 0; n < 2; ++n) { const int c = bj * HALF + n * 16;
                const f32x4 gg = *(const f32x4*)(g + col0 + c), sc = *(const f32x4*)(mp + off_scale + c) + 1.f, sh = *(const f32x4*)(mp + off_shift + c);
                float wa[4];
                if constexpr (ROUTER) {
#pragma unroll
                    for (int x = 0; x < 4; ++x) wa[x] = (fr2 < 8) ? rw[(col0 + c + x) * 8 + fr2] : 0.f; }
#pragma unroll
                for (int ai = 0; ai < 2; ++ai)
#pragma unroll
                    for (int m = 0; m < 4; ++m) { const f32x4 v = ((acc[ai][bj][m][n] * rs[ai][m]) * gg) * sc + sh;
                        *(unsigned long long*)((char*)dst + ((r0 >> 1) + (unsigned)(((ai * HALF + m * 16) * 1024 + c) * 2))) = (unsigned long long)cvt_pk_bf16(v[0], v[1]) | ((unsigned long long)cvt_pk_bf16(v[2], v[3]) << 32);
                        if constexpr (ROUTER) {
#pragma unroll
                            for (int x = 0; x < 4; ++x) dl[ai][m] = __builtin_amdgcn_mfma_f32_16x16x4f32(wa[x], v[x], dl[ai][m], 0, 0, 0); } } }
        if constexpr (ROUTER) {
            PG8_LAS float* T = (PG8_LAS float*)lds;
            if (fq < 2) {
#pragma unroll
                for (int ai = 0; ai < 2; ++ai)
#pragma unroll
                    for (int m = 0; m < 4; ++m)
#pragma unroll
                        for (int x = 0; x < 4; ++x) T[(ai * HALF + wr * 64 + m * 16 + fr2) * 32 + (4 * fq + x) * 4 + wc] = dl[ai][m][x]; }
            asm volatile("s_waitcnt lgkmcnt(0)" ::: "memory"); __builtin_amdgcn_s_barrier(); asm volatile("" ::: "memory");
            const int t = wid * 64 + lane, trow = t >> 1, th = t & 1; f32x4 sum;
#pragma unroll
            for (int x = 0; x < 4; ++x) { const f32x4 q = *(const PG8_LAS f32x4*)(T + trow * 32 + (4 * th + x) * 4); sum[x] = (q[0] + q[1]) + (q[2] + q[3]); }
            *(f32x4*)(plog + ((size_t)(rt * BM + trow) * 4 + u.pn) * 8 + 4 * th) = sum;
        }
    }
};
typedef EpiResGateNormT<false> EpiResGateNorm;
struct EpiSwiGLU {
    static constexpr bool PERM = true, AFTER_DRAIN = false;
    bf16_t* O; int ldo; int nt_mod;
    __device__ __forceinline__ void operator()(const f32x4 (&acc)[2][2][4][2], const Unit& u, int wr, int wc, int fr, int fq) const {
        const int pnl = u.pn % nt_mod; const int row0 = u.pm * BM + wr * 64 + fr, col0 = pnl * HALF + wc * 32 + 8 * fq;
#pragma unroll
        for (int ai = 0; ai < 2; ++ai)
#pragma unroll
            for (int m = 0; m < 4; ++m) { bf16_t* rowp = O + (size_t)(row0 + ai * HALF + m * 16) * ldo + col0;
                float h[8];
#pragma unroll
                for (int n = 0; n < 2; ++n)
#pragma unroll
                    for (int e = 0; e < 4; ++e) { const float a = acc[ai][0][m][n][e], b = acc[ai][1][m][n][e]; h[n * 4 + e] = a * b * __builtin_amdgcn_rcpf(1.f + __expf(-a)); }
                u32x4 w; w.x = cvt_pk_bf16(h[0], h[1]); w.y = cvt_pk_bf16(h[2], h[3]); w.z = cvt_pk_bf16(h[4], h[5]); w.w = cvt_pk_bf16(h[6], h[7]);
                PG8_ST16(O, rowp, w); }
    }
};
struct EpiPlainMod {
    static constexpr bool PERM = true, AFTER_DRAIN = false;
    bf16_t* O; int ldo; int nt_mod;
    __device__ __forceinline__ void operator()(const f32x4 (&acc)[2][2][4][2], const Unit& u, int wr, int wc, int fr, int fq) const {
        const int pnl = u.pn % nt_mod; const int row0 = u.pm * BM + wr * 64 + fr, col0 = pnl * BM + wc * 32 + 8 * fq;
#pragma unroll
        for (int ai = 0; ai < 2; ++ai)
#pragma unroll
            for (int m = 0; m < 4; ++m) { bf16_t* rowp = O + (size_t)(row0 + ai * HALF + m * 16) * ldo + col0;
#pragma unroll
                for (int bj = 0; bj < 2; ++bj) { const f32x4 v0 = acc[ai][bj][m][0], v1 = acc[ai][bj][m][1];
                    u32x4 w; w.x = cvt_pk_bf16(v0[0], v0[1]); w.y = cvt_pk_bf16(v0[2], v0[3]); w.z = cvt_pk_bf16(v1[0], v1[1]); w.w = cvt_pk_bf16(v1[2], v1[3]);
                    PG8_ST16(O, rowp + bj * HALF, w); } }
    }
};
struct SplitKOrder {
    int ntm, nN, ns, kslice, G, c;
    __device__ __forceinline__ bool next(int i, Unit& u) const {
        const int L = i * G + c; if (L >= ntm * nN * ns) return false;
        const int ks = L % ns, t = L / ns; u.pn = t % nN; u.pm = t / nN; u.k0 = ks * kslice; return true;
    }
    __device__ __forceinline__ void a_ready(const Unit&) const {}
    __device__ __forceinline__ void done(const Unit&) const {}
};
struct EpiSlabGate {
    static constexpr bool PERM = false, AFTER_DRAIN = false;
    float* slab; const float* gate; int kslice;
    __device__ __forceinline__ void operator()(const f32x4 (&acc)[2][2][4][2], const Unit& u, int wr, int wc, int fr, int fq) const {
        const int col0 = u.pn * BM + wc * 32 + 4 * fq; float* out = slab + (size_t)(u.k0 / kslice) * (2048 * 1024);
        f32x4 gv[2][2];
#pragma unroll
        for (int bj = 0; bj < 2; ++bj)
#pragma unroll
            for (int n = 0; n < 2; ++n) gv[bj][n] = *(const f32x4*)(gate + col0 + bj * HALF + n * 16);
#pragma unroll
        for (int ai = 0; ai < 2; ++ai)
#pragma unroll
            for (int m = 0; m < 4; ++m) { float* op = out + (size_t)(u.pm * BM + ai * HALF + wr * 64 + m * 16 + fr) * 1024 + col0;
#pragma unroll
                for (int bj = 0; bj < 2; ++bj)
#pragma unroll
                    for (int n = 0; n < 2; ++n) *(f32x4*)(op + bj * HALF + n * 16) = gv[bj][n] * acc[ai][bj][m][n]; }
    }
};
struct MoeOrder {
    int tb[9]; int ntn, G, c; int limit = 0x7fffffff;
    __device__ __forceinline__ bool next(int i, Unit& u) const {
        const int L = i * G + c; if (L >= tb[8] * ntn || L >= limit) return false;
        const int mt = L / ntn, pn = L % ntn; int e = 0;
#pragma unroll
        for (int k = 1; k < 8; ++k) e += (mt >= tb[k]) ? 1 : 0;
        u.pm = mt; u.pn = e * ntn + pn; return true;
    }
    __device__ __forceinline__ void a_ready(const Unit&) const {}
    __device__ __forceinline__ void done(const Unit&) const {}
};
struct MoeTailOrder {
    int tb[9]; int first, ntail, G, c;
    __device__ __forceinline__ bool next(int i, Unit& u) const {
        const int L = i * G + c; if (L >= ntail * 11) return false;
        const int tu = L / 11, ks = L % 11, gu = first + tu, mt = gu >> 2, pn = gu & 3; int e = 0;
#pragma unroll
        for (int k = 1; k < 8; ++k) e += (mt >= tb[k]) ? 1 : 0;
        u.pm = mt; u.pn = e * 4 + pn; u.k0 = ks * 256; return true;
    }
    __device__ __forceinline__ void a_ready(const Unit&) const {}
    __device__ __forceinline__ void done(const Unit&) const {}
};
struct EpiTailSlab {
    static constexpr bool PERM = false, AFTER_DRAIN = false;
    float* slab; int first, ntail;
    __device__ __forceinline__ void operator()(const f32x4 (&acc)[2][2][4][2], const Unit& u, int wr, int wc, int fr, int fq) const {
        const int col0 = (u.pn & 3) * BM + wc * 32 + 4 * fq; float* out = slab + (size_t)(u.k0 >> 8) * ((size_t)(ntail >> 2) * 256 * 1024);
        const int rt = u.pm - (first >> 2);
#pragma unroll
        for (int ai = 0; ai < 2; ++ai)
#pragma unroll
            for (int m = 0; m < 4; ++m) { float* op = out + (size_t)(rt * BM + ai * HALF + wr * 64 + m * 16 + fr) * 1024 + col0;
#pragma unroll
                for (int bj = 0; bj < 2; ++bj)
#pragma unroll
                    for (int n = 0; n < 2; ++n) *(f32x4*)(op + bj * HALF + n * 16) = acc[ai][bj][m][n]; }
    }
};
}

struct PrepIn { const float *rw_mu, *rw_w0, *rw_w_up, *rw_a0, *rw_a_up, *rw_g_up, *rw_k_k, *rw_k_a, *rw_r_k, *conv_w, *conv_b, *dt_bias; };
__device__ __forceinline__ bf16x8 gather8(const float* p, int stride) {
    v4u w; w.x = pk2(p[0], p[stride]); w.y = pk2(p[2 * stride], p[3 * stride]); w.z = pk2(p[4 * stride], p[5 * stride]); w.w = pk2(p[6 * stride], p[7 * stride]); return __builtin_bit_cast(bf16x8, w);
}
constexpr int ACT_ST = 464;
__device__ __forceinline__ void prepare_phase(Frame& F, const PrepIn& P, const bf16* Z, bf16* PR, bf16* PM, float* DT, float* BONUS, bf16* GATE, bf16* ZG) {
    LAS unsigned short* zs = (LAS unsigned short*)F.lds;
    LAS unsigned char* actb = F.lds + 24576;
    LAS float* cst = (LAS float*)(F.lds + 24576 + 16 * ACT_ST);
    const int tid = F.tid, lane = F.lane, fr = lane & 15, fq = lane >> 4, w = F.wave;
    const int hf = F.bid & 1, wl = w & 3, hd = 4 * hf + wl;
    __syncthreads();
    if (tid < 256) { const int c = 256 * hf + tid; cst[tid] = P.rw_w0[c]; cst[256 + tid] = P.rw_w0[512 + c]; cst[512 + tid] = P.rw_a0[c]; cst[768 + tid] = P.rw_a0[512 + c];
      cst[1024 + tid] = P.rw_k_k[c]; cst[1280 + tid] = P.rw_k_a[c]; cst[1536 + tid] = P.rw_r_k[c]; cst[1792 + tid] = P.rw_r_k[512 + c]; }
    bf16x8 W[16];
#pragma unroll
    for (int cb = 0; cb < 4; ++cb) { const int c = 64 * hd + 4 * fr + cb;
        if (w < 4) { W[cb] = gather8(P.rw_w_up + (size_t)(8 * fq) * 512 + c, 512); W[4 + cb] = gather8(P.rw_w_up + (size_t)(32 + 8 * fq) * 512 + c, 512);
                     W[8 + cb] = gather8(P.rw_a_up + (size_t)(8 * fq) * 512 + c, 512); W[12 + cb] = gather8(P.rw_a_up + (size_t)(32 + 8 * fq) * 512 + c, 512); }
        else { W[cb] = gather8(P.rw_g_up + (size_t)(8 * fq) * 512 + c, 512); W[4 + cb] = gather8(P.rw_g_up + (size_t)(32 + 8 * fq) * 512 + c, 512); W[8 + cb] = gather8(P.rw_g_up + (size_t)(64 + 8 * fq) * 512 + c, 512); W[12 + cb] = W[cb]; } }
    const int col0 = (tid < 256) ? (256 * hf + tid) : (512 + 256 * hf + tid - 256), col1 = (tid < 256) ? (1024 + 256 * hf + tid) : ((tid < 480) ? (1536 + tid - 256) : 1536);
    const int zo0 = tid, zo1 = 512 + (tid & 255);
    const float mu00 = P.rw_mu[col0], mu10 = P.rw_mu[RWC + col0], mu01 = P.rw_mu[col1], mu11 = P.rw_mu[RWC + col1];
    float cw[5];
#pragma unroll
    for (int k = 0; k < 5; ++k) cw[k] = P.conv_w[k * 1024 + 512 * hf + tid];
    const float cbv = P.conv_b[512 * hf + tid], dtb = P.dt_bias[tid & 15];
    __syncthreads();

#ifndef PREP_REPS
#define PREP_REPS 1
#endif
    for (int rb_ = F.bid >> 1; rb_ < (M_ALL / 16) * PREP_REPS; rb_ += (F.G >> 1)) {
        const int rb = rb_ % (M_ALL / 16); const int g0 = rb * 16; const bool isctx = g0 < M_CTX; const int T = isctx ? CTXL : SEQ; const int t0 = isctx ? (g0 & (CTXL - 1)) : ((g0 - M_CTX) & (SEQ - 1));
        const bf16* zb = Z + (size_t)g0 * ZLD;
        const bool hp = t0 > 0, hn = (t0 + 16 < T), hp2 = t0 >= 2, hn2 = (t0 + 17 < T);
        float z0[18], z1[18], x[20];
        const int ccol = RWC + 512 + 512 * hf + tid;
#pragma unroll
        for (int i = 0; i < 18; ++i) { const bool ok = (i == 0) ? hp : ((i == 17) ? hn : true); z0[i] = ok ? ldbf(zb + (ptrdiff_t)(i - 1) * ZLD + col0) : 0.f; z1[i] = ok ? ldbf(zb + (ptrdiff_t)(i - 1) * ZLD + col1) : 0.f; }
#pragma unroll
        for (int i = 0; i < 20; ++i) { const bool ok = (i == 0) ? hp2 : (i == 1) ? hp : (i == 18) ? hn : (i == 19) ? hn2 : true; x[i] = ok ? ldbf(zb + (ptrdiff_t)(i - 2) * ZLD + ccol) : 0.f; }
#pragma unroll
        for (int tb = 0; tb < 16; ++tb) zs[tb * 768 + zo0] = (unsigned short)f2bf(z0[tb + 1] + mu00 * (z0[tb] - z0[tb + 1]) + mu10 * (z0[tb + 2] - z0[tb + 1]));
        {
            const int a = tid - 256;
#pragma unroll
            for (int tb = 0; tb < 16; ++tb) {
                const float zsft = z1[tb + 1] + mu01 * (z1[tb] - z1[tb + 1]) + mu11 * (z1[tb + 2] - z1[tb + 1]);
                if (tid < 256) zs[tb * 768 + zo1] = (unsigned short)f2bf(zsft);
                else if (tid < 480) { const float sg = sigm((a < 64) ? 2.f * zsft : zsft); const float av = (a < 64) ? (2.f * sg - 1.f) : ((a < 128) ? zsft : sg);
                    *(LAS unsigned short*)(actb + tb * ACT_ST + a * 2) = (unsigned short)f2bf(av); }
            }
        }
#pragma unroll
        for (int tb = 0; tb < 16; ++tb) {
            float y = cbv + cw[0] * x[tb] + cw[1] * x[tb + 1] + cw[2] * x[tb + 2] + cw[3] * x[tb + 3] + cw[4] * x[tb + 4];
            y = y * sigm(y);
            PM[(size_t)(g0 + tb) * 1024 + 512 * hf + tid] = (bf16)f2bf(y);
        }
        { const int tb = tid >> 5, cc = tid & 31;
          *(GAS v4u*)(ZG + (size_t)(g0 + tb) * 512 + 256 * hf + cc * 8) = *(const GAS v4u*)(zb + (size_t)tb * ZLD + RWC + 256 * hf + cc * 8); }
        if (hf == 0 && tid < 256) { const int tb = tid >> 4, cc = tid & 15; const float x = ldbf(zb + (size_t)tb * ZLD + RWC + 1536 + cc) + dtb; DT[(size_t)(g0 + tb) * 16 + cc] = (x > 20.f) ? x : log1pf(__expf(x)); }
        __syncthreads();
        const f32x4 zero = {0.f, 0.f, 0.f, 0.f};
        const int cl0 = 64 * wl + 4 * fr;
        if (w < 4) {
            bf16x8 Af[4];
#pragma unroll
            for (int kb = 0; kb < 4; ++kb) Af[kb] = *(const LAS bf16x8*)(actb + fr * ACT_ST + kb * 64 + fq * 16);
            f32x4 lw0[4], lw1[4], ia0[4], ia1[4];
#pragma unroll
            for (int cb = 0; cb < 4; ++cb) {
                lw0[cb] = __builtin_amdgcn_mfma_f32_16x16x32_bf16(Af[0], W[cb], zero, 0, 0, 0); lw1[cb] = __builtin_amdgcn_mfma_f32_16x16x32_bf16(Af[1], W[4 + cb], zero, 0, 0, 0);
                ia0[cb] = __builtin_amdgcn_mfma_f32_16x16x32_bf16(Af[2], W[8 + cb], zero, 0, 0, 0); ia1[cb] = __builtin_amdgcn_mfma_f32_16x16x32_bf16(Af[3], W[12 + cb], zero, 0, 0, 0);
            }
            const f32x4 w00 = *(const LAS f32x4*)(cst + cl0), w01 = *(const LAS f32x4*)(cst + 256 + cl0), a00 = *(const LAS f32x4*)(cst + 512 + cl0), a01 = *(const LAS f32x4*)(cst + 768 + cl0);
            const f32x4 kkc = *(const LAS f32x4*)(cst + 1024 + cl0), kac = *(const LAS f32x4*)(cst + 1280 + cl0), rk0 = *(const LAS f32x4*)(cst + 1536 + cl0), rk1 = *(const LAS f32x4*)(cst + 1792 + cl0);
#pragma unroll
            for (int e = 0; e < 4; ++e) {
                const int tok = 4 * fq + e; const size_t g = (size_t)(g0 + tok);
                const v2u ru = *(const LAS v2u*)(zs + tok * 768 + cl0), ku = *(const LAS v2u*)(zs + tok * 768 + 256 + cl0), vu = *(const LAS v2u*)(zs + tok * 768 + 512 + cl0);
                const f32x4 r = {bflo(ru.x), bfhi(ru.x), bflo(ru.y), bfhi(ru.y)}, k = {bflo(ku.x), bfhi(ku.x), bflo(ku.y), bfhi(ku.y)};
                const f32x4 kks = k * kkc;
                const float ssq = sum16((kks[0] * kks[0] + kks[1] * kks[1]) + (kks[2] * kks[2] + kks[3] * kks[3]));
                const float rn = __builtin_amdgcn_rcpf(fmaxf(sqrtf(ssq), 1e-12f));
                float ee0[4], ee1[4], kd0[4], kd1[4], bb0[4], bb1[4], na[4]; float bon = 0.f;
#pragma unroll
                for (int cb = 0; cb < 4; ++cb) {
                    ee0[cb] = 0.60653066f * sigm(w00[cb] + lw0[cb][e]); ee1[cb] = 0.60653066f * sigm(w01[cb] + lw1[cb][e]);
                    const float ic0 = sigm(a00[cb] + ia0[cb][e]), ic1 = sigm(a01[cb] + ia1[cb][e]);
                    const float kkn = kks[cb] * rn;
                    kd0[cb] = k[cb] * (1.f + (ic0 - 1.f) * kac[cb]); kd1[cb] = k[cb] * (1.f + (ic1 - 1.f) * kac[cb]);
                    bon += r[cb] * (kd0[cb] * rk0[cb] + kd1[cb] * rk1[cb]);
                    na[cb] = -kkn; bb0[cb] = kkn * ic0; bb1[cb] = kkn * ic1;
                }
                bon = sum16(bon); if (fr == 0) BONUS[g * 8 + hd] = bon;
                bf16* pr = PR + g * PRV + 256 * hf + cl0;
                *(GAS v2u*)(pr) = ru; *(GAS v2u*)(pr + 512) = vu;
                v2u o;
                o.x = pk2(na[0], na[1]); o.y = pk2(na[2], na[3]); *(GAS v2u*)(pr + 1024) = o;
                o.x = pk2(ee0[0], ee0[1]); o.y = pk2(ee0[2], ee0[3]); *(GAS v2u*)(pr + 1536) = o;
                o.x = pk2(kd0[0], kd0[1]); o.y = pk2(kd0[2], kd0[3]); *(GAS v2u*)(pr + 2048) = o;
                o.x = pk2(bb0[0], bb0[1]); o.y = pk2(bb0[2], bb0[3]); *(GAS v2u*)(pr + 2560) = o;
                o.x = pk2(ee1[0], ee1[1]); o.y = pk2(ee1[2], ee1[3]); *(GAS v2u*)(pr + 3072) = o;
                o.x = pk2(kd1[0], kd1[1]); o.y = pk2(kd1[2], kd1[3]); *(GAS v2u*)(pr + 3584) = o;
                o.x = pk2(bb1[0], bb1[1]); o.y = pk2(bb1[2], bb1[3]); *(GAS v2u*)(pr + 4096) = o;
            }
        } else {
            bf16x8 Af[3];
#pragma unroll
            for (int kb = 0; kb < 3; ++kb) Af[kb] = *(const LAS bf16x8*)(actb + fr * ACT_ST + (4 + kb) * 64 + fq * 16);
            f32x4 gt[4];
#pragma unroll
            for (int cb = 0; cb < 4; ++cb) {
                gt[cb] = __builtin_amdgcn_mfma_f32_16x16x32_bf16(Af[0], W[cb], zero, 0, 0, 0);
                gt[cb] = __builtin_amdgcn_mfma_f32_16x16x32_bf16(Af[1], W[4 + cb], gt[cb], 0, 0, 0); gt[cb] = __builtin_amdgcn_mfma_f32_16x16x32_bf16(Af[2], W[8 + cb], gt[cb], 0, 0, 0);
            }
#pragma unroll
            for (int e = 0; e < 4; ++e) { v2u o; o.x = pk2(gt[0][e], gt[1][e]); o.y = pk2(gt[2][e], gt[3][e]); *(GAS v2u*)(GATE + (size_t)(g0 + 4 * fq + e) * 512 + 256 * hf + cl0) = o; }
        }
        __syncthreads();
    }
}

template <int SH> __device__ __forceinline__ float dpp_shr(float x) { return __int_as_float(__builtin_amdgcn_update_dpp(0, __float_as_int(x), 0x110 + SH, 0xF, 0xF, true)); }
__device__ __forceinline__ int scan_row16(int c, int t, int b, int d) {
    const int st = c * 16 + t; const int seg = (st >= CTXL) ? 1 : 0; const int T = seg ? SEQ : CTXL; const int sl = st - seg * CTXL;
    return (seg ? (M_CTX + b * SEQ) : b * CTXL) + (d ? (T - 1 - sl) : sl);
}
__device__ __forceinline__ v4u scale8(const v4u u, float s) {
    v4u o; o.x = pk2(bflo(u.x) * s, bfhi(u.x) * s); o.y = pk2(bflo(u.y) * s, bfhi(u.y) * s); o.z = pk2(bflo(u.z) * s, bfhi(u.z) * s); o.w = pk2(bflo(u.w) * s, bfhi(u.w) * s); return o;
}
__device__ __forceinline__ bf16x8 pack4z(const f32x4& a) { v4u w; w.x = pk2(a[0], a[1]); w.y = pk2(a[2], a[3]); w.z = 0u; w.w = 0u; return __builtin_bit_cast(bf16x8, w); }
__device__ __forceinline__ bf16x8 tr4z(const LAS unsigned char* p) {
    const v2u t = __builtin_bit_cast(v2u, __builtin_amdgcn_ds_read_tr16_b64_v4i16((LAS v4i16_t*)p)); v4u w; w.x = t.x; w.y = t.y; w.z = 0u; w.w = 0u; return __builtin_bit_cast(bf16x8, w);
}
__device__ __forceinline__ bf16x8 cat44(const v2u a, const v2u b) { v4u w; w.x = a.x; w.y = a.y; w.z = b.x; w.w = b.y; return __builtin_bit_cast(bf16x8, w); }
constexpr int NCH16 = (CTXL + SEQ) / 16;
__device__ __forceinline__ f32x4 mm16(const f32x4& xT_c, const f32x4& y_c, const f32x4& acc) {
    return __builtin_amdgcn_mfma_f32_16x16x32_bf16(pack4z(xT_c), pack4z(y_c), acc, 0, 0, 0);
}
constexpr int RING_FLAGS = 122880;
constexpr int NSLOT = 6;
__device__ __forceinline__ unsigned lds_flag_ld(volatile LAS unsigned* p) { return (unsigned)__builtin_amdgcn_readfirstlane((int)*p); }
__device__ __forceinline__ void ring_wait_full(volatile LAS unsigned* fl, int s, int c) { while (lds_flag_ld(fl + s) != (unsigned)(c + 1)) __builtin_amdgcn_s_sleep(1); asm volatile("" ::: "memory"); }
__device__ __forceinline__ void ring_wait_free(volatile LAS unsigned* fl, int s, int c, int nslot = NSLOT, unsigned ncons = 4u) { const unsigned want = ncons * (unsigned)(c / nslot); while (lds_flag_ld(fl + 8 + s) < want) __builtin_amdgcn_s_sleep(1); asm volatile("" ::: "memory"); }
__device__ __forceinline__ void ring_set_full(volatile LAS unsigned* fl, int s, int c, int lane) { asm volatile("s_waitcnt lgkmcnt(0)" ::: "memory"); if (lane == 0) fl[s] = (unsigned)(c + 1); }
__device__ __forceinline__ void ring_done(volatile LAS unsigned* fl, int s, int lane) { asm volatile("s_waitcnt lgkmcnt(0)" ::: "memory"); if (lane == 0) __hip_atomic_fetch_add((LAS unsigned*)(fl + 8 + s), 1u, __ATOMIC_RELAXED, __HIP_MEMORY_SCOPE_WORKGROUP); }

constexpr int RST = 144, RIMG = 16 * RST;
constexpr int RW_SLOT = 18432;
__device__ __forceinline__ void rwkv_block(Frame& F, int unit, const bf16* PR, bf16* YRW) {
    const int d = unit & 1, h = (unit >> 1) & 7, b = unit >> 4;
    const int lane = F.lane, fr = lane & 15, fq = lane >> 4, tq = (lane & 15) >> 2, tp = lane & 3;
    volatile LAS unsigned* fl = (volatile LAS unsigned*)(F.lds + RING_FLAGS);
    __syncthreads();
    if (F.tid < 16) fl[F.tid] = 0u;
    __syncthreads();
    if (F.wave >= 4) {
        const int p = F.wave - 4;
        const int ve = (3 + 3 * d) * 512, vb = (5 + 3 * d) * 512, vk = (4 + 3 * d) * 512;
        bf16x8 Ltri; { v4u w; w.x = ((4 * fq + 0 <= fr) ? 0x3F80u : 0u) | ((4 * fq + 1 <= fr) ? 0x3F800000u : 0u); w.y = ((4 * fq + 2 <= fr) ? 0x3F80u : 0u) | ((4 * fq + 3 <= fr) ? 0x3F800000u : 0u); w.z = 0u; w.w = 0u; Ltri = __builtin_bit_cast(bf16x8, w); }
        v4u rE[2], rA[2], rB[2], rK[2], rR[2], rV[2];
#define RW_LOAD(c_) do { \
        _Pragma("unroll") for (int i = 0; i < 2; ++i) { const int id = lane + 64 * i; const bf16* src = PR + (size_t)scan_row16((c_), id >> 3, b, d) * PRV + h * 64 + (id & 7) * 8; \
            rE[i] = *(const GAS v4u*)(src + ve); rA[i] = *(const GAS v4u*)(src + 1024); rB[i] = *(const GAS v4u*)(src + vb); rK[i] = *(const GAS v4u*)(src + vk); rR[i] = *(const GAS v4u*)(src); rV[i] = *(const GAS v4u*)(src + 512); } } while (0)
        RW_LOAD(p);
        for (int c = p; c < NCH16; c += 4) {
            const int s = c % NSLOT;
            LAS unsigned char* sb = F.lds + s * RW_SLOT;
            LAS unsigned char* RE = sb; LAS unsigned char* RA = sb + RIMG; LAS unsigned char* RB = sb + 2 * RIMG; LAS unsigned char* RK = sb + 3 * RIMG; LAS unsigned char* RR = sb + 4 * RIMG;
            LAS unsigned char* RV = sb + 5 * RIMG; LAS unsigned char* FRG = sb + 6 * RIMG; LAS float* GC = (LAS float*)(sb + 6 * RIMG + 4096);
            ring_wait_free(fl, s, c);
#pragma unroll
            for (int i = 0; i < 2; ++i) { const int id = lane + 64 * i; const int o = (id >> 3) * RST + (id & 7) * 16;
                *(LAS v4u*)(RE + o) = rE[i]; *(LAS v4u*)(RA + o) = rA[i]; *(LAS v4u*)(RB + o) = rB[i]; *(LAS v4u*)(RK + o) = rK[i]; *(LAS v4u*)(RR + o) = rR[i]; *(LAS v4u*)(RV + o) = rV[i]; }
            if (c + 4 < NCH16) RW_LOAD(c + 4);
            asm volatile("s_waitcnt lgkmcnt(0)" ::: "memory");
#pragma unroll
            for (int jb = 0; jb < 4; ++jb) {
                const int tro = (4 * fq + tq) * RST + (16 * jb + 4 * tp) * 2;
                const v2u eu = __builtin_bit_cast(v2u, __builtin_amdgcn_ds_read_tr16_b64_v4i16((LAS v4i16_t*)(RE + tro)));
                const v2u au = __builtin_bit_cast(v2u, __builtin_amdgcn_ds_read_tr16_b64_v4i16((LAS v4i16_t*)(RA + tro)));
                const v2u bu = __builtin_bit_cast(v2u, __builtin_amdgcn_ds_read_tr16_b64_v4i16((LAS v4i16_t*)(RB + tro)));
                const v2u ku = __builtin_bit_cast(v2u, __builtin_amdgcn_ds_read_tr16_b64_v4i16((LAS v4i16_t*)(RK + tro)));
                const v2u ru = __builtin_bit_cast(v2u, __builtin_amdgcn_ds_read_tr16_b64_v4i16((LAS v4i16_t*)(RR + tro)));
                v4u ew; ew.x = eu.x; ew.y = eu.y; ew.z = 0u; ew.w = 0u;
                const f32x4 cum = __builtin_amdgcn_mfma_f32_16x16x32_bf16(Ltri, __builtin_bit_cast(bf16x8, ew), (f32x4){0.f, 0.f, 0.f, 0.f}, 0, 0, 0);
                const float ev[4] = {bflo(eu.x), bfhi(eu.x), bflo(eu.y), bfhi(eu.y)}, av[4] = {bflo(au.x), bfhi(au.x), bflo(au.y), bfhi(au.y)}, bv[4] = {bflo(bu.x), bfhi(bu.x), bflo(bu.y), bfhi(bu.y)};
                const float kv[4] = {bflo(ku.x), bfhi(ku.x), bflo(ku.y), bfhi(ku.y)}, rv[4] = {bflo(ru.x), bfhi(ru.x), bflo(ru.y), bfhi(ru.y)};
#pragma unroll
                for (int e = 0; e < 4; ++e) {
                    const float G = __expf(-cum[e]), Gi = __expf(cum[e]), Gx = __expf(ev[e] - cum[e]);
                    const int o = (4 * fq + e) * RST + (16 * jb + fr) * 2;
                    const unsigned ab = pk2(av[e] * Gx, bv[e] * Gi), kr = pk2(kv[e] * Gi, rv[e] * G);
                    *(LAS unsigned short*)(RA + o) = (unsigned short)ab; *(LAS unsigned short*)(RB + o) = (unsigned short)(ab >> 16);
                    *(LAS unsigned short*)(RK + o) = (unsigned short)kr; *(LAS unsigned short*)(RR + o) = (unsigned short)(kr >> 16);
                    if (e == 3 && fq == 3) GC[16 * jb + fr] = G;
                }
            }
            asm volatile("s_waitcnt lgkmcnt(0)" ::: "memory");
            f32x4 aba = {0.f, 0.f, 0.f, 0.f}, aka = aba, abr = aba, akr = aba, abaT = aba;
#pragma unroll
            for (int kb = 0; kb < 2; ++kb) {
                const int o = fr * RST + kb * 64 + fq * 16;
                const bf16x8 fb = *(const LAS bf16x8*)(RB + o), fk = *(const LAS bf16x8*)(RK + o), fa = *(const LAS bf16x8*)(RA + o), frr = *(const LAS bf16x8*)(RR + o);
                aba = __builtin_amdgcn_mfma_f32_16x16x32_bf16(fb, fa, aba, 0, 0, 0); aka = __builtin_amdgcn_mfma_f32_16x16x32_bf16(fk, fa, aka, 0, 0, 0);
                abr = __builtin_amdgcn_mfma_f32_16x16x32_bf16(fb, frr, abr, 0, 0, 0); akr = __builtin_amdgcn_mfma_f32_16x16x32_bf16(fk, frr, akr, 0, 0, 0);
                abaT = __builtin_amdgcn_mfma_f32_16x16x32_bf16(fa, fb, abaT, 0, 0, 0);
            }
            f32x4 idc;
#pragma unroll
            for (int e = 0; e < 4; ++e) { const int row = 4 * fq + e;
                aba[e] = (row < fr) ? aba[e] : 0.f; aka[e] = (row < fr) ? aka[e] : 0.f; abr[e] = (row <= fr) ? abr[e] : 0.f; akr[e] = (row <= fr) ? akr[e] : 0.f;
                abaT[e] = (fr < row) ? abaT[e] : 0.f; idc[e] = (row == fr) ? 1.f : 0.f; }
            f32x4 t_c = idc + aba, t_T = idc + abaT;
            f32x4 p_c = mm16(abaT, aba, (f32x4){0.f, 0.f, 0.f, 0.f}), p_T = mm16(aba, abaT, (f32x4){0.f, 0.f, 0.f, 0.f});
            { const f32x4 n_c = mm16(t_T, p_c, t_c), n_T = mm16(p_c, t_T, t_T); t_c = n_c; t_T = n_T; }
            { const f32x4 q_c = mm16(p_T, p_c, (f32x4){0.f, 0.f, 0.f, 0.f}), q_T = mm16(p_c, p_T, (f32x4){0.f, 0.f, 0.f, 0.f}); p_c = q_c; p_T = q_T; }
            { const f32x4 n_c = mm16(t_T, p_c, t_c), n_T = mm16(p_c, t_T, t_T); t_c = n_c; t_T = n_T; }
            { const f32x4 q_c = mm16(p_T, p_c, (f32x4){0.f, 0.f, 0.f, 0.f}); p_c = q_c; }
            const f32x4 tm_c = mm16(t_T, p_c, t_c);
            *(LAS bf16x8*)(FRG + lane * 16) = pack4z(tm_c); *(LAS bf16x8*)(FRG + 1024 + lane * 16) = pack4z(aka);
            *(LAS bf16x8*)(FRG + 2048 + lane * 16) = pack4z(abr); *(LAS bf16x8*)(FRG + 3072 + lane * 16) = pack4z(akr);
            ring_set_full(fl, s, c, lane);
        }
#undef RW_LOAD
    } else {
        const int q = F.wave;
        __builtin_amdgcn_s_setprio(3);
        bf16* yout = YRW + (size_t)d * M_ALL * 512 + h * 64 + 16 * q;
        f32x4 T[4];
#pragma unroll
        for (int jb = 0; jb < 4; ++jb) T[jb] = (f32x4){0.f, 0.f, 0.f, 0.f};
        for (int c = 0; c < NCH16; ++c) {
            const int s = c % NSLOT;
            LAS unsigned char* sb = F.lds + s * RW_SLOT;
            LAS unsigned char* RA = sb + RIMG; LAS unsigned char* RB = sb + 2 * RIMG; LAS unsigned char* RK = sb + 3 * RIMG; LAS unsigned char* RR = sb + 4 * RIMG;
            LAS unsigned char* RV = sb + 5 * RIMG; LAS unsigned char* FRG = sb + 6 * RIMG; LAS float* GC = (LAS float*)(sb + 6 * RIMG + 4096);
            ring_wait_full(fl, s, c);
            const bf16x8 tmA = *(const LAS bf16x8*)(FRG + lane * 16), akaA = *(const LAS bf16x8*)(FRG + 1024 + lane * 16), abrA = *(const LAS bf16x8*)(FRG + 2048 + lane * 16), akrA = *(const LAS bf16x8*)(FRG + 3072 + lane * 16);
            const bf16x8 Vf = tr4z(RV + (4 * fq + tq) * RST + (16 * q + 4 * tp) * 2);
            f32x4 x = {0.f, 0.f, 0.f, 0.f}, y = {0.f, 0.f, 0.f, 0.f};
#pragma unroll
            for (int jp = 0; jp < 2; ++jp) {
                const int o = fr * RST + (32 * jp + 4 * fq) * 2;
                const bf16x8 tf = pack8(T[2 * jp], T[2 * jp + 1]);
                x = __builtin_amdgcn_mfma_f32_16x16x32_bf16(cat44(*(const LAS v2u*)(RA + o), *(const LAS v2u*)(RA + o + 32)), tf, x, 0, 0, 0);
                y = __builtin_amdgcn_mfma_f32_16x16x32_bf16(cat44(*(const LAS v2u*)(RR + o), *(const LAS v2u*)(RR + o + 32)), tf, y, 0, 0, 0);
            }
            x = __builtin_amdgcn_mfma_f32_16x16x32_bf16(akaA, Vf, x, 0, 0, 0);
            const f32x4 ut = __builtin_amdgcn_mfma_f32_16x16x32_bf16(tmA, pack4z(x), (f32x4){0.f, 0.f, 0.f, 0.f}, 0, 0, 0);
            y = __builtin_amdgcn_mfma_f32_16x16x32_bf16(abrA, pack4z(ut), y, 0, 0, 0);
            y = __builtin_amdgcn_mfma_f32_16x16x32_bf16(akrA, Vf, y, 0, 0, 0);
            bf16x8 UV; { const v4u vw = __builtin_bit_cast(v4u, Vf); v4u w; w.x = pk2(ut[0], ut[1]); w.y = pk2(ut[2], ut[3]); w.z = vw.x; w.w = vw.y; UV = __builtin_bit_cast(bf16x8, w); }
#pragma unroll
            for (int jb = 0; jb < 4; ++jb) {
                const int tro = (4 * fq + tq) * RST + (16 * jb + 4 * tp) * 2;
                const v2u bt = __builtin_bit_cast(v2u, __builtin_amdgcn_ds_read_tr16_b64_v4i16((LAS v4i16_t*)(RB + tro))), kt = __builtin_bit_cast(v2u, __builtin_amdgcn_ds_read_tr16_b64_v4i16((LAS v4i16_t*)(RK + tro)));
                const f32x4 gc = *(const LAS f32x4*)(GC + 16 * jb + 4 * fq);
                T[jb] = __builtin_amdgcn_mfma_f32_16x16x32_bf16(cat44(bt, kt), UV, T[jb], 0, 0, 0); T[jb] = T[jb] * gc;
            }
            ring_done(fl, s, lane);
            { const int row0 = scan_row16(c, 0, b, d), stp = d ? -1 : 1;
#pragma unroll
              for (int e = 0; e < 4; ++e) yout[(size_t)(row0 + stp * (4 * fq + e)) * 512 + fr] = (bf16)f2bf(y[e]); }
        }
        __builtin_amdgcn_s_setprio(0);
    }
}

constexpr int MST = 272, MIMG = 16 * MST;
constexpr int MB_NSLOT = 5;
constexpr int MB_SLOT = 21504;
__device__ __forceinline__ void mamba_block(Frame& F, int unit, const bf16* PM, const float* DT, const float* a_log, bf16* YMB) {
    const int d = unit & 1, h = (unit >> 1) & 7, b = unit >> 4, grp = h >> 2;
    const int lane = F.lane, fr = lane & 15, fq = lane >> 4, tq = (lane & 15) >> 2, tp = lane & 3;
    volatile LAS unsigned* fl = (volatile LAS unsigned*)(F.lds + RING_FLAGS);
    __syncthreads();
    if (F.tid < 16) fl[F.tid] = 0u;
    __syncthreads();
    if (F.wave >= 4) {
        const int p = F.wave - 4;
        const float a_neg = -__expf(a_log[d * 8 + h]);
        v4u rB[4], rC[4], rX[2]; float rdt;
#define MB_LOAD(c_) do { \
        _Pragma("unroll") for (int i = 0; i < 4; ++i) { const int t = (lane >> 4) + 4 * i; const bf16* src = PM + (size_t)scan_row16((c_), t, b, d) * 1024 + 512 + grp * 128 + (lane & 15) * 8; rB[i] = *(const GAS v4u*)src; rC[i] = *(const GAS v4u*)(src + 256); } \
        _Pragma("unroll") for (int i = 0; i < 2; ++i) { const int id = lane + 64 * i; rX[i] = *(const GAS v4u*)(PM + (size_t)scan_row16((c_), id >> 3, b, d) * 1024 + h * 64 + (id & 7) * 8); } \
        rdt = DT[(size_t)scan_row16((c_), lane & 15, b, d) * 16 + d * 8 + h]; } while (0)
        MB_LOAD(p);
        for (int c = p; c < NCH16; c += 4) {
            const int s = c % MB_NSLOT;
            LAS unsigned char* sb = F.lds + s * MB_SLOT;
            LAS unsigned char* BR = sb; LAS unsigned char* CR = sb + MIMG; LAS unsigned char* RT = sb + 2 * MIMG; LAS unsigned char* KH = sb + 3 * MIMG; LAS unsigned char* VX = sb + 4 * MIMG;
            LAS unsigned char* FRG = sb + 4 * MIMG + RIMG; LAS float* scal = (LAS float*)(sb + 4 * MIMG + RIMG + 1024);
            ring_wait_free(fl, s, c, MB_NSLOT);
            float cs = rdt * a_neg;
            cs += dpp_shr<1>(cs); cs += dpp_shr<2>(cs); cs += dpp_shr<4>(cs); cs += dpp_shr<8>(cs);
            const float cse = __int_as_float(__builtin_amdgcn_readlane(__float_as_int(cs), 15));
            if (lane < 16) { scal[16 + lane] = cs; scal[32 + lane] = __expf(cs); scal[48 + lane] = rdt; scal[64 + lane] = __expf(cse - cs); }
            if (lane == 0) scal[0] = __expf(cse);
            asm volatile("s_waitcnt lgkmcnt(0)" ::: "memory");
#pragma unroll
            for (int i = 0; i < 4; ++i) { const int t = (lane >> 4) + 4 * i; const float sk = scal[64 + t], sr = scal[32 + t]; const int o = t * MST + (lane & 15) * 16;
                *(LAS v4u*)(BR + o) = rB[i]; *(LAS v4u*)(CR + o) = rC[i]; *(LAS v4u*)(KH + o) = scale8(rB[i], sk); *(LAS v4u*)(RT + o) = scale8(rC[i], sr); }
#pragma unroll
            for (int i = 0; i < 2; ++i) { const int id = lane + 64 * i; const int t = id >> 3; *(LAS v4u*)(VX + t * RST + (id & 7) * 16) = scale8(rX[i], scal[48 + t]); }
            if (c + 4 < NCH16) MB_LOAD(c + 4);
            asm volatile("s_waitcnt lgkmcnt(0)" ::: "memory");
            f32x4 akr = {0.f, 0.f, 0.f, 0.f};
#pragma unroll
            for (int kb = 0; kb < 4; ++kb) akr = __builtin_amdgcn_mfma_f32_16x16x32_bf16(*(const LAS bf16x8*)(BR + fr * MST + kb * 64 + fq * 16), *(const LAS bf16x8*)(CR + fr * MST + kb * 64 + fq * 16), akr, 0, 0, 0);
            const float cst = scal[16 + fr]; const f32x4 css = *(const LAS f32x4*)(scal + 16 + 4 * fq);
#pragma unroll
            for (int e = 0; e < 4; ++e) akr[e] = (4 * fq + e <= fr) ? akr[e] * __expf(cst - css[e]) : 0.f;
            *(LAS bf16x8*)(FRG + lane * 16) = pack4z(akr);
            ring_set_full(fl, s, c, lane);
        }
#undef MB_LOAD
    } else {
        const int q = F.wave;
        __builtin_amdgcn_s_setprio(3);
        bf16* yout = YMB + (size_t)d * M_ALL * 512 + h * 64 + 16 * q;
        unsigned long long prof_wait = 0ull; (void)prof_wait;
        f32x4 T[8];
#pragma unroll
        for (int jb = 0; jb < 8; ++jb) T[jb] = (f32x4){0.f, 0.f, 0.f, 0.f};
        for (int c = 0; c < NCH16; ++c) {
            const int s = c % MB_NSLOT;
            LAS unsigned char* sb = F.lds + s * MB_SLOT;
            LAS unsigned char* RT = sb + 2 * MIMG; LAS unsigned char* KH = sb + 3 * MIMG; LAS unsigned char* VX = sb + 4 * MIMG;
            LAS unsigned char* FRG = sb + 4 * MIMG + RIMG; LAS float* scal = (LAS float*)(sb + 4 * MIMG + RIMG + 1024);
#ifdef PROF_MBWAIT
            const unsigned long long tw0_ = __builtin_amdgcn_s_memrealtime();
#endif
            ring_wait_full(fl, s, c);
#ifdef PROF_MBWAIT
            prof_wait += __builtin_amdgcn_s_memrealtime() - tw0_;
#endif
#ifdef PROF_MBSEG
            unsigned long long ts0_ = __builtin_amdgcn_s_memrealtime();
#endif
            const bf16x8 akrA = *(const LAS bf16x8*)(FRG + lane * 16); const float gC = scal[0];
            const bf16x8 Vf = tr4z(VX + (4 * fq + tq) * RST + (16 * q + 4 * tp) * 2);
            f32x4 ya = {0.f, 0.f, 0.f, 0.f}, yb = __builtin_amdgcn_mfma_f32_16x16x32_bf16(akrA, Vf, (f32x4){0.f, 0.f, 0.f, 0.f}, 0, 0, 0);
#pragma unroll
            for (int jp = 0; jp < 4; ++jp) {
                const LAS unsigned char* rp = RT + fr * MST + (32 * jp + 4 * fq) * 2;
                const bf16x8 ra = cat44(*(const LAS v2u*)rp, *(const LAS v2u*)(rp + 32)), tf = pack8(T[2 * jp], T[2 * jp + 1]);
                if (jp & 1) yb = __builtin_amdgcn_mfma_f32_16x16x32_bf16(ra, tf, yb, 0, 0, 0); else ya = __builtin_amdgcn_mfma_f32_16x16x32_bf16(ra, tf, ya, 0, 0, 0);
            }
            const f32x4 y = ya + yb;
#ifdef PROF_MBSEG
            asm volatile("" :: "v"(y)); { const unsigned long long t_ = __builtin_amdgcn_s_memrealtime(); if (PROF_MBSEG == 1) prof_wait += t_ - ts0_; ts0_ = t_; }
#endif
#ifdef MB_CONS2X
            { f32x4 yd = {0.f, 0.f, 0.f, 0.f};
#pragma unroll
              for (int jp = 0; jp < 4; ++jp) { const LAS unsigned char* rp = RT + fr * MST + (32 * jp + 4 * fq) * 2 + 8;
                  yd = __builtin_amdgcn_mfma_f32_16x16x32_bf16(cat44(*(const LAS v2u*)rp, *(const LAS v2u*)(rp + 32)), pack8(T[2 * jp] * 1.0001f, T[2 * jp + 1] * 1.0001f), yd, 0, 0, 0); }
              yd = __builtin_amdgcn_mfma_f32_16x16x32_bf16(akrA, Vf, yd, 0, 0, 0);
              asm volatile("" :: "v"(yd)); }
#endif
#pragma unroll
            for (int jb = 0; jb < 8; ++jb) T[jb] = __builtin_amdgcn_mfma_f32_16x16x32_bf16(tr4z(KH + (4 * fq + tq) * MST + (16 * jb + 4 * tp) * 2), Vf, T[jb] * gC, 0, 0, 0);
#ifdef PROF_MBSEG
            asm volatile("" :: "v"(T[0]), "v"(T[7])); { const unsigned long long t_ = __builtin_amdgcn_s_memrealtime(); if (PROF_MBSEG == 2) prof_wait += t_ - ts0_; ts0_ = t_; }
#endif
            ring_done(fl, s, lane);
#ifdef PROF_MBSEG
            { const unsigned long long t_ = __builtin_amdgcn_s_memrealtime(); if (PROF_MBSEG == 3) prof_wait += t_ - ts0_; ts0_ = t_; }
#endif
            { const int row0 = scan_row16(c, 0, b, d), stp = d ? -1 : 1;
#pragma unroll
              for (int e = 0; e < 4; ++e) yout[(size_t)(row0 + stp * (4 * fq + e)) * 512 + fr] = (bf16)f2bf(y[e]); }
#ifdef PROF_MBSEG
            { const unsigned long long t_ = __builtin_amdgcn_s_memrealtime(); if (PROF_MBSEG == 4) prof_wait += t_ - ts0_; ts0_ = t_; }
#endif
        }
#if defined(PROF_MBWAIT) || defined(PROF_MBSEG)
        if (F.bid == 128 && F.tid == 0) __hip_atomic_store(F.ctl + 2, __float_as_uint((float)prof_wait * 0.01f), RLX_AGENT);
#endif
        __builtin_amdgcn_s_setprio(0);
    }
}

struct FinIn { const float *gn_w, *gn_b, *mb_d, *mb_norm_w; };
__device__ __forceinline__ void finish_phase(Frame& F, const FinIn& P, const bf16* YRW, const bf16* YMB, const bf16* PR, const bf16* PM, const float* BONUS, const bf16* GATE, const bf16* ZG, bf16* A) {
    const int gw = F.bid * NWAVES + F.wave, NGW = F.G * NWAVES; const int c0 = F.lane * 8, head = F.lane >> 3;
    float gnw[8], gnb[8], nw[8];
#pragma unroll
    for (int i = 0; i < 8; ++i) { gnw[i] = P.gn_w[c0 + i]; gnb[i] = P.gn_b[c0 + i]; nw[i] = P.mb_norm_w[c0 + i]; }
    const float dd = P.mb_d[head];
    struct FinIn9 { v4u y0, y1, vv, gg, m0, m1, xx, zz; float bon; };
    FinIn9 cur, nxt;
#define FIN_FETCH(R_, g_) do { const size_t gs_ = (size_t)(g_); \
        R_.y0 = *(const GAS v4u*)(YRW + gs_ * 512 + c0); R_.y1 = *(const GAS v4u*)(YRW + (size_t)M_ALL * 512 + gs_ * 512 + c0); R_.vv = *(const GAS v4u*)(PR + gs_ * PRV + 512 + c0); R_.gg = *(const GAS v4u*)(GATE + gs_ * 512 + c0); \
        R_.m0 = *(const GAS v4u*)(YMB + gs_ * 512 + c0); R_.m1 = *(const GAS v4u*)(YMB + (size_t)M_ALL * 512 + gs_ * 512 + c0); R_.xx = *(const GAS v4u*)(PM + gs_ * 1024 + c0); R_.zz = *(const GAS v4u*)(ZG + gs_ * 512 + c0); \
        R_.bon = BONUS[gs_ * 8 + head]; } while (0)
    if (gw < M_ALL) FIN_FETCH(cur, gw);
    for (int g = gw; g < M_ALL; g += NGW) {
        const size_t gs = (size_t)g;
        if (g + NGW < M_ALL) FIN_FETCH(nxt, g + NGW);
        const v4u y0 = cur.y0, y1 = cur.y1, vv = cur.vv, gg = cur.gg, m0 = cur.m0, m1 = cur.m1, xx = cur.xx, zz = cur.zz; const float bon = cur.bon;
        cur = nxt;
        float y[8], vf[8], gf[8];
#pragma unroll
        for (int i = 0; i < 4; ++i) { y[2 * i] = bflo(y0[i]) + bflo(y1[i]); y[2 * i + 1] = bfhi(y0[i]) + bfhi(y1[i]); vf[2 * i] = bflo(vv[i]); vf[2 * i + 1] = bfhi(vv[i]); gf[2 * i] = bflo(gg[i]); gf[2 * i + 1] = bfhi(gg[i]); }
        float s = 0.f;
#pragma unroll
        for (int i = 0; i < 8; ++i) s += y[i];
        s = sum8(s);
        const float mu = s * (1.f / 64.f); float q = 0.f;
#pragma unroll
        for (int i = 0; i < 8; ++i) { y[i] -= mu; q += y[i] * y[i]; }
        q = sum8(q);
        const float rstd = rsqrtf(q * (1.f / 64.f) + 64e-5f);
        float o[8];
#pragma unroll
        for (int i = 0; i < 8; ++i) o[i] = ((y[i] * rstd) * gnw[i] + gnb[i] + bon * vf[i]) * gf[i];
        v4u w; w.x = pk2(o[0], o[1]); w.y = pk2(o[2], o[3]); w.z = pk2(o[4], o[5]); w.w = pk2(o[6], o[7]);
        *(GAS v4u*)(A + gs * 1024 + c0) = w;
        float ym[8]; float ss = 0.f;
#pragma unroll
        for (int i = 0; i < 4; ++i) {
            const float z0 = bflo(zz[i]), z1 = bfhi(zz[i]);
            ym[2 * i] = (bflo(m0[i]) + bflo(m1[i]) + dd * bflo(xx[i])) * (z0 * sigm(z0)); ym[2 * i + 1] = (bfhi(m0[i]) + bfhi(m1[i]) + dd * bfhi(xx[i])) * (z1 * sigm(z1));
            ss += ym[2 * i] * ym[2 * i] + ym[2 * i + 1] * ym[2 * i + 1];
        }
        ss = half_sum(ss, F.lane);
        const float rr = rsqrtf(ss * (1.f / 256.f) + 1e-6f);
        v4u w2; w2.x = pk2(ym[0] * rr * nw[0], ym[1] * rr * nw[1]); w2.y = pk2(ym[2] * rr * nw[2], ym[3] * rr * nw[3]); w2.z = pk2(ym[4] * rr * nw[4], ym[5] * rr * nw[5]); w2.w = pk2(ym[6] * rr * nw[6], ym[7] * rr * nw[7]);
        *(GAS v4u*)(A + gs * 1024 + 512 + c0) = w2;
    }
#undef FIN_FETCH
}
#ifndef PROF_K
#define PROF_K 1e-5f
#endif
#ifndef PROF_PH0
#define PROF_PH0 PROF_PH
#endif
#ifndef PROF_OFF
#define PROF_OFF 0.f
#endif

__device__ __forceinline__ bf16x8 tr2(const LAS unsigned char* p0, const LAS unsigned char* p1) {
    const s16x4 t0 = __builtin_bit_cast(s16x4, __builtin_amdgcn_ds_read_tr16_b64_v4i16((LAS v4i16_t*)p0));
    const s16x4 t1 = __builtin_bit_cast(s16x4, __builtin_amdgcn_ds_read_tr16_b64_v4i16((LAS v4i16_t*)p1));
    bf16x8 r; r[0] = t0[0]; r[1] = t0[1]; r[2] = t0[2]; r[3] = t0[3]; r[4] = t1[0]; r[5] = t1[1]; r[6] = t1[2]; r[7] = t1[3]; return r;
}
__device__ __forceinline__ int swz(int row, int chunk) { return row * 128 + ((chunk ^ (row & 7)) << 4); }
constexpr int AT_CTXK = 0, AT_CTXV = 32768, AT_VRING = 65536, AT_NSLOT = 9, AT_RPB = AT_VRING + AT_NSLOT * 8192;
__device__ __forceinline__ void attn_phase(Frame& F, const bf16* Q, const bf16* K, const bf16* V, const float* rpb, bf16* O) {
    LAS unsigned char* ctxK = F.lds + AT_CTXK; LAS unsigned char* ctxV = F.lds + AT_CTXV; LAS unsigned char* vring = F.lds + AT_VRING; LAS float* rp = (LAS float*)(F.lds + AT_RPB);
    const int lane = F.lane, fr = lane & 15, fq = lane >> 4, tq = (lane & 15) >> 2, tp = lane & 3;
#ifndef ATT_REPS
#define ATT_REPS 1
#endif
    const int avcu = (F.G % 8 == 0) ? (F.bid % 8) * (F.G / 8) + F.bid / 8 : F.bid;
    for (int u_ = avcu; u_ < 256 * ATT_REPS; u_ += F.G) {
        const int u = u_ & 255; const int bh = u >> 1, half = u & 1, b = bh >> 4, h = bh & 15;
        const unsigned latbase = (unsigned)(M_CTX + b * SEQ);
        const int vcol = F.tid >> 3, vch = F.tid & 7;
        const unsigned vsrc = (unsigned)((latbase + vcol) * D + h * 64 + vch * 8);
        const int vdst = vcol * 128 + ((vch ^ (vcol & 7)) << 4);
        __syncthreads();
        {
            const int key = F.tid >> 1, hf = F.tid & 1; const size_t src = (size_t)(b * CTXL + key) * D + h * 64 + hf * 32;
#pragma unroll
            for (int i = 0; i < 4; ++i) { *(LAS v4u*)(ctxK + swz(key, hf * 4 + i)) = *(const GAS v4u*)(K + src + 8 * i); *(LAS v4u*)(ctxV + swz(key, hf * 4 + i)) = *(const GAS v4u*)(V + src + 8 * i); }
            if (F.tid < 465) rp[F.tid] = rpb[h * 465 + F.tid] * 1.4426950408889634f;
            const int r0 = 16 * half, lo0 = min(max(r0 - 4, 0), 24), hi0 = min(max(r0 + 1 - 4, 0), 24) + 7;
            for (int kr = lo0; kr <= hi0; ++kr) *(LAS v4u*)(vring + (kr % AT_NSLOT) * 8192 + vdst) = *(const GAS v4u*)(V + vsrc + (unsigned)(kr * 64 * D));
        }
        __syncthreads();
        for (int it = 0; it < 8; ++it) {
            const int ra = 16 * half + 2 * it;
            const int r = ra + (F.wave >> 2), j = F.wave & 3;
            const int rs = min(max(r - 4, 0), 24); const int kb = (j == 0) ? 0 : (j == 1) ? 8 : (j == 2) ? 24 : 32;
            const int qc = 16 * j + fr, wsq = min(max(qc - 8, 0), 48);
            const int hi = min(max(ra + 1 - 4, 0), 24) + 7, hin = (it < 7) ? (min(max(ra + 3 - 4, 0), 24) + 7) : hi;
            bf16x8 qf[2];
            { const bf16* qp = Q + (unsigned)((latbase + r * 64 + qc) * D + h * 64 + 8 * fq); qf[0] = *(const GAS bf16x8*)qp; qf[1] = *(const GAS bf16x8*)(qp + 32); }
            const int cv = kb + 4 * fq - wsq, cc2 = kb + 4 * fq - qc + 15;
            f32x4 sl[8][2], sc[16];
            const unsigned koff = (unsigned)((latbase + rs * 64 + kb + fr) * D + h * 64 + 8 * fq);
            bf16x8 kc[4], kn[4];
#pragma unroll
            for (int x = 0; x < 4; ++x) kc[x] = *(const GAS bf16x8*)(K + koff + (x >> 1) * 16 * D + (x & 1) * 32);
#pragma unroll
            for (int i = 0; i < 8; ++i) {
                const int brow = (rs + i - r + 7) * 31;
                if (i < 7) {
#pragma unroll
                    for (int x = 0; x < 4; ++x) kn[x] = *(const GAS bf16x8*)(K + koff + (unsigned)((i + 1) * 64 * D) + (x >> 1) * 16 * D + (x & 1) * 32);
                }
#pragma unroll
                for (int blk = 0; blk < 2; ++blk) {
                    f32x4 s = {0.f, 0.f, 0.f, 0.f};
                    s = __builtin_amdgcn_mfma_f32_16x16x32_bf16(kc[2 * blk], qf[0], s, 0, 0, 0);
                    s = __builtin_amdgcn_mfma_f32_16x16x32_bf16(kc[2 * blk + 1], qf[1], s, 0, 0, 0);
#pragma unroll
                    for (int e = 0; e < 4; ++e) s[e] = ((unsigned)(cv + 16 * blk + e) < 16u) ? (s[e] + rp[brow + min(max(cc2 + 16 * blk + e, 0), 30)]) : -INFINITY;
                    sl[i][blk] = s;
                }
#pragma unroll
                for (int x = 0; x < 4; ++x) kc[x] = kn[x];
            }
#pragma unroll
            for (int cb = 0; cb < 16; ++cb) {
                const int key = 16 * cb + fr;
                const bf16x8 k0 = *(const LAS bf16x8*)(ctxK + swz(key, fq)), k1 = *(const LAS bf16x8*)(ctxK + swz(key, 4 + fq));
                f32x4 s = {0.f, 0.f, 0.f, 0.f};
                s = __builtin_amdgcn_mfma_f32_16x16x32_bf16(k0, qf[0], s, 0, 0, 0);
                s = __builtin_amdgcn_mfma_f32_16x16x32_bf16(k1, qf[1], s, 0, 0, 0);
                sc[cb] = s;
            }
            v4u vnew[2];
#pragma unroll
            for (int n = 0; n < 2; ++n) if (hi + 1 + n <= hin) vnew[n] = *(const GAS v4u*)(V + vsrc + (unsigned)((hi + 1 + n) * 64 * D));
            float m = -INFINITY;
#pragma unroll
            for (int i = 0; i < 8; ++i)
#pragma unroll
                for (int blk = 0; blk < 2; ++blk)
#pragma unroll
                    for (int e = 0; e < 4; ++e) m = fmaxf(m, sl[i][blk][e]);
#pragma unroll
            for (int cb = 0; cb < 16; ++cb)
#pragma unroll
                for (int e = 0; e < 4; ++e) m = fmaxf(m, sc[cb][e]);
            m = fmaxf(m, __shfl_xor(m, 16)); m = fmaxf(m, __shfl_xor(m, 32));
            float l = 0.f;
#pragma unroll
            for (int i = 0; i < 8; ++i)
#pragma unroll
                for (int blk = 0; blk < 2; ++blk)
#pragma unroll
                    for (int e = 0; e < 4; ++e) { const float p = __builtin_amdgcn_exp2f(sl[i][blk][e] - m); sl[i][blk][e] = p; l += p; }
#pragma unroll
            for (int cb = 0; cb < 16; ++cb)
#pragma unroll
                for (int e = 0; e < 4; ++e) { const float p = __builtin_amdgcn_exp2f(sc[cb][e] - m); sc[cb][e] = p; l += p; }
            l += __shfl_xor(l, 16); l += __shfl_xor(l, 32);
            const float linv = __builtin_amdgcn_rcpf(l);
            f32x4 o[4];
#pragma unroll
            for (int db = 0; db < 4; ++db) o[db] = (f32x4){0.f, 0.f, 0.f, 0.f};
#pragma unroll
            for (int i = 0; i < 8; ++i) {
                const LAS unsigned char* vrow = vring + ((rs + i) % AT_NSLOT) * 8192;
                const bf16x8 pa = pack8(sl[i][0], sl[i][1]);
                const int c0 = kb + 4 * fq + tq, c1 = c0 + 16;
#pragma unroll
                for (int db = 0; db < 4; ++db) {
                    const int ch = 2 * db + (tp >> 1), wi = 8 * (tp & 1);
                    const bf16x8 vb = tr2(vrow + swz(c0, ch) + wi, vrow + swz(c1, ch) + wi);
                    o[db] = __builtin_amdgcn_mfma_f32_16x16x32_bf16(pa, vb, o[db], 0, 0, 0);
                }
            }
#pragma unroll
            for (int cc = 0; cc < 8; ++cc) {
                const bf16x8 pa = pack8(sc[2 * cc], sc[2 * cc + 1]);
                const int k0 = 32 * cc + 4 * fq + tq, k1 = k0 + 16;
#pragma unroll
                for (int db = 0; db < 4; ++db) {
                    const int ch = 2 * db + (tp >> 1), wi = 8 * (tp & 1);
                    const bf16x8 vb = tr2(ctxV + swz(k0, ch) + wi, ctxV + swz(k1, ch) + wi);
                    o[db] = __builtin_amdgcn_mfma_f32_16x16x32_bf16(pa, vb, o[db], 0, 0, 0);
                }
            }
#pragma unroll
            for (int e = 0; e < 4; ++e) {
                const float li = __shfl(linv, 4 * fq + e);
                bf16* op = O + (unsigned)((b * SEQ + r * 64 + 16 * j + 4 * fq + e) * D + h * 64 + fr);
#pragma unroll
                for (int db = 0; db < 4; ++db) op[db * 16] = (bf16)f2bf(o[db][e] * li);
            }
            __syncthreads();
#pragma unroll
            for (int n = 0; n < 2; ++n) if (hi + 1 + n <= hin) *(LAS v4u*)(vring + ((hi + 1 + n) % AT_NSLOT) * 8192 + vdst) = vnew[n];
            __syncthreads();
        }
    }
}

template <bool PRE = false> __device__ __forceinline__ void router_phase(Frame& F, const float* hlat, const float* g, const float* mods_l, const float* router_w, const float* router_b, bf16* A4, unsigned* tokinfo, gu32* cntb, const float* plog = nullptr) {
    LAS int* se = (LAS int*)F.lds;
    LAS float* sg = (LAS float*)(F.lds + 512);
    LAS int* srow = (LAS int*)(F.lds + 1024);
    LAS unsigned* spos = (LAS unsigned*)(F.lds + 1280);
    const int gw = F.bid * NWAVES + F.wave, NGW = F.G * NWAVES;
    const int nbatch = (M_LAT + NGW * 8 - 1) / (NGW * 8);
    LAS float* srw = (LAS float*)(F.lds + 2048);
    __syncthreads();
    if constexpr (!PRE) for (int i = F.tid; i < 2048; i += NTHR) ((LAS f32x4*)srw)[i] = ((const GAS f32x4*)router_w)[i];
    f32x4 gg[4];
#pragma unroll
    for (int j = 0; j < 4; ++j) gg[j] = ((const GAS f32x4*)g)[F.lane + 64 * j];
    RowIn cur, nxt;
#define RT_FETCH(R_, r_) do { const float* mp_ = mods_l + ((r_) >> 11) * 6144; row_fetch(R_, hlat + (size_t)(r_) * D, mp_ + 3072, mp_ + 4096, F.lane); } while (0)
    if constexpr (!PRE) { if (gw < M_LAT) RT_FETCH(cur, gw); }
    for (int bt = 0; bt < nbatch; ++bt) {
        __syncthreads();
#pragma unroll 1
        for (int k = 0; k < 8; ++k) {
            const int r = gw + (bt * 8 + k) * NGW, slot = F.wave * 8 + k;
            if (r >= M_LAT) { if (F.lane == 0) { se[2 * slot] = -1; se[2 * slot + 1] = -1; srow[slot] = 0; } continue; }
            float lg[8];
            if constexpr (PRE) {
                const GAS f32x4* pl = (const GAS f32x4*)(plog + (size_t)r * 32); f32x4 q[8];
#pragma unroll
                for (int i = 0; i < 8; ++i) q[i] = pl[i];
#pragma unroll
                for (int e = 0; e < 4; ++e) { lg[e] = ((q[0][e] + q[2][e]) + (q[4][e] + q[6][e])) + router_b[e]; lg[4 + e] = ((q[1][e] + q[3][e]) + (q[5][e] + q[7][e])) + router_b[4 + e]; }
            } else {
            if (r + NGW < M_LAT) RT_FETCH(nxt, r + NGW);
            f32x4 a[4]; row_finish(cur, gg, A4 + (size_t)r * D, F.lane, a);
            cur = nxt;
#pragma unroll
            for (int e = 0; e < 8; ++e) lg[e] = 0.f;
#pragma unroll
            for (int j = 0; j < 4; ++j)
#pragma unroll
                for (int x = 0; x < 4; ++x) { const LAS float* rw = srw + ((F.lane + 64 * j) * 4 + x) * 8; const f32x4 w0 = *(const LAS f32x4*)rw, w1 = *(const LAS f32x4*)(rw + 4); const float av = a[j][x];
#pragma unroll
                    for (int e = 0; e < 4; ++e) { lg[e] += av * w0[e]; lg[4 + e] += av * w1[e]; } }
#pragma unroll
            for (int e = 0; e < 8; ++e) lg[e] = wave_sum(lg[e]) + router_b[e];
            }
            int e0 = 0; float v0 = lg[0];
#pragma unroll
            for (int e = 1; e < 8; ++e) if (lg[e] > v0) { v0 = lg[e]; e0 = e; }
            int e1 = -1; float v1 = -INFINITY;
#pragma unroll
            for (int e = 0; e < 8; ++e) if (e != e0 && lg[e] > v1) { v1 = lg[e]; e1 = e; }
            const float g0 = 1.f / (1.f + __expf(v1 - v0)), g1 = 1.f - g0;
            if (F.lane == 0) { se[2 * slot] = e0; se[2 * slot + 1] = e1; sg[2 * slot] = g0; sg[2 * slot + 1] = g1; srow[slot] = r; }
        }
        __syncthreads();
        if (F.wave == 0) {
            const int l = F.lane; const int ea = se[l], eb = se[64 + l];
            const unsigned long long below = (l == 0) ? 0ull : (~0ull >> (64 - l));
            unsigned ra = 0u, rb = 0u, tot = 0u;
#pragma unroll
            for (int e = 0; e < 8; ++e) {
                const unsigned long long ma = __ballot(ea == e), mb = __ballot(eb == e);
                const unsigned ca = (unsigned)__popcll(ma), cb = (unsigned)__popcll(mb);
                if (ea == e) ra = (unsigned)__popcll(ma & below);
                if (eb == e) rb = ca + (unsigned)__popcll(mb & below);
                if (l == e) tot = ca + cb;
            }
            if (l < 8) cntb[(size_t)(bt * F.G + F.bid) * 8 + l] = tot;
            spos[l] = ra; spos[64 + l] = rb;
            asm volatile("s_waitcnt lgkmcnt(0)" ::: "memory");
            if (se[2 * l] >= 0) {
                v4u t0; t0.x = (unsigned)se[2 * l]; t0.y = spos[2 * l]; t0.z = __float_as_uint(sg[2 * l]); t0.w = (unsigned)se[2 * l + 1];
                v4u t1; t1.x = spos[2 * l + 1]; t1.y = __float_as_uint(sg[2 * l + 1]); t1.z = 0u; t1.w = 0u;
                const size_t row = (size_t)srow[l];
                *(GAS v4u*)(tokinfo + row * 8) = t0; *(GAS v4u*)(tokinfo + row * 8 + 4) = t1;
            }
        }
    }
}
#undef RT_FETCH
__device__ __forceinline__ void moe_bases(gu32* cnt, int (&tb)[9]) {
    int acc = 0;
#pragma unroll
    for (int e = 0; e < 8; ++e) { tb[e] = acc; const unsigned c = __hip_atomic_load(cnt + 64 * e, RLX_AGENT); acc += (int)((c + 255u) >> 8); }
    tb[8] = acc;
}
#ifndef MOE_TAIL_SPLIT
#define MOE_TAIL_SPLIT 1
#endif
__device__ __forceinline__ void moe_tail_split(const int (&tb)[9], int G, int& first, int& ntail) {
    const int U = tb[8] * 4; first = (U / G) * G; ntail = U - first;
    if (first == 0 || (first & 3) || ntail > 32) { first = U; ntail = 0; }
#if !MOE_TAIL_SPLIT
    first = U; ntail = 0;
#endif
}
__device__ __forceinline__ void gather_phase(Frame& F, const bf16* A4, unsigned* tokinfo, gu32* cnt, const gu32* cntb, bf16* XG) {
    const int gw = F.bid * NWAVES + F.wave, NGW = F.G * NWAVES;
    const int nbatch = (M_LAT + NGW * 8 - 1) / (NGW * 8), nent = nbatch * F.G;
    LAS float* sred = (LAS float*)F.lds;
    __syncthreads();
    if (F.wave == 0) {
        float tot[8];
#pragma unroll
        for (int e = 0; e < 8; ++e) tot[e] = 0.f;
        for (int i = F.lane; i < nent; i += 64) { const v4u a = *(const GAS v4u*)(cntb + (size_t)i * 8), b = *(const GAS v4u*)(cntb + (size_t)i * 8 + 4);
            tot[0] += (float)a.x; tot[1] += (float)a.y; tot[2] += (float)a.z; tot[3] += (float)a.w; tot[4] += (float)b.x; tot[5] += (float)b.y; tot[6] += (float)b.z; tot[7] += (float)b.w; }
#pragma unroll
        for (int e = 0; e < 8; ++e) { const float s = wave_sum(tot[e]); if (F.lane == 0) sred[e] = s; }
        for (int bt = 0; bt < nbatch; ++bt) {
            const int mine = bt * F.G + F.bid; float pre[8];
#pragma unroll
            for (int e = 0; e < 8; ++e) pre[e] = 0.f;
            for (int i = F.lane; i < mine; i += 64) { const v4u a = *(const GAS v4u*)(cntb + (size_t)i * 8), b = *(const GAS v4u*)(cntb + (size_t)i * 8 + 4);
                pre[0] += (float)a.x; pre[1] += (float)a.y; pre[2] += (float)a.z; pre[3] += (float)a.w; pre[4] += (float)b.x; pre[5] += (float)b.y; pre[6] += (float)b.z; pre[7] += (float)b.w; }
#pragma unroll
            for (int e = 0; e < 8; ++e) { const float s = wave_sum(pre[e]); if (F.lane == 0) sred[8 + 8 * bt + e] = s; }
        }
    }
    __syncthreads();
    int tb[9]; { int acc = 0;
#pragma unroll
        for (int e = 0; e < 8; ++e) { tb[e] = acc; const unsigned c = (unsigned)sred[e]; acc += (int)((c + 255u) >> 8); if (F.bid == 0 && F.tid == 0) __hip_atomic_store(cnt + 64 * e, c, RLX_AGENT); }
        tb[8] = acc; }
    struct GIn { v4u t0, t1, x0, x1; };
    GIn cur, nxt;
#define G_FETCH(R_, r_) do { R_.t0 = *(const GAS v4u*)(tokinfo + (size_t)(r_) * 8); R_.t1 = *(const GAS v4u*)(tokinfo + (size_t)(r_) * 8 + 4); \
        const GAS v4u* s_ = (const GAS v4u*)(A4 + (size_t)(r_) * D); R_.x0 = s_[F.lane]; R_.x1 = s_[F.lane + 64]; } while (0)
    if (gw < M_LAT) G_FETCH(cur, gw);
    int k = 0;
    for (int r = gw; r < M_LAT; r += NGW, ++k) {
        if (r + NGW < M_LAT) G_FETCH(nxt, r + NGW);
        const v4u t0 = cur.t0, t1 = cur.t1, x0 = cur.x0, x1 = cur.x1; cur = nxt;
        const LAS float* pre = sred + 8 + 8 * (k >> 3);
        int tbe0 = 0, tbe1 = 0; unsigned pr0 = 0u, pr1 = 0u;
#pragma unroll
        for (int e = 0; e < 8; ++e) { if ((int)t0.x == e) { tbe0 = tb[e]; pr0 = (unsigned)pre[e]; } if ((int)t0.w == e) { tbe1 = tb[e]; pr1 = (unsigned)pre[e]; } }
        const unsigned row0 = (unsigned)tbe0 * 256u + pr0 + t0.y, row1 = (unsigned)tbe1 * 256u + pr1 + t1.x;
        GAS v4u* d0 = (GAS v4u*)(XG + (size_t)row0 * D); GAS v4u* d1 = (GAS v4u*)(XG + (size_t)row1 * D);
        d0[F.lane] = x0; d0[F.lane + 64] = x1; d1[F.lane] = x0; d1[F.lane + 64] = x1;
        if (F.lane == 0) { tokinfo[(size_t)r * 8 + 6] = row0; tokinfo[(size_t)r * 8 + 7] = row1; }
    }
#undef G_FETCH
}
__device__ __forceinline__ f32x4 moe_y4(const bf16* YG, const float* slab, unsigned row, int j, int lane, unsigned tailrow0, int first, int ntail) {
    if (row < tailrow0) { const v2u a = ((const GAS v2u*)(YG + (size_t)row * D) + lane)[64 * j]; return (f32x4){bflo(a.x), bfhi(a.x), bflo(a.y), bfhi(a.y)}; }
    const size_t kstride = (size_t)(ntail >> 2) * 256 * 1024; const float* p = slab + (size_t)(row - tailrow0) * 1024 + (lane + 64 * j) * 4; f32x4 s = {0.f, 0.f, 0.f, 0.f};
    for (int ks = 0; ks < 11; ++ks) s += *(const GAS f32x4*)(p + ks * kstride);
    const unsigned w0 = pk2(s[0], s[1]), w1 = pk2(s[2], s[3]);
    return (f32x4){bflo(w0), bfhi(w0), bflo(w1), bfhi(w1)};
}
__device__ __forceinline__ void final_phase(Frame& F, float* hout, const bf16* YG, const unsigned* tokinfo, const float* mods_l, const float* norm_final, const float* slab, gu32* cnt) {
    const int gw = F.bid * NWAVES + F.wave, NGW = F.G * NWAVES;
    int tb[9]; moe_bases(cnt, tb); int first, ntail; moe_tail_split(tb, F.G, first, ntail); const unsigned tailrow0 = (unsigned)(first >> 2) * 256u;
#if defined(PROF_PH) || defined(PROF_SCANWAIT) || defined(PROF_MBWAIT) || defined(PROF_MBSEG)
    const float prof_scale = 1.f + sqrtf(__uint_as_float(__hip_atomic_load(F.ctl + 2, RLX_AGENT)) * PROF_K);
#else
    const float prof_scale = 1.f;
#endif
    for (int r = gw; r < M_LAT; r += NGW) {
        const v4u t0 = *(const GAS v4u*)(tokinfo + (size_t)r * 8), t1 = *(const GAS v4u*)(tokinfo + (size_t)r * 8 + 4);
        const float g0 = __uint_as_float(t0.z), g1 = __uint_as_float(t1.y); const unsigned row0 = t1.z, row1 = t1.w;
        const float* mp = mods_l + (r >> 11) * 6144 + 5120;
        GAS f32x4* hr = (GAS f32x4*)(hout + (size_t)r * D) + F.lane;
        f32x4 v[4]; float ss = 0.f;
#pragma unroll
        for (int j = 0; j < 4; ++j) {
            const f32x4 hh = hr[64 * j], mm = ((const GAS f32x4*)mp)[F.lane + 64 * j];
            const f32x4 ya = moe_y4(YG, slab, row0, j, F.lane, tailrow0, first, ntail), yb = moe_y4(YG, slab, row1, j, F.lane, tailrow0, first, ntail);
            v[j] = hh + mm * (ya * g0 + yb * g1);
            ss += (v[j].x * v[j].x + v[j].y * v[j].y) + (v[j].z * v[j].z + v[j].w * v[j].w);
        }
        const float rs = rsqrtf(wave_sum(ss) * (1.f / 1024.f) + 1e-6f);
#pragma unroll
        for (int j = 0; j < 4; ++j) { const f32x4 gg = ((const GAS f32x4*)norm_final)[F.lane + 64 * j]; hr[64 * j] = (v[j] * (rs * prof_scale)) * gg; }
    }
}

constexpr int NPHASE = 19;
#ifndef MK_PER_PHASE
#define MK_PER_PHASE 0
#endif
__device__ __forceinline__ int fresh_lane() { int l; asm volatile("v_mbcnt_lo_u32_b32 %0, -1, 0\n\tv_mbcnt_hi_u32_b32 %0, -1, %0" : "=v"(l)); return l; }
struct Args { const float* in[39]; float* out; unsigned char* ws; int ph_lo, ph_hi; };
#define KARGP(k) (((void* const __attribute__((address_space(4)))*)__builtin_amdgcn_kernarg_segment_ptr())[k])
#define KARG(k) ((const float*)KARGP(k))
__global__ void __launch_bounds__(NWAVES * 64, 2) mk_fwd(Args args) {
    extern __shared__ __attribute__((aligned(16))) unsigned char lds[];
    Frame F;
    F.lds = (LAS unsigned char*)lds; F.MISC = (volatile LAS unsigned*)(F.lds + MISC_OFF);
    F.tid = threadIdx.x; F.lane = F.tid & 63; F.wave = __builtin_amdgcn_readfirstlane(F.tid >> 6); F.G = gridDim.x; F.bid = blockIdx.x;
    unsigned char* ws = (unsigned char*)KARGP(40); F.ctl = (gu32*)(ws + WS_CTL);
    for (int u = F.tid; u < (LDS_BYTES - LDSCTL_OFF) / 4; u += NWAVES * 64) ((LAS unsigned*)(F.lds + LDSCTL_OFF))[u] = 0u;
    __syncthreads();
    const int lo = args.ph_lo, hi = args.ph_hi;
    unsigned long long prof_t0 = 0ull; (void)prof_t0;
    XcdBarrier bar; bar.bar = (unsigned*)(F.ctl + CW_BAR); bar.x = 0; bar.st = nullptr;
    if (hi - lo > 1) bar = xcd_barrier_post((unsigned*)(F.ctl + CW_BAR), F.MISC + 8);
#ifdef PH_MASK
#define IN(k) ((((PH_MASK) >> (k)) & 1) && lo <= (k) && (k) < hi)
#else
#define IN(k) (lo <= (k) && (k) < hi)
#endif
#ifndef DUP_MASK
#define DUP_MASK 0
#endif
#ifdef PROF_PH
#define PROF_T0(k) do { if ((k) == PROF_PH0 && F.bid == 0 && F.tid == 0) __hip_atomic_store(F.ctl + 4, (unsigned)__builtin_amdgcn_s_memrealtime(), RLX_AGENT); } while (0)
#define PROF_T1(k) do { if ((k) == PROF_PH && F.bid == 0 && F.tid == 0) { const unsigned t1_ = (unsigned)__builtin_amdgcn_s_memrealtime(); __hip_atomic_store(F.ctl + 2, __float_as_uint(fmaxf((float)(t1_ - __hip_atomic_load(F.ctl + 4, RLX_AGENT)) * 0.01f - (PROF_OFF), 0.f)), RLX_AGENT); } } while (0)
#else
#define PROF_T0(k) do {} while (0)
#define PROF_T1(k) do {} while (0)
#endif
#define REPS(k) (1 + (((DUP_MASK) >> (k)) & 1))
#ifdef DOUBLE_BAR
#define SEAM(k) do { if (IN(k) && IN((k) + 1)) { xcd_barrier(bar); xcd_barrier(bar); } } while (0)
#else
#define SEAM(k) do { if (IN(k) && IN((k) + 1)) xcd_barrier(bar); } while (0)
#endif
    const float* x = KARG(0); const float* ctx = KARG(2);
    float* mods = (float*)(ws + WS_MODS); float* hctx = (float*)(ws + WS_HCTX); float* hlat = (float*)KARGP(39);
    bf16* A = (bf16*)(ws + WS_A);
    const int vcu = (F.G % 8 == 0) ? (F.bid % 8) * (F.G / 8) + F.bid / 8 : F.bid;

    PROF_T0(0); if (IN(0)) for (int rep_ = 0; rep_ < REPS(0); ++rep_) { if (rep_) __syncthreads(); F.lane = fresh_lane(); F.tid = F.wave * 64 + F.lane; p0_phase(F, KARG(1), KARG(3), KARG(4), KARG(5), mods, KARG(9), KARG(10), KARG(28), KARG(29), KARG(30), KARG(31), KARG(32), ws); }
    SEAM(0); PROF_T1(0);
    PROF_T0(1); if (IN(1)) for (int rep_ = 0; rep_ < REPS(1); ++rep_) { if (rep_) __syncthreads(); F.lane = fresh_lane(); F.tid = F.wave * 64 + F.lane; normmod_phase(F, ctx, x, KARG(6), mods, 0, 1024, A); }
    SEAM(1); PROF_T1(1);
    PROF_T0(2); if (IN(2)) for (int rep_ = 0; rep_ < REPS(2); ++rep_) { if (rep_) __syncthreads(); F.lane = fresh_lane(); F.tid = F.wave * 64 + F.lane;
        pg8::Gemm g{A, (const bf16*)(ws + WS_WIN_T), M_ALL, ZLD, D}; pg8::StaticOrder S; S.init(M_ALL, ZLD, F.G, F.bid);
        pg8::EpiBf16<0> E{(bf16*)(ws + WS_Z), ZLD, nullptr, 0, 0, 1.f};
        pg8::gemm_phase<pg8::EpiBf16<0>, pg8::StaticOrder, true, true>(F.lds, g, S, E);
    }
    SEAM(2); PROF_T1(2);
    PROF_T0(3); if (IN(3)) for (int rep_ = 0; rep_ < REPS(3); ++rep_) { if (rep_) __syncthreads(); F.lane = fresh_lane(); F.tid = F.wave * 64 + F.lane;
        PrepIn P{KARG(11), KARG(12), KARG(13), KARG(14), KARG(15), KARG(16), KARG(17), KARG(18), KARG(19), KARG(22), KARG(23), KARG(24)};
        prepare_phase(F, P, (const bf16*)(ws + WS_Z), (bf16*)(ws + WS_PR), (bf16*)(ws + WS_PM), (float*)(ws + WS_DT), (float*)(ws + WS_BONUS), (bf16*)(ws + WS_GATE), (bf16*)(ws + WS_ZG));
    }
    SEAM(3); PROF_T1(3);
    PROF_T0(4); if (IN(4)) for (int rep_ = 0; rep_ < REPS(4); ++rep_) { if (rep_) __syncthreads(); F.lane = fresh_lane(); F.tid = F.wave * 64 + F.lane;
        for (int u = F.bid; u < 256; u += F.G) {
            if (u < 128) { rwkv_block(F, u, (const bf16*)(ws + WS_PR), (bf16*)(ws + WS_YRW));
#ifdef RWKV2X
                rwkv_block(F, u, (const bf16*)(ws + WS_PR), (bf16*)(ws + WS_YRW));
#endif
            }
            else { mamba_block(F, u - 128, (const bf16*)(ws + WS_PM), (const float*)(ws + WS_DT), KARG(25), (bf16*)(ws + WS_YMB));
#ifdef MAMBA2X
                   mamba_block(F, u - 128, (const bf16*)(ws + WS_PM), (const float*)(ws + WS_DT), KARG(25), (bf16*)(ws + WS_YMB));
#endif
            }
        }
    }
    SEAM(4); PROF_T1(4);
    PROF_T0(5); if (IN(5)) for (int rep_ = 0; rep_ < REPS(5); ++rep_) { if (rep_) __syncthreads(); F.lane = fresh_lane(); F.tid = F.wave * 64 + F.lane;
        FinIn P{KARG(20), KARG(21), KARG(26), KARG(27)};
        finish_phase(F, P, (const bf16*)(ws + WS_YRW), (const bf16*)(ws + WS_YMB), (const bf16*)(ws + WS_PR), (const bf16*)(ws + WS_PM), (const float*)(ws + WS_BONUS), (const bf16*)(ws + WS_GATE), (const bf16*)(ws + WS_ZG), A);
    }
    SEAM(5); PROF_T1(5);
    PROF_T0(6); if (IN(6)) for (int rep_ = 0; rep_ < REPS(6); ++rep_) { if (rep_) __syncthreads(); F.lane = fresh_lane(); F.tid = F.wave * 64 + F.lane;
        {
            pg8::Gemm g{A + (size_t)M_CTX * D, (const bf16*)(ws + WS_WOUT_T), M_LAT, D, D}; pg8::StaticOrder S; S.init(M_LAT, D, F.G, F.bid);
            if (F.G == 256) { pg8::EpiResGateNorm E{x, hlat, mods, 2048, KARG(7), 3072, 4096, (bf16*)(ws + WS_A2) + (size_t)M_CTX * D, (float*)(ws + WS_XBUF), (unsigned*)(F.ctl + CW_XCNT)};
                pg8::gemm_phase<pg8::EpiResGateNorm, pg8::StaticOrder, true, true>(F.lds, g, S, E); }
            else { pg8::EpiResGate E{x, x, hlat, hlat, mods, 2048, 0};
                pg8::gemm_phase<pg8::EpiResGate, pg8::StaticOrder, true, true>(F.lds, g, S, E); }
        }
        { int l_; asm volatile("v_mbcnt_lo_u32_b32 %0, -1, 0\n\tv_mbcnt_hi_u32_b32 %0, -1, %0" : "=v"(l_) :: "memory"); F.lane = l_; F.tid = F.wave * 64 + F.lane; }
        {
            pg8::Gemm g{A, (const bf16*)(ws + WS_WOUT_T), M_CTX, D, 256, D}; pg8::SplitKOrder S{8, 4, 4, 256, F.G, F.bid};
            pg8::EpiSlabGate E{(float*)(ws + WS_SLAB6), mods + 8 * 6144 + 2048, 256};
            pg8::gemm_phase<pg8::EpiSlabGate, pg8::SplitKOrder, true, true>(F.lds, g, S, E);
        }
        { const int nsub = 8 * 4 * 4; if (F.G > nsub && F.bid >= nsub) moe_weight_phase(F, KARG(36), KARG(37), KARG(38), ws, 0, MOE_ITEMS_P6, F.bid - nsub, F.G - nsub);
          else if (F.G <= nsub) moe_weight_phase(F, KARG(36), KARG(37), KARG(38), ws, 0, MOE_ITEMS_P6, F.bid, F.G); }
    }
    SEAM(6); PROF_T1(6);
    PROF_T0(7); if (IN(7)) for (int rep_ = 0; rep_ < REPS(7); ++rep_) { if (rep_) __syncthreads(); F.lane = fresh_lane(); F.tid = F.wave * 64 + F.lane; normmod_phase(F, ctx, hlat, KARG(7), mods, 3072, 4096, (bf16*)(ws + WS_A2), (const float*)(ws + WS_SLAB6), 4, hctx, F.G == 256 ? M_CTX : M_ALL); moe_weight_phase(F, KARG(36), KARG(37), KARG(38), ws, MOE_ITEMS_P6, MOE_ITEMS_P7, F.bid, F.G); }
    SEAM(7); PROF_T1(7);
    PROF_T0(8); if (IN(8)) for (int rep_ = 0; rep_ < REPS(8); ++rep_) { if (rep_) __syncthreads(); F.lane = fresh_lane(); F.tid = F.wave * 64 + F.lane;
        pg8::Gemm g{(const bf16*)(ws + WS_A2), (const bf16*)(ws + WS_W13_T), M_ALL, 2 * FF, D}; pg8::StaticOrder S; S.init(M_ALL, 2 * FF, F.G, F.bid);
        pg8::EpiSwiGLU E{(bf16*)(ws + WS_HID), FF, 1 << 20};
        pg8::gemm_phase<pg8::EpiSwiGLU, pg8::StaticOrder, true, true>(F.lds, g, S, E);
        {
            const int nfull = ((M_ALL / 256) * (2 * FF / 256)) % F.G;
            if (nfull != 0 && F.bid >= nfull) moe_weight_phase(F, KARG(36), KARG(37), KARG(38), ws, MOE_ITEMS_P7, MOE_ITEMS_P7 + MOE_ITEMS_P8, F.bid - nfull, F.G - nfull);
            else if (nfull == 0) moe_weight_phase(F, KARG(36), KARG(37), KARG(38), ws, MOE_ITEMS_P7, MOE_ITEMS_P7 + MOE_ITEMS_P8, F.bid, F.G);
        }
    }
    SEAM(8); PROF_T1(8);
    PROF_T0(9); if (IN(9)) for (int rep_ = 0; rep_ < REPS(9); ++rep_) { if (rep_) __syncthreads(); F.lane = fresh_lane(); F.tid = F.wave * 64 + F.lane;
        {
            pg8::Gemm g{(const bf16*)(ws + WS_HID) + (size_t)M_CTX * FF, (const bf16*)(ws + WS_W2_T), M_LAT, D, FF}; pg8::StaticOrder S; S.init(M_LAT, D, F.G, F.bid);
            if (F.G == 256) { pg8::EpiResGateNorm E{hlat, hlat, mods, 5120, KARG(6) + D, 0, 1024, A + (size_t)M_CTX * D, (float*)(ws + WS_XBUF) + 65536, (unsigned*)(F.ctl + CW_XCNT + 4096)};
                E.mods_l = mods; E.off_shift = 9 * 6144; E.off_scale = 9 * 6144 + 1024;
                pg8::gemm_phase<pg8::EpiResGateNorm, pg8::StaticOrder, true, true>(F.lds, g, S, E); }
            else { pg8::EpiResGate E{hlat, hlat, hlat, hlat, mods, 5120, 0};
                pg8::gemm_phase<pg8::EpiResGate, pg8::StaticOrder, true, true>(F.lds, g, S, E); }
        }
        { int l_; asm volatile("v_mbcnt_lo_u32_b32 %0, -1, 0\n\tv_mbcnt_hi_u32_b32 %0, -1, %0" : "=v"(l_) :: "memory"); F.lane = l_; F.tid = F.wave * 64 + F.lane; }
        {
            pg8::Gemm g{(const bf16*)(ws + WS_HID), (const bf16*)(ws + WS_W2_T), M_CTX, D, 1408, FF}; pg8::SplitKOrder S{8, 4, 2, 1408, F.G, F.bid};
            pg8::EpiSlabGate E{(float*)(ws + WS_SLAB9), mods + 8 * 6144 + 5120, 1408};
            pg8::gemm_phase<pg8::EpiSlabGate, pg8::SplitKOrder, true, true>(F.lds, g, S, E);
        }
        {
            const int nsub = 8 * 4 * 2;
            if (F.G > nsub) { if (F.bid >= nsub) moe_weight_phase(F, KARG(36), KARG(37), KARG(38), ws, MOE_ITEMS_P7 + MOE_ITEMS_P8, MOE_ITEMS_P7 + MOE_ITEMS_P8 + MOE_ITEMS_P9, F.bid - nsub, F.G - nsub); }
            else moe_weight_phase(F, KARG(36), KARG(37), KARG(38), ws, MOE_ITEMS_P7 + MOE_ITEMS_P8, MOE_ITEMS_P7 + MOE_ITEMS_P8 + MOE_ITEMS_P9, F.bid, F.G);
        }
    }
    SEAM(9); PROF_T1(9);
    const float* mods1 = mods + 9 * 6144;
    PROF_T0(10); if (IN(10)) for (int rep_ = 0; rep_ < REPS(10); ++rep_) { if (rep_) __syncthreads(); F.lane = fresh_lane(); F.tid = F.wave * 64 + F.lane; normmod_phase(F, hctx, hlat, KARG(6) + D, mods1, 0, 1024, A, (const float*)(ws + WS_SLAB9), 2, nullptr, F.G == 256 ? M_CTX : M_ALL); }
    SEAM(10); PROF_T1(10);
    PROF_T0(11); if (IN(11)) for (int rep_ = 0; rep_ < REPS(11); ++rep_) { if (rep_) __syncthreads(); F.lane = fresh_lane(); F.tid = F.wave * 64 + F.lane;
        pg8::Gemm g{A, (const bf16*)(ws + WS_QKV_T), M_ALL, 3 * D, D}; pg8::StaticOrder S; S.init(M_ALL, 3 * D, F.G, F.bid);
        pg8::EpiBf16<0> E{(bf16*)(ws + WS_Q), D, nullptr, D, (size_t)M_ALL * D, 0.125f * 1.4426950408889634f};
        pg8::gemm_phase<pg8::EpiBf16<0>, pg8::StaticOrder, true, true>(F.lds, g, S, E);
        {
            const int nfull = ((M_ALL / 256) * (3 * D / 256)) % F.G;
            if (nfull != 0 && F.bid >= nfull) moe_weight_phase(F, KARG(36), KARG(37), KARG(38), ws, MOE_ITEMS - MOE_ITEMS_P16 - MOE_ITEMS_P11, MOE_ITEMS - MOE_ITEMS_P16, F.bid - nfull, F.G - nfull);
            else if (nfull == 0) moe_weight_phase(F, KARG(36), KARG(37), KARG(38), ws, MOE_ITEMS - MOE_ITEMS_P16 - MOE_ITEMS_P11, MOE_ITEMS - MOE_ITEMS_P16, F.bid, F.G);
        }
    }
    SEAM(11); PROF_T1(11);
    PROF_T0(12); if (IN(12)) for (int rep_ = 0; rep_ < REPS(12); ++rep_) { if (rep_) __syncthreads(); F.lane = fresh_lane(); F.tid = F.wave * 64 + F.lane; attn_phase(F, (const bf16*)(ws + WS_Q), (const bf16*)(ws + WS_K), (const bf16*)(ws + WS_V), KARG(33), (bf16*)(ws + WS_O)); }
    SEAM(12); PROF_T1(12);
    PROF_T0(13); if (IN(13)) for (int rep_ = 0; rep_ < REPS(13); ++rep_) { if (rep_) __syncthreads(); F.lane = fresh_lane(); F.tid = F.wave * 64 + F.lane;
        pg8::Gemm g{(const bf16*)(ws + WS_O), (const bf16*)(ws + WS_NAO_T), M_LAT, D, D}; pg8::StaticOrder S; S.init(M_LAT, D, F.G, F.bid);
        if (F.G == 256) { pg8::EpiResGateNormT<true> E{hlat, hlat, mods1, 2048, KARG(7) + D, 3072, 4096, (bf16*)(ws + WS_A4), (float*)(ws + WS_XBUF) + 131072, (unsigned*)(F.ctl + CW_XCNT + 8192), KARG(34), (float*)(ws + WS_PLOG)};
            pg8::gemm_phase<pg8::EpiResGateNormT<true>, pg8::StaticOrder, true, true>(F.lds, g, S, E); }
        else { pg8::EpiResGate E{hlat, hlat, hlat, hlat, mods1, 2048, 0};
            pg8::gemm_phase<pg8::EpiResGate, pg8::StaticOrder, true, true>(F.lds, g, S, E); }
    }
    SEAM(13); PROF_T1(13);
    PROF_T0(14); if (IN(14)) for (int rep_ = 0; rep_ < REPS(14); ++rep_) { if (rep_) __syncthreads(); F.lane = fresh_lane(); F.tid = F.wave * 64 + F.lane; if (F.G == 256) router_phase<true>(F, hlat, KARG(7) + D, mods1, KARG(34), KARG(35), (bf16*)(ws + WS_A4), (unsigned*)(ws + WS_TOK), F.ctl + CW_CNTB, (const float*)(ws + WS_PLOG));
        else router_phase<false>(F, hlat, KARG(7) + D, mods1, KARG(34), KARG(35), (bf16*)(ws + WS_A4), (unsigned*)(ws + WS_TOK), F.ctl + CW_CNTB); }
    SEAM(14); PROF_T1(14);
    PROF_T0(15); if (IN(15)) for (int rep_ = 0; rep_ < REPS(15); ++rep_) { if (rep_) __syncthreads(); F.lane = fresh_lane(); F.tid = F.wave * 64 + F.lane; gather_phase(F, (const bf16*)(ws + WS_A4), (unsigned*)(ws + WS_TOK), F.ctl + CW_CNT, F.ctl + CW_CNTB, (bf16*)(ws + WS_XG)); }
    SEAM(15); PROF_T1(15);
    PROF_T0(16); if (IN(16)) for (int rep_ = 0; rep_ < REPS(16); ++rep_) { if (rep_) __syncthreads(); F.lane = fresh_lane(); F.tid = F.wave * 64 + F.lane;
        pg8::MoeOrder S; moe_bases(F.ctl + CW_CNT, S.tb); S.ntn = 22; S.G = F.G; S.c = vcu;
        pg8::Gemm g{(const bf16*)(ws + WS_XG), (const bf16*)(ws + WS_MOEW13), MOE_ROWS, NE * 2 * FF, D};
        pg8::EpiSwiGLU E{(bf16*)(ws + WS_HIDG), FF, 22};
        pg8::gemm_phase<pg8::EpiSwiGLU, pg8::MoeOrder, true, true>(F.lds, g, S, E);
        {
            const int nlast = (S.tb[8] * 22) % F.G;
            if (nlast != 0 && vcu >= nlast) moe_weight_phase(F, KARG(36), KARG(37), KARG(38), ws, MOE_ITEMS - MOE_ITEMS_P16, MOE_ITEMS, vcu - nlast, F.G - nlast);
            else if (nlast == 0) moe_weight_phase(F, KARG(36), KARG(37), KARG(38), ws, MOE_ITEMS - MOE_ITEMS_P16, MOE_ITEMS, F.bid, F.G);
        }
    }
    SEAM(16); PROF_T1(16);
    PROF_T0(17); if (IN(17)) for (int rep_ = 0; rep_ < REPS(17); ++rep_) { if (rep_) __syncthreads(); F.lane = fresh_lane(); F.tid = F.wave * 64 + F.lane;
        pg8::MoeOrder S; moe_bases(F.ctl + CW_CNT, S.tb); S.ntn = 4; S.G = F.G; S.c = vcu;
        int first, ntail; moe_tail_split(S.tb, F.G, first, ntail); S.limit = first;
        {
            pg8::Gemm g{(const bf16*)(ws + WS_HIDG), (const bf16*)(ws + WS_MOEW2), MOE_ROWS, NE * D, FF};
            pg8::EpiPlainMod E{(bf16*)(ws + WS_YG), D, 4};
            pg8::gemm_phase<pg8::EpiPlainMod, pg8::MoeOrder, true, true>(F.lds, g, S, E);
        }
#if MOE_TAIL_SPLIT
        if (ntail > 0) {
            pg8::MoeTailOrder ST;
#pragma unroll
            for (int k = 0; k < 9; ++k) ST.tb[k] = S.tb[k];
            ST.first = first; ST.ntail = ntail; ST.G = F.G; ST.c = vcu;
            pg8::Gemm g{(const bf16*)(ws + WS_HIDG), (const bf16*)(ws + WS_MOEW2), MOE_ROWS, NE * D, 256, FF};
            pg8::EpiTailSlab E{(float*)(ws + WS_TAIL), first, ntail};
            pg8::gemm_phase<pg8::EpiTailSlab, pg8::MoeTailOrder, true, true>(F.lds, g, ST, E);
        }
#endif
    }
    SEAM(17); PROF_T1(17);
    PROF_T0(18); if (IN(18)) for (int rep_ = 0; rep_ < REPS(18); ++rep_) { if (rep_) __syncthreads(); F.lane = fresh_lane(); F.tid = F.wave * 64 + F.lane; final_phase(F, hlat, (const bf16*)(ws + WS_YG), (const unsigned*)(ws + WS_TOK), mods1, KARG(8), (const float*)(ws + WS_TAIL), F.ctl + CW_CNT); }
#undef IN
#undef SEAM
}

extern "C" void kernel_launch(void* const* d_in, const int* in_sizes, int n_in, void* d_out, int out_size, void* d_ws, size_t ws_size, hipStream_t stream) {
    static int grid = 0;
    if (grid == 0) {
        if (n_in != 39 || out_size != M_LAT * D || ws_size < WS_END) { fprintf(stderr, "kernel_launch: unexpected shapes (n_in %d, out %d, ws %zu)\n", n_in, out_size, ws_size); grid = -1; return; }
        int dev = 0, cus = 0, per_cu = 0;
        if (hipGetDevice(&dev) != hipSuccess || hipDeviceGetAttribute(&cus, hipDeviceAttributeMultiprocessorCount, dev) != hipSuccess) { grid = -1; return; }
        if (hipFuncSetAttribute((const void*)mk_fwd, hipFuncAttributeMaxDynamicSharedMemorySize, LDS_BYTES) != hipSuccess) { fprintf(stderr, "kernel_launch: hipFuncSetAttribute failed\n"); grid = -1; return; }
        if (hipOccupancyMaxActiveBlocksPerMultiprocessor(&per_cu, (const void*)mk_fwd, NWAVES * 64, LDS_BYTES) != hipSuccess || per_cu < 1) fprintf(stderr, "kernel_launch: occupancy query says %d\n", per_cu);
        (void)hipGetLastError();
        grid = cus;
    }
    if (grid < 0) return;
    if (hipMemsetAsync((char*)d_ws + WS_CTL, 0, CTL_ZERO_BYTES, stream) != hipSuccess) return;
    Args a{};
    for (int i = 0; i < 39; ++i) a.in[i] = (const float*)d_in[i];
    a.out = (float*)d_out; a.ws = (unsigned char*)d_ws;
#if MK_PER_PHASE
    for (int p = 0; p < NPHASE; ++p) { a.ph_lo = p; a.ph_hi = p + 1; hipLaunchKernelGGL(mk_fwd, dim3(grid), dim3(NWAVES * 64), LDS_BYTES, stream, a); }
#else
    a.ph_lo = 0; a.ph_hi = NPHASE; hipLaunchKernelGGL(mk_fwd, dim3(grid), dim3(NWAVES * 64), LDS_BYTES, stream, a);
#endif
}
```

```cpp
#include <hip/hip_runtime.h>
#include <cstdio>
#include <cstdint>
#include <cmath>
#define MK_PER_PHASE 0
namespace pg8 {
#define PG8_LAS __attribute__((address_space(3)))
typedef unsigned short bf16_t;
typedef short bf16x8 __attribute__((ext_vector_type(8)));
typedef float f32x4 __attribute__((ext_vector_type(4)));
typedef unsigned u32x4 __attribute__((ext_vector_type(4)));
constexpr int BM = 256, BK = 64, HALF = 128, HTB = HALF * BK * 2  , STAGE_BYTES = 8 * HTB, NXCD = 8, WGM = 8;

__host__ __device__ __forceinline__ int lds_byte(int r, int c) { const int st = (r >> 4) * 2 + (c >> 5), rr = r & 15, cc = c & 31, ob = rr * 64 + cc * 2; return st * 1024 + (ob ^ (((ob >> 9) & 1) << 5)); }
__host__ __device__ __forceinline__ void stage_rc(int b, int& R, int& C) { const int st = b / 1024, sb = b % 1024, swz = sb ^ (((sb >> 9) & 1) << 5); R = (st >> 1) * 16 + swz / 64; C = (st & 1) * 32 + (swz % 64) / 2; }
__host__ __device__ __forceinline__ int perm32(int rho) { const int n = rho >> 4, i = rho & 15; return 8 * (i >> 2) + 4 * n + (i & 3); }

#ifndef PG8_WT
#define PG8_WT 0
#endif
#if PG8_WT
#define PG8_ST16(base_, ptr_, v_) __builtin_amdgcn_raw_buffer_store_b128((v_), __builtin_amdgcn_make_buffer_rsrc((void*)(base_), (short)0, 0x7fffffff, 0x00020000), (int)((const char*)(ptr_) - (const char*)(base_)), 0, 16)
#else
#define PG8_ST16(base_, ptr_, v_) (*(u32x4*)(ptr_) = (v_))
#endif
struct Unit { int pm, pn; int k0 = 0; };
struct Gemm { const bf16_t* A; const bf16_t* Bt; int M, N, K; int ld = 0; };

struct StaticOrder {
    int nM, nN, nwg, G, c;
    __host__ __device__ void init(int M, int N, int G_, int c_) { nM = M / BM; nN = N / BM; nwg = nM * nN; G = G_; c = c_; }
    __host__ __device__ bool next(int i, Unit& u) const {
        const long L = (long)i * G + c; if (L >= nwg) return false;
        int wgid = (int)L; { const int q = nwg / NXCD, r = nwg % NXCD, xcd = wgid % NXCD, off = wgid / NXCD; wgid = (xcd < r ? xcd * (q + 1) : r * (q + 1) + (xcd - r) * q) + off; }
        const int nig = WGM * nN, gid = wgid / nig, fm = gid * WGM, gsz = (nM - fm) < WGM ? (nM - fm) : WGM;
        u.pm = fm + ((wgid % nig) % gsz); u.pn = (wgid % nig) / gsz; return true;
    }
    __device__ __forceinline__ void a_ready(const Unit&) const {}
    __device__ __forceinline__ void done(const Unit&) const {}
};

__device__ __forceinline__ unsigned cvt_pk_bf16(float lo, float hi) { unsigned r; asm volatile("v_cvt_pk_bf16_f32 %0, %1, %2" : "=v"(r) : "v"(lo), "v"(hi)); return r; }
typedef float f32x2 __attribute__((ext_vector_type(2)));
__device__ __forceinline__ f32x2 gelu_pk(f32x2 v) {
    const f32x2 av = __builtin_elementwise_abs(v), d = av * 0.2316418882f + 1.0f;
    f32x2 t; t.x = __builtin_amdgcn_rcpf(d.x); t.y = __builtin_amdgcn_rcpf(d.y);
    f32x2 q = t * 0.5307027145f + (-0.7265760135f); q = q * t + 0.7107068705f; q = q * t + (-0.142248368f); q = q * t + 0.127414796f; q = q * t;
    const f32x2 s = (v * v) * (-0.72134752044f);
    f32x2 e; e.x = __builtin_amdgcn_exp2f(s.x); e.y = __builtin_amdgcn_exp2f(s.y);
    const f32x2 m = v * (q * e), r = v - m;
    f32x2 o; o.x = v.x < 0.f ? m.x : r.x; o.y = v.y < 0.f ? m.y : r.y; return o;
}

template <int ACT  > struct EpiBf16 {
    static constexpr bool PERM = true, AFTER_DRAIN = false; static_assert(ACT == 0 || ACT == 1, "EpiBf16: ACT is 0 (none) or 1 (gelu_pk)");
    bf16_t* O; int ldc; const float* bias; int split_cols; size_t split_stride; float scale0;
    __device__ __forceinline__ void operator()(const f32x4 (&acc)[2][2][4][2], const Unit& u, int wr, int wc, int fr, int fq) const {
        const int row0 = u.pm * BM + wr * 64 + fr; int colt = u.pn * BM; bf16_t* base = O;
        float sc = 1.f; if (split_cols) { const int t = colt / split_cols; base += (size_t)t * split_stride; colt -= t * split_cols; if (t == 0) sc = scale0; }
        const int col0 = colt + wc * 32 + 8 * fq, bcol0 = u.pn * BM + wc * 32 + 8 * fq;
        f32x4 bv[2][2];
#pragma unroll
        for (int bj = 0; bj < 2; ++bj)
#pragma unroll
            for (int n = 0; n < 2; ++n) bv[bj][n] = bias ? *(const f32x4*)(bias + bcol0 + bj * HALF + 4 * n) : (f32x4){0.f, 0.f, 0.f, 0.f};
#pragma unroll
        for (int ai = 0; ai < 2; ++ai)
#pragma unroll
            for (int m = 0; m < 4; ++m) { bf16_t* rowp = base + (size_t)(row0 + ai * HALF + m * 16) * ldc + col0;
#pragma unroll
                for (int bj = 0; bj < 2; ++bj) { f32x4 v0 = acc[ai][bj][m][0] + bv[bj][0], v1 = acc[ai][bj][m][1] + bv[bj][1];
                    if (ACT == 1) { f32x2 a = gelu_pk((f32x2){v0[0], v0[1]}), b = gelu_pk((f32x2){v0[2], v0[3]}), c = gelu_pk((f32x2){v1[0], v1[1]}), d = gelu_pk((f32x2){v1[2], v1[3]});
                        v0 = (f32x4){a.x, a.y, b.x, b.y}; v1 = (f32x4){c.x, c.y, d.x, d.y}; }
                    v0 = v0 * sc; v1 = v1 * sc; u32x4 w; w.x = cvt_pk_bf16(v0[0], v0[1]); w.y = cvt_pk_bf16(v0[2], v0[3]); w.z = cvt_pk_bf16(v1[0], v1[1]); w.w = cvt_pk_bf16(v1[2], v1[3]);
                    PG8_ST16(base, rowp + bj * HALF, w); } }
    }
};
template <class Epi, class Sched, bool ALIGN_EPI = false, bool SP2 = false>
__device__ __forceinline__ void gemm_phase(PG8_LAS unsigned char* lds, const Gemm g, const Sched& S, const Epi& E) {
    int tid_ = threadIdx.x; asm volatile("" : "+v"(tid_) :: "memory");
    const int tid = tid_, wid = __builtin_amdgcn_readfirstlane(tid >> 6), lane = tid & 63, wr = wid >> 2, wc = wid & 3, fr = lane & 15, fq = lane >> 4;
    const int K = g.K, nt = K / BK, LD = g.ld ? g.ld : g.K;
    unsigned voffA[2], voffB[2];
#pragma unroll
    for (int i = 0; i < 2; ++i) { int R, C; stage_rc(tid * 16 + i * 8192, R, C); const int Rb = Epi::PERM ? ((R & ~31) + perm32(R & 31)) : R;
        voffA[i] = (unsigned)(R * LD + C) * 2u; voffB[i] = (unsigned)(Rb * LD + C) * 2u; }
    const size_t kstep = (size_t)(BK * 2);
    const size_t hstep = (size_t)HALF * LD * 2;
    const size_t tstep = 2 * hstep;
    const unsigned ldsw = (unsigned)wid * 1024u;
    const int aoff = lds_byte(wr * 64 + fr, fq * 8), boff = lds_byte(wc * 32 + fr, fq * 8);
#define PG8_SA(b, h) (((b) * 2 + (h)) * HTB)
#define PG8_SB(b, h) ((4 + (b) * 2 + (h)) * HTB)
#define PG8_STAGE(bufoff, gbase, voff) do { _Pragma("unroll") for (int _i = 0; _i < 2; ++_i) \
        __builtin_amdgcn_global_load_lds((const unsigned*)((const char*)(gbase) + (voff)[_i]), (PG8_LAS unsigned*)(lds + (bufoff) + ldsw + _i * 8192), 16, 0, 0); } while (0)
#define PG8_LDA(dst, b, h) do { _Pragma("unroll") for (int m = 0; m < 4; ++m) _Pragma("unroll") for (int k = 0; k < 2; ++k) dst[m][k] = *(const PG8_LAS bf16x8*)(lds + PG8_SA(b, h) + aoff + m * 2048 + k * 1024); } while (0)
#define PG8_LDB(dst, b, h) do { _Pragma("unroll") for (int n = 0; n < 2; ++n) _Pragma("unroll") for (int k = 0; k < 2; ++k) dst[n][k] = *(const PG8_LAS bf16x8*)(lds + PG8_SB(b, h) + boff + n * 2048 + k * 1024); } while (0)
#define PG8_MMA(ai, bj, At, Bt) do { __builtin_amdgcn_s_setprio(1); _Pragma("unroll") for (int m = 0; m < 4; ++m) _Pragma("unroll") for (int n = 0; n < 2; ++n) _Pragma("unroll") for (int k = 0; k < 2; ++k) \
        acc[ai][bj][m][n] = __builtin_amdgcn_mfma_f32_16x16x32_bf16(Bt[n][k], At[m][k], acc[ai][bj][m][n], 0, 0, 0); __builtin_amdgcn_s_setprio(0); } while (0)
#define PG8_WAIT_V(n) asm volatile("s_waitcnt vmcnt(" #n ")" ::: "memory")
#define PG8_WAIT_L(n) asm volatile("s_waitcnt lgkmcnt(" #n ")" ::: "memory")
#define PG8_BAR __builtin_amdgcn_s_barrier()
#define PG8_SCHED __builtin_amdgcn_sched_barrier(0)
    Unit cur, nxt; int ui = 0;
    if (!S.next(0, cur)) return;
    f32x4 acc[2][2][4][2];
#pragma unroll
    for (int a = 0; a < 2; ++a)
#pragma unroll
        for (int b = 0; b < 2; ++b)
#pragma unroll
            for (int m = 0; m < 4; ++m)
#pragma unroll
                for (int n = 0; n < 2; ++n) acc[a][b][m][n] = (f32x4){0.f, 0.f, 0.f, 0.f};
    bf16x8 At[4][2], B0[2][2], B1[2][2];
    const char* cA = (const char*)g.A + (size_t)cur.pm * tstep + (size_t)cur.k0 * 2; const char* cB = (const char*)g.Bt + (size_t)cur.pn * tstep + (size_t)cur.k0 * 2;
    S.a_ready(cur);
    if constexpr (SP2) {
        PG8_STAGE(PG8_SB(0, 0), cB, voffB); PG8_STAGE(PG8_SB(0, 1), cB + hstep, voffB); PG8_STAGE(PG8_SA(0, 0), cA, voffA); PG8_STAGE(PG8_SA(0, 1), cA + hstep, voffA);
        if (wr == 1) PG8_BAR;
        PG8_WAIT_V(2); PG8_BAR;
        PG8_STAGE(PG8_SB(1, 0), cB + kstep, voffB); PG8_STAGE(PG8_SA(1, 0), cA + kstep, voffA); PG8_STAGE(PG8_SB(1, 1), cB + hstep + kstep, voffB);
        PG8_WAIT_V(6); PG8_BAR;
    } else {
        PG8_STAGE(PG8_SB(0, 0), cB, voffB); PG8_STAGE(PG8_SA(0, 0), cA, voffA); PG8_STAGE(PG8_SB(0, 1), cB + hstep, voffB); PG8_STAGE(PG8_SA(0, 1), cA + hstep, voffA);
        if (wr == 1) PG8_BAR;
        PG8_WAIT_V(4); PG8_BAR;
        PG8_STAGE(PG8_SB(1, 0), cB + kstep, voffB); PG8_STAGE(PG8_SA(1, 0), cA + kstep, voffA); PG8_STAGE(PG8_SB(1, 1), cB + hstep + kstep, voffB);
        PG8_WAIT_V(6); PG8_BAR;
    }
    for (;;) {
        const bool has_next = S.next(ui + 1, nxt);
        const char* nA = has_next ? (const char*)g.A + (size_t)nxt.pm * tstep + (size_t)nxt.k0 * 2 : cA; const char* nB = has_next ? (const char*)g.Bt + (size_t)nxt.pn * tstep + (size_t)nxt.k0 * 2 : cB;
        for (int t = 0; t < nt; t += 2) {
            const bool last = (t == nt - 2);
            const char* a1 = cA + (size_t)(t + 1) * kstep;
            const char* a2 = last ? nA : cA + (size_t)(t + 2) * kstep; const char* b2 = last ? nB : cB + (size_t)(t + 2) * kstep;
            const char* a3 = a2 + kstep; const char* b3 = b2 + kstep;
            if (last && has_next) S.a_ready(nxt);
            if constexpr (SP2) {
            PG8_LDB(B0, 0, 0); PG8_LDB(B1, 0, 1); PG8_SCHED; PG8_LDA(At, 0, 0); PG8_STAGE(PG8_SA(1, 1), a1 + hstep, voffA);
            PG8_WAIT_V(8); PG8_WAIT_L(0); PG8_BAR; PG8_MMA(0, 0, At, B0); PG8_MMA(0, 1, At, B1); PG8_BAR; PG8_SCHED;
            PG8_LDA(At, 0, 1); PG8_STAGE(PG8_SB(0, 0), b2, voffB); PG8_STAGE(PG8_SB(0, 1), b2 + hstep, voffB); PG8_STAGE(PG8_SA(0, 0), a2, voffA);
            PG8_WAIT_V(8); PG8_WAIT_L(0); PG8_BAR; PG8_MMA(1, 0, At, B0); PG8_MMA(1, 1, At, B1); PG8_BAR; PG8_SCHED;
            PG8_LDB(B0, 1, 0); PG8_LDB(B1, 1, 1); PG8_SCHED; PG8_LDA(At, 1, 0); PG8_STAGE(PG8_SA(0, 1), a2 + hstep, voffA);
            PG8_WAIT_V(8); PG8_WAIT_L(0); PG8_BAR; PG8_MMA(0, 0, At, B0); PG8_MMA(0, 1, At, B1); PG8_BAR; PG8_SCHED;
            PG8_LDA(At, 1, 1); PG8_STAGE(PG8_SB(1, 0), b3, voffB); PG8_STAGE(PG8_SB(1, 1), b3 + hstep, voffB); PG8_STAGE(PG8_SA(1, 0), a3, voffA);
            PG8_WAIT_V(8); PG8_WAIT_L(0); PG8_BAR; PG8_MMA(1, 0, At, B0); PG8_MMA(1, 1, At, B1); PG8_BAR; PG8_SCHED;
            } else {
            PG8_LDB(B0, 0, 0); PG8_SCHED; PG8_LDA(At, 0, 0); PG8_STAGE(PG8_SA(1, 1), a1 + hstep, voffA);
            PG8_WAIT_L(8); PG8_BAR; PG8_WAIT_L(0); PG8_MMA(0, 0, At, B0); PG8_BAR; PG8_SCHED;
            PG8_LDB(B1, 0, 1); PG8_STAGE(PG8_SB(0, 0), b2, voffB);
            PG8_BAR; PG8_WAIT_L(0); PG8_MMA(0, 1, At, B1); PG8_BAR;
            PG8_LDA(At, 0, 1); PG8_STAGE(PG8_SA(0, 0), a2, voffA);
            PG8_BAR; PG8_WAIT_L(0); PG8_MMA(1, 0, At, B0); PG8_BAR; PG8_SCHED;
            PG8_STAGE(PG8_SB(0, 1), b2 + hstep, voffB);
            PG8_WAIT_V(6); PG8_BAR; PG8_MMA(1, 1, At, B1); PG8_BAR;
            PG8_LDB(B0, 1, 0); PG8_SCHED; PG8_LDA(At, 1, 0); PG8_STAGE(PG8_SA(0, 1), a2 + hstep, voffA);
            PG8_WAIT_L(8); PG8_BAR; PG8_WAIT_L(0); PG8_MMA(0, 0, At, B0); PG8_BAR; PG8_SCHED;
            PG8_LDB(B1, 1, 1); PG8_STAGE(PG8_SB(1, 0), b3, voffB);
            PG8_BAR; PG8_WAIT_L(0); PG8_MMA(0, 1, At, B1); PG8_BAR;
            PG8_LDA(At, 1, 1); PG8_STAGE(PG8_SA(1, 0), a3, voffA);
            PG8_BAR; PG8_WAIT_L(0); PG8_MMA(1, 0, At, B0); PG8_BAR; PG8_SCHED;
            PG8_STAGE(PG8_SB(1, 1), b3 + hstep, voffB);
            PG8_WAIT_V(6); PG8_BAR; PG8_MMA(1, 1, At, B1); PG8_BAR;
            }
        }
        if constexpr (ALIGN_EPI) { if (wr == 0) PG8_BAR; }
        if constexpr (!Epi::AFTER_DRAIN) { E(acc, cur, wr, wc, fr, fq); S.done(cur); }
        if (!has_next) break;
#pragma unroll
        for (int a = 0; a < 2; ++a)
#pragma unroll
            for (int b = 0; b < 2; ++b)
#pragma unroll
                for (int m = 0; m < 4; ++m)
#pragma unroll
                    for (int n = 0; n < 2; ++n) acc[a][b][m][n] = (f32x4){0.f, 0.f, 0.f, 0.f};
        cur = nxt; cA = nA; cB = nB; ++ui;
        if constexpr (ALIGN_EPI) { if (wr == 1) PG8_BAR; }
    }
    PG8_WAIT_V(0);
    if constexpr (!ALIGN_EPI) { if (wr == 0) PG8_BAR; }
    PG8_BAR;
    if constexpr (Epi::AFTER_DRAIN) { E.fused(acc, cur, wr, wc, fr, fq, lds, wid, lane); S.done(cur); }
#undef PG8_SA
#undef PG8_SB
#undef PG8_STAGE
#undef PG8_LDA
#undef PG8_LDB
#undef PG8_MMA
#undef PG8_WAIT_V
#undef PG8_WAIT_L
#undef PG8_BAR
#undef PG8_SCHED
}
}

#define GAS __attribute__((address_space(1)))
#define LAS __attribute__((address_space(3)))
typedef unsigned short bf16;
typedef unsigned v4u __attribute__((ext_vector_type(4)));
typedef float f32x4 __attribute__((ext_vector_type(4)));
typedef short bf16x8 __attribute__((ext_vector_type(8)));
typedef GAS unsigned gu32;
typedef GAS unsigned long long gu64;
#define RLX_AGENT __ATOMIC_RELAXED, __HIP_MEMORY_SCOPE_AGENT
#define LDS_WAIT() asm volatile("s_waitcnt lgkmcnt(0)" ::: "memory")
#define VM_WAIT() asm volatile("s_waitcnt vmcnt(0)" ::: "memory")
__device__ __forceinline__ unsigned long long rt() { return __builtin_amdgcn_s_memrealtime(); }
typedef float f32x2_t __attribute__((ext_vector_type(2))); typedef __bf16 bf16x2_t __attribute__((ext_vector_type(2)));
__device__ __forceinline__ unsigned pk2(float lo, float hi) { const f32x2_t v = {lo, hi}; const bf16x2_t b = __builtin_convertvector(v, bf16x2_t); return __builtin_bit_cast(unsigned, b); }
__device__ __forceinline__ unsigned f2bf(float f) { return pk2(f, f) & 0xffffu; }
#define XB_TMO      128
#define XB_XCNT(j)  (256  + 64 * (j))
#define XB_XSUB(j)  (1280 + 64 * (j))
#define XB_XGEN(j)  (2304 + 64 * (j))
#define XB_TOP      3328
#define XB_TOPGEN   3392
#define XCD_BAR_WORDS 3456
#define XB_SPIN_CAP (1u << 18)

__device__ __forceinline__ unsigned xb_ld(unsigned* p)              { return __hip_atomic_load(p, __ATOMIC_RELAXED, __HIP_MEMORY_SCOPE_AGENT); }
__device__ __forceinline__ unsigned xb_add(unsigned* p, unsigned v) { return __hip_atomic_fetch_add(p, v, __ATOMIC_RELAXED, __HIP_MEMORY_SCOPE_AGENT); }
__device__ __forceinline__ unsigned xb_xcc_id() { return (unsigned)__builtin_amdgcn_s_getreg((3 << 11) | 20) & 0xFu; }
#define XB_SPIN(cond, bar) do { unsigned _sp = 0; while (cond) { __builtin_amdgcn_s_sleep(1); \
    if ((++_sp & 255u) == 0u) { if (xb_ld(&(bar)[XB_TMO])) break; if (_sp > XB_SPIN_CAP) { atomicAdd(&(bar)[XB_TMO], 1u); break; } } } } while (0)

struct XcdBarrier {
    unsigned* bar; unsigned x;
    volatile LAS unsigned* st;
};

__device__ __forceinline__ XcdBarrier xcd_barrier_post(unsigned* bar, volatile LAS unsigned* st) {
    XcdBarrier b; b.bar = bar; b.x = xb_xcc_id(); b.st = st;
    if (threadIdx.x == 0) (void)xb_add(&bar[XB_XCNT(b.x)], 1u);
    return b;
}
__device__ __forceinline__ void xcd_barrier_complete(unsigned* bar, unsigned x, unsigned& nloc, unsigned& nx) {
    const unsigned G = gridDim.x * gridDim.y * gridDim.z;
    unsigned sum, cnt, mine, sp = 0u;
    for (;;) {
        sum = 0u; cnt = 0u; mine = 0u;
#pragma unroll
        for (unsigned j = 0; j < 16; ++j) { const unsigned c = xb_ld(&bar[XB_XCNT(j)]); sum += c; cnt += (c > 0u) ? 1u : 0u; mine = (j == x) ? c : mine; }
        if (sum == G) break;
        __builtin_amdgcn_s_sleep(1);
        if ((++sp & 255u) == 0u) { if (xb_ld(&bar[XB_TMO])) break; if (sp > XB_SPIN_CAP) { atomicAdd(&bar[XB_TMO], 1u); break; } }
    }
    nloc = mine > 0u ? mine : 1u; nx = cnt > 0u ? cnt : 1u;
}

__device__ __forceinline__ void xcd_barrier(const XcdBarrier& b) {
    asm volatile("s_waitcnt vmcnt(0)" ::: "memory");
    __syncthreads();
    if (threadIdx.x == 0) {
        unsigned* bar = b.bar;
        __builtin_amdgcn_s_waitcnt(0);
        unsigned nloc = b.st[0], nx = b.st[1];
        if (nloc == 0u) { xcd_barrier_complete(bar, b.x, nloc, nx); b.st[0] = nloc; b.st[1] = nx; }
        const unsigned old = xb_add(&bar[XB_XSUB(b.x)], 1u);
        const unsigned gen = old / nloc;
        if (old + 1u == (gen + 1u) * nloc) {
            __builtin_amdgcn_fence(__ATOMIC_RELEASE, "agent");
            asm volatile("s_waitcnt vmcnt(0)" ::: "memory");
            const unsigned og = xb_add(&bar[XB_TOP], 1u);
            const unsigned tg = og / nx;
            if (og + 1u == (tg + 1u) * nx) xb_add(&bar[XB_TOPGEN], 1u);
            else XB_SPIN(xb_ld(&bar[XB_TOPGEN]) == tg, bar);
            __builtin_amdgcn_fence(__ATOMIC_ACQUIRE, "agent");
            xb_add(&bar[XB_XGEN(b.x)], 1u);
            asm volatile("s_waitcnt vmcnt(0)" ::: "memory");
        } else {
            XB_SPIN(xb_ld(&bar[XB_XGEN(b.x)]) == gen, bar);
            __builtin_amdgcn_fence(__ATOMIC_ACQUIRE, "agent");
            asm volatile("s_waitcnt vmcnt(0)" ::: "memory");
        }
    }
    __syncthreads();
}


constexpr int NWAVES = 8, NTHR = 512;
constexpr int D = 1024, NB = 8, SEQ = 2048, CTXL = 256;
constexpr int M_CTX = NB * CTXL, M_LAT = NB * SEQ, M_ALL = M_CTX + M_LAT;
constexpr int RWC = 1760, MIXIN = 3312, ZLD = 3328, FF = 2816, NE = 8;
constexpr int PRV = 9 * 512;
constexpr int MOE_ROWS = 34816;
constexpr size_t MiB = 1u << 20;
constexpr size_t WS_CTL = 0, CTL_ZERO_BYTES = 1 * MiB;
constexpr size_t WS_MODS = 1 * MiB;
constexpr size_t WS_TOK = 1 * MiB + 512 * 1024;
constexpr size_t WS_WIN_T = 2 * MiB;
constexpr size_t WS_WOUT_T = WS_WIN_T + (size_t)ZLD * D * 2;
constexpr size_t WS_W13_T = WS_WOUT_T + 2 * MiB;
constexpr size_t WS_W2_T = WS_W13_T + 11 * MiB;
constexpr size_t WS_QKV_T = WS_W2_T + (size_t)D * FF * 2;
constexpr size_t WS_NAO_T = WS_QKV_T + 6 * MiB;
constexpr size_t WS_HCTX = 35 * MiB;
constexpr size_t WS_A = 43 * MiB;
constexpr size_t WS_R = 79 * MiB;
constexpr size_t WS_Z = WS_R;
constexpr size_t WS_PR = 196 * MiB;
constexpr size_t WS_PM = 358 * MiB;
constexpr size_t WS_DT = 394 * MiB;
constexpr size_t WS_BONUS = 395 * MiB + 256 * 1024;
constexpr size_t WS_GATE = 396 * MiB;
constexpr size_t WS_ZG = 414 * MiB;
constexpr size_t WS_YRW = WS_R;
constexpr size_t WS_YMB = WS_R + 36 * MiB;
constexpr size_t WS_HID = WS_R;
constexpr size_t WS_MOEW13 = 316 * MiB;
constexpr size_t WS_MOEW2 = 404 * MiB;
constexpr size_t WS_Q = WS_R, WS_K = WS_R + 36 * MiB, WS_V = WS_R + 72 * MiB;
constexpr size_t WS_O = WS_R + 108 * MiB;
constexpr size_t WS_A4 = 111 * MiB;
constexpr size_t WS_XG = 43 * MiB;
constexpr size_t WS_HIDG = 111 * MiB;
constexpr size_t WS_YG = 43 * MiB;
constexpr size_t WS_SLAB6 = WS_R;
constexpr size_t WS_SLAB9 = WS_R + 99 * MiB;
constexpr size_t WS_TAIL = 316 * MiB;
constexpr size_t WS_A2 = 196 * MiB;
constexpr size_t WS_XBUF = 300 * MiB;
constexpr size_t WS_PLOG = 301 * MiB;
constexpr size_t WS_END = 448 * MiB;
static_assert(WS_NAO_T + 2 * MiB <= WS_HCTX && WS_ZG + 18 * MiB <= WS_END && WS_MOEW2 + 44 * MiB <= WS_END && WS_HIDG + (size_t)MOE_ROWS * FF * 2 <= WS_MOEW13, "ws map");
static_assert(WS_Z + (size_t)M_ALL * ZLD * 2 <= WS_PR && WS_PR + (size_t)M_ALL * PRV * 2 <= WS_PM && WS_XG + (size_t)MOE_ROWS * D * 2 <= WS_HIDG, "ws map 2");
constexpr int CW_TMO = 0, CW_CODE = 1, CW_BAR = 4096, CW_CNT = 8192, CW_CNTB = 16384, CW_XCNT = 131072;
constexpr int RING_BYTES = 131072, LDSCTL_OFF = 145408, MISC_OFF = LDSCTL_OFF + 320, LDS_BYTES = 147456;

typedef unsigned v2u __attribute__((ext_vector_type(2)));
typedef float v2f __attribute__((ext_vector_type(2)));
typedef short s16x4 __attribute__((ext_vector_type(4)));
typedef short v4i16_t __attribute__((ext_vector_type(4)));
__device__ __forceinline__ float bflo(unsigned u) { return __uint_as_float(u << 16); }
__device__ __forceinline__ float bfhi(unsigned u) { return __uint_as_float(u & 0xffff0000u); }
__device__ __forceinline__ float ldbf(const bf16* p) { return __uint_as_float((unsigned)(*p) << 16); }
__device__ __forceinline__ float sigm(float x) { return __builtin_amdgcn_rcpf(1.f + __expf(-x)); }
__device__ __forceinline__ bf16x8 pack8(const f32x4& a, const f32x4& b) {
    v4u w; w.x = pk2(a[0], a[1]); w.y = pk2(a[2], a[3]); w.z = pk2(b[0], b[1]); w.w = pk2(b[2], b[3]); return __builtin_bit_cast(bf16x8, w);
}
template <int CTRL> __device__ __forceinline__ float dppf(float x) { return __int_as_float(__builtin_amdgcn_update_dpp(0, __float_as_int(x), CTRL, 0xF, 0xF, true)); }
__device__ __forceinline__ float sum8(float x) { x += dppf<0xB1>(x); x += dppf<0x4E>(x); x += dppf<0x141>(x); return x; }
__device__ __forceinline__ float sum16(float x) { x = sum8(x); x += dppf<0x140>(x); return x; }
__device__ __forceinline__ float rlf(float v, int l) { return __int_as_float(__builtin_amdgcn_readlane(__float_as_int(v), l)); }
__device__ __forceinline__ float wave_sum(float v) { v = sum16(v); return (rlf(v, 0) + rlf(v, 16)) + (rlf(v, 32) + rlf(v, 48)); }
__device__ __forceinline__ float half_sum(float v, int lane) { v = sum16(v); const float lo = rlf(v, 0) + rlf(v, 16), hi = rlf(v, 32) + rlf(v, 48); return lane < 32 ? lo : hi; }

struct Frame {
    LAS unsigned char* lds;
    volatile LAS unsigned* MISC;
    gu32* ctl;
    int tid, lane, wave, G, bid;
};

__device__ __forceinline__ void tr_item(const float* W, int K, int N, bf16* WT, int drow0, int k0, int n0, LAS float* scr, int lane) {
    const int nn = n0 + (lane & 31);
    float t[32];
#pragma unroll
    for (int i = 0; i < 32; ++i) { const int kk = 2 * i + (lane >> 5); t[i] = (nn < N) ? W[(size_t)(k0 + kk) * N + nn] : 0.f; }
#pragma unroll
    for (int i = 0; i < 32; ++i) { const int kk = 2 * i + (lane >> 5); scr[kk * 33 + (lane & 31)] = t[i]; }
    LDS_WAIT(); asm volatile("" ::: "memory");
    const int c = lane & 7;
#pragma unroll
    for (int j = 0; j < 4; ++j) { const int n = (lane >> 3) + 8 * j; const LAS float* s = scr + (8 * c) * 33 + n;
        v4u o; o.x = pk2(s[0 * 33], s[1 * 33]); o.y = pk2(s[2 * 33], s[3 * 33]); o.z = pk2(s[4 * 33], s[5 * 33]); o.w = pk2(s[6 * 33], s[7 * 33]);
        *(GAS v4u*)(WT + (size_t)(drow0 + n) * K + k0 + 8 * c) = o; }
    LDS_WAIT(); asm volatile("" ::: "memory");
}
template <int MODE  >
__device__ __forceinline__ bool tr_matrix(int& it, const float* W, int K, int N, bf16* WT, LAS float* scr, int lane) {
    const int nblk = (N + 31) / 32, items = (K / 64) * nblk;
    if (it >= items) { it -= items; return false; }
    const int kb = it / nblk, nb = it % nblk, n0 = nb * 32;
    int drow0 = n0;
    if (MODE == 1) drow0 = (n0 >> 7) * 256 + (n0 & 127);
    if (MODE == 2) drow0 = (n0 >> 7) * 256 + 128 + (n0 & 127);
    tr_item(W, K, N, WT, drow0, kb * 64, n0, scr, lane);
    return true;
}

constexpr int DW_P0_END = 16 * 104, DW_P2_END = DW_P0_END + 512 + 1600, DW_P6_END = DW_P0_END + 512 + 2816, DW_P8_END = DW_P6_END + 1408, DW_P9_END = DW_P8_END + 1536, DW_END = DW_P9_END + 512;
__device__ __forceinline__ void dense_weight_phase(Frame& F, const float* mix_w_in, const float* mix_w_out, const float* ffn_w1, const float* ffn_w3, const float* ffn_w2,
                                                   const float* na_w_qkv, const float* na_w_out, unsigned char* ws, int lo, int hi, int widx, int nw);
__device__ __forceinline__ void p0_phase(Frame& F, const float* c, const float* c_ctx, const float* w_ada, const float* b_ada, float* mods,
                                         const float* mix_w_in, const float* mix_w_out, const float* ffn_w1, const float* ffn_w3, const float* ffn_w2,
                                         const float* na_w_qkv, const float* na_w_out, unsigned char* ws) {
    for (int u = F.bid; u < 192; u += F.G) {
        LAS float* sc = (LAS float*)(F.lds);
        LAS float* red = (LAS float*)(F.lds + 36864);
        for (int i = F.tid; i < 9 * 1024; i += NTHR) { const int b = i >> 10, k = i & 1023; const float v = (b < 8) ? c[b * 1024 + k] : c_ctx[k]; sc[i] = v / (1.f + __expf(-v)); }
        __syncthreads();
        const int layer = u / 96, col = (u % 96) * 64 + F.lane;
        const float* W = w_ada + (size_t)layer * 1024 * 6144 + col;
        float acc[9];
#pragma unroll
        for (int b = 0; b < 9; ++b) acc[b] = 0.f;
        const int k0 = F.wave * 128;
#pragma unroll 8
        for (int k = 0; k < 128; ++k) { const float w = W[(size_t)(k0 + k) * 6144];
#pragma unroll
            for (int b = 0; b < 9; ++b) acc[b] += sc[b * 1024 + k0 + k] * w; }
#pragma unroll
        for (int b = 0; b < 9; ++b) red[(F.wave * 9 + b) * 64 + F.lane] = acc[b];
        __syncthreads();
        if (F.wave == 0) {
#pragma unroll
            for (int b = 0; b < 9; ++b) { float s = 0.f;
#pragma unroll
                for (int w = 0; w < 8; ++w) s += red[(w * 9 + b) * 64 + F.lane];
                mods[(layer * 9 + b) * 6144 + col] = s + b_ada[layer * 6144 + col]; }
        }
        __syncthreads();
    }
    dense_weight_phase(F, mix_w_in, mix_w_out, ffn_w1, ffn_w3, ffn_w2, na_w_qkv, na_w_out, ws, 0, DW_P0_END, F.bid, F.G);
}
__device__ __forceinline__ void dense_weight_phase(Frame& F, const float* mix_w_in, const float* mix_w_out, const float* ffn_w1, const float* ffn_w3, const float* ffn_w2,
                                                   const float* na_w_qkv, const float* na_w_out, unsigned char* ws, int lo, int hi, int widx, int nw) {
    LAS float* scr = (LAS float*)(F.lds + 57344 + F.wave * 8704);
    const int gw = widx * NWAVES + F.wave, NGW = nw * NWAVES;
    for (int it0 = lo + gw; it0 < hi; it0 += NGW) {
        int it = it0;
        if (tr_matrix<0>(it, mix_w_in, 1024, MIXIN, (bf16*)(ws + WS_WIN_T), scr, F.lane)) continue;
        if (tr_matrix<0>(it, mix_w_out, 1024, 1024, (bf16*)(ws + WS_WOUT_T), scr, F.lane)) continue;
        if (tr_matrix<1>(it, ffn_w1, 1024, FF, (bf16*)(ws + WS_W13_T), scr, F.lane)) continue;
        if (tr_matrix<2>(it, ffn_w3, 1024, FF, (bf16*)(ws + WS_W13_T), scr, F.lane)) continue;
        if (tr_matrix<0>(it, ffn_w2, FF, 1024, (bf16*)(ws + WS_W2_T), scr, F.lane)) continue;
        if (tr_matrix<0>(it, na_w_qkv, 1024, 3072, (bf16*)(ws + WS_QKV_T), scr, F.lane)) continue;
        tr_matrix<0>(it, na_w_out, 1024, 1024, (bf16*)(ws + WS_NAO_T), scr, F.lane);
    }
}
constexpr int MOE_ITEMS = NE * 1408 * 3, MOE_W13_ITEMS = NE * 2816, MOE_ITEMS_P6 = 0, MOE_ITEMS_P8 = 8832, MOE_ITEMS_P9 = 14848, MOE_ITEMS_P11 = 2944, MOE_ITEMS_P16 = 7168, MOE_ITEMS_P7 = MOE_ITEMS - MOE_ITEMS_P8 - MOE_ITEMS_P9 - MOE_ITEMS_P11 - MOE_ITEMS_P16;
static_assert(MOE_ITEMS - MOE_ITEMS_P16 >= MOE_W13_ITEMS, "the items left for P16's idle workgroups must all be w2 items (the w1|w3 copies are read by P16 itself)");
__device__ __forceinline__ void moe_weight_phase(Frame& F, const float* w1, const float* w3, const float* w2, unsigned char* ws, int lo, int hi, int widx, int nw) {
    LAS float* scr = (LAS float*)(F.lds + 57344 + F.wave * 8704);
    const int gw = widx * NWAVES + F.wave, NGW = nw * NWAVES;
    for (int it0 = lo + gw; it0 < hi; it0 += NGW) {
        const bool isw2 = it0 >= MOE_W13_ITEMS; const int e = isw2 ? (it0 - MOE_W13_ITEMS) / 1408 : it0 / 2816; int it = isw2 ? 2816 + (it0 - MOE_W13_ITEMS) % 1408 : it0 % 2816;
        bf16* w13t = (bf16*)(ws + WS_MOEW13) + (size_t)e * 5632 * 1024; bf16* w2t = (bf16*)(ws + WS_MOEW2) + (size_t)e * 1024 * FF;
        if (tr_matrix<1>(it, w1 + (size_t)e * 1024 * FF, 1024, FF, w13t, scr, F.lane)) continue;
        if (tr_matrix<2>(it, w3 + (size_t)e * 1024 * FF, 1024, FF, w13t, scr, F.lane)) continue;
        tr_matrix<0>(it, w2 + (size_t)e * 1024 * FF, FF, 1024, w2t, scr, F.lane);
    }
}

struct RowIn { f32x4 x[4], sh[4], sc[4]; };
__device__ __forceinline__ void row_fetch(RowIn& R, const float* xrow, const float* sh, const float* sc, int lane) {
#pragma unroll
    for (int j = 0; j < 4; ++j) { R.x[j] = ((const GAS f32x4*)xrow)[lane + 64 * j]; R.sh[j] = ((const GAS f32x4*)sh)[lane + 64 * j]; R.sc[j] = ((const GAS f32x4*)sc)[lane + 64 * j]; }
}
__device__ __forceinline__ void row_finish(const RowIn& R, const f32x4 (&gg)[4], bf16* orow, int lane, f32x4 (&a)[4], const float* slab = nullptr, int nslab = 0, float* wb = nullptr) {
    float ss = 0.f;
#pragma unroll
    for (int j = 0; j < 4; ++j) a[j] = R.x[j];
    for (int s = 0; s < nslab; ++s) { const GAS f32x4* sr = (const GAS f32x4*)(slab + (size_t)s * (2048 * 1024)) + lane;
#pragma unroll
        for (int j = 0; j < 4; ++j) a[j] += sr[64 * j]; }
    if (wb) { GAS f32x4* w4 = (GAS f32x4*)wb + lane;
#pragma unroll
        for (int j = 0; j < 4; ++j) w4[64 * j] = a[j]; }
#pragma unroll
    for (int j = 0; j < 4; ++j) ss += (a[j].x * a[j].x + a[j].y * a[j].y) + (a[j].z * a[j].z + a[j].w * a[j].w);
    const float rs = rsqrtf(wave_sum(ss) * (1.f / 1024.f) + 1e-6f);
    GAS unsigned long long* o8 = (GAS unsigned long long*)orow + lane;
#pragma unroll
    for (int j = 0; j < 4; ++j) {
        a[j] = (a[j] * rs) * gg[j] * (R.sc[j] + 1.f) + R.sh[j];
        o8[64 * j] = (unsigned long long)pk2(a[j].x, a[j].y) | ((unsigned long long)pk2(a[j].z, a[j].w) << 32);
    }
}
__device__ __forceinline__ void normmod_phase(Frame& F, const float* src_ctx, const float* src_lat, const float* g, const float* mods_l, int off_shift, int off_scale, bf16* dst, const float* slab = nullptr, int nslab = 0, float* wb_ctx = nullptr, int m_end = M_ALL) {
    const int gw = F.bid * NWAVES + F.wave, NGW = F.G * NWAVES;
    f32x4 gg[4];
#pragma unroll
    for (int j = 0; j < 4; ++j) gg[j] = ((const GAS f32x4*)g)[F.lane + 64 * j];
    RowIn cur, nxt;
    int r = gw; bool have = r < m_end;
#define NM_FETCH(R_, r_) do { const bool ic_ = (r_) < M_CTX; const int rl_ = ic_ ? (r_) : (r_) - M_CTX; const float* mp_ = mods_l + (ic_ ? 8 : (rl_ >> 11)) * 6144; \
        row_fetch(R_, (ic_ ? src_ctx : src_lat) + (size_t)rl_ * D, mp_ + off_shift, mp_ + off_scale, F.lane); } while (0)
    if (have) NM_FETCH(cur, r);
    while (have) {
        const int rn = r + NGW; const bool hn = rn < m_end;
        if (hn) NM_FETCH(nxt, rn);
        const bool isctx = r < M_CTX; const int rl = isctx ? r : r - M_CTX;
        f32x4 a[4];
        if (isctx) row_finish(cur, gg, dst + (size_t)r * D, F.lane, a, slab ? slab + (size_t)rl * D : nullptr, nslab, wb_ctx ? wb_ctx + (size_t)rl * D : nullptr);
        else row_finish(cur, gg, dst + (size_t)r * D, F.lane, a);
        cur = nxt; r = rn; have = hn;
    }
#undef NM_FETCH
}

namespace pg8 {
struct EpiResGate {
    static constexpr bool PERM = false, AFTER_DRAIN = false;
    const float* base_c; const float* base_l; float* out_c; float* out_l; const float* mods_l; int gate_off; int ctx_tiles;
    __device__ __forceinline__ void operator()(const f32x4 (&acc)[2][2][4][2], const Unit& u, int wr, int wc, int fr, int fq) const {
        const bool isctx = u.pm < ctx_tiles; const int rt = isctx ? u.pm : u.pm - ctx_tiles; const int mi = isctx ? 8 : (rt >> 3);
        const float* base = isctx ? base_c : base_l; float* out = isctx ? out_c : out_l;
        const int col0 = u.pn * BM + wc * 32 + 4 * fq; const float* gp = mods_l + mi * 6144 + gate_off + col0;
        f32x4 gv[2][2];
#pragma unroll
        for (int bj = 0; bj < 2; ++bj)
#pragma unroll
            for (int n = 0; n < 2; ++n) gv[bj][n] = *(const f32x4*)(gp + bj * HALF + n * 16);
#pragma unroll
        for (int ai = 0; ai < 2; ++ai)
#pragma unroll
            for (int m = 0; m < 4; ++m) { const size_t off = (size_t)(rt * BM + ai * HALF + wr * 64 + m * 16 + fr) * 1024 + col0;
#pragma unroll
                for (int bj = 0; bj < 2; ++bj)
#pragma unroll
                    for (int n = 0; n < 2; ++n) { const f32x4 b = *(const f32x4*)(base + off + bj * HALF + n * 16); *(f32x4*)(out + off + bj * HALF + n * 16) = b + gv[bj][n] * acc[ai][bj][m][n]; } }
    }
};
template <bool ROUTER> struct EpiResGateNormT {
    static constexpr bool PERM = false, AFTER_DRAIN = true;
    const float* base; float* out; const float* mods_l; int gate_off;
    const float* g; int off_shift, off_scale; bf16_t* dst;
    float* xbuf; unsigned* cnt;
    const float* rw; float* plog;
    __device__ __forceinline__ void operator()(const f32x4 (&)[2][2][4][2], const Unit&, int, int, int, int) const {}
    __device__ __forceinline__ void fused(f32x4 (&acc)[2][2][4][2], const Unit& u, int wr, int wc, int fr, int fq, PG8_LAS unsigned char* lds, int wid, int lane) const {
        PG8_LAS float* P = (PG8_LAS float*)lds;
        PG8_LAS float* S = (PG8_LAS float*)(lds + 4096);
        const int rt = u.pm, col0 = u.pn * BM + wc * 32 + 4 * fq; const float* mp = mods_l + (rt >> 3) * 6144 + col0;
        const unsigned r0 = (unsigned)((rt * BM + wr * 64 + fr) * 1024 + col0) * 4u;
        unsigned rb = r0; constexpr int NB = ROUTER ? 8 : 12;
#define ERN_IDX(i) const int bj_ = (i) >> 4, n_ = ((i) >> 3) & 1, ai_ = ((i) >> 2) & 1, m_ = (i) & 3
#pragma unroll
        for (int b0 = 0; b0 < 32; b0 += NB) { f32x4 bv[NB];
            if (b0) {
#pragma unroll
                for (int i = b0 - NB; i < b0; ++i) { ERN_IDX(i); asm volatile("" : "+v"(rb) : "v"(acc[ai_][bj_][m_][n_][3])); } }
#pragma unroll
            for (int i = b0; i < b0 + NB && i < 32; ++i) { ERN_IDX(i); bv[i - b0] = *(const f32x4*)((const char*)base + (rb + (unsigned)(((ai_ * HALF + m_ * 16) * 1024 + bj_ * HALF + n_ * 16) * 4))); }
#pragma unroll
            for (int i = b0; i < b0 + NB && i < 32; ++i) { ERN_IDX(i); const f32x4 gv = *(const f32x4*)(mp + gate_off + bj_ * HALF + n_ * 16); acc[ai_][bj_][m_][n_] = bv[i - b0] + gv * acc[ai_][bj_][m_][n_]; } }
#undef ERN_IDX
#pragma unroll
        for (int ai = 0; ai < 2; ++ai)
#pragma unroll
            for (int m = 0; m < 4; ++m) { float s = 0.f;
#pragma unroll
                for (int bj = 0; bj < 2; ++bj)
#pragma unroll
                    for (int n = 0; n < 2; ++n) { const f32x4 x = acc[ai][bj][m][n]; s += (x[0] * x[0] + x[1] * x[1]) + (x[2] * x[2] + x[3] * x[3]); }
                s += __shfl_xor(s, 16); s += __shfl_xor(s, 32);
                if (fq == 0) P[(ai * HALF + wr * 64 + m * 16 + fr) * 4 + wc] = s; }
        asm volatile("s_waitcnt lgkmcnt(0)" ::: "memory"); __builtin_amdgcn_s_barrier(); asm volatile("" ::: "memory");
        const int row = wid * 32 + (lane & 31);
        if (lane < 32) { const float t = (P[row * 4 + 0] + P[row * 4 + 1]) + (P[row * 4 + 2] + P[row * 4 + 3]);
            __hip_atomic_store(xbuf + (size_t)(rt * BM + row) * 4 + u.pn, t, __ATOMIC_RELAXED, __HIP_MEMORY_SCOPE_AGENT); }
        asm volatile("s_waitcnt vmcnt(0)" ::: "memory");
        if (lane == 0) __hip_atomic_fetch_add(cnt + 64 * rt, 1u, __ATOMIC_RELAXED, __HIP_MEMORY_SCOPE_AGENT);
#pragma unroll
        for (int ai = 0; ai < 2; ++ai)
#pragma unroll
            for (int m = 0; m < 4; ++m)
#pragma unroll
                for (int bj = 0; bj < 2; ++bj)
#pragma unroll
                    for (int n = 0; n < 2; ++n) *(f32x4*)((char*)out + (r0 + (unsigned)(((ai * HALF + m * 16) * 1024 + bj * HALF + n * 16) * 4))) = acc[ai][bj][m][n];
        if (wid == 0) {
            while ((unsigned)__builtin_amdgcn_readfirstlane(__hip_atomic_load(cnt + 64 * rt, __ATOMIC_RELAXED, __HIP_MEMORY_SCOPE_AGENT)) < 32u) __builtin_amdgcn_s_sleep(2);
            __builtin_amdgcn_fence(__ATOMIC_ACQUIRE, "agent");
        }
        asm volatile("s_waitcnt lgkmcnt(0)" ::: "memory"); __builtin_amdgcn_s_barrier(); asm volatile("" ::: "memory");
        if (lane < 32) { const float* sl = xbuf + (size_t)(rt * BM + row) * 4;
            const float t = (__hip_atomic_load(sl + 0, __ATOMIC_RELAXED, __HIP_MEMORY_SCOPE_AGENT) + __hip_atomic_load(sl + 1, __ATOMIC_RELAXED, __HIP_MEMORY_SCOPE_AGENT))
                          + (__hip_atomic_load(sl + 2, __ATOMIC_RELAXED, __HIP_MEMORY_SCOPE_AGENT) + __hip_atomic_load(sl + 3, __ATOMIC_RELAXED, __HIP_MEMORY_SCOPE_AGENT));
            S[row] = rsqrtf(t * (1.f / 1024.f) + 1e-6f); }
        asm volatile("s_waitcnt vmcnt(0) lgkmcnt(0)" ::: "memory"); __builtin_amdgcn_s_barrier(); asm volatile("" ::: "memory");
        float rs[2][4]; int fr2; asm volatile("v_mbcnt_lo_u32_b32 %0, -1, 0\n\tv_mbcnt_hi_u32_b32 %0, -1, %0" : "=v"(fr2)); fr2 &= 15;
#pragma unroll
        for (int ai = 0; ai < 2; ++ai)
#pragma unroll
            for (int m = 0; m < 4; ++m) rs[ai][m] = S[ai * HALF + wr * 64 + m * 16 + fr2];
        asm volatile("s_waitcnt lgkmcnt(0)" ::: "memory"); __builtin_amdgcn_s_barrier(); asm volatile("" ::: "memory");
        f32x4 dl[2][4];
        if constexpr (ROUTER) {
#pragma unroll
            for (int ai = 0; ai < 2; ++ai)
#pragma unroll
                for (int m = 0; m < 4; ++m) dl[ai][m] = (f32x4){0.f, 0.f, 0.f, 0.f}; }
#pragma unroll
        for (int bj = 0; bj < 2; ++bj)
#pragma unroll
            for (int n = 0; n < 2; ++n) { const int c = bj * HALF + n * 16;
                const f32x4 gg = *(const f32x4*)(g + col0 + c), sc = *(const f32x4*)(mp + off_scale + c) + 1.f, sh = *(const f32x4*)(mp + off_shift + c);
                float wa[4];
                if constexpr (ROUTER) {
#pragma unroll
                    for (int x = 0; x < 4; ++x) wa[x] = (fr2 < 8) ? rw[(col0 + c + x) * 8 + fr2] : 0.f; }
#pragma unroll
                for (int ai = 0; ai < 2; ++ai)
#pragma unroll
                    for (int m = 0; m < 4; ++m) { const f32x4 v = ((acc[ai][bj][m][n] * rs[ai][m]) * gg) * sc + sh;
                        *(unsigned long long*)((char*)dst + ((r0 >> 1) + (unsigned)(((ai * HALF + m * 16) * 1024 + c) * 2))) = (unsigned long long)cvt_pk_bf16(v[0], v[1]) | ((unsigned long long)cvt_pk_bf16(v[2], v[3]) << 32);
                        if constexpr (ROUTER) {
#pragma unroll
                            for (int x = 0; x < 4; ++x) dl[ai][m] = __builtin_amdgcn_mfma_f32_16x16x4f32(wa[x], v[x], dl[ai][m], 0, 0, 0); } } }
        if constexpr (ROUTER) {
            PG8_LAS float* T = (PG8_LAS float*)lds;
            if (fq < 2) {
#pragma unroll
                for (int ai = 0; ai < 2; ++ai)
#pragma unroll
                    for (int m = 0; m < 4; ++m)
#pragma unroll
                        for (int x = 0; x < 4; ++x) T[(ai * HALF + wr * 64 + m * 16 + fr2) * 32 + (4 * fq + x) * 4 + wc] = dl[ai][m][x]; }
            asm volatile("s_waitcnt lgkmcnt(0)" ::: "memory"); __builtin_amdgcn_s_barrier(); asm volatile("" ::: "memory");
            const int t = wid * 64 + lane, trow = t >> 1, th = t & 1; f32x4 sum;
#pragma unroll
            for (int x = 0; x < 4; ++x) { const f32x4 q = *(const PG8_LAS f32x4*)(T + trow * 32 + (4 * th + x) * 4); sum[x] = (q[0] + q[1]) + (q[2] + q[3]); }
            *(f32x4*)(plog + ((size_t)(rt * BM + trow) * 4 + u.pn) * 8 + 4 * th) = sum;
        }
    }
};
typedef EpiResGateNormT<false> EpiResGateNorm;
struct EpiSwiGLU {
    static constexpr bool PERM = true, AFTER_DRAIN = false;
    bf16_t* O; int ldo; int nt_mod;
    __device__ __forceinline__ void operator()(const f32x4 (&acc)[2][2][4][2], const Unit& u, int wr, int wc, int fr, int fq) const {
        const int pnl = u.pn % nt_mod; const int row0 = u.pm * BM + wr * 64 + fr, col0 = pnl * HALF + wc * 32 + 8 * fq;
#pragma unroll
        for (int ai = 0; ai < 2; ++ai)
#pragma unroll
            for (int m = 0; m < 4; ++m) { bf16_t* rowp = O + (size_t)(row0 + ai * HALF + m * 16) * ldo + col0;
                float h[8];
#pragma unroll
                for (int n = 0; n < 2; ++n)
#pragma unroll
                    for (int e = 0; e < 4; ++e) { const float a = acc[ai][0][m][n][e], b = acc[ai][1][m][n][e]; h[n * 4 + e] = a * b * __builtin_amdgcn_rcpf(1.f + __expf(-a)); }
                u32x4 w; w.x = cvt_pk_bf16(h[0], h[1]); w.y = cvt_pk_bf16(h[2], h[3]); w.z = cvt_pk_bf16(h[4], h[5]); w.w = cvt_pk_bf16(h[6], h[7]);
                PG8_ST16(O, rowp, w); }
    }
};
struct EpiPlainMod {
    static constexpr bool PERM = true, AFTER_DRAIN = false;
    bf16_t* O; int ldo; int nt_mod;
    __device__ __forceinline__ void operator()(const f32x4 (&acc)[2][2][4][2], const Unit& u, int wr, int wc, int fr, int fq) const {
        const int pnl = u.pn % nt_mod; const int row0 = u.pm * BM + wr * 64 + fr, col0 = pnl * BM + wc * 32 + 8 * fq;
#pragma unroll
        for (int ai = 0; ai < 2; ++ai)
#pragma unroll
            for (int m = 0; m < 4; ++m) { bf16_t* rowp = O + (size_t)(row0 + ai * HALF + m * 16) * ldo + col0;
#pragma unroll
                for (int bj = 0; bj < 2; ++bj) { const f32x4 v0 = acc[ai][bj][m][0], v1 = acc[ai][bj][m][1];
                    u32x4 w; w.x = cvt_pk_bf16(v0[0], v0[1]); w.y = cvt_pk_bf16(v0[2], v0[3]); w.z = cvt_pk_bf16(v1[0], v1[1]); w.w = cvt_pk_bf16(v1[2], v1[3]);
                    PG8_ST16(O, rowp + bj * HALF, w); } }
    }
};
struct SplitKOrder {
    int ntm, nN, ns, kslice, G, c;
    __device__ __forceinline__ bool next(int i, Unit& u) const {
        const int L = i * G + c; if (L >= ntm * nN * ns) return false;
        const int ks = L % ns, t = L / ns; u.pn = t % nN; u.pm = t / nN; u.k0 = ks * kslice; return true;
    }
    __device__ __forceinline__ void a_ready(const Unit&) const {}
    __device__ __forceinline__ void done(const Unit&) const {}
};
struct EpiSlabGate {
    static constexpr bool PERM = false, AFTER_DRAIN = false;
    float* slab; const float* gate; int kslice;
    __device__ __forceinline__ void operator()(const f32x4 (&acc)[2][2][4][2], const Unit& u, int wr, int wc, int fr, int fq) const {
        const int col0 = u.pn * BM + wc * 32 + 4 * fq; float* out = slab + (size_t)(u.k0 / kslice) * (2048 * 1024);
        f32x4 gv[2][2];
#pragma unroll
        for (int bj = 0; bj < 2; ++bj)
#pragma unroll
            for (int n = 0; n < 2; ++n) gv[bj][n] = *(const f32x4*)(gate + col0 + bj * HALF + n * 16);
#pragma unroll
        for (int ai = 0; ai < 2; ++ai)
#pragma unroll
            for (int m = 0; m < 4; ++m) { float* op = out + (size_t)(u.pm * BM + ai * HALF + wr * 64 + m * 16 + fr) * 1024 + col0;
#pragma unroll
                for (int bj = 0; bj < 2; ++bj)
#pragma unroll
                    for (int n = 0; n < 2; ++n) *(f32x4*)(op + bj * HALF + n * 16) = gv[bj][n] * acc[ai][bj][m][n]; }
    }
};
struct MoeOrder {
    int tb[9]; int ntn, G, c; int limit = 0x7fffffff;
    __device__ __forceinline__ bool next(int i, Unit& u) const {
        const int L = i * G + c; if (L >= tb[8] * ntn || L >= limit) return false;
        const int mt = L / ntn, pn = L % ntn; int e = 0;
#pragma unroll
        for (int k = 1; k < 8; ++k) e += (mt >= tb[k]) ? 1 : 0;
        u.pm = mt; u.pn = e * ntn + pn; return true;
    }
    __device__ __forceinline__ void a_ready(const Unit&) const {}
    __device__ __forceinline__ void done(const Unit&) const {}
};
struct MoeTailOrder {
    int tb[9]; int first, ntail, G, c;
    __device__ __forceinline__ bool next(int i, Unit& u) const {
        const int L = i * G + c; if (L >= ntail * 11) return false;
        const int tu = L / 11, ks = L % 11, gu = first + tu, mt = gu >> 2, pn = gu & 3; int e = 0;
#pragma unroll
        for (int k = 1; k < 8; ++k) e += (mt >= tb[k]) ? 1 : 0;
        u.pm = mt; u.pn = e * 4 + pn; u.k0 = ks * 256; return true;
    }
    __device__ __forceinline__ void a_ready(const Unit&) const {}
    __device__ __forceinline__ void done(const Unit&) const {}
};
struct EpiTailSlab {
    static constexpr bool PERM = false, AFTER_DRAIN = false;
    float* slab; int first, ntail;
    __device__ __forceinline__ void operator()(const f32x4 (&acc)[2][2][4][2], const Unit& u, int wr, int wc, int fr, int fq) const {
        const int col0 = (u.pn & 3) * BM + wc * 32 + 4 * fq; float* out = slab + (size_t)(u.k0 >> 8) * ((size_t)(ntail >> 2) * 256 * 1024);
        const int rt = u.pm - (first >> 2);
#pragma unroll
        for (int ai = 0; ai < 2; ++ai)
#pragma unroll
            for (int m = 0; m < 4; ++m) { float* op = out + (size_t)(rt * BM + ai * HALF + wr * 64 + m * 16 + fr) * 1024 + col0;
#pragma unroll
                for (int bj = 0; bj < 2; ++bj)
#pragma unroll
                    for (int n = 0; n < 2; ++n) *(f32x4*)(op + bj * HALF + n * 16) = acc[ai][bj][m][n]; }
    }
};
}

struct PrepIn { const float *rw_mu, *rw_w0, *rw_w_up, *rw_a0, *rw_a_up, *rw_g_up, *rw_k_k, *rw_k_a, *rw_r_k, *conv_w, *conv_b, *dt_bias; };
__device__ __forceinline__ bf16x8 gather8(const float* p, int stride) {
    v4u w; w.x = pk2(p[0], p[stride]); w.y = pk2(p[2 * stride], p[3 * stride]); w.z = pk2(p[4 * stride], p[5 * stride]); w.w = pk2(p[6 * stride], p[7 * stride]); return __builtin_bit_cast(bf16x8, w);
}
constexpr int ACT_ST = 464;
__device__ __forceinline__ void prepare_phase(Frame& F, const PrepIn& P, const bf16* Z, bf16* PR, bf16* PM, float* DT, float* BONUS, bf16* GATE, bf16* ZG) {
    LAS unsigned short* zs = (LAS unsigned short*)F.lds;
    LAS unsigned char* actb = F.lds + 24576;
    LAS float* cst = (LAS float*)(F.lds + 24576 + 16 * ACT_ST);
    const int tid = F.tid, lane = F.lane, fr = lane & 15, fq = lane >> 4, w = F.wave;
    const int hf = F.bid & 1, wl = w & 3, hd = 4 * hf + wl;
    __syncthreads();
    if (tid < 256) { const int c = 256 * hf + tid; cst[tid] = P.rw_w0[c]; cst[256 + tid] = P.rw_w0[512 + c]; cst[512 + tid] = P.rw_a0[c]; cst[768 + tid] = P.rw_a0[512 + c];
      cst[1024 + tid] = P.rw_k_k[c]; cst[1280 + tid] = P.rw_k_a[c]; cst[1536 + tid] = P.rw_r_k[c]; cst[1792 + tid] = P.rw_r_k[512 + c]; }
    bf16x8 W[16];
#pragma unroll
    for (int cb = 0; cb < 4; ++cb) { const int c = 64 * hd + 4 * fr + cb;
        if (w < 4) { W[cb] = gather8(P.rw_w_up + (size_t)(8 * fq) * 512 + c, 512); W[4 + cb] = gather8(P.rw_w_up + (size_t)(32 + 8 * fq) * 512 + c, 512);
                     W[8 + cb] = gather8(P.rw_a_up + (size_t)(8 * fq) * 512 + c, 512); W[12 + cb] = gather8(P.rw_a_up + (size_t)(32 + 8 * fq) * 512 + c, 512); }
        else { W[cb] = gather8(P.rw_g_up + (size_t)(8 * fq) * 512 + c, 512); W[4 + cb] = gather8(P.rw_g_up + (size_t)(32 + 8 * fq) * 512 + c, 512); W[8 + cb] = gather8(P.rw_g_up + (size_t)(64 + 8 * fq) * 512 + c, 512); W[12 + cb] = W[cb]; } }
    const int col0 = (tid < 256) ? (256 * hf + tid) : (512 + 256 * hf + tid - 256), col1 = (tid < 256) ? (1024 + 256 * hf + tid) : ((tid < 480) ? (1536 + tid - 256) : 1536);
    const int zo0 = tid, zo1 = 512 + (tid & 255);
    const float mu00 = P.rw_mu[col0], mu10 = P.rw_mu[RWC + col0], mu01 = P.rw_mu[col1], mu11 = P.rw_mu[RWC + col1];
    float cw[5];
#pragma unroll
    for (int k = 0; k < 5; ++k) cw[k] = P.conv_w[k * 1024 + 512 * hf + tid];
    const float cbv = P.conv_b[512 * hf + tid], dtb = P.dt_bias[tid & 15];
    __syncthreads();

#ifndef PREP_REPS
#define PREP_REPS 1
#endif
    for (int rb_ = F.bid >> 1; rb_ < (M_ALL / 16) * PREP_REPS; rb_ += (F.G >> 1)) {
        const int rb = rb_ % (M_ALL / 16); const int g0 = rb * 16; const bool isctx = g0 < M_CTX; const int T = isctx ? CTXL : SEQ; const int t0 = isctx ? (g0 & (CTXL - 1)) : ((g0 - M_CTX) & (SEQ - 1));
        const bf16* zb = Z + (size_t)g0 * ZLD;
        const bool hp = t0 > 0, hn = (t0 + 16 < T), hp2 = t0 >= 2, hn2 = (t0 + 17 < T);
        float z0[18], z1[18], x[20];
        const int ccol = RWC + 512 + 512 * hf + tid;
#pragma unroll
        for (int i = 0; i < 18; ++i) { const bool ok = (i == 0) ? hp : ((i == 17) ? hn : true); z0[i] = ok ? ldbf(zb + (ptrdiff_t)(i - 1) * ZLD + col0) : 0.f; z1[i] = ok ? ldbf(zb + (ptrdiff_t)(i - 1) * ZLD + col1) : 0.f; }
#pragma unroll
        for (int i = 0; i < 20; ++i) { const bool ok = (i == 0) ? hp2 : (i == 1) ? hp : (i == 18) ? hn : (i == 19) ? hn2 : true; x[i] = ok ? ldbf(zb + (ptrdiff_t)(i - 2) * ZLD + ccol) : 0.f; }
#pragma unroll
        for (int tb = 0; tb < 16; ++tb) zs[tb * 768 + zo0] = (unsigned short)f2bf(z0[tb + 1] + mu00 * (z0[tb] - z0[tb + 1]) + mu10 * (z0[tb + 2] - z0[tb + 1]));
        {
            const int a = tid - 256;
#pragma unroll
            for (int tb = 0; tb < 16; ++tb) {
                const float zsft = z1[tb + 1] + mu01 * (z1[tb] - z1[tb + 1]) + mu11 * (z1[tb + 2] - z1[tb + 1]);
                if (tid < 256) zs[tb * 768 + zo1] = (unsigned short)f2bf(zsft);
                else if (tid < 480) { const float sg = sigm((a < 64) ? 2.f * zsft : zsft); const float av = (a < 64) ? (2.f * sg - 1.f) : ((a < 128) ? zsft : sg);
                    *(LAS unsigned short*)(actb + tb * ACT_ST + a * 2) = (unsigned short)f2bf(av); }
            }
        }
#pragma unroll
        for (int tb = 0; tb < 16; ++tb) {
            float y = cbv + cw[0] * x[tb] + cw[1] * x[tb + 1] + cw[2] * x[tb + 2] + cw[3] * x[tb + 3] + cw[4] * x[tb + 4];
            y = y * sigm(y);
            PM[(size_t)(g0 + tb) * 1024 + 512 * hf + tid] = (bf16)f2bf(y);
        }
        { const int tb = tid >> 5, cc = tid & 31;
          *(GAS v4u*)(ZG + (size_t)(g0 + tb) * 512 + 256 * hf + cc * 8) = *(const GAS v4u*)(zb + (size_t)tb * ZLD + RWC + 256 * hf + cc * 8); }
        if (hf == 0 && tid < 256) { const int tb = tid >> 4, cc = tid & 15; const float x = ldbf(zb + (size_t)tb * ZLD + RWC + 1536 + cc) + dtb; DT[(size_t)(g0 + tb) * 16 + cc] = (x > 20.f) ? x : log1pf(__expf(x)); }
        __syncthreads();
        const f32x4 zero = {0.f, 0.f, 0.f, 0.f};
        const int cl0 = 64 * wl + 4 * fr;
        if (w < 4) {
            bf16x8 Af[4];
#pragma unroll
            for (int kb = 0; kb < 4; ++kb) Af[kb] = *(const LAS bf16x8*)(actb + fr * ACT_ST + kb * 64 + fq * 16);
            f32x4 lw0[4], lw1[4], ia0[4], ia1[4];
#pragma unroll
            for (int cb = 0; cb < 4; ++cb) {
                lw0[cb] = __builtin_amdgcn_mfma_f32_16x16x32_bf16(Af[0], W[cb], zero, 0, 0, 0); lw1[cb] = __builtin_amdgcn_mfma_f32_16x16x32_bf16(Af[1], W[4 + cb], zero, 0, 0, 0);
                ia0[cb] = __builtin_amdgcn_mfma_f32_16x16x32_bf16(Af[2], W[8 + cb], zero, 0, 0, 0); ia1[cb] = __builtin_amdgcn_mfma_f32_16x16x32_bf16(Af[3], W[12 + cb], zero, 0, 0, 0);
            }
            const f32x4 w00 = *(const LAS f32x4*)(cst + cl0), w01 = *(const LAS f32x4*)(cst + 256 + cl0), a00 = *(const LAS f32x4*)(cst + 512 + cl0), a01 = *(const LAS f32x4*)(cst + 768 + cl0);
            const f32x4 kkc = *(const LAS f32x4*)(cst + 1024 + cl0), kac = *(const LAS f32x4*)(cst + 1280 + cl0), rk0 = *(const LAS f32x4*)(cst + 1536 + cl0), rk1 = *(const LAS f32x4*)(cst + 1792 + cl0);
#pragma unroll
            for (int e = 0; e < 4; ++e) {
                const int tok = 4 * fq + e; const size_t g = (size_t)(g0 + tok);
                const v2u ru = *(const LAS v2u*)(zs + tok * 768 + cl0), ku = *(const LAS v2u*)(zs + tok * 768 + 256 + cl0), vu = *(const LAS v2u*)(zs + tok * 768 + 512 + cl0);
                const f32x4 r = {bflo(ru.x), bfhi(ru.x), bflo(ru.y), bfhi(ru.y)}, k = {bflo(ku.x), bfhi(ku.x), bflo(ku.y), bfhi(ku.y)};
                const f32x4 kks = k * kkc;
                const float ssq = sum16((kks[0] * kks[0] + kks[1] * kks[1]) + (kks[2] * kks[2] + kks[3] * kks[3]));
                const float rn = __builtin_amdgcn_rcpf(fmaxf(sqrtf(ssq), 1e-12f));
                float ee0[4], ee1[4], kd0[4], kd1[4], bb0[4], bb1[4], na[4]; float bon = 0.f;
#pragma unroll
                for (int cb = 0; cb < 4; ++cb) {
                    ee0[cb] = 0.60653066f * sigm(w00[cb] + lw0[cb][e]); ee1[cb] = 0.60653066f * sigm(w01[cb] + lw1[cb][e]);
                    const float ic0 = sigm(a00[cb] + ia0[cb][e]), ic1 = sigm(a01[cb] + ia1[cb][e]);
                    const float kkn = kks[cb] * rn;
                    kd0[cb] = k[cb] * (1.f + (ic0 - 1.f) * kac[cb]); kd1[cb] = k[cb] * (1.f + (ic1 - 1.f) * kac[cb]);
                    bon += r[cb] * (kd0[cb] * rk0[cb] + kd1[cb] * rk1[cb]);
                    na[cb] = -kkn; bb0[cb] = kkn * ic0; bb1[cb] = kkn * ic1;
                }
                bon = sum16(bon); if (fr == 0) BONUS[g * 8 + hd] = bon;
                bf16* pr = PR + g * PRV + 256 * hf + cl0;
                *(GAS v2u*)(pr) = ru; *(GAS v2u*)(pr + 512) = vu;
                v2u o;
                o.x = pk2(na[0], na[1]); o.y = pk2(na[2], na[3]); *(GAS v2u*)(pr + 1024) = o;
                o.x = pk2(ee0[0], ee0[1]); o.y = pk2(ee0[2], ee0[3]); *(GAS v2u*)(pr + 1536) = o;
                o.x = pk2(kd0[0], kd0[1]); o.y = pk2(kd0[2], kd0[3]); *(GAS v2u*)(pr + 2048) = o;
                o.x = pk2(bb0[0], bb0[1]); o.y = pk2(bb0[2], bb0[3]); *(GAS v2u*)(pr + 2560) = o;
                o.x = pk2(ee1[0], ee1[1]); o.y = pk2(ee1[2], ee1[3]); *(GAS v2u*)(pr + 3072) = o;
                o.x = pk2(kd1[0], kd1[1]); o.y = pk2(kd1[2], kd1[3]); *(GAS v2u*)(pr + 3584) = o;
                o.x = pk2(bb1[0], bb1[1]); o.y = pk2(bb1[2], bb1[3]); *(GAS v2u*)(pr + 4096) = o;
            }
        } else {
            bf16x8 Af[3];
#pragma unroll
            for (int kb = 0; kb < 3; ++kb) Af[kb] = *(const LAS bf16x8*)(actb + fr * ACT_ST + (4 + kb) * 64 + fq * 16);
            f32x4 gt[4];
#pragma unroll
            for (int cb = 0; cb < 4; ++cb) {
                gt[cb] = __builtin_amdgcn_mfma_f32_16x16x32_bf16(Af[0], W[cb], zero, 0, 0, 0);
                gt[cb] = __builtin_amdgcn_mfma_f32_16x16x32_bf16(Af[1], W[4 + cb], gt[cb], 0, 0, 0); gt[cb] = __builtin_amdgcn_mfma_f32_16x16x32_bf16(Af[2], W[8 + cb], gt[cb], 0, 0, 0);
            }
#pragma unroll
            for (int e = 0; e < 4; ++e) { v2u o; o.x = pk2(gt[0][e], gt[1][e]); o.y = pk2(gt[2][e], gt[3][e]); *(GAS v2u*)(GATE + (size_t)(g0 + 4 * fq + e) * 512 + 256 * hf + cl0) = o; }
        }
        __syncthreads();
    }
}

template <int SH> __device__ __forceinline__ float dpp_shr(float x) { return __int_as_float(__builtin_amdgcn_update_dpp(0, __float_as_int(x), 0x110 + SH, 0xF, 0xF, true)); }
__device__ __forceinline__ int scan_row16(int c, int t, int b, int d) {
    const int st = c * 16 + t; const int seg = (st >= CTXL) ? 1 : 0; const int T = seg ? SEQ : CTXL; const int sl = st - seg * CTXL;
    return (seg ? (M_CTX + b * SEQ) : b * CTXL) + (d ? (T - 1 - sl) : sl);
}
__device__ __forceinline__ v4u scale8(const v4u u, float s) {
    v4u o; o.x = pk2(bflo(u.x) * s, bfhi(u.x) * s); o.y = pk2(bflo(u.y) * s, bfhi(u.y) * s); o.z = pk2(bflo(u.z) * s, bfhi(u.z) * s); o.w = pk2(bflo(u.w) * s, bfhi(u.w) * s); return o;
}
__device__ __forceinline__ bf16x8 pack4z(const f32x4& a) { v4u w; w.x = pk2(a[0], a[1]); w.y = pk2(a[2], a[3]); w.z = 0u; w.w = 0u; return __builtin_bit_cast(bf16x8, w); }
__device__ __forceinline__ bf16x8 tr4z(const LAS unsigned char* p) {
    const v2u t = __builtin_bit_cast(v2u, __builtin_amdgcn_ds_read_tr16_b64_v4i16((LAS v4i16_t*)p)); v4u w; w.x = t.x; w.y = t.y; w.z = 0u; w.w = 0u; return __builtin_bit_cast(bf16x8, w);
}
__device__ __forceinline__ bf16x8 cat44(const v2u a, const v2u b) { v4u w; w.x = a.x; w.y = a.y; w.z = b.x; w.w = b.y; return __builtin_bit_cast(bf16x8, w); }
constexpr int NCH16 = (CTXL + SEQ) / 16;
__device__ __forceinline__ f32x4 mm16(const f32x4& xT_c, const f32x4& y_c, const f32x4& acc) {
    return __builtin_amdgcn_mfma_f32_16x16x32_bf16(pack4z(xT_c), pack4z(y_c), acc, 0, 0, 0);
}
constexpr int RING_FLAGS = 122880;
constexpr int NSLOT = 6;
__device__ __forceinline__ unsigned lds_flag_ld(volatile LAS unsigned* p) { return (unsigned)__builtin_amdgcn_readfirstlane((int)*p); }
__device__ __forceinline__ void ring_wait_full(volatile LAS unsigned* fl, int s, int c) { while (lds_flag_ld(fl + s) != (unsigned)(c + 1)) __builtin_amdgcn_s_sleep(1); asm volatile("" ::: "memory"); }
__device__ __forceinline__ void ring_wait_free(volatile LAS unsigned* fl, int s, int c, int nslot = NSLOT, unsigned ncons = 4u) { const unsigned want = ncons * (unsigned)(c / nslot); while (lds_flag_ld(fl + 8 + s) < want) __builtin_amdgcn_s_sleep(1); asm volatile("" ::: "memory"); }
__device__ __forceinline__ void ring_set_full(volatile LAS unsigned* fl, int s, int c, int lane) { asm volatile("s_waitcnt lgkmcnt(0)" ::: "memory"); if (lane == 0) fl[s] = (unsigned)(c + 1); }
__device__ __forceinline__ void ring_done(volatile LAS unsigned* fl, int s, int lane) { asm volatile("s_waitcnt lgkmcnt(0)" ::: "memory"); if (lane == 0) __hip_atomic_fetch_add((LAS unsigned*)(fl + 8 + s), 1u, __ATOMIC_RELAXED, __HIP_MEMORY_SCOPE_WORKGROUP); }

constexpr int RST = 144, RIMG = 16 * RST;
constexpr int RW_SLOT = 18432;
__device__ __forceinline__ void rwkv_block(Frame& F, int unit, const bf16* PR, bf16* YRW) {
    const int d = unit & 1, h = (unit >> 1) & 7, b = unit >> 4;
    const int lane = F.lane, fr = lane & 15, fq = lane >> 4, tq = (lane & 15) >> 2, tp = lane & 3;
    volatile LAS unsigned* fl = (volatile LAS unsigned*)(F.lds + RING_FLAGS);
    __syncthreads();
    if (F.tid < 16) fl[F.tid] = 0u;
    __syncthreads();
    if (F.wave >= 4) {
        const int p = F.wave - 4;
        const int ve = (3 + 3 * d) * 512, vb = (5 + 3 * d) * 512, vk = (4 + 3 * d) * 512;
        bf16x8 Ltri; { v4u w; w.x = ((4 * fq + 0 <= fr) ? 0x3F80u : 0u) | ((4 * fq + 1 <= fr) ? 0x3F800000u : 0u); w.y = ((4 * fq + 2 <= fr) ? 0x3F80u : 0u) | ((4 * fq + 3 <= fr) ? 0x3F800000u : 0u); w.z = 0u; w.w = 0u; Ltri = __builtin_bit_cast(bf16x8, w); }
        v4u rE[2], rA[2], rB[2], rK[2], rR[2], rV[2];
#define RW_LOAD(c_) do { \
        _Pragma("unroll") for (int i = 0; i < 2; ++i) { const int id = lane + 64 * i; const bf16* src = PR + (size_t)scan_row16((c_), id >> 3, b, d) * PRV + h * 64 + (id & 7) * 8; \
            rE[i] = *(const GAS v4u*)(src + ve); rA[i] = *(const GAS v4u*)(src + 1024); rB[i] = *(const GAS v4u*)(src + vb); rK[i] = *(const GAS v4u*)(src + vk); rR[i] = *(const GAS v4u*)(src); rV[i] = *(const GAS v4u*)(src + 512); } } while (0)
        RW_LOAD(p);
        for (int c = p; c < NCH16; c += 4) {
            const int s = c % NSLOT;
            LAS unsigned char* sb = F.lds + s * RW_SLOT;
            LAS unsigned char* RE = sb; LAS unsigned char* RA = sb + RIMG; LAS unsigned char* RB = sb + 2 * RIMG; LAS unsigned char* RK = sb + 3 * RIMG; LAS unsigned char* RR = sb + 4 * RIMG;
            LAS unsigned char* RV = sb + 5 * RIMG; LAS unsigned char* FRG = sb + 6 * RIMG; LAS float* GC = (LAS float*)(sb + 6 * RIMG + 4096);
            ring_wait_free(fl, s, c);
#pragma unroll
            for (int i = 0; i < 2; ++i) { const int id = lane + 64 * i; const int o = (id >> 3) * RST + (id & 7) * 16;
                *(LAS v4u*)(RE + o) = rE[i]; *(LAS v4u*)(RA + o) = rA[i]; *(LAS v4u*)(RB + o) = rB[i]; *(LAS v4u*)(RK + o) = rK[i]; *(LAS v4u*)(RR + o) = rR[i]; *(LAS v4u*)(RV + o) = rV[i]; }
            if (c + 4 < NCH16) RW_LOAD(c + 4);
            asm volatile("s_waitcnt lgkmcnt(0)" ::: "memory");
#pragma unroll
            for (int jb = 0; jb < 4; ++jb) {
                const int tro = (4 * fq + tq) * RST + (16 * jb + 4 * tp) * 2;
                const v2u eu = __builtin_bit_cast(v2u, __builtin_amdgcn_ds_read_tr16_b64_v4i16((LAS v4i16_t*)(RE + tro)));
                const v2u au = __builtin_bit_cast(v2u, __builtin_amdgcn_ds_read_tr16_b64_v4i16((LAS v4i16_t*)(RA + tro)));
                const v2u bu = __builtin_bit_cast(v2u, __builtin_amdgcn_ds_read_tr16_b64_v4i16((LAS v4i16_t*)(RB + tro)));
                const v2u ku = __builtin_bit_cast(v2u, __builtin_amdgcn_ds_read_tr16_b64_v4i16((LAS v4i16_t*)(RK + tro)));
                const v2u ru = __builtin_bit_cast(v2u, __builtin_amdgcn_ds_read_tr16_b64_v4i16((LAS v4i16_t*)(RR + tro)));
                v4u ew; ew.x = eu.x; ew.y = eu.y; ew.z = 0u; ew.w = 0u;
                const f32x4 cum = __builtin_amdgcn_mfma_f32_16x16x32_bf16(Ltri, __builtin_bit_cast(bf16x8, ew), (f32x4){0.f, 0.f, 0.f, 0.f}, 0, 0, 0);
                const float ev[4] = {bflo(eu.x), bfhi(eu.x), bflo(eu.y), bfhi(eu.y)}, av[4] = {bflo(au.x), bfhi(au.x), bflo(au.y), bfhi(au.y)}, bv[4] = {bflo(bu.x), bfhi(bu.x), bflo(bu.y), bfhi(bu.y)};
                const float kv[4] = {bflo(ku.x), bfhi(ku.x), bflo(ku.y), bfhi(ku.y)}, rv[4] = {bflo(ru.x), bfhi(ru.x), bflo(ru.y), bfhi(ru.y)};
#pragma unroll
                for (int e = 0; e < 4; ++e) {
                    const float G = __expf(-cum[e]), Gi = __expf(cum[e]), Gx = __expf(ev[e] - cum[e]);
                    const int o = (4 * fq + e) * RST + (16 * jb + fr) * 2;
                    const unsigned ab = pk2(av[e] * Gx, bv[e] * Gi), kr = pk2(kv[e] * Gi, rv[e] * G);
                    *(LAS unsigned short*)(RA + o) = (unsigned short)ab; *(LAS unsigned short*)(RB + o) = (unsigned short)(ab >> 16);
                    *(LAS unsigned short*)(RK + o) = (unsigned short)kr; *(LAS unsigned short*)(RR + o) = (unsigned short)(kr >> 16);
                    if (e == 3 && fq == 3) GC[16 * jb + fr] = G;
                }
            }
            asm volatile("s_waitcnt lgkmcnt(0)" ::: "memory");
            f32x4 aba = {0.f, 0.f, 0.f, 0.f}, aka = aba, abr = aba, akr = aba, abaT = aba;
#pragma unroll
            for (int kb = 0; kb < 2; ++kb) {
                const int o = fr * RST + kb * 64 + fq * 16;
                const bf16x8 fb = *(const LAS bf16x8*)(RB + o), fk = *(const LAS bf16x8*)(RK + o), fa = *(const LAS bf16x8*)(RA + o), frr = *(const LAS bf16x8*)(RR + o);
                aba = __builtin_amdgcn_mfma_f32_16x16x32_bf16(fb, fa, aba, 0, 0, 0); aka = __builtin_amdgcn_mfma_f32_16x16x32_bf16(fk, fa, aka, 0, 0, 0);
                abr = __builtin_amdgcn_mfma_f32_16x16x32_bf16(fb, frr, abr, 0, 0, 0); akr = __builtin_amdgcn_mfma_f32_16x16x32_bf16(fk, frr, akr, 0, 0, 0);
                abaT = __builtin_amdgcn_mfma_f32_16x16x32_bf16(fa, fb, abaT, 0, 0, 0);
            }
            f32x4 idc;
#pragma unroll
            for (int e = 0; e < 4; ++e) { const int row = 4 * fq + e;
                aba[e] = (row < fr) ? aba[e] : 0.f; aka[e] = (row < fr) ? aka[e] : 0.f; abr[e] = (row <= fr) ? abr[e] : 0.f; akr[e] = (row <= fr) ? akr[e] : 0.f;
                abaT[e] = (fr < row) ? abaT[e] : 0.f; idc[e] = (row == fr) ? 1.f : 0.f; }
            f32x4 t_c = idc + aba, t_T = idc + abaT;
            f32x4 p_c = mm16(abaT, aba, (f32x4){0.f, 0.f, 0.f, 0.f}), p_T = mm16(aba, abaT, (f32x4){0.f, 0.f, 0.f, 0.f});
            { const f32x4 n_c = mm16(t_T, p_c, t_c), n_T = mm16(p_c, t_T, t_T); t_c = n_c; t_T = n_T; }
            { const f32x4 q_c = mm16(p_T, p_c, (f32x4){0.f, 0.f, 0.f, 0.f}), q_T = mm16(p_c, p_T, (f32x4){0.f, 0.f, 0.f, 0.f}); p_c = q_c; p_T = q_T; }
            { const f32x4 n_c = mm16(t_T, p_c, t_c), n_T = mm16(p_c, t_T, t_T); t_c = n_c; t_T = n_T; }
            { const f32x4 q_c = mm16(p_T, p_c, (f32x4){0.f, 0.f, 0.f, 0.f}); p_c = q_c; }
            const f32x4 tm_c = mm16(t_T, p_c, t_c);
            *(LAS bf16x8*)(FRG + lane * 16) = pack4z(tm_c); *(LAS bf16x8*)(FRG + 1024 + lane * 16) = pack4z(aka);
            *(LAS bf16x8*)(FRG + 2048 + lane * 16) = pack4z(abr); *(LAS bf16x8*)(FRG + 3072 + lane * 16) = pack4z(akr);
            ring_set_full(fl, s, c, lane);
        }
#undef RW_LOAD
    } else {
        const int q = F.wave;
        __builtin_amdgcn_s_setprio(3);
        bf16* yout = YRW + (size_t)d * M_ALL * 512 + h * 64 + 16 * q;
        f32x4 T[4];
#pragma unroll
        for (int jb = 0; jb < 4; ++jb) T[jb] = (f32x4){0.f, 0.f, 0.f, 0.f};
        for (int c = 0; c < NCH16; ++c) {
            const int s = c % NSLOT;
            LAS unsigned char* sb = F.lds + s * RW_SLOT;
            LAS unsigned char* RA = sb + RIMG; LAS unsigned char* RB = sb + 2 * RIMG; LAS unsigned char* RK = sb + 3 * RIMG; LAS unsigned char* RR = sb + 4 * RIMG;
            LAS unsigned char* RV = sb + 5 * RIMG; LAS unsigned char* FRG = sb + 6 * RIMG; LAS float* GC = (LAS float*)(sb + 6 * RIMG + 4096);
            ring_wait_full(fl, s, c);
            const bf16x8 tmA = *(const LAS bf16x8*)(FRG + lane * 16), akaA = *(const LAS bf16x8*)(FRG + 1024 + lane * 16), abrA = *(const LAS bf16x8*)(FRG + 2048 + lane * 16), akrA = *(const LAS bf16x8*)(FRG + 3072 + lane * 16);
            const bf16x8 Vf = tr4z(RV + (4 * fq + tq) * RST + (16 * q + 4 * tp) * 2);
            f32x4 x = {0.f, 0.f, 0.f, 0.f}, y = {0.f, 0.f, 0.f, 0.f};
#pragma unroll
            for (int jp = 0; jp < 2; ++jp) {
                const int o = fr * RST + (32 * jp + 4 * fq) * 2;
                const bf16x8 tf = pack8(T[2 * jp], T[2 * jp + 1]);
                x = __builtin_amdgcn_mfma_f32_16x16x32_bf16(cat44(*(const LAS v2u*)(RA + o), *(const LAS v2u*)(RA + o + 32)), tf, x, 0, 0, 0);
                y = __builtin_amdgcn_mfma_f32_16x16x32_bf16(cat44(*(const LAS v2u*)(RR + o), *(const LAS v2u*)(RR + o + 32)), tf, y, 0, 0, 0);
            }
            x = __builtin_amdgcn_mfma_f32_16x16x32_bf16(akaA, Vf, x, 0, 0, 0);
            const f32x4 ut = __builtin_amdgcn_mfma_f32_16x16x32_bf16(tmA, pack4z(x), (f32x4){0.f, 0.f, 0.f, 0.f}, 0, 0, 0);
            y = __builtin_amdgcn_mfma_f32_16x16x32_bf16(abrA, pack4z(ut), y, 0, 0, 0);
            y = __builtin_amdgcn_mfma_f32_16x16x32_bf16(akrA, Vf, y, 0, 0, 0);
            bf16x8 UV; { const v4u vw = __builtin_bit_cast(v4u, Vf); v4u w; w.x = pk2(ut[0], ut[1]); w.y = pk2(ut[2], ut[3]); w.z = vw.x; w.w = vw.y; UV = __builtin_bit_cast(bf16x8, w); }
#pragma unroll
            for (int jb = 0; jb < 4; ++jb) {
                const int tro = (4 * fq + tq) * RST + (16 * jb + 4 * tp) * 2;
                const v2u bt = __builtin_bit_cast(v2u, __builtin_amdgcn_ds_read_tr16_b64_v4i16((LAS v4i16_t*)(RB + tro))), kt = __builtin_bit_cast(v2u, __builtin_amdgcn_ds_read_tr16_b64_v4i16((LAS v4i16_t*)(RK + tro)));
                const f32x4 gc = *(const LAS f32x4*)(GC + 16 * jb + 4 * fq);
                T[jb] = __builtin_amdgcn_mfma_f32_16x16x32_bf16(cat44(bt, kt), UV, T[jb], 0, 0, 0); T[jb] = T[jb] * gc;
            }
            ring_done(fl, s, lane);
            { const int row0 = scan_row16(c, 0, b, d), stp = d ? -1 : 1;
#pragma unroll
              for (int e = 0; e < 4; ++e) yout[(size_t)(row0 + stp * (4 * fq + e)) * 512 + fr] = (bf16)f2bf(y[e]); }
        }
        __builtin_amdgcn_s_setprio(0);
    }
}

constexpr int MST = 272, MIMG = 16 * MST;
constexpr int MB_NSLOT = 5;
constexpr int MB_SLOT = 21504;
__device__ __forceinline__ void mamba_block(Frame& F, int unit, const bf16* PM, const float* DT, const float* a_log, bf16* YMB) {
    const int d = unit & 1, h = (unit >> 1) & 7, b = unit >> 4, grp = h >> 2;
    const int lane = F.lane, fr = lane & 15, fq = lane >> 4, tq = (lane & 15) >> 2, tp = lane & 3;
    volatile LAS unsigned* fl = (volatile LAS unsigned*)(F.lds + RING_FLAGS);
    __syncthreads();
    if (F.tid < 16) fl[F.tid] = 0u;
    __syncthreads();
    if (F.wave >= 4) {
        const int p = F.wave - 4;
        const float a_neg = -__expf(a_log[d * 8 + h]);
        v4u rB[4], rC[4], rX[2]; float rdt;
#define MB_LOAD(c_) do { \
        _Pragma("unroll") for (int i = 0; i < 4; ++i) { const int t = (lane >> 4) + 4 * i; const bf16* src = PM + (size_t)scan_row16((c_), t, b, d) * 1024 + 512 + grp * 128 + (lane & 15) * 8; rB[i] = *(const GAS v4u*)src; rC[i] = *(const GAS v4u*)(src + 256); } \
        _Pragma("unroll") for (int i = 0; i < 2; ++i) { const int id = lane + 64 * i; rX[i] = *(const GAS v4u*)(PM + (size_t)scan_row16((c_), id >> 3, b, d) * 1024 + h * 64 + (id & 7) * 8); } \
        rdt = DT[(size_t)scan_row16((c_), lane & 15, b, d) * 16 + d * 8 + h]; } while (0)
        MB_LOAD(p);
        for (int c = p; c < NCH16; c += 4) {
            const int s = c % MB_NSLOT;
            LAS unsigned char* sb = F.lds + s * MB_SLOT;
            LAS unsigned char* BR = sb; LAS unsigned char* CR = sb + MIMG; LAS unsigned char* RT = sb + 2 * MIMG; LAS unsigned char* KH = sb + 3 * MIMG; LAS unsigned char* VX = sb + 4 * MIMG;
            LAS unsigned char* FRG = sb + 4 * MIMG + RIMG; LAS float* scal = (LAS float*)(sb + 4 * MIMG + RIMG + 1024);
            ring_wait_free(fl, s, c, MB_NSLOT);
            float cs = rdt * a_neg;
            cs += dpp_shr<1>(cs); cs += dpp_shr<2>(cs); cs += dpp_shr<4>(cs); cs += dpp_shr<8>(cs);
            const float cse = __int_as_float(__builtin_amdgcn_readlane(__float_as_int(cs), 15));
            if (lane < 16) { scal[16 + lane] = cs; scal[32 + lane] = __expf(cs); scal[48 + lane] = rdt; scal[64 + lane] = __expf(cse - cs); }
            if (lane == 0) scal[0] = __expf(cse);
            asm volatile("s_waitcnt lgkmcnt(0)" ::: "memory");
#pragma unroll
            for (int i = 0; i < 4; ++i) { const int t = (lane >> 4) + 4 * i; const float sk = scal[64 + t], sr = scal[32 + t]; const int o = t * MST + (lane & 15) * 16;
                *(LAS v4u*)(BR + o) = rB[i]; *(LAS v4u*)(CR + o) = rC[i]; *(LAS v4u*)(KH + o) = scale8(rB[i], sk); *(LAS v4u*)(RT + o) = scale8(rC[i], sr); }
#pragma unroll
            for (int i = 0; i < 2; ++i) { const int id = lane + 64 * i; const int t = id >> 3; *(LAS v4u*)(VX + t * RST + (id & 7) * 16) = scale8(rX[i], scal[48 + t]); }
            if (c + 4 < NCH16) MB_LOAD(c + 4);
            asm volatile("s_waitcnt lgkmcnt(0)" ::: "memory");
            f32x4 akr = {0.f, 0.f, 0.f, 0.f};
#pragma unroll
            for (int kb = 0; kb < 4; ++kb) akr = __builtin_amdgcn_mfma_f32_16x16x32_bf16(*(const LAS bf16x8*)(BR + fr * MST + kb * 64 + fq * 16), *(const LAS bf16x8*)(CR + fr * MST + kb * 64 + fq * 16), akr, 0, 0, 0);
            const float cst = scal[16 + fr]; const f32x4 css = *(const LAS f32x4*)(scal + 16 + 4 * fq);
#pragma unroll
            for (int e = 0; e < 4; ++e) akr[e] = (4 * fq + e <= fr) ? akr[e] * __expf(cst - css[e]) : 0.f;
            *(LAS bf16x8*)(FRG + lane * 16) = pack4z(akr);
            ring_set_full(fl, s, c, lane);
        }
#undef MB_LOAD
    } else {
        const int q = F.wave;
        __builtin_amdgcn_s_setprio(3);
        bf16* yout = YMB + (size_t)d * M_ALL * 512 + h * 64 + 16 * q;
        unsigned long long prof_wait = 0ull; (void)prof_wait;
        f32x4 T[8];
#pragma unroll
        for (int jb = 0; jb < 8; ++jb) T[jb] = (f32x4){0.f, 0.f, 0.f, 0.f};
        for (int c = 0; c < NCH16; ++c) {
            const int s = c % MB_NSLOT;
            LAS unsigned char* sb = F.lds + s * MB_SLOT;
            LAS unsigned char* RT = sb + 2 * MIMG; LAS unsigned char* KH = sb + 3 * MIMG; LAS unsigned char* VX = sb + 4 * MIMG;
            LAS unsigned char* FRG = sb + 4 * MIMG + RIMG; LAS float* scal = (LAS float*)(sb + 4 * MIMG + RIMG + 1024);
#ifdef PROF_MBWAIT
            const unsigned long long tw0_ = __builtin_amdgcn_s_memrealtime();
#endif
            ring_wait_full(fl, s, c);
#ifdef PROF_MBWAIT
            prof_wait += __builtin_amdgcn_s_memrealtime() - tw0_;
#endif
#ifdef PROF_MBSEG
            unsigned long long ts0_ = __builtin_amdgcn_s_memrealtime();
#endif
            const bf16x8 akrA = *(const LAS bf16x8*)(FRG + lane * 16); const float gC = scal[0];
            const bf16x8 Vf = tr4z(VX + (4 * fq + tq) * RST + (16 * q + 4 * tp) * 2);
            f32x4 ya = {0.f, 0.f, 0.f, 0.f}, yb = __builtin_amdgcn_mfma_f32_16x16x32_bf16(akrA, Vf, (f32x4){0.f, 0.f, 0.f, 0.f}, 0, 0, 0);
#pragma unroll
            for (int jp = 0; jp < 4; ++jp) {
                const LAS unsigned char* rp = RT + fr * MST + (32 * jp + 4 * fq) * 2;
                const bf16x8 ra = cat44(*(const LAS v2u*)rp, *(const LAS v2u*)(rp + 32)), tf = pack8(T[2 * jp], T[2 * jp + 1]);
                if (jp & 1) yb = __builtin_amdgcn_mfma_f32_16x16x32_bf16(ra, tf, yb, 0, 0, 0); else ya = __builtin_amdgcn_mfma_f32_16x16x32_bf16(ra, tf, ya, 0, 0, 0);
            }
            const f32x4 y = ya + yb;
#ifdef PROF_MBSEG
            asm volatile("" :: "v"(y)); { const unsigned long long t_ = __builtin_amdgcn_s_memrealtime(); if (PROF_MBSEG == 1) prof_wait += t_ - ts0_; ts0_ = t_; }
#endif
#ifdef MB_CONS2X
            { f32x4 yd = {0.f, 0.f, 0.f, 0.f};
#pragma unroll
              for (int jp = 0; jp < 4; ++jp) { const LAS unsigned char* rp = RT + fr * MST + (32 * jp + 4 * fq) * 2 + 8;
                  yd = __builtin_amdgcn_mfma_f32_16x16x32_bf16(cat44(*(const LAS v2u*)rp, *(const LAS v2u*)(rp + 32)), pack8(T[2 * jp] * 1.0001f, T[2 * jp + 1] * 1.0001f), yd, 0, 0, 0); }
              yd = __builtin_amdgcn_mfma_f32_16x16x32_bf16(akrA, Vf, yd, 0, 0, 0);
              asm volatile("" :: "v"(yd)); }
#endif
#pragma unroll
            for (int jb = 0; jb < 8; ++jb) T[jb] = __builtin_amdgcn_mfma_f32_16x16x32_bf16(tr4z(KH + (4 * fq + tq) * MST + (16 * jb + 4 * tp) * 2), Vf, T[jb] * gC, 0, 0, 0);
#ifdef PROF_MBSEG
            asm volatile("" :: "v"(T[0]), "v"(T[7])); { const unsigned long long t_ = __builtin_amdgcn_s_memrealtime(); if (PROF_MBSEG == 2) prof_wait += t_ - ts0_; ts0_ = t_; }
#endif
            ring_done(fl, s, lane);
#ifdef PROF_MBSEG
            { const unsigned long long t_ = __builtin_amdgcn_s_memrealtime(); if (PROF_MBSEG == 3) prof_wait += t_ - ts0_; ts0_ = t_; }
#endif
            { const int row0 = scan_row16(c, 0, b, d), stp = d ? -1 : 1;
#pragma unroll
              for (int e = 0; e < 4; ++e) yout[(size_t)(row0 + stp * (4 * fq + e)) * 512 + fr] = (bf16)f2bf(y[e]); }
#ifdef PROF_MBSEG
            { const unsigned long long t_ = __builtin_amdgcn_s_memrealtime(); if (PROF_MBSEG == 4) prof_wait += t_ - ts0_; ts0_ = t_; }
#endif
        }
#if defined(PROF_MBWAIT) || defined(PROF_MBSEG)
        if (F.bid == 128 && F.tid == 0) __hip_atomic_store(F.ctl + 2, __float_as_uint((float)prof_wait * 0.01f), RLX_AGENT);
#endif
        __builtin_amdgcn_s_setprio(0);
    }
}

struct FinIn { const float *gn_w, *gn_b, *mb_d, *mb_norm_w; };
__device__ __forceinline__ void finish_phase(Frame& F, const FinIn& P, const bf16* YRW, const bf16* YMB, const bf16* PR, const bf16* PM, const float* BONUS, const bf16* GATE, const bf16* ZG, bf16* A) {
    const int gw = F.bid * NWAVES + F.wave, NGW = F.G * NWAVES; const int c0 = F.lane * 8, head = F.lane >> 3;
    float gnw[8], gnb[8], nw[8];
#pragma unroll
    for (int i = 0; i < 8; ++i) { gnw[i] = P.gn_w[c0 + i]; gnb[i] = P.gn_b[c0 + i]; nw[i] = P.mb_norm_w[c0 + i]; }
    const float dd = P.mb_d[head];
    struct FinIn9 { v4u y0, y1, vv, gg, m0, m1, xx, zz; float bon; };
    FinIn9 cur, nxt;
#define FIN_FETCH(R_, g_) do { const size_t gs_ = (size_t)(g_); \
        R_.y0 = *(const GAS v4u*)(YRW + gs_ * 512 + c0); R_.y1 = *(const GAS v4u*)(YRW + (size_t)M_ALL * 512 + gs_ * 512 + c0); R_.vv = *(const GAS v4u*)(PR + gs_ * PRV + 512 + c0); R_.gg = *(const GAS v4u*)(GATE + gs_ * 512 + c0); \
        R_.m0 = *(const GAS v4u*)(YMB + gs_ * 512 + c0); R_.m1 = *(const GAS v4u*)(YMB + (size_t)M_ALL * 512 + gs_ * 512 + c0); R_.xx = *(const GAS v4u*)(PM + gs_ * 1024 + c0); R_.zz = *(const GAS v4u*)(ZG + gs_ * 512 + c0); \
        R_.bon = BONUS[gs_ * 8 + head]; } while (0)
    if (gw < M_ALL) FIN_FETCH(cur, gw);
    for (int g = gw; g < M_ALL; g += NGW) {
        const size_t gs = (size_t)g;
        if (g + NGW < M_ALL) FIN_FETCH(nxt, g + NGW);
        const v4u y0 = cur.y0, y1 = cur.y1, vv = cur.vv, gg = cur.gg, m0 = cur.m0, m1 = cur.m1, xx = cur.xx, zz = cur.zz; const float bon = cur.bon;
        cur = nxt;
        float y[8], vf[8], gf[8];
#pragma unroll
        for (int i = 0; i < 4; ++i) { y[2 * i] = bflo(y0[i]) + bflo(y1[i]); y[2 * i + 1] = bfhi(y0[i]) + bfhi(y1[i]); vf[2 * i] = bflo(vv[i]); vf[2 * i + 1] = bfhi(vv[i]); gf[2 * i] = bflo(gg[i]); gf[2 * i + 1] = bfhi(gg[i]); }
        float s = 0.f;
#pragma unroll
        for (int i = 0; i < 8; ++i) s += y[i];
        s = sum8(s);
        const float mu = s * (1.f / 64.f); float q = 0.f;
#pragma unroll
        for (int i = 0; i < 8; ++i) { y[i] -= mu; q += y[i] * y[i]; }
        q = sum8(q);
        const float rstd = rsqrtf(q * (1.f / 64.f) + 64e-5f);
        float o[8];
#pragma unroll
        for (int i = 0; i < 8; ++i) o[i] = ((y[i] * rstd) * gnw[i] + gnb[i] + bon * vf[i]) * gf[i];
        v4u w; w.x = pk2(o[0], o[1]); w.y = pk2(o[2], o[3]); w.z = pk2(o[4], o[5]); w.w = pk2(o[6], o[7]);
        *(GAS v4u*)(A + gs * 1024 + c0) = w;
        float ym[8]; float ss = 0.f;
#pragma unroll
        for (int i = 0; i < 4; ++i) {
            const float z0 = bflo(zz[i]), z1 = bfhi(zz[i]);
            ym[2 * i] = (bflo(m0[i]) + bflo(m1[i]) + dd * bflo(xx[i])) * (z0 * sigm(z0)); ym[2 * i + 1] = (bfhi(m0[i]) + bfhi(m1[i]) + dd * bfhi(xx[i])) * (z1 * sigm(z1));
            ss += ym[2 * i] * ym[2 * i] + ym[2 * i + 1] * ym[2 * i + 1];
        }
        ss = half_sum(ss, F.lane);
        const float rr = rsqrtf(ss * (1.f / 256.f) + 1e-6f);
        v4u w2; w2.x = pk2(ym[0] * rr * nw[0], ym[1] * rr * nw[1]); w2.y = pk2(ym[2] * rr * nw[2], ym[3] * rr * nw[3]); w2.z = pk2(ym[4] * rr * nw[4], ym[5] * rr * nw[5]); w2.w = pk2(ym[6] * rr * nw[6], ym[7] * rr * nw[7]);
        *(GAS v4u*)(A + gs * 1024 + 512 + c0) = w2;
    }
#undef FIN_FETCH
}
#ifndef PROF_K
#define PROF_K 1e-5f
#endif
#ifndef PROF_PH0
#define PROF_PH0 PROF_PH
#endif
#ifndef PROF_OFF
#define PROF_OFF 0.f
#endif
__device__ __forceinline__ int fresh_lane() { int l; asm volatile("v_mbcnt_lo_u32_b32 %0, -1, 0\n\tv_mbcnt_hi_u32_b32 %0, -1, %0" : "=v"(l)); return l; }

__device__ __forceinline__ bf16x8 tr2(const LAS unsigned char* p0, const LAS unsigned char* p1) {
    const s16x4 t0 = __builtin_bit_cast(s16x4, __builtin_amdgcn_ds_read_tr16_b64_v4i16((LAS v4i16_t*)p0));
    const s16x4 t1 = __builtin_bit_cast(s16x4, __builtin_amdgcn_ds_read_tr16_b64_v4i16((LAS v4i16_t*)p1));
    bf16x8 r; r[0] = t0[0]; r[1] = t0[1]; r[2] = t0[2]; r[3] = t0[3]; r[4] = t1[0]; r[5] = t1[1]; r[6] = t1[2]; r[7] = t1[3]; return r;
}
__device__ __forceinline__ int swz(int row, int chunk) { return row * 128 + ((chunk ^ (row & 7)) << 4); }
constexpr int AT_CTXK = 0, AT_CTXV = 32768, AT_VRING = 65536, AT_NSLOT = 9, AT_RPB = AT_VRING + AT_NSLOT * 8192;
__device__ __forceinline__ void attn_phase(Frame& F, const bf16* Q, const bf16* K, const bf16* V, const float* rpb, bf16* O) {
    LAS unsigned char* ctxK = F.lds + AT_CTXK; LAS unsigned char* ctxV = F.lds + AT_CTXV; LAS unsigned char* vring = F.lds + AT_VRING; LAS float* rp = (LAS float*)(F.lds + AT_RPB);
    const int lane = F.lane, fr = lane & 15, fq = lane >> 4, tq = (lane & 15) >> 2, tp = lane & 3;
#ifndef ATT_REPS
#define ATT_REPS 1
#endif
    const int avcu = (F.G % 8 == 0) ? (F.bid % 8) * (F.G / 8) + F.bid / 8 : F.bid;
    for (int u_ = avcu; u_ < 256 * ATT_REPS; u_ += F.G) {
        const int u = u_ & 255; const int bh = u >> 1, half = u & 1, b = bh >> 4, h = bh & 15;
        const unsigned latbase = (unsigned)(M_CTX + b * SEQ);
        const int vcol = F.tid >> 3, vch = F.tid & 7;
        const unsigned vsrc = (unsigned)((latbase + vcol) * D + h * 64 + vch * 8);
        const int vdst = vcol * 128 + ((vch ^ (vcol & 7)) << 4);
        __syncthreads();
        {
            const int key = F.tid >> 1, hf = F.tid & 1; const size_t src = (size_t)(b * CTXL + key) * D + h * 64 + hf * 32;
#pragma unroll
            for (int i = 0; i < 4; ++i) { *(LAS v4u*)(ctxK + swz(key, hf * 4 + i)) = *(const GAS v4u*)(K + src + 8 * i); *(LAS v4u*)(ctxV + swz(key, hf * 4 + i)) = *(const GAS v4u*)(V + src + 8 * i); }
            if (F.tid < 465) rp[F.tid] = rpb[h * 465 + F.tid] * 1.4426950408889634f;
            const int r0 = 16 * half, lo0 = min(max(r0 - 4, 0), 24), hi0 = min(max(r0 + 1 - 4, 0), 24) + 7;
            for (int kr = lo0; kr <= hi0; ++kr) *(LAS v4u*)(vring + (kr % AT_NSLOT) * 8192 + vdst) = *(const GAS v4u*)(V + vsrc + (unsigned)(kr * 64 * D));
        }
        __syncthreads();
        for (int it = 0; it < 8; ++it) {
            const int ra = 16 * half + 2 * it;
            const int r = ra + (F.wave >> 2), j = F.wave & 3;
            const int rs = min(max(r - 4, 0), 24); const int kb = (j == 0) ? 0 : (j == 1) ? 8 : (j == 2) ? 24 : 32;
            const int qc = 16 * j + fr, wsq = min(max(qc - 8, 0), 48);
            const int hi = min(max(ra + 1 - 4, 0), 24) + 7, hin = (it < 7) ? (min(max(ra + 3 - 4, 0), 24) + 7) : hi;
            bf16x8 qf[2];
            { const bf16* qp = Q + (unsigned)((latbase + r * 64 + qc) * D + h * 64 + 8 * fq); qf[0] = *(const GAS bf16x8*)qp; qf[1] = *(const GAS bf16x8*)(qp + 32); }
            const int cv = kb + 4 * fq - wsq, cc2 = kb + 4 * fq - qc + 15;
            f32x4 sl[8][2], sc[16];
            const unsigned koff = (unsigned)((latbase + rs * 64 + kb + fr) * D + h * 64 + 8 * fq);
            bf16x8 kc[4], kn[4];
#pragma unroll
            for (int x = 0; x < 4; ++x) kc[x] = *(const GAS bf16x8*)(K + koff + (x >> 1) * 16 * D + (x & 1) * 32);
#pragma unroll
            for (int i = 0; i < 8; ++i) {
                const int brow = (rs + i - r + 7) * 31;
                if (i < 7) {
#pragma unroll
                    for (int x = 0; x < 4; ++x) kn[x] = *(const GAS bf16x8*)(K + koff + (unsigned)((i + 1) * 64 * D) + (x >> 1) * 16 * D + (x & 1) * 32);
                }
#pragma unroll
                for (int blk = 0; blk < 2; ++blk) {
                    f32x4 s = {0.f, 0.f, 0.f, 0.f};
                    s = __builtin_amdgcn_mfma_f32_16x16x32_bf16(kc[2 * blk], qf[0], s, 0, 0, 0);
                    s = __builtin_amdgcn_mfma_f32_16x16x32_bf16(kc[2 * blk + 1], qf[1], s, 0, 0, 0);
#pragma unroll
                    for (int e = 0; e < 4; ++e) s[e] = ((unsigned)(cv + 16 * blk + e) < 16u) ? (s[e] + rp[brow + min(max(cc2 + 16 * blk + e, 0), 30)]) : -INFINITY;
                    sl[i][blk] = s;
                }
#pragma unroll
                for (int x = 0; x < 4; ++x) kc[x] = kn[x];
            }
#pragma unroll
            for (int cb = 0; cb < 16; ++cb) {
                const int key = 16 * cb + fr;
                const bf16x8 k0 = *(const LAS bf16x8*)(ctxK + swz(key, fq)), k1 = *(const LAS bf16x8*)(ctxK + swz(key, 4 + fq));
                f32x4 s = {0.f, 0.f, 0.f, 0.f};
                s = __builtin_amdgcn_mfma_f32_16x16x32_bf16(k0, qf[0], s, 0, 0, 0);
                s = __builtin_amdgcn_mfma_f32_16x16x32_bf16(k1, qf[1], s, 0, 0, 0);
                sc[cb] = s;
            }
            v4u vnew[2];
#pragma unroll
            for (int n = 0; n < 2; ++n) if (hi + 1 + n <= hin) vnew[n] = *(const GAS v4u*)(V + vsrc + (unsigned)((hi + 1 + n) * 64 * D));
            float m = -INFINITY;
#pragma unroll
            for (int i = 0; i < 8; ++i)
#pragma unroll
                for (int blk = 0; blk < 2; ++blk)
#pragma unroll
                    for (int e = 0; e < 4; ++e) m = fmaxf(m, sl[i][blk][e]);
#pragma unroll
            for (int cb = 0; cb < 16; ++cb)
#pragma unroll
                for (int e = 0; e < 4; ++e) m = fmaxf(m, sc[cb][e]);
            m = fmaxf(m, __shfl_xor(m, 16)); m = fmaxf(m, __shfl_xor(m, 32));
            float l = 0.f;
#pragma unroll
            for (int i = 0; i < 8; ++i)
#pragma unroll
                for (int blk = 0; blk < 2; ++blk)
#pragma unroll
                    for (int e = 0; e < 4; ++e) { const float p = __builtin_amdgcn_exp2f(sl[i][blk][e] - m); sl[i][blk][e] = p; l += p; }
#pragma unroll
            for (int cb = 0; cb < 16; ++cb)
#pragma unroll
                for (int e = 0; e < 4; ++e) { const float p = __builtin_amdgcn_exp2f(sc[cb][e] - m); sc[cb][e] = p; l += p; }
            l += __shfl_xor(l, 16); l += __shfl_xor(l, 32);
            const float linv = __builtin_amdgcn_rcpf(l);
            f32x4 o[4];
#pragma unroll
            for (int db = 0; db < 4; ++db) o[db] = (f32x4){0.f, 0.f, 0.f, 0.f};
#pragma unroll
            for (int i = 0; i < 8; ++i) {
                const LAS unsigned char* vrow = vring + ((rs + i) % AT_NSLOT) * 8192;
                const bf16x8 pa = pack8(sl[i][0], sl[i][1]);
                const int c0 = kb + 4 * fq + tq, c1 = c0 + 16;
#pragma unroll
                for (int db = 0; db < 4; ++db) {
                    const int ch = 2 * db + (tp >> 1), wi = 8 * (tp & 1);
                    const bf16x8 vb = tr2(vrow + swz(c0, ch) + wi, vrow + swz(c1, ch) + wi);
                    o[db] = __builtin_amdgcn_mfma_f32_16x16x32_bf16(pa, vb, o[db], 0, 0, 0);
                }
            }
#pragma unroll
            for (int cc = 0; cc < 8; ++cc) {
                const bf16x8 pa = pack8(sc[2 * cc], sc[2 * cc + 1]);
                const int k0 = 32 * cc + 4 * fq + tq, k1 = k0 + 16;
#pragma unroll
                for (int db = 0; db < 4; ++db) {
                    const int ch = 2 * db + (tp >> 1), wi = 8 * (tp & 1);
                    const bf16x8 vb = tr2(ctxV + swz(k0, ch) + wi, ctxV + swz(k1, ch) + wi);
                    o[db] = __builtin_amdgcn_mfma_f32_16x16x32_bf16(pa, vb, o[db], 0, 0, 0);
                }
            }
#pragma unroll
            for (int e = 0; e < 4; ++e) {
                const float li = __shfl(linv, 4 * fq + e);
                bf16* op = O + (unsigned)((b * SEQ + r * 64 + 16 * j + 4 * fq + e) * D + h * 64 + fr);
#pragma unroll
                for (int db = 0; db < 4; ++db) op[db * 16] = (bf16)f2bf(o[db][e] * li);
            }
            __syncthreads();
#pragma unroll
            for (int n = 0; n < 2; ++n) if (hi + 1 + n <= hin) *(LAS v4u*)(vring + ((hi + 1 + n) % AT_NSLOT) * 8192 + vdst) = vnew[n];
            __syncthreads();
        }
    }
}

template <bool PRE = false> __device__ __forceinline__ void router_phase(Frame& F, const float* hlat, const float* g, const float* mods_l, const float* router_w, const float* router_b, bf16* A4, unsigned* tokinfo, gu32* cntb, const float* plog = nullptr) {
    LAS int* se = (LAS int*)F.lds;
    LAS float* sg = (LAS float*)(F.lds + 512);
    LAS int* srow = (LAS int*)(F.lds + 1024);
    LAS unsigned* spos = (LAS unsigned*)(F.lds + 1280);
    const int gw = F.bid * NWAVES + F.wave, NGW = F.G * NWAVES;
    const int nbatch = (M_LAT + NGW * 8 - 1) / (NGW * 8);
    LAS float* srw = (LAS float*)(F.lds + 2048);
    __syncthreads();
    if constexpr (!PRE) for (int i = F.tid; i < 2048; i += NTHR) ((LAS f32x4*)srw)[i] = ((const GAS f32x4*)router_w)[i];
    f32x4 gg[4];
#pragma unroll
    for (int j = 0; j < 4; ++j) gg[j] = ((const GAS f32x4*)g)[F.lane + 64 * j];
    RowIn cur, nxt;
#define RT_FETCH(R_, r_) do { const float* mp_ = mods_l + ((r_) >> 11) * 6144; row_fetch(R_, hlat + (size_t)(r_) * D, mp_ + 3072, mp_ + 4096, F.lane); } while (0)
    if constexpr (!PRE) { if (gw < M_LAT) RT_FETCH(cur, gw); }
    for (int bt = 0; bt < nbatch; ++bt) {
        __syncthreads();
#pragma unroll 1
        for (int k = 0; k < 8; ++k) {
            const int r = gw + (bt * 8 + k) * NGW, slot = F.wave * 8 + k;
            if (r >= M_LAT) { if (F.lane == 0) { se[2 * slot] = -1; se[2 * slot + 1] = -1; srow[slot] = 0; } continue; }
            float lg[8];
            if constexpr (PRE) {
                const GAS f32x4* pl = (const GAS f32x4*)(plog + (size_t)r * 32); f32x4 q[8];
#pragma unroll
                for (int i = 0; i < 8; ++i) q[i] = pl[i];
#pragma unroll
                for (int e = 0; e < 4; ++e) { lg[e] = ((q[0][e] + q[2][e]) + (q[4][e] + q[6][e])) + router_b[e]; lg[4 + e] = ((q[1][e] + q[3][e]) + (q[5][e] + q[7][e])) + router_b[4 + e]; }
            } else {
            if (r + NGW < M_LAT) RT_FETCH(nxt, r + NGW);
            f32x4 a[4]; row_finish(cur, gg, A4 + (size_t)r * D, F.lane, a);
            cur = nxt;
#pragma unroll
            for (int e = 0; e < 8; ++e) lg[e] = 0.f;
#pragma unroll
            for (int j = 0; j < 4; ++j)
#pragma unroll
                for (int x = 0; x < 4; ++x) { const LAS float* rw = srw + ((F.lane + 64 * j) * 4 + x) * 8; const f32x4 w0 = *(const LAS f32x4*)rw, w1 = *(const LAS f32x4*)(rw + 4); const float av = a[j][x];
#pragma unroll
                    for (int e = 0; e < 4; ++e) { lg[e] += av * w0[e]; lg[4 + e] += av * w1[e]; } }
#pragma unroll
            for (int e = 0; e < 8; ++e) lg[e] = wave_sum(lg[e]) + router_b[e];
            }
            int e0 = 0; float v0 = lg[0];
#pragma unroll
            for (int e = 1; e < 8; ++e) if (lg[e] > v0) { v0 = lg[e]; e0 = e; }
            int e1 = -1; float v1 = -INFINITY;
#pragma unroll
            for (int e = 0; e < 8; ++e) if (e != e0 && lg[e] > v1) { v1 = lg[e]; e1 = e; }
            const float g0 = 1.f / (1.f + __expf(v1 - v0)), g1 = 1.f - g0;
            if (F.lane == 0) { se[2 * slot] = e0; se[2 * slot + 1] = e1; sg[2 * slot] = g0; sg[2 * slot + 1] = g1; srow[slot] = r; }
        }
        __syncthreads();
        if (F.wave == 0) {
            const int l = F.lane; const int ea = se[l], eb = se[64 + l];
            const unsigned long long below = (l == 0) ? 0ull : (~0ull >> (64 - l));
            unsigned ra = 0u, rb = 0u, tot = 0u;
#pragma unroll
            for (int e = 0; e < 8; ++e) {
                const unsigned long long ma = __ballot(ea == e), mb = __ballot(eb == e);
                const unsigned ca = (unsigned)__popcll(ma), cb = (unsigned)__popcll(mb);
                if (ea == e) ra = (unsigned)__popcll(ma & below);
                if (eb == e) rb = ca + (unsigned)__popcll(mb & below);
                if (l == e) tot = ca + cb;
            }
            if (l < 8) cntb[(size_t)(bt * F.G + F.bid) * 8 + l] = tot;
            spos[l] = ra; spos[64 + l] = rb;
            asm volatile("s_waitcnt lgkmcnt(0)" ::: "memory");
            if (se[2 * l] >= 0) {
                v4u t0; t0.x = (unsigned)se[2 * l]; t0.y = spos[2 * l]; t0.z = __float_as_uint(sg[2 * l]); t0.w = (unsigned)se[2 * l + 1];
                v4u t1; t1.x = spos[2 * l + 1]; t1.y = __float_as_uint(sg[2 * l + 1]); t1.z = 0u; t1.w = 0u;
                const size_t row = (size_t)srow[l];
                *(GAS v4u*)(tokinfo + row * 8) = t0; *(GAS v4u*)(tokinfo + row * 8 + 4) = t1;
            }
        }
    }
}
#undef RT_FETCH
__device__ __forceinline__ void moe_bases(gu32* cnt, int (&tb)[9]) {
    int acc = 0;
#pragma unroll
    for (int e = 0; e < 8; ++e) { tb[e] = acc; const unsigned c = __hip_atomic_load(cnt + 64 * e, RLX_AGENT); acc += (int)((c + 255u) >> 8); }
    tb[8] = acc;
}
#ifndef MOE_TAIL_SPLIT
#define MOE_TAIL_SPLIT 1
#endif
__device__ __forceinline__ void moe_tail_split(const int (&tb)[9], int G, int& first, int& ntail) {
    const int U = tb[8] * 4; first = (U / G) * G; ntail = U - first;
    if (first == 0 || (first & 3) || ntail > 32) { first = U; ntail = 0; }
#if !MOE_TAIL_SPLIT
    first = U; ntail = 0;
#endif
}
__device__ __forceinline__ void gather_phase(Frame& F, const bf16* A4, unsigned* tokinfo, gu32* cnt, const gu32* cntb, bf16* XG) {
    const int gw = F.bid * NWAVES + F.wave, NGW = F.G * NWAVES;
    const int nbatch = (M_LAT + NGW * 8 - 1) / (NGW * 8), nent = nbatch * F.G;
    LAS float* sred = (LAS float*)F.lds;
    __syncthreads();
    if (F.wave == 0) {
        float tot[8];
#pragma unroll
        for (int e = 0; e < 8; ++e) tot[e] = 0.f;
        for (int i = F.lane; i < nent; i += 64) { const v4u a = *(const GAS v4u*)(cntb + (size_t)i * 8), b = *(const GAS v4u*)(cntb + (size_t)i * 8 + 4);
            tot[0] += (float)a.x; tot[1] += (float)a.y; tot[2] += (float)a.z; tot[3] += (float)a.w; tot[4] += (float)b.x; tot[5] += (float)b.y; tot[6] += (float)b.z; tot[7] += (float)b.w; }
#pragma unroll
        for (int e = 0; e < 8; ++e) { const float s = wave_sum(tot[e]); if (F.lane == 0) sred[e] = s; }
        for (int bt = 0; bt < nbatch; ++bt) {
            const int mine = bt * F.G + F.bid; float pre[8];
#pragma unroll
            for (int e = 0; e < 8; ++e) pre[e] = 0.f;
            for (int i = F.lane; i < mine; i += 64) { const v4u a = *(const GAS v4u*)(cntb + (size_t)i * 8), b = *(const GAS v4u*)(cntb + (size_t)i * 8 + 4);
                pre[0] += (float)a.x; pre[1] += (float)a.y; pre[2] += (float)a.z; pre[3] += (float)a.w; pre[4] += (float)b.x; pre[5] += (float)b.y; pre[6] += (float)b.z; pre[7] += (float)b.w; }
#pragma unroll
            for (int e = 0; e < 8; ++e) { const float s = wave_sum(pre[e]); if (F.lane == 0) sred[8 + 8 * bt + e] = s; }
        }
    }
    __syncthreads();
    int tb[9]; { int acc = 0;
#pragma unroll
        for (int e = 0; e < 8; ++e) { tb[e] = acc; const unsigned c = (unsigned)sred[e]; acc += (int)((c + 255u) >> 8); if (F.bid == 0 && F.wave == 0 && fresh_lane() == 0) __hip_atomic_store(cnt + 64 * e, c, RLX_AGENT); }
        tb[8] = acc; }
    struct GIn { v4u t0, t1, x0, x1; };
    GIn cur, nxt;
#define G_FETCH(R_, r_) do { R_.t0 = *(const GAS v4u*)(tokinfo + (size_t)(r_) * 8); R_.t1 = *(const GAS v4u*)(tokinfo + (size_t)(r_) * 8 + 4); \
        const GAS v4u* s_ = (const GAS v4u*)(A4 + (size_t)(r_) * D); R_.x0 = s_[F.lane]; R_.x1 = s_[F.lane + 64]; } while (0)
    if (gw < M_LAT) G_FETCH(cur, gw);
    int k = 0;
    for (int r = gw; r < M_LAT; r += NGW, ++k) {
        if (r + NGW < M_LAT) G_FETCH(nxt, r + NGW);
        const v4u t0 = cur.t0, t1 = cur.t1, x0 = cur.x0, x1 = cur.x1; cur = nxt;
        const LAS float* pre = sred + 8 + 8 * (k >> 3);
        int tbe0 = 0, tbe1 = 0; unsigned pr0 = 0u, pr1 = 0u;
#pragma unroll
        for (int e = 0; e < 8; ++e) { if ((int)t0.x == e) { tbe0 = tb[e]; pr0 = (unsigned)pre[e]; } if ((int)t0.w == e) { tbe1 = tb[e]; pr1 = (unsigned)pre[e]; } }
        const unsigned row0 = (unsigned)tbe0 * 256u + pr0 + t0.y, row1 = (unsigned)tbe1 * 256u + pr1 + t1.x;
        GAS v4u* d0 = (GAS v4u*)(XG + (size_t)row0 * D); GAS v4u* d1 = (GAS v4u*)(XG + (size_t)row1 * D);
        d0[F.lane] = x0; d0[F.lane + 64] = x1; d1[F.lane] = x0; d1[F.lane + 64] = x1;
        if (F.lane == 0) { tokinfo[(size_t)r * 8 + 6] = row0; tokinfo[(size_t)r * 8 + 7] = row1; }
    }
#undef G_FETCH
}
__device__ __forceinline__ f32x4 moe_y4(const bf16* YG, const float* slab, unsigned row, int j, int lane, unsigned tailrow0, int first, int ntail) {
    if (row < tailrow0) { const v2u a = ((const GAS v2u*)(YG + (size_t)row * D) + lane)[64 * j]; return (f32x4){bflo(a.x), bfhi(a.x), bflo(a.y), bfhi(a.y)}; }
    const size_t kstride = (size_t)(ntail >> 2) * 256 * 1024; const float* p = slab + (size_t)(row - tailrow0) * 1024 + (lane + 64 * j) * 4; f32x4 s = {0.f, 0.f, 0.f, 0.f};
    for (int ks = 0; ks < 11; ++ks) s += *(const GAS f32x4*)(p + ks * kstride);
    const unsigned w0 = pk2(s[0], s[1]), w1 = pk2(s[2], s[3]);
    return (f32x4){bflo(w0), bfhi(w0), bflo(w1), bfhi(w1)};
}
__device__ __forceinline__ void final_phase(Frame& F, float* hout, const bf16* YG, const unsigned* tokinfo, const float* mods_l, const float* norm_final, const float* slab, gu32* cnt) {
    const int gw = F.bid * NWAVES + F.wave, NGW = F.G * NWAVES;
    int tb[9]; moe_bases(cnt, tb); int first, ntail; moe_tail_split(tb, F.G, first, ntail); const unsigned tailrow0 = (unsigned)(first >> 2) * 256u;
#if defined(PROF_PH) || defined(PROF_SCANWAIT) || defined(PROF_MBWAIT) || defined(PROF_MBSEG)
#ifdef PROF_RAW
    const float prof_scale = 1.f + sqrtf(fmaxf((float)(__hip_atomic_load(F.ctl + 2, RLX_AGENT) - __hip_atomic_load(F.ctl + 4, RLX_AGENT)) * 0.01f - (PROF_OFF), 0.f) * PROF_K);
#else
    const float prof_scale = 1.f + sqrtf(__uint_as_float(__hip_atomic_load(F.ctl + 2, RLX_AGENT)) * PROF_K);
#endif
#else
    const float prof_scale = 1.f;
#endif
    for (int r = gw; r < M_LAT; r += NGW) {
        const v4u t0 = *(const GAS v4u*)(tokinfo + (size_t)r * 8), t1 = *(const GAS v4u*)(tokinfo + (size_t)r * 8 + 4);
        const float g0 = __uint_as_float(t0.z), g1 = __uint_as_float(t1.y); const unsigned row0 = t1.z, row1 = t1.w;
        const float* mp = mods_l + (r >> 11) * 6144 + 5120;
        GAS f32x4* hr = (GAS f32x4*)(hout + (size_t)r * D) + F.lane;
        f32x4 v[4]; float ss = 0.f;
#pragma unroll
        for (int j = 0; j < 4; ++j) {
            const f32x4 hh = hr[64 * j], mm = ((const GAS f32x4*)mp)[F.lane + 64 * j];
            const f32x4 ya = moe_y4(YG, slab, row0, j, F.lane, tailrow0, first, ntail), yb = moe_y4(YG, slab, row1, j, F.lane, tailrow0, first, ntail);
            v[j] = hh + mm * (ya * g0 + yb * g1);
            ss += (v[j].x * v[j].x + v[j].y * v[j].y) + (v[j].z * v[j].z + v[j].w * v[j].w);
        }
        const float rs = rsqrtf(wave_sum(ss) * (1.f / 1024.f) + 1e-6f);
#pragma unroll
        for (int j = 0; j < 4; ++j) { const f32x4 gg = ((const GAS f32x4*)norm_final)[F.lane + 64 * j]; hr[64 * j] = (v[j] * (rs * prof_scale)) * gg; }
    }
}

constexpr int NPHASE = 19;
#ifndef MK_PER_PHASE
#define MK_PER_PHASE 0
#endif
struct Args { const float* in[39]; float* out; unsigned char* ws; int ph_lo, ph_hi; };
#define KARGP(k) (((void* const __attribute__((address_space(4)))*)__builtin_amdgcn_kernarg_segment_ptr())[k])
#define KARG(k) ((const float*)KARGP(k))
__global__ void __launch_bounds__(NWAVES * 64, 2) mk_fwd(Args args) {
    extern __shared__ __attribute__((aligned(16))) unsigned char lds[];
    Frame F;
    F.lds = (LAS unsigned char*)lds; F.MISC = (volatile LAS unsigned*)(F.lds + MISC_OFF);
    F.tid = threadIdx.x; F.lane = F.tid & 63; F.wave = __builtin_amdgcn_readfirstlane(F.tid >> 6); F.G = gridDim.x; F.bid = blockIdx.x;
    unsigned char* ws = (unsigned char*)KARGP(40); F.ctl = (gu32*)(ws + WS_CTL);
    for (int u = F.tid; u < (LDS_BYTES - LDSCTL_OFF) / 4; u += NWAVES * 64) ((LAS unsigned*)(F.lds + LDSCTL_OFF))[u] = 0u;
    __syncthreads();
    const int lo = args.ph_lo, hi = args.ph_hi;
    unsigned long long prof_t0 = 0ull; (void)prof_t0;
    XcdBarrier bar; bar.bar = (unsigned*)(F.ctl + CW_BAR); bar.x = 0; bar.st = nullptr;
    if (hi - lo > 1) bar = xcd_barrier_post((unsigned*)(F.ctl + CW_BAR), F.MISC + 8);
#ifdef PH_MASK
#define IN(k) ((((PH_MASK) >> (k)) & 1) && lo <= (k) && (k) < hi)
#else
#define IN(k) (lo <= (k) && (k) < hi)
#endif
#ifndef DUP_MASK
#define DUP_MASK 0
#endif
#ifdef PROF_PH
#define PROF_T0(k) do { if ((k) == PROF_PH0 && F.bid == 0 && F.wave == 0 && fresh_lane() == 0) __hip_atomic_store(F.ctl + 4, (unsigned)__builtin_amdgcn_s_memrealtime(), RLX_AGENT); } while (0)
#ifdef PROF_RAW
#define PROF_T1(k) do { if ((k) == PROF_PH && F.bid == 0 && F.wave == 0 && fresh_lane() == 0) __hip_atomic_store(F.ctl + 2, (unsigned)__builtin_amdgcn_s_memrealtime(), RLX_AGENT); } while (0)
#else
#define PROF_T1(k) do { if ((k) == PROF_PH && F.bid == 0 && F.wave == 0 && fresh_lane() == 0) { const unsigned t1_ = (unsigned)__builtin_amdgcn_s_memrealtime(); __hip_atomic_store(F.ctl + 2, __float_as_uint(fmaxf((float)(t1_ - __hip_atomic_load(F.ctl + 4, RLX_AGENT)) * 0.01f - (PROF_OFF), 0.f)), RLX_AGENT); } } while (0)
#endif
#else
#define PROF_T0(k) do {} while (0)
#define PROF_T1(k) do {} while (0)
#endif
#define REPS(k) (1 + (((DUP_MASK) >> (k)) & 1))
#ifdef DOUBLE_BAR
#define SEAM(k) do { if (IN(k) && IN((k) + 1)) { xcd_barrier(bar); xcd_barrier(bar); } } while (0)
#else
#define SEAM(k) do { if (IN(k) && IN((k) + 1)) xcd_barrier(bar); } while (0)
#endif
    const float* x = KARG(0); const float* ctx = KARG(2);
    float* mods = (float*)(ws + WS_MODS); float* hctx = (float*)(ws + WS_HCTX); float* hlat = (float*)KARGP(39);
    bf16* A = (bf16*)(ws + WS_A);
    const int vcu = (F.G % 8 == 0) ? (F.bid % 8) * (F.G / 8) + F.bid / 8 : F.bid;

#define DENSEW(lo_, hi_, widx_, nw_) dense_weight_phase(F, KARG(9), KARG(10), KARG(28), KARG(29), KARG(30), KARG(31), KARG(32), ws, lo_, hi_, widx_, nw_)
    PROF_T0(0); if (IN(0)) for (int rep_ = 0; rep_ < REPS(0); ++rep_) { if (rep_) __syncthreads(); F.lane = fresh_lane(); F.tid = F.wave * 64 + F.lane; p0_phase(F, KARG(1), KARG(3), KARG(4), KARG(5), mods, KARG(9), KARG(10), KARG(28), KARG(29), KARG(30), KARG(31), KARG(32), ws); }
    SEAM(0); PROF_T1(0);
    PROF_T0(1); if (IN(1)) for (int rep_ = 0; rep_ < REPS(1); ++rep_) { if (rep_) __syncthreads(); F.lane = fresh_lane(); F.tid = F.wave * 64 + F.lane; normmod_phase(F, ctx, x, KARG(6), mods, 0, 1024, A); }
    SEAM(1); PROF_T1(1);
    PROF_T0(2); if (IN(2)) for (int rep_ = 0; rep_ < REPS(2); ++rep_) { if (rep_) __syncthreads(); F.lane = fresh_lane(); F.tid = F.wave * 64 + F.lane;
        pg8::Gemm g{A, (const bf16*)(ws + WS_WIN_T), M_ALL, ZLD, D}; pg8::StaticOrder S; S.init(M_ALL, ZLD, F.G, F.bid);
        pg8::EpiBf16<0> E{(bf16*)(ws + WS_Z), ZLD, nullptr, 0, 0, 1.f};
        pg8::gemm_phase<pg8::EpiBf16<0>, pg8::StaticOrder, true, true>(F.lds, g, S, E);
        { const int nfull = ((M_ALL / 256) * (ZLD / 256)) % F.G;
          if (nfull != 0 && F.bid >= nfull) DENSEW(DW_P0_END, DW_P2_END, F.bid - nfull, F.G - nfull); else if (nfull == 0) DENSEW(DW_P0_END, DW_P2_END, F.bid, F.G); }
    }
    SEAM(2); PROF_T1(2);
    PROF_T0(3); if (IN(3)) for (int rep_ = 0; rep_ < REPS(3); ++rep_) { if (rep_) __syncthreads(); F.lane = fresh_lane(); F.tid = F.wave * 64 + F.lane;
        PrepIn P{KARG(11), KARG(12), KARG(13), KARG(14), KARG(15), KARG(16), KARG(17), KARG(18), KARG(19), KARG(22), KARG(23), KARG(24)};
        prepare_phase(F, P, (const bf16*)(ws + WS_Z), (bf16*)(ws + WS_PR), (bf16*)(ws + WS_PM), (float*)(ws + WS_DT), (float*)(ws + WS_BONUS), (bf16*)(ws + WS_GATE), (bf16*)(ws + WS_ZG));
    }
    SEAM(3); PROF_T1(3);
    PROF_T0(4); if (IN(4)) for (int rep_ = 0; rep_ < REPS(4); ++rep_) { if (rep_) __syncthreads(); F.lane = fresh_lane(); F.tid = F.wave * 64 + F.lane;
        for (int u = F.bid; u < 256; u += F.G) {
            if (u < 128) { rwkv_block(F, u, (const bf16*)(ws + WS_PR), (bf16*)(ws + WS_YRW));
#ifdef RWKV2X
                rwkv_block(F, u, (const bf16*)(ws + WS_PR), (bf16*)(ws + WS_YRW));
#endif
            }
            else { mamba_block(F, u - 128, (const bf16*)(ws + WS_PM), (const float*)(ws + WS_DT), KARG(25), (bf16*)(ws + WS_YMB));
#ifdef MAMBA2X
                   mamba_block(F, u - 128, (const bf16*)(ws + WS_PM), (const float*)(ws + WS_DT), KARG(25), (bf16*)(ws + WS_YMB));
#endif
            }
        }
    }
    SEAM(4); PROF_T1(4);
    PROF_T0(5); if (IN(5)) for (int rep_ = 0; rep_ < REPS(5); ++rep_) { if (rep_) __syncthreads(); F.lane = fresh_lane(); F.tid = F.wave * 64 + F.lane;
        FinIn P{KARG(20), KARG(21), KARG(26), KARG(27)};
        finish_phase(F, P, (const bf16*)(ws + WS_YRW), (const bf16*)(ws + WS_YMB), (const bf16*)(ws + WS_PR), (const bf16*)(ws + WS_PM), (const float*)(ws + WS_BONUS), (const bf16*)(ws + WS_GATE), (const bf16*)(ws + WS_ZG), A);
    }
    SEAM(5); PROF_T1(5);
    PROF_T0(6); if (IN(6)) for (int rep_ = 0; rep_ < REPS(6); ++rep_) { if (rep_) __syncthreads(); F.lane = fresh_lane(); F.tid = F.wave * 64 + F.lane;
        {
            pg8::Gemm g{A + (size_t)M_CTX * D, (const bf16*)(ws + WS_WOUT_T), M_LAT, D, D}; pg8::StaticOrder S; S.init(M_LAT, D, F.G, F.bid);
            if (F.G == 256) { pg8::EpiResGateNorm E{x, hlat, mods, 2048, KARG(7), 3072, 4096, (bf16*)(ws + WS_A2) + (size_t)M_CTX * D, (float*)(ws + WS_XBUF), (unsigned*)(F.ctl + CW_XCNT)};
                pg8::gemm_phase<pg8::EpiResGateNorm, pg8::StaticOrder, true, true>(F.lds, g, S, E); }
            else { pg8::EpiResGate E{x, x, hlat, hlat, mods, 2048, 0};
                pg8::gemm_phase<pg8::EpiResGate, pg8::StaticOrder, true, true>(F.lds, g, S, E); }
        }
        { int l_; asm volatile("v_mbcnt_lo_u32_b32 %0, -1, 0\n\tv_mbcnt_hi_u32_b32 %0, -1, %0" : "=v"(l_) :: "memory"); F.lane = l_; F.tid = F.wave * 64 + F.lane; }
        {
            pg8::Gemm g{A, (const bf16*)(ws + WS_WOUT_T), M_CTX, D, 256, D}; pg8::SplitKOrder S{8, 4, 4, 256, F.G, F.bid};
            pg8::EpiSlabGate E{(float*)(ws + WS_SLAB6), mods + 8 * 6144 + 2048, 256};
            pg8::gemm_phase<pg8::EpiSlabGate, pg8::SplitKOrder, true, true>(F.lds, g, S, E);
        }
        { const int nsub = 8 * 4 * 4; if (F.G > nsub && F.bid >= nsub) { DENSEW(DW_P2_END, DW_P6_END, F.bid - nsub, F.G - nsub); moe_weight_phase(F, KARG(36), KARG(37), KARG(38), ws, 0, MOE_ITEMS_P6, F.bid - nsub, F.G - nsub); }
          else if (F.G <= nsub) { DENSEW(DW_P2_END, DW_P6_END, F.bid, F.G); moe_weight_phase(F, KARG(36), KARG(37), KARG(38), ws, 0, MOE_ITEMS_P6, F.bid, F.G); } }
    }
    SEAM(6); PROF_T1(6);
    PROF_T0(7); if (IN(7)) for (int rep_ = 0; rep_ < REPS(7); ++rep_) { if (rep_) __syncthreads(); F.lane = fresh_lane(); F.tid = F.wave * 64 + F.lane; normmod_phase(F, ctx, hlat, KARG(7), mods, 3072, 4096, (bf16*)(ws + WS_A2), (const float*)(ws + WS_SLAB6), 4, hctx, F.G == 256 ? M_CTX : M_ALL); moe_weight_phase(F, KARG(36), KARG(37), KARG(38), ws, MOE_ITEMS_P6, MOE_ITEMS_P7, F.bid, F.G); }
    SEAM(7); PROF_T1(7);
    PROF_T0(8); if (IN(8)) for (int rep_ = 0; rep_ < REPS(8); ++rep_) { if (rep_) __syncthreads(); F.lane = fresh_lane(); F.tid = F.wave * 64 + F.lane;
        pg8::Gemm g{(const bf16*)(ws + WS_A2), (const bf16*)(ws + WS_W13_T), M_ALL, 2 * FF, D}; pg8::StaticOrder S; S.init(M_ALL, 2 * FF, F.G, F.bid);
        pg8::EpiSwiGLU E{(bf16*)(ws + WS_HID), FF, 1 << 20};
        pg8::gemm_phase<pg8::EpiSwiGLU, pg8::StaticOrder, true, true>(F.lds, g, S, E);
        {
            const int nfull = ((M_ALL / 256) * (2 * FF / 256)) % F.G;
            if (nfull != 0 && F.bid >= nfull) { DENSEW(DW_P6_END, DW_P8_END, F.bid - nfull, F.G - nfull); moe_weight_phase(F, KARG(36), KARG(37), KARG(38), ws, MOE_ITEMS_P7, MOE_ITEMS_P7 + MOE_ITEMS_P8, F.bid - nfull, F.G - nfull); }
            else if (nfull == 0) { DENSEW(DW_P6_END, DW_P8_END, F.bid, F.G); moe_weight_phase(F, KARG(36), KARG(37), KARG(38), ws, MOE_ITEMS_P7, MOE_ITEMS_P7 + MOE_ITEMS_P8, F.bid, F.G); }
        }
    }
    SEAM(8); PROF_T1(8);
    PROF_T0(9); if (IN(9)) for (int rep_ = 0; rep_ < REPS(9); ++rep_) { if (rep_) __syncthreads(); F.lane = fresh_lane(); F.tid = F.wave * 64 + F.lane;
        {
            pg8::Gemm g{(const bf16*)(ws + WS_HID) + (size_t)M_CTX * FF, (const bf16*)(ws + WS_W2_T), M_LAT, D, FF}; pg8::StaticOrder S; S.init(M_LAT, D, F.G, F.bid);
            if (F.G == 256) { pg8::EpiResGateNorm E{hlat, hlat, mods, 5120, KARG(6) + D, 0, 1024, A + (size_t)M_CTX * D, (float*)(ws + WS_XBUF) + 65536, (unsigned*)(F.ctl + CW_XCNT + 4096)};
                E.mods_l = mods; E.off_shift = 9 * 6144; E.off_scale = 9 * 6144 + 1024;
                pg8::gemm_phase<pg8::EpiResGateNorm, pg8::StaticOrder, true, true>(F.lds, g, S, E); }
            else { pg8::EpiResGate E{hlat, hlat, hlat, hlat, mods, 5120, 0};
                pg8::gemm_phase<pg8::EpiResGate, pg8::StaticOrder, true, true>(F.lds, g, S, E); }
        }
        { int l_; asm volatile("v_mbcnt_lo_u32_b32 %0, -1, 0\n\tv_mbcnt_hi_u32_b32 %0, -1, %0" : "=v"(l_) :: "memory"); F.lane = l_; F.tid = F.wave * 64 + F.lane; }
        {
            pg8::Gemm g{(const bf16*)(ws + WS_HID), (const bf16*)(ws + WS_W2_T), M_CTX, D, 1408, FF}; pg8::SplitKOrder S{8, 4, 2, 1408, F.G, F.bid};
            pg8::EpiSlabGate E{(float*)(ws + WS_SLAB9), mods + 8 * 6144 + 5120, 1408};
            pg8::gemm_phase<pg8::EpiSlabGate, pg8::SplitKOrder, true, true>(F.lds, g, S, E);
        }
        {
            const int nsub = 8 * 4 * 2;
            if (F.G > nsub) { if (F.bid >= nsub) { DENSEW(DW_P8_END, DW_P9_END, F.bid - nsub, F.G - nsub); moe_weight_phase(F, KARG(36), KARG(37), KARG(38), ws, MOE_ITEMS_P7 + MOE_ITEMS_P8, MOE_ITEMS_P7 + MOE_ITEMS_P8 + MOE_ITEMS_P9, F.bid - nsub, F.G - nsub); } }
            else { DENSEW(DW_P8_END, DW_P9_END, F.bid, F.G); moe_weight_phase(F, KARG(36), KARG(37), KARG(38), ws, MOE_ITEMS_P7 + MOE_ITEMS_P8, MOE_ITEMS_P7 + MOE_ITEMS_P8 + MOE_ITEMS_P9, F.bid, F.G); }
        }
    }
    SEAM(9); PROF_T1(9);
    const float* mods1 = mods + 9 * 6144;
    PROF_T0(10); if (IN(10)) for (int rep_ = 0; rep_ < REPS(10); ++rep_) { if (rep_) __syncthreads(); F.lane = fresh_lane(); F.tid = F.wave * 64 + F.lane; normmod_phase(F, hctx, hlat, KARG(6) + D, mods1, 0, 1024, A, (const float*)(ws + WS_SLAB9), 2, nullptr, F.G == 256 ? M_CTX : M_ALL); }
    SEAM(10); PROF_T1(10);
    PROF_T0(11); if (IN(11)) for (int rep_ = 0; rep_ < REPS(11); ++rep_) { if (rep_) __syncthreads(); F.lane = fresh_lane(); F.tid = F.wave * 64 + F.lane;
        pg8::Gemm g{A, (const bf16*)(ws + WS_QKV_T), M_ALL, 3 * D, D}; pg8::StaticOrder S; S.init(M_ALL, 3 * D, F.G, F.bid);
        pg8::EpiBf16<0> E{(bf16*)(ws + WS_Q), D, nullptr, D, (size_t)M_ALL * D, 0.125f * 1.4426950408889634f};
        pg8::gemm_phase<pg8::EpiBf16<0>, pg8::StaticOrder, true, true>(F.lds, g, S, E);
        {
            const int nfull = ((M_ALL / 256) * (3 * D / 256)) % F.G;
            if (nfull != 0 && F.bid >= nfull) { DENSEW(DW_P9_END, DW_END, F.bid - nfull, F.G - nfull); moe_weight_phase(F, KARG(36), KARG(37), KARG(38), ws, MOE_ITEMS - MOE_ITEMS_P16 - MOE_ITEMS_P11, MOE_ITEMS - MOE_ITEMS_P16, F.bid - nfull, F.G - nfull); }
            else if (nfull == 0) { DENSEW(DW_P9_END, DW_END, F.bid, F.G); moe_weight_phase(F, KARG(36), KARG(37), KARG(38), ws, MOE_ITEMS - MOE_ITEMS_P16 - MOE_ITEMS_P11, MOE_ITEMS - MOE_ITEMS_P16, F.bid, F.G); }
        }
    }
    SEAM(11); PROF_T1(11);
    PROF_T0(12); if (IN(12)) for (int rep_ = 0; rep_ < REPS(12); ++rep_) { if (rep_) __syncthreads(); F.lane = fresh_lane(); F.tid = F.wave * 64 + F.lane; attn_phase(F, (const bf16*)(ws + WS_Q), (const bf16*)(ws + WS_K), (const bf16*)(ws + WS_V), KARG(33), (bf16*)(ws + WS_O)); }
    SEAM(12); PROF_T1(12);
    PROF_T0(13); if (IN(13)) for (int rep_ = 0; rep_ < REPS(13); ++rep_) { if (rep_) __syncthreads(); F.lane = fresh_lane(); F.tid = F.wave * 64 + F.lane;
        pg8::Gemm g{(const bf16*)(ws + WS_O), (const bf16*)(ws + WS_NAO_T), M_LAT, D, D}; pg8::StaticOrder S; S.init(M_LAT, D, F.G, F.bid);
        if (F.G == 256) { pg8::EpiResGateNormT<true> E{hlat, hlat, mods1, 2048, KARG(7) + D, 3072, 4096, (bf16*)(ws + WS_A4), (float*)(ws + WS_XBUF) + 131072, (unsigned*)(F.ctl + CW_XCNT + 8192), KARG(34), (float*)(ws + WS_PLOG)};
            pg8::gemm_phase<pg8::EpiResGateNormT<true>, pg8::StaticOrder, true, true>(F.lds, g, S, E); }
        else { pg8::EpiResGate E{hlat, hlat, hlat, hlat, mods1, 2048, 0};
            pg8::gemm_phase<pg8::EpiResGate, pg8::StaticOrder, true, true>(F.lds, g, S, E); }
    }
    SEAM(13); PROF_T1(13);
    PROF_T0(14); if (IN(14)) for (int rep_ = 0; rep_ < REPS(14); ++rep_) { if (rep_) __syncthreads(); F.lane = fresh_lane(); F.tid = F.wave * 64 + F.lane; if (F.G == 256) router_phase<true>(F, hlat, KARG(7) + D, mods1, KARG(34), KARG(35), (bf16*)(ws + WS_A4), (unsigned*)(ws + WS_TOK), F.ctl + CW_CNTB, (const float*)(ws + WS_PLOG));
        else router_phase<false>(F, hlat, KARG(7) + D, mods1, KARG(34), KARG(35), (bf16*)(ws + WS_A4), (unsigned*)(ws + WS_TOK), F.ctl + CW_CNTB); }
    SEAM(14); PROF_T1(14);
    PROF_T0(15); if (IN(15)) for (int rep_ = 0; rep_ < REPS(15); ++rep_) { if (rep_) __syncthreads(); F.lane = fresh_lane(); F.tid = F.wave * 64 + F.lane; gather_phase(F, (const bf16*)(ws + WS_A4), (unsigned*)(ws + WS_TOK), F.ctl + CW_CNT, F.ctl + CW_CNTB, (bf16*)(ws + WS_XG)); }
    SEAM(15); PROF_T1(15);
    PROF_T0(16); if (IN(16)) for (int rep_ = 0; rep_ < REPS(16); ++rep_) { if (rep_) __syncthreads(); F.lane = fresh_lane(); F.tid = F.wave * 64 + F.lane;
        pg8::MoeOrder S; moe_bases(F.ctl + CW_CNT, S.tb); S.ntn = 22; S.G = F.G; S.c = vcu;
        pg8::Gemm g{(const bf16*)(ws + WS_XG), (const bf16*)(ws + WS_MOEW13), MOE_ROWS, NE * 2 * FF, D};
        pg8::EpiSwiGLU E{(bf16*)(ws + WS_HIDG), FF, 22};
        pg8::gemm_phase<pg8::EpiSwiGLU, pg8::MoeOrder, true, true>(F.lds, g, S, E);
        {
            const int nlast = (S.tb[8] * 22) % F.G;
            if (nlast != 0 && vcu >= nlast) moe_weight_phase(F, KARG(36), KARG(37), KARG(38), ws, MOE_ITEMS - MOE_ITEMS_P16, MOE_ITEMS, vcu - nlast, F.G - nlast);
            else if (nlast == 0) moe_weight_phase(F, KARG(36), KARG(37), KARG(38), ws, MOE_ITEMS - MOE_ITEMS_P16, MOE_ITEMS, F.bid, F.G);
        }
    }
    SEAM(16); PROF_T1(16);
    PROF_T0(17); if (IN(17)) for (int rep_ = 0; rep_ < REPS(17); ++rep_) { if (rep_) __syncthreads(); F.lane = fresh_lane(); F.tid = F.wave * 64 + F.lane;
        pg8::MoeOrder S; moe_bases(F.ctl + CW_CNT, S.tb); S.ntn = 4; S.G = F.G; S.c = vcu;
        int first, ntail; moe_tail_split(S.tb, F.G, first, ntail); S.limit = first;
        {
            pg8::Gemm g{(const bf16*)(ws + WS_HIDG), (const bf16*)(ws + WS_MOEW2), MOE_ROWS, NE * D, FF};
            pg8::EpiPlainMod E{(bf16*)(ws + WS_YG), D, 4};
            pg8::gemm_phase<pg8::EpiPlainMod, pg8::MoeOrder, true, true>(F.lds, g, S, E);
        }
#if MOE_TAIL_SPLIT
        if (ntail > 0) {
            pg8::MoeTailOrder ST;
#pragma unroll
            for (int k = 0; k < 9; ++k) ST.tb[k] = S.tb[k];
            ST.first = first; ST.ntail = ntail; ST.G = F.G; ST.c = vcu;
            pg8::Gemm g{(const bf16*)(ws + WS_HIDG), (const bf16*)(ws + WS_MOEW2), MOE_ROWS, NE * D, 256, FF};
            pg8::EpiTailSlab E{(float*)(ws + WS_TAIL), first, ntail};
            pg8::gemm_phase<pg8::EpiTailSlab, pg8::MoeTailOrder, true, true>(F.lds, g, ST, E);
        }
#endif
    }
    SEAM(17); PROF_T1(17);
    PROF_T0(18); if (IN(18)) for (int rep_ = 0; rep_ < REPS(18); ++rep_) { if (rep_) __syncthreads(); F.lane = fresh_lane(); F.tid = F.wave * 64 + F.lane; final_phase(F, hlat, (const bf16*)(ws + WS_YG), (const unsigned*)(ws + WS_TOK), mods1, KARG(8), (const float*)(ws + WS_TAIL), F.ctl + CW_CNT); }
#undef IN
#undef SEAM
}

extern "C" void kernel_launch(void* const* d_in, const int* in_sizes, int n_in, void* d_out, int out_size, void* d_ws, size_t ws_size, hipStream_t stream) {
    static int grid = 0;
    if (grid == 0) {
        if (n_in != 39 || out_size != M_LAT * D || ws_size < WS_END) { fprintf(stderr, "kernel_launch: unexpected shapes (n_in %d, out %d, ws %zu)\n", n_in, out_size, ws_size); grid = -1; return; }
        int dev = 0, cus = 0, per_cu = 0;
        if (hipGetDevice(&dev) != hipSuccess || hipDeviceGetAttribute(&cus, hipDeviceAttributeMultiprocessorCount, dev) != hipSuccess) { grid = -1; return; }
        if (hipFuncSetAttribute((const void*)mk_fwd, hipFuncAttributeMaxDynamicSharedMemorySize, LDS_BYTES) != hipSuccess) { fprintf(stderr, "kernel_launch: hipFuncSetAttribute failed\n"); grid = -1; return; }
        if (hipOccupancyMaxActiveBlocksPerMultiprocessor(&per_cu, (const void*)mk_fwd, NWAVES * 64, LDS_BYTES) != hipSuccess || per_cu < 1) fprintf(stderr, "kernel_launch: occupancy query says %d\n", per_cu);
        (void)hipGetLastError();
        grid = cus;
    }
    if (grid < 0) return;
    if (hipMemsetAsync((char*)d_ws + WS_CTL, 0, CTL_ZERO_BYTES, stream) != hipSuccess) return;
    Args a{};
    for (int i = 0; i < 39; ++i) a.in[i] = (const float*)d_in[i];
    a.out = (float*)d_out; a.ws = (unsigned char*)d_ws;
#if MK_PER_PHASE
    for (int p = 0; p < NPHASE; ++p) { a.ph_lo = p; a.ph_hi = p + 1; hipLaunchKernelGGL(mk_fwd, dim3(grid), dim3(NWAVES * 64), LDS_BYTES, stream, a); }
#else
    a.ph_lo = 0; a.ph_hi = NPHASE; hipLaunchKernelGGL(mk_fwd, dim3(grid), dim3(NWAVES * 64), LDS_BYTES, stream, a);
#endif
}
```

```cpp
#include <hip/hip_runtime.h>
#include <cstdio>
#include <cstdint>
#include <cmath>
#define MK_PER_PHASE 0
namespace pg8 {
#define PG8_LAS __attribute__((address_space(3)))
typedef unsigned short bf16_t;
typedef short bf16x8 __attribute__((ext_vector_type(8)));
typedef float f32x4 __attribute__((ext_vector_type(4)));
typedef unsigned u32x4 __attribute__((ext_vector_type(4)));
constexpr int BM = 256, BK = 64, HALF = 128, HTB = HALF * BK * 2  , STAGE_BYTES = 8 * HTB, NXCD = 8, WGM = 8;

__host__ __device__ __forceinline__ int lds_byte(int r, int c) { const int st = (r >> 4) * 2 + (c >> 5), rr = r & 15, cc = c & 31, ob = rr * 64 + cc * 2; return st * 1024 + (ob ^ (((ob >> 9) & 1) << 5)); }
__host__ __device__ __forceinline__ void stage_rc(int b, int& R, int& C) { const int st = b / 1024, sb = b % 1024, swz = sb ^ (((sb >> 9) & 1) << 5); R = (st >> 1) * 16 + swz / 64; C = (st & 1) * 32 + (swz % 64) / 2; }
__host__ __device__ __forceinline__ int perm32(int rho) { const int n = rho >> 4, i = rho & 15; return 8 * (i >> 2) + 4 * n + (i & 3); }

#ifndef PG8_WT
#define PG8_WT 0
#endif
#if PG8_WT
#define PG8_ST16(base_, ptr_, v_) __builtin_amdgcn_raw_buffer_store_b128((v_), __builtin_amdgcn_make_buffer_rsrc((void*)(base_), (short)0, 0x7fffffff, 0x00020000), (int)((const char*)(ptr_) - (const char*)(base_)), 0, 16)
#else
#define PG8_ST16(base_, ptr_, v_) (*(u32x4*)(ptr_) = (v_))
#endif
struct Unit { int pm, pn; int k0 = 0; };
struct Gemm { const bf16_t* A; const bf16_t* Bt; int M, N, K; int ld = 0; int ablk = 0; int bblk = 0; };

struct StaticOrder {
    int nM, nN, nwg, G, c;
    __host__ __device__ void init(int M, int N, int G_, int c_) { nM = M / BM; nN = N / BM; nwg = nM * nN; G = G_; c = c_; }
    __host__ __device__ bool next(int i, Unit& u) const {
        const long L = (long)i * G + c; if (L >= nwg) return false;
        int wgid = (int)L; { const int q = nwg / NXCD, r = nwg % NXCD, xcd = wgid % NXCD, off = wgid / NXCD; wgid = (xcd < r ? xcd * (q + 1) : r * (q + 1) + (xcd - r) * q) + off; }
        const int nig = WGM * nN, gid = wgid / nig, fm = gid * WGM, gsz = (nM - fm) < WGM ? (nM - fm) : WGM;
        u.pm = fm + ((wgid % nig) % gsz); u.pn = (wgid % nig) / gsz; return true;
    }
    __device__ __forceinline__ void a_ready(const Unit&) const {}
    __device__ __forceinline__ void done(const Unit&) const {}
};

__device__ __forceinline__ unsigned cvt_pk_bf16(float lo, float hi) { unsigned r; asm volatile("v_cvt_pk_bf16_f32 %0, %1, %2" : "=v"(r) : "v"(lo), "v"(hi)); return r; }
typedef float f32x2 __attribute__((ext_vector_type(2)));
__device__ __forceinline__ f32x2 gelu_pk(f32x2 v) {
    const f32x2 av = __builtin_elementwise_abs(v), d = av * 0.2316418882f + 1.0f;
    f32x2 t; t.x = __builtin_amdgcn_rcpf(d.x); t.y = __builtin_amdgcn_rcpf(d.y);
    f32x2 q = t * 0.5307027145f + (-0.7265760135f); q = q * t + 0.7107068705f; q = q * t + (-0.142248368f); q = q * t + 0.127414796f; q = q * t;
    const f32x2 s = (v * v) * (-0.72134752044f);
    f32x2 e; e.x = __builtin_amdgcn_exp2f(s.x); e.y = __builtin_amdgcn_exp2f(s.y);
    const f32x2 m = v * (q * e), r = v - m;
    f32x2 o; o.x = v.x < 0.f ? m.x : r.x; o.y = v.y < 0.f ? m.y : r.y; return o;
}

template <int ACT  > struct EpiBf16 {
    static constexpr bool PERM = true, AFTER_DRAIN = false; static_assert(ACT == 0 || ACT == 1, "EpiBf16: ACT is 0 (none) or 1 (gelu_pk)");
    bf16_t* O; int ldc; const float* bias; int split_cols; size_t split_stride; float scale0;
    __device__ __forceinline__ void operator()(const f32x4 (&acc)[2][2][4][2], const Unit& u, int wr, int wc, int fr, int fq) const {
        const int row0 = u.pm * BM + wr * 64 + fr; int colt = u.pn * BM; bf16_t* base = O;
        float sc = 1.f; if (split_cols) { const int t = colt / split_cols; base += (size_t)t * split_stride; colt -= t * split_cols; if (t == 0) sc = scale0; }
        const int col0 = colt + wc * 32 + 8 * fq, bcol0 = u.pn * BM + wc * 32 + 8 * fq;
        f32x4 bv[2][2];
#pragma unroll
        for (int bj = 0; bj < 2; ++bj)
#pragma unroll
            for (int n = 0; n < 2; ++n) bv[bj][n] = bias ? *(const f32x4*)(bias + bcol0 + bj * HALF + 4 * n) : (f32x4){0.f, 0.f, 0.f, 0.f};
#pragma unroll
        for (int ai = 0; ai < 2; ++ai)
#pragma unroll
            for (int m = 0; m < 4; ++m) { bf16_t* rowp = base + (size_t)(row0 + ai * HALF + m * 16) * ldc + col0;
#pragma unroll
                for (int bj = 0; bj < 2; ++bj) { f32x4 v0 = acc[ai][bj][m][0] + bv[bj][0], v1 = acc[ai][bj][m][1] + bv[bj][1];
                    if (ACT == 1) { f32x2 a = gelu_pk((f32x2){v0[0], v0[1]}), b = gelu_pk((f32x2){v0[2], v0[3]}), c = gelu_pk((f32x2){v1[0], v1[1]}), d = gelu_pk((f32x2){v1[2], v1[3]});
                        v0 = (f32x4){a.x, a.y, b.x, b.y}; v1 = (f32x4){c.x, c.y, d.x, d.y}; }
                    v0 = v0 * sc; v1 = v1 * sc; u32x4 w; w.x = cvt_pk_bf16(v0[0], v0[1]); w.y = cvt_pk_bf16(v0[2], v0[3]); w.z = cvt_pk_bf16(v1[0], v1[1]); w.w = cvt_pk_bf16(v1[2], v1[3]);
                    PG8_ST16(base, rowp + bj * HALF, w); } }
    }
};
template <class Epi, class Sched, bool ALIGN_EPI = false, bool SP2 = false>
__device__ __forceinline__ void gemm_phase(PG8_LAS unsigned char* lds, const Gemm g, const Sched& S, const Epi& E) {
    int tid_ = threadIdx.x; asm volatile("" : "+v"(tid_) :: "memory");
    const int tid = tid_, wid = __builtin_amdgcn_readfirstlane(tid >> 6), lane = tid & 63, wr = wid >> 2, wc = wid & 3, fr = lane & 15, fq = lane >> 4;
    const int K = g.K, nt = K / BK, LD = g.ld ? g.ld : g.K, LDA = g.ablk ? BK : LD, LDB = g.bblk ? BK : LD;
    unsigned voffA[2], voffB[2];
#pragma unroll
    for (int i = 0; i < 2; ++i) { int R, C; stage_rc(tid * 16 + i * 8192, R, C); const int Rb = Epi::PERM ? ((R & ~31) + perm32(R & 31)) : R;
        voffA[i] = (unsigned)(R * LDA + C) * 2u; voffB[i] = (unsigned)(Rb * LDB + C) * 2u; }
    const size_t kstep = (size_t)(BK * 2);
    const size_t hstep = (size_t)HALF * LD * 2;
    const size_t tstep = 2 * hstep;
    const size_t kstepA = g.ablk ? (size_t)(BM * BK * 2) : kstep, hstepA = (size_t)HALF * LDA * 2, tstepA = g.ablk ? (size_t)g.ablk * (BM * BK * 2) : 2 * hstepA;
    const size_t kstepB = g.bblk ? (size_t)(BM * BK * 2) : kstep, hstepB = (size_t)HALF * LDB * 2, tstepB = g.bblk ? (size_t)g.bblk * (BM * BK * 2) : 2 * hstepB;
#define PG8_K0B(k0_) (g.bblk ? (size_t)((k0_) / BK) * (size_t)(BM * BK * 2) : (size_t)(k0_) * 2)
#define PG8_K0A(k0_) (g.ablk ? (size_t)((k0_) / BK) * (size_t)(BM * BK * 2) : (size_t)(k0_) * 2)
    const unsigned ldsw = (unsigned)wid * 1024u;
    const int aoff = lds_byte(wr * 64 + fr, fq * 8), boff = lds_byte(wc * 32 + fr, fq * 8);
#define PG8_SA(b, h) (((b) * 2 + (h)) * HTB)
#define PG8_SB(b, h) ((4 + (b) * 2 + (h)) * HTB)
#define PG8_STAGE(bufoff, gbase, voff) do { _Pragma("unroll") for (int _i = 0; _i < 2; ++_i) \
        __builtin_amdgcn_global_load_lds((const unsigned*)((const char*)(gbase) + (voff)[_i]), (PG8_LAS unsigned*)(lds + (bufoff) + ldsw + _i * 8192), 16, 0, 0); } while (0)
#define PG8_LDA(dst, b, h) do { _Pragma("unroll") for (int m = 0; m < 4; ++m) _Pragma("unroll") for (int k = 0; k < 2; ++k) dst[m][k] = *(const PG8_LAS bf16x8*)(lds + PG8_SA(b, h) + aoff + m * 2048 + k * 1024); } while (0)
#define PG8_LDB(dst, b, h) do { _Pragma("unroll") for (int n = 0; n < 2; ++n) _Pragma("unroll") for (int k = 0; k < 2; ++k) dst[n][k] = *(const PG8_LAS bf16x8*)(lds + PG8_SB(b, h) + boff + n * 2048 + k * 1024); } while (0)
#define PG8_MMA(ai, bj, At, Bt) do { __builtin_amdgcn_s_setprio(1); _Pragma("unroll") for (int m = 0; m < 4; ++m) _Pragma("unroll") for (int n = 0; n < 2; ++n) _Pragma("unroll") for (int k = 0; k < 2; ++k) \
        acc[ai][bj][m][n] = __builtin_amdgcn_mfma_f32_16x16x32_bf16(Bt[n][k], At[m][k], acc[ai][bj][m][n], 0, 0, 0); __builtin_amdgcn_s_setprio(0); } while (0)
#define PG8_WAIT_V(n) asm volatile("s_waitcnt vmcnt(" #n ")" ::: "memory")
#define PG8_WAIT_L(n) asm volatile("s_waitcnt lgkmcnt(" #n ")" ::: "memory")
#define PG8_BAR __builtin_amdgcn_s_barrier()
#define PG8_SCHED __builtin_amdgcn_sched_barrier(0)
    Unit cur, nxt; int ui = 0;
    if (!S.next(0, cur)) return;
    f32x4 acc[2][2][4][2];
#pragma unroll
    for (int a = 0; a < 2; ++a)
#pragma unroll
        for (int b = 0; b < 2; ++b)
#pragma unroll
            for (int m = 0; m < 4; ++m)
#pragma unroll
                for (int n = 0; n < 2; ++n) acc[a][b][m][n] = (f32x4){0.f, 0.f, 0.f, 0.f};
    bf16x8 At[4][2], B0[2][2], B1[2][2];
    const char* cA = (const char*)g.A + (size_t)cur.pm * tstepA + PG8_K0A(cur.k0); const char* cB = (const char*)g.Bt + (size_t)cur.pn * tstepB + PG8_K0B(cur.k0);
    S.a_ready(cur);
    if constexpr (SP2) {
        PG8_STAGE(PG8_SB(0, 0), cB, voffB); PG8_STAGE(PG8_SB(0, 1), cB + hstepB, voffB); PG8_STAGE(PG8_SA(0, 0), cA, voffA); PG8_STAGE(PG8_SA(0, 1), cA + hstepA, voffA);
        if (wr == 1) PG8_BAR;
        PG8_WAIT_V(2); PG8_BAR;
        PG8_STAGE(PG8_SB(1, 0), cB + kstepB, voffB); PG8_STAGE(PG8_SA(1, 0), cA + kstepA, voffA); PG8_STAGE(PG8_SB(1, 1), cB + hstepB + kstepB, voffB);
        PG8_WAIT_V(6); PG8_BAR;
    } else {
        PG8_STAGE(PG8_SB(0, 0), cB, voffB); PG8_STAGE(PG8_SA(0, 0), cA, voffA); PG8_STAGE(PG8_SB(0, 1), cB + hstepB, voffB); PG8_STAGE(PG8_SA(0, 1), cA + hstepA, voffA);
        if (wr == 1) PG8_BAR;
        PG8_WAIT_V(4); PG8_BAR;
        PG8_STAGE(PG8_SB(1, 0), cB + kstepB, voffB); PG8_STAGE(PG8_SA(1, 0), cA + kstepA, voffA); PG8_STAGE(PG8_SB(1, 1), cB + hstepB + kstepB, voffB);
        PG8_WAIT_V(6); PG8_BAR;
    }
    for (;;) {
        const bool has_next = S.next(ui + 1, nxt);
        const char* nA = has_next ? (const char*)g.A + (size_t)nxt.pm * tstepA + PG8_K0A(nxt.k0) : cA; const char* nB = has_next ? (const char*)g.Bt + (size_t)nxt.pn * tstepB + PG8_K0B(nxt.k0) : cB;
        for (int t = 0; t < nt; t += 2) {
            const bool last = (t == nt - 2);
            const char* a1 = cA + (size_t)(t + 1) * kstepA;
            const char* a2 = last ? nA : cA + (size_t)(t + 2) * kstepA; const char* b2 = last ? nB : cB + (size_t)(t + 2) * kstepB;
            const char* a3 = a2 + kstepA; const char* b3 = b2 + kstepB;
            if (last && has_next) S.a_ready(nxt);
            if constexpr (SP2) {
            PG8_LDB(B0, 0, 0); PG8_LDB(B1, 0, 1); PG8_SCHED; PG8_LDA(At, 0, 0); PG8_STAGE(PG8_SA(1, 1), a1 + hstepA, voffA);
            PG8_WAIT_V(8); PG8_WAIT_L(0); PG8_BAR; PG8_MMA(0, 0, At, B0); PG8_MMA(0, 1, At, B1); PG8_BAR; PG8_SCHED;
            PG8_LDA(At, 0, 1); PG8_STAGE(PG8_SB(0, 0), b2, voffB); PG8_STAGE(PG8_SB(0, 1), b2 + hstepB, voffB); PG8_STAGE(PG8_SA(0, 0), a2, voffA);
            PG8_WAIT_V(8); PG8_WAIT_L(0); PG8_BAR; PG8_MMA(1, 0, At, B0); PG8_MMA(1, 1, At, B1); PG8_BAR; PG8_SCHED;
            PG8_LDB(B0, 1, 0); PG8_LDB(B1, 1, 1); PG8_SCHED; PG8_LDA(At, 1, 0); PG8_STAGE(PG8_SA(0, 1), a2 + hstepA, voffA);
            PG8_WAIT_V(8); PG8_WAIT_L(0); PG8_BAR; PG8_MMA(0, 0, At, B0); PG8_MMA(0, 1, At, B1); PG8_BAR; PG8_SCHED;
            PG8_LDA(At, 1, 1); PG8_STAGE(PG8_SB(1, 0), b3, voffB); PG8_STAGE(PG8_SB(1, 1), b3 + hstepB, voffB); PG8_STAGE(PG8_SA(1, 0), a3, voffA);
            PG8_WAIT_V(8); PG8_WAIT_L(0); PG8_BAR; PG8_MMA(1, 0, At, B0); PG8_MMA(1, 1, At, B1); PG8_BAR; PG8_SCHED;
            } else {
            PG8_LDB(B0, 0, 0); PG8_SCHED; PG8_LDA(At, 0, 0); PG8_STAGE(PG8_SA(1, 1), a1 + hstepA, voffA);
            PG8_WAIT_L(8); PG8_BAR; PG8_WAIT_L(0); PG8_MMA(0, 0, At, B0); PG8_BAR; PG8_SCHED;
            PG8_LDB(B1, 0, 1); PG8_STAGE(PG8_SB(0, 0), b2, voffB);
            PG8_BAR; PG8_WAIT_L(0); PG8_MMA(0, 1, At, B1); PG8_BAR;
            PG8_LDA(At, 0, 1); PG8_STAGE(PG8_SA(0, 0), a2, voffA);
            PG8_BAR; PG8_WAIT_L(0); PG8_MMA(1, 0, At, B0); PG8_BAR; PG8_SCHED;
            PG8_STAGE(PG8_SB(0, 1), b2 + hstepB, voffB);
            PG8_WAIT_V(6); PG8_BAR; PG8_MMA(1, 1, At, B1); PG8_BAR;
            PG8_LDB(B0, 1, 0); PG8_SCHED; PG8_LDA(At, 1, 0); PG8_STAGE(PG8_SA(0, 1), a2 + hstepA, voffA);
            PG8_WAIT_L(8); PG8_BAR; PG8_WAIT_L(0); PG8_MMA(0, 0, At, B0); PG8_BAR; PG8_SCHED;
            PG8_LDB(B1, 1, 1); PG8_STAGE(PG8_SB(1, 0), b3, voffB);
            PG8_BAR; PG8_WAIT_L(0); PG8_MMA(0, 1, At, B1); PG8_BAR;
            PG8_LDA(At, 1, 1); PG8_STAGE(PG8_SA(1, 0), a3, voffA);
            PG8_BAR; PG8_WAIT_L(0); PG8_MMA(1, 0, At, B0); PG8_BAR; PG8_SCHED;
            PG8_STAGE(PG8_SB(1, 1), b3 + hstepB, voffB);
            PG8_WAIT_V(6); PG8_BAR; PG8_MMA(1, 1, At, B1); PG8_BAR;
            }
        }
        if constexpr (ALIGN_EPI) { if (wr == 0) PG8_BAR; }
        if constexpr (!Epi::AFTER_DRAIN) { E(acc, cur, wr, wc, fr, fq); S.done(cur); }
        if (!has_next) break;
#pragma unroll
        for (int a = 0; a < 2; ++a)
#pragma unroll
            for (int b = 0; b < 2; ++b)
#pragma unroll
                for (int m = 0; m < 4; ++m)
#pragma unroll
                    for (int n = 0; n < 2; ++n) acc[a][b][m][n] = (f32x4){0.f, 0.f, 0.f, 0.f};
        cur = nxt; cA = nA; cB = nB; ++ui;
        if constexpr (ALIGN_EPI) { if (wr == 1) PG8_BAR; }
    }
    PG8_WAIT_V(0);
    if constexpr (!ALIGN_EPI) { if (wr == 0) PG8_BAR; }
    PG8_BAR;
    if constexpr (Epi::AFTER_DRAIN) { E.fused(acc, cur, wr, wc, fr, fq, lds, wid, lane); S.done(cur); }
#undef PG8_SA
#undef PG8_SB
#undef PG8_STAGE
#undef PG8_LDA
#undef PG8_LDB
#undef PG8_MMA
#undef PG8_WAIT_V
#undef PG8_WAIT_L
#undef PG8_BAR
#undef PG8_SCHED
}
}

#define GAS __attribute__((address_space(1)))
#define LAS __attribute__((address_space(3)))
typedef unsigned short bf16;
typedef unsigned v4u __attribute__((ext_vector_type(4)));
typedef float f32x4 __attribute__((ext_vector_type(4)));
typedef short bf16x8 __attribute__((ext_vector_type(8)));
typedef GAS unsigned gu32;
typedef GAS unsigned long long gu64;
#define RLX_AGENT __ATOMIC_RELAXED, __HIP_MEMORY_SCOPE_AGENT
#define LDS_WAIT() asm volatile("s_waitcnt lgkmcnt(0)" ::: "memory")
#define VM_WAIT() asm volatile("s_waitcnt vmcnt(0)" ::: "memory")
__device__ __forceinline__ unsigned long long rt() { return __builtin_amdgcn_s_memrealtime(); }
typedef float f32x2_t __attribute__((ext_vector_type(2))); typedef __bf16 bf16x2_t __attribute__((ext_vector_type(2)));
__device__ __forceinline__ unsigned pk2(float lo, float hi) { const f32x2_t v = {lo, hi}; const bf16x2_t b = __builtin_convertvector(v, bf16x2_t); return __builtin_bit_cast(unsigned, b); }
__device__ __forceinline__ unsigned f2bf(float f) { return pk2(f, f) & 0xffffu; }
#define XB_TMO      128
#define XB_XCNT(j)  (256  + 64 * (j))
#define XB_XSUB(j)  (1280 + 64 * (j))
#define XB_XGEN(j)  (2304 + 64 * (j))
#define XB_TOP      3328
#define XB_TOPGEN   3392
#define XCD_BAR_WORDS 3456
#define XB_SPIN_CAP (1u << 18)

__device__ __forceinline__ unsigned xb_ld(unsigned* p)              { return __hip_atomic_load(p, __ATOMIC_RELAXED, __HIP_MEMORY_SCOPE_AGENT); }
__device__ __forceinline__ unsigned xb_add(unsigned* p, unsigned v) { return __hip_atomic_fetch_add(p, v, __ATOMIC_RELAXED, __HIP_MEMORY_SCOPE_AGENT); }
__device__ __forceinline__ unsigned xb_xcc_id() { return (unsigned)__builtin_amdgcn_s_getreg((3 << 11) | 20) & 0xFu; }
#define XB_SPIN(cond, bar) do { unsigned _sp = 0; while (cond) { __builtin_amdgcn_s_sleep(1); \
    if ((++_sp & 255u) == 0u) { if (xb_ld(&(bar)[XB_TMO])) break; if (_sp > XB_SPIN_CAP) { atomicAdd(&(bar)[XB_TMO], 1u); break; } } } } while (0)

struct XcdBarrier {
    unsigned* bar; unsigned x;
    volatile LAS unsigned* st;
};

__device__ __forceinline__ XcdBarrier xcd_barrier_post(unsigned* bar, volatile LAS unsigned* st) {
    XcdBarrier b; b.bar = bar; b.x = xb_xcc_id(); b.st = st;
    if (threadIdx.x == 0) (void)xb_add(&bar[XB_XCNT(b.x)], 1u);
    return b;
}
__device__ __forceinline__ void xcd_barrier_complete(unsigned* bar, unsigned x, unsigned& nloc, unsigned& nx) {
    const unsigned G = gridDim.x * gridDim.y * gridDim.z;
    unsigned sum, cnt, mine, sp = 0u;
    for (;;) {
        sum = 0u; cnt = 0u; mine = 0u;
#pragma unroll
        for (unsigned j = 0; j < 16; ++j) { const unsigned c = xb_ld(&bar[XB_XCNT(j)]); sum += c; cnt += (c > 0u) ? 1u : 0u; mine = (j == x) ? c : mine; }
        if (sum == G) break;
        __builtin_amdgcn_s_sleep(1);
        if ((++sp & 255u) == 0u) { if (xb_ld(&bar[XB_TMO])) break; if (sp > XB_SPIN_CAP) { atomicAdd(&bar[XB_TMO], 1u); break; } }
    }
    nloc = mine > 0u ? mine : 1u; nx = cnt > 0u ? cnt : 1u;
}

__device__ __forceinline__ void xcd_barrier(const XcdBarrier& b) {
    asm volatile("s_waitcnt vmcnt(0)" ::: "memory");
    __syncthreads();
    if (threadIdx.x == 0) {
        unsigned* bar = b.bar;
        __builtin_amdgcn_s_waitcnt(0);
        unsigned nloc = b.st[0], nx = b.st[1];
        if (nloc == 0u) { xcd_barrier_complete(bar, b.x, nloc, nx); b.st[0] = nloc; b.st[1] = nx; }
        const unsigned old = xb_add(&bar[XB_XSUB(b.x)], 1u);
        const unsigned gen = old / nloc;
        if (old + 1u == (gen + 1u) * nloc) {
            __builtin_amdgcn_fence(__ATOMIC_RELEASE, "agent");
            asm volatile("s_waitcnt vmcnt(0)" ::: "memory");
            const unsigned og = xb_add(&bar[XB_TOP], 1u);
            const unsigned tg = og / nx;
            if (og + 1u == (tg + 1u) * nx) xb_add(&bar[XB_TOPGEN], 1u);
            else XB_SPIN(xb_ld(&bar[XB_TOPGEN]) == tg, bar);
            __builtin_amdgcn_fence(__ATOMIC_ACQUIRE, "agent");
            xb_add(&bar[XB_XGEN(b.x)], 1u);
            asm volatile("s_waitcnt vmcnt(0)" ::: "memory");
        } else {
            XB_SPIN(xb_ld(&bar[XB_XGEN(b.x)]) == gen, bar);
            __builtin_amdgcn_fence(__ATOMIC_ACQUIRE, "agent");
            asm volatile("s_waitcnt vmcnt(0)" ::: "memory");
        }
    }
    __syncthreads();
}


constexpr int NWAVES = 8, NTHR = 512;
constexpr int D = 1024, NB = 8, SEQ = 2048, CTXL = 256;
constexpr int M_CTX = NB * CTXL, M_LAT = NB * SEQ, M_ALL = M_CTX + M_LAT;
constexpr int RWC = 1760, MIXIN = 3312, ZLD = 3328, FF = 2816, NE = 8;
constexpr int PRV = 9 * 512;
constexpr int MOE_ROWS = 34816;
constexpr size_t MiB = 1u << 20;
constexpr size_t WS_CTL = 0, CTL_ZERO_BYTES = 1 * MiB;
constexpr size_t WS_MODS = 1 * MiB;
constexpr size_t WS_TOK = 1 * MiB + 512 * 1024;
constexpr size_t WS_WIN_T = 2 * MiB;
constexpr size_t WS_WOUT_T = WS_WIN_T + (size_t)ZLD * D * 2;
constexpr size_t WS_W13_T = WS_WOUT_T + 2 * MiB;
constexpr size_t WS_W2_T = WS_W13_T + 11 * MiB;
constexpr size_t WS_QKV_T = WS_W2_T + (size_t)D * FF * 2;
constexpr size_t WS_NAO_T = WS_QKV_T + 6 * MiB;
constexpr size_t WS_HCTX = 35 * MiB;
constexpr size_t WS_A = 43 * MiB;
constexpr size_t WS_R = 79 * MiB;
constexpr size_t WS_Z = WS_R;
constexpr size_t WS_PR = 196 * MiB;
constexpr size_t WS_PM = 358 * MiB;
constexpr size_t WS_DT = 394 * MiB;
constexpr size_t WS_BONUS = 395 * MiB + 256 * 1024;
constexpr size_t WS_GATE = 396 * MiB;
constexpr size_t WS_ZG = 414 * MiB;
constexpr size_t WS_YRW = WS_R;
constexpr size_t WS_YMB = WS_R + 36 * MiB;
constexpr size_t WS_HID = WS_R;
constexpr size_t WS_MOEW13 = 316 * MiB;
constexpr size_t WS_MOEW2 = 404 * MiB;
constexpr size_t WS_Q = WS_R, WS_K = WS_R + 36 * MiB, WS_V = WS_R + 72 * MiB;
constexpr size_t WS_O = WS_R + 108 * MiB;
constexpr size_t WS_A4 = 111 * MiB;
constexpr size_t WS_XG = 43 * MiB;
constexpr size_t WS_HIDG = 111 * MiB;
constexpr size_t WS_YG = 43 * MiB;
constexpr size_t WS_SLAB6 = WS_R;
constexpr size_t WS_SLAB9 = WS_R + 99 * MiB;
constexpr size_t WS_TAIL = 316 * MiB;
constexpr size_t WS_A2 = 196 * MiB;
constexpr size_t WS_XBUF = 256 * 1024;
constexpr size_t WS_PLOG = 301 * MiB;
constexpr size_t WS_END = 448 * MiB;
static_assert(WS_NAO_T + 2 * MiB <= WS_HCTX && WS_ZG + 18 * MiB <= WS_END && WS_MOEW2 + 44 * MiB <= WS_END && WS_HIDG + (size_t)MOE_ROWS * FF * 2 <= WS_MOEW13, "ws map");
static_assert(WS_Z + (size_t)M_ALL * ZLD * 2 <= WS_PR && WS_PR + (size_t)M_ALL * PRV * 2 <= WS_PM && WS_XG + (size_t)MOE_ROWS * D * 2 <= WS_HIDG, "ws map 2");
constexpr int CW_TMO = 0, CW_CODE = 1, CW_BAR = 4096, CW_CNT = 8192, CW_CNTB = 16384, CW_XCNT = 131072, CW_MODS0 = 128;
constexpr int RING_BYTES = 131072, LDSCTL_OFF = 145408, MISC_OFF = LDSCTL_OFF + 320, LDS_BYTES = 147456;

typedef unsigned v2u __attribute__((ext_vector_type(2)));
typedef float v2f __attribute__((ext_vector_type(2)));
typedef short s16x4 __attribute__((ext_vector_type(4)));
typedef short v4i16_t __attribute__((ext_vector_type(4)));
__device__ __forceinline__ float bflo(unsigned u) { return __uint_as_float(u << 16); }
__device__ __forceinline__ float bfhi(unsigned u) { return __uint_as_float(u & 0xffff0000u); }
__device__ __forceinline__ float ldbf(const bf16* p) { return __uint_as_float((unsigned)(*p) << 16); }
__device__ __forceinline__ float sigm(float x) { return __builtin_amdgcn_rcpf(1.f + __expf(-x)); }
__device__ __forceinline__ bf16x8 pack8(const f32x4& a, const f32x4& b) {
    v4u w; w.x = pk2(a[0], a[1]); w.y = pk2(a[2], a[3]); w.z = pk2(b[0], b[1]); w.w = pk2(b[2], b[3]); return __builtin_bit_cast(bf16x8, w);
}
template <int CTRL> __device__ __forceinline__ float dppf(float x) { return __int_as_float(__builtin_amdgcn_update_dpp(0, __float_as_int(x), CTRL, 0xF, 0xF, true)); }
__device__ __forceinline__ float sum8(float x) { x += dppf<0xB1>(x); x += dppf<0x4E>(x); x += dppf<0x141>(x); return x; }
__device__ __forceinline__ float sum16(float x) { x = sum8(x); x += dppf<0x140>(x); return x; }
__device__ __forceinline__ float rlf(float v, int l) { return __int_as_float(__builtin_amdgcn_readlane(__float_as_int(v), l)); }
__device__ __forceinline__ float wave_sum(float v) { v = sum16(v); return (rlf(v, 0) + rlf(v, 16)) + (rlf(v, 32) + rlf(v, 48)); }
__device__ __forceinline__ float half_sum(float v, int lane) { v = sum16(v); const float lo = rlf(v, 0) + rlf(v, 16), hi = rlf(v, 32) + rlf(v, 48); return lane < 32 ? lo : hi; }

struct Frame {
    LAS unsigned char* lds;
    volatile LAS unsigned* MISC;
    gu32* ctl;
    int tid, lane, wave, G, bid;
};

template <bool BLK = false, bool NTS = false> __device__ __forceinline__ void tr_item(const float* W, int K, int N, bf16* WT, int drow0, int k0, int n0, LAS float* scr, int lane) {
    const int nn = n0 + (lane & 31);
    float t[32];
#pragma unroll
    for (int i = 0; i < 32; ++i) { const int kk = 2 * i + (lane >> 5); t[i] = (nn < N) ? __builtin_nontemporal_load(W + (size_t)(k0 + kk) * N + nn) : 0.f; }
#pragma unroll
    for (int i = 0; i < 32; ++i) { const int kk = 2 * i + (lane >> 5); scr[kk * 33 + (lane & 31)] = t[i]; }
    LDS_WAIT(); asm volatile("" ::: "memory");
    const int c = lane & 7;
#pragma unroll
    for (int j = 0; j < 4; ++j) { const int n = (lane >> 3) + 8 * j; const LAS float* s = scr + (8 * c) * 33 + n;
        v4u o; o.x = pk2(s[0 * 33], s[1 * 33]); o.y = pk2(s[2 * 33], s[3 * 33]); o.z = pk2(s[4 * 33], s[5 * 33]); o.w = pk2(s[6 * 33], s[7 * 33]);
        GAS v4u* dp;
        if constexpr (BLK) { const int dr = drow0 + n; dp = (GAS v4u*)(WT + ((size_t)((dr >> 8) * (K >> 6) + (k0 >> 6)) * 256 + (dr & 255)) * 64 + 8 * c); }
        else dp = (GAS v4u*)(WT + (size_t)(drow0 + n) * K + k0 + 8 * c);
        if constexpr (NTS) __builtin_nontemporal_store(o, dp); else *dp = o; }
    LDS_WAIT(); asm volatile("" ::: "memory");
}
template <int MODE  , bool NTS = false>
__device__ __forceinline__ bool tr_matrix(int& it, const float* W, int K, int N, bf16* WT, LAS float* scr, int lane) {
    const int nblk = (N + 31) / 32, items = (K / 64) * nblk;
    if (it >= items) { it -= items; return false; }
    const int kb = it / nblk, nb = it % nblk, n0 = nb * 32;
    int drow0 = n0;
    if (MODE == 1) drow0 = (n0 >> 7) * 256 + (n0 & 127);
    if (MODE == 2) drow0 = (n0 >> 7) * 256 + 128 + (n0 & 127);
    if (MODE == 3) tr_item<true, NTS>(W, K, N, WT, drow0, kb * 64, n0, scr, lane); else tr_item<false, NTS>(W, K, N, WT, drow0, kb * 64, n0, scr, lane);
    return true;
}

constexpr int DW_P0_END = 16 * 104, DW_P2_END = DW_P0_END + 512 + 1600, DW_P6_END = DW_P0_END + 512 + 2816, DW_P8_END = DW_P6_END + 1408, DW_P9_END = DW_P8_END + 1536, DW_END = DW_P9_END + 512;
__device__ __forceinline__ void dense_weight_phase(Frame& F, const float* mix_w_in, const float* mix_w_out, const float* ffn_w1, const float* ffn_w3, const float* ffn_w2,
                                                   const float* na_w_qkv, const float* na_w_out, unsigned char* ws, int lo, int hi, int widx, int nw);
__device__ __forceinline__ void p0_phase(Frame& F, const float* c, const float* c_ctx, const float* w_ada, const float* b_ada, float* mods,
                                         const float* mix_w_in, const float* mix_w_out, const float* ffn_w1, const float* ffn_w3, const float* ffn_w2,
                                         const float* na_w_qkv, const float* na_w_out, unsigned char* ws) {
    for (int u = F.bid; u < 192; u += F.G) {
        LAS float* sc = (LAS float*)(F.lds);
        LAS float* red = (LAS float*)(F.lds + 40960);
        for (int i = F.tid; i < 9 * 1024; i += NTHR) { const int b = i >> 10, k = i & 1023; const float v = (b < 8) ? c[b * 1024 + k] : c_ctx[k]; sc[b * 1028 + k] = v / (1.f + __expf(-v)); }
        __syncthreads();
        const int layer = u / 96, cb = (u % 96) * 64, j = F.lane & 15, kq = F.lane >> 4, k0 = F.wave * 128;
        const float* W = w_ada + (size_t)layer * 1024 * 6144 + (size_t)(k0 + kq) * 6144 + cb + 4 * j;
        f32x4 dacc[4];
#pragma unroll
        for (int x = 0; x < 4; ++x) dacc[x] = (f32x4){0.f, 0.f, 0.f, 0.f};
#pragma unroll
        for (int h = 0; h < 2; ++h) { f32x4 wv[16];
#pragma unroll
            for (int ks = 0; ks < 16; ++ks) wv[ks] = *(const GAS f32x4*)(W + (size_t)((h * 16 + ks) * 4) * 6144);
#pragma unroll
            for (int ks = 0; ks < 16; ++ks) { const float a = (j < 9) ? sc[j * 1028 + k0 + (h * 16 + ks) * 4 + kq] : 0.f;
#pragma unroll
                for (int x = 0; x < 4; ++x) dacc[x] = __builtin_amdgcn_mfma_f32_16x16x4f32(a, wv[ks][x], dacc[x], 0, 0, 0); } }
        if (kq < 3) {
#pragma unroll
            for (int x = 0; x < 4; ++x)
#pragma unroll
                for (int e = 0; e < 4; ++e) red[(F.wave * 12 + 4 * kq + e) * 64 + 4 * j + x] = dacc[x][e]; }
        __syncthreads();
        if (F.wave == 0) {
#pragma unroll
            for (int b = 0; b < 9; ++b) { float s = 0.f;
#pragma unroll
                for (int w = 0; w < 8; ++w) s += red[(w * 12 + b) * 64 + F.lane];
                __hip_atomic_store(mods + (layer * 9 + b) * 6144 + cb + F.lane, s + b_ada[layer * 6144 + cb + F.lane], __ATOMIC_RELAXED, __HIP_MEMORY_SCOPE_AGENT); }
            if (u < 32) { asm volatile("s_waitcnt vmcnt(0)" ::: "memory"); if (F.lane == 0) __hip_atomic_fetch_add((unsigned*)(F.ctl + CW_MODS0), 1u, __ATOMIC_RELAXED, __HIP_MEMORY_SCOPE_AGENT); }
        }
        __syncthreads();
    }
    dense_weight_phase(F, mix_w_in, mix_w_out, ffn_w1, ffn_w3, ffn_w2, na_w_qkv, na_w_out, ws, 0, DW_P0_END, F.bid, F.G);
}
__device__ __forceinline__ void dense_weight_phase(Frame& F, const float* mix_w_in, const float* mix_w_out, const float* ffn_w1, const float* ffn_w3, const float* ffn_w2,
                                                   const float* na_w_qkv, const float* na_w_out, unsigned char* ws, int lo, int hi, int widx, int nw) {
    LAS float* scr = (LAS float*)(F.lds + 57344 + F.wave * 8704);
    const int gw = widx * NWAVES + F.wave, NGW = nw * NWAVES;
    for (int it0 = lo + gw; it0 < hi; it0 += NGW) {
        int it = it0;
        if (tr_matrix<0>(it, mix_w_in, 1024, MIXIN, (bf16*)(ws + WS_WIN_T), scr, F.lane)) continue;
        if (tr_matrix<0>(it, mix_w_out, 1024, 1024, (bf16*)(ws + WS_WOUT_T), scr, F.lane)) continue;
        if (tr_matrix<1>(it, ffn_w1, 1024, FF, (bf16*)(ws + WS_W13_T), scr, F.lane)) continue;
        if (tr_matrix<2>(it, ffn_w3, 1024, FF, (bf16*)(ws + WS_W13_T), scr, F.lane)) continue;
        if (tr_matrix<3>(it, ffn_w2, FF, 1024, (bf16*)(ws + WS_W2_T), scr, F.lane)) continue;
        if (tr_matrix<0>(it, na_w_qkv, 1024, 3072, (bf16*)(ws + WS_QKV_T), scr, F.lane)) continue;
        tr_matrix<0>(it, na_w_out, 1024, 1024, (bf16*)(ws + WS_NAO_T), scr, F.lane);
    }
}
constexpr int MOE_ITEMS = NE * 1408 * 3, MOE_W13_ITEMS = NE * 2816, MOE_ITEMS_P6 = 0, MOE_ITEMS_P8 = 8832, MOE_ITEMS_P9 = 12800, MOE_ITEMS_P11 = 4992, MOE_ITEMS_P16 = 7168, MOE_ITEMS_P7 = MOE_ITEMS - MOE_ITEMS_P8 - MOE_ITEMS_P9 - MOE_ITEMS_P11 - MOE_ITEMS_P16;
static_assert(MOE_ITEMS - MOE_ITEMS_P16 >= MOE_W13_ITEMS, "the items left for P16's idle workgroups must all be w2 items (the w1|w3 copies are read by P16 itself)");
__device__ __forceinline__ void moe_weight_phase(Frame& F, const float* w1, const float* w3, const float* w2, unsigned char* ws, int lo, int hi, int widx, int nw) {
    LAS float* scr = (LAS float*)(F.lds + 57344 + F.wave * 8704);
    const int gw = widx * NWAVES + F.wave, NGW = nw * NWAVES;
    for (int it0 = lo + gw; it0 < hi; it0 += NGW) {
        const bool isw2 = it0 >= MOE_W13_ITEMS; const int e = isw2 ? (it0 - MOE_W13_ITEMS) / 1408 : it0 / 2816; int it = isw2 ? 2816 + (it0 - MOE_W13_ITEMS) % 1408 : it0 % 2816;
        bf16* w13t = (bf16*)(ws + WS_MOEW13) + (size_t)e * 5632 * 1024; bf16* w2t = (bf16*)(ws + WS_MOEW2) + (size_t)e * 1024 * FF;
        if (tr_matrix<1, true>(it, w1 + (size_t)e * 1024 * FF, 1024, FF, w13t, scr, F.lane)) continue;
        if (tr_matrix<2, true>(it, w3 + (size_t)e * 1024 * FF, 1024, FF, w13t, scr, F.lane)) continue;
        tr_matrix<3, true>(it, w2 + (size_t)e * 1024 * FF, FF, 1024, w2t, scr, F.lane);
    }
}

__device__ __forceinline__ void counter_wait(const unsigned* flag, unsigned want) {
    while (__hip_atomic_load(flag, __ATOMIC_RELAXED, __HIP_MEMORY_SCOPE_AGENT) < want) __builtin_amdgcn_s_sleep(2);
    asm volatile("" ::: "memory");
}
struct RowIn { f32x4 x[4], sh[4], sc[4]; };
__device__ __forceinline__ void row_fetch(RowIn& R, const float* xrow, const float* sh, const float* sc, int lane) {
#pragma unroll
    for (int j = 0; j < 4; ++j) { R.x[j] = ((const GAS f32x4*)xrow)[lane + 64 * j]; R.sh[j] = ((const GAS f32x4*)sh)[lane + 64 * j]; R.sc[j] = ((const GAS f32x4*)sc)[lane + 64 * j]; }
}
__device__ __forceinline__ void row_finish(const RowIn& R, const f32x4 (&gg)[4], bf16* orow, int lane, f32x4 (&a)[4], const float* slab = nullptr, int nslab = 0, float* wb = nullptr) {
    float ss = 0.f;
#pragma unroll
    for (int j = 0; j < 4; ++j) a[j] = R.x[j];
    for (int s = 0; s < nslab; ++s) { const GAS f32x4* sr = (const GAS f32x4*)(slab + (size_t)s * (2048 * 1024)) + lane;
#pragma unroll
        for (int j = 0; j < 4; ++j) a[j] += sr[64 * j]; }
    if (wb) { GAS f32x4* w4 = (GAS f32x4*)wb + lane;
#pragma unroll
        for (int j = 0; j < 4; ++j) w4[64 * j] = a[j]; }
#pragma unroll
    for (int j = 0; j < 4; ++j) ss += (a[j].x * a[j].x + a[j].y * a[j].y) + (a[j].z * a[j].z + a[j].w * a[j].w);
    const float rs = rsqrtf(wave_sum(ss) * (1.f / 1024.f) + 1e-6f);
    GAS unsigned long long* o8 = (GAS unsigned long long*)orow + lane;
#pragma unroll
    for (int j = 0; j < 4; ++j) {
        a[j] = (a[j] * rs) * gg[j] * (R.sc[j] + 1.f) + R.sh[j];
        o8[64 * j] = (unsigned long long)pk2(a[j].x, a[j].y) | ((unsigned long long)pk2(a[j].z, a[j].w) << 32);
    }
}
__device__ __forceinline__ void normmod_phase(Frame& F, const float* src_ctx, const float* src_lat, const float* g, const float* mods_l, int off_shift, int off_scale, bf16* dst, const float* slab = nullptr, int nslab = 0, float* wb_ctx = nullptr, int m_end = M_ALL) {
    const int gw = F.bid * NWAVES + F.wave, NGW = F.G * NWAVES;
    f32x4 gg[4];
#pragma unroll
    for (int j = 0; j < 4; ++j) gg[j] = ((const GAS f32x4*)g)[F.lane + 64 * j];
    RowIn cur, nxt;
    int r = gw; bool have = r < m_end;
#define NM_FETCH(R_, r_) do { const bool ic_ = (r_) < M_CTX; const int rl_ = ic_ ? (r_) : (r_) - M_CTX; const float* mp_ = mods_l + (ic_ ? 8 : (rl_ >> 11)) * 6144; \
        row_fetch(R_, (ic_ ? src_ctx : src_lat) + (size_t)rl_ * D, mp_ + off_shift, mp_ + off_scale, F.lane); } while (0)
    if (have) NM_FETCH(cur, r);
    while (have) {
        const int rn = r + NGW; const bool hn = rn < m_end;
        if (hn) NM_FETCH(nxt, rn);
        const bool isctx = r < M_CTX; const int rl = isctx ? r : r - M_CTX;
        f32x4 a[4];
        if (isctx) row_finish(cur, gg, dst + (size_t)r * D, F.lane, a, slab ? slab + (size_t)rl * D : nullptr, nslab, wb_ctx ? wb_ctx + (size_t)rl * D : nullptr);
        else row_finish(cur, gg, dst + (size_t)r * D, F.lane, a);
        cur = nxt; r = rn; have = hn;
    }
#undef NM_FETCH
}

namespace pg8 {
struct EpiResGate {
    static constexpr bool PERM = false, AFTER_DRAIN = false;
    const float* base_c; const float* base_l; float* out_c; float* out_l; const float* mods_l; int gate_off; int ctx_tiles;
    __device__ __forceinline__ void operator()(const f32x4 (&acc)[2][2][4][2], const Unit& u, int wr, int wc, int fr, int fq) const {
        const bool isctx = u.pm < ctx_tiles; const int rt = isctx ? u.pm : u.pm - ctx_tiles; const int mi = isctx ? 8 : (rt >> 3);
        const float* base = isctx ? base_c : base_l; float* out = isctx ? out_c : out_l;
        const int col0 = u.pn * BM + wc * 32 + 4 * fq; const float* gp = mods_l + mi * 6144 + gate_off + col0;
        f32x4 gv[2][2];
#pragma unroll
        for (int bj = 0; bj < 2; ++bj)
#pragma unroll
            for (int n = 0; n < 2; ++n) gv[bj][n] = *(const f32x4*)(gp + bj * HALF + n * 16);
#pragma unroll
        for (int ai = 0; ai < 2; ++ai)
#pragma unroll
            for (int m = 0; m < 4; ++m) { const size_t off = (size_t)(rt * BM + ai * HALF + wr * 64 + m * 16 + fr) * 1024 + col0;
#pragma unroll
                for (int bj = 0; bj < 2; ++bj)
#pragma unroll
                    for (int n = 0; n < 2; ++n) { const f32x4 b = *(const f32x4*)(base + off + bj * HALF + n * 16); *(f32x4*)(out + off + bj * HALF + n * 16) = b + gv[bj][n] * acc[ai][bj][m][n]; } }
    }
};
template <bool ROUTER> struct EpiResGateNormT {
    static constexpr bool PERM = false, AFTER_DRAIN = true;
    const float* base; float* out; const float* mods_l; int gate_off;
    const float* g; int off_shift, off_scale; bf16_t* dst;
    float* xbuf; unsigned* cnt;
    const float* rw; float* plog;
    __device__ __forceinline__ void operator()(const f32x4 (&)[2][2][4][2], const Unit&, int, int, int, int) const {}
    __device__ __forceinline__ void fused(f32x4 (&acc)[2][2][4][2], const Unit& u, int wr, int wc, int fr, int fq, PG8_LAS unsigned char* lds, int wid, int lane) const {
        PG8_LAS float* P = (PG8_LAS float*)lds;
        PG8_LAS float* S = (PG8_LAS float*)(lds + 4096);
        const int rt = u.pm, col0 = u.pn * BM + wc * 32 + 4 * fq; const float* mp = mods_l + (rt >> 3) * 6144 + col0;
        const unsigned r0 = (unsigned)((rt * BM + wr * 64 + fr) * 1024 + col0) * 4u;
        unsigned rb = r0; constexpr int NB = ROUTER ? 8 : 12;
#define ERN_IDX(i) const int bj_ = (i) >> 4, n_ = ((i) >> 3) & 1, ai_ = ((i) >> 2) & 1, m_ = (i) & 3
#pragma unroll
        for (int b0 = 0; b0 < 32; b0 += NB) { f32x4 bv[NB];
            if (b0) {
#pragma unroll
                for (int i = b0 - NB; i < b0; ++i) { ERN_IDX(i); asm volatile("" : "+v"(rb) : "v"(acc[ai_][bj_][m_][n_][3])); } }
#pragma unroll
            for (int i = b0; i < b0 + NB && i < 32; ++i) { ERN_IDX(i); bv[i - b0] = *(const f32x4*)((const char*)base + (rb + (unsigned)(((ai_ * HALF + m_ * 16) * 1024 + bj_ * HALF + n_ * 16) * 4))); }
#pragma unroll
            for (int i = b0; i < b0 + NB && i < 32; ++i) { ERN_IDX(i); const f32x4 gv = *(const f32x4*)(mp + gate_off + bj_ * HALF + n_ * 16); acc[ai_][bj_][m_][n_] = bv[i - b0] + gv * acc[ai_][bj_][m_][n_]; } }
#undef ERN_IDX
#pragma unroll
        for (int ai = 0; ai < 2; ++ai)
#pragma unroll
            for (int m = 0; m < 4; ++m) { float s = 0.f;
#pragma unroll
                for (int bj = 0; bj < 2; ++bj)
#pragma unroll
                    for (int n = 0; n < 2; ++n) { const f32x4 x = acc[ai][bj][m][n]; s += (x[0] * x[0] + x[1] * x[1]) + (x[2] * x[2] + x[3] * x[3]); }
                s += __shfl_xor(s, 16); s += __shfl_xor(s, 32);
                if (fq == 0) P[(ai * HALF + wr * 64 + m * 16 + fr) * 4 + wc] = s; }
        asm volatile("s_waitcnt lgkmcnt(0)" ::: "memory"); __builtin_amdgcn_s_barrier(); asm volatile("" ::: "memory");
        const int row = wid * 32 + (lane & 31);
        if (lane < 32) { const float t = (P[row * 4 + 0] + P[row * 4 + 1]) + (P[row * 4 + 2] + P[row * 4 + 3]);
            __hip_atomic_store(xbuf + (size_t)(rt * BM + row) * 4 + u.pn, -t, __ATOMIC_RELAXED, __HIP_MEMORY_SCOPE_AGENT); }
#pragma unroll
        for (int ai = 0; ai < 2; ++ai)
#pragma unroll
            for (int m = 0; m < 4; ++m)
#pragma unroll
                for (int bj = 0; bj < 2; ++bj)
#pragma unroll
                    for (int n = 0; n < 2; ++n) *(f32x4*)((char*)out + (r0 + (unsigned)(((ai * HALF + m * 16) * 1024 + bj * HALF + n * 16) * 4))) = acc[ai][bj][m][n];
        if (lane < 32) { const float* sl = xbuf + (size_t)(rt * BM + row) * 4; float q0, q1, q2, q3;
            for (;;) {
                q0 = __hip_atomic_load(sl + 0, __ATOMIC_RELAXED, __HIP_MEMORY_SCOPE_AGENT); q1 = __hip_atomic_load(sl + 1, __ATOMIC_RELAXED, __HIP_MEMORY_SCOPE_AGENT);
                q2 = __hip_atomic_load(sl + 2, __ATOMIC_RELAXED, __HIP_MEMORY_SCOPE_AGENT); q3 = __hip_atomic_load(sl + 3, __ATOMIC_RELAXED, __HIP_MEMORY_SCOPE_AGENT);
                if ((__float_as_uint(q0) != 0u) & (__float_as_uint(q1) != 0u) & (__float_as_uint(q2) != 0u) & (__float_as_uint(q3) != 0u)) break;
                __builtin_amdgcn_s_sleep(1);
            }
            S[row] = rsqrtf(-((q0 + q1) + (q2 + q3)) * (1.f / 1024.f) + 1e-6f); }
        asm volatile("s_waitcnt vmcnt(0) lgkmcnt(0)" ::: "memory"); __builtin_amdgcn_s_barrier(); asm volatile("" ::: "memory");
        float rs[2][4]; int fr2; asm volatile("v_mbcnt_lo_u32_b32 %0, -1, 0\n\tv_mbcnt_hi_u32_b32 %0, -1, %0" : "=v"(fr2)); fr2 &= 15;
#pragma unroll
        for (int ai = 0; ai < 2; ++ai)
#pragma unroll
            for (int m = 0; m < 4; ++m) rs[ai][m] = S[ai * HALF + wr * 64 + m * 16 + fr2];
        asm volatile("s_waitcnt lgkmcnt(0)" ::: "memory"); __builtin_amdgcn_s_barrier(); asm volatile("" ::: "memory");
        f32x4 dl[2][4];
        if constexpr (ROUTER) {
#pragma unroll
            for (int ai = 0; ai < 2; ++ai)
#pragma unroll
                for (int m = 0; m < 4; ++m) dl[ai][m] = (f32x4){0.f, 0.f, 0.f, 0.f}; }
#pragma unroll
        for (int bj = 0; bj < 2; ++bj)
#pragma unroll
            for (int n = 0; n < 2; ++n) { const int c = bj * HALF + n * 16;
                const f32x4 gg = *(const f32x4*)(g + col0 + c), sc = *(const f32x4*)(mp + off_scale + c) + 1.f, sh = *(const f32x4*)(mp + off_shift + c);
                float wa[4];
                if constexpr (ROUTER) {
#pragma unroll
                    for (int x = 0; x < 4; ++x) wa[x] = (fr2 < 8) ? rw[(col0 + c + x) * 8 + fr2] : 0.f; }
#pragma unroll
                for (int ai = 0; ai < 2; ++ai)
#pragma unroll
                    for (int m = 0; m < 4; ++m) { const f32x4 v = ((acc[ai][bj][m][n] * rs[ai][m]) * gg) * sc + sh;
                        *(unsigned long long*)((char*)dst + ((r0 >> 1) + (unsigned)(((ai * HALF + m * 16) * 1024 + c) * 2))) = (unsigned long long)cvt_pk_bf16(v[0], v[1]) | ((unsigned long long)cvt_pk_bf16(v[2], v[3]) << 32);
                        if constexpr (ROUTER) {
#pragma unroll
                            for (int x = 0; x < 4; ++x) dl[ai][m] = __builtin_amdgcn_mfma_f32_16x16x4f32(wa[x], v[x], dl[ai][m], 0, 0, 0); } } }
        if constexpr (ROUTER) {
            PG8_LAS float* T = (PG8_LAS float*)lds;
            if (fq < 2) {
#pragma unroll
                for (int ai = 0; ai < 2; ++ai)
#pragma unroll
                    for (int m = 0; m < 4; ++m)
#pragma unroll
                        for (int x = 0; x < 4; ++x) T[(ai * HALF + wr * 64 + m * 16 + fr2) * 32 + (4 * fq + x) * 4 + wc] = dl[ai][m][x]; }
            asm volatile("s_waitcnt lgkmcnt(0)" ::: "memory"); __builtin_amdgcn_s_barrier(); asm volatile("" ::: "memory");
            const int t = wid * 64 + lane, trow = t >> 1, th = t & 1; f32x4 sum;
#pragma unroll
            for (int x = 0; x < 4; ++x) { const f32x4 q = *(const PG8_LAS f32x4*)(T + trow * 32 + (4 * th + x) * 4); sum[x] = (q[0] + q[1]) + (q[2] + q[3]); }
            *(f32x4*)(plog + ((size_t)(rt * BM + trow) * 4 + u.pn) * 8 + 4 * th) = sum;
        }
    }
};
typedef EpiResGateNormT<false> EpiResGateNorm;
struct EpiSwiGLU {
    static constexpr bool PERM = true, AFTER_DRAIN = false;
    bf16_t* O; int ldo; int nt_mod; int blk = 0; int nts = 0;
    __device__ __forceinline__ void operator()(const f32x4 (&acc)[2][2][4][2], const Unit& u, int wr, int wc, int fr, int fq) const {
        const int pnl = u.pn % nt_mod; const int row0 = u.pm * BM + wr * 64 + fr, col0 = pnl * HALF + wc * 32 + 8 * fq;
        bf16_t* Ob = blk ? O + ((size_t)(u.pm * blk + (col0 >> 6)) * BM + wr * 64 + fr) * 64 + (col0 & 63) : nullptr;
#pragma unroll
        for (int ai = 0; ai < 2; ++ai)
#pragma unroll
            for (int m = 0; m < 4; ++m) { bf16_t* rowp = blk ? Ob + (ai * HALF + m * 16) * 64 : O + (size_t)(row0 + ai * HALF + m * 16) * ldo + col0;
                float h[8];
#pragma unroll
                for (int n = 0; n < 2; ++n)
#pragma unroll
                    for (int e = 0; e < 4; ++e) { const float a = acc[ai][0][m][n][e], b = acc[ai][1][m][n][e]; h[n * 4 + e] = a * b * __builtin_amdgcn_rcpf(1.f + __expf(-a)); }
                u32x4 w; w.x = cvt_pk_bf16(h[0], h[1]); w.y = cvt_pk_bf16(h[2], h[3]); w.z = cvt_pk_bf16(h[4], h[5]); w.w = cvt_pk_bf16(h[6], h[7]);
                if (nts) __builtin_nontemporal_store(w, (u32x4*)rowp); else PG8_ST16(O, rowp, w); }
    }
};
struct EpiPlainMod {
    static constexpr bool PERM = true, AFTER_DRAIN = false;
    bf16_t* O; int ldo; int nt_mod;
    __device__ __forceinline__ void operator()(const f32x4 (&acc)[2][2][4][2], const Unit& u, int wr, int wc, int fr, int fq) const {
        const int pnl = u.pn % nt_mod; const int row0 = u.pm * BM + wr * 64 + fr, col0 = pnl * BM + wc * 32 + 8 * fq;
#pragma unroll
        for (int ai = 0; ai < 2; ++ai)
#pragma unroll
            for (int m = 0; m < 4; ++m) { bf16_t* rowp = O + (size_t)(row0 + ai * HALF + m * 16) * ldo + col0;
#pragma unroll
                for (int bj = 0; bj < 2; ++bj) { const f32x4 v0 = acc[ai][bj][m][0], v1 = acc[ai][bj][m][1];
                    u32x4 w; w.x = cvt_pk_bf16(v0[0], v0[1]); w.y = cvt_pk_bf16(v0[2], v0[3]); w.z = cvt_pk_bf16(v1[0], v1[1]); w.w = cvt_pk_bf16(v1[2], v1[3]);
                    PG8_ST16(O, rowp + bj * HALF, w); } }
    }
};
struct SplitKOrder {
    int ntm, nN, ns, kslice, G, c;
    __device__ __forceinline__ bool next(int i, Unit& u) const {
        const int L = i * G + c; if (L >= ntm * nN * ns) return false;
        const int ks = L % ns, t = L / ns; u.pn = t % nN; u.pm = t / nN; u.k0 = ks * kslice; return true;
    }
    __device__ __forceinline__ void a_ready(const Unit&) const {}
    __device__ __forceinline__ void done(const Unit&) const {}
};
struct EpiSlabGate {
    static constexpr bool PERM = false, AFTER_DRAIN = false;
    float* slab; const float* gate; int kslice;
    __device__ __forceinline__ void operator()(const f32x4 (&acc)[2][2][4][2], const Unit& u, int wr, int wc, int fr, int fq) const {
        const int col0 = u.pn * BM + wc * 32 + 4 * fq; float* out = slab + (size_t)(u.k0 / kslice) * (2048 * 1024);
        f32x4 gv[2][2];
#pragma unroll
        for (int bj = 0; bj < 2; ++bj)
#pragma unroll
            for (int n = 0; n < 2; ++n) gv[bj][n] = *(const f32x4*)(gate + col0 + bj * HALF + n * 16);
#pragma unroll
        for (int ai = 0; ai < 2; ++ai)
#pragma unroll
            for (int m = 0; m < 4; ++m) { float* op = out + (size_t)(u.pm * BM + ai * HALF + wr * 64 + m * 16 + fr) * 1024 + col0;
#pragma unroll
                for (int bj = 0; bj < 2; ++bj)
#pragma unroll
                    for (int n = 0; n < 2; ++n) *(f32x4*)(op + bj * HALF + n * 16) = gv[bj][n] * acc[ai][bj][m][n]; }
    }
};
struct MoeOrder {
    int tb[9]; int ntn, G, c; int limit = 0x7fffffff;
    __device__ __forceinline__ bool next(int i, Unit& u) const {
        const int L = i * G + c; if (L >= tb[8] * ntn || L >= limit) return false;
        const int mt = L / ntn, pn = L % ntn; int e = 0;
#pragma unroll
        for (int k = 1; k < 8; ++k) e += (mt >= tb[k]) ? 1 : 0;
        u.pm = mt; u.pn = e * ntn + pn; return true;
    }
    __device__ __forceinline__ void a_ready(const Unit&) const {}
    __device__ __forceinline__ void done(const Unit&) const {}
};
struct MoeTailOrder {
    int tb[9]; int first, ntail, G, c;
    __device__ __forceinline__ bool next(int i, Unit& u) const {
        const int L = i * G + c; if (L >= ntail * 11) return false;
        const int tu = L / 11, ks = L % 11, gu = first + tu, mt = gu >> 2, pn = gu & 3; int e = 0;
#pragma unroll
        for (int k = 1; k < 8; ++k) e += (mt >= tb[k]) ? 1 : 0;
        u.pm = mt; u.pn = e * 4 + pn; u.k0 = ks * 256; return true;
    }
    __device__ __forceinline__ void a_ready(const Unit&) const {}
    __device__ __forceinline__ void done(const Unit&) const {}
};
struct EpiTailSlab {
    static constexpr bool PERM = false, AFTER_DRAIN = false;
    float* slab; int first, ntail;
    __device__ __forceinline__ void operator()(const f32x4 (&acc)[2][2][4][2], const Unit& u, int wr, int wc, int fr, int fq) const {
        const int col0 = (u.pn & 3) * BM + wc * 32 + 4 * fq; float* out = slab + (size_t)(u.k0 >> 8) * ((size_t)(ntail >> 2) * 256 * 1024);
        const int rt = u.pm - (first >> 2);
#pragma unroll
        for (int ai = 0; ai < 2; ++ai)
#pragma unroll
            for (int m = 0; m < 4; ++m) { float* op = out + (size_t)(rt * BM + ai * HALF + wr * 64 + m * 16 + fr) * 1024 + col0;
#pragma unroll
                for (int bj = 0; bj < 2; ++bj)
#pragma unroll
                    for (int n = 0; n < 2; ++n) *(f32x4*)(op + bj * HALF + n * 16) = acc[ai][bj][m][n]; }
    }
};
}

struct PrepIn { const float *rw_mu, *rw_w0, *rw_w_up, *rw_a0, *rw_a_up, *rw_g_up, *rw_k_k, *rw_k_a, *rw_r_k, *conv_w, *conv_b, *dt_bias; };
__device__ __forceinline__ bf16x8 gather8(const float* p, int stride) {
    v4u w; w.x = pk2(p[0], p[stride]); w.y = pk2(p[2 * stride], p[3 * stride]); w.z = pk2(p[4 * stride], p[5 * stride]); w.w = pk2(p[6 * stride], p[7 * stride]); return __builtin_bit_cast(bf16x8, w);
}
constexpr int ACT_ST = 464;
__device__ __forceinline__ void prepare_phase(Frame& F, const PrepIn& P, const bf16* Z, bf16* PR, bf16* PM, float* DT, float* BONUS, bf16* GATE, bf16* ZG) {
    LAS unsigned short* zs = (LAS unsigned short*)F.lds;
    LAS unsigned char* actb = F.lds + 24576;
    LAS float* cst = (LAS float*)(F.lds + 24576 + 16 * ACT_ST);
    const int tid = F.tid, lane = F.lane, fr = lane & 15, fq = lane >> 4, w = F.wave;
    const int hf = F.bid & 1, wl = w & 3, hd = 4 * hf + wl;
    __syncthreads();
    if (tid < 256) { const int c = 256 * hf + tid; cst[tid] = P.rw_w0[c]; cst[256 + tid] = P.rw_w0[512 + c]; cst[512 + tid] = P.rw_a0[c]; cst[768 + tid] = P.rw_a0[512 + c];
      cst[1024 + tid] = P.rw_k_k[c]; cst[1280 + tid] = P.rw_k_a[c]; cst[1536 + tid] = P.rw_r_k[c]; cst[1792 + tid] = P.rw_r_k[512 + c]; }
    bf16x8 W[16];
#pragma unroll
    for (int cb = 0; cb < 4; ++cb) { const int c = 64 * hd + 4 * fr + cb;
        if (w < 4) { W[cb] = gather8(P.rw_w_up + (size_t)(8 * fq) * 512 + c, 512); W[4 + cb] = gather8(P.rw_w_up + (size_t)(32 + 8 * fq) * 512 + c, 512);
                     W[8 + cb] = gather8(P.rw_a_up + (size_t)(8 * fq) * 512 + c, 512); W[12 + cb] = gather8(P.rw_a_up + (size_t)(32 + 8 * fq) * 512 + c, 512); }
        else { W[cb] = gather8(P.rw_g_up + (size_t)(8 * fq) * 512 + c, 512); W[4 + cb] = gather8(P.rw_g_up + (size_t)(32 + 8 * fq) * 512 + c, 512); W[8 + cb] = gather8(P.rw_g_up + (size_t)(64 + 8 * fq) * 512 + c, 512); W[12 + cb] = W[cb]; } }
    const int col0 = (tid < 256) ? (256 * hf + tid) : (512 + 256 * hf + tid - 256), col1 = (tid < 256) ? (1024 + 256 * hf + tid) : ((tid < 480) ? (1536 + tid - 256) : 1536);
    const int zo0 = tid, zo1 = 512 + (tid & 255);
    const float mu00 = P.rw_mu[col0], mu10 = P.rw_mu[RWC + col0], mu01 = P.rw_mu[col1], mu11 = P.rw_mu[RWC + col1];
    float cw[5];
#pragma unroll
    for (int k = 0; k < 5; ++k) cw[k] = P.conv_w[k * 1024 + 512 * hf + tid];
    const float cbv = P.conv_b[512 * hf + tid], dtb = P.dt_bias[tid & 15];
    __syncthreads();

#ifndef PREP_REPS
#define PREP_REPS 1
#endif
    for (int rb_ = F.bid >> 1; rb_ < (M_ALL / 16) * PREP_REPS; rb_ += (F.G >> 1)) {
        const int rb = rb_ % (M_ALL / 16); const int g0 = rb * 16; const bool isctx = g0 < M_CTX; const int T = isctx ? CTXL : SEQ; const int t0 = isctx ? (g0 & (CTXL - 1)) : ((g0 - M_CTX) & (SEQ - 1));
        const bf16* zb = Z + (size_t)g0 * ZLD;
        const bool hp = t0 > 0, hn = (t0 + 16 < T), hp2 = t0 >= 2, hn2 = (t0 + 17 < T);
        float z0[18], z1[18], x[20];
        const int ccol = RWC + 512 + 512 * hf + tid;
#pragma unroll
        for (int i = 0; i < 18; ++i) { const bool ok = (i == 0) ? hp : ((i == 17) ? hn : true); z0[i] = ok ? ldbf(zb + (ptrdiff_t)(i - 1) * ZLD + col0) : 0.f; z1[i] = ok ? ldbf(zb + (ptrdiff_t)(i - 1) * ZLD + col1) : 0.f; }
#pragma unroll
        for (int i = 0; i < 20; ++i) { const bool ok = (i == 0) ? hp2 : (i == 1) ? hp : (i == 18) ? hn : (i == 19) ? hn2 : true; x[i] = ok ? ldbf(zb + (ptrdiff_t)(i - 2) * ZLD + ccol) : 0.f; }
#pragma unroll
        for (int tb = 0; tb < 16; ++tb) zs[tb * 768 + zo0] = (unsigned short)f2bf(z0[tb + 1] + mu00 * (z0[tb] - z0[tb + 1]) + mu10 * (z0[tb + 2] - z0[tb + 1]));
        {
            const int a = tid - 256;
#pragma unroll
            for (int tb = 0; tb < 16; ++tb) {
                const float zsft = z1[tb + 1] + mu01 * (z1[tb] - z1[tb + 1]) + mu11 * (z1[tb + 2] - z1[tb + 1]);
                if (tid < 256) zs[tb * 768 + zo1] = (unsigned short)f2bf(zsft);
                else if (tid < 480) { const float sg = sigm((a < 64) ? 2.f * zsft : zsft); const float av = (a < 64) ? (2.f * sg - 1.f) : ((a < 128) ? zsft : sg);
                    *(LAS unsigned short*)(actb + tb * ACT_ST + a * 2) = (unsigned short)f2bf(av); }
            }
        }
#pragma unroll
        for (int tb = 0; tb < 16; ++tb) {
            float y = cbv + cw[0] * x[tb] + cw[1] * x[tb + 1] + cw[2] * x[tb + 2] + cw[3] * x[tb + 3] + cw[4] * x[tb + 4];
            y = y * sigm(y);
            PM[(size_t)(g0 + tb) * 1024 + 512 * hf + tid] = (bf16)f2bf(y);
        }
        { const int tb = tid >> 5, cc = tid & 31;
          *(GAS v4u*)(ZG + (size_t)(g0 + tb) * 512 + 256 * hf + cc * 8) = *(const GAS v4u*)(zb + (size_t)tb * ZLD + RWC + 256 * hf + cc * 8); }
        if (hf == 0 && tid < 256) { const int tb = tid >> 4, cc = tid & 15; const float x = ldbf(zb + (size_t)tb * ZLD + RWC + 1536 + cc) + dtb; DT[(size_t)(g0 + tb) * 16 + cc] = (x > 20.f) ? x : log1pf(__expf(x)); }
        __syncthreads();
        const f32x4 zero = {0.f, 0.f, 0.f, 0.f};
        const int cl0 = 64 * wl + 4 * fr;
        if (w < 4) {
            bf16x8 Af[4];
#pragma unroll
            for (int kb = 0; kb < 4; ++kb) Af[kb] = *(const LAS bf16x8*)(actb + fr * ACT_ST + kb * 64 + fq * 16);
            f32x4 lw0[4], lw1[4], ia0[4], ia1[4];
#pragma unroll
            for (int cb = 0; cb < 4; ++cb) {
                lw0[cb] = __builtin_amdgcn_mfma_f32_16x16x32_bf16(Af[0], W[cb], zero, 0, 0, 0); lw1[cb] = __builtin_amdgcn_mfma_f32_16x16x32_bf16(Af[1], W[4 + cb], zero, 0, 0, 0);
                ia0[cb] = __builtin_amdgcn_mfma_f32_16x16x32_bf16(Af[2], W[8 + cb], zero, 0, 0, 0); ia1[cb] = __builtin_amdgcn_mfma_f32_16x16x32_bf16(Af[3], W[12 + cb], zero, 0, 0, 0);
            }
            const f32x4 w00 = *(const LAS f32x4*)(cst + cl0), w01 = *(const LAS f32x4*)(cst + 256 + cl0), a00 = *(const LAS f32x4*)(cst + 512 + cl0), a01 = *(const LAS f32x4*)(cst + 768 + cl0);
            const f32x4 kkc = *(const LAS f32x4*)(cst + 1024 + cl0), kac = *(const LAS f32x4*)(cst + 1280 + cl0), rk0 = *(const LAS f32x4*)(cst + 1536 + cl0), rk1 = *(const LAS f32x4*)(cst + 1792 + cl0);
#pragma unroll
            for (int e = 0; e < 4; ++e) {
                const int tok = 4 * fq + e; const size_t g = (size_t)(g0 + tok);
                const v2u ru = *(const LAS v2u*)(zs + tok * 768 + cl0), ku = *(const LAS v2u*)(zs + tok * 768 + 256 + cl0), vu = *(const LAS v2u*)(zs + tok * 768 + 512 + cl0);
                const f32x4 r = {bflo(ru.x), bfhi(ru.x), bflo(ru.y), bfhi(ru.y)}, k = {bflo(ku.x), bfhi(ku.x), bflo(ku.y), bfhi(ku.y)};
                const f32x4 kks = k * kkc;
                const float ssq = sum16((kks[0] * kks[0] + kks[1] * kks[1]) + (kks[2] * kks[2] + kks[3] * kks[3]));
                const float rn = __builtin_amdgcn_rcpf(fmaxf(sqrtf(ssq), 1e-12f));
                float ee0[4], ee1[4], kd0[4], kd1[4], bb0[4], bb1[4], na[4]; float bon = 0.f;
#pragma unroll
                for (int cb = 0; cb < 4; ++cb) {
                    ee0[cb] = 0.60653066f * sigm(w00[cb] + lw0[cb][e]); ee1[cb] = 0.60653066f * sigm(w01[cb] + lw1[cb][e]);
                    const float ic0 = sigm(a00[cb] + ia0[cb][e]), ic1 = sigm(a01[cb] + ia1[cb][e]);
                    const float kkn = kks[cb] * rn;
                    kd0[cb] = k[cb] * (1.f + (ic0 - 1.f) * kac[cb]); kd1[cb] = k[cb] * (1.f + (ic1 - 1.f) * kac[cb]);
                    bon += r[cb] * (kd0[cb] * rk0[cb] + kd1[cb] * rk1[cb]);
                    na[cb] = -kkn; bb0[cb] = kkn * ic0; bb1[cb] = kkn * ic1;
                }
                bon = sum16(bon); if (fr == 0) BONUS[g * 8 + hd] = bon;
                bf16* pr = PR + g * PRV + 256 * hf + cl0;
                *(GAS v2u*)(pr) = ru; *(GAS v2u*)(pr + 512) = vu;
                v2u o;
                o.x = pk2(na[0], na[1]); o.y = pk2(na[2], na[3]); *(GAS v2u*)(pr + 1024) = o;
                o.x = pk2(ee0[0], ee0[1]); o.y = pk2(ee0[2], ee0[3]); *(GAS v2u*)(pr + 1536) = o;
                o.x = pk2(kd0[0], kd0[1]); o.y = pk2(kd0[2], kd0[3]); *(GAS v2u*)(pr + 2048) = o;
                o.x = pk2(bb0[0], bb0[1]); o.y = pk2(bb0[2], bb0[3]); *(GAS v2u*)(pr + 2560) = o;
                o.x = pk2(ee1[0], ee1[1]); o.y = pk2(ee1[2], ee1[3]); *(GAS v2u*)(pr + 3072) = o;
                o.x = pk2(kd1[0], kd1[1]); o.y = pk2(kd1[2], kd1[3]); *(GAS v2u*)(pr + 3584) = o;
                o.x = pk2(bb1[0], bb1[1]); o.y = pk2(bb1[2], bb1[3]); *(GAS v2u*)(pr + 4096) = o;
            }
        } else {
            bf16x8 Af[3];
#pragma unroll
            for (int kb = 0; kb < 3; ++kb) Af[kb] = *(const LAS bf16x8*)(actb + fr * ACT_ST + (4 + kb) * 64 + fq * 16);
            f32x4 gt[4];
#pragma unroll
            for (int cb = 0; cb < 4; ++cb) {
                gt[cb] = __builtin_amdgcn_mfma_f32_16x16x32_bf16(Af[0], W[cb], zero, 0, 0, 0);
                gt[cb] = __builtin_amdgcn_mfma_f32_16x16x32_bf16(Af[1], W[4 + cb], gt[cb], 0, 0, 0); gt[cb] = __builtin_amdgcn_mfma_f32_16x16x32_bf16(Af[2], W[8 + cb], gt[cb], 0, 0, 0);
            }
#pragma unroll
            for (int e = 0; e < 4; ++e) { v2u o; o.x = pk2(gt[0][e], gt[1][e]); o.y = pk2(gt[2][e], gt[3][e]); *(GAS v2u*)(GATE + (size_t)(g0 + 4 * fq + e) * 512 + 256 * hf + cl0) = o; }
        }
        __syncthreads();
    }
}

template <int SH> __device__ __forceinline__ float dpp_shr(float x) { return __int_as_float(__builtin_amdgcn_update_dpp(0, __float_as_int(x), 0x110 + SH, 0xF, 0xF, true)); }
__device__ __forceinline__ int scan_row16(int c, int t, int b, int d) {
    const int st = c * 16 + t; const int seg = (st >= CTXL) ? 1 : 0; const int T = seg ? SEQ : CTXL; const int sl = st - seg * CTXL;
    return (seg ? (M_CTX + b * SEQ) : b * CTXL) + (d ? (T - 1 - sl) : sl);
}
__device__ __forceinline__ v4u scale8(const v4u u, float s) {
    v4u o; o.x = pk2(bflo(u.x) * s, bfhi(u.x) * s); o.y = pk2(bflo(u.y) * s, bfhi(u.y) * s); o.z = pk2(bflo(u.z) * s, bfhi(u.z) * s); o.w = pk2(bflo(u.w) * s, bfhi(u.w) * s); return o;
}
__device__ __forceinline__ bf16x8 pack4z(const f32x4& a) { v4u w; w.x = pk2(a[0], a[1]); w.y = pk2(a[2], a[3]); w.z = 0u; w.w = 0u; return __builtin_bit_cast(bf16x8, w); }
__device__ __forceinline__ bf16x8 tr4z(const LAS unsigned char* p) {
    const v2u t = __builtin_bit_cast(v2u, __builtin_amdgcn_ds_read_tr16_b64_v4i16((LAS v4i16_t*)p)); v4u w; w.x = t.x; w.y = t.y; w.z = 0u; w.w = 0u; return __builtin_bit_cast(bf16x8, w);
}
__device__ __forceinline__ bf16x8 cat44(const v2u a, const v2u b) { v4u w; w.x = a.x; w.y = a.y; w.z = b.x; w.w = b.y; return __builtin_bit_cast(bf16x8, w); }
constexpr int NCH16 = (CTXL + SEQ) / 16;
__device__ __forceinline__ f32x4 mm16(const f32x4& xT_c, const f32x4& y_c, const f32x4& acc) {
    return __builtin_amdgcn_mfma_f32_16x16x32_bf16(pack4z(xT_c), pack4z(y_c), acc, 0, 0, 0);
}
constexpr int RING_FLAGS = 122880;
constexpr int NSLOT = 6;
__device__ __forceinline__ unsigned lds_flag_ld(volatile LAS unsigned* p) { return (unsigned)__builtin_amdgcn_readfirstlane((int)*p); }
__device__ __forceinline__ void ring_wait_full(volatile LAS unsigned* fl, int s, int c) { while (lds_flag_ld(fl + s) != (unsigned)(c + 1)) __builtin_amdgcn_s_sleep(1); asm volatile("" ::: "memory"); }
__device__ __forceinline__ void ring_wait_free(volatile LAS unsigned* fl, int s, int c, int nslot = NSLOT, unsigned ncons = 4u) { const unsigned want = ncons * (unsigned)(c / nslot); while (lds_flag_ld(fl + 8 + s) < want) __builtin_amdgcn_s_sleep(1); asm volatile("" ::: "memory"); }
__device__ __forceinline__ void ring_set_full(volatile LAS unsigned* fl, int s, int c, int lane) { asm volatile("s_waitcnt lgkmcnt(0)" ::: "memory"); if (lane == 0) fl[s] = (unsigned)(c + 1); }
__device__ __forceinline__ void ring_done(volatile LAS unsigned* fl, int s, int lane) { asm volatile("s_waitcnt lgkmcnt(0)" ::: "memory"); if (lane == 0) __hip_atomic_fetch_add((LAS unsigned*)(fl + 8 + s), 1u, __ATOMIC_RELAXED, __HIP_MEMORY_SCOPE_WORKGROUP); }

constexpr int RST = 144, RIMG = 16 * RST;
constexpr int RW_SLOT = 18432;
__device__ __forceinline__ void rwkv_block(Frame& F, int unit, const bf16* PR, bf16* YRW) {
    const int d = unit & 1, h = (unit >> 1) & 7, b = unit >> 4;
    const int lane = F.lane, fr = lane & 15, fq = lane >> 4, tq = (lane & 15) >> 2, tp = lane & 3;
    volatile LAS unsigned* fl = (volatile LAS unsigned*)(F.lds + RING_FLAGS);
    __syncthreads();
    if (F.tid < 16) fl[F.tid] = 0u;
    __syncthreads();
    if (F.wave >= 4) {
        const int p = F.wave - 4;
        const int ve = (3 + 3 * d) * 512, vb = (5 + 3 * d) * 512, vk = (4 + 3 * d) * 512;
        bf16x8 Ltri; { v4u w; w.x = ((4 * fq + 0 <= fr) ? 0x3F80u : 0u) | ((4 * fq + 1 <= fr) ? 0x3F800000u : 0u); w.y = ((4 * fq + 2 <= fr) ? 0x3F80u : 0u) | ((4 * fq + 3 <= fr) ? 0x3F800000u : 0u); w.z = 0u; w.w = 0u; Ltri = __builtin_bit_cast(bf16x8, w); }
        v4u rE[2], rA[2], rB[2], rK[2], rR[2], rV[2];
#define RW_LOAD(c_) do { \
        _Pragma("unroll") for (int i = 0; i < 2; ++i) { const int id = lane + 64 * i; const bf16* src = PR + (size_t)scan_row16((c_), id >> 3, b, d) * PRV + h * 64 + (id & 7) * 8; \
            rE[i] = *(const GAS v4u*)(src + ve); rA[i] = *(const GAS v4u*)(src + 1024); rB[i] = *(const GAS v4u*)(src + vb); rK[i] = *(const GAS v4u*)(src + vk); rR[i] = *(const GAS v4u*)(src); rV[i] = *(const GAS v4u*)(src + 512); } } while (0)
        RW_LOAD(p);
        for (int c = p; c < NCH16; c += 4) {
            const int s = c % NSLOT;
            LAS unsigned char* sb = F.lds + s * RW_SLOT;
            LAS unsigned char* RE = sb; LAS unsigned char* RA = sb + RIMG; LAS unsigned char* RB = sb + 2 * RIMG; LAS unsigned char* RK = sb + 3 * RIMG; LAS unsigned char* RR = sb + 4 * RIMG;
            LAS unsigned char* RV = sb + 5 * RIMG; LAS unsigned char* FRG = sb + 6 * RIMG; LAS float* GC = (LAS float*)(sb + 6 * RIMG + 4096);
            ring_wait_free(fl, s, c);
#pragma unroll
            for (int i = 0; i < 2; ++i) { const int id = lane + 64 * i; const int o = (id >> 3) * RST + (id & 7) * 16;
                *(LAS v4u*)(RE + o) = rE[i]; *(LAS v4u*)(RA + o) = rA[i]; *(LAS v4u*)(RB + o) = rB[i]; *(LAS v4u*)(RK + o) = rK[i]; *(LAS v4u*)(RR + o) = rR[i]; *(LAS v4u*)(RV + o) = rV[i]; }
            if (c + 4 < NCH16) RW_LOAD(c + 4);
            asm volatile("s_waitcnt lgkmcnt(0)" ::: "memory");
#pragma unroll
            for (int jb = 0; jb < 4; ++jb) {
                const int tro = (4 * fq + tq) * RST + (16 * jb + 4 * tp) * 2;
                const v2u eu = __builtin_bit_cast(v2u, __builtin_amdgcn_ds_read_tr16_b64_v4i16((LAS v4i16_t*)(RE + tro)));
                const v2u au = __builtin_bit_cast(v2u, __builtin_amdgcn_ds_read_tr16_b64_v4i16((LAS v4i16_t*)(RA + tro)));
                const v2u bu = __builtin_bit_cast(v2u, __builtin_amdgcn_ds_read_tr16_b64_v4i16((LAS v4i16_t*)(RB + tro)));
                const v2u ku = __builtin_bit_cast(v2u, __builtin_amdgcn_ds_read_tr16_b64_v4i16((LAS v4i16_t*)(RK + tro)));
                const v2u ru = __builtin_bit_cast(v2u, __builtin_amdgcn_ds_read_tr16_b64_v4i16((LAS v4i16_t*)(RR + tro)));
                v4u ew; ew.x = eu.x; ew.y = eu.y; ew.z = 0u; ew.w = 0u;
                const f32x4 cum = __builtin_amdgcn_mfma_f32_16x16x32_bf16(Ltri, __builtin_bit_cast(bf16x8, ew), (f32x4){0.f, 0.f, 0.f, 0.f}, 0, 0, 0);
                const float ev[4] = {bflo(eu.x), bfhi(eu.x), bflo(eu.y), bfhi(eu.y)}, av[4] = {bflo(au.x), bfhi(au.x), bflo(au.y), bfhi(au.y)}, bv[4] = {bflo(bu.x), bfhi(bu.x), bflo(bu.y), bfhi(bu.y)};
                const float kv[4] = {bflo(ku.x), bfhi(ku.x), bflo(ku.y), bfhi(ku.y)}, rv[4] = {bflo(ru.x), bfhi(ru.x), bflo(ru.y), bfhi(ru.y)};
#pragma unroll
                for (int e = 0; e < 4; ++e) {
                    const float G = __expf(-cum[e]), Gi = __expf(cum[e]), Gx = __expf(ev[e] - cum[e]);
                    const int o = (4 * fq + e) * RST + (16 * jb + fr) * 2;
                    const unsigned ab = pk2(av[e] * Gx, bv[e] * Gi), kr = pk2(kv[e] * Gi, rv[e] * G);
                    *(LAS unsigned short*)(RA + o) = (unsigned short)ab; *(LAS unsigned short*)(RB + o) = (unsigned short)(ab >> 16);
                    *(LAS unsigned short*)(RK + o) = (unsigned short)kr; *(LAS unsigned short*)(RR + o) = (unsigned short)(kr >> 16);
                    if (e == 3 && fq == 3) GC[16 * jb + fr] = G;
                }
            }
            asm volatile("s_waitcnt lgkmcnt(0)" ::: "memory");
            f32x4 aba = {0.f, 0.f, 0.f, 0.f}, aka = aba, abr = aba, akr = aba, abaT = aba;
#pragma unroll
            for (int kb = 0; kb < 2; ++kb) {
                const int o = fr * RST + kb * 64 + fq * 16;
                const bf16x8 fb = *(const LAS bf16x8*)(RB + o), fk = *(const LAS bf16x8*)(RK + o), fa = *(const LAS bf16x8*)(RA + o), frr = *(const LAS bf16x8*)(RR + o);
                aba = __builtin_amdgcn_mfma_f32_16x16x32_bf16(fb, fa, aba, 0, 0, 0); aka = __builtin_amdgcn_mfma_f32_16x16x32_bf16(fk, fa, aka, 0, 0, 0);
                abr = __builtin_amdgcn_mfma_f32_16x16x32_bf16(fb, frr, abr, 0, 0, 0); akr = __builtin_amdgcn_mfma_f32_16x16x32_bf16(fk, frr, akr, 0, 0, 0);
                abaT = __builtin_amdgcn_mfma_f32_16x16x32_bf16(fa, fb, abaT, 0, 0, 0);
            }
            f32x4 idc;
#pragma unroll
            for (int e = 0; e < 4; ++e) { const int row = 4 * fq + e;
                aba[e] = (row < fr) ? aba[e] : 0.f; aka[e] = (row < fr) ? aka[e] : 0.f; abr[e] = (row <= fr) ? abr[e] : 0.f; akr[e] = (row <= fr) ? akr[e] : 0.f;
                abaT[e] = (fr < row) ? abaT[e] : 0.f; idc[e] = (row == fr) ? 1.f : 0.f; }
            f32x4 t_c = idc + aba, t_T = idc + abaT;
            f32x4 p_c = mm16(abaT, aba, (f32x4){0.f, 0.f, 0.f, 0.f}), p_T = mm16(aba, abaT, (f32x4){0.f, 0.f, 0.f, 0.f});
            { const f32x4 n_c = mm16(t_T, p_c, t_c), n_T = mm16(p_c, t_T, t_T); t_c = n_c; t_T = n_T; }
            { const f32x4 q_c = mm16(p_T, p_c, (f32x4){0.f, 0.f, 0.f, 0.f}), q_T = mm16(p_c, p_T, (f32x4){0.f, 0.f, 0.f, 0.f}); p_c = q_c; p_T = q_T; }
            { const f32x4 n_c = mm16(t_T, p_c, t_c), n_T = mm16(p_c, t_T, t_T); t_c = n_c; t_T = n_T; }
            { const f32x4 q_c = mm16(p_T, p_c, (f32x4){0.f, 0.f, 0.f, 0.f}); p_c = q_c; }
            const f32x4 tm_c = mm16(t_T, p_c, t_c);
            *(LAS bf16x8*)(FRG + lane * 16) = pack4z(tm_c); *(LAS bf16x8*)(FRG + 1024 + lane * 16) = pack4z(aka);
            *(LAS bf16x8*)(FRG + 2048 + lane * 16) = pack4z(abr); *(LAS bf16x8*)(FRG + 3072 + lane * 16) = pack4z(akr);
            ring_set_full(fl, s, c, lane);
        }
#undef RW_LOAD
    } else {
        const int q = F.wave;
        __builtin_amdgcn_s_setprio(3);
        bf16* yout = YRW + (size_t)d * M_ALL * 512 + h * 64 + 16 * q;
        f32x4 T[4];
#pragma unroll
        for (int jb = 0; jb < 4; ++jb) T[jb] = (f32x4){0.f, 0.f, 0.f, 0.f};
        for (int c = 0; c < NCH16; ++c) {
            const int s = c % NSLOT;
            LAS unsigned char* sb = F.lds + s * RW_SLOT;
            LAS unsigned char* RA = sb + RIMG; LAS unsigned char* RB = sb + 2 * RIMG; LAS unsigned char* RK = sb + 3 * RIMG; LAS unsigned char* RR = sb + 4 * RIMG;
            LAS unsigned char* RV = sb + 5 * RIMG; LAS unsigned char* FRG = sb + 6 * RIMG; LAS float* GC = (LAS float*)(sb + 6 * RIMG + 4096);
            ring_wait_full(fl, s, c);
            const bf16x8 tmA = *(const LAS bf16x8*)(FRG + lane * 16), akaA = *(const LAS bf16x8*)(FRG + 1024 + lane * 16), abrA = *(const LAS bf16x8*)(FRG + 2048 + lane * 16), akrA = *(const LAS bf16x8*)(FRG + 3072 + lane * 16);
            const bf16x8 Vf = tr4z(RV + (4 * fq + tq) * RST + (16 * q + 4 * tp) * 2);
            f32x4 x = {0.f, 0.f, 0.f, 0.f}, y = {0.f, 0.f, 0.f, 0.f};
#pragma unroll
            for (int jp = 0; jp < 2; ++jp) {
                const int o = fr * RST + (32 * jp + 4 * fq) * 2;
                const bf16x8 tf = pack8(T[2 * jp], T[2 * jp + 1]);
                x = __builtin_amdgcn_mfma_f32_16x16x32_bf16(cat44(*(const LAS v2u*)(RA + o), *(const LAS v2u*)(RA + o + 32)), tf, x, 0, 0, 0);
                y = __builtin_amdgcn_mfma_f32_16x16x32_bf16(cat44(*(const LAS v2u*)(RR + o), *(const LAS v2u*)(RR + o + 32)), tf, y, 0, 0, 0);
            }
            x = __builtin_amdgcn_mfma_f32_16x16x32_bf16(akaA, Vf, x, 0, 0, 0);
            const f32x4 ut = __builtin_amdgcn_mfma_f32_16x16x32_bf16(tmA, pack4z(x), (f32x4){0.f, 0.f, 0.f, 0.f}, 0, 0, 0);
            y = __builtin_amdgcn_mfma_f32_16x16x32_bf16(abrA, pack4z(ut), y, 0, 0, 0);
            y = __builtin_amdgcn_mfma_f32_16x16x32_bf16(akrA, Vf, y, 0, 0, 0);
            bf16x8 UV; { const v4u vw = __builtin_bit_cast(v4u, Vf); v4u w; w.x = pk2(ut[0], ut[1]); w.y = pk2(ut[2], ut[3]); w.z = vw.x; w.w = vw.y; UV = __builtin_bit_cast(bf16x8, w); }
#pragma unroll
            for (int jb = 0; jb < 4; ++jb) {
                const int tro = (4 * fq + tq) * RST + (16 * jb + 4 * tp) * 2;
                const v2u bt = __builtin_bit_cast(v2u, __builtin_amdgcn_ds_read_tr16_b64_v4i16((LAS v4i16_t*)(RB + tro))), kt = __builtin_bit_cast(v2u, __builtin_amdgcn_ds_read_tr16_b64_v4i16((LAS v4i16_t*)(RK + tro)));
                const f32x4 gc = *(const LAS f32x4*)(GC + 16 * jb + 4 * fq);
                T[jb] = __builtin_amdgcn_mfma_f32_16x16x32_bf16(cat44(bt, kt), UV, T[jb], 0, 0, 0); T[jb] = T[jb] * gc;
            }
            ring_done(fl, s, lane);
            { const int row0 = scan_row16(c, 0, b, d), stp = d ? -1 : 1;
#pragma unroll
              for (int e = 0; e < 4; ++e) yout[(size_t)(row0 + stp * (4 * fq + e)) * 512 + fr] = (bf16)f2bf(y[e]); }
        }
        __builtin_amdgcn_s_setprio(0);
    }
}

constexpr int MST = 272, MIMG = 16 * MST;
constexpr int MB_NSLOT = 5;
constexpr int MB_SLOT = 21504;
__device__ __forceinline__ void mamba_block(Frame& F, int unit, const bf16* PM, const float* DT, const float* a_log, bf16* YMB) {
    const int d = unit & 1, h = (unit >> 1) & 7, b = unit >> 4, grp = h >> 2;
    const int lane = F.lane, fr = lane & 15, fq = lane >> 4, tq = (lane & 15) >> 2, tp = lane & 3;
    volatile LAS unsigned* fl = (volatile LAS unsigned*)(F.lds + RING_FLAGS);
    __syncthreads();
    if (F.tid < 16) fl[F.tid] = 0u;
    __syncthreads();
    if (F.wave >= 4) {
        const int p = F.wave - 4;
        const float a_neg = -__expf(a_log[d * 8 + h]);
        v4u rB[4], rC[4], rX[2]; float rdt;
#define MB_LOAD(c_) do { \
        _Pragma("unroll") for (int i = 0; i < 4; ++i) { const int t = (lane >> 4) + 4 * i; const bf16* src = PM + (size_t)scan_row16((c_), t, b, d) * 1024 + 512 + grp * 128 + (lane & 15) * 8; rB[i] = *(const GAS v4u*)src; rC[i] = *(const GAS v4u*)(src + 256); } \
        _Pragma("unroll") for (int i = 0; i < 2; ++i) { const int id = lane + 64 * i; rX[i] = *(const GAS v4u*)(PM + (size_t)scan_row16((c_), id >> 3, b, d) * 1024 + h * 64 + (id & 7) * 8); } \
        rdt = DT[(size_t)scan_row16((c_), lane & 15, b, d) * 16 + d * 8 + h]; } while (0)
        MB_LOAD(p);
        for (int c = p; c < NCH16; c += 4) {
            const int s = c % MB_NSLOT;
            LAS unsigned char* sb = F.lds + s * MB_SLOT;
            LAS unsigned char* BR = sb; LAS unsigned char* CR = sb + MIMG; LAS unsigned char* RT = sb + 2 * MIMG; LAS unsigned char* KH = sb + 3 * MIMG; LAS unsigned char* VX = sb + 4 * MIMG;
            LAS unsigned char* FRG = sb + 4 * MIMG + RIMG; LAS float* scal = (LAS float*)(sb + 4 * MIMG + RIMG + 1024);
            ring_wait_free(fl, s, c, MB_NSLOT);
            float cs = rdt * a_neg;
            cs += dpp_shr<1>(cs); cs += dpp_shr<2>(cs); cs += dpp_shr<4>(cs); cs += dpp_shr<8>(cs);
            const float cse = __int_as_float(__builtin_amdgcn_readlane(__float_as_int(cs), 15));
            if (lane < 16) { scal[16 + lane] = cs; scal[32 + lane] = __expf(cs); scal[48 + lane] = rdt; scal[64 + lane] = __expf(cse - cs); }
            if (lane == 0) scal[0] = __expf(cse);
            asm volatile("s_waitcnt lgkmcnt(0)" ::: "memory");
#pragma unroll
            for (int i = 0; i < 4; ++i) { const int t = (lane >> 4) + 4 * i; const float sk = scal[64 + t], sr = scal[32 + t]; const int o = t * MST + (lane & 15) * 16;
                *(LAS v4u*)(BR + o) = rB[i]; *(LAS v4u*)(CR + o) = rC[i]; *(LAS v4u*)(KH + o) = scale8(rB[i], sk); *(LAS v4u*)(RT + o) = scale8(rC[i], sr); }
#pragma unroll
            for (int i = 0; i < 2; ++i) { const int id = lane + 64 * i; const int t = id >> 3; *(LAS v4u*)(VX + t * RST + (id & 7) * 16) = scale8(rX[i], scal[48 + t]); }
            if (c + 4 < NCH16) MB_LOAD(c + 4);
            asm volatile("s_waitcnt lgkmcnt(0)" ::: "memory");
            f32x4 akr = {0.f, 0.f, 0.f, 0.f};
#pragma unroll
            for (int kb = 0; kb < 4; ++kb) akr = __builtin_amdgcn_mfma_f32_16x16x32_bf16(*(const LAS bf16x8*)(BR + fr * MST + kb * 64 + fq * 16), *(const LAS bf16x8*)(CR + fr * MST + kb * 64 + fq * 16), akr, 0, 0, 0);
            const float cst = scal[16 + fr]; const f32x4 css = *(const LAS f32x4*)(scal + 16 + 4 * fq);
#pragma unroll
            for (int e = 0; e < 4; ++e) akr[e] = (4 * fq + e <= fr) ? akr[e] * __expf(cst - css[e]) : 0.f;
            *(LAS bf16x8*)(FRG + lane * 16) = pack4z(akr);
            ring_set_full(fl, s, c, lane);
        }
#undef MB_LOAD
    } else {
        const int q = F.wave;
        __builtin_amdgcn_s_setprio(3);
        bf16* yout = YMB + (size_t)d * M_ALL * 512 + h * 64 + 16 * q;
        unsigned long long prof_wait = 0ull; (void)prof_wait;
        f32x4 T[8];
#pragma unroll
        for (int jb = 0; jb < 8; ++jb) T[jb] = (f32x4){0.f, 0.f, 0.f, 0.f};
        for (int c = 0; c < NCH16; ++c) {
            const int s = c % MB_NSLOT;
            LAS unsigned char* sb = F.lds + s * MB_SLOT;
            LAS unsigned char* RT = sb + 2 * MIMG; LAS unsigned char* KH = sb + 3 * MIMG; LAS unsigned char* VX = sb + 4 * MIMG;
            LAS unsigned char* FRG = sb + 4 * MIMG + RIMG; LAS float* scal = (LAS float*)(sb + 4 * MIMG + RIMG + 1024);
#ifdef PROF_MBWAIT
            const unsigned long long tw0_ = __builtin_amdgcn_s_memrealtime();
#endif
            ring_wait_full(fl, s, c);
#ifdef PROF_MBWAIT
            prof_wait += __builtin_amdgcn_s_memrealtime() - tw0_;
#endif
#ifdef PROF_MBSEG
            unsigned long long ts0_ = __builtin_amdgcn_s_memrealtime();
#endif
            const bf16x8 akrA = *(const LAS bf16x8*)(FRG + lane * 16); const float gC = scal[0];
            const bf16x8 Vf = tr4z(VX + (4 * fq + tq) * RST + (16 * q + 4 * tp) * 2);
            f32x4 ya = {0.f, 0.f, 0.f, 0.f}, yb = __builtin_amdgcn_mfma_f32_16x16x32_bf16(akrA, Vf, (f32x4){0.f, 0.f, 0.f, 0.f}, 0, 0, 0);
#pragma unroll
            for (int jp = 0; jp < 4; ++jp) {
                const LAS unsigned char* rp = RT + fr * MST + (32 * jp + 4 * fq) * 2;
                const bf16x8 ra = cat44(*(const LAS v2u*)rp, *(const LAS v2u*)(rp + 32)), tf = pack8(T[2 * jp], T[2 * jp + 1]);
                if (jp & 1) yb = __builtin_amdgcn_mfma_f32_16x16x32_bf16(ra, tf, yb, 0, 0, 0); else ya = __builtin_amdgcn_mfma_f32_16x16x32_bf16(ra, tf, ya, 0, 0, 0);
            }
            const f32x4 y = ya + yb;
#ifdef PROF_MBSEG
            asm volatile("" :: "v"(y)); { const unsigned long long t_ = __builtin_amdgcn_s_memrealtime(); if (PROF_MBSEG == 1) prof_wait += t_ - ts0_; ts0_ = t_; }
#endif
#ifdef MB_CONS2X
            { f32x4 yd = {0.f, 0.f, 0.f, 0.f};
#pragma unroll
              for (int jp = 0; jp < 4; ++jp) { const LAS unsigned char* rp = RT + fr * MST + (32 * jp + 4 * fq) * 2 + 8;
                  yd = __builtin_amdgcn_mfma_f32_16x16x32_bf16(cat44(*(const LAS v2u*)rp, *(const LAS v2u*)(rp + 32)), pack8(T[2 * jp] * 1.0001f, T[2 * jp + 1] * 1.0001f), yd, 0, 0, 0); }
              yd = __builtin_amdgcn_mfma_f32_16x16x32_bf16(akrA, Vf, yd, 0, 0, 0);
              asm volatile("" :: "v"(yd)); }
#endif
#pragma unroll
            for (int jb = 0; jb < 8; ++jb) T[jb] = __builtin_amdgcn_mfma_f32_16x16x32_bf16(tr4z(KH + (4 * fq + tq) * MST + (16 * jb + 4 * tp) * 2), Vf, T[jb] * gC, 0, 0, 0);
#ifdef PROF_MBSEG
            asm volatile("" :: "v"(T[0]), "v"(T[7])); { const unsigned long long t_ = __builtin_amdgcn_s_memrealtime(); if (PROF_MBSEG == 2) prof_wait += t_ - ts0_; ts0_ = t_; }
#endif
            ring_done(fl, s, lane);
#ifdef PROF_MBSEG
            { const unsigned long long t_ = __builtin_amdgcn_s_memrealtime(); if (PROF_MBSEG == 3) prof_wait += t_ - ts0_; ts0_ = t_; }
#endif
            { const int row0 = scan_row16(c, 0, b, d), stp = d ? -1 : 1;
#pragma unroll
              for (int e = 0; e < 4; ++e) yout[(size_t)(row0 + stp * (4 * fq + e)) * 512 + fr] = (bf16)f2bf(y[e]); }
#ifdef PROF_MBSEG
            { const unsigned long long t_ = __builtin_amdgcn_s_memrealtime(); if (PROF_MBSEG == 4) prof_wait += t_ - ts0_; ts0_ = t_; }
#endif
        }
#if defined(PROF_MBWAIT) || defined(PROF_MBSEG)
        if (F.bid == 128 && F.tid == 0) __hip_atomic_store(F.ctl + 2, __float_as_uint((float)prof_wait * 0.01f), RLX_AGENT);
#endif
        __builtin_amdgcn_s_setprio(0);
    }
}

struct FinIn { const float *gn_w, *gn_b, *mb_d, *mb_norm_w; };
__device__ __forceinline__ void finish_phase(Frame& F, const FinIn& P, const bf16* YRW, const bf16* YMB, const bf16* PR, const bf16* PM, const float* BONUS, const bf16* GATE, const bf16* ZG, bf16* A) {
    const int gw = F.bid * NWAVES + F.wave, NGW = F.G * NWAVES; const int c0 = F.lane * 8, head = F.lane >> 3;
    float gnw[8], gnb[8], nw[8];
#pragma unroll
    for (int i = 0; i < 8; ++i) { gnw[i] = P.gn_w[c0 + i]; gnb[i] = P.gn_b[c0 + i]; nw[i] = P.mb_norm_w[c0 + i]; }
    const float dd = P.mb_d[head];
    struct FinIn9 { v4u y0, y1, vv, gg, m0, m1, xx, zz; float bon; };
    FinIn9 cur, nxt;
#define FIN_FETCH(R_, g_) do { const size_t gs_ = (size_t)(g_); \
        R_.y0 = *(const GAS v4u*)(YRW + gs_ * 512 + c0); R_.y1 = *(const GAS v4u*)(YRW + (size_t)M_ALL * 512 + gs_ * 512 + c0); R_.vv = *(const GAS v4u*)(PR + gs_ * PRV + 512 + c0); R_.gg = *(const GAS v4u*)(GATE + gs_ * 512 + c0); \
        R_.m0 = *(const GAS v4u*)(YMB + gs_ * 512 + c0); R_.m1 = *(const GAS v4u*)(YMB + (size_t)M_ALL * 512 + gs_ * 512 + c0); R_.xx = *(const GAS v4u*)(PM + gs_ * 1024 + c0); R_.zz = *(const GAS v4u*)(ZG + gs_ * 512 + c0); \
        R_.bon = BONUS[gs_ * 8 + head]; } while (0)
    if (gw < M_ALL) FIN_FETCH(cur, gw);
    for (int g = gw; g < M_ALL; g += NGW) {
        const size_t gs = (size_t)g;
        if (g + NGW < M_ALL) FIN_FETCH(nxt, g + NGW);
        const v4u y0 = cur.y0, y1 = cur.y1, vv = cur.vv, gg = cur.gg, m0 = cur.m0, m1 = cur.m1, xx = cur.xx, zz = cur.zz; const float bon = cur.bon;
        cur = nxt;
        float y[8], vf[8], gf[8];
#pragma unroll
        for (int i = 0; i < 4; ++i) { y[2 * i] = bflo(y0[i]) + bflo(y1[i]); y[2 * i + 1] = bfhi(y0[i]) + bfhi(y1[i]); vf[2 * i] = bflo(vv[i]); vf[2 * i + 1] = bfhi(vv[i]); gf[2 * i] = bflo(gg[i]); gf[2 * i + 1] = bfhi(gg[i]); }
        float s = 0.f;
#pragma unroll
        for (int i = 0; i < 8; ++i) s += y[i];
        s = sum8(s);
        const float mu = s * (1.f / 64.f); float q = 0.f;
#pragma unroll
        for (int i = 0; i < 8; ++i) { y[i] -= mu; q += y[i] * y[i]; }
        q = sum8(q);
        const float rstd = rsqrtf(q * (1.f / 64.f) + 64e-5f);
        float o[8];
#pragma unroll
        for (int i = 0; i < 8; ++i) o[i] = ((y[i] * rstd) * gnw[i] + gnb[i] + bon * vf[i]) * gf[i];
        v4u w; w.x = pk2(o[0], o[1]); w.y = pk2(o[2], o[3]); w.z = pk2(o[4], o[5]); w.w = pk2(o[6], o[7]);
        *(GAS v4u*)(A + gs * 1024 + c0) = w;
        float ym[8]; float ss = 0.f;
#pragma unroll
        for (int i = 0; i < 4; ++i) {
            const float z0 = bflo(zz[i]), z1 = bfhi(zz[i]);
            ym[2 * i] = (bflo(m0[i]) + bflo(m1[i]) + dd * bflo(xx[i])) * (z0 * sigm(z0)); ym[2 * i + 1] = (bfhi(m0[i]) + bfhi(m1[i]) + dd * bfhi(xx[i])) * (z1 * sigm(z1));
            ss += ym[2 * i] * ym[2 * i] + ym[2 * i + 1] * ym[2 * i + 1];
        }
        ss = half_sum(ss, F.lane);
        const float rr = rsqrtf(ss * (1.f / 256.f) + 1e-6f);
        v4u w2; w2.x = pk2(ym[0] * rr * nw[0], ym[1] * rr * nw[1]); w2.y = pk2(ym[2] * rr * nw[2], ym[3] * rr * nw[3]); w2.z = pk2(ym[4] * rr * nw[4], ym[5] * rr * nw[5]); w2.w = pk2(ym[6] * rr * nw[6], ym[7] * rr * nw[7]);
        *(GAS v4u*)(A + gs * 1024 + 512 + c0) = w2;
    }
#undef FIN_FETCH
}
#ifndef PROF_K
#define PROF_K 1e-5f
#endif
#ifndef PROF_PH0
#define PROF_PH0 PROF_PH
#endif
#ifndef PROF_OFF
#define PROF_OFF 0.f
#endif
__device__ __forceinline__ int fresh_lane() { int l; asm volatile("v_mbcnt_lo_u32_b32 %0, -1, 0\n\tv_mbcnt_hi_u32_b32 %0, -1, %0" : "=v"(l)); return l; }

__device__ __forceinline__ bf16x8 tr2(const LAS unsigned char* p0, const LAS unsigned char* p1) {
    const s16x4 t0 = __builtin_bit_cast(s16x4, __builtin_amdgcn_ds_read_tr16_b64_v4i16((LAS v4i16_t*)p0));
    const s16x4 t1 = __builtin_bit_cast(s16x4, __builtin_amdgcn_ds_read_tr16_b64_v4i16((LAS v4i16_t*)p1));
    bf16x8 r; r[0] = t0[0]; r[1] = t0[1]; r[2] = t0[2]; r[3] = t0[3]; r[4] = t1[0]; r[5] = t1[1]; r[6] = t1[2]; r[7] = t1[3]; return r;
}
__device__ __forceinline__ int swz(int row, int chunk) { return row * 128 + ((chunk ^ (row & 7)) << 4); }
constexpr int AT_CTXK = 0, AT_CTXV = 32768, AT_VRING = 65536, AT_NSLOT = 9, AT_RPB = AT_VRING + AT_NSLOT * 8192;
__device__ __forceinline__ void attn_phase(Frame& F, const bf16* Q, const bf16* K, const bf16* V, const float* rpb, bf16* O) {
    LAS unsigned char* ctxK = F.lds + AT_CTXK; LAS unsigned char* ctxV = F.lds + AT_CTXV; LAS unsigned char* vring = F.lds + AT_VRING; LAS float* rp = (LAS float*)(F.lds + AT_RPB);
    const int lane = F.lane, fr = lane & 15, fq = lane >> 4, tq = (lane & 15) >> 2, tp = lane & 3;
#ifndef ATT_REPS
#define ATT_REPS 1
#endif
    const int avcu = (F.G % 8 == 0) ? (F.bid % 8) * (F.G / 8) + F.bid / 8 : F.bid;
    for (int u_ = avcu; u_ < 256 * ATT_REPS; u_ += F.G) {
        const int u = u_ & 255; const int bh = u >> 1, half = u & 1, b = bh >> 4, h = bh & 15;
        const unsigned latbase = (unsigned)(M_CTX + b * SEQ);
        const int vcol = F.tid >> 3, vch = F.tid & 7;
        const unsigned vsrc = (unsigned)((latbase + vcol) * D + h * 64 + vch * 8);
        const int vdst = vcol * 128 + ((vch ^ (vcol & 7)) << 4);
        __syncthreads();
        {
            const int key = F.tid >> 1, hf = F.tid & 1; const size_t src = (size_t)(b * CTXL + key) * D + h * 64 + hf * 32;
#pragma unroll
            for (int i = 0; i < 4; ++i) { *(LAS v4u*)(ctxK + swz(key, hf * 4 + i)) = *(const GAS v4u*)(K + src + 8 * i); *(LAS v4u*)(ctxV + swz(key, hf * 4 + i)) = *(const GAS v4u*)(V + src + 8 * i); }
            if (F.tid < 465) rp[F.tid] = rpb[h * 465 + F.tid] * 1.4426950408889634f;
            const int r0 = 16 * half, lo0 = min(max(r0 - 4, 0), 24), hi0 = min(max(r0 + 1 - 4, 0), 24) + 7;
            for (int kr = lo0; kr <= hi0; ++kr) *(LAS v4u*)(vring + (kr % AT_NSLOT) * 8192 + vdst) = *(const GAS v4u*)(V + vsrc + (unsigned)(kr * 64 * D));
        }
        __syncthreads();
        bf16x8 qf[2];
        {   const int r = 16 * half + (F.wave >> 2), qc = 16 * (F.wave & 3) + fr;
            const bf16* qp = Q + (unsigned)((latbase + r * 64 + qc) * D + h * 64 + 8 * fq); qf[0] = *(const GAS bf16x8*)qp; qf[1] = *(const GAS bf16x8*)(qp + 32); }
        for (int it = 0; it < 8; ++it) {
            const int ra = 16 * half + 2 * it;
            const int r = ra + (F.wave >> 2), j = F.wave & 3;
            const int rs = min(max(r - 4, 0), 24); const int kb = (j == 0) ? 0 : (j == 1) ? 8 : (j == 2) ? 24 : 32;
            const int qc = 16 * j + fr, wsq = min(max(qc - 8, 0), 48);
            const int hi = min(max(ra + 1 - 4, 0), 24) + 7, hin = (it < 7) ? (min(max(ra + 3 - 4, 0), 24) + 7) : hi;
            const int cv = kb + 4 * fq - wsq, cc2 = kb + 4 * fq - qc + 15;
            f32x4 sl[8][2], sc[16];
            const unsigned koff = (unsigned)((latbase + rs * 64 + kb + fr) * D + h * 64 + 8 * fq);
            bf16x8 kc[4], kn[4], kn2[4];
#pragma unroll
            for (int x = 0; x < 4; ++x) kc[x] = *(const GAS bf16x8*)(K + koff + (x >> 1) * 16 * D + (x & 1) * 32);
#pragma unroll
            for (int x = 0; x < 4; ++x) kn[x] = *(const GAS bf16x8*)(K + koff + (unsigned)(64 * D) + (x >> 1) * 16 * D + (x & 1) * 32);
#pragma unroll
            for (int cb = 0; cb < 16; ++cb) {
                const int key = 16 * cb + fr;
                const bf16x8 k0 = *(const LAS bf16x8*)(ctxK + swz(key, fq)), k1 = *(const LAS bf16x8*)(ctxK + swz(key, 4 + fq));
                f32x4 s = {0.f, 0.f, 0.f, 0.f};
                s = __builtin_amdgcn_mfma_f32_16x16x32_bf16(k0, qf[0], s, 0, 0, 0);
                s = __builtin_amdgcn_mfma_f32_16x16x32_bf16(k1, qf[1], s, 0, 0, 0);
                sc[cb] = s;
            }
#pragma unroll
            for (int i = 0; i < 8; ++i) {
                const int brow = (rs + i - r + 7) * 31;
                if (i < 6) {
#pragma unroll
                    for (int x = 0; x < 4; ++x) kn2[x] = *(const GAS bf16x8*)(K + koff + (unsigned)((i + 2) * 64 * D) + (x >> 1) * 16 * D + (x & 1) * 32);
                }
#pragma unroll
                for (int blk = 0; blk < 2; ++blk) {
                    f32x4 s = {0.f, 0.f, 0.f, 0.f};
                    s = __builtin_amdgcn_mfma_f32_16x16x32_bf16(kc[2 * blk], qf[0], s, 0, 0, 0);
                    s = __builtin_amdgcn_mfma_f32_16x16x32_bf16(kc[2 * blk + 1], qf[1], s, 0, 0, 0);
#pragma unroll
                    for (int e = 0; e < 4; ++e) s[e] = ((unsigned)(cv + 16 * blk + e) < 16u) ? (s[e] + rp[brow + min(max(cc2 + 16 * blk + e, 0), 30)]) : -INFINITY;
                    sl[i][blk] = s;
                }
#pragma unroll
                for (int x = 0; x < 4; ++x) { kc[x] = kn[x]; kn[x] = kn2[x]; }
            }
            v4u vnew[2];
#pragma unroll
            for (int n = 0; n < 2; ++n) if (hi + 1 + n <= hin) vnew[n] = *(const GAS v4u*)(V + vsrc + (unsigned)((hi + 1 + n) * 64 * D));
            float m = -INFINITY;
#pragma unroll
            for (int i = 0; i < 8; ++i)
#pragma unroll
                for (int blk = 0; blk < 2; ++blk)
#pragma unroll
                    for (int e = 0; e < 4; ++e) m = fmaxf(m, sl[i][blk][e]);
#pragma unroll
            for (int cb = 0; cb < 16; ++cb)
#pragma unroll
                for (int e = 0; e < 4; ++e) m = fmaxf(m, sc[cb][e]);
            m = fmaxf(m, __shfl_xor(m, 16)); m = fmaxf(m, __shfl_xor(m, 32));
            float l = 0.f;
#pragma unroll
            for (int i = 0; i < 8; ++i)
#pragma unroll
                for (int blk = 0; blk < 2; ++blk)
#pragma unroll
                    for (int e = 0; e < 4; ++e) { const float p = __builtin_amdgcn_exp2f(sl[i][blk][e] - m); sl[i][blk][e] = p; l += p; }
#pragma unroll
            for (int cb = 0; cb < 16; ++cb)
#pragma unroll
                for (int e = 0; e < 4; ++e) { const float p = __builtin_amdgcn_exp2f(sc[cb][e] - m); sc[cb][e] = p; l += p; }
            l += __shfl_xor(l, 16); l += __shfl_xor(l, 32);
            const float linv = __builtin_amdgcn_rcpf(l);
            f32x4 o[4];
#pragma unroll
            for (int db = 0; db < 4; ++db) o[db] = (f32x4){0.f, 0.f, 0.f, 0.f};
#pragma unroll
            for (int i = 0; i < 8; ++i) {
                const LAS unsigned char* vrow = vring + ((rs + i) % AT_NSLOT) * 8192;
                const bf16x8 pa = pack8(sl[i][0], sl[i][1]);
                const int c0 = kb + 4 * fq + tq, c1 = c0 + 16;
#pragma unroll
                for (int db = 0; db < 4; ++db) {
                    const int ch = 2 * db + (tp >> 1), wi = 8 * (tp & 1);
                    const bf16x8 vb = tr2(vrow + swz(c0, ch) + wi, vrow + swz(c1, ch) + wi);
                    o[db] = __builtin_amdgcn_mfma_f32_16x16x32_bf16(pa, vb, o[db], 0, 0, 0);
                }
            }
            bf16x8 qn[2];
            if (it < 7) { const bf16* qp = Q + (unsigned)((latbase + (r + 2) * 64 + qc) * D + h * 64 + 8 * fq); qn[0] = *(const GAS bf16x8*)qp; qn[1] = *(const GAS bf16x8*)(qp + 32); }
#pragma unroll
            for (int cc = 0; cc < 8; ++cc) {
                const bf16x8 pa = pack8(sc[2 * cc], sc[2 * cc + 1]);
                const int k0 = 32 * cc + 4 * fq + tq, k1 = k0 + 16;
#pragma unroll
                for (int db = 0; db < 4; ++db) {
                    const int ch = 2 * db + (tp >> 1), wi = 8 * (tp & 1);
                    const bf16x8 vb = tr2(ctxV + swz(k0, ch) + wi, ctxV + swz(k1, ch) + wi);
                    o[db] = __builtin_amdgcn_mfma_f32_16x16x32_bf16(pa, vb, o[db], 0, 0, 0);
                }
            }
#pragma unroll
            for (int e = 0; e < 4; ++e) {
                const float li = __shfl(linv, 4 * fq + e);
                bf16* op = O + (unsigned)((b * SEQ + r * 64 + 16 * j + 4 * fq + e) * D + h * 64 + fr);
#pragma unroll
                for (int db = 0; db < 4; ++db) op[db * 16] = (bf16)f2bf(o[db][e] * li);
            }
            __syncthreads();
#pragma unroll
            for (int n = 0; n < 2; ++n) if (hi + 1 + n <= hin) *(LAS v4u*)(vring + ((hi + 1 + n) % AT_NSLOT) * 8192 + vdst) = vnew[n];
            __syncthreads();
            if (it < 7) { qf[0] = qn[0]; qf[1] = qn[1]; }
        }
    }
}

template <bool PRE = false> __device__ __forceinline__ void router_phase(Frame& F, const float* hlat, const float* g, const float* mods_l, const float* router_w, const float* router_b, bf16* A4, unsigned* tokinfo, gu32* cntb, const float* plog = nullptr) {
    LAS int* se = (LAS int*)F.lds;
    LAS float* sg = (LAS float*)(F.lds + 512);
    LAS int* srow = (LAS int*)(F.lds + 1024);
    LAS unsigned* spos = (LAS unsigned*)(F.lds + 1280);
    const int gw = F.bid * NWAVES + F.wave, NGW = F.G * NWAVES;
    const int nbatch = (M_LAT + NGW * 8 - 1) / (NGW * 8);
    LAS float* srw = (LAS float*)(F.lds + 2048);
    __syncthreads();
    if constexpr (!PRE) for (int i = F.tid; i < 2048; i += NTHR) ((LAS f32x4*)srw)[i] = ((const GAS f32x4*)router_w)[i];
    f32x4 gg[4];
#pragma unroll
    for (int j = 0; j < 4; ++j) gg[j] = ((const GAS f32x4*)g)[F.lane + 64 * j];
    RowIn cur, nxt;
#define RT_FETCH(R_, r_) do { const float* mp_ = mods_l + ((r_) >> 11) * 6144; row_fetch(R_, hlat + (size_t)(r_) * D, mp_ + 3072, mp_ + 4096, F.lane); } while (0)
    if constexpr (!PRE) { if (gw < M_LAT) RT_FETCH(cur, gw); }
    for (int bt = 0; bt < nbatch; ++bt) {
        __syncthreads();
        if constexpr (PRE) {
            const int k = F.lane;
            if (k < 8) { const int r = gw + (bt * 8 + k) * NGW, slot = F.wave * 8 + k;
                if (r >= M_LAT) { se[2 * slot] = -1; se[2 * slot + 1] = -1; srow[slot] = 0; }
                else { const GAS f32x4* pl = (const GAS f32x4*)(plog + (size_t)r * 32); f32x4 q[8]; float lg[8];
#pragma unroll
                    for (int i = 0; i < 8; ++i) q[i] = pl[i];
#pragma unroll
                    for (int e = 0; e < 4; ++e) { lg[e] = ((q[0][e] + q[2][e]) + (q[4][e] + q[6][e])) + router_b[e]; lg[4 + e] = ((q[1][e] + q[3][e]) + (q[5][e] + q[7][e])) + router_b[4 + e]; }
                    int e0 = 0; float v0 = lg[0];
#pragma unroll
                    for (int e = 1; e < 8; ++e) if (lg[e] > v0) { v0 = lg[e]; e0 = e; }
                    int e1 = -1; float v1 = -INFINITY;
#pragma unroll
                    for (int e = 0; e < 8; ++e) if (e != e0 && lg[e] > v1) { v1 = lg[e]; e1 = e; }
                    const float g0 = 1.f / (1.f + __expf(v1 - v0)), g1 = 1.f - g0;
                    se[2 * slot] = e0; se[2 * slot + 1] = e1; sg[2 * slot] = g0; sg[2 * slot + 1] = g1; srow[slot] = r; } }
        }
#pragma unroll 1
        for (int k = 0; k < (PRE ? 0 : 8); ++k) {
            const int r = gw + (bt * 8 + k) * NGW, slot = F.wave * 8 + k;
            if (r >= M_LAT) { if (F.lane == 0) { se[2 * slot] = -1; se[2 * slot + 1] = -1; srow[slot] = 0; } continue; }
            float lg[8];
            if constexpr (PRE) {
                const GAS f32x4* pl = (const GAS f32x4*)(plog + (size_t)r * 32); f32x4 q[8];
#pragma unroll
                for (int i = 0; i < 8; ++i) q[i] = pl[i];
#pragma unroll
                for (int e = 0; e < 4; ++e) { lg[e] = ((q[0][e] + q[2][e]) + (q[4][e] + q[6][e])) + router_b[e]; lg[4 + e] = ((q[1][e] + q[3][e]) + (q[5][e] + q[7][e])) + router_b[4 + e]; }
            } else {
            if (r + NGW < M_LAT) RT_FETCH(nxt, r + NGW);
            f32x4 a[4]; row_finish(cur, gg, A4 + (size_t)r * D, F.lane, a);
            cur = nxt;
#pragma unroll
            for (int e = 0; e < 8; ++e) lg[e] = 0.f;
#pragma unroll
            for (int j = 0; j < 4; ++j)
#pragma unroll
                for (int x = 0; x < 4; ++x) { const LAS float* rw = srw + ((F.lane + 64 * j) * 4 + x) * 8; const f32x4 w0 = *(const LAS f32x4*)rw, w1 = *(const LAS f32x4*)(rw + 4); const float av = a[j][x];
#pragma unroll
                    for (int e = 0; e < 4; ++e) { lg[e] += av * w0[e]; lg[4 + e] += av * w1[e]; } }
#pragma unroll
            for (int e = 0; e < 8; ++e) lg[e] = wave_sum(lg[e]) + router_b[e];
            }
            int e0 = 0; float v0 = lg[0];
#pragma unroll
            for (int e = 1; e < 8; ++e) if (lg[e] > v0) { v0 = lg[e]; e0 = e; }
            int e1 = -1; float v1 = -INFINITY;
#pragma unroll
            for (int e = 0; e < 8; ++e) if (e != e0 && lg[e] > v1) { v1 = lg[e]; e1 = e; }
            const float g0 = 1.f / (1.f + __expf(v1 - v0)), g1 = 1.f - g0;
            if (F.lane == 0) { se[2 * slot] = e0; se[2 * slot + 1] = e1; sg[2 * slot] = g0; sg[2 * slot + 1] = g1; srow[slot] = r; }
        }
        __syncthreads();
        if (F.wave == 0) {
            const int l = F.lane; const int ea = se[l], eb = se[64 + l];
            const unsigned long long below = (l == 0) ? 0ull : (~0ull >> (64 - l));
            unsigned ra = 0u, rb = 0u, tot = 0u;
#pragma unroll
            for (int e = 0; e < 8; ++e) {
                const unsigned long long ma = __ballot(ea == e), mb = __ballot(eb == e);
                const unsigned ca = (unsigned)__popcll(ma), cb = (unsigned)__popcll(mb);
                if (ea == e) ra = (unsigned)__popcll(ma & below);
                if (eb == e) rb = ca + (unsigned)__popcll(mb & below);
                if (l == e) tot = ca + cb;
            }
            if (l < 8) cntb[(size_t)(bt * F.G + F.bid) * 8 + l] = tot;
            spos[l] = ra; spos[64 + l] = rb;
            asm volatile("s_waitcnt lgkmcnt(0)" ::: "memory");
            if (se[2 * l] >= 0) {
                v4u t0; t0.x = (unsigned)se[2 * l]; t0.y = spos[2 * l]; t0.z = __float_as_uint(sg[2 * l]); t0.w = (unsigned)se[2 * l + 1];
                v4u t1; t1.x = spos[2 * l + 1]; t1.y = __float_as_uint(sg[2 * l + 1]); t1.z = 0u; t1.w = 0u;
                const size_t row = (size_t)srow[l];
                *(GAS v4u*)(tokinfo + row * 8) = t0; *(GAS v4u*)(tokinfo + row * 8 + 4) = t1;
            }
        }
    }
}
#undef RT_FETCH
__device__ __forceinline__ void moe_bases(gu32* cnt, int (&tb)[9]) {
    int acc = 0;
#pragma unroll
    for (int e = 0; e < 8; ++e) { tb[e] = acc; const unsigned c = __hip_atomic_load(cnt + 64 * e, RLX_AGENT); acc += (int)((c + 255u) >> 8); }
    tb[8] = acc;
}
#ifndef MOE_TAIL_SPLIT
#define MOE_TAIL_SPLIT 1
#endif
__device__ __forceinline__ void moe_tail_split(const int (&tb)[9], int G, int& first, int& ntail) {
    const int U = tb[8] * 4; first = (U / G) * G; ntail = U - first;
    if (first == 0 || (first & 3) || ntail > 32) { first = U; ntail = 0; }
#if !MOE_TAIL_SPLIT
    first = U; ntail = 0;
#endif
}
__device__ __forceinline__ void gather_phase(Frame& F, const bf16* A4, unsigned* tokinfo, gu32* cnt, const gu32* cntb, bf16* XG) {
    const int gw = F.bid * NWAVES + F.wave, NGW = F.G * NWAVES;
    const int nbatch = (M_LAT + NGW * 8 - 1) / (NGW * 8), nent = nbatch * F.G;
    LAS float* sred = (LAS float*)F.lds;
    struct GIn { v4u t0, t1, x0, x1; };
    GIn cur, nxt;
#define G_FETCH(R_, r_) do { R_.t0 = *(const GAS v4u*)(tokinfo + (size_t)(r_) * 8); R_.t1 = *(const GAS v4u*)(tokinfo + (size_t)(r_) * 8 + 4); \
        const GAS v4u* s_ = (const GAS v4u*)(A4 + (size_t)(r_) * D); R_.x0 = s_[F.lane]; R_.x1 = s_[F.lane + 64]; } while (0)
    if (gw < M_LAT) G_FETCH(cur, gw);
    __syncthreads();
    if (F.wave == 0) {
        float tot[8];
#pragma unroll
        for (int e = 0; e < 8; ++e) tot[e] = 0.f;
        for (int i = F.lane; i < nent; i += 64) { const v4u a = *(const GAS v4u*)(cntb + (size_t)i * 8), b = *(const GAS v4u*)(cntb + (size_t)i * 8 + 4);
            tot[0] += (float)a.x; tot[1] += (float)a.y; tot[2] += (float)a.z; tot[3] += (float)a.w; tot[4] += (float)b.x; tot[5] += (float)b.y; tot[6] += (float)b.z; tot[7] += (float)b.w; }
#pragma unroll
        for (int e = 0; e < 8; ++e) { const float s = wave_sum(tot[e]); if (F.lane == 0) sred[e] = s; }
        for (int bt = 0; bt < nbatch; ++bt) {
            const int mine = bt * F.G + F.bid; float pre[8];
#pragma unroll
            for (int e = 0; e < 8; ++e) pre[e] = 0.f;
            for (int i = F.lane; i < mine; i += 64) { const v4u a = *(const GAS v4u*)(cntb + (size_t)i * 8), b = *(const GAS v4u*)(cntb + (size_t)i * 8 + 4);
                pre[0] += (float)a.x; pre[1] += (float)a.y; pre[2] += (float)a.z; pre[3] += (float)a.w; pre[4] += (float)b.x; pre[5] += (float)b.y; pre[6] += (float)b.z; pre[7] += (float)b.w; }
#pragma unroll
            for (int e = 0; e < 8; ++e) { const float s = wave_sum(pre[e]); if (F.lane == 0) sred[8 + 8 * bt + e] = s; }
        }
    }
    __syncthreads();
    int tb[9]; { int acc = 0;
#pragma unroll
        for (int e = 0; e < 8; ++e) { tb[e] = acc; const unsigned c = (unsigned)sred[e]; acc += (int)((c + 255u) >> 8); if (F.bid == 0 && F.wave == 0 && fresh_lane() == 0) __hip_atomic_store(cnt + 64 * e, c, RLX_AGENT); }
        tb[8] = acc; }
    int k = 0;
    for (int r = gw; r < M_LAT; r += NGW, ++k) {
        if (r + NGW < M_LAT) G_FETCH(nxt, r + NGW);
        const v4u t0 = cur.t0, t1 = cur.t1, x0 = cur.x0, x1 = cur.x1; cur = nxt;
        const LAS float* pre = sred + 8 + 8 * (k >> 3);
        int tbe0 = 0, tbe1 = 0; unsigned pr0 = 0u, pr1 = 0u;
#pragma unroll
        for (int e = 0; e < 8; ++e) { if ((int)t0.x == e) { tbe0 = tb[e]; pr0 = (unsigned)pre[e]; } if ((int)t0.w == e) { tbe1 = tb[e]; pr1 = (unsigned)pre[e]; } }
        const unsigned row0 = (unsigned)tbe0 * 256u + pr0 + t0.y, row1 = (unsigned)tbe1 * 256u + pr1 + t1.x;
        GAS v4u* d0 = (GAS v4u*)(XG + (size_t)row0 * D); GAS v4u* d1 = (GAS v4u*)(XG + (size_t)row1 * D);
        d0[F.lane] = x0; d0[F.lane + 64] = x1; d1[F.lane] = x0; d1[F.lane + 64] = x1;
        if (F.lane == 0) { tokinfo[(size_t)r * 8 + 6] = row0; tokinfo[(size_t)r * 8 + 7] = row1; }
    }
#undef G_FETCH
}
__device__ __forceinline__ f32x4 moe_y4(const bf16* YG, const float* slab, unsigned row, int j, int lane, unsigned tailrow0, int first, int ntail) {
    if (row < tailrow0) { const v2u a = ((const GAS v2u*)(YG + (size_t)row * D) + lane)[64 * j]; return (f32x4){bflo(a.x), bfhi(a.x), bflo(a.y), bfhi(a.y)}; }
    const size_t kstride = (size_t)(ntail >> 2) * 256 * 1024; const float* p = slab + (size_t)(row - tailrow0) * 1024 + (lane + 64 * j) * 4; f32x4 s = {0.f, 0.f, 0.f, 0.f};
    for (int ks = 0; ks < 11; ++ks) s += *(const GAS f32x4*)(p + ks * kstride);
    const unsigned w0 = pk2(s[0], s[1]), w1 = pk2(s[2], s[3]);
    return (f32x4){bflo(w0), bfhi(w0), bflo(w1), bfhi(w1)};
}
__device__ __forceinline__ void final_phase(Frame& F, float* hout, const bf16* YG, const unsigned* tokinfo, const float* mods_l, const float* norm_final, const float* slab, gu32* cnt) {
    const int gw = F.bid * NWAVES + F.wave, NGW = F.G * NWAVES;
    v4u t0c, t1c; f32x4 hc[4];
    if (gw < M_LAT) { t0c = *(const GAS v4u*)(tokinfo + (size_t)gw * 8); t1c = *(const GAS v4u*)(tokinfo + (size_t)gw * 8 + 4);
#pragma unroll
        for (int j = 0; j < 4; ++j) hc[j] = ((const GAS f32x4*)(hout + (size_t)gw * D) + F.lane)[64 * j]; }
    int tb[9]; moe_bases(cnt, tb); int first, ntail; moe_tail_split(tb, F.G, first, ntail); const unsigned tailrow0 = (unsigned)(first >> 2) * 256u;
#if defined(PROF_PH) || defined(PROF_SCANWAIT) || defined(PROF_MBWAIT) || defined(PROF_MBSEG)
#ifdef PROF_RAW
    const float prof_scale = 1.f + sqrtf(fmaxf((float)(__hip_atomic_load(F.ctl + 2, RLX_AGENT) - __hip_atomic_load(F.ctl + 4, RLX_AGENT)) * 0.01f - (PROF_OFF), 0.f) * PROF_K);
#else
    const float prof_scale = 1.f + sqrtf(__uint_as_float(__hip_atomic_load(F.ctl + 2, RLX_AGENT)) * PROF_K);
#endif
#else
    const float prof_scale = 1.f;
#endif
    for (int r = gw; r < M_LAT; r += NGW) {
        const v4u t0 = t0c, t1 = t1c; f32x4 hcur[4];
#pragma unroll
        for (int j = 0; j < 4; ++j) hcur[j] = hc[j];
        const int rn = r + NGW;
        if (rn < M_LAT) { t0c = *(const GAS v4u*)(tokinfo + (size_t)rn * 8); t1c = *(const GAS v4u*)(tokinfo + (size_t)rn * 8 + 4);
#pragma unroll
            for (int j = 0; j < 4; ++j) hc[j] = ((const GAS f32x4*)(hout + (size_t)rn * D) + F.lane)[64 * j]; }
        const float g0 = __uint_as_float(t0.z), g1 = __uint_as_float(t1.y); const unsigned row0 = t1.z, row1 = t1.w;
        const float* mp = mods_l + (r >> 11) * 6144 + 5120;
        GAS f32x4* hr = (GAS f32x4*)(hout + (size_t)r * D) + F.lane;
        f32x4 v[4]; float ss = 0.f;
#pragma unroll
        for (int j = 0; j < 4; ++j) {
            const f32x4 hh = hcur[j], mm = ((const GAS f32x4*)mp)[F.lane + 64 * j];
            const f32x4 ya = moe_y4(YG, slab, row0, j, F.lane, tailrow0, first, ntail), yb = moe_y4(YG, slab, row1, j, F.lane, tailrow0, first, ntail);
            v[j] = hh + mm * (ya * g0 + yb * g1);
            ss += (v[j].x * v[j].x + v[j].y * v[j].y) + (v[j].z * v[j].z + v[j].w * v[j].w);
        }
        const float rs = rsqrtf(wave_sum(ss) * (1.f / 1024.f) + 1e-6f);
#pragma unroll
        for (int j = 0; j < 4; ++j) { const f32x4 gg = ((const GAS f32x4*)norm_final)[F.lane + 64 * j]; hr[64 * j] = (v[j] * (rs * prof_scale)) * gg; }
    }
}

constexpr int NPHASE = 19;
#ifndef MK_PER_PHASE
#define MK_PER_PHASE 0
#endif
struct Args { const float* in[39]; float* out; unsigned char* ws; int ph_lo, ph_hi; };
#define KARGP(k) (((void* const __attribute__((address_space(4)))*)__builtin_amdgcn_kernarg_segment_ptr())[k])
#define KARG(k) ((const float*)KARGP(k))
__global__ void __launch_bounds__(NWAVES * 64, 2) mk_fwd(Args args) {
    extern __shared__ __attribute__((aligned(16))) unsigned char lds[];
    Frame F;
    F.lds = (LAS unsigned char*)lds; F.MISC = (volatile LAS unsigned*)(F.lds + MISC_OFF);
    F.tid = threadIdx.x; F.lane = F.tid & 63; F.wave = __builtin_amdgcn_readfirstlane(F.tid >> 6); F.G = gridDim.x; F.bid = blockIdx.x;
    unsigned char* ws = (unsigned char*)KARGP(40); F.ctl = (gu32*)(ws + WS_CTL);
    for (int u = F.tid; u < (LDS_BYTES - LDSCTL_OFF) / 4; u += NWAVES * 64) ((LAS unsigned*)(F.lds + LDSCTL_OFF))[u] = 0u;
    __syncthreads();
    const int lo = args.ph_lo, hi = args.ph_hi;
    unsigned long long prof_t0 = 0ull; (void)prof_t0;
    XcdBarrier bar; bar.bar = (unsigned*)(F.ctl + CW_BAR); bar.x = 0; bar.st = nullptr;
    if (hi - lo > 1) bar = xcd_barrier_post((unsigned*)(F.ctl + CW_BAR), F.MISC + 8);
#ifdef PH_MASK
#define IN(k) ((((PH_MASK) >> (k)) & 1) && lo <= (k) && (k) < hi)
#else
#define IN(k) (lo <= (k) && (k) < hi)
#endif
#ifndef DUP_MASK
#define DUP_MASK 0
#endif
#ifdef PROF_PH
#define PROF_T0(k) do { if ((k) == PROF_PH0 && F.bid == 0 && F.wave == 0 && fresh_lane() == 0) __hip_atomic_store(F.ctl + 4, (unsigned)__builtin_amdgcn_s_memrealtime(), RLX_AGENT); } while (0)
#ifdef PROF_RAW
#define PROF_T1(k) do { if ((k) == PROF_PH && F.bid == 0 && F.wave == 0 && fresh_lane() == 0) __hip_atomic_store(F.ctl + 2, (unsigned)__builtin_amdgcn_s_memrealtime(), RLX_AGENT); } while (0)
#else
#define PROF_T1(k) do { if ((k) == PROF_PH && F.bid == 0 && F.wave == 0 && fresh_lane() == 0) { const unsigned t1_ = (unsigned)__builtin_amdgcn_s_memrealtime(); __hip_atomic_store(F.ctl + 2, __float_as_uint(fmaxf((float)(t1_ - __hip_atomic_load(F.ctl + 4, RLX_AGENT)) * 0.01f - (PROF_OFF), 0.f)), RLX_AGENT); } } while (0)
#endif
#else
#define PROF_T0(k) do {} while (0)
#define PROF_T1(k) do {} while (0)
#endif
#define REPS(k) (1 + (((DUP_MASK) >> (k)) & 1))
#ifdef DOUBLE_BAR
#define SEAM(k) do { if (IN(k) && IN((k) + 1)) { xcd_barrier(bar); xcd_barrier(bar); } } while (0)
#else
#define SEAM(k) do { if (IN(k) && IN((k) + 1)) xcd_barrier(bar); } while (0)
#endif
    const float* x = KARG(0); const float* ctx = KARG(2);
    float* mods = (float*)(ws + WS_MODS); float* hctx = (float*)(ws + WS_HCTX); float* hlat = (float*)KARGP(39);
    bf16* A = (bf16*)(ws + WS_A);
    const int vcu = (F.G % 8 == 0) ? (F.bid % 8) * (F.G / 8) + F.bid / 8 : F.bid;

#define DENSEW(lo_, hi_, widx_, nw_) dense_weight_phase(F, KARG(9), KARG(10), KARG(28), KARG(29), KARG(30), KARG(31), KARG(32), ws, lo_, hi_, widx_, nw_)
    PROF_T0(0); if (IN(0)) for (int rep_ = 0; rep_ < REPS(0); ++rep_) { if (rep_) __syncthreads(); F.lane = fresh_lane(); F.tid = F.wave * 64 + F.lane; p0_phase(F, KARG(1), KARG(3), KARG(4), KARG(5), mods, KARG(9), KARG(10), KARG(28), KARG(29), KARG(30), KARG(31), KARG(32), ws); }
#ifndef P01_MERGE
#define P01_MERGE 1
#endif
    if (F.G != 256 || !P01_MERGE) SEAM(0);
    PROF_T1(0);
    PROF_T0(1); if (IN(1)) for (int rep_ = 0; rep_ < REPS(1); ++rep_) { if (rep_) __syncthreads(); F.lane = fresh_lane(); F.tid = F.wave * 64 + F.lane; if (F.G == 256 && P01_MERGE && IN(0)) counter_wait((const unsigned*)(F.ctl + CW_MODS0), 32u); normmod_phase(F, ctx, x, KARG(6), mods, 0, 1024, A); }
    SEAM(1); PROF_T1(1);
    PROF_T0(2); if (IN(2)) for (int rep_ = 0; rep_ < REPS(2); ++rep_) { if (rep_) __syncthreads(); F.lane = fresh_lane(); F.tid = F.wave * 64 + F.lane;
        pg8::Gemm g{A, (const bf16*)(ws + WS_WIN_T), M_ALL, ZLD, D}; pg8::StaticOrder S; S.init(M_ALL, ZLD, F.G, F.bid);
        pg8::EpiBf16<0> E{(bf16*)(ws + WS_Z), ZLD, nullptr, 0, 0, 1.f};
        pg8::gemm_phase<pg8::EpiBf16<0>, pg8::StaticOrder, true, true>(F.lds, g, S, E);
        { const int nfull = ((M_ALL / 256) * (ZLD / 256)) % F.G;
          if (nfull != 0 && F.bid >= nfull) DENSEW(DW_P0_END, DW_P2_END, F.bid - nfull, F.G - nfull); else if (nfull == 0) DENSEW(DW_P0_END, DW_P2_END, F.bid, F.G); }
    }
    SEAM(2); PROF_T1(2);
    PROF_T0(3); if (IN(3)) for (int rep_ = 0; rep_ < REPS(3); ++rep_) { if (rep_) __syncthreads(); F.lane = fresh_lane(); F.tid = F.wave * 64 + F.lane;
        PrepIn P{KARG(11), KARG(12), KARG(13), KARG(14), KARG(15), KARG(16), KARG(17), KARG(18), KARG(19), KARG(22), KARG(23), KARG(24)};
        prepare_phase(F, P, (const bf16*)(ws + WS_Z), (bf16*)(ws + WS_PR), (bf16*)(ws + WS_PM), (float*)(ws + WS_DT), (float*)(ws + WS_BONUS), (bf16*)(ws + WS_GATE), (bf16*)(ws + WS_ZG));
    }
    SEAM(3); PROF_T1(3);
    PROF_T0(4); if (IN(4)) for (int rep_ = 0; rep_ < REPS(4); ++rep_) { if (rep_) __syncthreads(); F.lane = fresh_lane(); F.tid = F.wave * 64 + F.lane;
        for (int u = F.bid; u < 256; u += F.G) {
            if (u < 128) { rwkv_block(F, u, (const bf16*)(ws + WS_PR), (bf16*)(ws + WS_YRW));
#ifdef RWKV2X
                rwkv_block(F, u, (const bf16*)(ws + WS_PR), (bf16*)(ws + WS_YRW));
#endif
            }
            else { mamba_block(F, u - 128, (const bf16*)(ws + WS_PM), (const float*)(ws + WS_DT), KARG(25), (bf16*)(ws + WS_YMB));
#ifdef MAMBA2X
                   mamba_block(F, u - 128, (const bf16*)(ws + WS_PM), (const float*)(ws + WS_DT), KARG(25), (bf16*)(ws + WS_YMB));
#endif
            }
        }
    }
    SEAM(4); PROF_T1(4);
    PROF_T0(5); if (IN(5)) for (int rep_ = 0; rep_ < REPS(5); ++rep_) { if (rep_) __syncthreads(); F.lane = fresh_lane(); F.tid = F.wave * 64 + F.lane;
        FinIn P{KARG(20), KARG(21), KARG(26), KARG(27)};
        finish_phase(F, P, (const bf16*)(ws + WS_YRW), (const bf16*)(ws + WS_YMB), (const bf16*)(ws + WS_PR), (const bf16*)(ws + WS_PM), (const float*)(ws + WS_BONUS), (const bf16*)(ws + WS_GATE), (const bf16*)(ws + WS_ZG), A);
    }
    SEAM(5); PROF_T1(5);
    PROF_T0(6); if (IN(6)) for (int rep_ = 0; rep_ < REPS(6); ++rep_) { if (rep_) __syncthreads(); F.lane = fresh_lane(); F.tid = F.wave * 64 + F.lane;
        {
            pg8::Gemm g{A + (size_t)M_CTX * D, (const bf16*)(ws + WS_WOUT_T), M_LAT, D, D}; pg8::StaticOrder S; S.init(M_LAT, D, F.G, F.bid);
            if (F.G == 256) { pg8::EpiResGateNorm E{x, hlat, mods, 2048, KARG(7), 3072, 4096, (bf16*)(ws + WS_A2) + (size_t)M_CTX * D, (float*)(ws + WS_XBUF), (unsigned*)(F.ctl + CW_XCNT)};
                pg8::gemm_phase<pg8::EpiResGateNorm, pg8::StaticOrder, true, true>(F.lds, g, S, E); }
            else { pg8::EpiResGate E{x, x, hlat, hlat, mods, 2048, 0};
                pg8::gemm_phase<pg8::EpiResGate, pg8::StaticOrder, true, true>(F.lds, g, S, E); }
        }
        { int l_; asm volatile("v_mbcnt_lo_u32_b32 %0, -1, 0\n\tv_mbcnt_hi_u32_b32 %0, -1, %0" : "=v"(l_) :: "memory"); F.lane = l_; F.tid = F.wave * 64 + F.lane; }
        {
            pg8::Gemm g{A, (const bf16*)(ws + WS_WOUT_T), M_CTX, D, 256, D}; pg8::SplitKOrder S{8, 4, 4, 256, F.G, F.bid};
            pg8::EpiSlabGate E{(float*)(ws + WS_SLAB6), mods + 8 * 6144 + 2048, 256};
            pg8::gemm_phase<pg8::EpiSlabGate, pg8::SplitKOrder, true, true>(F.lds, g, S, E);
        }
        { const int nsub = 8 * 4 * 4; if (F.G > nsub && F.bid >= nsub) { DENSEW(DW_P2_END, DW_P6_END, F.bid - nsub, F.G - nsub); moe_weight_phase(F, KARG(36), KARG(37), KARG(38), ws, 0, MOE_ITEMS_P6, F.bid - nsub, F.G - nsub); }
          else if (F.G <= nsub) { DENSEW(DW_P2_END, DW_P6_END, F.bid, F.G); moe_weight_phase(F, KARG(36), KARG(37), KARG(38), ws, 0, MOE_ITEMS_P6, F.bid, F.G); } }
    }
    SEAM(6); PROF_T1(6);
    PROF_T0(7); if (IN(7)) for (int rep_ = 0; rep_ < REPS(7); ++rep_) { if (rep_) __syncthreads(); F.lane = fresh_lane(); F.tid = F.wave * 64 + F.lane; normmod_phase(F, ctx, hlat, KARG(7), mods, 3072, 4096, (bf16*)(ws + WS_A2), (const float*)(ws + WS_SLAB6), 4, hctx, F.G == 256 ? M_CTX : M_ALL); moe_weight_phase(F, KARG(36), KARG(37), KARG(38), ws, MOE_ITEMS_P6, MOE_ITEMS_P7, F.bid, F.G); }
    SEAM(7); PROF_T1(7);
    PROF_T0(8); if (IN(8)) for (int rep_ = 0; rep_ < REPS(8); ++rep_) { if (rep_) __syncthreads(); F.lane = fresh_lane(); F.tid = F.wave * 64 + F.lane;
        pg8::Gemm g{(const bf16*)(ws + WS_A2), (const bf16*)(ws + WS_W13_T), M_ALL, 2 * FF, D}; pg8::StaticOrder S; S.init(M_ALL, 2 * FF, F.G, F.bid);
        pg8::EpiSwiGLU E{(bf16*)(ws + WS_HID), FF, 1 << 20, FF / 64};
        pg8::gemm_phase<pg8::EpiSwiGLU, pg8::StaticOrder, true, true>(F.lds, g, S, E);
        {
            const int nfull = ((M_ALL / 256) * (2 * FF / 256)) % F.G;
            if (nfull != 0 && F.bid >= nfull) { DENSEW(DW_P6_END, DW_P8_END, F.bid - nfull, F.G - nfull); moe_weight_phase(F, KARG(36), KARG(37), KARG(38), ws, MOE_ITEMS_P7, MOE_ITEMS_P7 + MOE_ITEMS_P8, F.bid - nfull, F.G - nfull); }
            else if (nfull == 0) { DENSEW(DW_P6_END, DW_P8_END, F.bid, F.G); moe_weight_phase(F, KARG(36), KARG(37), KARG(38), ws, MOE_ITEMS_P7, MOE_ITEMS_P7 + MOE_ITEMS_P8, F.bid, F.G); }
        }
    }
    SEAM(8); PROF_T1(8);
    PROF_T0(9); if (IN(9)) for (int rep_ = 0; rep_ < REPS(9); ++rep_) { if (rep_) __syncthreads(); F.lane = fresh_lane(); F.tid = F.wave * 64 + F.lane;
        {
            pg8::Gemm g{(const bf16*)(ws + WS_HID) + (size_t)M_CTX * FF, (const bf16*)(ws + WS_W2_T), M_LAT, D, FF, 0, FF / 64, FF / 64}; pg8::StaticOrder S; S.init(M_LAT, D, F.G, F.bid);
            if (F.G == 256) { pg8::EpiResGateNorm E{hlat, hlat, mods, 5120, KARG(6) + D, 0, 1024, A + (size_t)M_CTX * D, (float*)(ws + WS_XBUF) + 65536, (unsigned*)(F.ctl + CW_XCNT + 4096)};
                E.mods_l = mods; E.off_shift = 9 * 6144; E.off_scale = 9 * 6144 + 1024;
                pg8::gemm_phase<pg8::EpiResGateNorm, pg8::StaticOrder, true, true>(F.lds, g, S, E); }
            else { pg8::EpiResGate E{hlat, hlat, hlat, hlat, mods, 5120, 0};
                pg8::gemm_phase<pg8::EpiResGate, pg8::StaticOrder, true, true>(F.lds, g, S, E); }
        }
        { int l_; asm volatile("v_mbcnt_lo_u32_b32 %0, -1, 0\n\tv_mbcnt_hi_u32_b32 %0, -1, %0" : "=v"(l_) :: "memory"); F.lane = l_; F.tid = F.wave * 64 + F.lane; }
        {
            pg8::Gemm g{(const bf16*)(ws + WS_HID), (const bf16*)(ws + WS_W2_T), M_CTX, D, 1408, FF, FF / 64, FF / 64}; pg8::SplitKOrder S{8, 4, 2, 1408, F.G, F.bid};
            pg8::EpiSlabGate E{(float*)(ws + WS_SLAB9), mods + 8 * 6144 + 5120, 1408};
            pg8::gemm_phase<pg8::EpiSlabGate, pg8::SplitKOrder, true, true>(F.lds, g, S, E);
        }
        {
            const int nsub = 8 * 4 * 2;
            if (F.G > nsub) { if (F.bid >= nsub) { DENSEW(DW_P8_END, DW_P9_END, F.bid - nsub, F.G - nsub); moe_weight_phase(F, KARG(36), KARG(37), KARG(38), ws, MOE_ITEMS_P7 + MOE_ITEMS_P8, MOE_ITEMS_P7 + MOE_ITEMS_P8 + MOE_ITEMS_P9, F.bid - nsub, F.G - nsub); } }
            else { DENSEW(DW_P8_END, DW_P9_END, F.bid, F.G); moe_weight_phase(F, KARG(36), KARG(37), KARG(38), ws, MOE_ITEMS_P7 + MOE_ITEMS_P8, MOE_ITEMS_P7 + MOE_ITEMS_P8 + MOE_ITEMS_P9, F.bid, F.G); }
        }
    }
    SEAM(9); PROF_T1(9);
    const float* mods1 = mods + 9 * 6144;
    PROF_T0(10); if (IN(10)) for (int rep_ = 0; rep_ < REPS(10); ++rep_) { if (rep_) __syncthreads(); F.lane = fresh_lane(); F.tid = F.wave * 64 + F.lane; normmod_phase(F, hctx, hlat, KARG(6) + D, mods1, 0, 1024, A, (const float*)(ws + WS_SLAB9), 2, nullptr, F.G == 256 ? M_CTX : M_ALL); }
    SEAM(10); PROF_T1(10);
    PROF_T0(11); if (IN(11)) for (int rep_ = 0; rep_ < REPS(11); ++rep_) { if (rep_) __syncthreads(); F.lane = fresh_lane(); F.tid = F.wave * 64 + F.lane;
        pg8::Gemm g{A, (const bf16*)(ws + WS_QKV_T), M_ALL, 3 * D, D}; pg8::StaticOrder S; S.init(M_ALL, 3 * D, F.G, F.bid);
        pg8::EpiBf16<0> E{(bf16*)(ws + WS_Q), D, nullptr, D, (size_t)M_ALL * D, 0.125f * 1.4426950408889634f};
        pg8::gemm_phase<pg8::EpiBf16<0>, pg8::StaticOrder, true, true>(F.lds, g, S, E);
        {
            const int nfull = ((M_ALL / 256) * (3 * D / 256)) % F.G;
            if (nfull != 0 && F.bid >= nfull) { DENSEW(DW_P9_END, DW_END, F.bid - nfull, F.G - nfull); moe_weight_phase(F, KARG(36), KARG(37), KARG(38), ws, MOE_ITEMS - MOE_ITEMS_P16 - MOE_ITEMS_P11, MOE_ITEMS - MOE_ITEMS_P16, F.bid - nfull, F.G - nfull); }
            else if (nfull == 0) { DENSEW(DW_P9_END, DW_END, F.bid, F.G); moe_weight_phase(F, KARG(36), KARG(37), KARG(38), ws, MOE_ITEMS - MOE_ITEMS_P16 - MOE_ITEMS_P11, MOE_ITEMS - MOE_ITEMS_P16, F.bid, F.G); }
        }
    }
    SEAM(11); PROF_T1(11);
    PROF_T0(12); if (IN(12)) for (int rep_ = 0; rep_ < REPS(12); ++rep_) { if (rep_) __syncthreads(); F.lane = fresh_lane(); F.tid = F.wave * 64 + F.lane; attn_phase(F, (const bf16*)(ws + WS_Q), (const bf16*)(ws + WS_K), (const bf16*)(ws + WS_V), KARG(33), (bf16*)(ws + WS_O)); }
    SEAM(12); PROF_T1(12);
    PROF_T0(13); if (IN(13)) for (int rep_ = 0; rep_ < REPS(13); ++rep_) { if (rep_) __syncthreads(); F.lane = fresh_lane(); F.tid = F.wave * 64 + F.lane;
        pg8::Gemm g{(const bf16*)(ws + WS_O), (const bf16*)(ws + WS_NAO_T), M_LAT, D, D}; pg8::StaticOrder S; S.init(M_LAT, D, F.G, F.bid);
        if (F.G == 256) { pg8::EpiResGateNormT<true> E{hlat, hlat, mods1, 2048, KARG(7) + D, 3072, 4096, (bf16*)(ws + WS_A4), (float*)(ws + WS_XBUF) + 131072, (unsigned*)(F.ctl + CW_XCNT + 8192), KARG(34), (float*)(ws + WS_PLOG)};
            pg8::gemm_phase<pg8::EpiResGateNormT<true>, pg8::StaticOrder, true, true>(F.lds, g, S, E); }
        else { pg8::EpiResGate E{hlat, hlat, hlat, hlat, mods1, 2048, 0};
            pg8::gemm_phase<pg8::EpiResGate, pg8::StaticOrder, true, true>(F.lds, g, S, E); }
    }
    SEAM(13); PROF_T1(13);
    PROF_T0(14); if (IN(14)) for (int rep_ = 0; rep_ < REPS(14); ++rep_) { if (rep_) __syncthreads(); F.lane = fresh_lane(); F.tid = F.wave * 64 + F.lane; if (F.G == 256) router_phase<true>(F, hlat, KARG(7) + D, mods1, KARG(34), KARG(35), (bf16*)(ws + WS_A4), (unsigned*)(ws + WS_TOK), F.ctl + CW_CNTB, (const float*)(ws + WS_PLOG));
        else router_phase<false>(F, hlat, KARG(7) + D, mods1, KARG(34), KARG(35), (bf16*)(ws + WS_A4), (unsigned*)(ws + WS_TOK), F.ctl + CW_CNTB); }
    SEAM(14); PROF_T1(14);
    PROF_T0(15); if (IN(15)) for (int rep_ = 0; rep_ < REPS(15); ++rep_) { if (rep_) __syncthreads(); F.lane = fresh_lane(); F.tid = F.wave * 64 + F.lane; gather_phase(F, (const bf16*)(ws + WS_A4), (unsigned*)(ws + WS_TOK), F.ctl + CW_CNT, F.ctl + CW_CNTB, (bf16*)(ws + WS_XG)); }
    SEAM(15); PROF_T1(15);
    PROF_T0(16); if (IN(16)) for (int rep_ = 0; rep_ < REPS(16); ++rep_) { if (rep_) __syncthreads(); F.lane = fresh_lane(); F.tid = F.wave * 64 + F.lane;
        pg8::MoeOrder S; moe_bases(F.ctl + CW_CNT, S.tb); S.ntn = 22; S.G = F.G; S.c = vcu;
        pg8::Gemm g{(const bf16*)(ws + WS_XG), (const bf16*)(ws + WS_MOEW13), MOE_ROWS, NE * 2 * FF, D};
        pg8::EpiSwiGLU E{(bf16*)(ws + WS_HIDG), FF, 22, FF / 64, 1};
        pg8::gemm_phase<pg8::EpiSwiGLU, pg8::MoeOrder, true, true>(F.lds, g, S, E);
        {
            const int nlast = (S.tb[8] * 22) % F.G;
            if (nlast != 0 && vcu >= nlast) moe_weight_phase(F, KARG(36), KARG(37), KARG(38), ws, MOE_ITEMS - MOE_ITEMS_P16, MOE_ITEMS, vcu - nlast, F.G - nlast);
            else if (nlast == 0) moe_weight_phase(F, KARG(36), KARG(37), KARG(38), ws, MOE_ITEMS - MOE_ITEMS_P16, MOE_ITEMS, F.bid, F.G);
        }
    }
    SEAM(16); PROF_T1(16);
    PROF_T0(17); if (IN(17)) for (int rep_ = 0; rep_ < REPS(17); ++rep_) { if (rep_) __syncthreads(); F.lane = fresh_lane(); F.tid = F.wave * 64 + F.lane;
        pg8::MoeOrder S; moe_bases(F.ctl + CW_CNT, S.tb); S.ntn = 4; S.G = F.G; S.c = vcu;
        int first, ntail; moe_tail_split(S.tb, F.G, first, ntail); S.limit = first;
        {
            pg8::Gemm g{(const bf16*)(ws + WS_HIDG), (const bf16*)(ws + WS_MOEW2), MOE_ROWS, NE * D, FF, 0, FF / 64, FF / 64};
            pg8::EpiPlainMod E{(bf16*)(ws + WS_YG), D, 4};
            pg8::gemm_phase<pg8::EpiPlainMod, pg8::MoeOrder, true, true>(F.lds, g, S, E);
        }
#if MOE_TAIL_SPLIT
        if (ntail > 0) {
            pg8::MoeTailOrder ST;
#pragma unroll
            for (int k = 0; k < 9; ++k) ST.tb[k] = S.tb[k];
            ST.first = first; ST.ntail = ntail; ST.G = F.G; ST.c = vcu;
            pg8::Gemm g{(const bf16*)(ws + WS_HIDG), (const bf16*)(ws + WS_MOEW2), MOE_ROWS, NE * D, 256, FF, FF / 64, FF / 64};
            pg8::EpiTailSlab E{(float*)(ws + WS_TAIL), first, ntail};
            pg8::gemm_phase<pg8::EpiTailSlab, pg8::MoeTailOrder, true, true>(F.lds, g, ST, E);
        }
#endif
    }
    SEAM(17); PROF_T1(17);
    PROF_T0(18); if (IN(18)) for (int rep_ = 0; rep_ < REPS(18); ++rep_) { if (rep_) __syncthreads(); F.lane = fresh_lane(); F.tid = F.wave * 64 + F.lane; final_phase(F, hlat, (const bf16*)(ws + WS_YG), (const unsigned*)(ws + WS_TOK), mods1, KARG(8), (const float*)(ws + WS_TAIL), F.ctl + CW_CNT); }
#undef IN
#undef SEAM
}

extern "C" void kernel_launch(void* const* d_in, const int* in_sizes, int n_in, void* d_out, int out_size, void* d_ws, size_t ws_size, hipStream_t stream) {
    static int grid = 0;
    if (grid == 0) {
        if (n_in != 39 || out_size != M_LAT * D || ws_size < WS_END) { fprintf(stderr, "kernel_launch: unexpected shapes (n_in %d, out %d, ws %zu)\n", n_in, out_size, ws_size); grid = -1; return; }
        int dev = 0, cus = 0, per_cu = 0;
        if (hipGetDevice(&dev) != hipSuccess || hipDeviceGetAttribute(&cus, hipDeviceAttributeMultiprocessorCount, dev) != hipSuccess) { grid = -1; return; }
        if (hipFuncSetAttribute((const void*)mk_fwd, hipFuncAttributeMaxDynamicSharedMemorySize, LDS_BYTES) != hipSuccess) { fprintf(stderr, "kernel_launch: hipFuncSetAttribute failed\n"); grid = -1; return; }
        if (hipOccupancyMaxActiveBlocksPerMultiprocessor(&per_cu, (const void*)mk_fwd, NWAVES * 64, LDS_BYTES) != hipSuccess || per_cu < 1) fprintf(stderr, "kernel_launch: occupancy query says %d\n", per_cu);
        (void)hipGetLastError();
        grid = cus;
    }
    if (grid < 0) return;
    if (hipMemsetAsync((char*)d_ws + WS_CTL, 0, CTL_ZERO_BYTES, stream) != hipSuccess) return;
    Args a{};
    for (int i = 0; i < 39; ++i) a.in[i] = (const float*)d_in[i];
    a.out = (float*)d_out; a.ws = (unsigned char*)d_ws;
#if MK_PER_PHASE
    for (int p = 0; p < NPHASE; ++p) { a.ph_lo = p; a.ph_hi = p + 1; hipLaunchKernelGGL(mk_fwd, dim3(grid), dim3(NWAVES * 64), LDS_BYTES, stream, a); }
#else
    a.ph_lo = 0; a.ph_hi = NPHASE; hipLaunchKernelGGL(mk_fwd, dim3(grid), dim3(NWAVES * 64), LDS_BYTES, stream, a);
#endif
}
```
